# Optimizing an MI355X kernel written in HIP

```python
import math
import functools
import jax
import jax.numpy as jnp
from jax import lax
import numpy as np

D_MODEL = 1024
BATCH = 4
SEQ = 4096
DEPTH = 4

CTX_LEN = 256
GRID_W = 64
Q_BLOCK = 128
CHUNK = 128
ROPE_BASE = 10000.0
EPS = 1e-5
DEEPNORM_ALPHA = (2 * DEPTH) ** 0.25
DEEPNORM_BETA = (8 * DEPTH) ** -0.25
N_EVEN = (DEPTH + 1) // 2
N_ODD = DEPTH // 2
HA = 4
DKA = 64
DVA = 2 * DKA
HB = 4
DKB = 128
DVB = 128
CONV_W = 3
HC = 4
DKC = 64
DVC = 128
HD = 8
HKV = 2
DHD = 64
EVEN_SPLITS = (HA * 2 * DKA, HA * 2 * DKA, HA * DVA, HB * DKB, HB * DKB, HB * DVB, HB * DVB, 4 * HB)
ODD_SPLITS = (HC * DKC, HC * DKC, HC * DVC, HC * DVC, HD * DHD, HKV * DHD, HKV * DHD)
EVEN_IN = sum(EVEN_SPLITS)
ODD_IN = sum(ODD_SPLITS)
EVEN_OUT = HA * DVA + HB * DVB
ODD_OUT = HC * DVC + HD * DHD
N_GROUPS = 4
EXP_PER_GROUP = 8
N_EXPERTS = N_GROUPS * EXP_PER_GROUP
TOP_K = 2
D_EXPERT = 512
MOE_BLOCK = 128

kernel_name = "hybrid_diff_mlstm_retention_gqa_hmoe_prefix"

F32 = jnp.float32


def split_cols(p, sizes):
    return jnp.split(p, np.cumsum(sizes)[:-1].tolist(), axis=-1)


def to_heads(x, n_heads):
    b, t, _ = x.shape
    return x.reshape(b, t, n_heads, -1).transpose(0, 2, 1, 3)


def from_heads(x):
    b, h, t, d = x.shape
    return x.transpose(0, 2, 1, 3).reshape(b, t, h * d)


def layer_norm(x, g, b):
    xf = x.astype(F32)
    mu = xf.mean(-1, keepdims=True)
    var = jnp.square(xf - mu).mean(-1, keepdims=True)
    return ((xf - mu) * lax.rsqrt(var + EPS) * g + b).astype(x.dtype)


def rms_norm(x, g=None):
    xf = x.astype(F32)
    y = xf * lax.rsqrt(jnp.square(xf).mean(-1, keepdims=True) + EPS)
    if g is not None:
        y = y * g
    return y.astype(x.dtype)


def head_layer_norm(x, g, n_heads):
    b, t, w = x.shape
    xf = x.astype(F32).reshape(b, t, n_heads, w // n_heads)
    mu = xf.mean(-1, keepdims=True)
    var = jnp.square(xf - mu).mean(-1, keepdims=True)
    y = ((xf - mu) * lax.rsqrt(var + EPS)).reshape(b, t, w) * g
    return y.astype(x.dtype)


def axial_rope_tables(n_tokens, dim):
    n_rows = n_tokens // GRID_W
    row = jnp.repeat(jnp.arange(n_rows, dtype=F32), GRID_W)
    col = jnp.tile(jnp.arange(GRID_W, dtype=F32), n_rows)
    quarter = dim // 4
    inv_freq = ROPE_BASE ** (-jnp.arange(quarter, dtype=F32) / quarter)
    ang = jnp.concatenate([row[:, None] * inv_freq, col[:, None] * inv_freq], -1)
    return jnp.cos(ang), jnp.sin(ang)


def apply_rope(x, cos, sin):
    half = x.shape[-1] // 2
    x1, x2 = x[..., :half], x[..., half:]
    cos = cos.astype(x.dtype)
    sin = sin.astype(x.dtype)
    return jnp.concatenate([x1 * cos - x2 * sin, x1 * sin + x2 * cos], -1)


def map_query_blocks(block_fn, qs, t_axis):
    t = qs[0].shape[t_axis]
    nb = t // Q_BLOCK

    def split(q):
        q = q.reshape(q.shape[:t_axis] + (nb, Q_BLOCK) + q.shape[t_axis + 1:])
        return jnp.moveaxis(q, t_axis, 0)

    out = lax.map(lambda blk: block_fn(*blk), tuple(split(q) for q in qs))
    out = jnp.moveaxis(out, 0, t_axis)
    return out.reshape(out.shape[:t_axis] + (t,) + out.shape[t_axis + 2:])


def diff_attention(q1, q2, k1, k2, v, lam):
    scale = DKA ** -0.5

    def block(q1b, q2b):
        p1 = jax.nn.softmax(jnp.einsum('bhqd,bhkd->bhqk', q1b, k1).astype(F32) * scale, -1)
        p2 = jax.nn.softmax(jnp.einsum('bhqd,bhkd->bhqk', q2b, k2).astype(F32) * scale, -1)
        return jnp.einsum('bhqk,bhkd->bhqd', (p1 - lam * p2).astype(v.dtype), v)

    return map_query_blocks(block, (q1, q2), 2)


def gqa_attention(q, k, v):
    scale = DHD ** -0.5

    def block(qb):
        s = jnp.einsum('bkgqd,bksd->bkgqs', qb, k).astype(F32) * scale
        p = jax.nn.softmax(s, -1)
        return jnp.einsum('bkgqs,bksd->bkgqd', p.astype(v.dtype), v)

    return map_query_blocks(block, (q,), 3)


def short_conv(x, w, b):
    pad = CONV_W // 2
    t = x.shape[1]
    xp = jnp.pad(x, ((0, 0), (pad, pad), (0, 0)))
    y = b
    for j in range(CONV_W):
        y = y + xp[:, j:j + t] * w[j]
    return y


def to_chunks(a):
    nc = a.shape[2] // CHUNK
    return jnp.moveaxis(a.reshape(a.shape[:2] + (nc, CHUNK) + a.shape[3:]), 2, 0)


def from_chunks(h):
    h = jnp.moveaxis(h, 0, 2)
    return h.reshape(h.shape[:2] + (h.shape[2] * h.shape[3],) + h.shape[4:])


def mlstm_scan(inputs, state, with_out):
    causal = jnp.tril(jnp.ones((CHUNK, CHUNK), bool))

    def body(carry, inp):
        c_mat, n_vec, m = carry
        qc, kc, vc, lic, lfc = inp
        b = jnp.cumsum(lfc, -1)
        b_end = b[..., -1]
        log_end = b_end[..., None] - b + lic
        m_new = jnp.maximum(b_end + m, log_end.max(-1))
        carry_w = jnp.exp(b_end + m - m_new)
        wk = jnp.exp(log_end - m_new[..., None])
        c_new = carry_w[..., None, None] * c_mat + jnp.einsum('bhs,bhse,bhsd->bhed', wk, vc, kc)
        n_new = carry_w[..., None] * n_vec + jnp.einsum('bhs,bhsd->bhd', wk, kc)
        if not with_out:
            return (c_new, n_new, m_new), None
        log_intra = jnp.where(causal, b[..., :, None] - b[..., None, :] + lic[..., None, :], -jnp.inf)
        log_inter = b + m[..., None]
        m_t = jnp.maximum(log_inter, log_intra.max(-1))
        w_intra = jnp.exp(log_intra - m_t[..., None])
        w_inter = jnp.exp(log_inter - m_t)
        s = jnp.einsum('bhtd,bhsd->bhts', qc, kc) * w_intra
        num = w_inter[..., None] * jnp.einsum('bhed,bhtd->bhte', c_mat, qc) + jnp.einsum('bhts,bhse->bhte', s, vc)
        den = w_inter * jnp.einsum('bhd,bhtd->bht', n_vec, qc) + s.sum(-1)
        h = num / jnp.maximum(jnp.abs(den), jnp.exp(-m_t))[..., None]
        return (c_new, n_new, m_new), h

    state, h = lax.scan(body, state, tuple(to_chunks(a) for a in inputs))
    return state, (from_chunks(h) if with_out else None)


def retention_scan(inputs, state, with_out, log_decay):
    pos = jnp.arange(CHUNK, dtype=F32)
    lag = pos[:, None] - pos[None, :]
    lg = log_decay[:, None, None]
    intra = jnp.where(lag >= 0, jnp.exp(jnp.maximum(lag, 0.0) * lg), 0.0)
    q_decay = jnp.exp((pos + 1.0) * log_decay[:, None])[..., None]
    k_decay = jnp.exp((CHUNK - 1.0 - pos) * log_decay[:, None])[..., None]
    chunk_decay = jnp.exp(CHUNK * log_decay)[:, None, None]

    def body(s_mat, inp):
        qc, kc, vc = inp
        s_new = chunk_decay * s_mat + jnp.einsum('bhsd,bhse->bhde', kc * k_decay, vc)
        if not with_out:
            return s_new, None
        scores = jnp.einsum('bhtd,bhsd->bhts', qc, kc) * intra
        o = jnp.einsum('bhts,bhse->bhte', scores, vc) + jnp.einsum('bhtd,bhde->bhte', qc * q_decay, s_mat)
        return s_new, o

    state, o = lax.scan(body, state, tuple(to_chunks(a) for a in inputs))
    return state, (from_chunks(o) if with_out else None)


def time_flip(a, reverse):
    return jnp.flip(a, axis=2) if reverse else a


def bidir_prefix_scan(scan_fns, ctx_dirs, lat_dirs, state0, with_ctx_out):
    h_ctx, h_lat = [], []
    for d in range(2):
        rev = d == 1
        st, oc = scan_fns[d](tuple(time_flip(a, rev) for a in ctx_dirs[d]), state0, with_ctx_out)
        _, ol = scan_fns[d](tuple(time_flip(a, rev) for a in lat_dirs[d]), st, True)
        h_lat.append(time_flip(ol, rev))
        if with_ctx_out:
            h_ctx.append(time_flip(oc, rev))
    return (h_ctx[0] + h_ctx[1] if with_ctx_out else None), h_lat[0] + h_lat[1]


def even_mixer(h_lat, h_ctx, w_in, w_out, lam_p, subln_g, conv_w, conv_b, gate_b, mnorm_g, layer_idx, with_ctx):
    bsz, t_lat, _ = h_lat.shape
    pl = split_cols(h_lat @ w_in, EVEN_SPLITS)
    pc = split_cols(h_ctx @ w_in, EVEN_SPLITS)
    lam_init = 0.8 - 0.6 * math.exp(-0.3 * layer_idx)
    lp = lam_p.astype(F32)
    lam = jnp.exp(jnp.sum(lp[0] * lp[1])) - jnp.exp(jnp.sum(lp[2] * lp[3])) + lam_init
    cos, sin = axial_rope_tables(t_lat, DKA)

    def diff_pair(a):
        b, t, _ = a.shape
        a = a.reshape(b, t, HA, 2, DKA).transpose(3, 0, 2, 1, 4)
        return a[0], a[1]

    def diff_post(o):
        return from_heads(rms_norm(o, subln_g) * (1.0 - lam_init))

    k1_c, k2_c = diff_pair(pc[1])
    v_c = to_heads(pc[2], HA)
    q1_l, q2_l = [apply_rope(a, cos, sin) for a in diff_pair(pl[0])]
    k1_l, k2_l = [apply_rope(a, cos, sin) for a in diff_pair(pl[1])]
    a_l = diff_post(diff_attention(q1_l, q2_l,
                                   jnp.concatenate([k1_c, k1_l], 2),
                                   jnp.concatenate([k2_c, k2_l], 2),
                                   jnp.concatenate([v_c, to_heads(pl[2], HA)], 2), lam))

    def mlstm_dirs(p):
        b, t, _ = p[3].shape
        qk = jax.nn.silu(short_conv(jnp.concatenate([p[3], p[4]], -1), conv_w, conv_b))
        q = to_heads(qk[..., :HB * DKB], HB).astype(F32)
        k = to_heads(qk[..., HB * DKB:], HB).astype(F32) * DKB ** -0.5
        v = to_heads(p[5], HB).astype(F32)
        g = (p[7].reshape(b, t, 4, HB).astype(F32) + gate_b).transpose(2, 0, 3, 1)
        return [(q, k, v, g[0], jax.nn.log_sigmoid(g[1])), (q, k, v, g[2], jax.nn.log_sigmoid(g[3]))]

    state0 = (jnp.zeros((bsz, HB, DVB, DKB), F32), jnp.zeros((bsz, HB, DKB), F32), jnp.zeros((bsz, HB), F32))
    m_c, m_l = bidir_prefix_scan([mlstm_scan, mlstm_scan], mlstm_dirs(pc), mlstm_dirs(pl), state0, with_ctx)

    def mlstm_post(h_sum, p):
        y = from_heads(h_sum).astype(p[6].dtype) * jax.nn.sigmoid(p[6])
        return head_layer_norm(y, mnorm_g, HB)

    out_l = jnp.concatenate([a_l, mlstm_post(m_l, pl)], -1) @ w_out
    out_c = None
    if with_ctx:
        q1_c, q2_c = diff_pair(pc[0])
        a_c = diff_post(diff_attention(q1_c, q2_c, k1_c, k2_c, v_c, lam))
        out_c = jnp.concatenate([a_c, mlstm_post(m_c, pc)], -1) @ w_out
    return out_l, out_c


def odd_mixer(h_lat, h_ctx, w_in, w_out, decay_logit, qk_g, with_ctx):
    bsz, t_lat, _ = h_lat.shape
    pl = split_cols(h_lat @ w_in, ODD_SPLITS)
    pc = split_cols(h_ctx @ w_in, ODD_SPLITS)
    log_decay = jax.nn.log_sigmoid(decay_logit.astype(F32))

    def ret_inputs(p):
        q = to_heads(p[0], HC).astype(F32)
        k = to_heads(p[1], HC).astype(F32) * DKC ** -0.5
        v = to_heads(p[2], HC).astype(F32)
        return (q, k, v)

    ret_c, ret_l = ret_inputs(pc), ret_inputs(pl)
    scan_fns = [functools.partial(retention_scan, log_decay=log_decay[d]) for d in range(2)]
    s0 = jnp.zeros((bsz, HC, DKC, DVC), F32)
    r_c, r_l = bidir_prefix_scan(scan_fns, [ret_c, ret_c], [ret_l, ret_l], s0, with_ctx)

    def ret_post(r, p):
        return from_heads(rms_norm(r)).astype(p[3].dtype) * jax.nn.silu(p[3])

    cos, sin = axial_rope_tables(t_lat, DHD)

    def group_q(q):
        b, h, t, d = q.shape
        return q.reshape(b, HKV, HD // HKV, t, d)

    def ungroup(o):
        b, k, g, t, d = o.shape
        return from_heads(o.reshape(b, k * g, t, d))

    k_c = rms_norm(to_heads(pc[5], HKV), qk_g[1])
    v_c = to_heads(pc[6], HKV)
    q_l = apply_rope(rms_norm(to_heads(pl[4], HD), qk_g[0]), cos, sin)
    k_l = apply_rope(rms_norm(to_heads(pl[5], HKV), qk_g[1]), cos, sin)
    a_l = ungroup(gqa_attention(group_q(q_l), jnp.concatenate([k_c, k_l], 2),
                                jnp.concatenate([v_c, to_heads(pl[6], HKV)], 2)))
    out_l = jnp.concatenate([ret_post(r_l, pl), a_l], -1) @ w_out
    out_c = None
    if with_ctx:
        q_c = rms_norm(to_heads(pc[4], HD), qk_g[0])
        a_c = ungroup(gqa_attention(group_q(q_c), k_c, v_c))
        out_c = jnp.concatenate([ret_post(r_c, pc), a_c], -1) @ w_out
    return out_l, out_c


def hier_moe(h, w_group, b_group, w_router, b_router, w_gate, w_up, w_down):
    n, d = h.shape
    hf = h.astype(F32)
    g_logits = hf @ w_group + b_group
    g_prob = jax.nn.softmax(g_logits, -1)
    g_idx = jnp.argmax(g_logits, -1)
    g_w = jnp.take_along_axis(g_prob, g_idx[:, None], -1)
    e_logits = (hf @ w_router + b_router).reshape(n, N_GROUPS, EXP_PER_GROUP)
    e_logits = jnp.take_along_axis(e_logits, g_idx[:, None, None], 1)[:, 0]
    top_v, top_i = lax.top_k(e_logits, TOP_K)
    weights = (jax.nn.softmax(top_v, -1) * g_w).reshape(-1)
    expert = (g_idx[:, None] * EXP_PER_GROUP + top_i).reshape(-1)
    token = jnp.repeat(jnp.arange(n), TOP_K)
    order = jnp.argsort(expert)
    s_exp, s_tok, s_w = expert[order], token[order], weights[order]
    counts = jnp.bincount(expert, length=N_EXPERTS)
    padded = (counts + MOE_BLOCK - 1) // MOE_BLOCK * MOE_BLOCK
    padded_end = jnp.cumsum(padded)
    dest = (padded_end - padded)[s_exp] + jnp.arange(n * TOP_K) - (jnp.cumsum(counts) - counts)[s_exp]
    n_blocks = -(-(n * TOP_K) // MOE_BLOCK) + N_EXPERTS
    buf = jnp.zeros((n_blocks * MOE_BLOCK, d), h.dtype).at[dest].set(h[s_tok])
    block_exp = jnp.minimum(jnp.searchsorted(padded_end, jnp.arange(n_blocks) * MOE_BLOCK, side='right'),
                            N_EXPERTS - 1)

    def expert_block(args):
        xb, e = args
        return (jax.nn.silu(xb @ w_gate[e]) * (xb @ w_up[e])) @ w_down[e]

    y = lax.map(expert_block, (buf.reshape(n_blocks, MOE_BLOCK, d), block_exp)).reshape(-1, d)
    out = jax.ops.segment_sum(y[dest].astype(F32) * s_w[:, None], s_tok, num_segments=n)
    return out.astype(h.dtype)


def setup_inputs(seed: int = 0) -> dict:
    key = jax.random.key(seed)
    keys = iter(jax.random.split(key, 40))

    def nrm(shape, scale):
        return jax.random.normal(next(keys), shape, F32) * scale

    d = D_MODEL
    forget_base = jnp.zeros((4, HB), F32).at[1].set(jnp.linspace(3.0, 6.0, HB)).at[3].set(jnp.linspace(3.0, 6.0, HB))
    decay_base = jnp.log(2.0 ** (5.0 + jnp.arange(HC, dtype=F32)) - 1.0)
    return {
        "x": nrm((BATCH, SEQ, d), 1.0),
        "c": nrm((BATCH, d), 1.0),
        "ctx": nrm((BATCH, CTX_LEN, d), 1.0),
        "c_ctx": nrm((d,), 1.0),
        "w_mod": nrm((DEPTH, d, 6 * d), 0.5 * d ** -0.5),
        "b_mod": nrm((DEPTH, 6 * d), 0.02),
        "ln_g": 1.0 + nrm((DEPTH, 2, d), 0.02),
        "ln_b": nrm((DEPTH, 2, d), 0.02),
        "ev_w_in": nrm((N_EVEN, d, EVEN_IN), d ** -0.5),
        "ev_w_out": nrm((N_EVEN, EVEN_OUT, d), DEEPNORM_BETA * EVEN_OUT ** -0.5),
        "ev_lambda": nrm((N_EVEN, 4, DKA), 0.1),
        "ev_subln_g": 1.0 + nrm((N_EVEN, DVA), 0.02),
        "ev_conv_w": nrm((N_EVEN, CONV_W, 2 * HB * DKB), CONV_W ** -0.5),
        "ev_conv_b": nrm((N_EVEN, 2 * HB * DKB), 0.02),
        "ev_gate_b": forget_base + nrm((N_EVEN, 4, HB), 0.1),
        "ev_mnorm_g": 1.0 + nrm((N_EVEN, HB * DVB), 0.02),
        "od_w_in": nrm((N_ODD, d, ODD_IN), d ** -0.5),
        "od_w_out": nrm((N_ODD, ODD_OUT, d), DEEPNORM_BETA * ODD_OUT ** -0.5),
        "od_decay": decay_base + nrm((N_ODD, 2, HC), 0.1),
        "od_qk_g": 1.0 + nrm((N_ODD, 2, DHD), 0.02),
        "moe_w_group": nrm((DEPTH, d, N_GROUPS), d ** -0.5),
        "moe_b_group": nrm((DEPTH, N_GROUPS), 0.01),
        "moe_w_router": nrm((DEPTH, d, N_EXPERTS), d ** -0.5),
        "moe_b_router": nrm((DEPTH, N_EXPERTS), 0.01),
        "moe_w_gate": nrm((DEPTH, N_EXPERTS, d, D_EXPERT), d ** -0.5),
        "moe_w_up": nrm((DEPTH, N_EXPERTS, d, D_EXPERT), d ** -0.5),
        "moe_w_down": nrm((DEPTH, N_EXPERTS, D_EXPERT, d), DEEPNORM_BETA * D_EXPERT ** -0.5),
    }


def reference(x, c, ctx, c_ctx, w_mod, b_mod, ln_g, ln_b, ev_w_in, ev_w_out, ev_lambda, ev_subln_g,
              ev_conv_w, ev_conv_b, ev_gate_b, ev_mnorm_g, od_w_in, od_w_out, od_decay, od_qk_g,
              moe_w_group, moe_b_group, moe_w_router, moe_b_router, moe_w_gate, moe_w_up, moe_w_down):
    c_act = jax.nn.silu(c)
    cc_act = jax.nn.silu(c_ctx)
    x_lat, x_ctx = x, ctx
    for layer in range(DEPTH):
        with_ctx = layer < DEPTH - 1
        i = layer // 2
        mod_l = [m[:, None, :] for m in jnp.split(c_act @ w_mod[layer] + b_mod[layer], 6, -1)]
        mod_c = jnp.split(cc_act @ w_mod[layer] + b_mod[layer], 6, -1)
        h_l = x_lat * (1.0 + mod_l[1]) + mod_l[0]
        h_c = x_ctx * (1.0 + mod_c[1]) + mod_c[0]
        if layer % 2 == 0:
            o_l, o_c = even_mixer(h_l, h_c, ev_w_in[i], ev_w_out[i], ev_lambda[i], ev_subln_g[i], ev_conv_w[i],
                                  ev_conv_b[i], ev_gate_b[i], ev_mnorm_g[i], layer, with_ctx)
        else:
            o_l, o_c = odd_mixer(h_l, h_c, od_w_in[i], od_w_out[i], od_decay[i], od_qk_g[i], with_ctx)
        x_lat = layer_norm(DEEPNORM_ALPHA * x_lat + mod_l[2] * o_l, ln_g[layer, 0], ln_b[layer, 0])
        h_l = x_lat * (1.0 + mod_l[4]) + mod_l[3]
        moe_p = (moe_w_group[layer], moe_b_group[layer], moe_w_router[layer], moe_b_router[layer],
                 moe_w_gate[layer], moe_w_up[layer], moe_w_down[layer])
        if with_ctx:
            x_ctx = layer_norm(DEEPNORM_ALPHA * x_ctx + mod_c[2] * o_c, ln_g[layer, 0], ln_b[layer, 0])
            h_c = x_ctx * (1.0 + mod_c[4]) + mod_c[3]
            n_c = h_c.shape[0] * h_c.shape[1]
            y = hier_moe(jnp.concatenate([h_c.reshape(n_c, -1), h_l.reshape(-1, h_l.shape[-1])], 0), *moe_p)
            x_ctx = layer_norm(DEEPNORM_ALPHA * x_ctx + mod_c[5] * y[:n_c].reshape(h_c.shape),
                               ln_g[layer, 1], ln_b[layer, 1])
            y_l = y[n_c:].reshape(h_l.shape)
        else:
            y_l = hier_moe(h_l.reshape(-1, h_l.shape[-1]), *moe_p).reshape(h_l.shape)
        x_lat = layer_norm(DEEPNORM_ALPHA * x_lat + mod_l[5] * y_l, ln_g[layer, 1], ln_b[layer, 1])
    return x_lat
```

```cpp
#ifdef CPU_EMU
#include "emu.h"
#else
#include <hip/hip_runtime.h>
#include <hip/hip_cooperative_groups.h>
#include <cstdio>
#include <cstdint>
#include <cstring>
namespace cg = cooperative_groups;
#endif

#define DEV __device__ __forceinline__
#ifdef CPU_EMU
#define SCHED_BARRIER() do {} while (0)
#else
#define SCHED_BARRIER() __builtin_amdgcn_sched_barrier(0)
#endif
#ifdef CPU_EMU
static inline int tid_() { return (int)threadIdx.x; }
static inline int bid_() { return (int)blockIdx.x; }
#else
__device__ __forceinline__ int tid_() { int t = threadIdx.x; asm volatile("" : "+v"(t)); return t; }
__device__ __forceinline__ int bid_() { int b = blockIdx.x; asm volatile("" : "+s"(b)); return b; }
#endif

#ifdef CPU_EMU_SMALL
constexpr int D_MODEL = 256, BATCH = 2, SEQ = 256, CTX = 256, D_EXPERT = 128;
#else
constexpr int D_MODEL = 1024, BATCH = 4, SEQ = 4096, CTX = 256, D_EXPERT = 512;
#endif
constexpr int DEPTH = 4, GRID_W = 64, CH = 128;
constexpr int TT = CTX + SEQ, NTOK = BATCH * TT, NCH = TT / CH, NCC = CTX / CH;
constexpr float EPS = 1e-5f;
constexpr float ALPHA = 1.6817928305074290f;
constexpr int HA = 4, HB = 4, HC = 4, HD = 8, HKV = 2;
constexpr int EVEN_IN = 3600, EVEN_INP = 3712, ODD_IN = 2304, MIX_OUT = 1024;
constexpr int NG = 4, EPG = 8, NE = 32, NR = NG + NE;
constexpr int NTHREADS = 256;
constexpr int LDS_BYTES = 76 * 1024;
constexpr int NCHAIN = BATCH * 4 * 2;
constexpr int EVR = 144;

typedef unsigned short bf16_t;
typedef short bf16x8 __attribute__((ext_vector_type(8)));
typedef float f32x4 __attribute__((ext_vector_type(4)));
typedef unsigned u32x4 __attribute__((ext_vector_type(4)));
typedef unsigned u32x2 __attribute__((ext_vector_type(2)));
union Frag { bf16x8 v; u32x4 q; u32x2 d[2]; unsigned u[4]; };
DEV int imin(int a, int b) { return a < b ? a : b; }

DEV bf16_t f2bf(float f) { unsigned u = __float_as_uint(f); u += 0x7FFFu + ((u >> 16) & 1u); return (bf16_t)(u >> 16); }
DEV float bf2f(bf16_t h) { return __uint_as_float(((unsigned)h) << 16); }
DEV unsigned pack2(float a, float b) { return (unsigned)f2bf(a) | ((unsigned)f2bf(b) << 16); }
DEV float siluf(float x) { return x / (1.0f + __expf(-x)); }
DEV float sigmf(float x) { return 1.0f / (1.0f + __expf(-x)); }
DEV float logsigf(float x) { return (x >= 0.f) ? -log1pf(expf(-x)) : x - log1pf(expf(x)); }
DEV float wsum(float v) { for (int m = 32; m >= 1; m >>= 1) v += __shfl_xor(v, m); return v; }
DEV float wmax(float v) { for (int m = 32; m >= 1; m >>= 1) v = fmaxf(v, __shfl_xor(v, m)); return v; }
DEV f32x4 mfma16(bf16x8 a, bf16x8 b, f32x4 c) { return __builtin_amdgcn_mfma_f32_16x16x32_bf16(a, b, c, 0, 0, 0); }

struct Params {
    const float *x, *c, *ctx, *c_ctx, *w_mod, *b_mod, *ln_g, *ln_b, *ev_w_in, *ev_w_out, *ev_lambda, *ev_subln_g, *ev_conv_w, *ev_conv_b,
        *ev_gate_b, *ev_mnorm_g, *od_w_in, *od_w_out, *od_decay, *od_qk_g, *moe_w_group, *moe_b_group, *moe_w_router, *moe_b_router,
        *moe_w_gate, *moe_w_up, *moe_w_down;
    float* out;
    float *X, *MOD, *ROPE, *LAM, *WrT;
    int* CNT;
    bf16_t *WinE, *WinO, *WoutT, *Wgu, *WdT;
    bf16_t *Q1, *K1, *V1T;
    bf16_t *PM, *V2T, *OG;
    float* G;
    bf16_t *Q2, *K2, *K2T;
    bf16_t* CAT;
    float* DC; bf16_t* CP;
    float *BC, *AT, *MT, *MS;
    bf16_t *H, *ACT; float* YS;
    int *LIST, *TOKSLOT, *BASE; float *LISTW;
};

constexpr int GLD = 72;
constexpr int GT = 128 * GLD;

struct BLoadW {
    const bf16_t* base; int ld; u32x4 r[4];
    DEV void fetch(int kt, int tid) {
#pragma unroll
        for (int i = 0; i < 4; ++i) { int c = tid + 256 * i, row = c >> 3, kc = c & 7; r[i] = *(const u32x4*)(base + (size_t)row * ld + kt * 64 + kc * 8); }
    }
    DEV void commit(bf16_t* S, int tid) {
#pragma unroll
        for (int i = 0; i < 4; ++i) { int c = tid + 256 * i, row = c >> 3, kc = c & 7; *(u32x4*)(S + row * GLD + kc * 8) = r[i]; }
    }
};
struct ALoadB {
    const bf16_t* base; int ld; u32x4 r[4];
    DEV void fetch(int kt, int tid) {
#pragma unroll
        for (int i = 0; i < 4; ++i) { int c = tid + 256 * i, row = c >> 3, kc = c & 7; r[i] = *(const u32x4*)(base + (size_t)row * ld + kt * 64 + kc * 8); }
    }
    DEV void commit(bf16_t* S, int tid) {
#pragma unroll
        for (int i = 0; i < 4; ++i) { int c = tid + 256 * i, row = c >> 3, kc = c & 7; *(u32x4*)(S + row * GLD + kc * 8) = r[i]; }
    }
};
struct ALoadG {
    const bf16_t* H; const int* list; int nvalid; u32x4 r[4];
    DEV void fetch(int kt, int tid) {
#pragma unroll
        for (int i = 0; i < 4; ++i) {
            int c = tid + 256 * i, row = c >> 3, kc = c & 7; int rr = row < nvalid ? row : nvalid - 1; int tok = list[rr];
            r[i] = *(const u32x4*)(H + (size_t)tok * D_MODEL + kt * 64 + kc * 8);
        }
    }
    DEV void commit(bf16_t* S, int tid) {
#pragma unroll
        for (int i = 0; i < 4; ++i) { int c = tid + 256 * i, row = c >> 3, kc = c & 7; *(u32x4*)(S + row * GLD + kc * 8) = r[i]; }
    }
};
struct ALoadX {
    const float* base; const float *sc, *sh; f32x4 r[8]; f32x4 s4, h4;
    DEV void fetch(int kt, int tid) {
        int kc = tid & 15;
        s4 = *(const f32x4*)(sc + kt * 64 + kc * 4); h4 = *(const f32x4*)(sh + kt * 64 + kc * 4);
#pragma unroll
        for (int i = 0; i < 8; ++i) { int row = (tid >> 4) + 16 * i; r[i] = *(const f32x4*)(base + (size_t)row * D_MODEL + kt * 64 + kc * 4); }
    }
    DEV void commit(bf16_t* S, int tid) {
        int kc = tid & 15;
#pragma unroll
        for (int i = 0; i < 8; ++i) {
            int row = (tid >> 4) + 16 * i;
            u32x2 o; o.x = pack2(r[i].x * (1.f + s4.x) + h4.x, r[i].y * (1.f + s4.y) + h4.y); o.y = pack2(r[i].z * (1.f + s4.z) + h4.z, r[i].w * (1.f + s4.w) + h4.w);
            *(u32x2*)(S + row * GLD + kc * 4) = o;
        }
    }
};

template <class AL, class BL, class EP>
DEV void gemm_tile(bf16_t* sm, AL& al, BL& bl, int nkt, EP& ep) {
    const int tid = tid_(), wid = tid >> 6, lane = tid & 63, wr = wid >> 1, wc = wid & 1, r = lane & 15, quad = lane >> 4;
    bf16_t* As = sm; bf16_t* Bs = sm + 2 * GT;
    f32x4 acc[4][4];
#pragma unroll
    for (int m = 0; m < 4; ++m)
#pragma unroll
        for (int n = 0; n < 4; ++n) acc[m][n] = f32x4{0.f, 0.f, 0.f, 0.f};
    al.fetch(0, tid); bl.fetch(0, tid); al.commit(As, tid); bl.commit(Bs, tid);
    __syncthreads();
    for (int kt = 0; kt < nkt; ++kt) {
        const int cur = kt & 1;
        if (kt + 1 < nkt) { al.fetch(kt + 1, tid); bl.fetch(kt + 1, tid); }
        const bf16_t* Ac = As + cur * GT + (wr * 64 + r) * GLD + quad * 8;
        const bf16_t* Bc = Bs + cur * GT + (wc * 64 + r) * GLD + quad * 8;
#pragma unroll
        for (int ks = 0; ks < 2; ++ks) {
            Frag a[4], b[4];
#pragma unroll
            for (int m = 0; m < 4; ++m) a[m].q = *(const u32x4*)(Ac + m * 16 * GLD + ks * 32);
#pragma unroll
            for (int n = 0; n < 4; ++n) b[n].q = *(const u32x4*)(Bc + n * 16 * GLD + ks * 32);
#pragma unroll
            for (int m = 0; m < 4; ++m)
#pragma unroll
                for (int n = 0; n < 4; ++n) acc[m][n] = mfma16(a[m].v, b[n].v, acc[m][n]);
        }
        if (kt + 1 < nkt) { al.commit(As + (cur ^ 1) * GT, tid); bl.commit(Bs + (cur ^ 1) * GT, tid); }
        __syncthreads();
    }
    ep(acc, wr, wc, lane);
}

DEV void conv_tile(float* T, const float* src, int ldsrc, int N, int K, int k0, int n0, bf16_t* dst, int mapkind) {
    const int tid = tid_();
    __syncthreads();
#pragma unroll
    for (int i = 0; i < 4; ++i) {
        int kk = (tid >> 4) + 16 * i, n4 = tid & 15; int n = n0 + 4 * n4;
        f32x4 v = f32x4{0.f, 0.f, 0.f, 0.f};
        if (n + 3 < N) v = *(const f32x4*)(src + (size_t)(k0 + kk) * ldsrc + n);
        T[(4 * n4 + 0) * 65 + kk] = v.x; T[(4 * n4 + 1) * 65 + kk] = v.y; T[(4 * n4 + 2) * 65 + kk] = v.z; T[(4 * n4 + 3) * 65 + kk] = v.w;
    }
    __syncthreads();
    {
        int nl = tid >> 2, ks = (tid & 3) * 16; int n = n0 + nl; int dr = n;
        if (mapkind == 1) dr = (n >> 5) * 64 + (n & 31); else if (mapkind == 2) dr = (n >> 5) * 64 + 32 + (n & 31);
        const float* t = T + nl * 65 + ks;
        u32x4 o0, o1;
        o0.x = pack2(t[0], t[1]); o0.y = pack2(t[2], t[3]); o0.z = pack2(t[4], t[5]); o0.w = pack2(t[6], t[7]);
        o1.x = pack2(t[8], t[9]); o1.y = pack2(t[10], t[11]); o1.z = pack2(t[12], t[13]); o1.w = pack2(t[14], t[15]);
        bf16_t* d = dst + (size_t)dr * K + k0 + ks;
        *(u32x4*)d = o0; *(u32x4*)(d + 8) = o1;
    }
}

DEV void phase0(const Params& p, unsigned char* smem) {
    const int tid = tid_();
    float* fs = (float*)smem;
    constexpr int NMOD = DEPTH * 6 * D_MODEL / 256;
    constexpr int NCOPY = NTOK / 64;
    constexpr int T_EIN = (D_MODEL / 64) * (EVEN_INP / 64), T_OIN = (D_MODEL / 64) * (ODD_IN / 64), T_OUT = (MIX_OUT / 64) * (D_MODEL / 64);
    constexpr int T_GU = (D_MODEL / 64) * (D_EXPERT / 64), T_DN = (D_EXPERT / 64) * (D_MODEL / 64);
    constexpr int C0 = NMOD + NCOPY + 1 + DEPTH;
    constexpr int C1 = C0 + 2 * T_EIN, C2 = C1 + 2 * T_OIN, C3 = C2 + DEPTH * T_OUT, C4 = C3 + DEPTH * NE * 2 * T_GU, C5 = C4 + DEPTH * NE * T_DN;
    for (int task = bid_(); task < C5; task += gridDim.x) {
        if (task < NMOD) {
            __syncthreads();
            for (int i = tid; i < (BATCH + 1) * D_MODEL; i += 256) { int bb = i / D_MODEL, k = i % D_MODEL; float v = bb < BATCH ? p.c[bb * D_MODEL + k] : p.c_ctx[k]; fs[i] = v / (1.f + expf(-v)); }
            __syncthreads();
            int col = task * 256 + tid; int layer = col / (6 * D_MODEL), j = col % (6 * D_MODEL);
            const float* w = p.w_mod + (size_t)layer * D_MODEL * 6 * D_MODEL + j;
            float acc[BATCH + 1];
#pragma unroll
            for (int bb = 0; bb <= BATCH; ++bb) acc[bb] = 0.f;
            for (int k = 0; k < D_MODEL; ++k) {
                float wv = w[(size_t)k * 6 * D_MODEL];
#pragma unroll
                for (int bb = 0; bb <= BATCH; ++bb) acc[bb] += fs[bb * D_MODEL + k] * wv;
            }
            float bm = p.b_mod[layer * 6 * D_MODEL + j];
#pragma unroll
            for (int bb = 0; bb <= BATCH; ++bb) p.MOD[((size_t)layer * (BATCH + 1) + bb) * 6 * D_MODEL + j] = acc[bb] + bm;
        } else if (task < NMOD + NCOPY) {
            int r0 = (task - NMOD) * 64;
            for (int i = tid; i < 64 * D_MODEL / 4; i += 256) {
                int row = r0 + i / (D_MODEL / 4), c4 = i % (D_MODEL / 4); int b = row / TT, s = row % TT;
                const float* src = s < CTX ? p.ctx + ((size_t)b * CTX + s) * D_MODEL : p.x + ((size_t)b * SEQ + (s - CTX)) * D_MODEL;
                *(f32x4*)(p.X + (size_t)row * D_MODEL + c4 * 4) = *(const f32x4*)(src + c4 * 4);
            }
        } else if (task == NMOD + NCOPY) {
            for (int i = tid; i < 64 * 16; i += 256) {
                int pos = i / 16, f = i % 16;
                double th = 1.0; for (int q = 0; q < f; ++q) th *= 0.5623413251903490804;
                double t2 = th * th, cs = 1.0, sn = th, tc = 1.0, ts = th;
                for (int n = 1; n < 14; ++n) { tc *= -t2 / ((2 * n - 1) * (2 * n)); ts *= -t2 / ((2 * n) * (2 * n + 1)); cs += tc; sn += ts; }
                double c = 1.0, s = 0.0;
                for (int q = 0; q < pos; ++q) { double cn = c * cs - s * sn, sn2 = s * cs + c * sn; c = cn; s = sn2; }
                p.ROPE[i * 2] = (float)c; p.ROPE[i * 2 + 1] = (float)s;
            }
            if (tid < 2) {
                const float* lp = p.ev_lambda + tid * 4 * 64; float s01 = 0.f, s23 = 0.f;
                for (int k = 0; k < 64; ++k) { s01 += lp[k] * lp[64 + k]; s23 += lp[128 + k] * lp[192 + k]; }
                float lam_init = 0.8f - 0.6f * expf(-0.3f * (float)(2 * tid));
                p.LAM[tid] = expf(s01) - expf(s23) + lam_init;
            }
            for (int i = tid; i < DEPTH * NE; i += 256) p.CNT[i] = 0;
        } else if (task < C0) {
            int layer = task - (NMOD + NCOPY + 1);
            for (int i = tid; i < NR * D_MODEL; i += 256) {
                int j = i / D_MODEL, k = i % D_MODEL;
                float v = j < NG ? p.moe_w_group[((size_t)layer * D_MODEL + k) * NG + j] : p.moe_w_router[((size_t)layer * D_MODEL + k) * NE + (j - NG)];
                p.WrT[(size_t)layer * NR * D_MODEL + i] = v;
            }
        } else if (task < C1) {
            int t = task - C0, i = t / T_EIN, tt = t % T_EIN; int nt = tt % (EVEN_INP / 64), kt = tt / (EVEN_INP / 64);
            conv_tile(fs, p.ev_w_in + (size_t)i * D_MODEL * EVEN_IN, EVEN_IN, EVEN_IN, D_MODEL, kt * 64, nt * 64, p.WinE + (size_t)i * EVEN_INP * D_MODEL, 0);
        } else if (task < C2) {
            int t = task - C1, i = t / T_OIN, tt = t % T_OIN; int nt = tt % (ODD_IN / 64), kt = tt / (ODD_IN / 64);
            conv_tile(fs, p.od_w_in + (size_t)i * D_MODEL * ODD_IN, ODD_IN, ODD_IN, D_MODEL, kt * 64, nt * 64, p.WinO + (size_t)i * ODD_IN * D_MODEL, 0);
        } else if (task < C3) {
            int t = task - C2, layer = t / T_OUT, tt = t % T_OUT; int nt = tt % (D_MODEL / 64), kt = tt / (D_MODEL / 64);
            const float* src = (layer & 1) ? p.od_w_out + (size_t)(layer >> 1) * MIX_OUT * D_MODEL : p.ev_w_out + (size_t)(layer >> 1) * MIX_OUT * D_MODEL;
            conv_tile(fs, src, D_MODEL, D_MODEL, MIX_OUT, kt * 64, nt * 64, p.WoutT + (size_t)layer * D_MODEL * MIX_OUT, 0);
        } else if (task < C4) {
            int t = task - C3, le = t / (2 * T_GU), tt = t % (2 * T_GU); int up = tt / T_GU; tt %= T_GU; int nt = tt % (D_EXPERT / 64), kt = tt / (D_EXPERT / 64);
            const float* src = (up ? p.moe_w_up : p.moe_w_gate) + (size_t)le * D_MODEL * D_EXPERT;
            conv_tile(fs, src, D_EXPERT, D_EXPERT, D_MODEL, kt * 64, nt * 64, p.Wgu + (size_t)le * 2 * D_EXPERT * D_MODEL, 1 + up);
        } else {
            int t = task - C4, le = t / T_DN, tt = t % T_DN; int nt = tt % (D_MODEL / 64), kt = tt / (D_MODEL / 64);
            conv_tile(fs, p.moe_w_down + (size_t)le * D_EXPERT * D_MODEL, D_MODEL, D_MODEL, D_EXPERT, kt * 64, nt * 64, p.WdT + (size_t)le * D_MODEL * D_EXPERT, 0);
        }
    }
}

DEV int chunk_of(int dir, int sp) { return dir == 0 ? sp : (sp < NCC ? NCC - 1 - sp : NCC + (NCH - 1 - sp)); }
DEV int sp_of(int dir, int u) { return dir == 0 ? u : (u < NCC ? NCC - 1 - u : NCC + (NCH - 1 - u)); }

template <bool RET>
DEV void gate_chain(const Params& p, int layer, int chain) {
    const int lane = tid_() & 63;
    const int dir = chain & 1, h = (chain >> 1) & 3, b = chain >> 3;
    float lg = 0.f;
    if (RET) lg = logsigf(p.od_decay[((layer >> 1) * 2 + dir) * HC + h]);
    float mprev = 0.f;
    for (int sp = 0; sp < NCH; ++sp) {
        const int u = chunk_of(dir, sp); const int sbase = u * CH;
        int i0 = 2 * lane, i1 = 2 * lane + 1;
        int s0 = dir ? sbase + 127 - i0 : sbase + i0, s1 = dir ? sbase + 127 - i1 : sbase + i1;
        float lf0, lf1, li0, li1;
        if (RET) { lf0 = lf1 = lg; li0 = li1 = 0.f; }
        else {
            const float* g0 = p.G + ((size_t)b * TT + s0) * 16; const float* g1 = p.G + ((size_t)b * TT + s1) * 16;
            li0 = g0[(2 * dir) * 4 + h]; li1 = g1[(2 * dir) * 4 + h];
            lf0 = logsigf(g0[(2 * dir + 1) * 4 + h]); lf1 = logsigf(g1[(2 * dir + 1) * 4 + h]);
        }
        float ps = lf0 + lf1;
        for (int d = 1; d < 64; d <<= 1) { float o = __shfl_up(ps, d); if (lane >= d) ps += o; }
        float b1 = ps, b0 = ps - lf1;
        float bend = __shfl(ps, 63);
        float a0 = li0 - b0, a1 = li1 - b1;
        float pm = fmaxf(a0, a1);
        float mx = pm;
        for (int d = 1; d < 64; d <<= 1) { float o = __shfl_up(mx, d); if (lane >= d) mx = fmaxf(mx, o); }
        float pmx_prev = __shfl_up(mx, 1); if (lane == 0) pmx_prev = -3.0e38f;
        float pm0 = fmaxf(pmx_prev, a0), pm1 = mx;
        float amax = __shfl(mx, 63);
        float mnew, carry, mt0, mt1;
        if (RET) { mnew = 0.f; carry = __expf(bend); mt0 = mt1 = 0.f; }
        else { mnew = fmaxf(bend + mprev, bend + amax); carry = __expf(bend + mprev - mnew); mt0 = b0 + fmaxf(mprev, pm0); mt1 = b1 + fmaxf(mprev, pm1); }
        size_t o = (size_t)chain * TT;
        p.BC[o + s0] = b0; p.BC[o + s1] = b1; p.AT[o + s0] = a0; p.AT[o + s1] = a1; p.MT[o + s0] = mt0; p.MT[o + s1] = mt1;
        if (lane == 0) { float* ms = p.MS + ((size_t)chain * NCH + sp) * 4; ms[0] = mprev; ms[1] = mnew; ms[2] = bend; ms[3] = carry; }
        mprev = mnew;
    }
}

struct EpInEven {
    const Params& p; int layer, row0, col0;
    DEV void operator()(f32x4 (&acc)[4][4], int wr, int wc, int lane) {
        const int r = lane & 15, quad = lane >> 4;
        const int c0 = col0 + wc * 64, rowb = row0 + wr * 64;
        const int b = row0 / TT; const int sb = rowb - b * TT; const bool lat = sb >= CTX;
        if (c0 < 1024) {
            bf16_t* dst = c0 < 512 ? p.Q1 : p.K1; const int cc = c0 & 511;
#pragma unroll
            for (int m = 0; m < 4; ++m)
#pragma unroll
                for (int j = 0; j < 4; ++j) {
                    const int row = rowb + m * 16 + quad * 4 + j;
                    float v0 = acc[m][0][j], v1 = acc[m][1][j], v2 = acc[m][2][j], v3 = acc[m][3][j];
                    if (lat) {
                        const int t = sb + m * 16 + quad * 4 + j - CTX; const int pr = t / GRID_W, pc = t % GRID_W;
                        const float cr = p.ROPE[(pr * 16 + r) * 2], sr = p.ROPE[(pr * 16 + r) * 2 + 1], cq = p.ROPE[(pc * 16 + r) * 2], sq = p.ROPE[(pc * 16 + r) * 2 + 1];
                        float o0 = v0 * cr - v2 * sr, o2 = v0 * sr + v2 * cr, o1 = v1 * cq - v3 * sq, o3 = v1 * sq + v3 * cq;
                        v0 = o0; v1 = o1; v2 = o2; v3 = o3;
                    }
                    bf16_t* d = dst + (size_t)row * 512 + cc + r;
                    d[0] = f2bf(v0); d[16] = f2bf(v1); d[32] = f2bf(v2); d[48] = f2bf(v3);
                }
        } else if (c0 < 1536 || (c0 >= 2560 && c0 < 3072)) {
            const bool at = c0 < 1536; const int cc = at ? c0 - 1024 : c0 - 2560; const int h = cc >> 7, e0 = (cc & 127);
            bf16_t* dst = (at ? p.V1T : p.V2T) + ((size_t)(b * 4 + h) * 128) * TT;
#pragma unroll
            for (int m = 0; m < 4; ++m)
#pragma unroll
                for (int n = 0; n < 4; ++n) {
                    u32x2 o; o.x = pack2(acc[m][n][0], acc[m][n][1]); o.y = pack2(acc[m][n][2], acc[m][n][3]);
                    *(u32x2*)(dst + (size_t)(e0 + n * 16 + r) * TT + sb + m * 16 + quad * 4) = o;
                }
        } else if (c0 < 2560 || (c0 >= 3072 && c0 < 3584)) {
            const bool pm = c0 < 2560; bf16_t* dst = pm ? p.PM : p.OG; const int ld = pm ? 1024 : 512; const int cc = pm ? c0 - 1536 : c0 - 3072;
#pragma unroll
            for (int m = 0; m < 4; ++m)
#pragma unroll
                for (int j = 0; j < 4; ++j) {
                    const int row = rowb + m * 16 + quad * 4 + j; bf16_t* d = dst + (size_t)row * ld + cc + r;
                    d[0] = f2bf(acc[m][0][j]); d[16] = f2bf(acc[m][1][j]); d[32] = f2bf(acc[m][2][j]); d[48] = f2bf(acc[m][3][j]);
                }
        } else if (c0 == 3584) {
            const float gb = p.ev_gate_b[(layer >> 1) * 16 + r];
#pragma unroll
            for (int m = 0; m < 4; ++m)
#pragma unroll
                for (int j = 0; j < 4; ++j) { const int row = rowb + m * 16 + quad * 4 + j; p.G[(size_t)row * 16 + r] = acc[m][0][j] + gb; }
        }
    }
};

struct EpInOdd {
    const Params& p; int layer, row0, col0;
    DEV void operator()(f32x4 (&acc)[4][4], int wr, int wc, int lane) {
        const int r = lane & 15, quad = lane >> 4;
        const int c0 = col0 + wc * 64, rowb = row0 + wr * 64;
        const int b = row0 / TT; const int sb = rowb - b * TT; const bool lat = sb >= CTX;
        if (c0 < 512 || (c0 >= 1024 && c0 < 1536)) {
            bf16_t* dst; int ld, cc; float scl = 1.f;
            if (c0 < 256) { dst = p.Q2; ld = 256; cc = c0; } else if (c0 < 512) { dst = p.K2; ld = 256; cc = c0 - 256; scl = 0.125f; } else { dst = p.OG; ld = 512; cc = c0 - 1024; }
#pragma unroll
            for (int m = 0; m < 4; ++m)
#pragma unroll
                for (int j = 0; j < 4; ++j) {
                    const int row = rowb + m * 16 + quad * 4 + j; bf16_t* d = dst + (size_t)row * ld + cc + r;
                    d[0] = f2bf(acc[m][0][j] * scl); d[16] = f2bf(acc[m][1][j] * scl); d[32] = f2bf(acc[m][2][j] * scl); d[48] = f2bf(acc[m][3][j] * scl);
                }
            if (c0 >= 256 && c0 < 512) {
                const int h = (c0 - 256) >> 6; bf16_t* dt = p.K2T + ((size_t)(b * 4 + h) * 64) * TT;
#pragma unroll
                for (int m = 0; m < 4; ++m)
#pragma unroll
                    for (int n = 0; n < 4; ++n) {
                        u32x2 o; o.x = pack2(acc[m][n][0] * scl, acc[m][n][1] * scl); o.y = pack2(acc[m][n][2] * scl, acc[m][n][3] * scl);
                        *(u32x2*)(dt + (size_t)(n * 16 + r) * TT + sb + m * 16 + quad * 4) = o;
                    }
            }
        } else if (c0 < 1024) {
            const int cc = c0 - 512; const int h = cc >> 7, e0 = cc & 127; bf16_t* dst = p.V2T + ((size_t)(b * 4 + h) * 128) * TT;
#pragma unroll
            for (int m = 0; m < 4; ++m)
#pragma unroll
                for (int n = 0; n < 4; ++n) {
                    u32x2 o; o.x = pack2(acc[m][n][0], acc[m][n][1]); o.y = pack2(acc[m][n][2], acc[m][n][3]);
                    *(u32x2*)(dst + (size_t)(e0 + n * 16 + r) * TT + sb + m * 16 + quad * 4) = o;
                }
        } else if (c0 < 2176) {
            const bool isq = c0 < 2048; bf16_t* dst = isq ? p.Q1 : p.K1; const int ld = isq ? 512 : 128; const int cc = isq ? c0 - 1536 : c0 - 2048;
            const float* g = p.od_qk_g + ((layer >> 1) * 2 + (isq ? 0 : 1)) * 64;
            const float g0 = g[r], g1 = g[16 + r], g2 = g[32 + r], g3 = g[48 + r];
#pragma unroll
            for (int m = 0; m < 4; ++m)
#pragma unroll
                for (int j = 0; j < 4; ++j) {
                    const int row = rowb + m * 16 + quad * 4 + j;
                    float v0 = acc[m][0][j], v1 = acc[m][1][j], v2 = acc[m][2][j], v3 = acc[m][3][j];
                    float ss = v0 * v0 + v1 * v1 + v2 * v2 + v3 * v3;
                    ss += __shfl_xor(ss, 1); ss += __shfl_xor(ss, 2); ss += __shfl_xor(ss, 4); ss += __shfl_xor(ss, 8);
                    const float rs = 1.0f / sqrtf(ss * (1.f / 64.f) + EPS);
                    v0 *= rs * g0; v1 *= rs * g1; v2 *= rs * g2; v3 *= rs * g3;
                    if (lat) {
                        const int t = sb + m * 16 + quad * 4 + j - CTX; const int pr = t / GRID_W, pc = t % GRID_W;
                        const float cr = p.ROPE[(pr * 16 + r) * 2], sr = p.ROPE[(pr * 16 + r) * 2 + 1], cq = p.ROPE[(pc * 16 + r) * 2], sq = p.ROPE[(pc * 16 + r) * 2 + 1];
                        float o0 = v0 * cr - v2 * sr, o2 = v0 * sr + v2 * cr, o1 = v1 * cq - v3 * sq, o3 = v1 * sq + v3 * cq;
                        v0 = o0; v1 = o1; v2 = o2; v3 = o3;
                    }
                    bf16_t* d = dst + (size_t)row * ld + cc + r;
                    d[0] = f2bf(v0); d[16] = f2bf(v1); d[32] = f2bf(v2); d[48] = f2bf(v3);
                }
        } else {
            const int kv = (c0 - 2176) >> 6; bf16_t* dst = p.V1T + ((size_t)(b * HKV + kv) * 64) * TT;
#pragma unroll
            for (int m = 0; m < 4; ++m)
#pragma unroll
                for (int n = 0; n < 4; ++n) {
                    u32x2 o; o.x = pack2(acc[m][n][0], acc[m][n][1]); o.y = pack2(acc[m][n][2], acc[m][n][3]);
                    *(u32x2*)(dst + (size_t)(n * 16 + r) * TT + sb + m * 16 + quad * 4) = o;
                }
        }
    }
};

DEV void phaseA(const Params& p, int layer, unsigned char* smem) {
    const bool odd = layer & 1;
    const int ncol = odd ? ODD_IN / 128 : EVEN_INP / 128; const int nrow = NTOK / 128;
    const bf16_t* W = odd ? p.WinO + (size_t)(layer >> 1) * ODD_IN * D_MODEL : p.WinE + (size_t)(layer >> 1) * EVEN_INP * D_MODEL;
    const int bid = bid_();
    if (odd && bid < NCHAIN && tid_() < 64) gate_chain<true>(p, layer, bid);
    for (int t = bid; t < nrow * ncol; t += gridDim.x) {
        const int rt = t / ncol, ct = t % ncol; const int row0 = rt * 128, col0 = ct * 128;
        const int b = row0 / TT, s = row0 % TT; const int bb = s < CTX ? BATCH : b;
        const float* mod = p.MOD + ((size_t)layer * (BATCH + 1) + bb) * 6 * D_MODEL;
        ALoadX al; al.base = p.X + (size_t)row0 * D_MODEL; al.sh = mod; al.sc = mod + D_MODEL;
        BLoadW bl; bl.base = W + (size_t)col0 * D_MODEL; bl.ld = D_MODEL;
        if (odd) { EpInOdd ep{p, layer, row0, col0}; gemm_tile((bf16_t*)smem, al, bl, D_MODEL / 64, ep); }
        else { EpInEven ep{p, layer, row0, col0}; gemm_tile((bf16_t*)smem, al, bl, D_MODEL / 64, ep); }
    }
}

DEV void phaseB(const Params& p, int layer) {
    const int tid = tid_();
    const int bid = bid_();
    if (bid < NCHAIN && tid < 64) gate_chain<false>(p, layer, bid);
    const float* cw = p.ev_conv_w + (size_t)(layer >> 1) * 3 * 1024; const float* cb = p.ev_conv_b + (size_t)(layer >> 1) * 1024;
    const int total = NTOK * 128;
    for (int idx = bid * 256 + tid; idx < total; idx += gridDim.x * 256) {
        const int row = idx >> 7, cg8 = (idx & 127) * 8; const int b = row / TT, s = row % TT;
        const bool hasp = (s != 0) && (s != CTX), hasn = (s != CTX - 1) && (s != TT - 1);
        Frag xm, x0, xp; x0.q = *(const u32x4*)(p.PM + (size_t)row * 1024 + cg8);
        xm.q = u32x4{0u, 0u, 0u, 0u}; xp.q = u32x4{0u, 0u, 0u, 0u};
        if (hasp) xm.q = *(const u32x4*)(p.PM + (size_t)(row - 1) * 1024 + cg8);
        if (hasn) xp.q = *(const u32x4*)(p.PM + (size_t)(row + 1) * 1024 + cg8);
        float y[8];
#pragma unroll
        for (int i = 0; i < 8; ++i) {
            const int ch = cg8 + i;
            float v = cb[ch] + bf2f((bf16_t)xm.v[i]) * cw[ch] + bf2f((bf16_t)x0.v[i]) * cw[1024 + ch] + bf2f((bf16_t)xp.v[i]) * cw[2048 + ch];
            y[i] = siluf(v);
        }
        if (cg8 < 512) {
            u32x4 o; o.x = pack2(y[0], y[1]); o.y = pack2(y[2], y[3]); o.z = pack2(y[4], y[5]); o.w = pack2(y[6], y[7]);
            *(u32x4*)(p.Q2 + (size_t)row * 512 + cg8) = o;
        } else {
            const float sc = 0.08838834764831845f;
#pragma unroll
            for (int i = 0; i < 8; ++i) y[i] *= sc;
            u32x4 o; o.x = pack2(y[0], y[1]); o.y = pack2(y[2], y[3]); o.z = pack2(y[4], y[5]); o.w = pack2(y[6], y[7]);
            const int kc = cg8 - 512; *(u32x4*)(p.K2 + (size_t)row * 512 + kc) = o;
            const int h = kc >> 7, d0 = kc & 127;
            bf16_t* dt = p.K2T + ((size_t)(b * 4 + h) * 128 + d0) * TT + s;
#pragma unroll
            for (int i = 0; i < 8; ++i) dt[(size_t)i * TT] = f2bf(y[i]);
        }
    }
}

constexpr int KLD1 = 136, KLD0 = 72, VLD = 72;
template <int NC, int DV, int QT>
struct AttnState { f32x4 O[NC][DV / 16][QT]; float m[NC][QT], l[NC][QT]; };

template <int NC, int DV, int QT, int KW>
DEV void attn_core(bf16_t* sm, const bf16_t* Kg, int ldk, const bf16_t* VTg, int nkeys, const Frag (&qf)[NC][2][QT], AttnState<NC, DV, QT>& st, float sc2, int koff) {
    constexpr int KLD = KW + 8;
    const int tid = tid_(), lane = tid & 63, r = lane & 15, quad = lane >> 4;
    bf16_t* Ks = sm; bf16_t* Vs = sm + 64 * KLD;
    for (int k0 = 0; k0 < nkeys; k0 += 64) {
        __syncthreads();
        for (int c = tid; c < 64 * KW / 8; c += 256) { int row = c / (KW / 8), kc = c % (KW / 8); *(u32x4*)(Ks + row * KLD + kc * 8) = *(const u32x4*)(Kg + (size_t)(k0 + row) * ldk + kc * 8); }
        for (int c = tid; c < DV * 8; c += 256) { int row = c >> 3, kc = c & 7; *(u32x4*)(Vs + row * VLD + kc * 8) = *(const u32x4*)(VTg + (size_t)row * TT + k0 + kc * 8); }
        __syncthreads();
#pragma unroll
        for (int c = 0; c < NC; ++c) {
            Frag pf[QT][2];
            f32x4 s[4][QT];
            SCHED_BARRIER();
#pragma unroll
            for (int kt = 0; kt < 4; ++kt) {
                Frag ka0, ka1;
                ka0.q = *(const u32x4*)(Ks + (kt * 16 + r) * KLD + koff + c * 64 + quad * 8);
                ka1.q = *(const u32x4*)(Ks + (kt * 16 + r) * KLD + koff + c * 64 + 32 + quad * 8);
#pragma unroll
                for (int qt = 0; qt < QT; ++qt) {
                    f32x4 z = f32x4{0.f, 0.f, 0.f, 0.f};
                    z = mfma16(ka0.v, qf[c][0][qt].v, z); z = mfma16(ka1.v, qf[c][1][qt].v, z); s[kt][qt] = z;
                }
            }
            SCHED_BARRIER();
#pragma unroll
            for (int qt = 0; qt < QT; ++qt) {
                float mx = -3.0e38f;
#pragma unroll
                for (int kt = 0; kt < 4; ++kt)
#pragma unroll
                    for (int j = 0; j < 4; ++j) mx = fmaxf(mx, s[kt][qt][j]);
                mx = fmaxf(mx, __shfl_xor(mx, 16)); mx = fmaxf(mx, __shfl_xor(mx, 32));
                const float mn = fmaxf(st.m[c][qt], mx * sc2);
                const float al = __builtin_amdgcn_exp2f(st.m[c][qt] - mn);
                st.m[c][qt] = mn;
                float ls = 0.f;
#pragma unroll
                for (int kt = 0; kt < 4; ++kt)
#pragma unroll
                    for (int j = 0; j < 4; ++j) { float e = __builtin_amdgcn_exp2f(s[kt][qt][j] * sc2 - mn); s[kt][qt][j] = e; ls += e; }
                st.l[c][qt] = st.l[c][qt] * al + ls;
#pragma unroll
                for (int et = 0; et < DV / 16; ++et) { st.O[c][et][qt][0] *= al; st.O[c][et][qt][1] *= al; st.O[c][et][qt][2] *= al; st.O[c][et][qt][3] *= al; }
#pragma unroll
                for (int kk = 0; kk < 2; ++kk) {
                    pf[qt][kk].u[0] = pack2(s[2 * kk][qt][0], s[2 * kk][qt][1]); pf[qt][kk].u[1] = pack2(s[2 * kk][qt][2], s[2 * kk][qt][3]);
                    pf[qt][kk].u[2] = pack2(s[2 * kk + 1][qt][0], s[2 * kk + 1][qt][1]); pf[qt][kk].u[3] = pack2(s[2 * kk + 1][qt][2], s[2 * kk + 1][qt][3]);
                }
            }
            SCHED_BARRIER();
#pragma unroll
            for (int et = 0; et < DV / 16; ++et) {
#pragma unroll
                for (int kk = 0; kk < 2; ++kk) {
                    Frag vf; const bf16_t* vp = Vs + (et * 16 + r) * VLD + kk * 32 + quad * 4;
                    vf.d[0] = *(const u32x2*)vp; vf.d[1] = *(const u32x2*)(vp + 16);
#pragma unroll
                    for (int qt = 0; qt < QT; ++qt) st.O[c][et][qt] = mfma16(vf.v, pf[qt][kk].v, st.O[c][et][qt]);
                }
                if ((et & 1) == 1) SCHED_BARRIER();
            }
        }
    }
#pragma unroll
    for (int c = 0; c < NC; ++c)
#pragma unroll
        for (int qt = 0; qt < QT; ++qt) { float l = st.l[c][qt]; l += __shfl_xor(l, 16); l += __shfl_xor(l, 32); st.l[c][qt] = l; }
}

DEV void attn_diff_item(const Params& p, int layer, int item, bf16_t* sm) {
    const int nqb = TT / 64; const int qb = item % nqb, h = (item / nqb) % HA, b = item / (nqb * HA);
    const int tid = tid_(), wid = tid >> 6, lane = tid & 63, r = lane & 15, quad = lane >> 4;
    const int comp = wid & 1, rg = wid >> 1;
    const int s0 = qb * 64; const bool ctxq = s0 < CTX; const int nkeys = ctxq ? CTX : TT;
    Frag qf[1][2][2];
#pragma unroll
    for (int ks = 0; ks < 2; ++ks)
#pragma unroll
        for (int qt = 0; qt < 2; ++qt) qf[0][ks][qt].q = *(const u32x4*)(p.Q1 + ((size_t)b * TT + s0 + rg * 32 + qt * 16 + r) * 512 + h * 128 + comp * 64 + ks * 32 + quad * 8);
    AttnState<1, 128, 2> st;
#pragma unroll
    for (int qt = 0; qt < 2; ++qt) {
        st.m[0][qt] = -3.0e38f; st.l[0][qt] = 0.f;
#pragma unroll
        for (int et = 0; et < 8; ++et) st.O[0][et][qt] = f32x4{0.f, 0.f, 0.f, 0.f};
    }
    attn_core<1, 128, 2, 128>(sm, p.K1 + (size_t)b * TT * 512 + h * 128, 512, p.V1T + ((size_t)(b * HA + h) * 128) * TT, nkeys, qf, st, 0.125f * 1.4426950408889634f, comp * 64);
    const float lam = p.LAM[layer >> 1]; const float lam_init = 0.8f - 0.6f * expf(-0.3f * (float)layer);
    const float* sg = p.ev_subln_g + (layer >> 1) * 128;
    f32x4* xo = (f32x4*)sm;
    __syncthreads();
    if (comp == 1) {
#pragma unroll
        for (int qt = 0; qt < 2; ++qt) {
            const float i2 = lam / st.l[0][qt];
#pragma unroll
            for (int et = 0; et < 8; ++et) xo[((rg * 2 + qt) * 8 + et) * 64 + lane] = f32x4{st.O[0][et][qt][0] * i2, st.O[0][et][qt][1] * i2, st.O[0][et][qt][2] * i2, st.O[0][et][qt][3] * i2};
        }
    }
    __syncthreads();
    if (comp == 0) {
#pragma unroll
        for (int qt = 0; qt < 2; ++qt) {
            const float i1 = 1.f / st.l[0][qt];
            float ss = 0.f; f32x4 o[8];
#pragma unroll
            for (int et = 0; et < 8; ++et) {
                const f32x4 x2 = xo[((rg * 2 + qt) * 8 + et) * 64 + lane];
#pragma unroll
                for (int j = 0; j < 4; ++j) { float v = st.O[0][et][qt][j] * i1 - x2[j]; o[et][j] = v; ss += v * v; }
            }
            ss += __shfl_xor(ss, 16); ss += __shfl_xor(ss, 32);
            const float rs = (1.f - lam_init) / sqrtf(ss * (1.f / 128.f) + EPS);
            bf16_t* dst = p.CAT + ((size_t)b * TT + s0 + rg * 32 + qt * 16 + r) * 1024 + h * 128;
#pragma unroll
            for (int et = 0; et < 8; ++et) {
                const int e = et * 16 + quad * 4;
                u32x2 w; w.x = pack2(o[et][0] * rs * sg[e], o[et][1] * rs * sg[e + 1]); w.y = pack2(o[et][2] * rs * sg[e + 2], o[et][3] * rs * sg[e + 3]);
                *(u32x2*)(dst + e) = w;
            }
        }
    }
}

DEV void attn_gqa_item(const Params& p, int item, bf16_t* sm) {
    const int nqb = TT / 64; const int qb = item % nqb, kv = (item / nqb) % HKV, b = item / (nqb * HKV);
    const int tid = tid_(), wid = tid >> 6, lane = tid & 63, r = lane & 15, quad = lane >> 4;
    const int s0 = qb * 64; const bool ctxq = s0 < CTX; const int nkeys = ctxq ? CTX : TT; const int hq = kv * 4 + wid;
    Frag qf[1][2][4];
#pragma unroll
    for (int ks = 0; ks < 2; ++ks)
#pragma unroll
        for (int qt = 0; qt < 4; ++qt) qf[0][ks][qt].q = *(const u32x4*)(p.Q1 + ((size_t)b * TT + s0 + qt * 16 + r) * 512 + hq * 64 + ks * 32 + quad * 8);
    AttnState<1, 64, 4> st;
#pragma unroll
    for (int qt = 0; qt < 4; ++qt) {
        st.m[0][qt] = -3.0e38f; st.l[0][qt] = 0.f;
#pragma unroll
        for (int et = 0; et < 4; ++et) st.O[0][et][qt] = f32x4{0.f, 0.f, 0.f, 0.f};
    }
    attn_core<1, 64, 4, 64>(sm, p.K1 + (size_t)b * TT * 128 + kv * 64, 128, p.V1T + ((size_t)(b * HKV + kv) * 64) * TT, nkeys, qf, st, 0.125f * 1.4426950408889634f, 0);
#pragma unroll
    for (int qt = 0; qt < 4; ++qt) {
        const float il = 1.f / st.l[0][qt];
        bf16_t* dst = p.CAT + ((size_t)b * TT + s0 + qt * 16 + r) * 1024 + 512 + hq * 64;
#pragma unroll
        for (int et = 0; et < 4; ++et) {
            const int e = et * 16 + quad * 4;
            u32x2 w; w.x = pack2(st.O[0][et][qt][0] * il, st.O[0][et][qt][1] * il); w.y = pack2(st.O[0][et][qt][2] * il, st.O[0][et][qt][3] * il);
            *(u32x2*)(dst + e) = w;
        }
    }
}

template <int DK, bool NRM>
DEV void rec_dc_item(const Params& p, int item, bf16_t* sm) {
    constexpr int ET = NRM ? 9 : 8; constexpr int ER = NRM ? EVR : 128; constexpr int SLD = 136;
    const int chain = item / NCH, sp = item % NCH; const int dir = chain & 1, h = (chain >> 1) & 3, b = chain >> 3;
    const int u = chunk_of(dir, sp), sbase = u * CH;
    const int tid = tid_(), wid = tid >> 6, lane = tid & 63, r = lane & 15, quad = lane >> 4;
    bf16_t* Vs = sm; bf16_t* Ks = sm + 128 * SLD; float* wk = (float*)(sm + 128 * SLD + DK * SLD);
    __syncthreads();
    const float* ms = p.MS + ((size_t)chain * NCH + sp) * 4;
    if (tid < 128) wk[tid] = __expf(ms[2] + p.AT[(size_t)chain * TT + sbase + tid] - ms[1]);
    const bf16_t* vt = p.V2T + ((size_t)(b * 4 + h) * 128) * TT + sbase;
    for (int c = tid; c < 128 * 16; c += 256) { int row = c >> 4, kc = c & 15; *(u32x4*)(Vs + row * SLD + kc * 8) = *(const u32x4*)(vt + (size_t)row * TT + kc * 8); }
    __syncthreads();
    const bf16_t* kt = p.K2T + ((size_t)(b * 4 + h) * DK) * TT + sbase;
    for (int c = tid; c < DK * 16; c += 256) {
        int row = c >> 4, kc = c & 15; Frag f; f.q = *(const u32x4*)(kt + (size_t)row * TT + kc * 8);
        Frag o;
#pragma unroll
        for (int i = 0; i < 4; ++i) o.u[i] = pack2(bf2f((bf16_t)f.v[2 * i]) * wk[kc * 8 + 2 * i], bf2f((bf16_t)f.v[2 * i + 1]) * wk[kc * 8 + 2 * i + 1]);
        *(u32x4*)(Ks + row * SLD + kc * 8) = o.q;
    }
    __syncthreads();
    constexpr int NTW = DK / 64;
    f32x4 acc[ET][NTW];
#pragma unroll
    for (int et = 0; et < ET; ++et)
#pragma unroll
        for (int n = 0; n < NTW; ++n) acc[et][n] = f32x4{0.f, 0.f, 0.f, 0.f};
#pragma unroll
    for (int ks = 0; ks < 4; ++ks) {
        Frag bf[NTW];
#pragma unroll
        for (int n = 0; n < NTW; ++n) bf[n].q = *(const u32x4*)(Ks + ((wid + 4 * n) * 16 + r) * SLD + ks * 32 + quad * 8);
#pragma unroll
        for (int et = 0; et < ET; ++et) {
            Frag af;
            if (et < 8) af.q = *(const u32x4*)(Vs + (et * 16 + r) * SLD + ks * 32 + quad * 8);
            else { const unsigned one = (r == 0) ? 0x3F803F80u : 0u; af.q = u32x4{one, one, one, one}; }
#pragma unroll
            for (int n = 0; n < NTW; ++n) acc[et][n] = mfma16(af.v, bf[n].v, acc[et][n]);
        }
    }
    float* dc = p.DC + ((size_t)chain * NCH + sp) * ER * DK;
#pragma unroll
    for (int et = 0; et < ET; ++et)
#pragma unroll
        for (int n = 0; n < NTW; ++n)
#pragma unroll
            for (int j = 0; j < 4; ++j) dc[(size_t)(et * 16 + quad * 4 + j) * DK + (wid + 4 * n) * 16 + r] = acc[et][n][j];
}

template <int DK, bool NRM>
DEV void rec_scan(const Params& p) {
    constexpr int ER = NRM ? EVR : 128;
    const int total = NCHAIN * ER * DK;
    for (int idx = bid_() * 256 + tid_(); idx < total; idx += gridDim.x * 256) {
        const int chain = idx / (ER * DK), el = idx % (ER * DK);
        float c = 0.f;
        for (int sp = 0; sp < NCH; ++sp) {
            const size_t o = ((size_t)chain * NCH + sp) * ER * DK + el;
            p.CP[o] = f2bf(c);
            c = p.MS[((size_t)chain * NCH + sp) * 4 + 3] * c + p.DC[o];
        }
    }
}

template <int DK, bool NRM>
DEV void rec_out_item(const Params& p, int layer, int item, bf16_t* sm) {
    constexpr int ET = NRM ? 9 : 8; constexpr int ER = NRM ? EVR : 128; constexpr int KLD = DK + 8; constexpr int SLD = 136; constexpr int NKS = DK / 32;
    const int half = item & 1, u = (item >> 1) % NCH, h = ((item >> 1) / NCH) & 3, b = (item >> 1) / (NCH * 4);
    const int tid = tid_(), wid = tid >> 6, lane = tid & 63, r = lane & 15, quad = lane >> 4;
    const int sbase = u * CH; const int tl = half * 64 + wid * 16 + r;
    const size_t rowt = (size_t)b * TT + sbase + tl; const int tq = tl - quad * 4;
    bf16_t* RA = sm; bf16_t* Vs = sm + ER * KLD; float* as_ = (float*)(Vs + 128 * SLD);
    __syncthreads();
    const bf16_t* kg = p.K2 + ((size_t)b * TT + sbase) * (4 * DK) + h * DK;
    for (int c = tid; c < 128 * (DK / 8); c += 256) { int row = c / (DK / 8), kc = c % (DK / 8); *(u32x4*)(RA + row * KLD + kc * 8) = *(const u32x4*)(kg + (size_t)row * (4 * DK) + kc * 8); }
    const int chain0 = (b * 4 + h) * 2;
    as_[tid] = p.AT[(size_t)(chain0 + (tid >> 7)) * TT + sbase + (tid & 127)];
    Frag qf[NKS];
#pragma unroll
    for (int ks = 0; ks < NKS; ++ks) qf[ks].q = *(const u32x4*)(p.Q2 + rowt * (4 * DK) + h * DK + ks * 32 + quad * 8);
    __syncthreads();
    f32x4 sT[8];
#pragma unroll
    for (int st = 0; st < 8; ++st) {
        if ((st & 1) == 0) SCHED_BARRIER();
        f32x4 z = f32x4{0.f, 0.f, 0.f, 0.f};
#pragma unroll
        for (int ks = 0; ks < NKS; ++ks) { Frag ka; ka.q = *(const u32x4*)(RA + (st * 16 + r) * KLD + ks * 32 + quad * 8); z = mfma16(ka.v, qf[ks].v, z); }
        sT[st] = z;
    }
    __syncthreads();
    const bf16_t* vt = p.V2T + ((size_t)(b * 4 + h) * 128) * TT + sbase;
    for (int c = tid; c < 128 * 16; c += 256) { int row = c >> 4, kc = c & 15; *(u32x4*)(Vs + row * SLD + kc * 8) = *(const u32x4*)(vt + (size_t)row * TT + kc * 8); }
    f32x4 hs[8];
#pragma unroll
    for (int et = 0; et < 8; ++et) hs[et] = f32x4{0.f, 0.f, 0.f, 0.f};
#pragma unroll 1
    for (int dir = 0; dir < 2; ++dir) {
        const int chain = chain0 + dir; const int sp = sp_of(dir, u);
        if (dir) __syncthreads();
        const bf16_t* cp = p.CP + ((size_t)chain * NCH + sp) * ER * DK;
        for (int c = tid; c < ER * (DK / 8); c += 256) { int row = c / (DK / 8), kc = c % (DK / 8); *(u32x4*)(RA + row * KLD + kc * 8) = *(const u32x4*)(cp + (size_t)row * DK + kc * 8); }
        __syncthreads();
        const float bt = p.BC[(size_t)chain * TT + sbase + tl], mt = p.MT[(size_t)chain * TT + sbase + tl];
        const float mprev = p.MS[((size_t)chain * NCH + sp) * 4];
        const float winter = __expf(bt + mprev - mt); const float ct = bt - mt;
        f32x4 acc[ET];
#pragma unroll
        for (int et = 0; et < ET; ++et) {
            if ((et & 1) == 0) SCHED_BARRIER();
            f32x4 z = f32x4{0.f, 0.f, 0.f, 0.f};
#pragma unroll
            for (int ks = 0; ks < NKS; ++ks) { Frag ca; ca.q = *(const u32x4*)(RA + (et * 16 + r) * KLD + ks * 32 + quad * 8); z = mfma16(ca.v, qf[ks].v, z); }
            acc[et] = f32x4{z[0] * winter, z[1] * winter, z[2] * winter, z[3] * winter};
        }
#pragma unroll
        for (int kk = 0; kk < 4; ++kk) {
            SCHED_BARRIER();
            Frag pf;
#pragma unroll
            for (int hf = 0; hf < 2; ++hf) {
                const int st = 2 * kk + hf; float w[4];
#pragma unroll
                for (int j = 0; j < 4; ++j) {
                    const int s = st * 16 + quad * 4 + j; const bool ok = dir ? ((st * 16 + j) >= tq) : ((st * 16 + j) <= tq);
                    w[j] = ok ? sT[st][j] * __expf(ct + as_[dir * 128 + s]) : 0.f;
                }
                pf.u[2 * hf] = pack2(w[0], w[1]); pf.u[2 * hf + 1] = pack2(w[2], w[3]);
            }
#pragma unroll
            for (int et = 0; et < ET; ++et) {
                Frag vf;
                if (et < 8) { const bf16_t* vp = Vs + (et * 16 + r) * SLD + kk * 32 + quad * 4; vf.d[0] = *(const u32x2*)vp; vf.d[1] = *(const u32x2*)(vp + 16); }
                else { const unsigned one = (r == 0) ? 0x3F803F80u : 0u; vf.q = u32x4{one, one, one, one}; }
                acc[et] = mfma16(vf.v, pf.v, acc[et]);
            }
        }
        if (NRM) {
            float den = __shfl(acc[ET - 1][0], r);
            const float dn = 1.f / fmaxf(fabsf(den), __expf(-mt));
#pragma unroll
            for (int et = 0; et < 8; ++et) { hs[et][0] += acc[et][0] * dn; hs[et][1] += acc[et][1] * dn; hs[et][2] += acc[et][2] * dn; hs[et][3] += acc[et][3] * dn; }
        } else {
#pragma unroll
            for (int et = 0; et < 8; ++et) { hs[et][0] += acc[et][0]; hs[et][1] += acc[et][1]; hs[et][2] += acc[et][2]; hs[et][3] += acc[et][3]; }
        }
    }
    if (NRM) {
        const bf16_t* og = p.OG + rowt * 512 + h * 128; const float* g = p.ev_mnorm_g + (layer >> 1) * 512 + h * 128;
        float sum = 0.f;
#pragma unroll
        for (int et = 0; et < 8; ++et) {
            const u32x2 gq = *(const u32x2*)(og + et * 16 + quad * 4);
            hs[et][0] *= sigmf(bf2f((bf16_t)(gq.x & 0xFFFF))); hs[et][1] *= sigmf(bf2f((bf16_t)(gq.x >> 16)));
            hs[et][2] *= sigmf(bf2f((bf16_t)(gq.y & 0xFFFF))); hs[et][3] *= sigmf(bf2f((bf16_t)(gq.y >> 16)));
            sum += hs[et][0] + hs[et][1] + hs[et][2] + hs[et][3];
        }
        sum += __shfl_xor(sum, 16); sum += __shfl_xor(sum, 32);
        const float mu = sum * (1.f / 128.f); float var = 0.f;
#pragma unroll
        for (int et = 0; et < 8; ++et)
#pragma unroll
            for (int j = 0; j < 4; ++j) { float d = hs[et][j] - mu; var += d * d; }
        var += __shfl_xor(var, 16); var += __shfl_xor(var, 32);
        const float rs = 1.f / sqrtf(var * (1.f / 128.f) + EPS);
        bf16_t* dst = p.CAT + rowt * 1024 + 512 + h * 128;
#pragma unroll
        for (int et = 0; et < 8; ++et) {
            const int e = et * 16 + quad * 4;
            u32x2 w; w.x = pack2((hs[et][0] - mu) * rs * g[e], (hs[et][1] - mu) * rs * g[e + 1]); w.y = pack2((hs[et][2] - mu) * rs * g[e + 2], (hs[et][3] - mu) * rs * g[e + 3]);
            *(u32x2*)(dst + e) = w;
        }
    } else {
        const bf16_t* og = p.OG + rowt * 512 + h * 128;
        float ss = 0.f;
#pragma unroll
        for (int et = 0; et < 8; ++et)
#pragma unroll
            for (int j = 0; j < 4; ++j) ss += hs[et][j] * hs[et][j];
        ss += __shfl_xor(ss, 16); ss += __shfl_xor(ss, 32);
        const float rs = 1.f / sqrtf(ss * (1.f / 128.f) + EPS);
        bf16_t* dst = p.CAT + rowt * 1024 + h * 128;
#pragma unroll
        for (int et = 0; et < 8; ++et) {
            const int e = et * 16 + quad * 4; const u32x2 gq = *(const u32x2*)(og + e);
            u32x2 w; w.x = pack2(hs[et][0] * rs * siluf(bf2f((bf16_t)(gq.x & 0xFFFF))), hs[et][1] * rs * siluf(bf2f((bf16_t)(gq.x >> 16))));
            w.y = pack2(hs[et][2] * rs * siluf(bf2f((bf16_t)(gq.y & 0xFFFF))), hs[et][3] * rs * siluf(bf2f((bf16_t)(gq.y >> 16))));
            *(u32x2*)(dst + e) = w;
        }
    }
}

DEV void phaseC(const Params& p, int layer, unsigned char* smem) {
    const bool odd = layer & 1; const bool with_ctx = layer < DEPTH - 1;
    bf16_t* sm = (bf16_t*)smem;
    const int nqb_l = SEQ / 64, nqb_c = CTX / 64; const int nh = odd ? HKV : HA;
    const int n_lat = BATCH * nh * nqb_l, n_ctx = with_ctx ? BATCH * nh * nqb_c : 0; const int n_dc = NCHAIN * NCH;
    for (int it = bid_(); it < n_lat + n_ctx + n_dc; it += gridDim.x) {
        if (it < n_lat + n_ctx) {
            int qb, bh;
            if (it < n_lat) { qb = nqb_c + it % nqb_l; bh = it / nqb_l; } else { int i2 = it - n_lat; qb = i2 % nqb_c; bh = i2 / nqb_c; }
            const int item = bh * (nqb_l + nqb_c) + qb;
            if (odd) attn_gqa_item(p, item, sm); else attn_diff_item(p, layer, item, sm);
        } else {
            const int item = it - n_lat - n_ctx;
            if (odd) rec_dc_item<64, false>(p, item, sm); else rec_dc_item<128, true>(p, item, sm);
        }
    }
}
DEV void phaseD(const Params& p, int layer) { if (layer & 1) rec_scan<64, false>(p); else rec_scan<128, true>(p); }
DEV void phaseE(const Params& p, int layer, unsigned char* smem) {
    const bool odd = layer & 1; const bool with_ctx = layer < DEPTH - 1;
    const int n = BATCH * 4 * NCH * 2;
    for (int it = bid_(); it < n; it += gridDim.x) {
        const int u = (it >> 1) % NCH; if (!with_ctx && u < NCC) continue;
        if (odd) rec_out_item<64, false>(p, layer, it, (bf16_t*)smem); else rec_out_item<128, true>(p, layer, it, (bf16_t*)smem);
    }
}

struct EpOut {
    const Params& p; const float* gate; int row0, col0;
    DEV void operator()(f32x4 (&acc)[4][4], int wr, int wc, int lane) {
        const int r = lane & 15, quad = lane >> 4;
#pragma unroll
        for (int n = 0; n < 4; ++n) {
            const int col = col0 + wc * 64 + n * 16 + r; const float g = gate[col];
#pragma unroll
            for (int m = 0; m < 4; ++m)
#pragma unroll
                for (int j = 0; j < 4; ++j) { float* x = p.X + (size_t)(row0 + wr * 64 + m * 16 + quad * 4 + j) * D_MODEL + col; *x = ALPHA * (*x) + g * acc[m][n][j]; }
        }
    }
};
DEV void phaseF(const Params& p, int layer, unsigned char* smem) {
    const bool with_ctx = layer < DEPTH - 1; const int ncol = D_MODEL / 128, nrow = NTOK / 128;
    for (int t = bid_(); t < nrow * ncol; t += gridDim.x) {
        const int rt = t / ncol, ct = t % ncol; const int row0 = rt * 128, col0 = ct * 128; const int b = row0 / TT, s = row0 % TT;
        if (!with_ctx && s < CTX) continue;
        const int bb = s < CTX ? BATCH : b;
        ALoadB al; al.base = p.CAT + (size_t)row0 * MIX_OUT; al.ld = MIX_OUT;
        BLoadW bl; bl.base = p.WoutT + ((size_t)layer * D_MODEL + col0) * MIX_OUT; bl.ld = MIX_OUT;
        EpOut ep{p, p.MOD + ((size_t)layer * (BATCH + 1) + bb) * 6 * D_MODEL + 2 * D_MODEL, row0, col0};
        gemm_tile((bf16_t*)smem, al, bl, MIX_OUT / 64, ep);
    }
}

constexpr int NV4 = D_MODEL / 256;
DEV void phaseG(const Params& p, int layer) {
    const bool with_ctx = layer < DEPTH - 1;
    const int wid = tid_() >> 6, lane = tid_() & 63;
    const float* lg = p.ln_g + (size_t)(layer * 2) * D_MODEL; const float* lb = p.ln_b + (size_t)(layer * 2) * D_MODEL;
    const float* wr = p.WrT + (size_t)layer * NR * D_MODEL;
    for (int tok = bid_() * 4 + wid; tok < NTOK; tok += gridDim.x * 4) {
        const int b = tok / TT, s = tok % TT; if (!with_ctx && s < CTX) continue;
        const int bb = s < CTX ? BATCH : b; const float* mod = p.MOD + ((size_t)layer * (BATCH + 1) + bb) * 6 * D_MODEL;
        f32x4 v[NV4]; float sum = 0.f;
#pragma unroll
        for (int i = 0; i < NV4; ++i) { v[i] = *(const f32x4*)(p.X + (size_t)tok * D_MODEL + (i * 64 + lane) * 4); sum += v[i].x + v[i].y + v[i].z + v[i].w; }
        const float mu = wsum(sum) * (1.f / D_MODEL); float var = 0.f;
#pragma unroll
        for (int i = 0; i < NV4; ++i) { float a = v[i].x - mu, bq = v[i].y - mu, c = v[i].z - mu, d = v[i].w - mu; var += a * a + bq * bq + c * c + d * d; }
        const float rs = 1.f / sqrtf(wsum(var) * (1.f / D_MODEL) + EPS);
        f32x4 hv[NV4];
#pragma unroll
        for (int i = 0; i < NV4; ++i) {
            const int k = (i * 64 + lane) * 4;
            const f32x4 g4 = *(const f32x4*)(lg + k), b4 = *(const f32x4*)(lb + k), sh = *(const f32x4*)(mod + 3 * D_MODEL + k), sc = *(const f32x4*)(mod + 4 * D_MODEL + k);
            f32x4 x1; x1.x = (v[i].x - mu) * rs * g4.x + b4.x; x1.y = (v[i].y - mu) * rs * g4.y + b4.y; x1.z = (v[i].z - mu) * rs * g4.z + b4.z; x1.w = (v[i].w - mu) * rs * g4.w + b4.w;
            *(f32x4*)(p.X + (size_t)tok * D_MODEL + k) = x1;
            hv[i].x = x1.x * (1.f + sc.x) + sh.x; hv[i].y = x1.y * (1.f + sc.y) + sh.y; hv[i].z = x1.z * (1.f + sc.z) + sh.z; hv[i].w = x1.w * (1.f + sc.w) + sh.w;
            u32x2 o; o.x = pack2(hv[i].x, hv[i].y); o.y = pack2(hv[i].z, hv[i].w);
            *(u32x2*)(p.H + (size_t)tok * D_MODEL + k) = o;
        }
        float gl[NG];
#pragma unroll
        for (int j = 0; j < NG; ++j) {
            float a = 0.f;
#pragma unroll
            for (int i = 0; i < NV4; ++i) { const f32x4 w4 = *(const f32x4*)(wr + (size_t)j * D_MODEL + (i * 64 + lane) * 4); a += hv[i].x * w4.x + hv[i].y * w4.y + hv[i].z * w4.z + hv[i].w * w4.w; }
            gl[j] = wsum(a) + p.moe_b_group[layer * NG + j];
        }
        int gi = 0; float gm = gl[0];
#pragma unroll
        for (int j = 1; j < NG; ++j) if (gl[j] > gm) { gm = gl[j]; gi = j; }
        float gs = 0.f;
#pragma unroll
        for (int j = 0; j < NG; ++j) gs += expf(gl[j] - gm);
        const float gw = 1.f / gs;
        float ev[EPG];
        const float* wre = wr + (size_t)(NG + gi * EPG) * D_MODEL;
#pragma unroll
        for (int j = 0; j < EPG; ++j) {
            float a = 0.f;
#pragma unroll
            for (int i = 0; i < NV4; ++i) { const f32x4 w4 = *(const f32x4*)(wre + (size_t)j * D_MODEL + (i * 64 + lane) * 4); a += hv[i].x * w4.x + hv[i].y * w4.y + hv[i].z * w4.z + hv[i].w * w4.w; }
            ev[j] = wsum(a) + p.moe_b_router[layer * NE + gi * EPG + j];
        }
        int i1 = 0; float v1 = ev[0];
#pragma unroll
        for (int j = 1; j < EPG; ++j) if (ev[j] > v1) { v1 = ev[j]; i1 = j; }
        int i2 = -1; float v2 = -3.0e38f;
#pragma unroll
        for (int j = 0; j < EPG; ++j) if (j != i1 && ev[j] > v2) { v2 = ev[j]; i2 = j; }
        const float e2 = expf(v2 - v1); const float w1 = gw / (1.f + e2), w2 = gw * e2 / (1.f + e2);
        if (lane == 0) {
            const int ea = gi * EPG + i1, eb = gi * EPG + i2;
            const int pa = atomicAdd(p.CNT + layer * NE + ea, 1), pb = atomicAdd(p.CNT + layer * NE + eb, 1);
            p.LIST[(size_t)ea * NTOK + pa] = tok; p.LISTW[(size_t)ea * NTOK + pa] = w1;
            p.LIST[(size_t)eb * NTOK + pb] = tok; p.LISTW[(size_t)eb * NTOK + pb] = w2;
            p.TOKSLOT[tok * 2] = (ea << 20) | pa; p.TOKSLOT[tok * 2 + 1] = (eb << 20) | pb;
        }
    }
}

struct EpGU {
    const Params& p; int slot0, nvalid, col0;
    DEV void operator()(f32x4 (&acc)[4][4], int wr, int wc, int lane) {
        const int r = lane & 15, quad = lane >> 4; const int j0 = (col0 + wc * 64) >> 1;
#pragma unroll
        for (int m = 0; m < 4; ++m)
#pragma unroll
            for (int j = 0; j < 4; ++j) {
                const int rl = wr * 64 + m * 16 + quad * 4 + j;
                if (rl < nvalid) {
                    bf16_t* d = p.ACT + (size_t)(slot0 + rl) * D_EXPERT + j0 + r;
                    d[0] = f2bf(siluf(acc[m][0][j]) * acc[m][2][j]); d[16] = f2bf(siluf(acc[m][1][j]) * acc[m][3][j]);
                }
            }
    }
};
struct EpDown {
    const Params& p; const float* lw; int slot0, nvalid, col0;
    DEV void operator()(f32x4 (&acc)[4][4], int wr, int wc, int lane) {
        const int r = lane & 15, quad = lane >> 4;
#pragma unroll
        for (int m = 0; m < 4; ++m)
#pragma unroll
            for (int j = 0; j < 4; ++j) {
                const int rl = wr * 64 + m * 16 + quad * 4 + j;
                if (rl < nvalid) {
                    const float w = lw[rl]; float* d = p.YS + (size_t)(slot0 + rl) * D_MODEL + col0 + wc * 64 + r;
                    d[0] = w * acc[m][0][j]; d[16] = w * acc[m][1][j]; d[32] = w * acc[m][2][j]; d[48] = w * acc[m][3][j];
                }
            }
    }
};
template <bool DOWN>
DEV void phaseHI(const Params& p, int layer, unsigned char* smem) {
    int* tpre = (int*)(smem + 74 * 1024); int* sbase = tpre + 40;
    const int tid = tid_(); const int bid = bid_();
    __syncthreads();
    if (tid == 0) {
        int ta = 0, sa = 0;
        for (int e = 0; e < NE; ++e) { const int c = p.CNT[layer * NE + e]; tpre[e] = ta; sbase[e] = sa; ta += (c + 127) >> 7; sa += c; }
        tpre[NE] = ta;
        if (bid == 0 && !DOWN) for (int e = 0; e < NE; ++e) p.BASE[e] = sbase[e];
    }
    __syncthreads();
    const int ncol = DOWN ? D_MODEL / 128 : 2 * D_EXPERT / 128; const int ntile = tpre[NE] * ncol;
    for (int t = bid; t < ntile; t += gridDim.x) {
        const int rtg = t / ncol, ct = t % ncol; int e = 0;
        for (int q = 1; q < NE; ++q) if (tpre[q] <= rtg) e = q;
        const int rt = rtg - tpre[e]; const int cnt = p.CNT[layer * NE + e]; const int nvalid = imin(128, cnt - rt * 128); const int slot0 = sbase[e] + rt * 128;
        if (!DOWN) {
            ALoadG al; al.H = p.H; al.list = p.LIST + (size_t)e * NTOK + rt * 128; al.nvalid = nvalid;
            BLoadW bl; bl.base = p.Wgu + ((size_t)(layer * NE + e) * 2 * D_EXPERT + ct * 128) * D_MODEL; bl.ld = D_MODEL;
            EpGU ep{p, slot0, nvalid, ct * 128};
            gemm_tile((bf16_t*)smem, al, bl, D_MODEL / 64, ep);
        } else {
            ALoadB al; al.base = p.ACT + (size_t)slot0 * D_EXPERT; al.ld = D_EXPERT;
            BLoadW bl; bl.base = p.WdT + ((size_t)(layer * NE + e) * D_MODEL + ct * 128) * D_EXPERT; bl.ld = D_EXPERT;
            EpDown ep{p, p.LISTW + (size_t)e * NTOK + rt * 128, slot0, nvalid, ct * 128};
            gemm_tile((bf16_t*)smem, al, bl, D_EXPERT / 64, ep);
        }
    }
}

DEV void phaseJ(const Params& p, int layer) {
    const bool with_ctx = layer < DEPTH - 1; const bool last = layer == DEPTH - 1;
    const int wid = tid_() >> 6, lane = tid_() & 63;
    const float* lg = p.ln_g + (size_t)(layer * 2 + 1) * D_MODEL; const float* lb = p.ln_b + (size_t)(layer * 2 + 1) * D_MODEL;
    for (int tok = bid_() * 4 + wid; tok < NTOK; tok += gridDim.x * 4) {
        const int b = tok / TT, s = tok % TT; if (!with_ctx && s < CTX) continue;
        const int bb = s < CTX ? BATCH : b; const float* gate = p.MOD + ((size_t)layer * (BATCH + 1) + bb) * 6 * D_MODEL + 5 * D_MODEL;
        const int ts0 = p.TOKSLOT[tok * 2], ts1 = p.TOKSLOT[tok * 2 + 1];
        const float* y0 = p.YS + (size_t)(p.BASE[ts0 >> 20] + (ts0 & 0xFFFFF)) * D_MODEL; const float* y1 = p.YS + (size_t)(p.BASE[ts1 >> 20] + (ts1 & 0xFFFFF)) * D_MODEL;
        f32x4 v[NV4]; float sum = 0.f;
#pragma unroll
        for (int i = 0; i < NV4; ++i) {
            const int k = (i * 64 + lane) * 4;
            const f32x4 x = *(const f32x4*)(p.X + (size_t)tok * D_MODEL + k), a = *(const f32x4*)(y0 + k), c = *(const f32x4*)(y1 + k), g = *(const f32x4*)(gate + k);
            v[i].x = ALPHA * x.x + g.x * (a.x + c.x); v[i].y = ALPHA * x.y + g.y * (a.y + c.y); v[i].z = ALPHA * x.z + g.z * (a.z + c.z); v[i].w = ALPHA * x.w + g.w * (a.w + c.w);
            sum += v[i].x + v[i].y + v[i].z + v[i].w;
        }
        const float mu = wsum(sum) * (1.f / D_MODEL); float var = 0.f;
#pragma unroll
        for (int i = 0; i < NV4; ++i) { float a = v[i].x - mu, bq = v[i].y - mu, c = v[i].z - mu, d = v[i].w - mu; var += a * a + bq * bq + c * c + d * d; }
        const float rs = 1.f / sqrtf(wsum(var) * (1.f / D_MODEL) + EPS);
        float* dst = last ? p.out + ((size_t)b * SEQ + (s - CTX)) * D_MODEL : p.X + (size_t)tok * D_MODEL;
#pragma unroll
        for (int i = 0; i < NV4; ++i) {
            const int k = (i * 64 + lane) * 4; const f32x4 g4 = *(const f32x4*)(lg + k), b4 = *(const f32x4*)(lb + k);
            f32x4 o; o.x = (v[i].x - mu) * rs * g4.x + b4.x; o.y = (v[i].y - mu) * rs * g4.y + b4.y; o.z = (v[i].z - mu) * rs * g4.z + b4.z; o.w = (v[i].w - mu) * rs * g4.w + b4.w;
            *(f32x4*)(dst + k) = o;
        }
    }
}

constexpr int PH_PER_LAYER = 10;
constexpr int NPHASE = 1 + DEPTH * PH_PER_LAYER;
DEV void run_phase(const Params& p, int ph, unsigned char* smem) {
    if (ph == 0) { phase0(p, smem); return; }
    const int layer = (ph - 1) / PH_PER_LAYER, sub = (ph - 1) % PH_PER_LAYER;
    switch (sub) {
        case 0: phaseA(p, layer, smem); break;
        case 1: if (!(layer & 1)) phaseB(p, layer); break;
        case 2: phaseC(p, layer, smem); break;
        case 3: phaseD(p, layer); break;
        case 4: phaseE(p, layer, smem); break;
        case 5: phaseF(p, layer, smem); break;
        case 6: phaseG(p, layer); break;
        case 7: phaseHI<false>(p, layer, smem); break;
        case 8: phaseHI<true>(p, layer, smem); break;
        default: phaseJ(p, layer); break;
    }
}
DEV bool phase_is_empty(int ph) { if (ph == 0) return false; return ((ph - 1) % PH_PER_LAYER) == 1 && (((ph - 1) / PH_PER_LAYER) & 1); }

struct Carver { char* base; size_t off; template <class T> T* take(size_t n) { off = (off + 255) & ~(size_t)255; T* r = (T*)(base + off); off += n * sizeof(T); return r; } };
static void make_params(Params& p, void* const* d_in, void* d_out, void* d_ws) {
    const float** in = (const float**)d_in;
    p.x = in[0]; p.c = in[1]; p.ctx = in[2]; p.c_ctx = in[3]; p.w_mod = in[4]; p.b_mod = in[5]; p.ln_g = in[6]; p.ln_b = in[7];
    p.ev_w_in = in[8]; p.ev_w_out = in[9]; p.ev_lambda = in[10]; p.ev_subln_g = in[11]; p.ev_conv_w = in[12]; p.ev_conv_b = in[13];
    p.ev_gate_b = in[14]; p.ev_mnorm_g = in[15]; p.od_w_in = in[16]; p.od_w_out = in[17]; p.od_decay = in[18]; p.od_qk_g = in[19];
    p.moe_w_group = in[20]; p.moe_b_group = in[21]; p.moe_w_router = in[22]; p.moe_b_router = in[23]; p.moe_w_gate = in[24]; p.moe_w_up = in[25]; p.moe_w_down = in[26];
    p.out = (float*)d_out;
    Carver cv{(char*)d_ws, 0};
    p.X = cv.take<float>((size_t)NTOK * D_MODEL);
    p.MOD = cv.take<float>((size_t)DEPTH * (BATCH + 1) * 6 * D_MODEL);
    p.ROPE = cv.take<float>(64 * 16 * 2); p.LAM = cv.take<float>(4);
    p.WrT = cv.take<float>((size_t)DEPTH * NR * D_MODEL);
    p.CNT = cv.take<int>(DEPTH * NE); p.BASE = cv.take<int>(NE);
    p.WinE = cv.take<bf16_t>((size_t)2 * EVEN_INP * D_MODEL); p.WinO = cv.take<bf16_t>((size_t)2 * ODD_IN * D_MODEL);
    p.WoutT = cv.take<bf16_t>((size_t)DEPTH * D_MODEL * MIX_OUT);
    p.Wgu = cv.take<bf16_t>((size_t)DEPTH * NE * 2 * D_EXPERT * D_MODEL); p.WdT = cv.take<bf16_t>((size_t)DEPTH * NE * D_MODEL * D_EXPERT);
    p.CAT = cv.take<bf16_t>((size_t)NTOK * 1024);
    p.LIST = cv.take<int>((size_t)NE * NTOK); p.LISTW = cv.take<float>((size_t)NE * NTOK); p.TOKSLOT = cv.take<int>((size_t)NTOK * 2);
    const size_t mix0 = cv.off;
    p.Q1 = cv.take<bf16_t>((size_t)NTOK * 512); p.K1 = cv.take<bf16_t>((size_t)NTOK * 512); p.V1T = cv.take<bf16_t>((size_t)NTOK * 512);
    p.PM = cv.take<bf16_t>((size_t)NTOK * 1024); p.V2T = cv.take<bf16_t>((size_t)NTOK * 512); p.OG = cv.take<bf16_t>((size_t)NTOK * 512);
    p.G = cv.take<float>((size_t)NTOK * 16);
    p.Q2 = cv.take<bf16_t>((size_t)NTOK * 512); p.K2 = cv.take<bf16_t>((size_t)NTOK * 512); p.K2T = cv.take<bf16_t>((size_t)NTOK * 512);
    p.DC = cv.take<float>((size_t)NCHAIN * NCH * EVR * 128); p.CP = cv.take<bf16_t>((size_t)NCHAIN * NCH * EVR * 128);
    p.BC = cv.take<float>((size_t)NCHAIN * TT); p.AT = cv.take<float>((size_t)NCHAIN * TT); p.MT = cv.take<float>((size_t)NCHAIN * TT); p.MS = cv.take<float>((size_t)NCHAIN * NCH * 4);
    cv.off = mix0;
    p.H = cv.take<bf16_t>((size_t)NTOK * D_MODEL); p.ACT = cv.take<bf16_t>((size_t)(2 * NTOK + 128) * D_EXPERT); p.YS = cv.take<float>((size_t)2 * NTOK * D_MODEL);
}

#ifndef CPU_EMU
__global__ void __launch_bounds__(NTHREADS, 2) fwd_megakernel(Params p) {
    __shared__ __attribute__((aligned(16))) unsigned char smem[LDS_BYTES];
    cg::grid_group grid = cg::this_grid();
    for (int ph = 0; ph < NPHASE; ++ph) {
        if (phase_is_empty(ph)) continue;
#if defined(__HIP_DEVICE_COMPILE__)
        const __attribute__((address_space(4))) Params* pp = (const __attribute__((address_space(4))) Params*)__builtin_amdgcn_kernarg_segment_ptr();
        asm volatile("" : "+s"(pp));
        const Params q = *pp;
        run_phase(q, ph, smem);
#else
        run_phase(p, ph, smem);
#endif
        if (ph + 1 < NPHASE) grid.sync();
    }
}

extern "C" void kernel_launch(void* const* d_in, const int* in_sizes, int n_in, void* d_out, int out_size, void* d_ws, size_t ws_size, hipStream_t stream) {
    static int grid_blocks = 0;
    if (!grid_blocks) {
        int dev = 0, cus = 0, per_cu = 0;
        (void)hipGetDevice(&dev); (void)hipDeviceGetAttribute(&cus, hipDeviceAttributeMultiprocessorCount, dev);
        (void)hipOccupancyMaxActiveBlocksPerMultiprocessor(&per_cu, fwd_megakernel, NTHREADS, 0);
        if (per_cu > 2) per_cu = 2;
        if (per_cu < 1) per_cu = 1;
        grid_blocks = cus * per_cu;
    }
    Params p; memset(&p, 0, sizeof(p));
    make_params(p, d_in, d_out, d_ws);
    void* args[] = {&p};
    hipError_t e = hipLaunchCooperativeKernel((void*)fwd_megakernel, dim3(grid_blocks), dim3(NTHREADS), args, 0, stream);
    if (e != hipSuccess) fprintf(stderr, "cooperative launch failed: %s (grid %d)\n", hipGetErrorString(e), grid_blocks);
}
#endif

#if defined(DIAG_KERNELS) && !defined(CPU_EMU)
template <int SUB, int ODD>
__global__ void __launch_bounds__(NTHREADS, 2) k_diag(Params p, int l2) {
    __shared__ __attribute__((aligned(16))) unsigned char smem[LDS_BYTES];
    const int layer = l2 * 2 + ODD;
    if (SUB == 100) { phase0(p, smem); return; }
    if (SUB == 0) phaseA(p, layer, smem);
    if (SUB == 1) phaseB(p, layer);
    if (SUB == 20) { for (int it = bid_(); it < 100; it += gridDim.x) { if (ODD) attn_gqa_item(p, it, (bf16_t*)smem); else attn_diff_item(p, layer, it, (bf16_t*)smem); } }
    if (SUB == 21) { for (int it = bid_(); it < 100; it += gridDim.x) { if (ODD) rec_dc_item<64, false>(p, it, (bf16_t*)smem); else rec_dc_item<128, true>(p, it, (bf16_t*)smem); } }
    if (SUB == 3) phaseD(p, layer);
    if (SUB == 4) phaseE(p, layer, smem);
    if (SUB == 5) phaseF(p, layer, smem);
    if (SUB == 6) phaseG(p, layer);
    if (SUB == 7) phaseHI<false>(p, layer, smem);
    if (SUB == 8) phaseHI<true>(p, layer, smem);
    if (SUB == 9) phaseJ(p, layer);
}
template __global__ void k_diag<100, 0>(Params, int);
template __global__ void k_diag<0, 0>(Params, int);
template __global__ void k_diag<0, 1>(Params, int);
template __global__ void k_diag<1, 0>(Params, int);
template __global__ void k_diag<20, 0>(Params, int);
template __global__ void k_diag<20, 1>(Params, int);
template __global__ void k_diag<21, 0>(Params, int);
template __global__ void k_diag<21, 1>(Params, int);
template __global__ void k_diag<3, 0>(Params, int);
template __global__ void k_diag<4, 0>(Params, int);
template __global__ void k_diag<4, 1>(Params, int);
template __global__ void k_diag<5, 0>(Params, int);
template __global__ void k_diag<6, 0>(Params, int);
template __global__ void k_diag<7, 0>(Params, int);
template __global__ void k_diag<8, 0>(Params, int);
template __global__ void k_diag<9, 0>(Params, int);
#endif
```

```cpp
#ifdef CPU_EMU
#include "emu.h"
#else
#include <hip/hip_runtime.h>
#include <hip/hip_cooperative_groups.h>
#include <cstdio>
#include <cstdint>
#include <cstring>
namespace cg = cooperative_groups;
#endif

#define DEV __device__ __forceinline__
#ifdef CPU_EMU
#define SCHED_BARRIER() do {} while (0)
#else
#define SCHED_BARRIER() __builtin_amdgcn_sched_barrier(0)
#endif
#ifdef CPU_EMU
static inline int tid_() { return (int)threadIdx.x; }
static inline int bid_() { return (int)blockIdx.x; }
#else
__device__ __forceinline__ int tid_() { int t = threadIdx.x; asm volatile("" : "+v"(t)); return t; }
__device__ __forceinline__ int bid_() { int b = blockIdx.x; asm volatile("" : "+s"(b)); return b; }
#endif

#ifdef CPU_EMU_SMALL
constexpr int D_MODEL = 256, BATCH = 2, SEQ = 256, CTX = 256, D_EXPERT = 128;
#else
constexpr int D_MODEL = 1024, BATCH = 4, SEQ = 4096, CTX = 256, D_EXPERT = 512;
#endif
constexpr int DEPTH = 4, GRID_W = 64, CH = 128;
constexpr int TT = CTX + SEQ, NTOK = BATCH * TT, NCH = TT / CH, NCC = CTX / CH;
constexpr float EPS = 1e-5f;
constexpr float ALPHA = 1.6817928305074290f;
constexpr int HA = 4, HB = 4, HC = 4, HD = 8, HKV = 2;
constexpr int EVEN_IN = 3600, EVEN_INP = 3712, ODD_IN = 2304, MIX_OUT = 1024;
constexpr int NG = 4, EPG = 8, NE = 32, NR = NG + NE;
constexpr int NTHREADS = 256;
constexpr int LDS_BYTES = 76 * 1024;
constexpr int NCHAIN = BATCH * 4 * 2;
constexpr int EVR = 144;

typedef unsigned short bf16_t;
typedef short bf16x8 __attribute__((ext_vector_type(8)));
typedef float f32x4 __attribute__((ext_vector_type(4)));
typedef unsigned u32x4 __attribute__((ext_vector_type(4)));
typedef unsigned u32x2 __attribute__((ext_vector_type(2)));
union Frag { bf16x8 v; u32x4 q; u32x2 d[2]; unsigned u[4]; };
DEV int imin(int a, int b) { return a < b ? a : b; }

DEV bf16_t f2bf(float f) { unsigned u = __float_as_uint(f); u += 0x7FFFu + ((u >> 16) & 1u); return (bf16_t)(u >> 16); }
DEV float bf2f(bf16_t h) { return __uint_as_float(((unsigned)h) << 16); }
DEV unsigned pack2(float a, float b) { return (unsigned)f2bf(a) | ((unsigned)f2bf(b) << 16); }
DEV float siluf(float x) { return x / (1.0f + __expf(-x)); }
DEV float sigmf(float x) { return 1.0f / (1.0f + __expf(-x)); }
DEV float logsigf(float x) { return (x >= 0.f) ? -log1pf(expf(-x)) : x - log1pf(expf(x)); }
DEV float wsum(float v) { for (int m = 32; m >= 1; m >>= 1) v += __shfl_xor(v, m); return v; }
DEV float wmax(float v) { for (int m = 32; m >= 1; m >>= 1) v = fmaxf(v, __shfl_xor(v, m)); return v; }
DEV f32x4 mfma16(bf16x8 a, bf16x8 b, f32x4 c) { return __builtin_amdgcn_mfma_f32_16x16x32_bf16(a, b, c, 0, 0, 0); }

struct Params {
    const float *x, *c, *ctx, *c_ctx, *w_mod, *b_mod, *ln_g, *ln_b, *ev_w_in, *ev_w_out, *ev_lambda, *ev_subln_g, *ev_conv_w, *ev_conv_b,
        *ev_gate_b, *ev_mnorm_g, *od_w_in, *od_w_out, *od_decay, *od_qk_g, *moe_w_group, *moe_b_group, *moe_w_router, *moe_b_router,
        *moe_w_gate, *moe_w_up, *moe_w_down;
    float* out;
    float *X, *MOD, *ROPE, *LAM, *WrT;
    int* CNT; unsigned* BAR;
    bf16_t *WinE, *WinO, *WoutT, *Wgu, *WdT;
    bf16_t *Q1, *K1, *V1T;
    bf16_t *PM, *V2T, *OG;
    float* G;
    bf16_t *Q2, *K2, *K2T;
    bf16_t* CAT;
    float* DC; bf16_t* CP;
    float *BC, *AT, *MT, *MS;
    bf16_t *H, *ACT; float* YS;
    int *LIST, *TOKSLOT, *BASE; float *LISTW;
};

constexpr int GLD = 72;
constexpr int GT = 128 * GLD;

struct BLoadW {
    const bf16_t* base; int ld; u32x4 r[4];
    DEV void fetch(int kt, int tid) {
#pragma unroll
        for (int i = 0; i < 4; ++i) { int c = tid + 256 * i, row = c >> 3, kc = c & 7; r[i] = *(const u32x4*)(base + (size_t)row * ld + kt * 64 + kc * 8); }
    }
    DEV void commit(bf16_t* S, int tid) {
#pragma unroll
        for (int i = 0; i < 4; ++i) { int c = tid + 256 * i, row = c >> 3, kc = c & 7; *(u32x4*)(S + row * GLD + kc * 8) = r[i]; }
    }
};
struct ALoadB {
    const bf16_t* base; int ld; u32x4 r[4];
    DEV void fetch(int kt, int tid) {
#pragma unroll
        for (int i = 0; i < 4; ++i) { int c = tid + 256 * i, row = c >> 3, kc = c & 7; r[i] = *(const u32x4*)(base + (size_t)row * ld + kt * 64 + kc * 8); }
    }
    DEV void commit(bf16_t* S, int tid) {
#pragma unroll
        for (int i = 0; i < 4; ++i) { int c = tid + 256 * i, row = c >> 3, kc = c & 7; *(u32x4*)(S + row * GLD + kc * 8) = r[i]; }
    }
};
struct ALoadG {
    const bf16_t* H; const int* list; int nvalid; u32x4 r[4];
    DEV void fetch(int kt, int tid) {
#pragma unroll
        for (int i = 0; i < 4; ++i) {
            int c = tid + 256 * i, row = c >> 3, kc = c & 7; int rr = row < nvalid ? row : nvalid - 1; int tok = list[rr];
            r[i] = *(const u32x4*)(H + (size_t)tok * D_MODEL + kt * 64 + kc * 8);
        }
    }
    DEV void commit(bf16_t* S, int tid) {
#pragma unroll
        for (int i = 0; i < 4; ++i) { int c = tid + 256 * i, row = c >> 3, kc = c & 7; *(u32x4*)(S + row * GLD + kc * 8) = r[i]; }
    }
};
struct ALoadX {
    const float* base; const float *sc, *sh; f32x4 r[8]; f32x4 s4, h4;
    DEV void fetch(int kt, int tid) {
        int kc = tid & 15;
        s4 = *(const f32x4*)(sc + kt * 64 + kc * 4); h4 = *(const f32x4*)(sh + kt * 64 + kc * 4);
#pragma unroll
        for (int i = 0; i < 8; ++i) { int row = (tid >> 4) + 16 * i; r[i] = *(const f32x4*)(base + (size_t)row * D_MODEL + kt * 64 + kc * 4); }
    }
    DEV void commit(bf16_t* S, int tid) {
        int kc = tid & 15;
#pragma unroll
        for (int i = 0; i < 8; ++i) {
            int row = (tid >> 4) + 16 * i;
            u32x2 o; o.x = pack2(r[i].x * (1.f + s4.x) + h4.x, r[i].y * (1.f + s4.y) + h4.y); o.y = pack2(r[i].z * (1.f + s4.z) + h4.z, r[i].w * (1.f + s4.w) + h4.w);
            *(u32x2*)(S + row * GLD + kc * 4) = o;
        }
    }
};

template <class AL, class BL, class EP>
DEV void gemm_tile(bf16_t* sm, AL& al, BL& bl, int nkt, EP& ep) {
    const int tid = tid_(), wid = tid >> 6, lane = tid & 63, wr = wid >> 1, wc = wid & 1, r = lane & 15, quad = lane >> 4;
    bf16_t* As = sm; bf16_t* Bs = sm + 2 * GT;
    f32x4 acc[4][4];
#pragma unroll
    for (int m = 0; m < 4; ++m)
#pragma unroll
        for (int n = 0; n < 4; ++n) acc[m][n] = f32x4{0.f, 0.f, 0.f, 0.f};
    al.fetch(0, tid); bl.fetch(0, tid); al.commit(As, tid); bl.commit(Bs, tid);
    __syncthreads();
    for (int kt = 0; kt < nkt; ++kt) {
        const int cur = kt & 1;
        if (kt + 1 < nkt) { al.fetch(kt + 1, tid); bl.fetch(kt + 1, tid); }
        const bf16_t* Ac = As + cur * GT + (wr * 64 + r) * GLD + quad * 8;
        const bf16_t* Bc = Bs + cur * GT + (wc * 64 + r) * GLD + quad * 8;
#pragma unroll
        for (int ks = 0; ks < 2; ++ks) {
            Frag a[4], b[4];
#pragma unroll
            for (int m = 0; m < 4; ++m) a[m].q = *(const u32x4*)(Ac + m * 16 * GLD + ks * 32);
#pragma unroll
            for (int n = 0; n < 4; ++n) b[n].q = *(const u32x4*)(Bc + n * 16 * GLD + ks * 32);
#pragma unroll
            for (int m = 0; m < 4; ++m)
#pragma unroll
                for (int n = 0; n < 4; ++n) acc[m][n] = mfma16(a[m].v, b[n].v, acc[m][n]);
        }
        if (kt + 1 < nkt) { al.commit(As + (cur ^ 1) * GT, tid); bl.commit(Bs + (cur ^ 1) * GT, tid); }
        __syncthreads();
    }
    ep(acc, wr, wc, lane);
}

DEV void conv_tile(float* T, const float* src, int ldsrc, int N, int K, int k0, int n0, bf16_t* dst, int mapkind) {
    const int tid = tid_();
    __syncthreads();
#pragma unroll
    for (int i = 0; i < 4; ++i) {
        int kk = (tid >> 4) + 16 * i, n4 = tid & 15; int n = n0 + 4 * n4;
        f32x4 v = f32x4{0.f, 0.f, 0.f, 0.f};
        if (n + 3 < N) v = *(const f32x4*)(src + (size_t)(k0 + kk) * ldsrc + n);
        T[(4 * n4 + 0) * 65 + kk] = v.x; T[(4 * n4 + 1) * 65 + kk] = v.y; T[(4 * n4 + 2) * 65 + kk] = v.z; T[(4 * n4 + 3) * 65 + kk] = v.w;
    }
    __syncthreads();
    {
        int nl = tid >> 2, ks = (tid & 3) * 16; int n = n0 + nl; int dr = n;
        if (mapkind == 1) dr = (n >> 5) * 64 + (n & 31); else if (mapkind == 2) dr = (n >> 5) * 64 + 32 + (n & 31);
        const float* t = T + nl * 65 + ks;
        u32x4 o0, o1;
        o0.x = pack2(t[0], t[1]); o0.y = pack2(t[2], t[3]); o0.z = pack2(t[4], t[5]); o0.w = pack2(t[6], t[7]);
        o1.x = pack2(t[8], t[9]); o1.y = pack2(t[10], t[11]); o1.z = pack2(t[12], t[13]); o1.w = pack2(t[14], t[15]);
        bf16_t* d = dst + (size_t)dr * K + k0 + ks;
        *(u32x4*)d = o0; *(u32x4*)(d + 8) = o1;
    }
}

DEV void phase0(const Params& p, unsigned char* smem) {
    const int tid = tid_();
    float* fs = (float*)smem;
    constexpr int NMOD = DEPTH * 6 * D_MODEL / 256;
    constexpr int NCOPY = NTOK / 64;
    constexpr int T_EIN = (D_MODEL / 64) * (EVEN_INP / 64), T_OIN = (D_MODEL / 64) * (ODD_IN / 64), T_OUT = (MIX_OUT / 64) * (D_MODEL / 64);
    constexpr int T_GU = (D_MODEL / 64) * (D_EXPERT / 64), T_DN = (D_EXPERT / 64) * (D_MODEL / 64);
    constexpr int C0 = NMOD + NCOPY + 1 + DEPTH;
    constexpr int C1 = C0 + 2 * T_EIN, C2 = C1 + 2 * T_OIN, C3 = C2 + DEPTH * T_OUT, C4 = C3 + DEPTH * NE * 2 * T_GU, C5 = C4 + DEPTH * NE * T_DN;
    for (int task = bid_(); task < C5; task += gridDim.x) {
        if (task < NMOD) {
            __syncthreads();
            for (int i = tid; i < (BATCH + 1) * D_MODEL; i += 256) { int bb = i / D_MODEL, k = i % D_MODEL; float v = bb < BATCH ? p.c[bb * D_MODEL + k] : p.c_ctx[k]; fs[i] = v / (1.f + expf(-v)); }
            __syncthreads();
            int col = task * 256 + tid; int layer = col / (6 * D_MODEL), j = col % (6 * D_MODEL);
            const float* w = p.w_mod + (size_t)layer * D_MODEL * 6 * D_MODEL + j;
            float acc[BATCH + 1];
#pragma unroll
            for (int bb = 0; bb <= BATCH; ++bb) acc[bb] = 0.f;
            for (int k = 0; k < D_MODEL; ++k) {
                float wv = w[(size_t)k * 6 * D_MODEL];
#pragma unroll
                for (int bb = 0; bb <= BATCH; ++bb) acc[bb] += fs[bb * D_MODEL + k] * wv;
            }
            float bm = p.b_mod[layer * 6 * D_MODEL + j];
#pragma unroll
            for (int bb = 0; bb <= BATCH; ++bb) p.MOD[((size_t)layer * (BATCH + 1) + bb) * 6 * D_MODEL + j] = acc[bb] + bm;
        } else if (task < NMOD + NCOPY) {
            int r0 = (task - NMOD) * 64;
            for (int i = tid; i < 64 * D_MODEL / 4; i += 256) {
                int row = r0 + i / (D_MODEL / 4), c4 = i % (D_MODEL / 4); int b = row / TT, s = row % TT;
                const float* src = s < CTX ? p.ctx + ((size_t)b * CTX + s) * D_MODEL : p.x + ((size_t)b * SEQ + (s - CTX)) * D_MODEL;
                *(f32x4*)(p.X + (size_t)row * D_MODEL + c4 * 4) = *(const f32x4*)(src + c4 * 4);
            }
        } else if (task == NMOD + NCOPY) {
            for (int i = tid; i < 64 * 16; i += 256) {
                int pos = i / 16, f = i % 16;
                double th = 1.0; for (int q = 0; q < f; ++q) th *= 0.5623413251903490804;
                double t2 = th * th, cs = 1.0, sn = th, tc = 1.0, ts = th;
                for (int n = 1; n < 14; ++n) { tc *= -t2 / ((2 * n - 1) * (2 * n)); ts *= -t2 / ((2 * n) * (2 * n + 1)); cs += tc; sn += ts; }
                double c = 1.0, s = 0.0;
                for (int q = 0; q < pos; ++q) { double cn = c * cs - s * sn, sn2 = s * cs + c * sn; c = cn; s = sn2; }
                p.ROPE[i * 2] = (float)c; p.ROPE[i * 2 + 1] = (float)s;
            }
            if (tid < 2) {
                const float* lp = p.ev_lambda + tid * 4 * 64; float s01 = 0.f, s23 = 0.f;
                for (int k = 0; k < 64; ++k) { s01 += lp[k] * lp[64 + k]; s23 += lp[128 + k] * lp[192 + k]; }
                float lam_init = 0.8f - 0.6f * expf(-0.3f * (float)(2 * tid));
                p.LAM[tid] = expf(s01) - expf(s23) + lam_init;
            }
            for (int i = tid; i < DEPTH * NE; i += 256) p.CNT[i] = 0;
        } else if (task < C0) {
            int layer = task - (NMOD + NCOPY + 1);
            for (int i = tid; i < NR * D_MODEL; i += 256) {
                int j = i / D_MODEL, k = i % D_MODEL;
                float v = j < NG ? p.moe_w_group[((size_t)layer * D_MODEL + k) * NG + j] : p.moe_w_router[((size_t)layer * D_MODEL + k) * NE + (j - NG)];
                p.WrT[(size_t)layer * NR * D_MODEL + i] = v;
            }
        } else if (task < C1) {
            int t = task - C0, i = t / T_EIN, tt = t % T_EIN; int nt = tt % (EVEN_INP / 64), kt = tt / (EVEN_INP / 64);
            conv_tile(fs, p.ev_w_in + (size_t)i * D_MODEL * EVEN_IN, EVEN_IN, EVEN_IN, D_MODEL, kt * 64, nt * 64, p.WinE + (size_t)i * EVEN_INP * D_MODEL, 0);
        } else if (task < C2) {
            int t = task - C1, i = t / T_OIN, tt = t % T_OIN; int nt = tt % (ODD_IN / 64), kt = tt / (ODD_IN / 64);
            conv_tile(fs, p.od_w_in + (size_t)i * D_MODEL * ODD_IN, ODD_IN, ODD_IN, D_MODEL, kt * 64, nt * 64, p.WinO + (size_t)i * ODD_IN * D_MODEL, 0);
        } else if (task < C3) {
            int t = task - C2, layer = t / T_OUT, tt = t % T_OUT; int nt = tt % (D_MODEL / 64), kt = tt / (D_MODEL / 64);
            const float* src = (layer & 1) ? p.od_w_out + (size_t)(layer >> 1) * MIX_OUT * D_MODEL : p.ev_w_out + (size_t)(layer >> 1) * MIX_OUT * D_MODEL;
            conv_tile(fs, src, D_MODEL, D_MODEL, MIX_OUT, kt * 64, nt * 64, p.WoutT + (size_t)layer * D_MODEL * MIX_OUT, 0);
        } else if (task < C4) {
            int t = task - C3, le = t / (2 * T_GU), tt = t % (2 * T_GU); int up = tt / T_GU; tt %= T_GU; int nt = tt % (D_EXPERT / 64), kt = tt / (D_EXPERT / 64);
            const float* src = (up ? p.moe_w_up : p.moe_w_gate) + (size_t)le * D_MODEL * D_EXPERT;
            conv_tile(fs, src, D_EXPERT, D_EXPERT, D_MODEL, kt * 64, nt * 64, p.Wgu + (size_t)le * 2 * D_EXPERT * D_MODEL, 1 + up);
        } else {
            int t = task - C4, le = t / T_DN, tt = t % T_DN; int nt = tt % (D_MODEL / 64), kt = tt / (D_MODEL / 64);
            conv_tile(fs, p.moe_w_down + (size_t)le * D_EXPERT * D_MODEL, D_MODEL, D_MODEL, D_EXPERT, kt * 64, nt * 64, p.WdT + (size_t)le * D_MODEL * D_EXPERT, 0);
        }
    }
}

DEV int chunk_of(int dir, int sp) { return dir == 0 ? sp : (sp < NCC ? NCC - 1 - sp : NCC + (NCH - 1 - sp)); }
DEV int sp_of(int dir, int u) { return dir == 0 ? u : (u < NCC ? NCC - 1 - u : NCC + (NCH - 1 - u)); }

template <bool RET>
DEV void gate_chain(const Params& p, int layer, int chain) {
    const int lane = tid_() & 63;
    const int dir = chain & 1, h = (chain >> 1) & 3, b = chain >> 3;
    float lg = 0.f;
    if (RET) lg = logsigf(p.od_decay[((layer >> 1) * 2 + dir) * HC + h]);
    float mprev = 0.f;
    for (int sp = 0; sp < NCH; ++sp) {
        const int u = chunk_of(dir, sp); const int sbase = u * CH;
        int i0 = 2 * lane, i1 = 2 * lane + 1;
        int s0 = dir ? sbase + 127 - i0 : sbase + i0, s1 = dir ? sbase + 127 - i1 : sbase + i1;
        float lf0, lf1, li0, li1;
        if (RET) { lf0 = lf1 = lg; li0 = li1 = 0.f; }
        else {
            const float* g0 = p.G + ((size_t)b * TT + s0) * 16; const float* g1 = p.G + ((size_t)b * TT + s1) * 16;
            li0 = g0[(2 * dir) * 4 + h]; li1 = g1[(2 * dir) * 4 + h];
            lf0 = logsigf(g0[(2 * dir + 1) * 4 + h]); lf1 = logsigf(g1[(2 * dir + 1) * 4 + h]);
        }
        float ps = lf0 + lf1;
        for (int d = 1; d < 64; d <<= 1) { float o = __shfl_up(ps, d); if (lane >= d) ps += o; }
        float b1 = ps, b0 = ps - lf1;
        float bend = __shfl(ps, 63);
        float a0 = li0 - b0, a1 = li1 - b1;
        float pm = fmaxf(a0, a1);
        float mx = pm;
        for (int d = 1; d < 64; d <<= 1) { float o = __shfl_up(mx, d); if (lane >= d) mx = fmaxf(mx, o); }
        float pmx_prev = __shfl_up(mx, 1); if (lane == 0) pmx_prev = -3.0e38f;
        float pm0 = fmaxf(pmx_prev, a0), pm1 = mx;
        float amax = __shfl(mx, 63);
        float mnew, carry, mt0, mt1;
        if (RET) { mnew = 0.f; carry = __expf(bend); mt0 = mt1 = 0.f; }
        else { mnew = fmaxf(bend + mprev, bend + amax); carry = __expf(bend + mprev - mnew); mt0 = b0 + fmaxf(mprev, pm0); mt1 = b1 + fmaxf(mprev, pm1); }
        size_t o = (size_t)chain * TT;
        p.BC[o + s0] = b0; p.BC[o + s1] = b1; p.AT[o + s0] = a0; p.AT[o + s1] = a1; p.MT[o + s0] = mt0; p.MT[o + s1] = mt1;
        if (lane == 0) { float* ms = p.MS + ((size_t)chain * NCH + sp) * 4; ms[0] = mprev; ms[1] = mnew; ms[2] = bend; ms[3] = carry; }
        mprev = mnew;
    }
}

struct EpInEven {
    const Params& p; int layer, row0, col0;
    DEV void operator()(f32x4 (&acc)[4][4], int wr, int wc, int lane) {
        const int r = lane & 15, quad = lane >> 4;
        const int c0 = col0 + wc * 64, rowb = row0 + wr * 64;
        const int b = row0 / TT; const int sb = rowb - b * TT; const bool lat = sb >= CTX;
        if (c0 < 1024) {
            bf16_t* dst = c0 < 512 ? p.Q1 : p.K1; const int cc = c0 & 511;
#pragma unroll
            for (int m = 0; m < 4; ++m)
#pragma unroll
                for (int j = 0; j < 4; ++j) {
                    const int row = rowb + m * 16 + quad * 4 + j;
                    float v0 = acc[m][0][j], v1 = acc[m][1][j], v2 = acc[m][2][j], v3 = acc[m][3][j];
                    if (lat) {
                        const int t = sb + m * 16 + quad * 4 + j - CTX; const int pr = t / GRID_W, pc = t % GRID_W;
                        const float cr = p.ROPE[(pr * 16 + r) * 2], sr = p.ROPE[(pr * 16 + r) * 2 + 1], cq = p.ROPE[(pc * 16 + r) * 2], sq = p.ROPE[(pc * 16 + r) * 2 + 1];
                        float o0 = v0 * cr - v2 * sr, o2 = v0 * sr + v2 * cr, o1 = v1 * cq - v3 * sq, o3 = v1 * sq + v3 * cq;
                        v0 = o0; v1 = o1; v2 = o2; v3 = o3;
                    }
                    bf16_t* d = dst + (size_t)row * 512 + cc + r;
                    d[0] = f2bf(v0); d[16] = f2bf(v1); d[32] = f2bf(v2); d[48] = f2bf(v3);
                }
        } else if (c0 < 1536 || (c0 >= 2560 && c0 < 3072)) {
            const bool at = c0 < 1536; const int cc = at ? c0 - 1024 : c0 - 2560; const int h = cc >> 7, e0 = (cc & 127);
            bf16_t* dst = (at ? p.V1T : p.V2T) + ((size_t)(b * 4 + h) * 128) * TT;
#pragma unroll
            for (int m = 0; m < 4; ++m)
#pragma unroll
                for (int n = 0; n < 4; ++n) {
                    u32x2 o; o.x = pack2(acc[m][n][0], acc[m][n][1]); o.y = pack2(acc[m][n][2], acc[m][n][3]);
                    *(u32x2*)(dst + (size_t)(e0 + n * 16 + r) * TT + sb + m * 16 + quad * 4) = o;
                }
        } else if (c0 < 2560 || (c0 >= 3072 && c0 < 3584)) {
            const bool pm = c0 < 2560; bf16_t* dst = pm ? p.PM : p.OG; const int ld = pm ? 1024 : 512; const int cc = pm ? c0 - 1536 : c0 - 3072;
#pragma unroll
            for (int m = 0; m < 4; ++m)
#pragma unroll
                for (int j = 0; j < 4; ++j) {
                    const int row = rowb + m * 16 + quad * 4 + j; bf16_t* d = dst + (size_t)row * ld + cc + r;
                    d[0] = f2bf(acc[m][0][j]); d[16] = f2bf(acc[m][1][j]); d[32] = f2bf(acc[m][2][j]); d[48] = f2bf(acc[m][3][j]);
                }
        } else if (c0 == 3584) {
            const float gb = p.ev_gate_b[(layer >> 1) * 16 + r];
#pragma unroll
            for (int m = 0; m < 4; ++m)
#pragma unroll
                for (int j = 0; j < 4; ++j) { const int row = rowb + m * 16 + quad * 4 + j; p.G[(size_t)row * 16 + r] = acc[m][0][j] + gb; }
        }
    }
};

struct EpInOdd {
    const Params& p; int layer, row0, col0;
    DEV void operator()(f32x4 (&acc)[4][4], int wr, int wc, int lane) {
        const int r = lane & 15, quad = lane >> 4;
        const int c0 = col0 + wc * 64, rowb = row0 + wr * 64;
        const int b = row0 / TT; const int sb = rowb - b * TT; const bool lat = sb >= CTX;
        if (c0 < 512 || (c0 >= 1024 && c0 < 1536)) {
            bf16_t* dst; int ld, cc; float scl = 1.f;
            if (c0 < 256) { dst = p.Q2; ld = 256; cc = c0; } else if (c0 < 512) { dst = p.K2; ld = 256; cc = c0 - 256; scl = 0.125f; } else { dst = p.OG; ld = 512; cc = c0 - 1024; }
#pragma unroll
            for (int m = 0; m < 4; ++m)
#pragma unroll
                for (int j = 0; j < 4; ++j) {
                    const int row = rowb + m * 16 + quad * 4 + j; bf16_t* d = dst + (size_t)row * ld + cc + r;
                    d[0] = f2bf(acc[m][0][j] * scl); d[16] = f2bf(acc[m][1][j] * scl); d[32] = f2bf(acc[m][2][j] * scl); d[48] = f2bf(acc[m][3][j] * scl);
                }
            if (c0 >= 256 && c0 < 512) {
                const int h = (c0 - 256) >> 6; bf16_t* dt = p.K2T + ((size_t)(b * 4 + h) * 64) * TT;
#pragma unroll
                for (int m = 0; m < 4; ++m)
#pragma unroll
                    for (int n = 0; n < 4; ++n) {
                        u32x2 o; o.x = pack2(acc[m][n][0] * scl, acc[m][n][1] * scl); o.y = pack2(acc[m][n][2] * scl, acc[m][n][3] * scl);
                        *(u32x2*)(dt + (size_t)(n * 16 + r) * TT + sb + m * 16 + quad * 4) = o;
                    }
            }
        } else if (c0 < 1024) {
            const int cc = c0 - 512; const int h = cc >> 7, e0 = cc & 127; bf16_t* dst = p.V2T + ((size_t)(b * 4 + h) * 128) * TT;
#pragma unroll
            for (int m = 0; m < 4; ++m)
#pragma unroll
                for (int n = 0; n < 4; ++n) {
                    u32x2 o; o.x = pack2(acc[m][n][0], acc[m][n][1]); o.y = pack2(acc[m][n][2], acc[m][n][3]);
                    *(u32x2*)(dst + (size_t)(e0 + n * 16 + r) * TT + sb + m * 16 + quad * 4) = o;
                }
        } else if (c0 < 2176) {
            const bool isq = c0 < 2048; bf16_t* dst = isq ? p.Q1 : p.K1; const int ld = isq ? 512 : 128; const int cc = isq ? c0 - 1536 : c0 - 2048;
            const float* g = p.od_qk_g + ((layer >> 1) * 2 + (isq ? 0 : 1)) * 64;
            const float g0 = g[r], g1 = g[16 + r], g2 = g[32 + r], g3 = g[48 + r];
#pragma unroll
            for (int m = 0; m < 4; ++m)
#pragma unroll
                for (int j = 0; j < 4; ++j) {
                    const int row = rowb + m * 16 + quad * 4 + j;
                    float v0 = acc[m][0][j], v1 = acc[m][1][j], v2 = acc[m][2][j], v3 = acc[m][3][j];
                    float ss = v0 * v0 + v1 * v1 + v2 * v2 + v3 * v3;
                    ss += __shfl_xor(ss, 1); ss += __shfl_xor(ss, 2); ss += __shfl_xor(ss, 4); ss += __shfl_xor(ss, 8);
                    const float rs = 1.0f / sqrtf(ss * (1.f / 64.f) + EPS);
                    v0 *= rs * g0; v1 *= rs * g1; v2 *= rs * g2; v3 *= rs * g3;
                    if (lat) {
                        const int t = sb + m * 16 + quad * 4 + j - CTX; const int pr = t / GRID_W, pc = t % GRID_W;
                        const float cr = p.ROPE[(pr * 16 + r) * 2], sr = p.ROPE[(pr * 16 + r) * 2 + 1], cq = p.ROPE[(pc * 16 + r) * 2], sq = p.ROPE[(pc * 16 + r) * 2 + 1];
                        float o0 = v0 * cr - v2 * sr, o2 = v0 * sr + v2 * cr, o1 = v1 * cq - v3 * sq, o3 = v1 * sq + v3 * cq;
                        v0 = o0; v1 = o1; v2 = o2; v3 = o3;
                    }
                    bf16_t* d = dst + (size_t)row * ld + cc + r;
                    d[0] = f2bf(v0); d[16] = f2bf(v1); d[32] = f2bf(v2); d[48] = f2bf(v3);
                }
        } else {
            const int kv = (c0 - 2176) >> 6; bf16_t* dst = p.V1T + ((size_t)(b * HKV + kv) * 64) * TT;
#pragma unroll
            for (int m = 0; m < 4; ++m)
#pragma unroll
                for (int n = 0; n < 4; ++n) {
                    u32x2 o; o.x = pack2(acc[m][n][0], acc[m][n][1]); o.y = pack2(acc[m][n][2], acc[m][n][3]);
                    *(u32x2*)(dst + (size_t)(n * 16 + r) * TT + sb + m * 16 + quad * 4) = o;
                }
        }
    }
};

DEV void phaseA(const Params& p, int layer, unsigned char* smem) {
    const bool odd = layer & 1;
    const int ncol = odd ? ODD_IN / 128 : EVEN_INP / 128; const int nrow = NTOK / 128;
    const bf16_t* W = odd ? p.WinO + (size_t)(layer >> 1) * ODD_IN * D_MODEL : p.WinE + (size_t)(layer >> 1) * EVEN_INP * D_MODEL;
    const int bid = bid_();
    if (odd && bid < NCHAIN && tid_() < 64) gate_chain<true>(p, layer, bid);
    for (int t = bid; t < nrow * ncol; t += gridDim.x) {
        const int rt = t / ncol, ct = t % ncol; const int row0 = rt * 128, col0 = ct * 128;
        const int b = row0 / TT, s = row0 % TT; const int bb = s < CTX ? BATCH : b;
        const float* mod = p.MOD + ((size_t)layer * (BATCH + 1) + bb) * 6 * D_MODEL;
        ALoadX al; al.base = p.X + (size_t)row0 * D_MODEL; al.sh = mod; al.sc = mod + D_MODEL;
        BLoadW bl; bl.base = W + (size_t)col0 * D_MODEL; bl.ld = D_MODEL;
        if (odd) { EpInOdd ep{p, layer, row0, col0}; gemm_tile((bf16_t*)smem, al, bl, D_MODEL / 64, ep); }
        else { EpInEven ep{p, layer, row0, col0}; gemm_tile((bf16_t*)smem, al, bl, D_MODEL / 64, ep); }
    }
}

DEV void phaseB(const Params& p, int layer) {
    const int tid = tid_();
    const int bid = bid_();
    if (bid < NCHAIN && tid < 64) gate_chain<false>(p, layer, bid);
    const float* cw = p.ev_conv_w + (size_t)(layer >> 1) * 3 * 1024; const float* cb = p.ev_conv_b + (size_t)(layer >> 1) * 1024;
    const int total = NTOK * 128;
    for (int idx = bid * 256 + tid; idx < total; idx += gridDim.x * 256) {
        const int row = idx >> 7, cg8 = (idx & 127) * 8; const int b = row / TT, s = row % TT;
        const bool hasp = (s != 0) && (s != CTX), hasn = (s != CTX - 1) && (s != TT - 1);
        Frag xm, x0, xp; x0.q = *(const u32x4*)(p.PM + (size_t)row * 1024 + cg8);
        xm.q = u32x4{0u, 0u, 0u, 0u}; xp.q = u32x4{0u, 0u, 0u, 0u};
        if (hasp) xm.q = *(const u32x4*)(p.PM + (size_t)(row - 1) * 1024 + cg8);
        if (hasn) xp.q = *(const u32x4*)(p.PM + (size_t)(row + 1) * 1024 + cg8);
        float y[8];
#pragma unroll
        for (int i = 0; i < 8; ++i) {
            const int ch = cg8 + i;
            float v = cb[ch] + bf2f((bf16_t)xm.v[i]) * cw[ch] + bf2f((bf16_t)x0.v[i]) * cw[1024 + ch] + bf2f((bf16_t)xp.v[i]) * cw[2048 + ch];
            y[i] = siluf(v);
        }
        if (cg8 < 512) {
            u32x4 o; o.x = pack2(y[0], y[1]); o.y = pack2(y[2], y[3]); o.z = pack2(y[4], y[5]); o.w = pack2(y[6], y[7]);
            *(u32x4*)(p.Q2 + (size_t)row * 512 + cg8) = o;
        } else {
            const float sc = 0.08838834764831845f;
#pragma unroll
            for (int i = 0; i < 8; ++i) y[i] *= sc;
            u32x4 o; o.x = pack2(y[0], y[1]); o.y = pack2(y[2], y[3]); o.z = pack2(y[4], y[5]); o.w = pack2(y[6], y[7]);
            const int kc = cg8 - 512; *(u32x4*)(p.K2 + (size_t)row * 512 + kc) = o;
            const int h = kc >> 7, d0 = kc & 127;
            bf16_t* dt = p.K2T + ((size_t)(b * 4 + h) * 128 + d0) * TT + s;
#pragma unroll
            for (int i = 0; i < 8; ++i) dt[(size_t)i * TT] = f2bf(y[i]);
        }
    }
}

constexpr int KLD1 = 136, KLD0 = 72, VLD = 72;
template <int NC, int DV, int QT>
struct AttnState { f32x4 O[NC][DV / 16][QT]; float m[NC][QT], l[NC][QT]; };

template <int NC, int DV, int QT, int KW>
DEV void attn_core(bf16_t* sm, const bf16_t* Kg, int ldk, const bf16_t* VTg, int nkeys, const Frag (&qf)[NC][2][QT], AttnState<NC, DV, QT>& st, float sc2, int koff) {
    constexpr int KLD = KW + 8;
    const int tid = tid_(), lane = tid & 63, r = lane & 15, quad = lane >> 4;
    bf16_t* Ks = sm; bf16_t* Vs = sm + 64 * KLD;
    for (int k0 = 0; k0 < nkeys; k0 += 64) {
        __syncthreads();
        for (int c = tid; c < 64 * KW / 8; c += 256) { int row = c / (KW / 8), kc = c % (KW / 8); *(u32x4*)(Ks + row * KLD + kc * 8) = *(const u32x4*)(Kg + (size_t)(k0 + row) * ldk + kc * 8); }
        for (int c = tid; c < DV * 8; c += 256) { int row = c >> 3, kc = c & 7; *(u32x4*)(Vs + row * VLD + kc * 8) = *(const u32x4*)(VTg + (size_t)row * TT + k0 + kc * 8); }
        __syncthreads();
#pragma unroll
        for (int c = 0; c < NC; ++c) {
            Frag pf[QT][2];
            f32x4 s[4][QT];
            SCHED_BARRIER();
#pragma unroll
            for (int kt = 0; kt < 4; ++kt) {
                Frag ka0, ka1;
                ka0.q = *(const u32x4*)(Ks + (kt * 16 + r) * KLD + koff + c * 64 + quad * 8);
                ka1.q = *(const u32x4*)(Ks + (kt * 16 + r) * KLD + koff + c * 64 + 32 + quad * 8);
#pragma unroll
                for (int qt = 0; qt < QT; ++qt) {
                    f32x4 z = f32x4{0.f, 0.f, 0.f, 0.f};
                    z = mfma16(ka0.v, qf[c][0][qt].v, z); z = mfma16(ka1.v, qf[c][1][qt].v, z); s[kt][qt] = z;
                }
            }
            SCHED_BARRIER();
#pragma unroll
            for (int qt = 0; qt < QT; ++qt) {
                float mx = -3.0e38f;
#pragma unroll
                for (int kt = 0; kt < 4; ++kt)
#pragma unroll
                    for (int j = 0; j < 4; ++j) mx = fmaxf(mx, s[kt][qt][j]);
                mx = fmaxf(mx, __shfl_xor(mx, 16)); mx = fmaxf(mx, __shfl_xor(mx, 32));
                const float mn = fmaxf(st.m[c][qt], mx * sc2);
                const float al = __builtin_amdgcn_exp2f(st.m[c][qt] - mn);
                st.m[c][qt] = mn;
                float ls = 0.f;
#pragma unroll
                for (int kt = 0; kt < 4; ++kt)
#pragma unroll
                    for (int j = 0; j < 4; ++j) { float e = __builtin_amdgcn_exp2f(s[kt][qt][j] * sc2 - mn); s[kt][qt][j] = e; ls += e; }
                st.l[c][qt] = st.l[c][qt] * al + ls;
#pragma unroll
                for (int et = 0; et < DV / 16; ++et) { st.O[c][et][qt][0] *= al; st.O[c][et][qt][1] *= al; st.O[c][et][qt][2] *= al; st.O[c][et][qt][3] *= al; }
#pragma unroll
                for (int kk = 0; kk < 2; ++kk) {
                    pf[qt][kk].u[0] = pack2(s[2 * kk][qt][0], s[2 * kk][qt][1]); pf[qt][kk].u[1] = pack2(s[2 * kk][qt][2], s[2 * kk][qt][3]);
                    pf[qt][kk].u[2] = pack2(s[2 * kk + 1][qt][0], s[2 * kk + 1][qt][1]); pf[qt][kk].u[3] = pack2(s[2 * kk + 1][qt][2], s[2 * kk + 1][qt][3]);
                }
            }
            SCHED_BARRIER();
#pragma unroll
            for (int et = 0; et < DV / 16; ++et) {
#pragma unroll
                for (int kk = 0; kk < 2; ++kk) {
                    Frag vf; const bf16_t* vp = Vs + (et * 16 + r) * VLD + kk * 32 + quad * 4;
                    vf.d[0] = *(const u32x2*)vp; vf.d[1] = *(const u32x2*)(vp + 16);
#pragma unroll
                    for (int qt = 0; qt < QT; ++qt) st.O[c][et][qt] = mfma16(vf.v, pf[qt][kk].v, st.O[c][et][qt]);
                }
                if ((et & 1) == 1) SCHED_BARRIER();
            }
        }
    }
#pragma unroll
    for (int c = 0; c < NC; ++c)
#pragma unroll
        for (int qt = 0; qt < QT; ++qt) { float l = st.l[c][qt]; l += __shfl_xor(l, 16); l += __shfl_xor(l, 32); st.l[c][qt] = l; }
}

DEV void attn_diff_item(const Params& p, int layer, int item, bf16_t* sm) {
    const int nqb = TT / 64; const int qb = item % nqb, h = (item / nqb) % HA, b = item / (nqb * HA);
    const int tid = tid_(), wid = tid >> 6, lane = tid & 63, r = lane & 15, quad = lane >> 4;
    const int comp = wid & 1, rg = wid >> 1;
    const int s0 = qb * 64; const bool ctxq = s0 < CTX; const int nkeys = ctxq ? CTX : TT;
    Frag qf[1][2][2];
#pragma unroll
    for (int ks = 0; ks < 2; ++ks)
#pragma unroll
        for (int qt = 0; qt < 2; ++qt) qf[0][ks][qt].q = *(const u32x4*)(p.Q1 + ((size_t)b * TT + s0 + rg * 32 + qt * 16 + r) * 512 + h * 128 + comp * 64 + ks * 32 + quad * 8);
    AttnState<1, 128, 2> st;
#pragma unroll
    for (int qt = 0; qt < 2; ++qt) {
        st.m[0][qt] = -3.0e38f; st.l[0][qt] = 0.f;
#pragma unroll
        for (int et = 0; et < 8; ++et) st.O[0][et][qt] = f32x4{0.f, 0.f, 0.f, 0.f};
    }
    attn_core<1, 128, 2, 128>(sm, p.K1 + (size_t)b * TT * 512 + h * 128, 512, p.V1T + ((size_t)(b * HA + h) * 128) * TT, nkeys, qf, st, 0.125f * 1.4426950408889634f, comp * 64);
    const float lam = p.LAM[layer >> 1]; const float lam_init = 0.8f - 0.6f * expf(-0.3f * (float)layer);
    const float* sg = p.ev_subln_g + (layer >> 1) * 128;
    f32x4* xo = (f32x4*)sm;
    __syncthreads();
    if (comp == 1) {
#pragma unroll
        for (int qt = 0; qt < 2; ++qt) {
            const float i2 = lam / st.l[0][qt];
#pragma unroll
            for (int et = 0; et < 8; ++et) xo[((rg * 2 + qt) * 8 + et) * 64 + lane] = f32x4{st.O[0][et][qt][0] * i2, st.O[0][et][qt][1] * i2, st.O[0][et][qt][2] * i2, st.O[0][et][qt][3] * i2};
        }
    }
    __syncthreads();
    if (comp == 0) {
#pragma unroll
        for (int qt = 0; qt < 2; ++qt) {
            const float i1 = 1.f / st.l[0][qt];
            float ss = 0.f; f32x4 o[8];
#pragma unroll
            for (int et = 0; et < 8; ++et) {
                const f32x4 x2 = xo[((rg * 2 + qt) * 8 + et) * 64 + lane];
#pragma unroll
                for (int j = 0; j < 4; ++j) { float v = st.O[0][et][qt][j] * i1 - x2[j]; o[et][j] = v; ss += v * v; }
            }
            ss += __shfl_xor(ss, 16); ss += __shfl_xor(ss, 32);
            const float rs = (1.f - lam_init) / sqrtf(ss * (1.f / 128.f) + EPS);
            bf16_t* dst = p.CAT + ((size_t)b * TT + s0 + rg * 32 + qt * 16 + r) * 1024 + h * 128;
#pragma unroll
            for (int et = 0; et < 8; ++et) {
                const int e = et * 16 + quad * 4;
                u32x2 w; w.x = pack2(o[et][0] * rs * sg[e], o[et][1] * rs * sg[e + 1]); w.y = pack2(o[et][2] * rs * sg[e + 2], o[et][3] * rs * sg[e + 3]);
                *(u32x2*)(dst + e) = w;
            }
        }
    }
}

DEV void attn_gqa_item(const Params& p, int item, bf16_t* sm) {
    const int nqb = TT / 64; const int qb = item % nqb, kv = (item / nqb) % HKV, b = item / (nqb * HKV);
    const int tid = tid_(), wid = tid >> 6, lane = tid & 63, r = lane & 15, quad = lane >> 4;
    const int s0 = qb * 64; const bool ctxq = s0 < CTX; const int nkeys = ctxq ? CTX : TT; const int hq = kv * 4 + wid;
    Frag qf[1][2][4];
#pragma unroll
    for (int ks = 0; ks < 2; ++ks)
#pragma unroll
        for (int qt = 0; qt < 4; ++qt) qf[0][ks][qt].q = *(const u32x4*)(p.Q1 + ((size_t)b * TT + s0 + qt * 16 + r) * 512 + hq * 64 + ks * 32 + quad * 8);
    AttnState<1, 64, 4> st;
#pragma unroll
    for (int qt = 0; qt < 4; ++qt) {
        st.m[0][qt] = -3.0e38f; st.l[0][qt] = 0.f;
#pragma unroll
        for (int et = 0; et < 4; ++et) st.O[0][et][qt] = f32x4{0.f, 0.f, 0.f, 0.f};
    }
    attn_core<1, 64, 4, 64>(sm, p.K1 + (size_t)b * TT * 128 + kv * 64, 128, p.V1T + ((size_t)(b * HKV + kv) * 64) * TT, nkeys, qf, st, 0.125f * 1.4426950408889634f, 0);
#pragma unroll
    for (int qt = 0; qt < 4; ++qt) {
        const float il = 1.f / st.l[0][qt];
        bf16_t* dst = p.CAT + ((size_t)b * TT + s0 + qt * 16 + r) * 1024 + 512 + hq * 64;
#pragma unroll
        for (int et = 0; et < 4; ++et) {
            const int e = et * 16 + quad * 4;
            u32x2 w; w.x = pack2(st.O[0][et][qt][0] * il, st.O[0][et][qt][1] * il); w.y = pack2(st.O[0][et][qt][2] * il, st.O[0][et][qt][3] * il);
            *(u32x2*)(dst + e) = w;
        }
    }
}

template <int DK, bool NRM>
DEV void rec_dc_item(const Params& p, int item, bf16_t* sm) {
    constexpr int ET = NRM ? 9 : 8; constexpr int ER = NRM ? EVR : 128; constexpr int SLD = 136;
    const int chain = item / NCH, sp = item % NCH; const int dir = chain & 1, h = (chain >> 1) & 3, b = chain >> 3;
    const int u = chunk_of(dir, sp), sbase = u * CH;
    const int tid = tid_(), wid = tid >> 6, lane = tid & 63, r = lane & 15, quad = lane >> 4;
    bf16_t* Vs = sm; bf16_t* Ks = sm + 128 * SLD; float* wk = (float*)(sm + 128 * SLD + DK * SLD);
    __syncthreads();
    const float* ms = p.MS + ((size_t)chain * NCH + sp) * 4;
    if (tid < 128) wk[tid] = __expf(ms[2] + p.AT[(size_t)chain * TT + sbase + tid] - ms[1]);
    const bf16_t* vt = p.V2T + ((size_t)(b * 4 + h) * 128) * TT + sbase;
    for (int c = tid; c < 128 * 16; c += 256) { int row = c >> 4, kc = c & 15; *(u32x4*)(Vs + row * SLD + kc * 8) = *(const u32x4*)(vt + (size_t)row * TT + kc * 8); }
    __syncthreads();
    const bf16_t* kt = p.K2T + ((size_t)(b * 4 + h) * DK) * TT + sbase;
    for (int c = tid; c < DK * 16; c += 256) {
        int row = c >> 4, kc = c & 15; Frag f; f.q = *(const u32x4*)(kt + (size_t)row * TT + kc * 8);
        Frag o;
#pragma unroll
        for (int i = 0; i < 4; ++i) o.u[i] = pack2(bf2f((bf16_t)f.v[2 * i]) * wk[kc * 8 + 2 * i], bf2f((bf16_t)f.v[2 * i + 1]) * wk[kc * 8 + 2 * i + 1]);
        *(u32x4*)(Ks + row * SLD + kc * 8) = o.q;
    }
    __syncthreads();
    constexpr int NTW = DK / 64;
    f32x4 acc[ET][NTW];
#pragma unroll
    for (int et = 0; et < ET; ++et)
#pragma unroll
        for (int n = 0; n < NTW; ++n) acc[et][n] = f32x4{0.f, 0.f, 0.f, 0.f};
#pragma unroll
    for (int ks = 0; ks < 4; ++ks) {
        Frag bf[NTW];
#pragma unroll
        for (int n = 0; n < NTW; ++n) bf[n].q = *(const u32x4*)(Ks + ((wid + 4 * n) * 16 + r) * SLD + ks * 32 + quad * 8);
#pragma unroll
        for (int et = 0; et < ET; ++et) {
            Frag af;
            if (et < 8) af.q = *(const u32x4*)(Vs + (et * 16 + r) * SLD + ks * 32 + quad * 8);
            else { const unsigned one = (r == 0) ? 0x3F803F80u : 0u; af.q = u32x4{one, one, one, one}; }
#pragma unroll
            for (int n = 0; n < NTW; ++n) acc[et][n] = mfma16(af.v, bf[n].v, acc[et][n]);
        }
    }
    float* dc = p.DC + ((size_t)chain * NCH + sp) * ER * DK;
#pragma unroll
    for (int et = 0; et < ET; ++et)
#pragma unroll
        for (int n = 0; n < NTW; ++n)
#pragma unroll
            for (int j = 0; j < 4; ++j) dc[(size_t)(et * 16 + quad * 4 + j) * DK + (wid + 4 * n) * 16 + r] = acc[et][n][j];
}

template <int DK, bool NRM>
DEV void rec_scan(const Params& p) {
    constexpr int ER = NRM ? EVR : 128;
    const int total = NCHAIN * ER * DK;
    for (int idx = bid_() * 256 + tid_(); idx < total; idx += gridDim.x * 256) {
        const int chain = idx / (ER * DK), el = idx % (ER * DK);
        float c = 0.f;
        for (int sp = 0; sp < NCH; ++sp) {
            const size_t o = ((size_t)chain * NCH + sp) * ER * DK + el;
            p.CP[o] = f2bf(c);
            c = p.MS[((size_t)chain * NCH + sp) * 4 + 3] * c + p.DC[o];
        }
    }
}

template <int DK, bool NRM>
DEV void rec_out_item(const Params& p, int layer, int item, bf16_t* sm) {
    constexpr int ET = NRM ? 9 : 8; constexpr int ER = NRM ? EVR : 128; constexpr int KLD = DK + 8; constexpr int SLD = 136; constexpr int NKS = DK / 32;
    const int half = item & 1, u = (item >> 1) % NCH, h = ((item >> 1) / NCH) & 3, b = (item >> 1) / (NCH * 4);
    const int tid = tid_(), wid = tid >> 6, lane = tid & 63, r = lane & 15, quad = lane >> 4;
    const int sbase = u * CH; const int tl = half * 64 + wid * 16 + r;
    const size_t rowt = (size_t)b * TT + sbase + tl; const int tq = tl - quad * 4;
    bf16_t* RA = sm; bf16_t* Vs = sm + ER * KLD; float* as_ = (float*)(Vs + 128 * SLD);
    __syncthreads();
    const bf16_t* kg = p.K2 + ((size_t)b * TT + sbase) * (4 * DK) + h * DK;
    for (int c = tid; c < 128 * (DK / 8); c += 256) { int row = c / (DK / 8), kc = c % (DK / 8); *(u32x4*)(RA + row * KLD + kc * 8) = *(const u32x4*)(kg + (size_t)row * (4 * DK) + kc * 8); }
    const int chain0 = (b * 4 + h) * 2;
    as_[tid] = p.AT[(size_t)(chain0 + (tid >> 7)) * TT + sbase + (tid & 127)];
    Frag qf[NKS];
#pragma unroll
    for (int ks = 0; ks < NKS; ++ks) qf[ks].q = *(const u32x4*)(p.Q2 + rowt * (4 * DK) + h * DK + ks * 32 + quad * 8);
    __syncthreads();
    f32x4 sT[8];
#pragma unroll
    for (int st = 0; st < 8; ++st) {
        if ((st & 1) == 0) SCHED_BARRIER();
        f32x4 z = f32x4{0.f, 0.f, 0.f, 0.f};
#pragma unroll
        for (int ks = 0; ks < NKS; ++ks) { Frag ka; ka.q = *(const u32x4*)(RA + (st * 16 + r) * KLD + ks * 32 + quad * 8); z = mfma16(ka.v, qf[ks].v, z); }
        sT[st] = z;
    }
    __syncthreads();
    const bf16_t* vt = p.V2T + ((size_t)(b * 4 + h) * 128) * TT + sbase;
    for (int c = tid; c < 128 * 16; c += 256) { int row = c >> 4, kc = c & 15; *(u32x4*)(Vs + row * SLD + kc * 8) = *(const u32x4*)(vt + (size_t)row * TT + kc * 8); }
    f32x4 hs[8];
#pragma unroll
    for (int et = 0; et < 8; ++et) hs[et] = f32x4{0.f, 0.f, 0.f, 0.f};
#pragma unroll 1
    for (int dir = 0; dir < 2; ++dir) {
        const int chain = chain0 + dir; const int sp = sp_of(dir, u);
        if (dir) __syncthreads();
        const bf16_t* cp = p.CP + ((size_t)chain * NCH + sp) * ER * DK;
        for (int c = tid; c < ER * (DK / 8); c += 256) { int row = c / (DK / 8), kc = c % (DK / 8); *(u32x4*)(RA + row * KLD + kc * 8) = *(const u32x4*)(cp + (size_t)row * DK + kc * 8); }
        __syncthreads();
        const float bt = p.BC[(size_t)chain * TT + sbase + tl], mt = p.MT[(size_t)chain * TT + sbase + tl];
        const float mprev = p.MS[((size_t)chain * NCH + sp) * 4];
        const float winter = __expf(bt + mprev - mt); const float ct = bt - mt;
        f32x4 acc[ET];
#pragma unroll
        for (int et = 0; et < ET; ++et) {
            if ((et & 1) == 0) SCHED_BARRIER();
            f32x4 z = f32x4{0.f, 0.f, 0.f, 0.f};
#pragma unroll
            for (int ks = 0; ks < NKS; ++ks) { Frag ca; ca.q = *(const u32x4*)(RA + (et * 16 + r) * KLD + ks * 32 + quad * 8); z = mfma16(ca.v, qf[ks].v, z); }
            acc[et] = f32x4{z[0] * winter, z[1] * winter, z[2] * winter, z[3] * winter};
        }
#pragma unroll
        for (int kk = 0; kk < 4; ++kk) {
            SCHED_BARRIER();
            Frag pf;
#pragma unroll
            for (int hf = 0; hf < 2; ++hf) {
                const int st = 2 * kk + hf; float w[4];
#pragma unroll
                for (int j = 0; j < 4; ++j) {
                    const int s = st * 16 + quad * 4 + j; const bool ok = dir ? ((st * 16 + j) >= tq) : ((st * 16 + j) <= tq);
                    w[j] = ok ? sT[st][j] * __expf(ct + as_[dir * 128 + s]) : 0.f;
                }
                pf.u[2 * hf] = pack2(w[0], w[1]); pf.u[2 * hf + 1] = pack2(w[2], w[3]);
            }
#pragma unroll
            for (int et = 0; et < ET; ++et) {
                Frag vf;
                if (et < 8) { const bf16_t* vp = Vs + (et * 16 + r) * SLD + kk * 32 + quad * 4; vf.d[0] = *(const u32x2*)vp; vf.d[1] = *(const u32x2*)(vp + 16); }
                else { const unsigned one = (r == 0) ? 0x3F803F80u : 0u; vf.q = u32x4{one, one, one, one}; }
                acc[et] = mfma16(vf.v, pf.v, acc[et]);
            }
        }
        if (NRM) {
            float den = __shfl(acc[ET - 1][0], r);
            const float dn = 1.f / fmaxf(fabsf(den), __expf(-mt));
#pragma unroll
            for (int et = 0; et < 8; ++et) { hs[et][0] += acc[et][0] * dn; hs[et][1] += acc[et][1] * dn; hs[et][2] += acc[et][2] * dn; hs[et][3] += acc[et][3] * dn; }
        } else {
#pragma unroll
            for (int et = 0; et < 8; ++et) { hs[et][0] += acc[et][0]; hs[et][1] += acc[et][1]; hs[et][2] += acc[et][2]; hs[et][3] += acc[et][3]; }
        }
    }
    if (NRM) {
        const bf16_t* og = p.OG + rowt * 512 + h * 128; const float* g = p.ev_mnorm_g + (layer >> 1) * 512 + h * 128;
        float sum = 0.f;
#pragma unroll
        for (int et = 0; et < 8; ++et) {
            const u32x2 gq = *(const u32x2*)(og + et * 16 + quad * 4);
            hs[et][0] *= sigmf(bf2f((bf16_t)(gq.x & 0xFFFF))); hs[et][1] *= sigmf(bf2f((bf16_t)(gq.x >> 16)));
            hs[et][2] *= sigmf(bf2f((bf16_t)(gq.y & 0xFFFF))); hs[et][3] *= sigmf(bf2f((bf16_t)(gq.y >> 16)));
            sum += hs[et][0] + hs[et][1] + hs[et][2] + hs[et][3];
        }
        sum += __shfl_xor(sum, 16); sum += __shfl_xor(sum, 32);
        const float mu = sum * (1.f / 128.f); float var = 0.f;
#pragma unroll
        for (int et = 0; et < 8; ++et)
#pragma unroll
            for (int j = 0; j < 4; ++j) { float d = hs[et][j] - mu; var += d * d; }
        var += __shfl_xor(var, 16); var += __shfl_xor(var, 32);
        const float rs = 1.f / sqrtf(var * (1.f / 128.f) + EPS);
        bf16_t* dst = p.CAT + rowt * 1024 + 512 + h * 128;
#pragma unroll
        for (int et = 0; et < 8; ++et) {
            const int e = et * 16 + quad * 4;
            u32x2 w; w.x = pack2((hs[et][0] - mu) * rs * g[e], (hs[et][1] - mu) * rs * g[e + 1]); w.y = pack2((hs[et][2] - mu) * rs * g[e + 2], (hs[et][3] - mu) * rs * g[e + 3]);
            *(u32x2*)(dst + e) = w;
        }
    } else {
        const bf16_t* og = p.OG + rowt * 512 + h * 128;
        float ss = 0.f;
#pragma unroll
        for (int et = 0; et < 8; ++et)
#pragma unroll
            for (int j = 0; j < 4; ++j) ss += hs[et][j] * hs[et][j];
        ss += __shfl_xor(ss, 16); ss += __shfl_xor(ss, 32);
        const float rs = 1.f / sqrtf(ss * (1.f / 128.f) + EPS);
        bf16_t* dst = p.CAT + rowt * 1024 + h * 128;
#pragma unroll
        for (int et = 0; et < 8; ++et) {
            const int e = et * 16 + quad * 4; const u32x2 gq = *(const u32x2*)(og + e);
            u32x2 w; w.x = pack2(hs[et][0] * rs * siluf(bf2f((bf16_t)(gq.x & 0xFFFF))), hs[et][1] * rs * siluf(bf2f((bf16_t)(gq.x >> 16))));
            w.y = pack2(hs[et][2] * rs * siluf(bf2f((bf16_t)(gq.y & 0xFFFF))), hs[et][3] * rs * siluf(bf2f((bf16_t)(gq.y >> 16))));
            *(u32x2*)(dst + e) = w;
        }
    }
}

DEV void phaseC(const Params& p, int layer, unsigned char* smem) {
    const bool odd = layer & 1; const bool with_ctx = layer < DEPTH - 1;
    bf16_t* sm = (bf16_t*)smem;
    const int nqb_l = SEQ / 64, nqb_c = CTX / 64; const int nh = odd ? HKV : HA;
    const int n_lat = BATCH * nh * nqb_l, n_ctx = with_ctx ? BATCH * nh * nqb_c : 0; const int n_dc = NCHAIN * NCH;
    for (int it = bid_(); it < n_lat + n_ctx + n_dc; it += gridDim.x) {
        if (it < n_lat + n_ctx) {
            int qb, bh;
            if (it < n_lat) { qb = nqb_c + it % nqb_l; bh = it / nqb_l; } else { int i2 = it - n_lat; qb = i2 % nqb_c; bh = i2 / nqb_c; }
            const int item = bh * (nqb_l + nqb_c) + qb;
            if (odd) attn_gqa_item(p, item, sm); else attn_diff_item(p, layer, item, sm);
        } else {
            const int item = it - n_lat - n_ctx;
            if (odd) rec_dc_item<64, false>(p, item, sm); else rec_dc_item<128, true>(p, item, sm);
        }
    }
}
DEV void phaseD(const Params& p, int layer) { if (layer & 1) rec_scan<64, false>(p); else rec_scan<128, true>(p); }
DEV void phaseE(const Params& p, int layer, unsigned char* smem) {
    const bool odd = layer & 1; const bool with_ctx = layer < DEPTH - 1;
    const int n = BATCH * 4 * NCH * 2;
    for (int it = bid_(); it < n; it += gridDim.x) {
        const int u = (it >> 1) % NCH; if (!with_ctx && u < NCC) continue;
        if (odd) rec_out_item<64, false>(p, layer, it, (bf16_t*)smem); else rec_out_item<128, true>(p, layer, it, (bf16_t*)smem);
    }
}

struct EpOut {
    const Params& p; const float* gate; int row0, col0;
    DEV void operator()(f32x4 (&acc)[4][4], int wr, int wc, int lane) {
        const int r = lane & 15, quad = lane >> 4;
#pragma unroll
        for (int n = 0; n < 4; ++n) {
            const int col = col0 + wc * 64 + n * 16 + r; const float g = gate[col];
#pragma unroll
            for (int m = 0; m < 4; ++m)
#pragma unroll
                for (int j = 0; j < 4; ++j) { float* x = p.X + (size_t)(row0 + wr * 64 + m * 16 + quad * 4 + j) * D_MODEL + col; *x = ALPHA * (*x) + g * acc[m][n][j]; }
        }
    }
};
DEV void phaseF(const Params& p, int layer, unsigned char* smem) {
    const bool with_ctx = layer < DEPTH - 1; const int ncol = D_MODEL / 128, nrow = NTOK / 128;
    for (int t = bid_(); t < nrow * ncol; t += gridDim.x) {
        const int rt = t / ncol, ct = t % ncol; const int row0 = rt * 128, col0 = ct * 128; const int b = row0 / TT, s = row0 % TT;
        if (!with_ctx && s < CTX) continue;
        const int bb = s < CTX ? BATCH : b;
        ALoadB al; al.base = p.CAT + (size_t)row0 * MIX_OUT; al.ld = MIX_OUT;
        BLoadW bl; bl.base = p.WoutT + ((size_t)layer * D_MODEL + col0) * MIX_OUT; bl.ld = MIX_OUT;
        EpOut ep{p, p.MOD + ((size_t)layer * (BATCH + 1) + bb) * 6 * D_MODEL + 2 * D_MODEL, row0, col0};
        gemm_tile((bf16_t*)smem, al, bl, MIX_OUT / 64, ep);
    }
}

constexpr int NV4 = D_MODEL / 256;
DEV void phaseG(const Params& p, int layer) {
    const bool with_ctx = layer < DEPTH - 1;
    const int wid = tid_() >> 6, lane = tid_() & 63;
    const float* lg = p.ln_g + (size_t)(layer * 2) * D_MODEL; const float* lb = p.ln_b + (size_t)(layer * 2) * D_MODEL;
    const float* wr = p.WrT + (size_t)layer * NR * D_MODEL;
    for (int tok = bid_() * 4 + wid; tok < NTOK; tok += gridDim.x * 4) {
        const int b = tok / TT, s = tok % TT; if (!with_ctx && s < CTX) continue;
        const int bb = s < CTX ? BATCH : b; const float* mod = p.MOD + ((size_t)layer * (BATCH + 1) + bb) * 6 * D_MODEL;
        f32x4 v[NV4]; float sum = 0.f;
#pragma unroll
        for (int i = 0; i < NV4; ++i) { v[i] = *(const f32x4*)(p.X + (size_t)tok * D_MODEL + (i * 64 + lane) * 4); sum += v[i].x + v[i].y + v[i].z + v[i].w; }
        const float mu = wsum(sum) * (1.f / D_MODEL); float var = 0.f;
#pragma unroll
        for (int i = 0; i < NV4; ++i) { float a = v[i].x - mu, bq = v[i].y - mu, c = v[i].z - mu, d = v[i].w - mu; var += a * a + bq * bq + c * c + d * d; }
        const float rs = 1.f / sqrtf(wsum(var) * (1.f / D_MODEL) + EPS);
        f32x4 hv[NV4];
#pragma unroll
        for (int i = 0; i < NV4; ++i) {
            const int k = (i * 64 + lane) * 4;
            const f32x4 g4 = *(const f32x4*)(lg + k), b4 = *(const f32x4*)(lb + k), sh = *(const f32x4*)(mod + 3 * D_MODEL + k), sc = *(const f32x4*)(mod + 4 * D_MODEL + k);
            f32x4 x1; x1.x = (v[i].x - mu) * rs * g4.x + b4.x; x1.y = (v[i].y - mu) * rs * g4.y + b4.y; x1.z = (v[i].z - mu) * rs * g4.z + b4.z; x1.w = (v[i].w - mu) * rs * g4.w + b4.w;
            *(f32x4*)(p.X + (size_t)tok * D_MODEL + k) = x1;
            hv[i].x = x1.x * (1.f + sc.x) + sh.x; hv[i].y = x1.y * (1.f + sc.y) + sh.y; hv[i].z = x1.z * (1.f + sc.z) + sh.z; hv[i].w = x1.w * (1.f + sc.w) + sh.w;
            u32x2 o; o.x = pack2(hv[i].x, hv[i].y); o.y = pack2(hv[i].z, hv[i].w);
            *(u32x2*)(p.H + (size_t)tok * D_MODEL + k) = o;
        }
        float gl[NG];
#pragma unroll
        for (int j = 0; j < NG; ++j) {
            float a = 0.f;
#pragma unroll
            for (int i = 0; i < NV4; ++i) { const f32x4 w4 = *(const f32x4*)(wr + (size_t)j * D_MODEL + (i * 64 + lane) * 4); a += hv[i].x * w4.x + hv[i].y * w4.y + hv[i].z * w4.z + hv[i].w * w4.w; }
            gl[j] = wsum(a) + p.moe_b_group[layer * NG + j];
        }
        int gi = 0; float gm = gl[0];
#pragma unroll
        for (int j = 1; j < NG; ++j) if (gl[j] > gm) { gm = gl[j]; gi = j; }
        float gs = 0.f;
#pragma unroll
        for (int j = 0; j < NG; ++j) gs += expf(gl[j] - gm);
        const float gw = 1.f / gs;
        float ev[EPG];
        const float* wre = wr + (size_t)(NG + gi * EPG) * D_MODEL;
#pragma unroll
        for (int j = 0; j < EPG; ++j) {
            float a = 0.f;
#pragma unroll
            for (int i = 0; i < NV4; ++i) { const f32x4 w4 = *(const f32x4*)(wre + (size_t)j * D_MODEL + (i * 64 + lane) * 4); a += hv[i].x * w4.x + hv[i].y * w4.y + hv[i].z * w4.z + hv[i].w * w4.w; }
            ev[j] = wsum(a) + p.moe_b_router[layer * NE + gi * EPG + j];
        }
        int i1 = 0; float v1 = ev[0];
#pragma unroll
        for (int j = 1; j < EPG; ++j) if (ev[j] > v1) { v1 = ev[j]; i1 = j; }
        int i2 = -1; float v2 = -3.0e38f;
#pragma unroll
        for (int j = 0; j < EPG; ++j) if (j != i1 && ev[j] > v2) { v2 = ev[j]; i2 = j; }
        const float e2 = expf(v2 - v1); const float w1 = gw / (1.f + e2), w2 = gw * e2 / (1.f + e2);
        if (lane == 0) {
            const int ea = gi * EPG + i1, eb = gi * EPG + i2;
            const int pa = atomicAdd(p.CNT + layer * NE + ea, 1), pb = atomicAdd(p.CNT + layer * NE + eb, 1);
            p.LIST[(size_t)ea * NTOK + pa] = tok; p.LISTW[(size_t)ea * NTOK + pa] = w1;
            p.LIST[(size_t)eb * NTOK + pb] = tok; p.LISTW[(size_t)eb * NTOK + pb] = w2;
            p.TOKSLOT[tok * 2] = (ea << 20) | pa; p.TOKSLOT[tok * 2 + 1] = (eb << 20) | pb;
        }
    }
}

struct EpGU {
    const Params& p; int slot0, nvalid, col0;
    DEV void operator()(f32x4 (&acc)[4][4], int wr, int wc, int lane) {
        const int r = lane & 15, quad = lane >> 4; const int j0 = (col0 + wc * 64) >> 1;
#pragma unroll
        for (int m = 0; m < 4; ++m)
#pragma unroll
            for (int j = 0; j < 4; ++j) {
                const int rl = wr * 64 + m * 16 + quad * 4 + j;
                if (rl < nvalid) {
                    bf16_t* d = p.ACT + (size_t)(slot0 + rl) * D_EXPERT + j0 + r;
                    d[0] = f2bf(siluf(acc[m][0][j]) * acc[m][2][j]); d[16] = f2bf(siluf(acc[m][1][j]) * acc[m][3][j]);
                }
            }
    }
};
struct EpDown {
    const Params& p; const float* lw; int slot0, nvalid, col0;
    DEV void operator()(f32x4 (&acc)[4][4], int wr, int wc, int lane) {
        const int r = lane & 15, quad = lane >> 4;
#pragma unroll
        for (int m = 0; m < 4; ++m)
#pragma unroll
            for (int j = 0; j < 4; ++j) {
                const int rl = wr * 64 + m * 16 + quad * 4 + j;
                if (rl < nvalid) {
                    const float w = lw[rl]; float* d = p.YS + (size_t)(slot0 + rl) * D_MODEL + col0 + wc * 64 + r;
                    d[0] = w * acc[m][0][j]; d[16] = w * acc[m][1][j]; d[32] = w * acc[m][2][j]; d[48] = w * acc[m][3][j];
                }
            }
    }
};
template <bool DOWN>
DEV void phaseHI(const Params& p, int layer, unsigned char* smem) {
    int* tpre = (int*)(smem + 74 * 1024); int* sbase = tpre + 40;
    const int tid = tid_(); const int bid = bid_();
    __syncthreads();
    if (tid == 0) {
        int ta = 0, sa = 0;
        for (int e = 0; e < NE; ++e) { const int c = p.CNT[layer * NE + e]; tpre[e] = ta; sbase[e] = sa; ta += (c + 127) >> 7; sa += c; }
        tpre[NE] = ta;
        if (bid == 0 && !DOWN) for (int e = 0; e < NE; ++e) p.BASE[e] = sbase[e];
    }
    __syncthreads();
    const int ncol = DOWN ? D_MODEL / 128 : 2 * D_EXPERT / 128; const int ntile = tpre[NE] * ncol;
    for (int t = bid; t < ntile; t += gridDim.x) {
        const int rtg = t / ncol, ct = t % ncol; int e = 0;
        for (int q = 1; q < NE; ++q) if (tpre[q] <= rtg) e = q;
        const int rt = rtg - tpre[e]; const int cnt = p.CNT[layer * NE + e]; const int nvalid = imin(128, cnt - rt * 128); const int slot0 = sbase[e] + rt * 128;
        if (!DOWN) {
            ALoadG al; al.H = p.H; al.list = p.LIST + (size_t)e * NTOK + rt * 128; al.nvalid = nvalid;
            BLoadW bl; bl.base = p.Wgu + ((size_t)(layer * NE + e) * 2 * D_EXPERT + ct * 128) * D_MODEL; bl.ld = D_MODEL;
            EpGU ep{p, slot0, nvalid, ct * 128};
            gemm_tile((bf16_t*)smem, al, bl, D_MODEL / 64, ep);
        } else {
            ALoadB al; al.base = p.ACT + (size_t)slot0 * D_EXPERT; al.ld = D_EXPERT;
            BLoadW bl; bl.base = p.WdT + ((size_t)(layer * NE + e) * D_MODEL + ct * 128) * D_EXPERT; bl.ld = D_EXPERT;
            EpDown ep{p, p.LISTW + (size_t)e * NTOK + rt * 128, slot0, nvalid, ct * 128};
            gemm_tile((bf16_t*)smem, al, bl, D_EXPERT / 64, ep);
        }
    }
}

DEV void phaseJ(const Params& p, int layer) {
    const bool with_ctx = layer < DEPTH - 1; const bool last = layer == DEPTH - 1;
    const int wid = tid_() >> 6, lane = tid_() & 63;
    const float* lg = p.ln_g + (size_t)(layer * 2 + 1) * D_MODEL; const float* lb = p.ln_b + (size_t)(layer * 2 + 1) * D_MODEL;
    for (int tok = bid_() * 4 + wid; tok < NTOK; tok += gridDim.x * 4) {
        const int b = tok / TT, s = tok % TT; if (!with_ctx && s < CTX) continue;
        const int bb = s < CTX ? BATCH : b; const float* gate = p.MOD + ((size_t)layer * (BATCH + 1) + bb) * 6 * D_MODEL + 5 * D_MODEL;
        const int ts0 = p.TOKSLOT[tok * 2], ts1 = p.TOKSLOT[tok * 2 + 1];
        const float* y0 = p.YS + (size_t)(p.BASE[ts0 >> 20] + (ts0 & 0xFFFFF)) * D_MODEL; const float* y1 = p.YS + (size_t)(p.BASE[ts1 >> 20] + (ts1 & 0xFFFFF)) * D_MODEL;
        f32x4 v[NV4]; float sum = 0.f;
#pragma unroll
        for (int i = 0; i < NV4; ++i) {
            const int k = (i * 64 + lane) * 4;
            const f32x4 x = *(const f32x4*)(p.X + (size_t)tok * D_MODEL + k), a = *(const f32x4*)(y0 + k), c = *(const f32x4*)(y1 + k), g = *(const f32x4*)(gate + k);
            v[i].x = ALPHA * x.x + g.x * (a.x + c.x); v[i].y = ALPHA * x.y + g.y * (a.y + c.y); v[i].z = ALPHA * x.z + g.z * (a.z + c.z); v[i].w = ALPHA * x.w + g.w * (a.w + c.w);
            sum += v[i].x + v[i].y + v[i].z + v[i].w;
        }
        const float mu = wsum(sum) * (1.f / D_MODEL); float var = 0.f;
#pragma unroll
        for (int i = 0; i < NV4; ++i) { float a = v[i].x - mu, bq = v[i].y - mu, c = v[i].z - mu, d = v[i].w - mu; var += a * a + bq * bq + c * c + d * d; }
        const float rs = 1.f / sqrtf(wsum(var) * (1.f / D_MODEL) + EPS);
        float* dst = last ? p.out + ((size_t)b * SEQ + (s - CTX)) * D_MODEL : p.X + (size_t)tok * D_MODEL;
#pragma unroll
        for (int i = 0; i < NV4; ++i) {
            const int k = (i * 64 + lane) * 4; const f32x4 g4 = *(const f32x4*)(lg + k), b4 = *(const f32x4*)(lb + k);
            f32x4 o; o.x = (v[i].x - mu) * rs * g4.x + b4.x; o.y = (v[i].y - mu) * rs * g4.y + b4.y; o.z = (v[i].z - mu) * rs * g4.z + b4.z; o.w = (v[i].w - mu) * rs * g4.w + b4.w;
            *(f32x4*)(dst + k) = o;
        }
    }
}

constexpr int PH_PER_LAYER = 10;
constexpr int NPHASE = 1 + DEPTH * PH_PER_LAYER;
DEV void run_phase(const Params& p, int ph, unsigned char* smem) {
    if (ph == 0) { phase0(p, smem); return; }
    const int layer = (ph - 1) / PH_PER_LAYER, sub = (ph - 1) % PH_PER_LAYER;
    switch (sub) {
        case 0: phaseA(p, layer, smem); break;
        case 1: if (!(layer & 1)) phaseB(p, layer); break;
        case 2: phaseC(p, layer, smem); break;
        case 3: phaseD(p, layer); break;
        case 4: phaseE(p, layer, smem); break;
        case 5: phaseF(p, layer, smem); break;
        case 6: phaseG(p, layer); break;
        case 7: phaseHI<false>(p, layer, smem); break;
        case 8: phaseHI<true>(p, layer, smem); break;
        default: phaseJ(p, layer); break;
    }
}
DEV bool phase_is_empty(int ph) { if (ph == 0) return false; return ((ph - 1) % PH_PER_LAYER) == 1 && (((ph - 1) / PH_PER_LAYER) & 1); }

struct Carver { char* base; size_t off; template <class T> T* take(size_t n) { off = (off + 255) & ~(size_t)255; T* r = (T*)(base + off); off += n * sizeof(T); return r; } };
static void make_params(Params& p, void* const* d_in, void* d_out, void* d_ws) {
    const float** in = (const float**)d_in;
    p.x = in[0]; p.c = in[1]; p.ctx = in[2]; p.c_ctx = in[3]; p.w_mod = in[4]; p.b_mod = in[5]; p.ln_g = in[6]; p.ln_b = in[7];
    p.ev_w_in = in[8]; p.ev_w_out = in[9]; p.ev_lambda = in[10]; p.ev_subln_g = in[11]; p.ev_conv_w = in[12]; p.ev_conv_b = in[13];
    p.ev_gate_b = in[14]; p.ev_mnorm_g = in[15]; p.od_w_in = in[16]; p.od_w_out = in[17]; p.od_decay = in[18]; p.od_qk_g = in[19];
    p.moe_w_group = in[20]; p.moe_b_group = in[21]; p.moe_w_router = in[22]; p.moe_b_router = in[23]; p.moe_w_gate = in[24]; p.moe_w_up = in[25]; p.moe_w_down = in[26];
    p.out = (float*)d_out;
    Carver cv{(char*)d_ws, 0};
    p.X = cv.take<float>((size_t)NTOK * D_MODEL);
    p.MOD = cv.take<float>((size_t)DEPTH * (BATCH + 1) * 6 * D_MODEL);
    p.ROPE = cv.take<float>(64 * 16 * 2); p.LAM = cv.take<float>(4);
    p.WrT = cv.take<float>((size_t)DEPTH * NR * D_MODEL);
    p.CNT = cv.take<int>(DEPTH * NE); p.BASE = cv.take<int>(NE); p.BAR = cv.take<unsigned>(4096);
    p.WinE = cv.take<bf16_t>((size_t)2 * EVEN_INP * D_MODEL); p.WinO = cv.take<bf16_t>((size_t)2 * ODD_IN * D_MODEL);
    p.WoutT = cv.take<bf16_t>((size_t)DEPTH * D_MODEL * MIX_OUT);
    p.Wgu = cv.take<bf16_t>((size_t)DEPTH * NE * 2 * D_EXPERT * D_MODEL); p.WdT = cv.take<bf16_t>((size_t)DEPTH * NE * D_MODEL * D_EXPERT);
    p.CAT = cv.take<bf16_t>((size_t)NTOK * 1024);
    p.LIST = cv.take<int>((size_t)NE * NTOK); p.LISTW = cv.take<float>((size_t)NE * NTOK); p.TOKSLOT = cv.take<int>((size_t)NTOK * 2);
    const size_t mix0 = cv.off;
    p.Q1 = cv.take<bf16_t>((size_t)NTOK * 512); p.K1 = cv.take<bf16_t>((size_t)NTOK * 512); p.V1T = cv.take<bf16_t>((size_t)NTOK * 512);
    p.PM = cv.take<bf16_t>((size_t)NTOK * 1024); p.V2T = cv.take<bf16_t>((size_t)NTOK * 512); p.OG = cv.take<bf16_t>((size_t)NTOK * 512);
    p.G = cv.take<float>((size_t)NTOK * 16);
    p.Q2 = cv.take<bf16_t>((size_t)NTOK * 512); p.K2 = cv.take<bf16_t>((size_t)NTOK * 512); p.K2T = cv.take<bf16_t>((size_t)NTOK * 512);
    p.DC = cv.take<float>((size_t)NCHAIN * NCH * EVR * 128); p.CP = cv.take<bf16_t>((size_t)NCHAIN * NCH * EVR * 128);
    p.BC = cv.take<float>((size_t)NCHAIN * TT); p.AT = cv.take<float>((size_t)NCHAIN * TT); p.MT = cv.take<float>((size_t)NCHAIN * TT); p.MS = cv.take<float>((size_t)NCHAIN * NCH * 4);
    cv.off = mix0;
    p.H = cv.take<bf16_t>((size_t)NTOK * D_MODEL); p.ACT = cv.take<bf16_t>((size_t)(2 * NTOK + 128) * D_EXPERT); p.YS = cv.take<float>((size_t)2 * NTOK * D_MODEL);
}

#ifndef CPU_EMU
#define XB_TMO      128
#define XB_XCNT(j)  (256  + 64 * (j))
#define XB_XSUB(j)  (1280 + 64 * (j))
#define XB_XGEN(j)  (2304 + 64 * (j))
#define XB_TOP      3328
#define XB_TOPGEN   3392
#define XCD_BAR_WORDS 3456
#define XB_SPIN_CAP (1u << 20)
#define LAS __attribute__((address_space(3)))
__device__ __forceinline__ unsigned xb_ld(unsigned* p)              { return __hip_atomic_load(p, __ATOMIC_RELAXED, __HIP_MEMORY_SCOPE_AGENT); }
__device__ __forceinline__ unsigned xb_add(unsigned* p, unsigned v) { return __hip_atomic_fetch_add(p, v, __ATOMIC_RELAXED, __HIP_MEMORY_SCOPE_AGENT); }
__device__ __forceinline__ unsigned xb_xcc_id() { return (unsigned)__builtin_amdgcn_s_getreg((3 << 11) | 20) & 0xFu; }
#define XB_SPIN(cond, bar) do { unsigned _sp = 0; while (cond) { __builtin_amdgcn_s_sleep(1); \
    if ((++_sp & 255u) == 0u) { if (xb_ld(&(bar)[XB_TMO])) break; if (_sp > XB_SPIN_CAP) { atomicAdd(&(bar)[XB_TMO], 1u); break; } } } } while (0)
struct XcdBarrier { unsigned* bar; unsigned x; volatile LAS unsigned* st; };
__device__ __forceinline__ XcdBarrier xcd_barrier_post(unsigned* bar, volatile LAS unsigned* st) {
    XcdBarrier b; b.bar = bar; b.x = xb_xcc_id(); b.st = st;
    if (threadIdx.x == 0) (void)xb_add(&bar[XB_XCNT(b.x)], 1u);
    return b;
}
__device__ __forceinline__ void xcd_barrier_complete(unsigned* bar, unsigned x, unsigned& nloc, unsigned& nx) {
    const unsigned G = gridDim.x * gridDim.y * gridDim.z;
    unsigned sum, cnt, mine, sp = 0u;
    for (;;) {
        sum = 0u; cnt = 0u; mine = 0u;
#pragma unroll
        for (unsigned j = 0; j < 16; ++j) { const unsigned c = xb_ld(&bar[XB_XCNT(j)]); sum += c; cnt += (c > 0u) ? 1u : 0u; mine = (j == x) ? c : mine; }
        if (sum == G) break;
        __builtin_amdgcn_s_sleep(1);
        if ((++sp & 255u) == 0u) { if (xb_ld(&bar[XB_TMO])) break; if (sp > XB_SPIN_CAP) { atomicAdd(&bar[XB_TMO], 1u); break; } }
    }
    nloc = mine > 0u ? mine : 1u; nx = cnt > 0u ? cnt : 1u;
}
__device__ __forceinline__ void xcd_barrier(const XcdBarrier& b) {
    asm volatile("s_waitcnt vmcnt(0)" ::: "memory");
    __syncthreads();
    if (threadIdx.x == 0) {
        unsigned* bar = b.bar;
        __builtin_amdgcn_s_waitcnt(0);
        unsigned nloc = b.st[0], nx = b.st[1];
        if (nloc == 0u) { xcd_barrier_complete(bar, b.x, nloc, nx); b.st[0] = nloc; b.st[1] = nx; }
        const unsigned old = xb_add(&bar[XB_XSUB(b.x)], 1u);
        const unsigned gen = old / nloc;
        if (old + 1u == (gen + 1u) * nloc) {
            __builtin_amdgcn_fence(__ATOMIC_RELEASE, "agent");
            asm volatile("s_waitcnt vmcnt(0)" ::: "memory");
            const unsigned og = xb_add(&bar[XB_TOP], 1u);
            const unsigned tg = og / nx;
            if (og + 1u == (tg + 1u) * nx) xb_add(&bar[XB_TOPGEN], 1u);
            else XB_SPIN(xb_ld(&bar[XB_TOPGEN]) == tg, bar);
            __builtin_amdgcn_fence(__ATOMIC_ACQUIRE, "agent");
            xb_add(&bar[XB_XGEN(b.x)], 1u);
            asm volatile("s_waitcnt vmcnt(0)" ::: "memory");
        } else {
            XB_SPIN(xb_ld(&bar[XB_XGEN(b.x)]) == gen, bar);
            __builtin_amdgcn_fence(__ATOMIC_ACQUIRE, "agent");
            asm volatile("s_waitcnt vmcnt(0)" ::: "memory");
        }
    }
    __syncthreads();
}

__global__ void __launch_bounds__(NTHREADS, 2) fwd_megakernel(Params p) {
    __shared__ __attribute__((aligned(16))) unsigned char smem[LDS_BYTES];
    cg::grid_group grid = cg::this_grid();
    volatile LAS unsigned* xst = (volatile LAS unsigned*)(smem + LDS_BYTES - 16);
    if (threadIdx.x == 0) { xst[0] = 0u; xst[1] = 0u; }
    __syncthreads();
    const XcdBarrier xb = xcd_barrier_post(p.BAR, xst);
    grid.sync();
    for (int ph = 0; ph < NPHASE; ++ph) {
        if (phase_is_empty(ph)) continue;
#if defined(__HIP_DEVICE_COMPILE__)
        const __attribute__((address_space(4))) Params* pp = (const __attribute__((address_space(4))) Params*)__builtin_amdgcn_kernarg_segment_ptr();
        asm volatile("" : "+s"(pp));
        const Params q = *pp;
        run_phase(q, ph, smem);
#else
        run_phase(p, ph, smem);
#endif
        if (ph + 1 < NPHASE) xcd_barrier(xb);
    }
}

extern "C" void kernel_launch(void* const* d_in, const int* in_sizes, int n_in, void* d_out, int out_size, void* d_ws, size_t ws_size, hipStream_t stream) {
    static int grid_blocks = 0;
    if (!grid_blocks) {
        int dev = 0, cus = 0, per_cu = 0;
        (void)hipGetDevice(&dev); (void)hipDeviceGetAttribute(&cus, hipDeviceAttributeMultiprocessorCount, dev);
        (void)hipOccupancyMaxActiveBlocksPerMultiprocessor(&per_cu, fwd_megakernel, NTHREADS, 0);
        if (per_cu > 2) per_cu = 2;
        if (per_cu < 1) per_cu = 1;
        grid_blocks = cus * per_cu;
    }
    Params p; memset(&p, 0, sizeof(p));
    make_params(p, d_in, d_out, d_ws);
    (void)hipMemsetAsync(p.BAR, 0, 4096 * sizeof(unsigned), stream);
    void* args[] = {&p};
    hipError_t e = hipLaunchCooperativeKernel((void*)fwd_megakernel, dim3(grid_blocks), dim3(NTHREADS), args, 0, stream);
    if (e != hipSuccess) fprintf(stderr, "cooperative launch failed: %s (grid %d)\n", hipGetErrorString(e), grid_blocks);
}
#endif

#if defined(DIAG_KERNELS) && !defined(CPU_EMU)
template <int SUB, int ODD>
__global__ void __launch_bounds__(NTHREADS, 2) k_diag(Params p, int l2) {
    __shared__ __attribute__((aligned(16))) unsigned char smem[LDS_BYTES];
    const int layer = l2 * 2 + ODD;
    if (SUB == 100) { phase0(p, smem); return; }
    if (SUB == 0) phaseA(p, layer, smem);
    if (SUB == 1) phaseB(p, layer);
    if (SUB == 20) { for (int it = bid_(); it < 100; it += gridDim.x) { if (ODD) attn_gqa_item(p, it, (bf16_t*)smem); else attn_diff_item(p, layer, it, (bf16_t*)smem); } }
    if (SUB == 21) { for (int it = bid_(); it < 100; it += gridDim.x) { if (ODD) rec_dc_item<64, false>(p, it, (bf16_t*)smem); else rec_dc_item<128, true>(p, it, (bf16_t*)smem); } }
    if (SUB == 3) phaseD(p, layer);
    if (SUB == 4) phaseE(p, layer, smem);
    if (SUB == 5) phaseF(p, layer, smem);
    if (SUB == 6) phaseG(p, layer);
    if (SUB == 7) phaseHI<false>(p, layer, smem);
    if (SUB == 8) phaseHI<true>(p, layer, smem);
    if (SUB == 9) phaseJ(p, layer);
}
template __global__ void k_diag<100, 0>(Params, int);
template __global__ void k_diag<0, 0>(Params, int);
template __global__ void k_diag<0, 1>(Params, int);
template __global__ void k_diag<1, 0>(Params, int);
template __global__ void k_diag<20, 0>(Params, int);
template __global__ void k_diag<20, 1>(Params, int);
template __global__ void k_diag<21, 0>(Params, int);
template __global__ void k_diag<21, 1>(Params, int);
template __global__ void k_diag<3, 0>(Params, int);
template __global__ void k_diag<4, 0>(Params, int);
template __global__ void k_diag<4, 1>(Params, int);
template __global__ void k_diag<5, 0>(Params, int);
template __global__ void k_diag<6, 0>(Params, int);
template __global__ void k_diag<7, 0>(Params, int);
template __global__ void k_diag<8, 0>(Params, int);
template __global__ void k_diag<9, 0>(Params, int);
#endif
```

```cpp
#ifdef CPU_EMU
#include "emu.h"
#else
#include <hip/hip_runtime.h>
#include <hip/hip_cooperative_groups.h>
#include <cstdio>
#include <cstdint>
#include <cstring>
namespace cg = cooperative_groups;
#endif

#define DEV __device__ __forceinline__
#ifdef CPU_EMU
#define SCHED_BARRIER() do {} while (0)
#else
#define SCHED_BARRIER() __builtin_amdgcn_sched_barrier(0)
#endif
#ifdef CPU_EMU
static inline void glds16(const void* g, void* l) { memcpy(l, g, 16); }
template <int N> static inline void wait_vm() {}
#define RAW_BARRIER() __syncthreads()
#else
__device__ __forceinline__ void glds16(const void* g, void* l) {
    __builtin_amdgcn_global_load_lds((const __attribute__((address_space(1))) unsigned*)g, (__attribute__((address_space(3))) unsigned*)l, 16, 0, 0);
}
template <int N> __device__ __forceinline__ void wait_vm() { asm volatile("s_waitcnt vmcnt(%0)" ::"n"(N) : "memory"); }
#define RAW_BARRIER() do { asm volatile("s_waitcnt lgkmcnt(0)" ::: "memory"); __builtin_amdgcn_s_barrier(); } while (0)
#endif
#ifdef CPU_EMU
static inline int tid_() { return (int)threadIdx.x; }
static inline int bid_() { return (int)blockIdx.x; }
#else
__device__ __forceinline__ int tid_() { int t = threadIdx.x; asm volatile("" : "+v"(t)); return t; }
__device__ __forceinline__ int bid_() { int b = blockIdx.x; asm volatile("" : "+s"(b)); return b; }
#endif

#ifdef CPU_EMU_SMALL
constexpr int D_MODEL = 256, BATCH = 2, SEQ = 256, CTX = 256, D_EXPERT = 128;
#else
constexpr int D_MODEL = 1024, BATCH = 4, SEQ = 4096, CTX = 256, D_EXPERT = 512;
#endif
constexpr int DEPTH = 4, GRID_W = 64, CH = 128;
constexpr int TT = CTX + SEQ, NTOK = BATCH * TT, NCH = TT / CH, NCC = CTX / CH;
constexpr float EPS = 1e-5f;
constexpr float ALPHA = 1.6817928305074290f;
constexpr int HA = 4, HB = 4, HC = 4, HD = 8, HKV = 2;
constexpr int EVEN_IN = 3600, EVEN_INP = 3840, ODD_IN = 2304, MIX_OUT = 1024;
constexpr int NG = 4, EPG = 8, NE = 32, NR = NG + NE;
constexpr int NTHREADS = 256;
constexpr int LDS_BYTES = 76 * 1024;
constexpr int NCHAIN = BATCH * 4 * 2;
constexpr int EVR = 144;

typedef unsigned short bf16_t;
typedef short bf16x8 __attribute__((ext_vector_type(8)));
typedef float f32x4 __attribute__((ext_vector_type(4)));
typedef unsigned u32x4 __attribute__((ext_vector_type(4)));
typedef unsigned u32x2 __attribute__((ext_vector_type(2)));
union Frag { bf16x8 v; u32x4 q; u32x2 d[2]; unsigned u[4]; };
DEV int imin(int a, int b) { return a < b ? a : b; }

#ifdef CPU_EMU
DEV bf16_t f2bf(float f) { unsigned u = __float_as_uint(f); u += 0x7FFFu + ((u >> 16) & 1u); return (bf16_t)(u >> 16); }
DEV unsigned pack2(float a, float b) { return (unsigned)f2bf(a) | ((unsigned)f2bf(b) << 16); }
#else
typedef __bf16 hwbf16x2 __attribute__((ext_vector_type(2)));
typedef float hwf32x2 __attribute__((ext_vector_type(2)));
DEV unsigned pack2(float a, float b) { hwf32x2 v = {a, b}; hwbf16x2 h = __builtin_convertvector(v, hwbf16x2); return __builtin_bit_cast(unsigned, h); }
DEV bf16_t f2bf(float f) { return (bf16_t)(pack2(f, 0.f) & 0xFFFFu); }
#endif
DEV float bf2f(bf16_t h) { return __uint_as_float(((unsigned)h) << 16); }
DEV float siluf(float x) { return x / (1.0f + __expf(-x)); }
DEV float sigmf(float x) { return 1.0f / (1.0f + __expf(-x)); }
DEV float logsigf(float x) { return (x >= 0.f) ? -log1pf(expf(-x)) : x - log1pf(expf(x)); }
#ifdef CPU_EMU
DEV float rowred_add(float v) { v += __shfl_xor(v, 1); v += __shfl_xor(v, 2); v += __shfl_xor(v, 4); v += __shfl_xor(v, 8); return v; }
DEV float rowred_max(float v) { v = fmaxf(v, __shfl_xor(v, 1)); v = fmaxf(v, __shfl_xor(v, 2)); v = fmaxf(v, __shfl_xor(v, 4)); v = fmaxf(v, __shfl_xor(v, 8)); return v; }
DEV float lane_read(float v, int src, int lane) { return __shfl(v, src); }
DEV float lane_up(float v, int d, int lane) { return __shfl_up(v, d); }
#else
template <int CTRL> DEV float dppf(float v) { return __uint_as_float((unsigned)__builtin_amdgcn_update_dpp(0, (int)__float_as_uint(v), CTRL, 0xF, 0xF, true)); }
DEV float rowred_add(float v) { v += dppf<0xB1>(v); v += dppf<0x4E>(v); v += dppf<0x141>(v); v += dppf<0x140>(v); return v; }
DEV float rowred_max(float v) { v = fmaxf(v, dppf<0xB1>(v)); v = fmaxf(v, dppf<0x4E>(v)); v = fmaxf(v, dppf<0x141>(v)); v = fmaxf(v, dppf<0x140>(v)); return v; }
DEV float lane_read(float v, int src, int lane) { return __uint_as_float((unsigned)__builtin_amdgcn_ds_bpermute((src & 63) << 2, (int)__float_as_uint(v))); }
DEV float lane_up(float v, int d, int lane) { const float o = __uint_as_float((unsigned)__builtin_amdgcn_ds_bpermute(((lane - d) & 63) << 2, (int)__float_as_uint(v))); return lane >= d ? o : v; }
#endif
#ifdef CPU_EMU
DEV float xch16(float v) { return __shfl_xor(v, 16); }
DEV float xch32(float v) { return __shfl_xor(v, 32); }
#else
typedef unsigned hwu2 __attribute__((ext_vector_type(2)));
DEV void xpair16(float v, float& a, float& b) { const unsigned u = __float_as_uint(v); hwu2 r = __builtin_amdgcn_permlane16_swap(u, u, false, false); a = __uint_as_float(r.x); b = __uint_as_float(r.y); }
DEV void xpair32(float v, float& a, float& b) { const unsigned u = __float_as_uint(v); hwu2 r = __builtin_amdgcn_permlane32_swap(u, u, false, false); a = __uint_as_float(r.x); b = __uint_as_float(r.y); }
#endif
DEV float xmax16(float v) {
#ifdef CPU_EMU
    return fmaxf(v, xch16(v));
#else
    float a, b; xpair16(v, a, b); return fmaxf(a, b);
#endif
}
DEV float xmax32(float v) {
#ifdef CPU_EMU
    return fmaxf(v, xch32(v));
#else
    float a, b; xpair32(v, a, b); return fmaxf(a, b);
#endif
}
DEV float xadd16(float v) {
#ifdef CPU_EMU
    return v + xch16(v);
#else
    float a, b; xpair16(v, a, b); return a + b;
#endif
}
DEV float xadd32(float v) {
#ifdef CPU_EMU
    return v + xch32(v);
#else
    float a, b; xpair32(v, a, b); return a + b;
#endif
}
DEV float wsum(float v) { v = rowred_add(v); v = xadd16(v); return xadd32(v); }
DEV float wmax(float v) { v = rowred_max(v); v = xmax16(v); return xmax32(v); }
DEV f32x4 mfma16(bf16x8 a, bf16x8 b, f32x4 c) { return __builtin_amdgcn_mfma_f32_16x16x32_bf16(a, b, c, 0, 0, 0); }

struct WorkRange { int lo, hi, step; };
DEV WorkRange xcd_range(int T, int bid) {
    WorkRange w; const int G = gridDim.x;
    if ((G & 7) == 0) { const int x = bid & 7, k = bid >> 3; w.lo = (int)(((long long)x * T) >> 3) + k; w.hi = (int)(((long long)(x + 1) * T) >> 3); w.step = G >> 3; }
    else { w.lo = bid; w.hi = T; w.step = G; }
    return w;
}
DEV void dense_tile(int t, int nrow, int ncol, int& rt, int& ct) {
    if ((nrow & 7) == 0) { const int rpg = nrow >> 3; const int rg = t / (ncol * rpg), q = t % (ncol * rpg); ct = q / rpg; rt = rg * rpg + q % rpg; }
    else { rt = t / ncol; ct = t % ncol; }
}

struct Params {
    const float *x, *c, *ctx, *c_ctx, *w_mod, *b_mod, *ln_g, *ln_b, *ev_w_in, *ev_w_out, *ev_lambda, *ev_subln_g, *ev_conv_w, *ev_conv_b,
        *ev_gate_b, *ev_mnorm_g, *od_w_in, *od_w_out, *od_decay, *od_qk_g, *moe_w_group, *moe_b_group, *moe_w_router, *moe_b_router,
        *moe_w_gate, *moe_w_up, *moe_w_down;
    float* out;
    float *X, *MOD, *ROPE, *LAM, *WrT;
    int* CNT; unsigned* BAR;
    bf16_t *WinE, *WinO, *WoutT, *Wgu, *WdT;
    bf16_t *Q1, *K1, *V1T;
    bf16_t *PM, *V2T, *OG;
    float* G;
    bf16_t *Q2, *K2, *K2T;
    bf16_t* CAT;
    bf16_t *DC, *CP;
    float *BC, *AT, *MT, *MS;
    bf16_t *H, *ACT, *HIN, *YS; float* STAT;
    int *LIST, *TOKSLOT, *BASE; float *LISTW;
};

constexpr int GLD = 72;
constexpr int GT = 128 * GLD;

struct BLoadW {
    const bf16_t* base; int ld; u32x4 r[4];
    DEV void fetch(int kt, int tid) {
#pragma unroll
        for (int i = 0; i < 4; ++i) { int c = tid + 256 * i, row = c >> 3, kc = c & 7; r[i] = *(const u32x4*)(base + (size_t)row * ld + kt * 64 + kc * 8); }
    }
    DEV void commit(bf16_t* S, int tid) {
#pragma unroll
        for (int i = 0; i < 4; ++i) { int c = tid + 256 * i, row = c >> 3, kc = c & 7; *(u32x4*)(S + row * GLD + kc * 8) = r[i]; }
    }
};
struct ALoadB {
    const bf16_t* base; int ld; u32x4 r[4];
    DEV void fetch(int kt, int tid) {
#pragma unroll
        for (int i = 0; i < 4; ++i) { int c = tid + 256 * i, row = c >> 3, kc = c & 7; r[i] = *(const u32x4*)(base + (size_t)row * ld + kt * 64 + kc * 8); }
    }
    DEV void commit(bf16_t* S, int tid) {
#pragma unroll
        for (int i = 0; i < 4; ++i) { int c = tid + 256 * i, row = c >> 3, kc = c & 7; *(u32x4*)(S + row * GLD + kc * 8) = r[i]; }
    }
};
struct ALoadG {
    const bf16_t* H; const int* list; int nvalid; u32x4 r[4];
    DEV void fetch(int kt, int tid) {
#pragma unroll
        for (int i = 0; i < 4; ++i) {
            int c = tid + 256 * i, row = c >> 3, kc = c & 7; int rr = row < nvalid ? row : nvalid - 1; int tok = list[rr];
            r[i] = *(const u32x4*)(H + (size_t)tok * D_MODEL + kt * 64 + kc * 8);
        }
    }
    DEV void commit(bf16_t* S, int tid) {
#pragma unroll
        for (int i = 0; i < 4; ++i) { int c = tid + 256 * i, row = c >> 3, kc = c & 7; *(u32x4*)(S + row * GLD + kc * 8) = r[i]; }
    }
};
struct ALoadX {
    const float* base; const float *sc, *sh; f32x4 r[8]; f32x4 s4, h4;
    DEV void fetch(int kt, int tid) {
        int kc = tid & 15;
        s4 = *(const f32x4*)(sc + kt * 64 + kc * 4); h4 = *(const f32x4*)(sh + kt * 64 + kc * 4);
#pragma unroll
        for (int i = 0; i < 8; ++i) { int row = (tid >> 4) + 16 * i; r[i] = *(const f32x4*)(base + (size_t)row * D_MODEL + kt * 64 + kc * 4); }
    }
    DEV void commit(bf16_t* S, int tid) {
        int kc = tid & 15;
#pragma unroll
        for (int i = 0; i < 8; ++i) {
            int row = (tid >> 4) + 16 * i;
            u32x2 o; o.x = pack2(r[i].x * (1.f + s4.x) + h4.x, r[i].y * (1.f + s4.y) + h4.y); o.y = pack2(r[i].z * (1.f + s4.z) + h4.z, r[i].w * (1.f + s4.w) + h4.w);
            *(u32x2*)(S + row * GLD + kc * 4) = o;
        }
    }
};

template <class AL, class BL, class EP>
DEV void gemm_tile(bf16_t* sm, AL& al, BL& bl, int nkt, EP& ep) {
    const int tid = tid_(), wid = tid >> 6, lane = tid & 63, wr = wid >> 1, wc = wid & 1, r = lane & 15, quad = lane >> 4;
    bf16_t* As = sm; bf16_t* Bs = sm + 2 * GT;
    f32x4 acc[4][4];
#pragma unroll
    for (int m = 0; m < 4; ++m)
#pragma unroll
        for (int n = 0; n < 4; ++n) acc[m][n] = f32x4{0.f, 0.f, 0.f, 0.f};
    al.fetch(0, tid); bl.fetch(0, tid); al.commit(As, tid); bl.commit(Bs, tid);
    __syncthreads();
    for (int kt = 0; kt < nkt; ++kt) {
        const int cur = kt & 1;
        if (kt + 1 < nkt) { al.fetch(kt + 1, tid); bl.fetch(kt + 1, tid); }
        const bf16_t* Ac = As + cur * GT + (wr * 64 + r) * GLD + quad * 8;
        const bf16_t* Bc = Bs + cur * GT + (wc * 64 + r) * GLD + quad * 8;
#pragma unroll
        for (int ks = 0; ks < 2; ++ks) {
            Frag a[4], b[4];
#pragma unroll
            for (int m = 0; m < 4; ++m) a[m].q = *(const u32x4*)(Ac + m * 16 * GLD + ks * 32);
#pragma unroll
            for (int n = 0; n < 4; ++n) b[n].q = *(const u32x4*)(Bc + n * 16 * GLD + ks * 32);
#pragma unroll
            for (int m = 0; m < 4; ++m)
#pragma unroll
                for (int n = 0; n < 4; ++n) acc[m][n] = mfma16(a[m].v, b[n].v, acc[m][n]);
        }
        if (kt + 1 < nkt) { al.commit(As + (cur ^ 1) * GT, tid); bl.commit(Bs + (cur ^ 1) * GT, tid); }
        __syncthreads();
    }
    ep(acc, wr, wc, lane);
}


DEV int g2_h(int g) { return (0x78 >> (2 * g)) & 3; }
template <int NH> struct G2 { static constexpr int BROWS = 128 * NH, STAGE = 8192 + BROWS * 64, NST = (NH == 2 ? 3 : 4), LPS = 2 + 2 * NH; };

template <int NH, bool TR, class EP>
DEV void gemm_tile2(unsigned char* sm, const bf16_t* a0, const bf16_t* a1, const bf16_t* bb, int ldb, int nkt, EP& ep) {
    constexpr int STAGE = G2<NH>::STAGE, NST = G2<NH>::NST, LPS = G2<NH>::LPS;
    const int tid = tid_(), wid = tid >> 6, lane = tid & 63, wr = wid >> 1, wc = wid & 1, r = lane & 15, quad = lane >> 4;
    f32x4 acc[NH][4][4];
#pragma unroll
    for (int h = 0; h < NH; ++h)
#pragma unroll
        for (int m = 0; m < 4; ++m)
#pragma unroll
            for (int n = 0; n < 4; ++n) acc[h][m][n] = f32x4{0.f, 0.f, 0.f, 0.f};
    unsigned char* dst0 = sm + tid * 16;
    auto issue = [&](int kt, int slot) {
        unsigned char* d = dst0 + slot * STAGE;
        glds16(a0 + kt * 32, d); glds16(a1 + kt * 32, d + 4096);
#pragma unroll
        for (int j = 0; j < 2 * NH; ++j) glds16(bb + (size_t)j * 64 * ldb + kt * 32, d + 8192 + j * 4096);
    };
    RAW_BARRIER();
#pragma unroll
    for (int st = 0; st < NST - 1; ++st) if (st < nkt) issue(st, st);
    const int pco = (quad ^ g2_h((r >> 2) & 3)) * 16;
    const unsigned char* afr = sm + (wr * 64 + r) * 64 + pco;
    const unsigned char* bfr = sm + 8192 + (wc * 64 * NH + r) * 64 + pco;
    int slot = 0;
    for (int kt = 0; kt < nkt; ++kt) {
        const int rem = nkt - 1 - kt;
        if (NST == 3) { if (rem >= 1) wait_vm<LPS>(); else wait_vm<0>(); }
        else { if (rem >= 2) wait_vm<2 * LPS>(); else if (rem == 1) wait_vm<LPS>(); else wait_vm<0>(); }
        RAW_BARRIER();
        if (kt + NST - 1 < nkt) { int ns = slot + NST - 1; if (ns >= NST) ns -= NST; issue(kt + NST - 1, ns); }
        const unsigned char* as = afr + slot * STAGE; const unsigned char* bs = bfr + slot * STAGE;
        Frag a[4];
#pragma unroll
        for (int m = 0; m < 4; ++m) a[m].q = *(const u32x4*)(as + m * 16 * 64);
#ifndef CPU_EMU
        __builtin_amdgcn_s_setprio(1);
#endif
#pragma unroll
        for (int h = 0; h < NH; ++h) {
            Frag b[4];
#pragma unroll
            for (int n = 0; n < 4; ++n) b[n].q = *(const u32x4*)(bs + (h * 64 + n * 16) * 64);
#pragma unroll
            for (int m = 0; m < 4; ++m)
#pragma unroll
                for (int n = 0; n < 4; ++n) acc[h][m][n] = TR ? mfma16(b[n].v, a[m].v, acc[h][m][n]) : mfma16(a[m].v, b[n].v, acc[h][m][n]);
        }
#ifndef CPU_EMU
        __builtin_amdgcn_s_setprio(0);
#endif
        if (++slot == NST) slot = 0;
    }
#pragma unroll
    for (int h = 0; h < NH; ++h) { if (TR) ep.nat(acc[h], wr, wc * NH + h, lane); else ep(acc[h], wr, wc * NH + h, lane); }
}
DEV int g2_lc(int tid) { return (tid & 3) ^ g2_h((tid >> 4) & 3); }

struct ConvJob { const float* src; bf16_t* dst; int ldsrc, N, K, k0, n0, mapkind; };
DEV void conv_load(const ConvJob& j, int tid, f32x4 (&v)[4]) {
#pragma unroll
    for (int i = 0; i < 4; ++i) {
        const int kk = (tid >> 4) + 16 * i, n = j.n0 + 4 * (tid & 15);
        v[i] = f32x4{0.f, 0.f, 0.f, 0.f};
        if (n + 3 < j.N) v[i] = *(const f32x4*)(j.src + (size_t)(j.k0 + kk) * j.ldsrc + n);
    }
}
DEV void conv_store(float* T, const ConvJob& j, int tid, const f32x4 (&v)[4]) {
    __syncthreads();
#pragma unroll
    for (int i = 0; i < 4; ++i) {
        const int kk = (tid >> 4) + 16 * i, n4 = tid & 15;
        T[(4 * n4 + 0) * 65 + kk] = v[i].x; T[(4 * n4 + 1) * 65 + kk] = v[i].y; T[(4 * n4 + 2) * 65 + kk] = v[i].z; T[(4 * n4 + 3) * 65 + kk] = v[i].w;
    }
    __syncthreads();
    const int nl = tid >> 2, ks = (tid & 3) * 16; const int n = j.n0 + nl; int dr = n;
    if (j.mapkind == 1) dr = (n >> 5) * 64 + (n & 31); else if (j.mapkind == 2) dr = (n >> 5) * 64 + 32 + (n & 31);
    const float* t = T + nl * 65 + ks;
    u32x4 o0, o1;
    o0.x = pack2(t[0], t[1]); o0.y = pack2(t[2], t[3]); o0.z = pack2(t[4], t[5]); o0.w = pack2(t[6], t[7]);
    o1.x = pack2(t[8], t[9]); o1.y = pack2(t[10], t[11]); o1.z = pack2(t[12], t[13]); o1.w = pack2(t[14], t[15]);
    bf16_t* d = j.dst + (size_t)dr * j.K + j.k0 + ks;
    *(u32x4*)d = o0; *(u32x4*)(d + 8) = o1;
}
constexpr int P0_NMOD = DEPTH * 6 * D_MODEL / 64;
constexpr int P0_NCOPY = NTOK / 64;
constexpr int T_EIN = (D_MODEL / 64) * (EVEN_INP / 64), T_OIN = (D_MODEL / 64) * (ODD_IN / 64), T_OUT = (MIX_OUT / 64) * (D_MODEL / 64);
constexpr int T_GU = (D_MODEL / 64) * (D_EXPERT / 64), T_DN = (D_EXPERT / 64) * (D_MODEL / 64);
constexpr int P0_C0 = P0_NMOD + P0_NCOPY + 1 + DEPTH;
constexpr int P0_C1 = 2 * T_EIN, P0_C2 = P0_C1 + 2 * T_OIN, P0_C3 = P0_C2 + DEPTH * T_OUT, P0_C4 = P0_C3 + DEPTH * NE * 2 * T_GU, P0_C5 = P0_C4 + DEPTH * NE * T_DN;
DEV ConvJob conv_job(const Params& p, int t) {
    ConvJob j;
    if (t < P0_C1) {
        const int i = t / T_EIN, tt = t % T_EIN; const int nt = tt % (EVEN_INP / 64), kt = tt / (EVEN_INP / 64);
        j.src = p.ev_w_in + (size_t)i * D_MODEL * EVEN_IN; j.ldsrc = EVEN_IN; j.N = EVEN_IN; j.K = D_MODEL; j.k0 = kt * 64; j.n0 = nt * 64; j.dst = p.WinE + (size_t)i * EVEN_INP * D_MODEL; j.mapkind = 0;
    } else if (t < P0_C2) {
        const int q = t - P0_C1, i = q / T_OIN, tt = q % T_OIN; const int nt = tt % (ODD_IN / 64), kt = tt / (ODD_IN / 64);
        j.src = p.od_w_in + (size_t)i * D_MODEL * ODD_IN; j.ldsrc = ODD_IN; j.N = ODD_IN; j.K = D_MODEL; j.k0 = kt * 64; j.n0 = nt * 64; j.dst = p.WinO + (size_t)i * ODD_IN * D_MODEL; j.mapkind = 0;
    } else if (t < P0_C3) {
        const int q = t - P0_C2, layer = q / T_OUT, tt = q % T_OUT; const int nt = tt % (D_MODEL / 64), kt = tt / (D_MODEL / 64);
        j.src = (layer & 1) ? p.od_w_out + (size_t)(layer >> 1) * MIX_OUT * D_MODEL : p.ev_w_out + (size_t)(layer >> 1) * MIX_OUT * D_MODEL;
        j.ldsrc = D_MODEL; j.N = D_MODEL; j.K = MIX_OUT; j.k0 = kt * 64; j.n0 = nt * 64; j.dst = p.WoutT + (size_t)layer * D_MODEL * MIX_OUT; j.mapkind = 0;
    } else if (t < P0_C4) {
        const int q = t - P0_C3, le = q / (2 * T_GU); int tt = q % (2 * T_GU); const int up = tt / T_GU; tt %= T_GU; const int nt = tt % (D_EXPERT / 64), kt = tt / (D_EXPERT / 64);
        j.src = (up ? p.moe_w_up : p.moe_w_gate) + (size_t)le * D_MODEL * D_EXPERT; j.ldsrc = D_EXPERT; j.N = D_EXPERT; j.K = D_MODEL; j.k0 = kt * 64; j.n0 = nt * 64;
        j.dst = p.Wgu + (size_t)le * 2 * D_EXPERT * D_MODEL; j.mapkind = 1 + up;
    } else {
        const int q = t - P0_C4, le = q / T_DN, tt = q % T_DN; const int nt = tt % (D_MODEL / 64), kt = tt / (D_MODEL / 64);
        j.src = p.moe_w_down + (size_t)le * D_EXPERT * D_MODEL; j.ldsrc = D_MODEL; j.N = D_MODEL; j.K = D_EXPERT; j.k0 = kt * 64; j.n0 = nt * 64; j.dst = p.WdT + (size_t)le * D_MODEL * D_EXPERT; j.mapkind = 0;
    }
    return j;
}

DEV void phase0(const Params& p, unsigned char* smem) {
    const int tid = tid_(); const int bid = bid_();
    float* fs = (float*)smem;
    for (int task = bid; task < P0_C0; task += gridDim.x) {
        if (task < P0_NMOD) {
            __syncthreads();
            for (int i = tid; i < (BATCH + 1) * D_MODEL; i += 256) { int bb = i / D_MODEL, k = i % D_MODEL; float v = bb < BATCH ? p.c[bb * D_MODEL + k] : p.c_ctx[k]; fs[i] = v / (1.f + expf(-v)); }
            __syncthreads();
            const int col = task * 64 + (tid & 63), kg = tid >> 6; const int layer = col / (6 * D_MODEL), j = col % (6 * D_MODEL);
            const float* w = p.w_mod + (size_t)layer * D_MODEL * 6 * D_MODEL + j;
            float acc[BATCH + 1];
#pragma unroll
            for (int bb = 0; bb <= BATCH; ++bb) acc[bb] = 0.f;
#pragma unroll 16
            for (int k = kg * (D_MODEL / 4); k < (kg + 1) * (D_MODEL / 4); ++k) {
                float wv = w[(size_t)k * 6 * D_MODEL];
#pragma unroll
                for (int bb = 0; bb <= BATCH; ++bb) acc[bb] += fs[bb * D_MODEL + k] * wv;
            }
            float* red = fs + (BATCH + 1) * D_MODEL;
#pragma unroll
            for (int bb = 0; bb <= BATCH; ++bb) red[(kg * (BATCH + 1) + bb) * 64 + (tid & 63)] = acc[bb];
            __syncthreads();
            if (tid < 64) {
                const float bm = p.b_mod[layer * 6 * D_MODEL + j];
#pragma unroll
                for (int bb = 0; bb <= BATCH; ++bb) {
                    const float sacc = red[(0 * (BATCH + 1) + bb) * 64 + tid] + red[(1 * (BATCH + 1) + bb) * 64 + tid] + red[(2 * (BATCH + 1) + bb) * 64 + tid] + red[(3 * (BATCH + 1) + bb) * 64 + tid];
                    p.MOD[((size_t)layer * (BATCH + 1) + bb) * 6 * D_MODEL + j] = sacc + bm;
                }
            }
        } else if (task < P0_NMOD + P0_NCOPY) {
            int r0 = (task - P0_NMOD) * 64;
            for (int i = tid; i < 64 * D_MODEL / 4; i += 256) {
                int row = r0 + i / (D_MODEL / 4), c4 = i % (D_MODEL / 4); int b = row / TT, s = row % TT;
                const float* src = s < CTX ? p.ctx + ((size_t)b * CTX + s) * D_MODEL : p.x + ((size_t)b * SEQ + (s - CTX)) * D_MODEL;
                *(f32x4*)(p.X + (size_t)row * D_MODEL + c4 * 4) = *(const f32x4*)(src + c4 * 4);

            }
        } else if (task == P0_NMOD + P0_NCOPY) {
            for (int i = tid; i < 64 * 16; i += 256) {
                int pos = i / 16, f = i % 16;
                double th = 1.0; for (int q = 0; q < f; ++q) th *= 0.5623413251903490804;
                double t2 = th * th, cs = 1.0, sn = th, tc = 1.0, ts = th;
                for (int n = 1; n < 14; ++n) { tc *= -t2 / ((2 * n - 1) * (2 * n)); ts *= -t2 / ((2 * n) * (2 * n + 1)); cs += tc; sn += ts; }
                double c = 1.0, s = 0.0;
                for (int q = 0; q < pos; ++q) { double cn = c * cs - s * sn, sn2 = s * cs + c * sn; c = cn; s = sn2; }
                p.ROPE[i * 2] = (float)c; p.ROPE[i * 2 + 1] = (float)s;
            }
            if (tid < 2) {
                const float* lp = p.ev_lambda + tid * 4 * 64; float s01 = 0.f, s23 = 0.f;
                for (int k = 0; k < 64; ++k) { s01 += lp[k] * lp[64 + k]; s23 += lp[128 + k] * lp[192 + k]; }
                float lam_init = 0.8f - 0.6f * expf(-0.3f * (float)(2 * tid));
                p.LAM[tid] = expf(s01) - expf(s23) + lam_init;
            }
            for (int i = tid; i < DEPTH * NE * 32; i += 256) p.CNT[i] = 0;
        } else {
            int layer = task - (P0_NMOD + P0_NCOPY + 1);
            for (int i = tid; i < NR * D_MODEL; i += 256) {
                int j = i / D_MODEL, k = i % D_MODEL;
                float v = j < NG ? p.moe_w_group[((size_t)layer * D_MODEL + k) * NG + j] : p.moe_w_router[((size_t)layer * D_MODEL + k) * NE + (j - NG)];
                p.WrT[(size_t)layer * NR * D_MODEL + i] = v;
            }
        }
    }
    {
        const int G = gridDim.x; int t = bid;
        ConvJob j0, j1, j2; f32x4 v0[4], v1[4], v2[4];
        const bool h0 = t < P0_C5, h1 = t + G < P0_C5;
        if (h0) { j0 = conv_job(p, t); conv_load(j0, tid, v0); } else { j0 = conv_job(p, 0); }
        if (h1) { j1 = conv_job(p, t + G); conv_load(j1, tid, v1); } else { j1 = j0; }
        j2 = j1;
        while (t < P0_C5) {
            const bool h2 = t + 2 * G < P0_C5;
            if (h2) { j2 = conv_job(p, t + 2 * G); conv_load(j2, tid, v2); }
            conv_store(fs, j0, tid, v0);
            j0 = j1; j1 = j2;
#pragma unroll
            for (int i = 0; i < 4; ++i) { v0[i] = v1[i]; v1[i] = v2[i]; }
            t += G;
        }
    }
}

DEV int chunk_of(int dir, int sp) { return dir == 0 ? sp : (sp < NCC ? NCC - 1 - sp : NCC + (NCH - 1 - sp)); }
DEV int sp_of(int dir, int u) { return dir == 0 ? u : (u < NCC ? NCC - 1 - u : NCC + (NCH - 1 - u)); }

template <bool RET>
DEV void gate_chain(const Params& p, int layer, int chain) {
    const int lane = tid_() & 63;
    const int dir = chain & 1, h = (chain >> 1) & 3, b = chain >> 3;
    float lg = 0.f;
    if (RET) lg = logsigf(p.od_decay[((layer >> 1) * 2 + dir) * HC + h]);
    float mprev = 0.f;
    for (int sp = 0; sp < NCH; ++sp) {
        const int u = chunk_of(dir, sp); const int sbase = u * CH;
        int i0 = 2 * lane, i1 = 2 * lane + 1;
        int s0 = dir ? sbase + 127 - i0 : sbase + i0, s1 = dir ? sbase + 127 - i1 : sbase + i1;
        float lf0, lf1, li0, li1;
        if (RET) { lf0 = lf1 = lg; li0 = li1 = 0.f; }
        else {
            const float* g0 = p.G + ((size_t)b * TT + s0) * 16; const float* g1 = p.G + ((size_t)b * TT + s1) * 16;
            li0 = g0[(2 * dir) * 4 + h]; li1 = g1[(2 * dir) * 4 + h];
            lf0 = logsigf(g0[(2 * dir + 1) * 4 + h]); lf1 = logsigf(g1[(2 * dir + 1) * 4 + h]);
        }
        float ps = lf0 + lf1;
        for (int d = 1; d < 64; d <<= 1) { float o = lane_up(ps, d, lane); if (lane >= d) ps += o; }
        float b1 = ps, b0 = ps - lf1;
        float bend = lane_read(ps, 63, lane);
        float a0 = li0 - b0, a1 = li1 - b1;
        float pm = fmaxf(a0, a1);
        float mx = pm;
        for (int d = 1; d < 64; d <<= 1) { float o = lane_up(mx, d, lane); if (lane >= d) mx = fmaxf(mx, o); }
        float pmx_prev = lane_up(mx, 1, lane); if (lane == 0) pmx_prev = -3.0e38f;
        float pm0 = fmaxf(pmx_prev, a0), pm1 = mx;
        float amax = lane_read(mx, 63, lane);
        float mnew, carry, mt0, mt1;
        if (RET) { mnew = 0.f; carry = __expf(bend); mt0 = mt1 = 0.f; }
        else { mnew = fmaxf(bend + mprev, bend + amax); carry = __expf(bend + mprev - mnew); mt0 = b0 + fmaxf(mprev, pm0); mt1 = b1 + fmaxf(mprev, pm1); }
        size_t o = (size_t)chain * TT;
        p.BC[o + s0] = b0; p.BC[o + s1] = b1; p.AT[o + s0] = a0; p.AT[o + s1] = a1; p.MT[o + s0] = mt0; p.MT[o + s1] = mt1;
        if (lane == 0) { float* ms = p.MS + ((size_t)chain * NCH + sp) * 4; ms[0] = mprev; ms[1] = mnew; ms[2] = bend; ms[3] = carry; }
        mprev = mnew;
    }
}

struct EpInEven {
    const Params& p; int layer, row0, col0;
    DEV void nat(f32x4 (&acc)[4][4], int wr, int wc, int lane) {
        const int r = lane & 15, quad = lane >> 4;
        const int c0 = col0 + wc * 64, rowb = row0 + wr * 64;
        const int b = row0 / TT; const int sb = rowb - b * TT; const bool lat = sb >= CTX;
        if (c0 < 1024) {
            bf16_t* dst = c0 < 512 ? p.Q1 : p.K1; const int cc = c0 & 511;
#pragma unroll
            for (int m = 0; m < 4; ++m) {
                const int row = rowb + m * 16 + r;
                f32x4 v0 = acc[m][0], v1 = acc[m][1], v2 = acc[m][2], v3 = acc[m][3];
                if (lat) {
                    const int t = sb + m * 16 + r - CTX; const int pr = t / GRID_W, pc = t % GRID_W;
                    const f32x4 ra = *(const f32x4*)(p.ROPE + (pr * 16 + quad * 4) * 2), rb = *(const f32x4*)(p.ROPE + (pr * 16 + quad * 4) * 2 + 4);
                    const f32x4 ca = *(const f32x4*)(p.ROPE + (pc * 16 + quad * 4) * 2), cb = *(const f32x4*)(p.ROPE + (pc * 16 + quad * 4) * 2 + 4);
                    const f32x4 cr = f32x4{ra[0], ra[2], rb[0], rb[2]}, sr = f32x4{ra[1], ra[3], rb[1], rb[3]};
                    const f32x4 cq = f32x4{ca[0], ca[2], cb[0], cb[2]}, sq = f32x4{ca[1], ca[3], cb[1], cb[3]};
                    const f32x4 o0 = v0 * cr - v2 * sr, o2 = v0 * sr + v2 * cr, o1 = v1 * cq - v3 * sq, o3 = v1 * sq + v3 * cq;
                    v0 = o0; v1 = o1; v2 = o2; v3 = o3;
                }
                bf16_t* d = dst + (size_t)row * 512 + cc + quad * 4;
                u32x2 w; w.x = pack2(v0[0], v0[1]); w.y = pack2(v0[2], v0[3]); *(u32x2*)d = w;
                w.x = pack2(v1[0], v1[1]); w.y = pack2(v1[2], v1[3]); *(u32x2*)(d + 16) = w;
                w.x = pack2(v2[0], v2[1]); w.y = pack2(v2[2], v2[3]); *(u32x2*)(d + 32) = w;
                w.x = pack2(v3[0], v3[1]); w.y = pack2(v3[2], v3[3]); *(u32x2*)(d + 48) = w;
            }
        } else if (c0 < 3584) {
            const bool pm = c0 < 2560; bf16_t* dst = pm ? p.PM : p.OG; const int ld = pm ? 1024 : 512; const int cc = pm ? c0 - 1536 : c0 - 3072;
#pragma unroll
            for (int m = 0; m < 4; ++m) {
                bf16_t* d = dst + (size_t)(rowb + m * 16 + r) * ld + cc + quad * 4;
#pragma unroll
                for (int n = 0; n < 4; ++n) { u32x2 w; w.x = pack2(acc[m][n][0], acc[m][n][1]); w.y = pack2(acc[m][n][2], acc[m][n][3]); *(u32x2*)(d + n * 16) = w; }
            }
        } else if (c0 == 3584) {
            const f32x4 gb = *(const f32x4*)(p.ev_gate_b + (layer >> 1) * 16 + quad * 4);
#pragma unroll
            for (int m = 0; m < 4; ++m) *(f32x4*)(p.G + (size_t)(rowb + m * 16 + r) * 16 + quad * 4) = acc[m][0] + gb;
        }
    }
    DEV void operator()(f32x4 (&acc)[4][4], int wr, int wc, int lane) {
        const int r = lane & 15, quad = lane >> 4;
        const int c0 = col0 + wc * 64, rowb = row0 + wr * 64;
        const int b = row0 / TT; const int sb = rowb - b * TT; const bool lat = sb >= CTX;
        if (c0 < 1024) {
            bf16_t* dst = c0 < 512 ? p.Q1 : p.K1; const int cc = c0 & 511;
#pragma unroll
            for (int m = 0; m < 4; ++m)
#pragma unroll
                for (int j = 0; j < 4; ++j) {
                    const int row = rowb + m * 16 + quad * 4 + j;
                    float v0 = acc[m][0][j], v1 = acc[m][1][j], v2 = acc[m][2][j], v3 = acc[m][3][j];
                    if (lat) {
                        const int t = sb + m * 16 + quad * 4 + j - CTX; const int pr = t / GRID_W, pc = t % GRID_W;
                        const float cr = p.ROPE[(pr * 16 + r) * 2], sr = p.ROPE[(pr * 16 + r) * 2 + 1], cq = p.ROPE[(pc * 16 + r) * 2], sq = p.ROPE[(pc * 16 + r) * 2 + 1];
                        float o0 = v0 * cr - v2 * sr, o2 = v0 * sr + v2 * cr, o1 = v1 * cq - v3 * sq, o3 = v1 * sq + v3 * cq;
                        v0 = o0; v1 = o1; v2 = o2; v3 = o3;
                    }
                    bf16_t* d = dst + (size_t)row * 512 + cc + r;
                    d[0] = f2bf(v0); d[16] = f2bf(v1); d[32] = f2bf(v2); d[48] = f2bf(v3);
                }
        } else if (c0 < 1536 || (c0 >= 2560 && c0 < 3072)) {
            const bool at = c0 < 1536; const int cc = at ? c0 - 1024 : c0 - 2560; const int h = cc >> 7, e0 = (cc & 127);
            bf16_t* dst = (at ? p.V1T : p.V2T) + ((size_t)(b * 4 + h) * 128) * TT;
#pragma unroll
            for (int m = 0; m < 4; ++m)
#pragma unroll
                for (int n = 0; n < 4; ++n) {
                    u32x2 o; o.x = pack2(acc[m][n][0], acc[m][n][1]); o.y = pack2(acc[m][n][2], acc[m][n][3]);
                    *(u32x2*)(dst + (size_t)(e0 + n * 16 + r) * TT + sb + m * 16 + quad * 4) = o;
                }
        } else if (c0 < 2560 || (c0 >= 3072 && c0 < 3584)) {
            const bool pm = c0 < 2560; bf16_t* dst = pm ? p.PM : p.OG; const int ld = pm ? 1024 : 512; const int cc = pm ? c0 - 1536 : c0 - 3072;
#pragma unroll
            for (int m = 0; m < 4; ++m)
#pragma unroll
                for (int j = 0; j < 4; ++j) {
                    const int row = rowb + m * 16 + quad * 4 + j; bf16_t* d = dst + (size_t)row * ld + cc + r;
                    d[0] = f2bf(acc[m][0][j]); d[16] = f2bf(acc[m][1][j]); d[32] = f2bf(acc[m][2][j]); d[48] = f2bf(acc[m][3][j]);
                }
        } else if (c0 == 3584) {
            const float gb = p.ev_gate_b[(layer >> 1) * 16 + r];
#pragma unroll
            for (int m = 0; m < 4; ++m)
#pragma unroll
                for (int j = 0; j < 4; ++j) { const int row = rowb + m * 16 + quad * 4 + j; p.G[(size_t)row * 16 + r] = acc[m][0][j] + gb; }
        }
    }
};

struct EpInOdd {
    const Params& p; int layer, row0, col0;
    DEV void nat(f32x4 (&acc)[4][4], int wr, int wc, int lane) {
        const int r = lane & 15, quad = lane >> 4;
        const int c0 = col0 + wc * 64, rowb = row0 + wr * 64;
        const int b = row0 / TT; const int sb = rowb - b * TT; const bool lat = sb >= CTX;
        if (c0 < 512 || (c0 >= 1024 && c0 < 1536)) {
            bf16_t* dst; int ld, cc; float scl = 1.f;
            if (c0 < 256) { dst = p.Q2; ld = 256; cc = c0; } else if (c0 < 512) { dst = p.K2; ld = 256; cc = c0 - 256; scl = 0.125f; } else { dst = p.OG; ld = 512; cc = c0 - 1024; }
#pragma unroll
            for (int m = 0; m < 4; ++m) {
                bf16_t* d = dst + (size_t)(rowb + m * 16 + r) * ld + cc + quad * 4;
#pragma unroll
                for (int n = 0; n < 4; ++n) { u32x2 w; w.x = pack2(acc[m][n][0] * scl, acc[m][n][1] * scl); w.y = pack2(acc[m][n][2] * scl, acc[m][n][3] * scl); *(u32x2*)(d + n * 16) = w; }
            }
        } else if (c0 >= 1536 && c0 < 2176) {
            const bool isq = c0 < 2048; bf16_t* dst = isq ? p.Q1 : p.K1; const int ld = isq ? 512 : 128; const int cc = isq ? c0 - 1536 : c0 - 2048;
            const float* g = p.od_qk_g + ((layer >> 1) * 2 + (isq ? 0 : 1)) * 64 + quad * 4;
            const f32x4 g0 = *(const f32x4*)g, g1 = *(const f32x4*)(g + 16), g2 = *(const f32x4*)(g + 32), g3 = *(const f32x4*)(g + 48);
#pragma unroll
            for (int m = 0; m < 4; ++m) {
                const int row = rowb + m * 16 + r;
                f32x4 v0 = acc[m][0], v1 = acc[m][1], v2 = acc[m][2], v3 = acc[m][3];
                float ss = 0.f;
#pragma unroll
                for (int j = 0; j < 4; ++j) ss += v0[j] * v0[j] + v1[j] * v1[j] + v2[j] * v2[j] + v3[j] * v3[j];
                ss = xadd16(ss); ss = xadd32(ss);
                const float rs = 1.0f / sqrtf(ss * (1.f / 64.f) + EPS);
                v0 = v0 * rs * g0; v1 = v1 * rs * g1; v2 = v2 * rs * g2; v3 = v3 * rs * g3;
                if (lat) {
                    const int t = sb + m * 16 + r - CTX; const int pr = t / GRID_W, pc = t % GRID_W;
                    const f32x4 ra = *(const f32x4*)(p.ROPE + (pr * 16 + quad * 4) * 2), rb = *(const f32x4*)(p.ROPE + (pr * 16 + quad * 4) * 2 + 4);
                    const f32x4 ca = *(const f32x4*)(p.ROPE + (pc * 16 + quad * 4) * 2), cb = *(const f32x4*)(p.ROPE + (pc * 16 + quad * 4) * 2 + 4);
                    const f32x4 cr = f32x4{ra[0], ra[2], rb[0], rb[2]}, sr = f32x4{ra[1], ra[3], rb[1], rb[3]};
                    const f32x4 cq = f32x4{ca[0], ca[2], cb[0], cb[2]}, sq = f32x4{ca[1], ca[3], cb[1], cb[3]};
                    const f32x4 o0 = v0 * cr - v2 * sr, o2 = v0 * sr + v2 * cr, o1 = v1 * cq - v3 * sq, o3 = v1 * sq + v3 * cq;
                    v0 = o0; v1 = o1; v2 = o2; v3 = o3;
                }
                bf16_t* d = dst + (size_t)row * ld + cc + quad * 4;
                u32x2 w; w.x = pack2(v0[0], v0[1]); w.y = pack2(v0[2], v0[3]); *(u32x2*)d = w;
                w.x = pack2(v1[0], v1[1]); w.y = pack2(v1[2], v1[3]); *(u32x2*)(d + 16) = w;
                w.x = pack2(v2[0], v2[1]); w.y = pack2(v2[2], v2[3]); *(u32x2*)(d + 32) = w;
                w.x = pack2(v3[0], v3[1]); w.y = pack2(v3[2], v3[3]); *(u32x2*)(d + 48) = w;
            }
        }
    }
    DEV void operator()(f32x4 (&acc)[4][4], int wr, int wc, int lane) {
        const int r = lane & 15, quad = lane >> 4;
        const int c0 = col0 + wc * 64, rowb = row0 + wr * 64;
        const int b = row0 / TT; const int sb = rowb - b * TT; const bool lat = sb >= CTX;
        if (c0 < 512 || (c0 >= 1024 && c0 < 1536)) {
            bf16_t* dst; int ld, cc; float scl = 1.f;
            if (c0 < 256) { dst = p.Q2; ld = 256; cc = c0; } else if (c0 < 512) { dst = p.K2; ld = 256; cc = c0 - 256; scl = 0.125f; } else { dst = p.OG; ld = 512; cc = c0 - 1024; }
#pragma unroll
            for (int m = 0; m < 4; ++m)
#pragma unroll
                for (int j = 0; j < 4; ++j) {
                    const int row = rowb + m * 16 + quad * 4 + j; bf16_t* d = dst + (size_t)row * ld + cc + r;
                    d[0] = f2bf(acc[m][0][j] * scl); d[16] = f2bf(acc[m][1][j] * scl); d[32] = f2bf(acc[m][2][j] * scl); d[48] = f2bf(acc[m][3][j] * scl);
                }
        } else if (c0 < 1024) {
            const int cc = c0 - 512; const int h = cc >> 7, e0 = cc & 127; bf16_t* dst = p.V2T + ((size_t)(b * 4 + h) * 128) * TT;
#pragma unroll
            for (int m = 0; m < 4; ++m)
#pragma unroll
                for (int n = 0; n < 4; ++n) {
                    u32x2 o; o.x = pack2(acc[m][n][0], acc[m][n][1]); o.y = pack2(acc[m][n][2], acc[m][n][3]);
                    *(u32x2*)(dst + (size_t)(e0 + n * 16 + r) * TT + sb + m * 16 + quad * 4) = o;
                }
        } else if (c0 < 2176) {
            const bool isq = c0 < 2048; bf16_t* dst = isq ? p.Q1 : p.K1; const int ld = isq ? 512 : 128; const int cc = isq ? c0 - 1536 : c0 - 2048;
            const float* g = p.od_qk_g + ((layer >> 1) * 2 + (isq ? 0 : 1)) * 64;
            const float g0 = g[r], g1 = g[16 + r], g2 = g[32 + r], g3 = g[48 + r];
#pragma unroll
            for (int m = 0; m < 4; ++m)
#pragma unroll
                for (int j = 0; j < 4; ++j) {
                    const int row = rowb + m * 16 + quad * 4 + j;
                    float v0 = acc[m][0][j], v1 = acc[m][1][j], v2 = acc[m][2][j], v3 = acc[m][3][j];
                    float ss = v0 * v0 + v1 * v1 + v2 * v2 + v3 * v3;
                    ss = rowred_add(ss);
                    const float rs = 1.0f / sqrtf(ss * (1.f / 64.f) + EPS);
                    v0 *= rs * g0; v1 *= rs * g1; v2 *= rs * g2; v3 *= rs * g3;
                    if (lat) {
                        const int t = sb + m * 16 + quad * 4 + j - CTX; const int pr = t / GRID_W, pc = t % GRID_W;
                        const float cr = p.ROPE[(pr * 16 + r) * 2], sr = p.ROPE[(pr * 16 + r) * 2 + 1], cq = p.ROPE[(pc * 16 + r) * 2], sq = p.ROPE[(pc * 16 + r) * 2 + 1];
                        float o0 = v0 * cr - v2 * sr, o2 = v0 * sr + v2 * cr, o1 = v1 * cq - v3 * sq, o3 = v1 * sq + v3 * cq;
                        v0 = o0; v1 = o1; v2 = o2; v3 = o3;
                    }
                    bf16_t* d = dst + (size_t)row * ld + cc + r;
                    d[0] = f2bf(v0); d[16] = f2bf(v1); d[32] = f2bf(v2); d[48] = f2bf(v3);
                }
        } else {
            const int kv = (c0 - 2176) >> 6; bf16_t* dst = p.V1T + ((size_t)(b * HKV + kv) * 64) * TT;
#pragma unroll
            for (int m = 0; m < 4; ++m)
#pragma unroll
                for (int n = 0; n < 4; ++n) {
                    u32x2 o; o.x = pack2(acc[m][n][0], acc[m][n][1]); o.y = pack2(acc[m][n][2], acc[m][n][3]);
                    *(u32x2*)(dst + (size_t)(n * 16 + r) * TT + sb + m * 16 + quad * 4) = o;
                }
        }
    }
};

DEV void phaseA(const Params& p, int layer, unsigned char* smem) {
    const bool odd = layer & 1;
    const int ncol = odd ? ODD_IN / 256 : EVEN_INP / 256; const int nrow = NTOK / 128;
    const bf16_t* W = odd ? p.WinO + (size_t)(layer >> 1) * ODD_IN * D_MODEL : p.WinE + (size_t)(layer >> 1) * EVEN_INP * D_MODEL;
    const int bid = bid_(); const int tid = tid_(); const int trow = tid >> 2, lc8 = g2_lc(tid) * 8;
    if (odd && bid < NCHAIN && tid < 64) gate_chain<true>(p, layer, bid);
    const WorkRange wr = xcd_range(nrow * ncol, bid);
    for (int t = wr.lo; t < wr.hi; t += wr.step) {
        int rt, ct; dense_tile(t, nrow, ncol, rt, ct); const int row0 = rt * 128, col0 = ct * 256;
        const bf16_t* a0 = p.HIN + (size_t)(row0 + trow) * D_MODEL + lc8;
        const bf16_t* bb = W + (size_t)(col0 + trow) * D_MODEL + lc8;
        if (odd) {
            EpInOdd ep{p, layer, row0, col0};
            if (ct == 2 || ct == 3 || ct == 8) gemm_tile2<2, false>(smem, a0, a0 + (size_t)64 * D_MODEL, bb, D_MODEL, D_MODEL / 32, ep);
            else gemm_tile2<2, true>(smem, a0, a0 + (size_t)64 * D_MODEL, bb, D_MODEL, D_MODEL / 32, ep);
        } else {
            EpInEven ep{p, layer, row0, col0};
            if (ct == 4 || ct == 5 || ct == 10 || ct == 11) gemm_tile2<2, false>(smem, a0, a0 + (size_t)64 * D_MODEL, bb, D_MODEL, D_MODEL / 32, ep);
            else gemm_tile2<2, true>(smem, a0, a0 + (size_t)64 * D_MODEL, bb, D_MODEL, D_MODEL / 32, ep);
        }
    }
#ifdef PROBE_GEMM
    {
        Params q = p; bf16_t* scr = (bf16_t*)p.DC;
        q.Q1 = scr; q.K1 = scr; q.V1T = scr; q.PM = scr; q.V2T = scr; q.OG = scr; q.G = (float*)scr; q.Q2 = scr; q.K2 = scr;
        for (int t = wr.lo; t < wr.hi; t += wr.step) {
            int rt, ct; dense_tile(t, nrow, ncol, rt, ct); const int row0 = rt * 128, col0 = ct * 256;
            const bf16_t* a0 = p.HIN + (size_t)(row0 + trow) * D_MODEL + lc8;
            const bf16_t* bb = W + (size_t)(col0 + trow) * D_MODEL + lc8;
            const int erow0 = (PROBE_GEMM == 2) ? (row0 % TT >= CTX ? CTX : 0) : row0;
            if (odd) {
                EpInOdd ep{q, layer, erow0, col0};
                if (ct == 2 || ct == 3 || ct == 8) gemm_tile2<2, false>(smem, a0, a0 + (size_t)64 * D_MODEL, bb, D_MODEL, D_MODEL / 32, ep);
                else gemm_tile2<2, true>(smem, a0, a0 + (size_t)64 * D_MODEL, bb, D_MODEL, D_MODEL / 32, ep);
            } else {
                EpInEven ep{q, layer, erow0, col0};
                if (ct == 4 || ct == 5 || ct == 10 || ct == 11) gemm_tile2<2, false>(smem, a0, a0 + (size_t)64 * D_MODEL, bb, D_MODEL, D_MODEL / 32, ep);
                else gemm_tile2<2, true>(smem, a0, a0 + (size_t)64 * D_MODEL, bb, D_MODEL, D_MODEL / 32, ep);
            }
        }
    }
#endif
}
DEV void phase0b(const Params& p) {
    const int total = NTOK * (D_MODEL / 4);
    for (int idx = bid_() * 256 + tid_(); idx < total; idx += gridDim.x * 256) {
        const int row = idx / (D_MODEL / 4), k = (idx % (D_MODEL / 4)) * 4; const int b = row / TT, sq = row % TT; const int bb = sq < CTX ? BATCH : b;
        const float* mod = p.MOD + (size_t)bb * 6 * D_MODEL;
        const f32x4 x = *(const f32x4*)(p.X + (size_t)row * D_MODEL + k), sh = *(const f32x4*)(mod + k), sc = *(const f32x4*)(mod + D_MODEL + k);
        u32x2 o; o.x = pack2(x.x * (1.f + sc.x) + sh.x, x.y * (1.f + sc.y) + sh.y); o.y = pack2(x.z * (1.f + sc.z) + sh.z, x.w * (1.f + sc.w) + sh.w);
        *(u32x2*)(p.HIN + (size_t)row * D_MODEL + k) = o;
    }
}

DEV void phaseB(const Params& p, int layer) {
    const int tid = tid_();
    const int bid = bid_();
    if (bid < NCHAIN && tid < 64) gate_chain<false>(p, layer, bid);
    const float* cw = p.ev_conv_w + (size_t)(layer >> 1) * 3 * 1024; const float* cb = p.ev_conv_b + (size_t)(layer >> 1) * 1024;
    const int total = NTOK * 128;
    for (int idx = bid * 256 + tid; idx < total; idx += gridDim.x * 256) {
        const int row = idx >> 7, cg8 = (idx & 127) * 8; const int b = row / TT, s = row % TT;
        const bool hasp = (s != 0) && (s != CTX), hasn = (s != CTX - 1) && (s != TT - 1);
        Frag xm, x0, xp; x0.q = *(const u32x4*)(p.PM + (size_t)row * 1024 + cg8);
        xm.q = u32x4{0u, 0u, 0u, 0u}; xp.q = u32x4{0u, 0u, 0u, 0u};
        if (hasp) xm.q = *(const u32x4*)(p.PM + (size_t)(row - 1) * 1024 + cg8);
        if (hasn) xp.q = *(const u32x4*)(p.PM + (size_t)(row + 1) * 1024 + cg8);
        float y[8];
#pragma unroll
        for (int i = 0; i < 8; ++i) {
            const int ch = cg8 + i;
            float v = cb[ch] + bf2f((bf16_t)xm.v[i]) * cw[ch] + bf2f((bf16_t)x0.v[i]) * cw[1024 + ch] + bf2f((bf16_t)xp.v[i]) * cw[2048 + ch];
            y[i] = siluf(v);
        }
        if (cg8 < 512) {
            u32x4 o; o.x = pack2(y[0], y[1]); o.y = pack2(y[2], y[3]); o.z = pack2(y[4], y[5]); o.w = pack2(y[6], y[7]);
            *(u32x4*)(p.Q2 + (size_t)row * 512 + cg8) = o;
        } else {
            const float sc = 0.08838834764831845f;
#pragma unroll
            for (int i = 0; i < 8; ++i) y[i] *= sc;
            u32x4 o; o.x = pack2(y[0], y[1]); o.y = pack2(y[2], y[3]); o.z = pack2(y[4], y[5]); o.w = pack2(y[6], y[7]);
            const int kc = cg8 - 512; *(u32x4*)(p.K2 + (size_t)row * 512 + kc) = o;
        }
    }
}

template <int NC, int DV, int QT>
struct AttnState { f32x4 O[NC][DV / 16][QT]; f32x4 L[NC][QT]; float m[NC][QT]; };

DEV float max3f(float a, float b, float c) {
#ifdef CPU_EMU
    return fmaxf(fmaxf(a, b), c);
#else
    float d; asm("v_max3_f32 %0, %1, %2, %3" : "=v"(d) : "v"(a), "v"(b), "v"(c)); return d;
#endif
}
DEV float max2f(float a, float b) {
#ifdef CPU_EMU
    return fmaxf(a, b);
#else
    float d; asm("v_max_f32 %0, %1, %2" : "=v"(d) : "v"(a), "v"(b)); return d;
#endif
}
DEV bool wave_any(bool pr) {
#ifdef CPU_EMU
    int v = pr ? 1 : 0; for (int m = 1; m < 64; m <<= 1) v |= __shfl_xor(v, m); return v != 0;
#else
    return __builtin_amdgcn_ballot_w64(pr) != 0;
#endif
}

template <int NC, int DV, int QT, int KW>
DEV void attn_core(bf16_t* sm, const bf16_t* Kg, int ldk, const bf16_t* VTg, int nkeys, const Frag (&qf)[NC][2][QT], AttnState<NC, DV, QT>& st, float sc2, int koff) {
    constexpr int KLD = KW, VLD = 64;
    constexpr int NKR = KW / 32, NVR = DV / 32;
    constexpr int KBUF = 64 * KLD, VBUF = DV * VLD;
    constexpr float TH = 6.0f;
    const float isc2 = 1.0f / sc2;
    const int tid = tid_(), lane = tid & 63, r = lane & 15, quad = lane >> 4;
    u32x4 kreg[NKR], vreg[NVR];
    constexpr int VTPR = 8 / NVR;
    const bf16_t* kp = Kg + (size_t)(tid >> 2) * ldk + (tid & 3) * NKR * 8;
    const bf16_t* vp0 = VTg + (size_t)(tid / VTPR) * TT + (tid % VTPR) * NVR * 8;
    const int krow = tid >> 2, kswz = KW == 128 ? (krow & 15) : ((krow >> 1) & 7);
    const int rswz = KW == 128 ? r : ((r >> 1) & 7), vswz = (r >> 1) & 7;
    const int kfo0 = r * KLD + ((((koff >> 3) + quad) ^ rswz) << 3), kfo1 = kfo0 ^ 32;
    const int vfo0 = r * VLD + ((quad ^ vswz) << 3), vfo1 = vfo0 ^ 32;
    const int nt = nkeys >> 6;
    Frag ones; ones.u[0] = ones.u[1] = ones.u[2] = ones.u[3] = 0x3F803F80u;
    auto loadK = [&]() {
#pragma unroll
        for (int i = 0; i < NKR; ++i) kreg[i] = *(const u32x4*)(kp + i * 8);
        kp += (size_t)64 * ldk; };
    auto loadV = [&]() {
#pragma unroll
        for (int i = 0; i < NVR; ++i) vreg[i] = *(const u32x4*)(vp0 + i * 8);
        vp0 += 64; };
    auto storeK = [&](int buf) {
#pragma unroll
        for (int i = 0; i < NKR; ++i) *(u32x4*)(sm + buf * KBUF + krow * KLD + ((((tid & 3) * NKR + i) ^ kswz) << 3)) = kreg[i]; };
    auto storeV = [&](int buf) {
        bf16_t* vrow = sm + buf * VBUF + 2 * KBUF + (tid / VTPR) * VLD; const int sw = ((tid / VTPR) >> 1) & 7;
#pragma unroll
        for (int i = 0; i < NVR; ++i) {
            const int c = (tid % VTPR) * NVR + i;
#pragma unroll
            for (int hh = 0; hh < 2; ++hh) {
                const int g = 2 * c + hh; const int blk = g >> 3, g32 = g & 7; const int pos = blk * 32 + (2 * (g32 & 3) + (g32 >> 2)) * 4;
                u32x2 w; w.x = hh ? vreg[i].z : vreg[i].x; w.y = hh ? vreg[i].w : vreg[i].y;
                *(u32x2*)(vrow + (((pos >> 3) ^ sw) << 3) + (pos & 7)) = w;
            }
        } };
    float al[QT], thr[QT], mxs[QT]; bool resc = false;
#pragma unroll
    for (int qt = 0; qt < QT; ++qt) { al[qt] = 1.f; thr[qt] = 0.f; mxs[qt] = 0.f; }
    auto sm_step = [&](int k, f32x4 (&sn)[4][QT], Frag (&pfn)[QT][2], const bool force) {
        if (k < QT) {
            const int qt = k;
            float mx = max3f(sn[0][qt][0], sn[0][qt][1], sn[0][qt][2]);
            mx = max3f(mx, sn[0][qt][3], sn[1][qt][0]); mx = max3f(mx, sn[1][qt][1], sn[1][qt][2]); mx = max3f(mx, sn[1][qt][3], sn[2][qt][0]);
            mx = max3f(mx, sn[2][qt][1], sn[2][qt][2]); mx = max3f(mx, sn[2][qt][3], sn[3][qt][0]); mx = max3f(mx, sn[3][qt][1], sn[3][qt][2]);
            mxs[qt] = max2f(mx, sn[3][qt][3]);
        } else if (k == QT) {
            bool need = false;
#pragma unroll
            for (int qt = 0; qt < QT; ++qt) need = need || (mxs[qt] > thr[qt]);
            if (force || wave_any(need)) {
#pragma unroll
                for (int qt = 0; qt < QT; ++qt) {
                    float mx = xmax16(mxs[qt]); mx = xmax32(mx);
                    const float mn = fmaxf(st.m[0][qt], mx * sc2);
                    al[qt] *= __builtin_amdgcn_exp2f(st.m[0][qt] - mn);
                    st.m[0][qt] = mn; thr[qt] = (mn + TH) * isc2;
                }
                resc = true;
            }
        } else if (k <= 5 * QT) {
            const int qt = (k - QT - 1) >> 2, kt = (k - QT - 1) & 3; const float mn = st.m[0][qt];
#pragma unroll
            for (int jj = 0; jj < 4; ++jj) sn[kt][qt][jj] = __builtin_amdgcn_exp2f(sn[kt][qt][jj] * sc2 - mn);
        } else if (k <= 7 * QT) {
            const int qt = (k - 5 * QT - 1) >> 1, kk = (k - 5 * QT - 1) & 1;
            pfn[qt][kk].u[0] = pack2(sn[2 * kk][qt][0], sn[2 * kk][qt][1]); pfn[qt][kk].u[1] = pack2(sn[2 * kk][qt][2], sn[2 * kk][qt][3]);
            pfn[qt][kk].u[2] = pack2(sn[2 * kk + 1][qt][0], sn[2 * kk + 1][qt][1]); pfn[qt][kk].u[3] = pack2(sn[2 * kk + 1][qt][2], sn[2 * kk + 1][qt][3]);
#ifndef CPU_EMU
            asm volatile("" : "+v"(pfn[qt][kk].u[0]), "+v"(pfn[qt][kk].u[1]), "+v"(pfn[qt][kk].u[2]), "+v"(pfn[qt][kk].u[3]));
#endif
        }
    };
    constexpr int NSM = 7 * QT + 1;
    auto rescale = [&]() {
        if (resc) {
#pragma unroll
            for (int qt = 0; qt < QT; ++qt) {
#pragma unroll
                for (int et = 0; et < DV / 16; ++et) { st.O[0][et][qt][0] *= al[qt]; st.O[0][et][qt][1] *= al[qt]; st.O[0][et][qt][2] *= al[qt]; st.O[0][et][qt][3] *= al[qt]; }
                st.L[0][qt][0] *= al[qt]; st.L[0][qt][1] *= al[qt]; st.L[0][qt][2] *= al[qt]; st.L[0][qt][3] *= al[qt];
                al[qt] = 1.f;
            }
            resc = false;
        }
    };
    auto pv = [&](int buf, const Frag (&pf)[QT][2]) {
        const bf16_t* Vs = sm + 2 * KBUF + buf * VBUF;
#pragma unroll
        for (int kk = 0; kk < 2; ++kk)
#pragma unroll
            for (int qt = 0; qt < QT; ++qt) st.L[0][qt] = mfma16(ones.v, pf[qt][kk].v, st.L[0][qt]);
#pragma unroll
        for (int et = 0; et < DV / 16; ++et) {
#pragma unroll
            for (int kk = 0; kk < 2; ++kk) {
                Frag vf; vf.q = *(const u32x4*)(Vs + et * 16 * VLD + (kk ? vfo1 : vfo0));
#pragma unroll
                for (int qt = 0; qt < QT; ++qt) st.O[0][et][qt] = mfma16(vf.v, pf[qt][kk].v, st.O[0][et][qt]);
            }
        } };
    Frag pfa[QT][2], pfb[QT][2];
    loadK();
    __syncthreads();
    storeK(0);
    loadK();
    loadV();
    __syncthreads();
    {
        f32x4 s0[4][QT];
        const bf16_t* Ks = sm;
#pragma unroll
        for (int kt = 0; kt < 4; ++kt) {
            Frag ka0, ka1;
            ka0.q = *(const u32x4*)(Ks + kt * 16 * KLD + kfo0);
            ka1.q = *(const u32x4*)(Ks + kt * 16 * KLD + kfo1);
#pragma unroll
            for (int qt = 0; qt < QT; ++qt) {
                f32x4 z = f32x4{0.f, 0.f, 0.f, 0.f};
                z = mfma16(ka0.v, qf[0][0][qt].v, z); z = mfma16(ka1.v, qf[0][1][qt].v, z); s0[kt][qt] = z;
            }
        }
#pragma unroll
        for (int k = 0; k < NSM; ++k) sm_step(k, s0, pfa, true);
    }
    storeK(1);
    storeV(0);
    __syncthreads();
    auto body = [&](const int par, const Frag (&pin)[QT][2], Frag (&pout)[QT][2]) {
        f32x4 sn[4][QT];
        constexpr int NPV = (DV / 16) * 2; constexpr int SPP = (NSM + NPV - 1) / NPV;
        constexpr int VPD = 2;
        const bf16_t* Ks = sm + ((par + 1) & 1) * KBUF; const bf16_t* Vs = sm + 2 * KBUF + (par & 1) * VBUF;
        Frag ka[2][2], vf[VPD + 1];
        ka[0][0].q = *(const u32x4*)(Ks + kfo0); ka[0][1].q = *(const u32x4*)(Ks + kfo1);
#pragma unroll
        for (int i = 0; i < VPD; ++i) vf[i].q = *(const u32x4*)(Vs + (i >> 1) * 16 * VLD + ((i & 1) ? vfo1 : vfo0));
        rescale();
#pragma unroll
        for (int kk = 0; kk < 2; ++kk)
#pragma unroll
            for (int qt = 0; qt < QT; ++qt) st.L[0][qt] = mfma16(ones.v, pin[qt][kk].v, st.L[0][qt]);
        SCHED_BARRIER();
#pragma unroll
        for (int kt = 0; kt < 4; ++kt) {
            if (kt < 3) { ka[(kt + 1) & 1][0].q = *(const u32x4*)(Ks + (kt + 1) * 16 * KLD + kfo0); ka[(kt + 1) & 1][1].q = *(const u32x4*)(Ks + (kt + 1) * 16 * KLD + kfo1); }
#pragma unroll
            for (int qt = 0; qt < QT; ++qt) {
                f32x4 z = f32x4{0.f, 0.f, 0.f, 0.f};
                z = mfma16(ka[kt & 1][0].v, qf[0][0][qt].v, z);
                z = mfma16(ka[kt & 1][1].v, qf[0][1][qt].v, z); sn[kt][qt] = z;
            }
            SCHED_BARRIER();
        }
#pragma unroll
        for (int i = 0; i < NPV; ++i) {
            const int et = i >> 1, kk = i & 1;
            if (i + VPD < NPV) vf[(i + VPD) % (VPD + 1)].q = *(const u32x4*)(Vs + ((i + VPD) >> 1) * 16 * VLD + (((i + VPD) & 1) ? vfo1 : vfo0));
#pragma unroll
            for (int qt = 0; qt < QT; ++qt) st.O[0][et][qt] = mfma16(vf[i % (VPD + 1)].v, pin[qt][kk].v, st.O[0][et][qt]);
#pragma unroll
            for (int q = 0; q < SPP; ++q) sm_step(i * SPP + q, sn, pout, false);
            SCHED_BARRIER();
        }
    };
    int j = 0;
    for (; j + 2 < nt; j += 2) {
        loadK(); loadV();
        body(0, pfa, pfb);
        storeK(0); storeV(1);
        __syncthreads();
        loadK(); loadV();
        body(1, pfb, pfa);
        storeK(1); storeV(0);
        __syncthreads();
    }
    loadV(); body(0, pfa, pfb); storeV(1); __syncthreads();
    rescale();
    pv(1, pfb);
    __syncthreads();
}

DEV void attn_diff_item(const Params& p, int layer, int item, bf16_t* sm) {
    const int nqb = TT / 64; const int qb = item % nqb, h = (item / nqb) % HA, b = item / (nqb * HA);
    const int tid = tid_(), wid = tid >> 6, lane = tid & 63, r = lane & 15, quad = lane >> 4;
    const int comp = wid & 1, rg = wid >> 1;
    const int s0 = qb * 64; const bool ctxq = s0 < CTX; const int nkeys = ctxq ? CTX : TT;
    Frag qf[1][2][2];
#pragma unroll
    for (int ks = 0; ks < 2; ++ks)
#pragma unroll
        for (int qt = 0; qt < 2; ++qt) qf[0][ks][qt].q = *(const u32x4*)(p.Q1 + ((size_t)b * TT + s0 + rg * 32 + qt * 16 + r) * 512 + h * 128 + comp * 64 + ks * 32 + quad * 8);
    AttnState<1, 128, 2> st;
#pragma unroll
    for (int qt = 0; qt < 2; ++qt) {
        st.m[0][qt] = -1.0e30f; st.L[0][qt] = f32x4{0.f, 0.f, 0.f, 0.f};
#pragma unroll
        for (int et = 0; et < 8; ++et) st.O[0][et][qt] = f32x4{0.f, 0.f, 0.f, 0.f};
    }
    attn_core<1, 128, 2, 128>(sm, p.K1 + (size_t)b * TT * 512 + h * 128, 512, p.V1T + ((size_t)(b * HA + h) * 128) * TT, nkeys, qf, st, 0.125f * 1.4426950408889634f, comp * 64);
    const float lam = p.LAM[layer >> 1]; const float lam_init = 0.8f - 0.6f * expf(-0.3f * (float)layer);
    const float* sg = p.ev_subln_g + (layer >> 1) * 128;
    f32x4* xo = (f32x4*)sm;
    __syncthreads();
    if (comp == 1) {
#pragma unroll
        for (int qt = 0; qt < 2; ++qt) {
            const float i2 = lam / st.L[0][qt][0];
#pragma unroll
            for (int et = 0; et < 8; ++et) xo[((rg * 2 + qt) * 8 + et) * 64 + lane] = f32x4{st.O[0][et][qt][0] * i2, st.O[0][et][qt][1] * i2, st.O[0][et][qt][2] * i2, st.O[0][et][qt][3] * i2};
        }
    }
    __syncthreads();
    if (comp == 0) {
#pragma unroll
        for (int qt = 0; qt < 2; ++qt) {
            const float i1 = 1.f / st.L[0][qt][0];
            float ss = 0.f; f32x4 o[8];
#pragma unroll
            for (int et = 0; et < 8; ++et) {
                const f32x4 x2 = xo[((rg * 2 + qt) * 8 + et) * 64 + lane];
#pragma unroll
                for (int j = 0; j < 4; ++j) { float v = st.O[0][et][qt][j] * i1 - x2[j]; o[et][j] = v; ss += v * v; }
            }
            ss = xadd16(ss); ss = xadd32(ss);
            const float rs = (1.f - lam_init) / sqrtf(ss * (1.f / 128.f) + EPS);
            bf16_t* dst = p.CAT + ((size_t)b * TT + s0 + rg * 32 + qt * 16 + r) * 1024 + h * 128;
#pragma unroll
            for (int et = 0; et < 8; ++et) {
                const int e = et * 16 + quad * 4;
                u32x2 w; w.x = pack2(o[et][0] * rs * sg[e], o[et][1] * rs * sg[e + 1]); w.y = pack2(o[et][2] * rs * sg[e + 2], o[et][3] * rs * sg[e + 3]);
                *(u32x2*)(dst + e) = w;
            }
        }
    }
}

DEV void attn_gqa_item(const Params& p, int item, bf16_t* sm) {
    const int nqb = TT / 32; const int qb = item % nqb, kv = (item / nqb) % HKV, b = item / (nqb * HKV);
    const int tid = tid_(), wid = tid >> 6, lane = tid & 63, r = lane & 15, quad = lane >> 4;
    const int s0 = qb * 32; const bool ctxq = s0 < CTX; const int nkeys = ctxq ? CTX : TT; const int hq = kv * 4 + wid;
    Frag qf[1][2][2];
#pragma unroll
    for (int ks = 0; ks < 2; ++ks)
#pragma unroll
        for (int qt = 0; qt < 2; ++qt) qf[0][ks][qt].q = *(const u32x4*)(p.Q1 + ((size_t)b * TT + s0 + qt * 16 + r) * 512 + hq * 64 + ks * 32 + quad * 8);
    AttnState<1, 64, 2> st;
#pragma unroll
    for (int qt = 0; qt < 2; ++qt) {
        st.m[0][qt] = -1.0e30f; st.L[0][qt] = f32x4{0.f, 0.f, 0.f, 0.f};
#pragma unroll
        for (int et = 0; et < 4; ++et) st.O[0][et][qt] = f32x4{0.f, 0.f, 0.f, 0.f};
    }
    attn_core<1, 64, 2, 64>(sm, p.K1 + (size_t)b * TT * 128 + kv * 64, 128, p.V1T + ((size_t)(b * HKV + kv) * 64) * TT, nkeys, qf, st, 0.125f * 1.4426950408889634f, 0);
#pragma unroll
    for (int qt = 0; qt < 2; ++qt) {
        const float il = 1.f / st.L[0][qt][0];
        bf16_t* dst = p.CAT + ((size_t)b * TT + s0 + qt * 16 + r) * 1024 + 512 + hq * 64;
#pragma unroll
        for (int et = 0; et < 4; ++et) {
            const int e = et * 16 + quad * 4;
            u32x2 w; w.x = pack2(st.O[0][et][qt][0] * il, st.O[0][et][qt][1] * il); w.y = pack2(st.O[0][et][qt][2] * il, st.O[0][et][qt][3] * il);
            *(u32x2*)(dst + e) = w;
        }
    }
}

template <int DK, bool NRM>
DEV void rec_dc_item(const Params& p, int item, bf16_t* sm) {
    constexpr int ET = NRM ? 9 : 8; constexpr int ER = NRM ? EVR : 128; constexpr int SLD = 136;
    const int chain = item / NCH, sp = item % NCH; const int dir = chain & 1, h = (chain >> 1) & 3, b = chain >> 3;
    const int u = chunk_of(dir, sp), sbase = u * CH;
    const int tid = tid_(), wid = tid >> 6, lane = tid & 63, r = lane & 15, quad = lane >> 4;
    bf16_t* Vs = sm; bf16_t* Ks = sm + 128 * SLD; float* wk = (float*)(sm + 128 * SLD + DK * SLD);
    __syncthreads();
    const float* ms = p.MS + ((size_t)chain * NCH + sp) * 4;
    if (tid < 128) wk[tid] = __expf(ms[2] + p.AT[(size_t)chain * TT + sbase + tid] - ms[1]);
    const bf16_t* vt = p.V2T + ((size_t)(b * 4 + h) * 128) * TT + sbase;
    for (int c = tid; c < 128 * 16; c += 256) { int row = c >> 4, kc = c & 15; *(u32x4*)(Vs + row * SLD + kc * 8) = *(const u32x4*)(vt + (size_t)row * TT + kc * 8); }
    __syncthreads();
    const bf16_t* kg = p.K2 + ((size_t)b * TT + sbase) * (4 * DK) + h * DK;
    for (int c = tid; c < 128 * (DK / 8); c += 256) {
        const int sl = c & 127, dc8 = (c >> 7) * 8; Frag f; f.q = *(const u32x4*)(kg + (size_t)sl * (4 * DK) + dc8);
        const float w = wk[sl];
#pragma unroll
        for (int i = 0; i < 8; ++i) Ks[(dc8 + i) * SLD + sl] = f2bf(bf2f((bf16_t)f.v[i]) * w);
    }
    __syncthreads();
    constexpr int NTW = DK / 64;
    f32x4 acc[ET][NTW];
#pragma unroll
    for (int et = 0; et < ET; ++et)
#pragma unroll
        for (int n = 0; n < NTW; ++n) acc[et][n] = f32x4{0.f, 0.f, 0.f, 0.f};
#pragma unroll
    for (int ks = 0; ks < 4; ++ks) {
        Frag bf[NTW];
#pragma unroll
        for (int n = 0; n < NTW; ++n) bf[n].q = *(const u32x4*)(Ks + ((wid + 4 * n) * 16 + r) * SLD + ks * 32 + quad * 8);
#pragma unroll
        for (int et = 0; et < ET; ++et) {
            Frag af;
            if (et < 8) af.q = *(const u32x4*)(Vs + (et * 16 + r) * SLD + ks * 32 + quad * 8);
            else { const unsigned one = (r == 0) ? 0x3F803F80u : 0u; af.q = u32x4{one, one, one, one}; }
#pragma unroll
            for (int n = 0; n < NTW; ++n) acc[et][n] = mfma16(af.v, bf[n].v, acc[et][n]);
        }
    }
    bf16_t* dc = p.DC + ((size_t)chain * NCH + sp) * ER * DK;
#pragma unroll
    for (int et = 0; et < ET; ++et)
#pragma unroll
        for (int n = 0; n < NTW; ++n)
#pragma unroll
            for (int j = 0; j < 4; ++j) dc[(size_t)(et * 16 + quad * 4 + j) * DK + (wid + 4 * n) * 16 + r] = f2bf(acc[et][n][j]);
}

template <int DK, bool NRM>
DEV void rec_scan(const Params& p) {
    constexpr int ER = NRM ? EVR : 128;
    const int total = NCHAIN * ER * DK;
    for (int idx = bid_() * 256 + tid_(); idx < total; idx += gridDim.x * 256) {
        const int chain = idx / (ER * DK), el = idx % (ER * DK);
        float c = 0.f;
        for (int sp = 0; sp < NCH; ++sp) {
            const size_t o = ((size_t)chain * NCH + sp) * ER * DK + el;
            p.CP[o] = f2bf(c);
            c = p.MS[((size_t)chain * NCH + sp) * 4 + 3] * c + bf2f(p.DC[o]);
        }
    }
}

template <int DK, bool NRM>
DEV void rec_out_item(const Params& p, int layer, int item, bf16_t* sm) {
    constexpr int ET = NRM ? 9 : 8; constexpr int ER = NRM ? EVR : 128; constexpr int KLD = DK + 8; constexpr int SLD = 136; constexpr int NKS = DK / 32;
    const int half = item & 1, u = (item >> 1) % NCH, h = ((item >> 1) / NCH) & 3, b = (item >> 1) / (NCH * 4);
    const int tid = tid_(), wid = tid >> 6, lane = tid & 63, r = lane & 15, quad = lane >> 4;
    const int sbase = u * CH; const int tl = half * 64 + wid * 16 + r;
    const size_t rowt = (size_t)b * TT + sbase + tl; const int tq = tl - quad * 4;
    bf16_t* RA = sm; bf16_t* Vs = sm + ER * KLD; float* as_ = (float*)(Vs + 128 * SLD);
    __syncthreads();
    const bf16_t* kg = p.K2 + ((size_t)b * TT + sbase) * (4 * DK) + h * DK;
    for (int c = tid; c < 128 * (DK / 8); c += 256) { int row = c / (DK / 8), kc = c % (DK / 8); *(u32x4*)(RA + row * KLD + kc * 8) = *(const u32x4*)(kg + (size_t)row * (4 * DK) + kc * 8); }
    const int chain0 = (b * 4 + h) * 2;
    as_[tid] = p.AT[(size_t)(chain0 + (tid >> 7)) * TT + sbase + (tid & 127)];
    Frag qf[NKS];
#pragma unroll
    for (int ks = 0; ks < NKS; ++ks) qf[ks].q = *(const u32x4*)(p.Q2 + rowt * (4 * DK) + h * DK + ks * 32 + quad * 8);
    __syncthreads();
    f32x4 sT[8];
#pragma unroll
    for (int st = 0; st < 8; ++st) {
        if ((st & 1) == 0) SCHED_BARRIER();
        f32x4 z = f32x4{0.f, 0.f, 0.f, 0.f};
#pragma unroll
        for (int ks = 0; ks < NKS; ++ks) { Frag ka; ka.q = *(const u32x4*)(RA + (st * 16 + r) * KLD + ks * 32 + quad * 8); z = mfma16(ka.v, qf[ks].v, z); }
        sT[st] = z;
    }
    __syncthreads();
    const bf16_t* vt = p.V2T + ((size_t)(b * 4 + h) * 128) * TT + sbase;
    for (int c = tid; c < 128 * 16; c += 256) { int row = c >> 4, kc = c & 15; *(u32x4*)(Vs + row * SLD + kc * 8) = *(const u32x4*)(vt + (size_t)row * TT + kc * 8); }
    f32x4 hs[8];
#pragma unroll
    for (int et = 0; et < 8; ++et) hs[et] = f32x4{0.f, 0.f, 0.f, 0.f};
#pragma unroll 1
    for (int dir = 0; dir < 2; ++dir) {
        const int chain = chain0 + dir; const int sp = sp_of(dir, u);
        if (dir) __syncthreads();
        const bf16_t* cp = p.CP + ((size_t)chain * NCH + sp) * ER * DK;
        for (int c = tid; c < ER * (DK / 8); c += 256) { int row = c / (DK / 8), kc = c % (DK / 8); *(u32x4*)(RA + row * KLD + kc * 8) = *(const u32x4*)(cp + (size_t)row * DK + kc * 8); }
        __syncthreads();
        const float bt = p.BC[(size_t)chain * TT + sbase + tl], mt = p.MT[(size_t)chain * TT + sbase + tl];
        const float mprev = p.MS[((size_t)chain * NCH + sp) * 4];
        const float winter = __expf(bt + mprev - mt); const float ct = bt - mt;
        f32x4 acc[ET];
#pragma unroll
        for (int et = 0; et < ET; ++et) {
            if ((et & 1) == 0) SCHED_BARRIER();
            f32x4 z = f32x4{0.f, 0.f, 0.f, 0.f};
#pragma unroll
            for (int ks = 0; ks < NKS; ++ks) { Frag ca; ca.q = *(const u32x4*)(RA + (et * 16 + r) * KLD + ks * 32 + quad * 8); z = mfma16(ca.v, qf[ks].v, z); }
            acc[et] = f32x4{z[0] * winter, z[1] * winter, z[2] * winter, z[3] * winter};
        }
#pragma unroll
        for (int kk = 0; kk < 4; ++kk) {
            SCHED_BARRIER();
            Frag pf;
#pragma unroll
            for (int hf = 0; hf < 2; ++hf) {
                const int st = 2 * kk + hf; float w[4];
#pragma unroll
                for (int j = 0; j < 4; ++j) {
                    const int s = st * 16 + quad * 4 + j; const bool ok = dir ? ((st * 16 + j) >= tq) : ((st * 16 + j) <= tq);
                    w[j] = ok ? sT[st][j] * __expf(ct + as_[dir * 128 + s]) : 0.f;
                }
                pf.u[2 * hf] = pack2(w[0], w[1]); pf.u[2 * hf + 1] = pack2(w[2], w[3]);
            }
#pragma unroll
            for (int et = 0; et < ET; ++et) {
                Frag vf;
                if (et < 8) { const bf16_t* vp = Vs + (et * 16 + r) * SLD + kk * 32 + quad * 4; vf.d[0] = *(const u32x2*)vp; vf.d[1] = *(const u32x2*)(vp + 16); }
                else { const unsigned one = (r == 0) ? 0x3F803F80u : 0u; vf.q = u32x4{one, one, one, one}; }
                acc[et] = mfma16(vf.v, pf.v, acc[et]);
            }
        }
        if (NRM) {
            float den = lane_read(acc[ET - 1][0], r, lane);
            const float dn = 1.f / fmaxf(fabsf(den), __expf(-mt));
#pragma unroll
            for (int et = 0; et < 8; ++et) { hs[et][0] += acc[et][0] * dn; hs[et][1] += acc[et][1] * dn; hs[et][2] += acc[et][2] * dn; hs[et][3] += acc[et][3] * dn; }
        } else {
#pragma unroll
            for (int et = 0; et < 8; ++et) { hs[et][0] += acc[et][0]; hs[et][1] += acc[et][1]; hs[et][2] += acc[et][2]; hs[et][3] += acc[et][3]; }
        }
    }
    if (NRM) {
        const bf16_t* og = p.OG + rowt * 512 + h * 128; const float* g = p.ev_mnorm_g + (layer >> 1) * 512 + h * 128;
        float sum = 0.f;
#pragma unroll
        for (int et = 0; et < 8; ++et) {
            const u32x2 gq = *(const u32x2*)(og + et * 16 + quad * 4);
            hs[et][0] *= sigmf(bf2f((bf16_t)(gq.x & 0xFFFF))); hs[et][1] *= sigmf(bf2f((bf16_t)(gq.x >> 16)));
            hs[et][2] *= sigmf(bf2f((bf16_t)(gq.y & 0xFFFF))); hs[et][3] *= sigmf(bf2f((bf16_t)(gq.y >> 16)));
            sum += hs[et][0] + hs[et][1] + hs[et][2] + hs[et][3];
        }
        sum = xadd16(sum); sum = xadd32(sum);
        const float mu = sum * (1.f / 128.f); float var = 0.f;
#pragma unroll
        for (int et = 0; et < 8; ++et)
#pragma unroll
            for (int j = 0; j < 4; ++j) { float d = hs[et][j] - mu; var += d * d; }
        var = xadd16(var); var = xadd32(var);
        const float rs = 1.f / sqrtf(var * (1.f / 128.f) + EPS);
        bf16_t* dst = p.CAT + rowt * 1024 + 512 + h * 128;
#pragma unroll
        for (int et = 0; et < 8; ++et) {
            const int e = et * 16 + quad * 4;
            u32x2 w; w.x = pack2((hs[et][0] - mu) * rs * g[e], (hs[et][1] - mu) * rs * g[e + 1]); w.y = pack2((hs[et][2] - mu) * rs * g[e + 2], (hs[et][3] - mu) * rs * g[e + 3]);
            *(u32x2*)(dst + e) = w;
        }
    } else {
        const bf16_t* og = p.OG + rowt * 512 + h * 128;
        float ss = 0.f;
#pragma unroll
        for (int et = 0; et < 8; ++et)
#pragma unroll
            for (int j = 0; j < 4; ++j) ss += hs[et][j] * hs[et][j];
        ss = xadd16(ss); ss = xadd32(ss);
        const float rs = 1.f / sqrtf(ss * (1.f / 128.f) + EPS);
        bf16_t* dst = p.CAT + rowt * 1024 + h * 128;
#pragma unroll
        for (int et = 0; et < 8; ++et) {
            const int e = et * 16 + quad * 4; const u32x2 gq = *(const u32x2*)(og + e);
            u32x2 w; w.x = pack2(hs[et][0] * rs * siluf(bf2f((bf16_t)(gq.x & 0xFFFF))), hs[et][1] * rs * siluf(bf2f((bf16_t)(gq.x >> 16))));
            w.y = pack2(hs[et][2] * rs * siluf(bf2f((bf16_t)(gq.y & 0xFFFF))), hs[et][3] * rs * siluf(bf2f((bf16_t)(gq.y >> 16))));
            *(u32x2*)(dst + e) = w;
        }
    }
}

DEV void phaseC(const Params& p, int layer, unsigned char* smem) {
    const bool odd = layer & 1; const bool with_ctx = layer < DEPTH - 1;
    bf16_t* sm = (bf16_t*)smem;
    const int nqb_l = odd ? SEQ / 32 : SEQ / 64, nqb_c = odd ? CTX / 32 : CTX / 64; const int nh = odd ? HKV : HA;
    const int n_lat = BATCH * nh * nqb_l, n_ctx = with_ctx ? BATCH * nh * nqb_c : 0; const int n_dc = NCHAIN * NCH;
    for (int it = bid_(); it < n_lat + n_ctx + n_dc; it += gridDim.x) {
        if (it < n_lat + n_ctx) {
            int qb, bh;
            if (it < n_lat) {
                const int nbh = BATCH * nh;
                if ((nbh & 7) == 0 && (gridDim.x & 7) == 0) { const int x = it & 7, j = it >> 3; bh = (j / nqb_l) * 8 + x; qb = nqb_c + j % nqb_l; }
                else { qb = nqb_c + it % nqb_l; bh = it / nqb_l; }
            } else { int i2 = it - n_lat; qb = i2 % nqb_c; bh = i2 / nqb_c; }
            const int item = bh * (nqb_l + nqb_c) + qb;
            if (odd) attn_gqa_item(p, item, sm); else attn_diff_item(p, layer, item, sm);
        } else {
            const int item = it - n_lat - n_ctx;
            if (odd) rec_dc_item<64, false>(p, item, sm); else rec_dc_item<128, true>(p, item, sm);
        }
    }
}
DEV void phaseD(const Params& p, int layer) { if (layer & 1) rec_scan<64, false>(p); else rec_scan<128, true>(p); }
DEV void phaseE(const Params& p, int layer, unsigned char* smem) {
    const bool odd = layer & 1; const bool with_ctx = layer < DEPTH - 1;
    const int n = BATCH * 4 * NCH * 2;
    for (int it = bid_(); it < n; it += gridDim.x) {
        const int u = (it >> 1) % NCH; if (!with_ctx && u < NCC) continue;
        if (odd) rec_out_item<64, false>(p, layer, it, (bf16_t*)smem); else rec_out_item<128, true>(p, layer, it, (bf16_t*)smem);
    }
}

struct EpOut {
    const Params& p; const float* gate; int row0, col0;
    DEV void nat(f32x4 (&acc)[4][4], int wr, int wc, int lane) {
        const int r = lane & 15, quad = lane >> 4;
#pragma unroll
        for (int n = 0; n < 4; ++n) {
            const int col = col0 + wc * 64 + n * 16 + quad * 4; const f32x4 g = *(const f32x4*)(gate + col);
#pragma unroll
            for (int m = 0; m < 4; ++m) { f32x4* x = (f32x4*)(p.X + (size_t)(row0 + wr * 64 + m * 16 + r) * D_MODEL + col); *x = ALPHA * (*x) + g * acc[m][n]; }
        }
    }
    DEV void operator()(f32x4 (&acc)[4][4], int wr, int wc, int lane) {
        const int r = lane & 15, quad = lane >> 4;
#pragma unroll
        for (int n = 0; n < 4; ++n) {
            const int col = col0 + wc * 64 + n * 16 + r; const float g = gate[col];
#pragma unroll
            for (int m = 0; m < 4; ++m)
#pragma unroll
                for (int j = 0; j < 4; ++j) { float* x = p.X + (size_t)(row0 + wr * 64 + m * 16 + quad * 4 + j) * D_MODEL + col; *x = ALPHA * (*x) + g * acc[m][n][j]; }
        }
    }
};
#ifdef CPU_EMU_SMALL
constexpr int FM_T = 16;
#else
constexpr int FM_T = 17;
#endif
constexpr int F_ROWS = 16 * FM_T, F_NA = 4 * F_ROWS, F_NCH = F_NA + 512, F_STAGE = F_NCH * 16, F_NJ = (F_NCH + 255) / 256;
static_assert(NTOK % F_ROWS == 0 && TT % F_ROWS == 0, "tall output-projection tiles must not straddle sequences");
static_assert(3 * F_STAGE <= LDS_BYTES - 16, "LDS ring of the tall tile");
DEV void phaseF(const Params& p, int layer, unsigned char* smem) {
    const bool with_ctx = layer < DEPTH - 1; const int ncol = D_MODEL / 128, nrow = NTOK / F_ROWS;
    const int tid = tid_(), wid = tid >> 6, lane = tid & 63, r = lane & 15, quad = lane >> 4;
    const int lc8 = g2_lc(tid) * 8;
    const WorkRange wr = xcd_range(nrow * ncol, bid_());
    for (int t = wr.lo; t < wr.hi; t += wr.step) {
        int rt, ct;
        if ((nrow & 7) == 0) { const int rpg = nrow >> 3; const int rg = t / (ncol * rpg), q = t % (ncol * rpg); ct = q / rpg; rt = rg * rpg + q % rpg; } else { rt = t / ncol; ct = t % ncol; }
        const int row0 = rt * F_ROWS, col0 = ct * 128; const int b = row0 / TT, s0 = row0 % TT;
        if (!with_ctx && s0 + F_ROWS <= CTX) continue;
        const bf16_t* abase = p.CAT + (size_t)(row0 + (tid >> 2)) * MIX_OUT + lc8;
        const bf16_t* bbase = p.WoutT + ((size_t)layer * D_MODEL + col0 + (tid >> 2)) * MIX_OUT + lc8;
        constexpr int JMIX = F_NA / 256;
        const bf16_t* mbase = (F_NA % 256 != 0 && tid < F_NA - 256 * JMIX) ? abase + (size_t)JMIX * 64 * MIX_OUT : bbase + (256 * JMIX - F_NA) / 4 * MIX_OUT;
        f32x4 acc[FM_T][2];
#pragma unroll
        for (int m = 0; m < FM_T; ++m) { acc[m][0] = f32x4{0.f, 0.f, 0.f, 0.f}; acc[m][1] = f32x4{0.f, 0.f, 0.f, 0.f}; }
        unsigned char* dst0 = smem + tid * 16;
        auto issue = [&](int kt, int slot) {
            unsigned char* d = dst0 + slot * F_STAGE;
#pragma unroll
            for (int j = 0; j < F_NJ; ++j) {
                if (256 * j + 255 < F_NA) glds16(abase + (size_t)j * 64 * MIX_OUT + kt * 32, d + j * 4096);
                else if (j == JMIX && F_NA % 256 != 0) glds16(mbase + kt * 32, d + j * 4096);
                else if (256 * j + 255 < F_NCH) glds16(bbase + (256 * j - F_NA) / 4 * MIX_OUT + kt * 32, d + j * 4096);
                else if (tid + 256 * j < F_NCH) glds16(bbase + (256 * j - F_NA) / 4 * MIX_OUT + kt * 32, d + j * 4096);
            }
        };
        constexpr int nkt = MIX_OUT / 32;
        RAW_BARRIER();
        issue(0, 0); issue(1, 1);
        const int pco = (quad ^ g2_h((r >> 2) & 3)) * 16;
        const unsigned char* afr = smem + r * 64 + pco;
        const unsigned char* bfr = smem + F_NA * 16 + (wid * 32 + r) * 64 + pco;
        int slot = 0;
        for (int kt = 0; kt < nkt; ++kt) {
            if (kt + 1 < nkt) wait_vm<6>(); else wait_vm<0>();
            RAW_BARRIER();
            if (kt + 2 < nkt) { int ns = slot + 2; if (ns >= 3) ns -= 3; issue(kt + 2, ns); }
            const unsigned char* as = afr + slot * F_STAGE; const unsigned char* bs = bfr + slot * F_STAGE;
            Frag b0, b1; b0.q = *(const u32x4*)bs; b1.q = *(const u32x4*)(bs + 16 * 64);
#ifndef CPU_EMU
            __builtin_amdgcn_s_setprio(1);
#endif
#pragma unroll
            for (int m = 0; m < FM_T; ++m) {
                Frag af; af.q = *(const u32x4*)(as + m * 16 * 64);
                acc[m][0] = mfma16(b0.v, af.v, acc[m][0]); acc[m][1] = mfma16(b1.v, af.v, acc[m][1]);
            }
#ifndef CPU_EMU
            __builtin_amdgcn_s_setprio(0);
#endif
            if (++slot == 3) slot = 0;
        }
        const float* gl = p.MOD + ((size_t)layer * (BATCH + 1) + b) * 6 * D_MODEL + 2 * D_MODEL; const float* gc = p.MOD + ((size_t)layer * (BATCH + 1) + BATCH) * 6 * D_MODEL + 2 * D_MODEL;
#pragma unroll
        for (int n = 0; n < 2; ++n) {
            const int col = col0 + wid * 32 + n * 16 + quad * 4; const f32x4 g_l = *(const f32x4*)(gl + col), g_c = *(const f32x4*)(gc + col);
#pragma unroll
            for (int m = 0; m < FM_T; ++m) {
                const int s = s0 + m * 16 + r; const bool isc = s < CTX;
                if (with_ctx || !isc) { f32x4* x = (f32x4*)(p.X + (size_t)(row0 + m * 16 + r) * D_MODEL + col); *x = ALPHA * (*x) + (isc ? g_c : g_l) * acc[m][n]; }
                if ((m & 3) == 3) SCHED_BARRIER();
            }
        }
    }
}

constexpr int NV4 = D_MODEL / 256;
DEV void phaseG(const Params& p, int layer, unsigned char* smem) {
    const bool with_ctx = layer < DEPTH - 1;
    const int tid = tid_(); const int wid = tid >> 6, lane = tid & 63; const int bid = bid_();
    const float* lg = p.ln_g + (size_t)(layer * 2) * D_MODEL; const float* lb = p.ln_b + (size_t)(layer * 2) * D_MODEL;
    const float* wr = p.WrT + (size_t)layer * NR * D_MODEL;
    int* lcnt = (int*)smem; int* lbase = lcnt + 32; int* rec = lbase + 32;
    const int half = gridDim.x * 4, stride = half * 2;
    const int nit = (NTOK - bid * 4 + stride - 1) / stride;
    __syncthreads();
    if (tid < 32) lcnt[tid] = 0;
    for (int i = tid; i < nit * 8; i += 256) rec[i * 8] = -1;
    __syncthreads();
    int tok0 = bid * 4 + wid;
    for (int it = 0; tok0 < NTOK; tok0 += stride, ++it) {
        f32x4 v[2][NV4]; int tk[2]; bool ok[2]; const float* mod[2];
#pragma unroll
        for (int u = 0; u < 2; ++u) {
            const int tl = imin(tok0 + u * half, NTOK - 1);
#pragma unroll
            for (int i = 0; i < NV4; ++i) v[u][i] = *(const f32x4*)(p.X + (size_t)tl * D_MODEL + (i * 64 + lane) * 4);
            const int t = tok0 + u * half; const int tc = imin(t, NTOK - 1); const int b = tc / TT, sq = tc % TT;
            tk[u] = tc; ok[u] = (t < NTOK) && (with_ctx || sq >= CTX);
            mod[u] = p.MOD + ((size_t)layer * (BATCH + 1) + (sq < CTX ? BATCH : b)) * 6 * D_MODEL;
        }
        float mu[2], rs[2];
#pragma unroll
        for (int u = 0; u < 2; ++u) { float sum = 0.f;
#pragma unroll
            for (int i = 0; i < NV4; ++i) sum += v[u][i].x + v[u][i].y + v[u][i].z + v[u][i].w;
            mu[u] = sum; }
        { mu[0] = wsum(mu[0]); mu[1] = wsum(mu[1]); }
#pragma unroll
        for (int u = 0; u < 2; ++u) { mu[u] *= (1.f / D_MODEL); float var = 0.f;
#pragma unroll
            for (int i = 0; i < NV4; ++i) { float a = v[u][i].x - mu[u], bq = v[u][i].y - mu[u], c = v[u][i].z - mu[u], d = v[u][i].w - mu[u]; var += a * a + bq * bq + c * c + d * d; }
            rs[u] = var; }
        { rs[0] = wsum(rs[0]); rs[1] = wsum(rs[1]); }
        f32x4 hv[2][NV4];
#pragma unroll
        for (int u = 0; u < 2; ++u) {
            rs[u] = 1.f / sqrtf(rs[u] * (1.f / D_MODEL) + EPS);
            if (lane == 0 && ok[u]) { p.STAT[tk[u] * 2] = mu[u]; p.STAT[tk[u] * 2 + 1] = rs[u]; }
#pragma unroll
            for (int i = 0; i < NV4; ++i) {
                const int k = (i * 64 + lane) * 4;
                const f32x4 g4 = *(const f32x4*)(lg + k), b4 = *(const f32x4*)(lb + k), sh = *(const f32x4*)(mod[u] + 3 * D_MODEL + k), sc = *(const f32x4*)(mod[u] + 4 * D_MODEL + k);
                const f32x4 x1 = (v[u][i] - mu[u]) * rs[u] * g4 + b4;
                hv[u][i] = x1 * (1.f + sc) + sh;
                if (ok[u]) { u32x2 o; o.x = pack2(hv[u][i].x, hv[u][i].y); o.y = pack2(hv[u][i].z, hv[u][i].w); *(u32x2*)(p.H + (size_t)tk[u] * D_MODEL + k) = o; }
            }
        }
        float gl[2][NG];
#pragma unroll
        for (int j = 0; j < NG; ++j) {
#pragma unroll
            for (int u = 0; u < 2; ++u) { float a = 0.f;
#pragma unroll
                for (int i = 0; i < NV4; ++i) { const f32x4 w4 = *(const f32x4*)(wr + (size_t)j * D_MODEL + (i * 64 + lane) * 4); a += hv[u][i].x * w4.x + hv[u][i].y * w4.y + hv[u][i].z * w4.z + hv[u][i].w * w4.w; }
                gl[u][j] = a; }
        }
#pragma unroll
        for (int j = 0; j < NG; ++j) { gl[0][j] = wsum(gl[0][j]); gl[1][j] = wsum(gl[1][j]); }
        int gi[2]; float gw[2]; float ev[2][EPG];
#pragma unroll
        for (int u = 0; u < 2; ++u) {
#pragma unroll
            for (int j = 0; j < NG; ++j) gl[u][j] += p.moe_b_group[layer * NG + j];
            int g = 0; float gm = gl[u][0];
#pragma unroll
            for (int j = 1; j < NG; ++j) if (gl[u][j] > gm) { gm = gl[u][j]; g = j; }
            float gs = 0.f;
#pragma unroll
            for (int j = 0; j < NG; ++j) gs += expf(gl[u][j] - gm);
            gi[u] = g; gw[u] = 1.f / gs;
            const float* wre = wr + (size_t)(NG + g * EPG) * D_MODEL;
#pragma unroll
            for (int j = 0; j < EPG; ++j) { float a = 0.f;
#pragma unroll
                for (int i = 0; i < NV4; ++i) { const f32x4 w4 = *(const f32x4*)(wre + (size_t)j * D_MODEL + (i * 64 + lane) * 4); a += hv[u][i].x * w4.x + hv[u][i].y * w4.y + hv[u][i].z * w4.z + hv[u][i].w * w4.w; }
                ev[u][j] = a; }
        }
#pragma unroll
        for (int j = 0; j < EPG; ++j) { ev[0][j] = wsum(ev[0][j]); ev[1][j] = wsum(ev[1][j]); }
#pragma unroll
        for (int u = 0; u < 2; ++u) {
#pragma unroll
            for (int j = 0; j < EPG; ++j) ev[u][j] += p.moe_b_router[layer * NE + gi[u] * EPG + j];
            int i1 = 0; float v1 = ev[u][0];
#pragma unroll
            for (int j = 1; j < EPG; ++j) if (ev[u][j] > v1) { v1 = ev[u][j]; i1 = j; }
            int i2 = -1; float v2 = -3.0e38f;
#pragma unroll
            for (int j = 0; j < EPG; ++j) if (j != i1 && ev[u][j] > v2) { v2 = ev[u][j]; i2 = j; }
            const float e2 = expf(v2 - v1); const float w1 = gw[u] / (1.f + e2), w2 = gw[u] * e2 / (1.f + e2);
            if (lane == 0 && ok[u]) {
                const int ea = gi[u] * EPG + i1, eb = gi[u] * EPG + i2;
                const int ra = atomicAdd(lcnt + ea, 1), rb = atomicAdd(lcnt + eb, 1);
                int* rc = rec + ((it * 2 + u) * 4 + wid) * 8;
                rc[0] = tk[u]; rc[1] = ea; rc[2] = eb; rc[3] = ra; rc[4] = rb; rc[5] = (int)__float_as_uint(w1); rc[6] = (int)__float_as_uint(w2);
            }
        }
    }
    __syncthreads();
    if (tid < 32) { const int c = lcnt[tid]; lbase[tid] = c ? atomicAdd(p.CNT + (layer * NE + tid) * 32, c) : 0; }
    __syncthreads();
    for (int i = tid; i < nit * 8; i += 256) {
        const int* rc = rec + i * 8; const int tk = rc[0];
        if (tk >= 0) {
            const int ea = rc[1], eb = rc[2]; const int pa = lbase[ea] + rc[3], pb = lbase[eb] + rc[4];
            p.LIST[(size_t)ea * NTOK + pa] = tk * 2; p.LISTW[(size_t)ea * NTOK + pa] = __uint_as_float((unsigned)rc[5]);
            p.LIST[(size_t)eb * NTOK + pb] = tk * 2 + 1; p.LISTW[(size_t)eb * NTOK + pb] = __uint_as_float((unsigned)rc[6]);
        }
    }
}

struct EpGU {
    const Params& p; int slot0, nvalid, col0;
    DEV void nat(f32x4 (&acc)[4][4], int wr, int wc, int lane) {
        const int r = lane & 15, quad = lane >> 4; const int j0 = (col0 + wc * 64) >> 1;
#pragma unroll
        for (int m = 0; m < 4; ++m) {
            const int rl = wr * 64 + m * 16 + r;
            if (rl < nvalid) {
                bf16_t* d = p.ACT + (size_t)(slot0 + rl) * D_EXPERT + j0 + quad * 4;
#pragma unroll
                for (int n = 0; n < 2; ++n) {
                    u32x2 w; w.x = pack2(siluf(acc[m][n][0]) * acc[m][n + 2][0], siluf(acc[m][n][1]) * acc[m][n + 2][1]);
                    w.y = pack2(siluf(acc[m][n][2]) * acc[m][n + 2][2], siluf(acc[m][n][3]) * acc[m][n + 2][3]);
                    *(u32x2*)(d + n * 16) = w;
                }
            }
        }
    }
    DEV void operator()(f32x4 (&acc)[4][4], int wr, int wc, int lane) {
        const int r = lane & 15, quad = lane >> 4; const int j0 = (col0 + wc * 64) >> 1;
#pragma unroll
        for (int m = 0; m < 4; ++m)
#pragma unroll
            for (int j = 0; j < 4; ++j) {
                const int rl = wr * 64 + m * 16 + quad * 4 + j;
                if (rl < nvalid) {
                    bf16_t* d = p.ACT + (size_t)(slot0 + rl) * D_EXPERT + j0 + r;
                    d[0] = f2bf(siluf(acc[m][0][j]) * acc[m][2][j]); d[16] = f2bf(siluf(acc[m][1][j]) * acc[m][3][j]);
                }
            }
    }
};
struct EpDown {
    const Params& p; const float* lw; const int* lp; int nvalid, col0;
    DEV void nat(f32x4 (&acc)[4][4], int wr, int wc, int lane) {
        const int r = lane & 15, quad = lane >> 4;
#pragma unroll
        for (int m = 0; m < 4; ++m) {
            const int rl = wr * 64 + m * 16 + r;
            if (rl < nvalid) {
                const float w = lw[rl]; bf16_t* d = p.YS + (size_t)lp[rl] * D_MODEL + col0 + wc * 64 + quad * 4;
#pragma unroll
                for (int n = 0; n < 4; ++n) { u32x2 o; o.x = pack2(w * acc[m][n][0], w * acc[m][n][1]); o.y = pack2(w * acc[m][n][2], w * acc[m][n][3]); *(u32x2*)(d + n * 16) = o; }
            }
        }
    }
    DEV void operator()(f32x4 (&acc)[4][4], int wr, int wc, int lane) {}
};
template <bool DOWN>
DEV void phaseHI(const Params& p, int layer, unsigned char* smem) {
    int* tpre = (int*)(smem + 74 * 1024); int* sbase = tpre + 40;
    const int tid = tid_(); const int bid = bid_();
    __syncthreads();
    if (tid == 0) {
        int ta = 0, sa = 0;
        for (int e = 0; e < NE; ++e) { const int c = p.CNT[(layer * NE + e) * 32]; tpre[e] = ta; sbase[e] = sa; ta += (c + 127) >> 7; sa += c; }
        tpre[NE] = ta;
        if (bid == 0 && !DOWN) for (int e = 0; e < NE; ++e) p.BASE[e] = sbase[e];
    }
    __syncthreads();
    const int ncol = DOWN ? D_MODEL / 256 : 2 * D_EXPERT / 256; const int ntile = tpre[NE] * ncol;
    const int trow = tid >> 2, lc8 = g2_lc(tid) * 8;
    const WorkRange wr = xcd_range(ntile, bid);
    for (int t = wr.lo; t < wr.hi; t += wr.step) {
        int e = 0;
        for (int q = 1; q < NE; ++q) if (tpre[q] * ncol <= t) e = q;
        const int nrt = tpre[e + 1] - tpre[e]; const int q2 = t - tpre[e] * ncol; const int ct = q2 / nrt, rt = q2 % nrt;
        const int cnt = p.CNT[(layer * NE + e) * 32]; const int nvalid = imin(128, cnt - rt * 128); const int slot0 = sbase[e] + rt * 128;
        if (!DOWN) {
            const int* list = p.LIST + (size_t)e * NTOK + rt * 128;
            const int r0 = imin(trow, nvalid - 1), r1 = imin(64 + trow, nvalid - 1);
            const bf16_t* a0 = p.H + (size_t)(list[r0] >> 1) * D_MODEL + lc8; const bf16_t* a1 = p.H + (size_t)(list[r1] >> 1) * D_MODEL + lc8;
            const bf16_t* bw = p.Wgu + ((size_t)(layer * NE + e) * 2 * D_EXPERT + ct * 256 + trow) * D_MODEL + lc8;
            EpGU ep{p, slot0, nvalid, ct * 256};
            gemm_tile2<2, true>(smem, a0, a1, bw, D_MODEL, D_MODEL / 32, ep);
        } else {
            const bf16_t* a0 = p.ACT + (size_t)(slot0 + trow) * D_EXPERT + lc8;
            const bf16_t* bw = p.WdT + ((size_t)(layer * NE + e) * D_MODEL + ct * 256 + trow) * D_EXPERT + lc8;
            EpDown ep{p, p.LISTW + (size_t)e * NTOK + rt * 128, p.LIST + (size_t)e * NTOK + rt * 128, nvalid, ct * 256};
            gemm_tile2<2, true>(smem, a0, a0 + (size_t)64 * D_EXPERT, bw, D_EXPERT, D_EXPERT / 32, ep);
        }
    }
}

DEV f32x4 bf4(u32x2 v) { return f32x4{__uint_as_float(v.x << 16), __uint_as_float(v.x & 0xFFFF0000u), __uint_as_float(v.y << 16), __uint_as_float(v.y & 0xFFFF0000u)}; }
DEV void phaseJ(const Params& p, int layer) {
    const bool with_ctx = layer < DEPTH - 1; const bool last = layer == DEPTH - 1;
    const int wid = tid_() >> 6, lane = tid_() & 63;
    const float* lg1 = p.ln_g + (size_t)(layer * 2) * D_MODEL; const float* lb1 = p.ln_b + (size_t)(layer * 2) * D_MODEL;
    const float* lg = p.ln_g + (size_t)(layer * 2 + 1) * D_MODEL; const float* lb = p.ln_b + (size_t)(layer * 2 + 1) * D_MODEL;
    const int stride = gridDim.x * 4;
    int tok = bid_() * 4 + wid;
    f32x4 xn[NV4]; u32x2 an[NV4], cn[NV4]; float mun = 0.f, rsn = 0.f;
    if (tok < NTOK) {
#pragma unroll
        for (int i = 0; i < NV4; ++i) {
            const int k = (i * 64 + lane) * 4;
            xn[i] = *(const f32x4*)(p.X + (size_t)tok * D_MODEL + k); an[i] = *(const u32x2*)(p.YS + (size_t)(tok * 2) * D_MODEL + k); cn[i] = *(const u32x2*)(p.YS + (size_t)(tok * 2 + 1) * D_MODEL + k);
        }
        mun = p.STAT[tok * 2]; rsn = p.STAT[tok * 2 + 1];
    }
    for (; tok < NTOK; tok += stride) {
        f32x4 x[NV4]; u32x2 a[NV4], c[NV4]; const float mu1 = mun, rs1 = rsn;
#pragma unroll
        for (int i = 0; i < NV4; ++i) { x[i] = xn[i]; a[i] = an[i]; c[i] = cn[i]; }
        const int tn = tok + stride;
        if (tn < NTOK) {
#pragma unroll
            for (int i = 0; i < NV4; ++i) {
                const int k = (i * 64 + lane) * 4;
                xn[i] = *(const f32x4*)(p.X + (size_t)tn * D_MODEL + k); an[i] = *(const u32x2*)(p.YS + (size_t)(tn * 2) * D_MODEL + k); cn[i] = *(const u32x2*)(p.YS + (size_t)(tn * 2 + 1) * D_MODEL + k);
            }
            mun = p.STAT[tn * 2]; rsn = p.STAT[tn * 2 + 1];
        }
        const int b = tok / TT, s = tok % TT; if (!with_ctx && s < CTX) continue;
        const int bb = s < CTX ? BATCH : b; const float* gate = p.MOD + ((size_t)layer * (BATCH + 1) + bb) * 6 * D_MODEL + 5 * D_MODEL;
        f32x4 v[NV4]; float sum = 0.f;
#pragma unroll
        for (int i = 0; i < NV4; ++i) {
            const int k = (i * 64 + lane) * 4; const f32x4 g = *(const f32x4*)(gate + k), g1 = *(const f32x4*)(lg1 + k), b1 = *(const f32x4*)(lb1 + k);
            const f32x4 x1 = (x[i] - mu1) * rs1 * g1 + b1;
            v[i] = ALPHA * x1 + g * (bf4(a[i]) + bf4(c[i]));
            sum += v[i].x + v[i].y + v[i].z + v[i].w;
        }
        const float mu = wsum(sum) * (1.f / D_MODEL); float var = 0.f;
#pragma unroll
        for (int i = 0; i < NV4; ++i) { float a0 = v[i].x - mu, bq = v[i].y - mu, c0 = v[i].z - mu, d = v[i].w - mu; var += a0 * a0 + bq * bq + c0 * c0 + d * d; }
        const float rs = 1.f / sqrtf(wsum(var) * (1.f / D_MODEL) + EPS);
        float* dst = last ? p.out + ((size_t)b * SEQ + (s - CTX)) * D_MODEL : p.X + (size_t)tok * D_MODEL;
#pragma unroll
        for (int i = 0; i < NV4; ++i) {
            const int k = (i * 64 + lane) * 4; const f32x4 g4 = *(const f32x4*)(lg + k), b4 = *(const f32x4*)(lb + k);
            f32x4 o; o.x = (v[i].x - mu) * rs * g4.x + b4.x; o.y = (v[i].y - mu) * rs * g4.y + b4.y; o.z = (v[i].z - mu) * rs * g4.z + b4.z; o.w = (v[i].w - mu) * rs * g4.w + b4.w;
            *(f32x4*)(dst + k) = o;
            if (!last) {
                const float* mn = p.MOD + ((size_t)(layer + 1) * (BATCH + 1) + bb) * 6 * D_MODEL;
                const f32x4 sh = *(const f32x4*)(mn + k), sc = *(const f32x4*)(mn + D_MODEL + k);
                u32x2 hq; hq.x = pack2(o.x * (1.f + sc.x) + sh.x, o.y * (1.f + sc.y) + sh.y); hq.y = pack2(o.z * (1.f + sc.z) + sh.z, o.w * (1.f + sc.w) + sh.w);
                *(u32x2*)(p.HIN + (size_t)tok * D_MODEL + k) = hq;
            }
        }
    }
}

constexpr int PH_PER_LAYER = 10;
constexpr int NPHASE = 2 + DEPTH * PH_PER_LAYER;
DEV void run_phase(const Params& p, int ph, unsigned char* smem) {
    if (ph == 0) { phase0(p, smem); return; }
    if (ph == 1) { phase0b(p); return; }
    const int layer = (ph - 2) / PH_PER_LAYER, sub = (ph - 2) % PH_PER_LAYER;
    switch (sub) {
        case 0: phaseA(p, layer, smem); break;
        case 1: if (!(layer & 1)) phaseB(p, layer); break;
        case 2: phaseC(p, layer, smem); break;
        case 3: phaseD(p, layer); break;
        case 4: phaseE(p, layer, smem); break;
        case 5: phaseF(p, layer, smem); break;
        case 6: phaseG(p, layer, smem); break;
        case 7: phaseHI<false>(p, layer, smem); break;
        case 8: phaseHI<true>(p, layer, smem); break;
        default: phaseJ(p, layer); break;
    }
}
DEV bool phase_is_empty(int ph) { if (ph < 2) return false; return ((ph - 2) % PH_PER_LAYER) == 1 && (((ph - 2) / PH_PER_LAYER) & 1); }

struct Carver { char* base; size_t off; template <class T> T* take(size_t n) { off = (off + 255) & ~(size_t)255; T* r = (T*)(base + off); off += n * sizeof(T); return r; } };
static void make_params(Params& p, void* const* d_in, void* d_out, void* d_ws) {
    const float** in = (const float**)d_in;
    p.x = in[0]; p.c = in[1]; p.ctx = in[2]; p.c_ctx = in[3]; p.w_mod = in[4]; p.b_mod = in[5]; p.ln_g = in[6]; p.ln_b = in[7];
    p.ev_w_in = in[8]; p.ev_w_out = in[9]; p.ev_lambda = in[10]; p.ev_subln_g = in[11]; p.ev_conv_w = in[12]; p.ev_conv_b = in[13];
    p.ev_gate_b = in[14]; p.ev_mnorm_g = in[15]; p.od_w_in = in[16]; p.od_w_out = in[17]; p.od_decay = in[18]; p.od_qk_g = in[19];
    p.moe_w_group = in[20]; p.moe_b_group = in[21]; p.moe_w_router = in[22]; p.moe_b_router = in[23]; p.moe_w_gate = in[24]; p.moe_w_up = in[25]; p.moe_w_down = in[26];
    p.out = (float*)d_out;
    Carver cv{(char*)d_ws, 0};
    p.X = cv.take<float>((size_t)NTOK * D_MODEL);
    p.MOD = cv.take<float>((size_t)DEPTH * (BATCH + 1) * 6 * D_MODEL);
    p.ROPE = cv.take<float>(64 * 16 * 2); p.LAM = cv.take<float>(4);
    p.WrT = cv.take<float>((size_t)DEPTH * NR * D_MODEL);
    p.CNT = cv.take<int>(DEPTH * NE * 32); p.BASE = cv.take<int>(NE); p.BAR = cv.take<unsigned>(4096);
    p.WinE = cv.take<bf16_t>((size_t)2 * EVEN_INP * D_MODEL); p.WinO = cv.take<bf16_t>((size_t)2 * ODD_IN * D_MODEL);
    p.WoutT = cv.take<bf16_t>((size_t)DEPTH * D_MODEL * MIX_OUT);
    p.Wgu = cv.take<bf16_t>((size_t)DEPTH * NE * 2 * D_EXPERT * D_MODEL); p.WdT = cv.take<bf16_t>((size_t)DEPTH * NE * D_MODEL * D_EXPERT);
    p.STAT = cv.take<float>((size_t)NTOK * 2);
    p.CAT = cv.take<bf16_t>((size_t)NTOK * 1024); p.HIN = cv.take<bf16_t>((size_t)NTOK * D_MODEL);
    p.LIST = cv.take<int>((size_t)NE * NTOK); p.LISTW = cv.take<float>((size_t)NE * NTOK); p.TOKSLOT = cv.take<int>((size_t)NTOK * 2);
    const size_t mix0 = cv.off;
    p.Q1 = cv.take<bf16_t>((size_t)NTOK * 512); p.K1 = cv.take<bf16_t>((size_t)NTOK * 512); p.V1T = cv.take<bf16_t>((size_t)NTOK * 512);
    p.PM = cv.take<bf16_t>((size_t)NTOK * 1024); p.V2T = cv.take<bf16_t>((size_t)NTOK * 512); p.OG = cv.take<bf16_t>((size_t)NTOK * 512);
    p.G = cv.take<float>((size_t)NTOK * 16);
    p.Q2 = cv.take<bf16_t>((size_t)NTOK * 512); p.K2 = cv.take<bf16_t>((size_t)NTOK * 512); p.K2T = cv.take<bf16_t>((size_t)NTOK * 512);
    p.DC = cv.take<bf16_t>((size_t)NCHAIN * NCH * EVR * 128); p.CP = cv.take<bf16_t>((size_t)NCHAIN * NCH * EVR * 128);
    p.BC = cv.take<float>((size_t)NCHAIN * TT); p.AT = cv.take<float>((size_t)NCHAIN * TT); p.MT = cv.take<float>((size_t)NCHAIN * TT); p.MS = cv.take<float>((size_t)NCHAIN * NCH * 4);
    cv.off = mix0;
    p.H = cv.take<bf16_t>((size_t)NTOK * D_MODEL); p.ACT = cv.take<bf16_t>((size_t)(2 * NTOK + 128) * D_EXPERT); p.YS = cv.take<bf16_t>((size_t)2 * NTOK * D_MODEL);
}

#ifndef CPU_EMU
#define XB_TMO      128
#define XB_XCNT(j)  (256  + 64 * (j))
#define XB_XSUB(j)  (1280 + 64 * (j))
#define XB_XGEN(j)  (2304 + 64 * (j))
#define XB_TOP      3328
#define XB_TOPGEN   3392
#define XCD_BAR_WORDS 3456
#define XB_SPIN_CAP (1u << 20)
#define LAS __attribute__((address_space(3)))
__device__ __forceinline__ unsigned xb_ld(unsigned* p)              { return __hip_atomic_load(p, __ATOMIC_RELAXED, __HIP_MEMORY_SCOPE_AGENT); }
__device__ __forceinline__ unsigned xb_add(unsigned* p, unsigned v) { return __hip_atomic_fetch_add(p, v, __ATOMIC_RELAXED, __HIP_MEMORY_SCOPE_AGENT); }
__device__ __forceinline__ unsigned xb_xcc_id() { return (unsigned)__builtin_amdgcn_s_getreg((3 << 11) | 20) & 0xFu; }
#define XB_SPIN(cond, bar) do { unsigned _sp = 0; while (cond) { __builtin_amdgcn_s_sleep(1); \
    if ((++_sp & 255u) == 0u) { if (xb_ld(&(bar)[XB_TMO])) break; if (_sp > XB_SPIN_CAP) { atomicAdd(&(bar)[XB_TMO], 1u); break; } } } } while (0)
struct XcdBarrier { unsigned* bar; unsigned x; volatile LAS unsigned* st; };
__device__ __forceinline__ XcdBarrier xcd_barrier_post(unsigned* bar, volatile LAS unsigned* st) {
    XcdBarrier b; b.bar = bar; b.x = xb_xcc_id(); b.st = st;
    if (threadIdx.x == 0) (void)xb_add(&bar[XB_XCNT(b.x)], 1u);
    return b;
}
__device__ __forceinline__ void xcd_barrier_complete(unsigned* bar, unsigned x, unsigned& nloc, unsigned& nx) {
    const unsigned G = gridDim.x * gridDim.y * gridDim.z;
    unsigned sum, cnt, mine, sp = 0u;
    for (;;) {
        sum = 0u; cnt = 0u; mine = 0u;
#pragma unroll
        for (unsigned j = 0; j < 16; ++j) { const unsigned c = xb_ld(&bar[XB_XCNT(j)]); sum += c; cnt += (c > 0u) ? 1u : 0u; mine = (j == x) ? c : mine; }
        if (sum == G) break;
        __builtin_amdgcn_s_sleep(1);
        if ((++sp & 255u) == 0u) { if (xb_ld(&bar[XB_TMO])) break; if (sp > XB_SPIN_CAP) { atomicAdd(&bar[XB_TMO], 1u); break; } }
    }
    nloc = mine > 0u ? mine : 1u; nx = cnt > 0u ? cnt : 1u;
}
__device__ __forceinline__ void xcd_barrier(const XcdBarrier& b) {
    asm volatile("s_waitcnt vmcnt(0)" ::: "memory");
    __syncthreads();
    if (threadIdx.x == 0) {
        unsigned* bar = b.bar;
        __builtin_amdgcn_s_waitcnt(0);
        unsigned nloc = b.st[0], nx = b.st[1];
        if (nloc == 0u) { xcd_barrier_complete(bar, b.x, nloc, nx); b.st[0] = nloc; b.st[1] = nx; }
        const unsigned old = xb_add(&bar[XB_XSUB(b.x)], 1u);
        const unsigned gen = old / nloc;
        if (old + 1u == (gen + 1u) * nloc) {
            __builtin_amdgcn_fence(__ATOMIC_RELEASE, "agent");
            asm volatile("s_waitcnt vmcnt(0)" ::: "memory");
            const unsigned og = xb_add(&bar[XB_TOP], 1u);
            const unsigned tg = og / nx;
            if (og + 1u == (tg + 1u) * nx) xb_add(&bar[XB_TOPGEN], 1u);
            else XB_SPIN(xb_ld(&bar[XB_TOPGEN]) == tg, bar);
            __builtin_amdgcn_fence(__ATOMIC_ACQUIRE, "agent");
            xb_add(&bar[XB_XGEN(b.x)], 1u);
            asm volatile("s_waitcnt vmcnt(0)" ::: "memory");
        } else {
            XB_SPIN(xb_ld(&bar[XB_XGEN(b.x)]) == gen, bar);
            __builtin_amdgcn_fence(__ATOMIC_ACQUIRE, "agent");
            asm volatile("s_waitcnt vmcnt(0)" ::: "memory");
        }
    }
    __syncthreads();
}

__global__ void __launch_bounds__(NTHREADS, 2) fwd_megakernel(Params p) {
    __shared__ __attribute__((aligned(16))) unsigned char smem[LDS_BYTES];
    cg::grid_group grid = cg::this_grid();
    volatile LAS unsigned* xst = (volatile LAS unsigned*)(smem + LDS_BYTES - 16);
    if (threadIdx.x == 0) { xst[0] = 0u; xst[1] = 0u; }
    __syncthreads();
    const XcdBarrier xb = xcd_barrier_post(p.BAR, xst);
    grid.sync();
#ifdef PROBE_TS
    unsigned long long ts_acc = 0ull;
#endif
    for (int ph = 0; ph < NPHASE; ++ph) {
        if (phase_is_empty(ph)) continue;
#ifdef PROBE_TS
        const int psub_ = ph == 0 ? 10 : ph == 1 ? 11 : (ph - 2) % PH_PER_LAYER;
        const unsigned long long ts0 = __builtin_amdgcn_s_memrealtime();
#endif
#if defined(__HIP_DEVICE_COMPILE__)
        const __attribute__((address_space(4))) Params* pp = (const __attribute__((address_space(4))) Params*)__builtin_amdgcn_kernarg_segment_ptr();
        asm volatile("" : "+s"(pp));
        const Params q = *pp;
        run_phase(q, ph, smem);
#ifdef DBL_MASK
        { const int sub_ = ph == 0 ? 10 : ph == 1 ? 11 : (ph - 2) % PH_PER_LAYER; if ((DBL_MASK >> sub_) & 1) run_phase(q, ph, smem); }
#endif
#else
        run_phase(p, ph, smem);
#endif
#ifdef PROBE_TS
        const unsigned long long ts1 = __builtin_amdgcn_s_memrealtime();
        xcd_barrier(xb);
        const unsigned long long ts2 = __builtin_amdgcn_s_memrealtime();
        if (PROBE_TS == 100) ts_acc += ts2 - ts1; else if (psub_ == PROBE_TS) ts_acc += ts2 - ts0;
#else
        if (ph + 1 < NPHASE) xcd_barrier(xb);
#endif
    }
#ifdef PROBE_TS
    if (blockIdx.x == 0) { const int np = (int)(ts_acc / 100ull); for (int i = threadIdx.x; i < np; i += NTHREADS) p.out[i] += 1.0f; }
#endif
}

extern "C" void kernel_launch(void* const* d_in, const int* in_sizes, int n_in, void* d_out, int out_size, void* d_ws, size_t ws_size, hipStream_t stream) {
    static int grid_blocks = 0;
    if (!grid_blocks) {
        int dev = 0, cus = 0, per_cu = 0;
        (void)hipGetDevice(&dev); (void)hipDeviceGetAttribute(&cus, hipDeviceAttributeMultiprocessorCount, dev);
        (void)hipOccupancyMaxActiveBlocksPerMultiprocessor(&per_cu, fwd_megakernel, NTHREADS, 0);
        if (per_cu > 2) per_cu = 2;
        if (per_cu < 1) per_cu = 1;
        grid_blocks = cus * per_cu;
    }
    Params p; memset(&p, 0, sizeof(p));
    make_params(p, d_in, d_out, d_ws);
    (void)hipMemsetAsync(p.BAR, 0, 4096 * sizeof(unsigned), stream);
    void* args[] = {&p};
    hipError_t e = hipLaunchCooperativeKernel((void*)fwd_megakernel, dim3(grid_blocks), dim3(NTHREADS), args, 0, stream);
    if (e != hipSuccess) fprintf(stderr, "cooperative launch failed: %s (grid %d)\n", hipGetErrorString(e), grid_blocks);
}
#endif

#if defined(DIAG_KERNELS) && !defined(CPU_EMU)
template <int SUB, int ODD>
__global__ void __launch_bounds__(NTHREADS, 2) k_diag(Params p, int l2) {
    __shared__ __attribute__((aligned(16))) unsigned char smem[LDS_BYTES];
    const int layer = l2 * 2 + ODD;
    if (SUB == 100) { phase0(p, smem); return; }
    if (SUB == 0) phaseA(p, layer, smem);
    if (SUB == 1) phaseB(p, layer);
    if (SUB == 20) { for (int it = bid_(); it < 100; it += gridDim.x) { if (ODD) attn_gqa_item(p, it, (bf16_t*)smem); else attn_diff_item(p, layer, it, (bf16_t*)smem); } }
    if (SUB == 21) { for (int it = bid_(); it < 100; it += gridDim.x) { if (ODD) rec_dc_item<64, false>(p, it, (bf16_t*)smem); else rec_dc_item<128, true>(p, it, (bf16_t*)smem); } }
    if (SUB == 3) phaseD(p, layer);
    if (SUB == 4) phaseE(p, layer, smem);
    if (SUB == 5) phaseF(p, layer, smem);
    if (SUB == 6) phaseG(p, layer, smem);
    if (SUB == 7) phaseHI<false>(p, layer, smem);
    if (SUB == 8) phaseHI<true>(p, layer, smem);
    if (SUB == 9) phaseJ(p, layer);
}
template __global__ void k_diag<100, 0>(Params, int);
template __global__ void k_diag<0, 0>(Params, int);
template __global__ void k_diag<0, 1>(Params, int);
template __global__ void k_diag<1, 0>(Params, int);
template __global__ void k_diag<20, 0>(Params, int);
template __global__ void k_diag<20, 1>(Params, int);
template __global__ void k_diag<21, 0>(Params, int);
template __global__ void k_diag<21, 1>(Params, int);
template __global__ void k_diag<3, 0>(Params, int);
template __global__ void k_diag<4, 0>(Params, int);
template __global__ void k_diag<4, 1>(Params, int);
template __global__ void k_diag<5, 0>(Params, int);
template __global__ void k_diag<6, 0>(Params, int);
template __global__ void k_diag<7, 0>(Params, int);
template __global__ void k_diag<8, 0>(Params, int);
template __global__ void k_diag<9, 0>(Params, int);
#endif
```

```cpp
#ifdef CPU_EMU
#include "emu.h"
#else
#include <hip/hip_runtime.h>
#include <hip/hip_cooperative_groups.h>
#include <cstdio>
#include <cstdint>
#include <cstring>
namespace cg = cooperative_groups;
#endif

#define DEV __device__ __forceinline__
#ifdef CPU_EMU
#define SCHED_BARRIER() do {} while (0)
#else
#define SCHED_BARRIER() __builtin_amdgcn_sched_barrier(0)
#endif
#ifdef CPU_EMU
static inline void glds16(const void* g, void* l) { memcpy(l, g, 16); }
template <int N> static inline void wait_vm() {}
#define RAW_BARRIER() __syncthreads()
#else
__device__ __forceinline__ void glds16(const void* g, void* l) {
    __builtin_amdgcn_global_load_lds((const __attribute__((address_space(1))) unsigned*)g, (__attribute__((address_space(3))) unsigned*)l, 16, 0, 0);
}
template <int N> __device__ __forceinline__ void wait_vm() { asm volatile("s_waitcnt vmcnt(%0)" ::"n"(N) : "memory"); }
#define RAW_BARRIER() do { asm volatile("s_waitcnt lgkmcnt(0)" ::: "memory"); __builtin_amdgcn_s_barrier(); } while (0)
#endif
#ifdef CPU_EMU
static inline int tid_() { return (int)threadIdx.x; }
static inline int bid_() { return (int)blockIdx.x; }
#else
__device__ __forceinline__ int tid_() { int t = threadIdx.x; asm volatile("" : "+v"(t)); return t; }
__device__ __forceinline__ int bid_() { int b = blockIdx.x; asm volatile("" : "+s"(b)); return b; }
#endif

#ifdef CPU_EMU_SMALL
constexpr int D_MODEL = 256, BATCH = 2, SEQ = 256, CTX = 256, D_EXPERT = 128;
#else
constexpr int D_MODEL = 1024, BATCH = 4, SEQ = 4096, CTX = 256, D_EXPERT = 512;
#endif
constexpr int DEPTH = 4, GRID_W = 64, CH = 128;
constexpr int TT = CTX + SEQ, NTOK = BATCH * TT, NCH = TT / CH, NCC = CTX / CH;
constexpr float EPS = 1e-5f;
constexpr float ALPHA = 1.6817928305074290f;
constexpr int HA = 4, HB = 4, HC = 4, HD = 8, HKV = 2;
constexpr int EVEN_IN = 3600, EVEN_INP = 3840, ODD_IN = 2304, MIX_OUT = 1024;
constexpr int NG = 4, EPG = 8, NE = 32, NR = NG + NE;
constexpr int NTHREADS = 256;
constexpr int LDS_BYTES = 76 * 1024;
constexpr int NCHAIN = BATCH * 4 * 2;
constexpr int EVR = 144;

typedef unsigned short bf16_t;
typedef short bf16x8 __attribute__((ext_vector_type(8)));
typedef float f32x4 __attribute__((ext_vector_type(4)));
typedef unsigned u32x4 __attribute__((ext_vector_type(4)));
typedef unsigned u32x2 __attribute__((ext_vector_type(2)));
union Frag { bf16x8 v; u32x4 q; u32x2 d[2]; unsigned u[4]; };
DEV int imin(int a, int b) { return a < b ? a : b; }

#ifdef CPU_EMU
DEV bf16_t f2bf(float f) { unsigned u = __float_as_uint(f); u += 0x7FFFu + ((u >> 16) & 1u); return (bf16_t)(u >> 16); }
DEV unsigned pack2(float a, float b) { return (unsigned)f2bf(a) | ((unsigned)f2bf(b) << 16); }
#else
typedef __bf16 hwbf16x2 __attribute__((ext_vector_type(2)));
typedef float hwf32x2 __attribute__((ext_vector_type(2)));
DEV unsigned pack2(float a, float b) { hwf32x2 v = {a, b}; hwbf16x2 h = __builtin_convertvector(v, hwbf16x2); return __builtin_bit_cast(unsigned, h); }
DEV bf16_t f2bf(float f) { return (bf16_t)(pack2(f, 0.f) & 0xFFFFu); }
#endif
DEV float bf2f(bf16_t h) { return __uint_as_float(((unsigned)h) << 16); }
DEV f32x4 bf4(u32x2 v) { return f32x4{__uint_as_float(v.x << 16), __uint_as_float(v.x & 0xFFFF0000u), __uint_as_float(v.y << 16), __uint_as_float(v.y & 0xFFFF0000u)}; }
DEV u32x2 pk4(f32x4 v) { u32x2 o; o.x = pack2(v.x, v.y); o.y = pack2(v.z, v.w); return o; }
DEV float siluf(float x) { return x / (1.0f + __expf(-x)); }
DEV float sigmf(float x) { return 1.0f / (1.0f + __expf(-x)); }
DEV float logsigf(float x) { return (x >= 0.f) ? -log1pf(expf(-x)) : x - log1pf(expf(x)); }
#ifdef CPU_EMU
DEV float rowred_add(float v) { v += __shfl_xor(v, 1); v += __shfl_xor(v, 2); v += __shfl_xor(v, 4); v += __shfl_xor(v, 8); return v; }
DEV float rowred_max(float v) { v = fmaxf(v, __shfl_xor(v, 1)); v = fmaxf(v, __shfl_xor(v, 2)); v = fmaxf(v, __shfl_xor(v, 4)); v = fmaxf(v, __shfl_xor(v, 8)); return v; }
DEV float lane_read(float v, int src, int lane) { return __shfl(v, src); }
DEV float lane_up(float v, int d, int lane) { return __shfl_up(v, d); }
#else
template <int CTRL> DEV float dppf(float v) { return __uint_as_float((unsigned)__builtin_amdgcn_update_dpp(0, (int)__float_as_uint(v), CTRL, 0xF, 0xF, true)); }
DEV float rowred_add(float v) { v += dppf<0xB1>(v); v += dppf<0x4E>(v); v += dppf<0x141>(v); v += dppf<0x140>(v); return v; }
DEV float rowred_max(float v) { v = fmaxf(v, dppf<0xB1>(v)); v = fmaxf(v, dppf<0x4E>(v)); v = fmaxf(v, dppf<0x141>(v)); v = fmaxf(v, dppf<0x140>(v)); return v; }
DEV float lane_read(float v, int src, int lane) { return __uint_as_float((unsigned)__builtin_amdgcn_ds_bpermute((src & 63) << 2, (int)__float_as_uint(v))); }
DEV float lane_up(float v, int d, int lane) { const float o = __uint_as_float((unsigned)__builtin_amdgcn_ds_bpermute(((lane - d) & 63) << 2, (int)__float_as_uint(v))); return lane >= d ? o : v; }
#endif
#ifdef CPU_EMU
DEV float xch16(float v) { return __shfl_xor(v, 16); }
DEV float xch32(float v) { return __shfl_xor(v, 32); }
#else
typedef unsigned hwu2 __attribute__((ext_vector_type(2)));
DEV void xpair16(float v, float& a, float& b) { const unsigned u = __float_as_uint(v); hwu2 r = __builtin_amdgcn_permlane16_swap(u, u, false, false); a = __uint_as_float(r.x); b = __uint_as_float(r.y); }
DEV void xpair32(float v, float& a, float& b) { const unsigned u = __float_as_uint(v); hwu2 r = __builtin_amdgcn_permlane32_swap(u, u, false, false); a = __uint_as_float(r.x); b = __uint_as_float(r.y); }
#endif
DEV float xmax16(float v) {
#ifdef CPU_EMU
    return fmaxf(v, xch16(v));
#else
    float a, b; xpair16(v, a, b); return fmaxf(a, b);
#endif
}
DEV float xmax32(float v) {
#ifdef CPU_EMU
    return fmaxf(v, xch32(v));
#else
    float a, b; xpair32(v, a, b); return fmaxf(a, b);
#endif
}
DEV float xadd16(float v) {
#ifdef CPU_EMU
    return v + xch16(v);
#else
    float a, b; xpair16(v, a, b); return a + b;
#endif
}
DEV float xadd32(float v) {
#ifdef CPU_EMU
    return v + xch32(v);
#else
    float a, b; xpair32(v, a, b); return a + b;
#endif
}
DEV float wsum(float v) { v = rowred_add(v); v = xadd16(v); return xadd32(v); }
DEV float wmax(float v) { v = rowred_max(v); v = xmax16(v); return xmax32(v); }
DEV f32x4 mfma16(bf16x8 a, bf16x8 b, f32x4 c) { return __builtin_amdgcn_mfma_f32_16x16x32_bf16(a, b, c, 0, 0, 0); }

struct WorkRange { int lo, hi, step; };
DEV WorkRange xcd_range(int T, int bid) {
    WorkRange w; const int G = gridDim.x;
    if ((G & 7) == 0) { const int x = bid & 7, k = bid >> 3; w.lo = (int)(((long long)x * T) >> 3) + k; w.hi = (int)(((long long)(x + 1) * T) >> 3); w.step = G >> 3; }
    else { w.lo = bid; w.hi = T; w.step = G; }
    return w;
}
DEV void dense_tile(int t, int nrow, int ncol, int& rt, int& ct) {
    if ((nrow & 7) == 0) { const int rpg = nrow >> 3; const int rg = t / (ncol * rpg), q = t % (ncol * rpg); ct = q / rpg; rt = rg * rpg + q % rpg; }
    else { rt = t / ncol; ct = t % ncol; }
}

struct Params {
    const float *x, *c, *ctx, *c_ctx, *w_mod, *b_mod, *ln_g, *ln_b, *ev_w_in, *ev_w_out, *ev_lambda, *ev_subln_g, *ev_conv_w, *ev_conv_b,
        *ev_gate_b, *ev_mnorm_g, *od_w_in, *od_w_out, *od_decay, *od_qk_g, *moe_w_group, *moe_b_group, *moe_w_router, *moe_b_router,
        *moe_w_gate, *moe_w_up, *moe_w_down;
    float* out;
    bf16_t* X;
    float *MOD, *ROPE, *LAM, *WrT;
    int* CNT; unsigned* BAR;
    bf16_t *WinE, *WinO, *WoutT, *Wgu, *WdT;
    bf16_t *Q1, *K1, *V1T;
    bf16_t *PM, *V2T, *OG;
    float* G;
    bf16_t *Q2, *K2, *K2T;
    bf16_t* CAT;
    bf16_t *DC, *CP;
    float *BC, *AT, *MT, *MS;
    bf16_t *H, *ACT, *HIN, *YS; float* STAT;
    int *LIST, *TOKSLOT, *BASE; float *LISTW;
};

constexpr int GLD = 72;
constexpr int GT = 128 * GLD;

struct BLoadW {
    const bf16_t* base; int ld; u32x4 r[4];
    DEV void fetch(int kt, int tid) {
#pragma unroll
        for (int i = 0; i < 4; ++i) { int c = tid + 256 * i, row = c >> 3, kc = c & 7; r[i] = *(const u32x4*)(base + (size_t)row * ld + kt * 64 + kc * 8); }
    }
    DEV void commit(bf16_t* S, int tid) {
#pragma unroll
        for (int i = 0; i < 4; ++i) { int c = tid + 256 * i, row = c >> 3, kc = c & 7; *(u32x4*)(S + row * GLD + kc * 8) = r[i]; }
    }
};
struct ALoadB {
    const bf16_t* base; int ld; u32x4 r[4];
    DEV void fetch(int kt, int tid) {
#pragma unroll
        for (int i = 0; i < 4; ++i) { int c = tid + 256 * i, row = c >> 3, kc = c & 7; r[i] = *(const u32x4*)(base + (size_t)row * ld + kt * 64 + kc * 8); }
    }
    DEV void commit(bf16_t* S, int tid) {
#pragma unroll
        for (int i = 0; i < 4; ++i) { int c = tid + 256 * i, row = c >> 3, kc = c & 7; *(u32x4*)(S + row * GLD + kc * 8) = r[i]; }
    }
};
struct ALoadG {
    const bf16_t* H; const int* list; int nvalid; u32x4 r[4];
    DEV void fetch(int kt, int tid) {
#pragma unroll
        for (int i = 0; i < 4; ++i) {
            int c = tid + 256 * i, row = c >> 3, kc = c & 7; int rr = row < nvalid ? row : nvalid - 1; int tok = list[rr];
            r[i] = *(const u32x4*)(H + (size_t)tok * D_MODEL + kt * 64 + kc * 8);
        }
    }
    DEV void commit(bf16_t* S, int tid) {
#pragma unroll
        for (int i = 0; i < 4; ++i) { int c = tid + 256 * i, row = c >> 3, kc = c & 7; *(u32x4*)(S + row * GLD + kc * 8) = r[i]; }
    }
};
struct ALoadX {
    const float* base; const float *sc, *sh; f32x4 r[8]; f32x4 s4, h4;
    DEV void fetch(int kt, int tid) {
        int kc = tid & 15;
        s4 = *(const f32x4*)(sc + kt * 64 + kc * 4); h4 = *(const f32x4*)(sh + kt * 64 + kc * 4);
#pragma unroll
        for (int i = 0; i < 8; ++i) { int row = (tid >> 4) + 16 * i; r[i] = *(const f32x4*)(base + (size_t)row * D_MODEL + kt * 64 + kc * 4); }
    }
    DEV void commit(bf16_t* S, int tid) {
        int kc = tid & 15;
#pragma unroll
        for (int i = 0; i < 8; ++i) {
            int row = (tid >> 4) + 16 * i;
            u32x2 o; o.x = pack2(r[i].x * (1.f + s4.x) + h4.x, r[i].y * (1.f + s4.y) + h4.y); o.y = pack2(r[i].z * (1.f + s4.z) + h4.z, r[i].w * (1.f + s4.w) + h4.w);
            *(u32x2*)(S + row * GLD + kc * 4) = o;
        }
    }
};

template <class AL, class BL, class EP>
DEV void gemm_tile(bf16_t* sm, AL& al, BL& bl, int nkt, EP& ep) {
    const int tid = tid_(), wid = tid >> 6, lane = tid & 63, wr = wid >> 1, wc = wid & 1, r = lane & 15, quad = lane >> 4;
    bf16_t* As = sm; bf16_t* Bs = sm + 2 * GT;
    f32x4 acc[4][4];
#pragma unroll
    for (int m = 0; m < 4; ++m)
#pragma unroll
        for (int n = 0; n < 4; ++n) acc[m][n] = f32x4{0.f, 0.f, 0.f, 0.f};
    al.fetch(0, tid); bl.fetch(0, tid); al.commit(As, tid); bl.commit(Bs, tid);
    __syncthreads();
    for (int kt = 0; kt < nkt; ++kt) {
        const int cur = kt & 1;
        if (kt + 1 < nkt) { al.fetch(kt + 1, tid); bl.fetch(kt + 1, tid); }
        const bf16_t* Ac = As + cur * GT + (wr * 64 + r) * GLD + quad * 8;
        const bf16_t* Bc = Bs + cur * GT + (wc * 64 + r) * GLD + quad * 8;
#pragma unroll
        for (int ks = 0; ks < 2; ++ks) {
            Frag a[4], b[4];
#pragma unroll
            for (int m = 0; m < 4; ++m) a[m].q = *(const u32x4*)(Ac + m * 16 * GLD + ks * 32);
#pragma unroll
            for (int n = 0; n < 4; ++n) b[n].q = *(const u32x4*)(Bc + n * 16 * GLD + ks * 32);
#pragma unroll
            for (int m = 0; m < 4; ++m)
#pragma unroll
                for (int n = 0; n < 4; ++n) acc[m][n] = mfma16(a[m].v, b[n].v, acc[m][n]);
        }
        if (kt + 1 < nkt) { al.commit(As + (cur ^ 1) * GT, tid); bl.commit(Bs + (cur ^ 1) * GT, tid); }
        __syncthreads();
    }
    ep(acc, wr, wc, lane);
}


DEV int g2_h(int g) { return (0x78 >> (2 * g)) & 3; }
template <int NH> struct G2 { static constexpr int BROWS = 128 * NH, STAGE = 8192 + BROWS * 64, NST = (NH == 2 ? 3 : 4), LPS = 2 + 2 * NH; };

template <int NH, bool TR, class EP>
DEV void gemm_tile2(unsigned char* sm, const bf16_t* a0, const bf16_t* a1, const bf16_t* bb, int ldb, int nkt, EP& ep) {
    constexpr int STAGE = G2<NH>::STAGE, NST = G2<NH>::NST, LPS = G2<NH>::LPS;
    const int tid = tid_(), wid = tid >> 6, lane = tid & 63, wr = wid >> 1, wc = wid & 1, r = lane & 15, quad = lane >> 4;
    f32x4 acc[NH][4][4];
#pragma unroll
    for (int h = 0; h < NH; ++h)
#pragma unroll
        for (int m = 0; m < 4; ++m)
#pragma unroll
            for (int n = 0; n < 4; ++n) acc[h][m][n] = f32x4{0.f, 0.f, 0.f, 0.f};
    unsigned char* dst0 = sm + tid * 16;
    auto issue = [&](int kt, int slot) {
        unsigned char* d = dst0 + slot * STAGE;
        glds16(a0 + kt * 32, d); glds16(a1 + kt * 32, d + 4096);
#pragma unroll
        for (int j = 0; j < 2 * NH; ++j) glds16(bb + (size_t)j * 64 * ldb + kt * 32, d + 8192 + j * 4096);
    };
    RAW_BARRIER();
#pragma unroll
    for (int st = 0; st < NST - 1; ++st) if (st < nkt) issue(st, st);
    const int pco = (quad ^ g2_h((r >> 2) & 3)) * 16;
    const unsigned char* afr = sm + (wr * 64 + r) * 64 + pco;
    const unsigned char* bfr = sm + 8192 + (wc * 64 * NH + r) * 64 + pco;
    int slot = 0;
    for (int kt = 0; kt < nkt; ++kt) {
        const int rem = nkt - 1 - kt;
        if (NST == 3) { if (rem >= 1) wait_vm<LPS>(); else wait_vm<0>(); }
        else { if (rem >= 2) wait_vm<2 * LPS>(); else if (rem == 1) wait_vm<LPS>(); else wait_vm<0>(); }
        RAW_BARRIER();
        if (kt + NST - 1 < nkt) { int ns = slot + NST - 1; if (ns >= NST) ns -= NST; issue(kt + NST - 1, ns); }
        const unsigned char* as = afr + slot * STAGE; const unsigned char* bs = bfr + slot * STAGE;
        Frag a[4];
#pragma unroll
        for (int m = 0; m < 4; ++m) a[m].q = *(const u32x4*)(as + m * 16 * 64);
#ifndef CPU_EMU
        __builtin_amdgcn_s_setprio(1);
#endif
#pragma unroll
        for (int h = 0; h < NH; ++h) {
            Frag b[4];
#pragma unroll
            for (int n = 0; n < 4; ++n) b[n].q = *(const u32x4*)(bs + (h * 64 + n * 16) * 64);
#pragma unroll
            for (int m = 0; m < 4; ++m)
#pragma unroll
                for (int n = 0; n < 4; ++n) acc[h][m][n] = TR ? mfma16(b[n].v, a[m].v, acc[h][m][n]) : mfma16(a[m].v, b[n].v, acc[h][m][n]);
        }
#ifndef CPU_EMU
        __builtin_amdgcn_s_setprio(0);
#endif
        if (++slot == NST) slot = 0;
    }
#pragma unroll
    for (int h = 0; h < NH; ++h) { if (TR) ep.nat(acc[h], wr, wc * NH + h, lane); else ep(acc[h], wr, wc * NH + h, lane); }
}
DEV int g2_lc(int tid) { return (tid & 3) ^ g2_h((tid >> 4) & 3); }

struct ConvJob { const float* src; bf16_t* dst; int ldsrc, N, K, k0, n0, mapkind; };
DEV void conv_load(const ConvJob& j, int tid, f32x4 (&v)[4]) {
#pragma unroll
    for (int i = 0; i < 4; ++i) {
        const int kk = (tid >> 4) + 16 * i, n = j.n0 + 4 * (tid & 15);
        v[i] = f32x4{0.f, 0.f, 0.f, 0.f};
        if (n + 3 < j.N) v[i] = *(const f32x4*)(j.src + (size_t)(j.k0 + kk) * j.ldsrc + n);
    }
}
DEV void conv_store(float* T, const ConvJob& j, int tid, const f32x4 (&v)[4]) {
    __syncthreads();
#pragma unroll
    for (int i = 0; i < 4; ++i) {
        const int kk = (tid >> 4) + 16 * i, n4 = tid & 15;
        T[(4 * n4 + 0) * 65 + kk] = v[i].x; T[(4 * n4 + 1) * 65 + kk] = v[i].y; T[(4 * n4 + 2) * 65 + kk] = v[i].z; T[(4 * n4 + 3) * 65 + kk] = v[i].w;
    }
    __syncthreads();
    const int nl = tid >> 2, ks = (tid & 3) * 16; const int n = j.n0 + nl; int dr = n;
    if (j.mapkind == 1) dr = (n >> 5) * 64 + (n & 31); else if (j.mapkind == 2) dr = (n >> 5) * 64 + 32 + (n & 31);
    const float* t = T + nl * 65 + ks;
    u32x4 o0, o1;
    o0.x = pack2(t[0], t[1]); o0.y = pack2(t[2], t[3]); o0.z = pack2(t[4], t[5]); o0.w = pack2(t[6], t[7]);
    o1.x = pack2(t[8], t[9]); o1.y = pack2(t[10], t[11]); o1.z = pack2(t[12], t[13]); o1.w = pack2(t[14], t[15]);
    bf16_t* d = j.dst + (size_t)dr * j.K + j.k0 + ks;
    *(u32x4*)d = o0; *(u32x4*)(d + 8) = o1;
}
constexpr int P0_NMOD = DEPTH * 6 * D_MODEL / 64;
constexpr int P0_NCOPY = NTOK / 64;
constexpr int T_EIN = (D_MODEL / 64) * (EVEN_INP / 64), T_OIN = (D_MODEL / 64) * (ODD_IN / 64), T_OUT = (MIX_OUT / 64) * (D_MODEL / 64);
constexpr int T_GU = (D_MODEL / 64) * (D_EXPERT / 64), T_DN = (D_EXPERT / 64) * (D_MODEL / 64);
constexpr int P0_C0 = P0_NMOD + P0_NCOPY + 1 + DEPTH;
constexpr int P0_C1 = 2 * T_EIN, P0_C2 = P0_C1 + 2 * T_OIN, P0_C3 = P0_C2 + DEPTH * T_OUT, P0_C4 = P0_C3 + DEPTH * NE * 2 * T_GU, P0_C5 = P0_C4 + DEPTH * NE * T_DN;
DEV ConvJob conv_job(const Params& p, int t) {
    ConvJob j;
    if (t < P0_C1) {
        const int i = t / T_EIN, tt = t % T_EIN; const int nt = tt % (EVEN_INP / 64), kt = tt / (EVEN_INP / 64);
        j.src = p.ev_w_in + (size_t)i * D_MODEL * EVEN_IN; j.ldsrc = EVEN_IN; j.N = EVEN_IN; j.K = D_MODEL; j.k0 = kt * 64; j.n0 = nt * 64; j.dst = p.WinE + (size_t)i * EVEN_INP * D_MODEL; j.mapkind = 0;
    } else if (t < P0_C2) {
        const int q = t - P0_C1, i = q / T_OIN, tt = q % T_OIN; const int nt = tt % (ODD_IN / 64), kt = tt / (ODD_IN / 64);
        j.src = p.od_w_in + (size_t)i * D_MODEL * ODD_IN; j.ldsrc = ODD_IN; j.N = ODD_IN; j.K = D_MODEL; j.k0 = kt * 64; j.n0 = nt * 64; j.dst = p.WinO + (size_t)i * ODD_IN * D_MODEL; j.mapkind = 0;
    } else if (t < P0_C3) {
        const int q = t - P0_C2, layer = q / T_OUT, tt = q % T_OUT; const int nt = tt % (D_MODEL / 64), kt = tt / (D_MODEL / 64);
        j.src = (layer & 1) ? p.od_w_out + (size_t)(layer >> 1) * MIX_OUT * D_MODEL : p.ev_w_out + (size_t)(layer >> 1) * MIX_OUT * D_MODEL;
        j.ldsrc = D_MODEL; j.N = D_MODEL; j.K = MIX_OUT; j.k0 = kt * 64; j.n0 = nt * 64; j.dst = p.WoutT + (size_t)layer * D_MODEL * MIX_OUT; j.mapkind = 0;
    } else if (t < P0_C4) {
        const int q = t - P0_C3, le = q / (2 * T_GU); int tt = q % (2 * T_GU); const int up = tt / T_GU; tt %= T_GU; const int nt = tt % (D_EXPERT / 64), kt = tt / (D_EXPERT / 64);
        j.src = (up ? p.moe_w_up : p.moe_w_gate) + (size_t)le * D_MODEL * D_EXPERT; j.ldsrc = D_EXPERT; j.N = D_EXPERT; j.K = D_MODEL; j.k0 = kt * 64; j.n0 = nt * 64;
        j.dst = p.Wgu + (size_t)le * 2 * D_EXPERT * D_MODEL; j.mapkind = 1 + up;
    } else {
        const int q = t - P0_C4, le = q / T_DN, tt = q % T_DN; const int nt = tt % (D_MODEL / 64), kt = tt / (D_MODEL / 64);
        j.src = p.moe_w_down + (size_t)le * D_EXPERT * D_MODEL; j.ldsrc = D_MODEL; j.N = D_MODEL; j.K = D_EXPERT; j.k0 = kt * 64; j.n0 = nt * 64; j.dst = p.WdT + (size_t)le * D_MODEL * D_EXPERT; j.mapkind = 0;
    }
    return j;
}

DEV void phase0(const Params& p, unsigned char* smem) {
    const int tid = tid_(); const int bid = bid_();
    float* fs = (float*)smem;
    for (int task = bid; task < P0_C0; task += gridDim.x) {
        if (task < P0_NMOD) {
            __syncthreads();
            for (int i = tid; i < (BATCH + 1) * D_MODEL; i += 256) { int bb = i / D_MODEL, k = i % D_MODEL; float v = bb < BATCH ? p.c[bb * D_MODEL + k] : p.c_ctx[k]; fs[i] = v / (1.f + expf(-v)); }
            __syncthreads();
            const int col = task * 64 + (tid & 63), kg = tid >> 6; const int layer = col / (6 * D_MODEL), j = col % (6 * D_MODEL);
            const float* w = p.w_mod + (size_t)layer * D_MODEL * 6 * D_MODEL + j;
            float acc[BATCH + 1];
#pragma unroll
            for (int bb = 0; bb <= BATCH; ++bb) acc[bb] = 0.f;
#pragma unroll 16
            for (int k = kg * (D_MODEL / 4); k < (kg + 1) * (D_MODEL / 4); ++k) {
                float wv = w[(size_t)k * 6 * D_MODEL];
#pragma unroll
                for (int bb = 0; bb <= BATCH; ++bb) acc[bb] += fs[bb * D_MODEL + k] * wv;
            }
            float* red = fs + (BATCH + 1) * D_MODEL;
#pragma unroll
            for (int bb = 0; bb <= BATCH; ++bb) red[(kg * (BATCH + 1) + bb) * 64 + (tid & 63)] = acc[bb];
            __syncthreads();
            if (tid < 64) {
                const float bm = p.b_mod[layer * 6 * D_MODEL + j];
#pragma unroll
                for (int bb = 0; bb <= BATCH; ++bb) {
                    const float sacc = red[(0 * (BATCH + 1) + bb) * 64 + tid] + red[(1 * (BATCH + 1) + bb) * 64 + tid] + red[(2 * (BATCH + 1) + bb) * 64 + tid] + red[(3 * (BATCH + 1) + bb) * 64 + tid];
                    p.MOD[((size_t)layer * (BATCH + 1) + bb) * 6 * D_MODEL + j] = sacc + bm;
                }
            }
        } else if (task < P0_NMOD + P0_NCOPY) {
            int r0 = (task - P0_NMOD) * 64;
            for (int i = tid; i < 64 * D_MODEL / 4; i += 256) {
                int row = r0 + i / (D_MODEL / 4), c4 = i % (D_MODEL / 4); int b = row / TT, s = row % TT;
                const float* src = s < CTX ? p.ctx + ((size_t)b * CTX + s) * D_MODEL : p.x + ((size_t)b * SEQ + (s - CTX)) * D_MODEL;
                *(u32x2*)(p.X + (size_t)row * D_MODEL + c4 * 4) = pk4(*(const f32x4*)(src + c4 * 4));

            }
        } else if (task == P0_NMOD + P0_NCOPY) {
            for (int i = tid; i < 64 * 16; i += 256) {
                int pos = i / 16, f = i % 16;
                double th = 1.0; for (int q = 0; q < f; ++q) th *= 0.5623413251903490804;
                double t2 = th * th, cs = 1.0, sn = th, tc = 1.0, ts = th;
                for (int n = 1; n < 14; ++n) { tc *= -t2 / ((2 * n - 1) * (2 * n)); ts *= -t2 / ((2 * n) * (2 * n + 1)); cs += tc; sn += ts; }
                double c = 1.0, s = 0.0;
                for (int q = 0; q < pos; ++q) { double cn = c * cs - s * sn, sn2 = s * cs + c * sn; c = cn; s = sn2; }
                p.ROPE[i * 2] = (float)c; p.ROPE[i * 2 + 1] = (float)s;
            }
            if (tid < 2) {
                const float* lp = p.ev_lambda + tid * 4 * 64; float s01 = 0.f, s23 = 0.f;
                for (int k = 0; k < 64; ++k) { s01 += lp[k] * lp[64 + k]; s23 += lp[128 + k] * lp[192 + k]; }
                float lam_init = 0.8f - 0.6f * expf(-0.3f * (float)(2 * tid));
                p.LAM[tid] = expf(s01) - expf(s23) + lam_init;
            }
            for (int i = tid; i < DEPTH * NE * 32; i += 256) p.CNT[i] = 0;
        } else {
            int layer = task - (P0_NMOD + P0_NCOPY + 1);
            for (int i = tid; i < NR * D_MODEL; i += 256) {
                int j = i / D_MODEL, k = i % D_MODEL;
                float v = j < NG ? p.moe_w_group[((size_t)layer * D_MODEL + k) * NG + j] : p.moe_w_router[((size_t)layer * D_MODEL + k) * NE + (j - NG)];
                p.WrT[(size_t)layer * NR * D_MODEL + i] = v;
            }
        }
    }
    {
        const int G = gridDim.x; int t = bid;
        ConvJob j0, j1, j2; f32x4 v0[4], v1[4], v2[4];
        const bool h0 = t < P0_C5, h1 = t + G < P0_C5;
        if (h0) { j0 = conv_job(p, t); conv_load(j0, tid, v0); } else { j0 = conv_job(p, 0); }
        if (h1) { j1 = conv_job(p, t + G); conv_load(j1, tid, v1); } else { j1 = j0; }
        j2 = j1;
        while (t < P0_C5) {
            const bool h2 = t + 2 * G < P0_C5;
            if (h2) { j2 = conv_job(p, t + 2 * G); conv_load(j2, tid, v2); }
            conv_store(fs, j0, tid, v0);
            j0 = j1; j1 = j2;
#pragma unroll
            for (int i = 0; i < 4; ++i) { v0[i] = v1[i]; v1[i] = v2[i]; }
            t += G;
        }
    }
}

DEV int chunk_of(int dir, int sp) { return dir == 0 ? sp : (sp < NCC ? NCC - 1 - sp : NCC + (NCH - 1 - sp)); }
DEV int sp_of(int dir, int u) { return dir == 0 ? u : (u < NCC ? NCC - 1 - u : NCC + (NCH - 1 - u)); }

template <bool RET>
DEV void gate_chain(const Params& p, int layer, int chain) {
    const int lane = tid_() & 63;
    const int dir = chain & 1, h = (chain >> 1) & 3, b = chain >> 3;
    float lg = 0.f;
    if (RET) lg = logsigf(p.od_decay[((layer >> 1) * 2 + dir) * HC + h]);
    float mprev = 0.f;
    for (int sp = 0; sp < NCH; ++sp) {
        const int u = chunk_of(dir, sp); const int sbase = u * CH;
        int i0 = 2 * lane, i1 = 2 * lane + 1;
        int s0 = dir ? sbase + 127 - i0 : sbase + i0, s1 = dir ? sbase + 127 - i1 : sbase + i1;
        float lf0, lf1, li0, li1;
        if (RET) { lf0 = lf1 = lg; li0 = li1 = 0.f; }
        else {
            const float* g0 = p.G + ((size_t)b * TT + s0) * 16; const float* g1 = p.G + ((size_t)b * TT + s1) * 16;
            li0 = g0[(2 * dir) * 4 + h]; li1 = g1[(2 * dir) * 4 + h];
            lf0 = logsigf(g0[(2 * dir + 1) * 4 + h]); lf1 = logsigf(g1[(2 * dir + 1) * 4 + h]);
        }
        float ps = lf0 + lf1;
        for (int d = 1; d < 64; d <<= 1) { float o = lane_up(ps, d, lane); if (lane >= d) ps += o; }
        float b1 = ps, b0 = ps - lf1;
        float bend = lane_read(ps, 63, lane);
        float a0 = li0 - b0, a1 = li1 - b1;
        float pm = fmaxf(a0, a1);
        float mx = pm;
        for (int d = 1; d < 64; d <<= 1) { float o = lane_up(mx, d, lane); if (lane >= d) mx = fmaxf(mx, o); }
        float pmx_prev = lane_up(mx, 1, lane); if (lane == 0) pmx_prev = -3.0e38f;
        float pm0 = fmaxf(pmx_prev, a0), pm1 = mx;
        float amax = lane_read(mx, 63, lane);
        float mnew, carry, mt0, mt1;
        if (RET) { mnew = 0.f; carry = __expf(bend); mt0 = mt1 = 0.f; }
        else { mnew = fmaxf(bend + mprev, bend + amax); carry = __expf(bend + mprev - mnew); mt0 = b0 + fmaxf(mprev, pm0); mt1 = b1 + fmaxf(mprev, pm1); }
        size_t o = (size_t)chain * TT;
        p.BC[o + s0] = b0; p.BC[o + s1] = b1; p.AT[o + s0] = a0; p.AT[o + s1] = a1; p.MT[o + s0] = mt0; p.MT[o + s1] = mt1;
        if (lane == 0) { float* ms = p.MS + ((size_t)chain * NCH + sp) * 4; ms[0] = mprev; ms[1] = mnew; ms[2] = bend; ms[3] = carry; }
        mprev = mnew;
    }
}

struct EpInEven {
    const Params& p; int layer, row0, col0;
    DEV void nat(f32x4 (&acc)[4][4], int wr, int wc, int lane) {
        const int r = lane & 15, quad = lane >> 4;
        const int c0 = col0 + wc * 64, rowb = row0 + wr * 64;
        const int b = row0 / TT; const int sb = rowb - b * TT; const bool lat = sb >= CTX;
        if (c0 < 1024) {
            bf16_t* dst = c0 < 512 ? p.Q1 : p.K1; const int cc = c0 & 511;
#pragma unroll
            for (int m = 0; m < 4; ++m) {
                const int row = rowb + m * 16 + r;
                f32x4 v0 = acc[m][0], v1 = acc[m][1], v2 = acc[m][2], v3 = acc[m][3];
                if (lat) {
                    const int t = sb + m * 16 + r - CTX; const int pr = t / GRID_W, pc = t % GRID_W;
                    const f32x4 ra = *(const f32x4*)(p.ROPE + (pr * 16 + quad * 4) * 2), rb = *(const f32x4*)(p.ROPE + (pr * 16 + quad * 4) * 2 + 4);
                    const f32x4 ca = *(const f32x4*)(p.ROPE + (pc * 16 + quad * 4) * 2), cb = *(const f32x4*)(p.ROPE + (pc * 16 + quad * 4) * 2 + 4);
                    const f32x4 cr = f32x4{ra[0], ra[2], rb[0], rb[2]}, sr = f32x4{ra[1], ra[3], rb[1], rb[3]};
                    const f32x4 cq = f32x4{ca[0], ca[2], cb[0], cb[2]}, sq = f32x4{ca[1], ca[3], cb[1], cb[3]};
                    const f32x4 o0 = v0 * cr - v2 * sr, o2 = v0 * sr + v2 * cr, o1 = v1 * cq - v3 * sq, o3 = v1 * sq + v3 * cq;
                    v0 = o0; v1 = o1; v2 = o2; v3 = o3;
                }
                bf16_t* d = dst + (size_t)row * 512 + cc + quad * 4;
                u32x2 w; w.x = pack2(v0[0], v0[1]); w.y = pack2(v0[2], v0[3]); *(u32x2*)d = w;
                w.x = pack2(v1[0], v1[1]); w.y = pack2(v1[2], v1[3]); *(u32x2*)(d + 16) = w;
                w.x = pack2(v2[0], v2[1]); w.y = pack2(v2[2], v2[3]); *(u32x2*)(d + 32) = w;
                w.x = pack2(v3[0], v3[1]); w.y = pack2(v3[2], v3[3]); *(u32x2*)(d + 48) = w;
            }
        } else if (c0 < 3584) {
            const bool pm = c0 < 2560; bf16_t* dst = pm ? p.PM : p.OG; const int ld = pm ? 1024 : 512; const int cc = pm ? c0 - 1536 : c0 - 3072;
#pragma unroll
            for (int m = 0; m < 4; ++m) {
                bf16_t* d = dst + (size_t)(rowb + m * 16 + r) * ld + cc + quad * 4;
#pragma unroll
                for (int n = 0; n < 4; ++n) { u32x2 w; w.x = pack2(acc[m][n][0], acc[m][n][1]); w.y = pack2(acc[m][n][2], acc[m][n][3]); *(u32x2*)(d + n * 16) = w; }
            }
        } else if (c0 == 3584) {
            const f32x4 gb = *(const f32x4*)(p.ev_gate_b + (layer >> 1) * 16 + quad * 4);
#pragma unroll
            for (int m = 0; m < 4; ++m) *(f32x4*)(p.G + (size_t)(rowb + m * 16 + r) * 16 + quad * 4) = acc[m][0] + gb;
        }
    }
    DEV void operator()(f32x4 (&acc)[4][4], int wr, int wc, int lane) {
        const int r = lane & 15, quad = lane >> 4;
        const int c0 = col0 + wc * 64, rowb = row0 + wr * 64;
        const int b = row0 / TT; const int sb = rowb - b * TT; const bool lat = sb >= CTX;
        if (c0 < 1024) {
            bf16_t* dst = c0 < 512 ? p.Q1 : p.K1; const int cc = c0 & 511;
#pragma unroll
            for (int m = 0; m < 4; ++m)
#pragma unroll
                for (int j = 0; j < 4; ++j) {
                    const int row = rowb + m * 16 + quad * 4 + j;
                    float v0 = acc[m][0][j], v1 = acc[m][1][j], v2 = acc[m][2][j], v3 = acc[m][3][j];
                    if (lat) {
                        const int t = sb + m * 16 + quad * 4 + j - CTX; const int pr = t / GRID_W, pc = t % GRID_W;
                        const float cr = p.ROPE[(pr * 16 + r) * 2], sr = p.ROPE[(pr * 16 + r) * 2 + 1], cq = p.ROPE[(pc * 16 + r) * 2], sq = p.ROPE[(pc * 16 + r) * 2 + 1];
                        float o0 = v0 * cr - v2 * sr, o2 = v0 * sr + v2 * cr, o1 = v1 * cq - v3 * sq, o3 = v1 * sq + v3 * cq;
                        v0 = o0; v1 = o1; v2 = o2; v3 = o3;
                    }
                    bf16_t* d = dst + (size_t)row * 512 + cc + r;
                    d[0] = f2bf(v0); d[16] = f2bf(v1); d[32] = f2bf(v2); d[48] = f2bf(v3);
                }
        } else if (c0 < 1536 || (c0 >= 2560 && c0 < 3072)) {
            const bool at = c0 < 1536; const int cc = at ? c0 - 1024 : c0 - 2560; const int h = cc >> 7, e0 = (cc & 127);
            bf16_t* dst = (at ? p.V1T : p.V2T) + ((size_t)(b * 4 + h) * 128) * TT;
#pragma unroll
            for (int m = 0; m < 4; ++m)
#pragma unroll
                for (int n = 0; n < 4; ++n) {
                    u32x2 o; o.x = pack2(acc[m][n][0], acc[m][n][1]); o.y = pack2(acc[m][n][2], acc[m][n][3]);
                    *(u32x2*)(dst + (size_t)(e0 + n * 16 + r) * TT + sb + m * 16 + quad * 4) = o;
                }
        } else if (c0 < 2560 || (c0 >= 3072 && c0 < 3584)) {
            const bool pm = c0 < 2560; bf16_t* dst = pm ? p.PM : p.OG; const int ld = pm ? 1024 : 512; const int cc = pm ? c0 - 1536 : c0 - 3072;
#pragma unroll
            for (int m = 0; m < 4; ++m)
#pragma unroll
                for (int j = 0; j < 4; ++j) {
                    const int row = rowb + m * 16 + quad * 4 + j; bf16_t* d = dst + (size_t)row * ld + cc + r;
                    d[0] = f2bf(acc[m][0][j]); d[16] = f2bf(acc[m][1][j]); d[32] = f2bf(acc[m][2][j]); d[48] = f2bf(acc[m][3][j]);
                }
        } else if (c0 == 3584) {
            const float gb = p.ev_gate_b[(layer >> 1) * 16 + r];
#pragma unroll
            for (int m = 0; m < 4; ++m)
#pragma unroll
                for (int j = 0; j < 4; ++j) { const int row = rowb + m * 16 + quad * 4 + j; p.G[(size_t)row * 16 + r] = acc[m][0][j] + gb; }
        }
    }
};

struct EpInOdd {
    const Params& p; int layer, row0, col0;
    DEV void nat(f32x4 (&acc)[4][4], int wr, int wc, int lane) {
        const int r = lane & 15, quad = lane >> 4;
        const int c0 = col0 + wc * 64, rowb = row0 + wr * 64;
        const int b = row0 / TT; const int sb = rowb - b * TT; const bool lat = sb >= CTX;
        if (c0 < 512 || (c0 >= 1024 && c0 < 1536)) {
            bf16_t* dst; int ld, cc; float scl = 1.f;
            if (c0 < 256) { dst = p.Q2; ld = 256; cc = c0; } else if (c0 < 512) { dst = p.K2; ld = 256; cc = c0 - 256; scl = 0.125f; } else { dst = p.OG; ld = 512; cc = c0 - 1024; }
#pragma unroll
            for (int m = 0; m < 4; ++m) {
                bf16_t* d = dst + (size_t)(rowb + m * 16 + r) * ld + cc + quad * 4;
#pragma unroll
                for (int n = 0; n < 4; ++n) { u32x2 w; w.x = pack2(acc[m][n][0] * scl, acc[m][n][1] * scl); w.y = pack2(acc[m][n][2] * scl, acc[m][n][3] * scl); *(u32x2*)(d + n * 16) = w; }
            }
        } else if (c0 >= 1536 && c0 < 2176) {
            const bool isq = c0 < 2048; bf16_t* dst = isq ? p.Q1 : p.K1; const int ld = isq ? 512 : 128; const int cc = isq ? c0 - 1536 : c0 - 2048;
            const float* g = p.od_qk_g + ((layer >> 1) * 2 + (isq ? 0 : 1)) * 64 + quad * 4;
            const f32x4 g0 = *(const f32x4*)g, g1 = *(const f32x4*)(g + 16), g2 = *(const f32x4*)(g + 32), g3 = *(const f32x4*)(g + 48);
#pragma unroll
            for (int m = 0; m < 4; ++m) {
                const int row = rowb + m * 16 + r;
                f32x4 v0 = acc[m][0], v1 = acc[m][1], v2 = acc[m][2], v3 = acc[m][3];
                float ss = 0.f;
#pragma unroll
                for (int j = 0; j < 4; ++j) ss += v0[j] * v0[j] + v1[j] * v1[j] + v2[j] * v2[j] + v3[j] * v3[j];
                ss = xadd16(ss); ss = xadd32(ss);
                const float rs = 1.0f / sqrtf(ss * (1.f / 64.f) + EPS);
                v0 = v0 * rs * g0; v1 = v1 * rs * g1; v2 = v2 * rs * g2; v3 = v3 * rs * g3;
                if (lat) {
                    const int t = sb + m * 16 + r - CTX; const int pr = t / GRID_W, pc = t % GRID_W;
                    const f32x4 ra = *(const f32x4*)(p.ROPE + (pr * 16 + quad * 4) * 2), rb = *(const f32x4*)(p.ROPE + (pr * 16 + quad * 4) * 2 + 4);
                    const f32x4 ca = *(const f32x4*)(p.ROPE + (pc * 16 + quad * 4) * 2), cb = *(const f32x4*)(p.ROPE + (pc * 16 + quad * 4) * 2 + 4);
                    const f32x4 cr = f32x4{ra[0], ra[2], rb[0], rb[2]}, sr = f32x4{ra[1], ra[3], rb[1], rb[3]};
                    const f32x4 cq = f32x4{ca[0], ca[2], cb[0], cb[2]}, sq = f32x4{ca[1], ca[3], cb[1], cb[3]};
                    const f32x4 o0 = v0 * cr - v2 * sr, o2 = v0 * sr + v2 * cr, o1 = v1 * cq - v3 * sq, o3 = v1 * sq + v3 * cq;
                    v0 = o0; v1 = o1; v2 = o2; v3 = o3;
                }
                bf16_t* d = dst + (size_t)row * ld + cc + quad * 4;
                u32x2 w; w.x = pack2(v0[0], v0[1]); w.y = pack2(v0[2], v0[3]); *(u32x2*)d = w;
                w.x = pack2(v1[0], v1[1]); w.y = pack2(v1[2], v1[3]); *(u32x2*)(d + 16) = w;
                w.x = pack2(v2[0], v2[1]); w.y = pack2(v2[2], v2[3]); *(u32x2*)(d + 32) = w;
                w.x = pack2(v3[0], v3[1]); w.y = pack2(v3[2], v3[3]); *(u32x2*)(d + 48) = w;
            }
        }
    }
    DEV void operator()(f32x4 (&acc)[4][4], int wr, int wc, int lane) {
        const int r = lane & 15, quad = lane >> 4;
        const int c0 = col0 + wc * 64, rowb = row0 + wr * 64;
        const int b = row0 / TT; const int sb = rowb - b * TT; const bool lat = sb >= CTX;
        if (c0 < 512 || (c0 >= 1024 && c0 < 1536)) {
            bf16_t* dst; int ld, cc; float scl = 1.f;
            if (c0 < 256) { dst = p.Q2; ld = 256; cc = c0; } else if (c0 < 512) { dst = p.K2; ld = 256; cc = c0 - 256; scl = 0.125f; } else { dst = p.OG; ld = 512; cc = c0 - 1024; }
#pragma unroll
            for (int m = 0; m < 4; ++m)
#pragma unroll
                for (int j = 0; j < 4; ++j) {
                    const int row = rowb + m * 16 + quad * 4 + j; bf16_t* d = dst + (size_t)row * ld + cc + r;
                    d[0] = f2bf(acc[m][0][j] * scl); d[16] = f2bf(acc[m][1][j] * scl); d[32] = f2bf(acc[m][2][j] * scl); d[48] = f2bf(acc[m][3][j] * scl);
                }
        } else if (c0 < 1024) {
            const int cc = c0 - 512; const int h = cc >> 7, e0 = cc & 127; bf16_t* dst = p.V2T + ((size_t)(b * 4 + h) * 128) * TT;
#pragma unroll
            for (int m = 0; m < 4; ++m)
#pragma unroll
                for (int n = 0; n < 4; ++n) {
                    u32x2 o; o.x = pack2(acc[m][n][0], acc[m][n][1]); o.y = pack2(acc[m][n][2], acc[m][n][3]);
                    *(u32x2*)(dst + (size_t)(e0 + n * 16 + r) * TT + sb + m * 16 + quad * 4) = o;
                }
        } else if (c0 < 2176) {
            const bool isq = c0 < 2048; bf16_t* dst = isq ? p.Q1 : p.K1; const int ld = isq ? 512 : 128; const int cc = isq ? c0 - 1536 : c0 - 2048;
            const float* g = p.od_qk_g + ((layer >> 1) * 2 + (isq ? 0 : 1)) * 64;
            const float g0 = g[r], g1 = g[16 + r], g2 = g[32 + r], g3 = g[48 + r];
#pragma unroll
            for (int m = 0; m < 4; ++m)
#pragma unroll
                for (int j = 0; j < 4; ++j) {
                    const int row = rowb + m * 16 + quad * 4 + j;
                    float v0 = acc[m][0][j], v1 = acc[m][1][j], v2 = acc[m][2][j], v3 = acc[m][3][j];
                    float ss = v0 * v0 + v1 * v1 + v2 * v2 + v3 * v3;
                    ss = rowred_add(ss);
                    const float rs = 1.0f / sqrtf(ss * (1.f / 64.f) + EPS);
                    v0 *= rs * g0; v1 *= rs * g1; v2 *= rs * g2; v3 *= rs * g3;
                    if (lat) {
                        const int t = sb + m * 16 + quad * 4 + j - CTX; const int pr = t / GRID_W, pc = t % GRID_W;
                        const float cr = p.ROPE[(pr * 16 + r) * 2], sr = p.ROPE[(pr * 16 + r) * 2 + 1], cq = p.ROPE[(pc * 16 + r) * 2], sq = p.ROPE[(pc * 16 + r) * 2 + 1];
                        float o0 = v0 * cr - v2 * sr, o2 = v0 * sr + v2 * cr, o1 = v1 * cq - v3 * sq, o3 = v1 * sq + v3 * cq;
                        v0 = o0; v1 = o1; v2 = o2; v3 = o3;
                    }
                    bf16_t* d = dst + (size_t)row * ld + cc + r;
                    d[0] = f2bf(v0); d[16] = f2bf(v1); d[32] = f2bf(v2); d[48] = f2bf(v3);
                }
        } else {
            const int kv = (c0 - 2176) >> 6; bf16_t* dst = p.V1T + ((size_t)(b * HKV + kv) * 64) * TT;
#pragma unroll
            for (int m = 0; m < 4; ++m)
#pragma unroll
                for (int n = 0; n < 4; ++n) {
                    u32x2 o; o.x = pack2(acc[m][n][0], acc[m][n][1]); o.y = pack2(acc[m][n][2], acc[m][n][3]);
                    *(u32x2*)(dst + (size_t)(n * 16 + r) * TT + sb + m * 16 + quad * 4) = o;
                }
        }
    }
};

DEV void phaseA(const Params& p, int layer, unsigned char* smem) {
    const bool odd = layer & 1;
    const int ncol = odd ? ODD_IN / 256 : EVEN_INP / 256; const int nrow = NTOK / 128;
    const bf16_t* W = odd ? p.WinO + (size_t)(layer >> 1) * ODD_IN * D_MODEL : p.WinE + (size_t)(layer >> 1) * EVEN_INP * D_MODEL;
    const int bid = bid_(); const int tid = tid_(); const int trow = tid >> 2, lc8 = g2_lc(tid) * 8;
    if (odd && bid < NCHAIN && tid < 64) gate_chain<true>(p, layer, bid);
    const WorkRange wr = xcd_range(nrow * ncol, bid);
    for (int t = wr.lo; t < wr.hi; t += wr.step) {
        int rt, ct; dense_tile(t, nrow, ncol, rt, ct); const int row0 = rt * 128, col0 = ct * 256;
        const bf16_t* a0 = p.HIN + (size_t)(row0 + trow) * D_MODEL + lc8;
        const bf16_t* bb = W + (size_t)(col0 + trow) * D_MODEL + lc8;
        if (odd) {
            EpInOdd ep{p, layer, row0, col0};
            if (ct == 2 || ct == 3 || ct == 8) gemm_tile2<2, false>(smem, a0, a0 + (size_t)64 * D_MODEL, bb, D_MODEL, D_MODEL / 32, ep);
            else gemm_tile2<2, true>(smem, a0, a0 + (size_t)64 * D_MODEL, bb, D_MODEL, D_MODEL / 32, ep);
        } else {
            EpInEven ep{p, layer, row0, col0};
            if (ct == 4 || ct == 5 || ct == 10 || ct == 11) gemm_tile2<2, false>(smem, a0, a0 + (size_t)64 * D_MODEL, bb, D_MODEL, D_MODEL / 32, ep);
            else gemm_tile2<2, true>(smem, a0, a0 + (size_t)64 * D_MODEL, bb, D_MODEL, D_MODEL / 32, ep);
        }
    }
#ifdef PROBE_GEMM
    {
        Params q = p; bf16_t* scr = (bf16_t*)p.DC;
        q.Q1 = scr; q.K1 = scr; q.V1T = scr; q.PM = scr; q.V2T = scr; q.OG = scr; q.G = (float*)scr; q.Q2 = scr; q.K2 = scr;
        for (int t = wr.lo; t < wr.hi; t += wr.step) {
            int rt, ct; dense_tile(t, nrow, ncol, rt, ct); const int row0 = rt * 128, col0 = ct * 256;
            const bf16_t* a0 = p.HIN + (size_t)(row0 + trow) * D_MODEL + lc8;
            const bf16_t* bb = W + (size_t)(col0 + trow) * D_MODEL + lc8;
            const int erow0 = (PROBE_GEMM == 2) ? (row0 % TT >= CTX ? CTX : 0) : row0;
            if (odd) {
                EpInOdd ep{q, layer, erow0, col0};
                if (ct == 2 || ct == 3 || ct == 8) gemm_tile2<2, false>(smem, a0, a0 + (size_t)64 * D_MODEL, bb, D_MODEL, D_MODEL / 32, ep);
                else gemm_tile2<2, true>(smem, a0, a0 + (size_t)64 * D_MODEL, bb, D_MODEL, D_MODEL / 32, ep);
            } else {
                EpInEven ep{q, layer, erow0, col0};
                if (ct == 4 || ct == 5 || ct == 10 || ct == 11) gemm_tile2<2, false>(smem, a0, a0 + (size_t)64 * D_MODEL, bb, D_MODEL, D_MODEL / 32, ep);
                else gemm_tile2<2, true>(smem, a0, a0 + (size_t)64 * D_MODEL, bb, D_MODEL, D_MODEL / 32, ep);
            }
        }
    }
#endif
}
DEV void phase0b(const Params& p) {
    const int total = NTOK * (D_MODEL / 4);
    for (int idx = bid_() * 256 + tid_(); idx < total; idx += gridDim.x * 256) {
        const int row = idx / (D_MODEL / 4), k = (idx % (D_MODEL / 4)) * 4; const int b = row / TT, sq = row % TT; const int bb = sq < CTX ? BATCH : b;
        const float* mod = p.MOD + (size_t)bb * 6 * D_MODEL;
        const f32x4 x = bf4(*(const u32x2*)(p.X + (size_t)row * D_MODEL + k)), sh = *(const f32x4*)(mod + k), sc = *(const f32x4*)(mod + D_MODEL + k);
        u32x2 o; o.x = pack2(x.x * (1.f + sc.x) + sh.x, x.y * (1.f + sc.y) + sh.y); o.y = pack2(x.z * (1.f + sc.z) + sh.z, x.w * (1.f + sc.w) + sh.w);
        *(u32x2*)(p.HIN + (size_t)row * D_MODEL + k) = o;
    }
}

DEV void phaseB(const Params& p, int layer) {
    const int tid = tid_();
    const int bid = bid_();
    if (bid < NCHAIN && tid < 64) gate_chain<false>(p, layer, bid);
    const float* cw = p.ev_conv_w + (size_t)(layer >> 1) * 3 * 1024; const float* cb = p.ev_conv_b + (size_t)(layer >> 1) * 1024;
    const int total = NTOK * 128;
    for (int idx = bid * 256 + tid; idx < total; idx += gridDim.x * 256) {
        const int row = idx >> 7, cg8 = (idx & 127) * 8; const int b = row / TT, s = row % TT;
        const bool hasp = (s != 0) && (s != CTX), hasn = (s != CTX - 1) && (s != TT - 1);
        Frag xm, x0, xp; x0.q = *(const u32x4*)(p.PM + (size_t)row * 1024 + cg8);
        xm.q = u32x4{0u, 0u, 0u, 0u}; xp.q = u32x4{0u, 0u, 0u, 0u};
        if (hasp) xm.q = *(const u32x4*)(p.PM + (size_t)(row - 1) * 1024 + cg8);
        if (hasn) xp.q = *(const u32x4*)(p.PM + (size_t)(row + 1) * 1024 + cg8);
        float y[8];
#pragma unroll
        for (int i = 0; i < 8; ++i) {
            const int ch = cg8 + i;
            float v = cb[ch] + bf2f((bf16_t)xm.v[i]) * cw[ch] + bf2f((bf16_t)x0.v[i]) * cw[1024 + ch] + bf2f((bf16_t)xp.v[i]) * cw[2048 + ch];
            y[i] = siluf(v);
        }
        if (cg8 < 512) {
            u32x4 o; o.x = pack2(y[0], y[1]); o.y = pack2(y[2], y[3]); o.z = pack2(y[4], y[5]); o.w = pack2(y[6], y[7]);
            *(u32x4*)(p.Q2 + (size_t)row * 512 + cg8) = o;
        } else {
            const float sc = 0.08838834764831845f;
#pragma unroll
            for (int i = 0; i < 8; ++i) y[i] *= sc;
            u32x4 o; o.x = pack2(y[0], y[1]); o.y = pack2(y[2], y[3]); o.z = pack2(y[4], y[5]); o.w = pack2(y[6], y[7]);
            const int kc = cg8 - 512; *(u32x4*)(p.K2 + (size_t)row * 512 + kc) = o;
        }
    }
}

constexpr int KLD1 = 136, KLD0 = 72, VLD = 72;
template <int NC, int DV, int QT>
struct AttnState { f32x4 O[NC][DV / 16][QT]; f32x4 L[NC][QT]; float m[NC][QT]; };

DEV float max3f(float a, float b, float c) {
#ifdef CPU_EMU
    return fmaxf(fmaxf(a, b), c);
#else
    float d; asm("v_max3_f32 %0, %1, %2, %3" : "=v"(d) : "v"(a), "v"(b), "v"(c)); return d;
#endif
}
DEV float max2f(float a, float b) {
#ifdef CPU_EMU
    return fmaxf(a, b);
#else
    float d; asm("v_max_f32 %0, %1, %2" : "=v"(d) : "v"(a), "v"(b)); return d;
#endif
}
DEV bool wave_any(bool pr) {
#ifdef CPU_EMU
    int v = pr ? 1 : 0; for (int m = 1; m < 64; m <<= 1) v |= __shfl_xor(v, m); return v != 0;
#else
    return __builtin_amdgcn_ballot_w64(pr) != 0;
#endif
}

template <int NC, int DV, int QT, int KW>
DEV void attn_core(bf16_t* sm, const bf16_t* Kg, int ldk, const bf16_t* VTg, int nkeys, const Frag (&qf)[NC][2][QT], AttnState<NC, DV, QT>& st, float sc2, int koff) {
    constexpr int KLD = KW + 8;
    constexpr int NKR = KW / 32, NVR = DV / 32;
    constexpr int KBUF = 64 * KLD, VBUF = DV * VLD;
    constexpr float TH = 6.0f;
    const float isc2 = 1.0f / sc2;
    const int tid = tid_(), lane = tid & 63, r = lane & 15, quad = lane >> 4;
    u32x4 kreg[NKR], vreg[NVR];
    constexpr int VTPR = 8 / NVR;
    const bf16_t* kp = Kg + (size_t)(tid >> 2) * ldk + (tid & 3) * NKR * 8;
    const bf16_t* vp0 = VTg + (size_t)(tid / VTPR) * TT + (tid % VTPR) * NVR * 8;
    const int klo = (tid >> 2) * KLD + (tid & 3) * NKR * 8;
    const int nt = nkeys >> 6;
    Frag ones; ones.u[0] = ones.u[1] = ones.u[2] = ones.u[3] = 0x3F803F80u;
    auto loadK = [&]() {
#pragma unroll
        for (int i = 0; i < NKR; ++i) kreg[i] = *(const u32x4*)(kp + i * 8);
        kp += (size_t)64 * ldk; };
    auto loadV = [&]() {
#pragma unroll
        for (int i = 0; i < NVR; ++i) vreg[i] = *(const u32x4*)(vp0 + i * 8);
        vp0 += 64; };
    auto storeK = [&](int buf) {
#pragma unroll
        for (int i = 0; i < NKR; ++i) *(u32x4*)(sm + buf * KBUF + klo + i * 8) = kreg[i]; };
    auto storeV = [&](int buf) {
        bf16_t* vrow = sm + buf * VBUF + 2 * KBUF + (tid / VTPR) * VLD;
#pragma unroll
        for (int i = 0; i < NVR; ++i) {
            const int c = (tid % VTPR) * NVR + i;
#pragma unroll
            for (int hh = 0; hh < 2; ++hh) {
                const int g = 2 * c + hh; const int blk = g >> 3, g32 = g & 7; const int pos = blk * 32 + (2 * (g32 & 3) + (g32 >> 2)) * 4;
                u32x2 w; w.x = hh ? vreg[i].z : vreg[i].x; w.y = hh ? vreg[i].w : vreg[i].y;
                *(u32x2*)(vrow + pos) = w;
            }
        } };
    float al[QT], thr[QT], mxs[QT]; bool resc = false;
#pragma unroll
    for (int qt = 0; qt < QT; ++qt) { al[qt] = 1.f; thr[qt] = 0.f; mxs[qt] = 0.f; }
    auto sm_step = [&](int k, f32x4 (&sn)[4][QT], Frag (&pfn)[QT][2], const bool force) {
        if (k < QT) {
            const int qt = k;
            float mx = max3f(sn[0][qt][0], sn[0][qt][1], sn[0][qt][2]);
            mx = max3f(mx, sn[0][qt][3], sn[1][qt][0]); mx = max3f(mx, sn[1][qt][1], sn[1][qt][2]); mx = max3f(mx, sn[1][qt][3], sn[2][qt][0]);
            mx = max3f(mx, sn[2][qt][1], sn[2][qt][2]); mx = max3f(mx, sn[2][qt][3], sn[3][qt][0]); mx = max3f(mx, sn[3][qt][1], sn[3][qt][2]);
            mxs[qt] = max2f(mx, sn[3][qt][3]);
        } else if (k == QT) {
            bool need = false;
#pragma unroll
            for (int qt = 0; qt < QT; ++qt) need = need || (mxs[qt] > thr[qt]);
            if (force || wave_any(need)) {
#pragma unroll
                for (int qt = 0; qt < QT; ++qt) {
                    float mx = xmax16(mxs[qt]); mx = xmax32(mx);
                    const float mn = fmaxf(st.m[0][qt], mx * sc2);
                    al[qt] *= __builtin_amdgcn_exp2f(st.m[0][qt] - mn);
                    st.m[0][qt] = mn; thr[qt] = (mn + TH) * isc2;
                }
                resc = true;
            }
        } else if (k <= 5 * QT) {
            const int qt = (k - QT - 1) >> 2, kt = (k - QT - 1) & 3; const float mn = st.m[0][qt];
#pragma unroll
            for (int jj = 0; jj < 4; ++jj) sn[kt][qt][jj] = __builtin_amdgcn_exp2f(sn[kt][qt][jj] * sc2 - mn);
        } else if (k <= 7 * QT) {
            const int qt = (k - 5 * QT - 1) >> 1, kk = (k - 5 * QT - 1) & 1;
            pfn[qt][kk].u[0] = pack2(sn[2 * kk][qt][0], sn[2 * kk][qt][1]); pfn[qt][kk].u[1] = pack2(sn[2 * kk][qt][2], sn[2 * kk][qt][3]);
            pfn[qt][kk].u[2] = pack2(sn[2 * kk + 1][qt][0], sn[2 * kk + 1][qt][1]); pfn[qt][kk].u[3] = pack2(sn[2 * kk + 1][qt][2], sn[2 * kk + 1][qt][3]);
#ifndef CPU_EMU
            asm volatile("" : "+v"(pfn[qt][kk].u[0]), "+v"(pfn[qt][kk].u[1]), "+v"(pfn[qt][kk].u[2]), "+v"(pfn[qt][kk].u[3]));
#endif
        }
    };
    constexpr int NSM = 7 * QT + 1;
    auto rescale = [&]() {
        if (resc) {
#pragma unroll
            for (int qt = 0; qt < QT; ++qt) {
#pragma unroll
                for (int et = 0; et < DV / 16; ++et) { st.O[0][et][qt][0] *= al[qt]; st.O[0][et][qt][1] *= al[qt]; st.O[0][et][qt][2] *= al[qt]; st.O[0][et][qt][3] *= al[qt]; }
                st.L[0][qt][0] *= al[qt]; st.L[0][qt][1] *= al[qt]; st.L[0][qt][2] *= al[qt]; st.L[0][qt][3] *= al[qt];
                al[qt] = 1.f;
            }
            resc = false;
        }
    };
    auto pv = [&](int buf, const Frag (&pf)[QT][2]) {
        const bf16_t* Vs = sm + 2 * KBUF + buf * VBUF;
#pragma unroll
        for (int kk = 0; kk < 2; ++kk)
#pragma unroll
            for (int qt = 0; qt < QT; ++qt) st.L[0][qt] = mfma16(ones.v, pf[qt][kk].v, st.L[0][qt]);
#pragma unroll
        for (int et = 0; et < DV / 16; ++et) {
#pragma unroll
            for (int kk = 0; kk < 2; ++kk) {
                Frag vf; vf.q = *(const u32x4*)(Vs + (et * 16 + r) * VLD + kk * 32 + quad * 8);
#pragma unroll
                for (int qt = 0; qt < QT; ++qt) st.O[0][et][qt] = mfma16(vf.v, pf[qt][kk].v, st.O[0][et][qt]);
            }
        } };
    Frag pfa[QT][2], pfb[QT][2];
    loadK();
    __syncthreads();
    storeK(0);
    loadK();
    loadV();
    __syncthreads();
    {
        f32x4 s0[4][QT];
        const bf16_t* Ks = sm;
#pragma unroll
        for (int kt = 0; kt < 4; ++kt) {
            Frag ka0, ka1;
            ka0.q = *(const u32x4*)(Ks + (kt * 16 + r) * KLD + koff + quad * 8);
            ka1.q = *(const u32x4*)(Ks + (kt * 16 + r) * KLD + koff + 32 + quad * 8);
#pragma unroll
            for (int qt = 0; qt < QT; ++qt) {
                f32x4 z = f32x4{0.f, 0.f, 0.f, 0.f};
                z = mfma16(ka0.v, qf[0][0][qt].v, z); z = mfma16(ka1.v, qf[0][1][qt].v, z); s0[kt][qt] = z;
            }
        }
#pragma unroll
        for (int k = 0; k < NSM; ++k) sm_step(k, s0, pfa, true);
    }
    storeK(1);
    storeV(0);
    __syncthreads();
    auto body = [&](const int par, const Frag (&pin)[QT][2], Frag (&pout)[QT][2]) {
        f32x4 sn[4][QT];
        rescale();
        {
            const bf16_t* Ks = sm + ((par + 1) & 1) * KBUF + r * KLD + koff + quad * 8;
            Frag ka[2][2];
            ka[0][0].q = *(const u32x4*)(Ks); ka[0][1].q = *(const u32x4*)(Ks + 32);
#pragma unroll
            for (int kt = 0; kt < 4; ++kt) {
                if (kt < 3) { ka[(kt + 1) & 1][0].q = *(const u32x4*)(Ks + (kt + 1) * 16 * KLD); ka[(kt + 1) & 1][1].q = *(const u32x4*)(Ks + (kt + 1) * 16 * KLD + 32); }
#pragma unroll
                for (int qt = 0; qt < QT; ++qt) {
                    f32x4 z = f32x4{0.f, 0.f, 0.f, 0.f};
                    z = mfma16(ka[kt & 1][0].v, qf[0][0][qt].v, z);
                    z = mfma16(ka[kt & 1][1].v, qf[0][1][qt].v, z); sn[kt][qt] = z;
                }
                if (kt < 2) {
#pragma unroll
                    for (int qt = 0; qt < QT; ++qt) st.L[0][qt] = mfma16(ones.v, pin[qt][kt].v, st.L[0][qt]);
                }
                SCHED_BARRIER();
            }
        }
        {
            const bf16_t* Vs = sm + 2 * KBUF + (par & 1) * VBUF + r * VLD + quad * 8;
            constexpr int NPV = (DV / 16) * 2; constexpr int SPP = (NSM + NPV - 1) / NPV;
            Frag vf[2];
            vf[0].q = *(const u32x4*)Vs;
#pragma unroll
            for (int i = 0; i < NPV; ++i) {
                const int et = i >> 1, kk = i & 1;
                if (i + 1 < NPV) vf[(i + 1) & 1].q = *(const u32x4*)(Vs + ((i + 1) >> 1) * 16 * VLD + ((i + 1) & 1) * 32);
#pragma unroll
                for (int qt = 0; qt < QT; ++qt) st.O[0][et][qt] = mfma16(vf[i & 1].v, pin[qt][kk].v, st.O[0][et][qt]);
#pragma unroll
                for (int q = 0; q < SPP; ++q) sm_step(i * SPP + q, sn, pout, false);
                SCHED_BARRIER();
            }
        }
    };
    int j = 0;
    for (; j + 2 < nt; j += 2) {
        loadK(); loadV();
        body(0, pfa, pfb);
        storeK(0); storeV(1);
        __syncthreads();
        loadK(); loadV();
        body(1, pfb, pfa);
        storeK(1); storeV(0);
        __syncthreads();
    }
    loadV(); body(0, pfa, pfb); storeV(1); __syncthreads();
    rescale();
    pv(1, pfb);
    __syncthreads();
}

DEV void attn_diff_item(const Params& p, int layer, int item, bf16_t* sm) {
    const int nqb = TT / 64; const int qb = item % nqb, h = (item / nqb) % HA, b = item / (nqb * HA);
    const int tid = tid_(), wid = tid >> 6, lane = tid & 63, r = lane & 15, quad = lane >> 4;
    const int comp = wid & 1, rg = wid >> 1;
    const int s0 = qb * 64; const bool ctxq = s0 < CTX; const int nkeys = ctxq ? CTX : TT;
    Frag qf[1][2][2];
#pragma unroll
    for (int ks = 0; ks < 2; ++ks)
#pragma unroll
        for (int qt = 0; qt < 2; ++qt) qf[0][ks][qt].q = *(const u32x4*)(p.Q1 + ((size_t)b * TT + s0 + rg * 32 + qt * 16 + r) * 512 + h * 128 + comp * 64 + ks * 32 + quad * 8);
    AttnState<1, 128, 2> st;
#pragma unroll
    for (int qt = 0; qt < 2; ++qt) {
        st.m[0][qt] = -1.0e30f; st.L[0][qt] = f32x4{0.f, 0.f, 0.f, 0.f};
#pragma unroll
        for (int et = 0; et < 8; ++et) st.O[0][et][qt] = f32x4{0.f, 0.f, 0.f, 0.f};
    }
    attn_core<1, 128, 2, 128>(sm, p.K1 + (size_t)b * TT * 512 + h * 128, 512, p.V1T + ((size_t)(b * HA + h) * 128) * TT, nkeys, qf, st, 0.125f * 1.4426950408889634f, comp * 64);
    const float lam = p.LAM[layer >> 1]; const float lam_init = 0.8f - 0.6f * expf(-0.3f * (float)layer);
    const float* sg = p.ev_subln_g + (layer >> 1) * 128;
    f32x4* xo = (f32x4*)sm;
    __syncthreads();
    if (comp == 1) {
#pragma unroll
        for (int qt = 0; qt < 2; ++qt) {
            const float i2 = lam / st.L[0][qt][0];
#pragma unroll
            for (int et = 0; et < 8; ++et) xo[((rg * 2 + qt) * 8 + et) * 64 + lane] = f32x4{st.O[0][et][qt][0] * i2, st.O[0][et][qt][1] * i2, st.O[0][et][qt][2] * i2, st.O[0][et][qt][3] * i2};
        }
    }
    __syncthreads();
    if (comp == 0) {
#pragma unroll
        for (int qt = 0; qt < 2; ++qt) {
            const float i1 = 1.f / st.L[0][qt][0];
            float ss = 0.f; f32x4 o[8];
#pragma unroll
            for (int et = 0; et < 8; ++et) {
                const f32x4 x2 = xo[((rg * 2 + qt) * 8 + et) * 64 + lane];
#pragma unroll
                for (int j = 0; j < 4; ++j) { float v = st.O[0][et][qt][j] * i1 - x2[j]; o[et][j] = v; ss += v * v; }
            }
            ss = xadd16(ss); ss = xadd32(ss);
            const float rs = (1.f - lam_init) / sqrtf(ss * (1.f / 128.f) + EPS);
            bf16_t* dst = p.CAT + ((size_t)b * TT + s0 + rg * 32 + qt * 16 + r) * 1024 + h * 128;
#pragma unroll
            for (int et = 0; et < 8; ++et) {
                const int e = et * 16 + quad * 4;
                u32x2 w; w.x = pack2(o[et][0] * rs * sg[e], o[et][1] * rs * sg[e + 1]); w.y = pack2(o[et][2] * rs * sg[e + 2], o[et][3] * rs * sg[e + 3]);
                *(u32x2*)(dst + e) = w;
            }
        }
    }
}

DEV void attn_gqa_item(const Params& p, int item, bf16_t* sm) {
    const int nqb = TT / 32; const int qb = item % nqb, kv = (item / nqb) % HKV, b = item / (nqb * HKV);
    const int tid = tid_(), wid = tid >> 6, lane = tid & 63, r = lane & 15, quad = lane >> 4;
    const int s0 = qb * 32; const bool ctxq = s0 < CTX; const int nkeys = ctxq ? CTX : TT; const int hq = kv * 4 + wid;
    Frag qf[1][2][2];
#pragma unroll
    for (int ks = 0; ks < 2; ++ks)
#pragma unroll
        for (int qt = 0; qt < 2; ++qt) qf[0][ks][qt].q = *(const u32x4*)(p.Q1 + ((size_t)b * TT + s0 + qt * 16 + r) * 512 + hq * 64 + ks * 32 + quad * 8);
    AttnState<1, 64, 2> st;
#pragma unroll
    for (int qt = 0; qt < 2; ++qt) {
        st.m[0][qt] = -1.0e30f; st.L[0][qt] = f32x4{0.f, 0.f, 0.f, 0.f};
#pragma unroll
        for (int et = 0; et < 4; ++et) st.O[0][et][qt] = f32x4{0.f, 0.f, 0.f, 0.f};
    }
    attn_core<1, 64, 2, 64>(sm, p.K1 + (size_t)b * TT * 128 + kv * 64, 128, p.V1T + ((size_t)(b * HKV + kv) * 64) * TT, nkeys, qf, st, 0.125f * 1.4426950408889634f, 0);
#pragma unroll
    for (int qt = 0; qt < 2; ++qt) {
        const float il = 1.f / st.L[0][qt][0];
        bf16_t* dst = p.CAT + ((size_t)b * TT + s0 + qt * 16 + r) * 1024 + 512 + hq * 64;
#pragma unroll
        for (int et = 0; et < 4; ++et) {
            const int e = et * 16 + quad * 4;
            u32x2 w; w.x = pack2(st.O[0][et][qt][0] * il, st.O[0][et][qt][1] * il); w.y = pack2(st.O[0][et][qt][2] * il, st.O[0][et][qt][3] * il);
            *(u32x2*)(dst + e) = w;
        }
    }
}

template <int DK, bool NRM>
DEV void rec_dc_item(const Params& p, int item, bf16_t* sm) {
    constexpr int ET = NRM ? 9 : 8; constexpr int ER = NRM ? EVR : 128; constexpr int SLD = 136;
    const int chain = item / NCH, sp = item % NCH; const int dir = chain & 1, h = (chain >> 1) & 3, b = chain >> 3;
    const int u = chunk_of(dir, sp), sbase = u * CH;
    const int tid = tid_(), wid = tid >> 6, lane = tid & 63, r = lane & 15, quad = lane >> 4;
    bf16_t* Vs = sm; bf16_t* Ks = sm + 128 * SLD; float* wk = (float*)(sm + 128 * SLD + DK * SLD);
    __syncthreads();
    const float* ms = p.MS + ((size_t)chain * NCH + sp) * 4;
    if (tid < 128) wk[tid] = __expf(ms[2] + p.AT[(size_t)chain * TT + sbase + tid] - ms[1]);
    const bf16_t* vt = p.V2T + ((size_t)(b * 4 + h) * 128) * TT + sbase;
    for (int c = tid; c < 128 * 16; c += 256) { int row = c >> 4, kc = c & 15; *(u32x4*)(Vs + row * SLD + kc * 8) = *(const u32x4*)(vt + (size_t)row * TT + kc * 8); }
    __syncthreads();
    const bf16_t* kg = p.K2 + ((size_t)b * TT + sbase) * (4 * DK) + h * DK;
    for (int c = tid; c < 128 * (DK / 8); c += 256) {
        const int sl = c & 127, dc8 = (c >> 7) * 8; Frag f; f.q = *(const u32x4*)(kg + (size_t)sl * (4 * DK) + dc8);
        const float w = wk[sl];
#pragma unroll
        for (int i = 0; i < 8; ++i) Ks[(dc8 + i) * SLD + sl] = f2bf(bf2f((bf16_t)f.v[i]) * w);
    }
    __syncthreads();
    constexpr int NTW = DK / 64;
    f32x4 acc[ET][NTW];
#pragma unroll
    for (int et = 0; et < ET; ++et)
#pragma unroll
        for (int n = 0; n < NTW; ++n) acc[et][n] = f32x4{0.f, 0.f, 0.f, 0.f};
#pragma unroll
    for (int ks = 0; ks < 4; ++ks) {
        Frag bf[NTW];
#pragma unroll
        for (int n = 0; n < NTW; ++n) bf[n].q = *(const u32x4*)(Ks + ((wid + 4 * n) * 16 + r) * SLD + ks * 32 + quad * 8);
#pragma unroll
        for (int et = 0; et < ET; ++et) {
            Frag af;
            if (et < 8) af.q = *(const u32x4*)(Vs + (et * 16 + r) * SLD + ks * 32 + quad * 8);
            else { const unsigned one = (r == 0) ? 0x3F803F80u : 0u; af.q = u32x4{one, one, one, one}; }
#pragma unroll
            for (int n = 0; n < NTW; ++n) acc[et][n] = mfma16(af.v, bf[n].v, acc[et][n]);
        }
    }
    bf16_t* dc = p.DC + ((size_t)chain * NCH + sp) * ER * DK;
#pragma unroll
    for (int et = 0; et < ET; ++et)
#pragma unroll
        for (int n = 0; n < NTW; ++n)
#pragma unroll
            for (int j = 0; j < 4; ++j) dc[(size_t)(et * 16 + quad * 4 + j) * DK + (wid + 4 * n) * 16 + r] = f2bf(acc[et][n][j]);
}

template <int DK, bool NRM>
DEV void rec_scan(const Params& p) {
    constexpr int ER = NRM ? EVR : 128;
    const int total = NCHAIN * ER * DK;
    for (int idx = bid_() * 256 + tid_(); idx < total; idx += gridDim.x * 256) {
        const int chain = idx / (ER * DK), el = idx % (ER * DK);
        float c = 0.f;
        for (int sp = 0; sp < NCH; ++sp) {
            const size_t o = ((size_t)chain * NCH + sp) * ER * DK + el;
            p.CP[o] = f2bf(c);
            c = p.MS[((size_t)chain * NCH + sp) * 4 + 3] * c + bf2f(p.DC[o]);
        }
    }
}

template <int DK, bool NRM>
DEV void rec_out_item(const Params& p, int layer, int item, bf16_t* sm) {
    constexpr int ET = NRM ? 9 : 8; constexpr int ER = NRM ? EVR : 128; constexpr int KLD = DK + 8; constexpr int SLD = 136; constexpr int NKS = DK / 32;
    const int half = item & 1, u = (item >> 1) % NCH, h = ((item >> 1) / NCH) & 3, b = (item >> 1) / (NCH * 4);
    const int tid = tid_(), wid = tid >> 6, lane = tid & 63, r = lane & 15, quad = lane >> 4;
    const int sbase = u * CH; const int tl = half * 64 + wid * 16 + r;
    const size_t rowt = (size_t)b * TT + sbase + tl; const int tq = tl - quad * 4;
    bf16_t* RA = sm; bf16_t* Vs = sm + ER * KLD; float* as_ = (float*)(Vs + 128 * SLD);
    __syncthreads();
    const bf16_t* kg = p.K2 + ((size_t)b * TT + sbase) * (4 * DK) + h * DK;
    for (int c = tid; c < 128 * (DK / 8); c += 256) { int row = c / (DK / 8), kc = c % (DK / 8); *(u32x4*)(RA + row * KLD + kc * 8) = *(const u32x4*)(kg + (size_t)row * (4 * DK) + kc * 8); }
    const int chain0 = (b * 4 + h) * 2;
    as_[tid] = p.AT[(size_t)(chain0 + (tid >> 7)) * TT + sbase + (tid & 127)];
    Frag qf[NKS];
#pragma unroll
    for (int ks = 0; ks < NKS; ++ks) qf[ks].q = *(const u32x4*)(p.Q2 + rowt * (4 * DK) + h * DK + ks * 32 + quad * 8);
    __syncthreads();
    f32x4 sT[8];
#pragma unroll
    for (int st = 0; st < 8; ++st) {
        if ((st & 1) == 0) SCHED_BARRIER();
        f32x4 z = f32x4{0.f, 0.f, 0.f, 0.f};
#pragma unroll
        for (int ks = 0; ks < NKS; ++ks) { Frag ka; ka.q = *(const u32x4*)(RA + (st * 16 + r) * KLD + ks * 32 + quad * 8); z = mfma16(ka.v, qf[ks].v, z); }
        sT[st] = z;
    }
    __syncthreads();
    const bf16_t* vt = p.V2T + ((size_t)(b * 4 + h) * 128) * TT + sbase;
    for (int c = tid; c < 128 * 16; c += 256) { int row = c >> 4, kc = c & 15; *(u32x4*)(Vs + row * SLD + kc * 8) = *(const u32x4*)(vt + (size_t)row * TT + kc * 8); }
    f32x4 hs[8];
#pragma unroll
    for (int et = 0; et < 8; ++et) hs[et] = f32x4{0.f, 0.f, 0.f, 0.f};
#pragma unroll 1
    for (int dir = 0; dir < 2; ++dir) {
        const int chain = chain0 + dir; const int sp = sp_of(dir, u);
        if (dir) __syncthreads();
        const bf16_t* cp = p.CP + ((size_t)chain * NCH + sp) * ER * DK;
        for (int c = tid; c < ER * (DK / 8); c += 256) { int row = c / (DK / 8), kc = c % (DK / 8); *(u32x4*)(RA + row * KLD + kc * 8) = *(const u32x4*)(cp + (size_t)row * DK + kc * 8); }
        __syncthreads();
        const float bt = p.BC[(size_t)chain * TT + sbase + tl], mt = p.MT[(size_t)chain * TT + sbase + tl];
        const float mprev = p.MS[((size_t)chain * NCH + sp) * 4];
        const float winter = __expf(bt + mprev - mt); const float ct = bt - mt;
        f32x4 acc[ET];
#pragma unroll
        for (int et = 0; et < ET; ++et) {
            if ((et & 1) == 0) SCHED_BARRIER();
            f32x4 z = f32x4{0.f, 0.f, 0.f, 0.f};
#pragma unroll
            for (int ks = 0; ks < NKS; ++ks) { Frag ca; ca.q = *(const u32x4*)(RA + (et * 16 + r) * KLD + ks * 32 + quad * 8); z = mfma16(ca.v, qf[ks].v, z); }
            acc[et] = f32x4{z[0] * winter, z[1] * winter, z[2] * winter, z[3] * winter};
        }
#pragma unroll
        for (int kk = 0; kk < 4; ++kk) {
            SCHED_BARRIER();
            Frag pf;
#pragma unroll
            for (int hf = 0; hf < 2; ++hf) {
                const int st = 2 * kk + hf; float w[4];
#pragma unroll
                for (int j = 0; j < 4; ++j) {
                    const int s = st * 16 + quad * 4 + j; const bool ok = dir ? ((st * 16 + j) >= tq) : ((st * 16 + j) <= tq);
                    w[j] = ok ? sT[st][j] * __expf(ct + as_[dir * 128 + s]) : 0.f;
                }
                pf.u[2 * hf] = pack2(w[0], w[1]); pf.u[2 * hf + 1] = pack2(w[2], w[3]);
            }
#pragma unroll
            for (int et = 0; et < ET; ++et) {
                Frag vf;
                if (et < 8) { const bf16_t* vp = Vs + (et * 16 + r) * SLD + kk * 32 + quad * 4; vf.d[0] = *(const u32x2*)vp; vf.d[1] = *(const u32x2*)(vp + 16); }
                else { const unsigned one = (r == 0) ? 0x3F803F80u : 0u; vf.q = u32x4{one, one, one, one}; }
                acc[et] = mfma16(vf.v, pf.v, acc[et]);
            }
        }
        if (NRM) {
            float den = lane_read(acc[ET - 1][0], r, lane);
            const float dn = 1.f / fmaxf(fabsf(den), __expf(-mt));
#pragma unroll
            for (int et = 0; et < 8; ++et) { hs[et][0] += acc[et][0] * dn; hs[et][1] += acc[et][1] * dn; hs[et][2] += acc[et][2] * dn; hs[et][3] += acc[et][3] * dn; }
        } else {
#pragma unroll
            for (int et = 0; et < 8; ++et) { hs[et][0] += acc[et][0]; hs[et][1] += acc[et][1]; hs[et][2] += acc[et][2]; hs[et][3] += acc[et][3]; }
        }
    }
    if (NRM) {
        const bf16_t* og = p.OG + rowt * 512 + h * 128; const float* g = p.ev_mnorm_g + (layer >> 1) * 512 + h * 128;
        float sum = 0.f;
#pragma unroll
        for (int et = 0; et < 8; ++et) {
            const u32x2 gq = *(const u32x2*)(og + et * 16 + quad * 4);
            hs[et][0] *= sigmf(bf2f((bf16_t)(gq.x & 0xFFFF))); hs[et][1] *= sigmf(bf2f((bf16_t)(gq.x >> 16)));
            hs[et][2] *= sigmf(bf2f((bf16_t)(gq.y & 0xFFFF))); hs[et][3] *= sigmf(bf2f((bf16_t)(gq.y >> 16)));
            sum += hs[et][0] + hs[et][1] + hs[et][2] + hs[et][3];
        }
        sum = xadd16(sum); sum = xadd32(sum);
        const float mu = sum * (1.f / 128.f); float var = 0.f;
#pragma unroll
        for (int et = 0; et < 8; ++et)
#pragma unroll
            for (int j = 0; j < 4; ++j) { float d = hs[et][j] - mu; var += d * d; }
        var = xadd16(var); var = xadd32(var);
        const float rs = 1.f / sqrtf(var * (1.f / 128.f) + EPS);
        bf16_t* dst = p.CAT + rowt * 1024 + 512 + h * 128;
#pragma unroll
        for (int et = 0; et < 8; ++et) {
            const int e = et * 16 + quad * 4;
            u32x2 w; w.x = pack2((hs[et][0] - mu) * rs * g[e], (hs[et][1] - mu) * rs * g[e + 1]); w.y = pack2((hs[et][2] - mu) * rs * g[e + 2], (hs[et][3] - mu) * rs * g[e + 3]);
            *(u32x2*)(dst + e) = w;
        }
    } else {
        const bf16_t* og = p.OG + rowt * 512 + h * 128;
        float ss = 0.f;
#pragma unroll
        for (int et = 0; et < 8; ++et)
#pragma unroll
            for (int j = 0; j < 4; ++j) ss += hs[et][j] * hs[et][j];
        ss = xadd16(ss); ss = xadd32(ss);
        const float rs = 1.f / sqrtf(ss * (1.f / 128.f) + EPS);
        bf16_t* dst = p.CAT + rowt * 1024 + h * 128;
#pragma unroll
        for (int et = 0; et < 8; ++et) {
            const int e = et * 16 + quad * 4; const u32x2 gq = *(const u32x2*)(og + e);
            u32x2 w; w.x = pack2(hs[et][0] * rs * siluf(bf2f((bf16_t)(gq.x & 0xFFFF))), hs[et][1] * rs * siluf(bf2f((bf16_t)(gq.x >> 16))));
            w.y = pack2(hs[et][2] * rs * siluf(bf2f((bf16_t)(gq.y & 0xFFFF))), hs[et][3] * rs * siluf(bf2f((bf16_t)(gq.y >> 16))));
            *(u32x2*)(dst + e) = w;
        }
    }
}

DEV void phaseC(const Params& p, int layer, unsigned char* smem) {
    const bool odd = layer & 1; const bool with_ctx = layer < DEPTH - 1;
    bf16_t* sm = (bf16_t*)smem;
    const int nqb_l = odd ? SEQ / 32 : SEQ / 64, nqb_c = odd ? CTX / 32 : CTX / 64; const int nh = odd ? HKV : HA;
    const int n_lat = BATCH * nh * nqb_l, n_ctx = with_ctx ? BATCH * nh * nqb_c : 0; const int n_dc = NCHAIN * NCH;
    for (int it = bid_(); it < n_lat + n_ctx + n_dc; it += gridDim.x) {
        if (it < n_lat + n_ctx) {
            int qb, bh;
            if (it < n_lat) {
                const int nbh = BATCH * nh;
                if ((nbh & 7) == 0 && (gridDim.x & 7) == 0) { const int x = it & 7, j = it >> 3; bh = (j / nqb_l) * 8 + x; qb = nqb_c + j % nqb_l; }
                else { qb = nqb_c + it % nqb_l; bh = it / nqb_l; }
            } else { int i2 = it - n_lat; qb = i2 % nqb_c; bh = i2 / nqb_c; }
            const int item = bh * (nqb_l + nqb_c) + qb;
            if (odd) attn_gqa_item(p, item, sm); else attn_diff_item(p, layer, item, sm);
        } else {
            const int item = it - n_lat - n_ctx;
            if (odd) rec_dc_item<64, false>(p, item, sm); else rec_dc_item<128, true>(p, item, sm);
        }
    }
}
DEV void phaseD(const Params& p, int layer) { if (layer & 1) rec_scan<64, false>(p); else rec_scan<128, true>(p); }
DEV void phaseE(const Params& p, int layer, unsigned char* smem) {
    const bool odd = layer & 1; const bool with_ctx = layer < DEPTH - 1;
    const int n = BATCH * 4 * NCH * 2;
    for (int it = bid_(); it < n; it += gridDim.x) {
        const int u = (it >> 1) % NCH; if (!with_ctx && u < NCC) continue;
        if (odd) rec_out_item<64, false>(p, layer, it, (bf16_t*)smem); else rec_out_item<128, true>(p, layer, it, (bf16_t*)smem);
    }
}

#ifdef CPU_EMU_SMALL
constexpr int FM_T = 16;
#else
constexpr int FM_T = 17;
#endif
constexpr int F_ROWS = 16 * FM_T, F_NA = 4 * F_ROWS, F_NCH = F_NA + 512, F_STAGE = F_NCH * 16, F_NJ = (F_NCH + 255) / 256;
static_assert(NTOK % F_ROWS == 0 && TT % F_ROWS == 0, "tall output-projection tiles must not straddle sequences");
static_assert(3 * F_STAGE <= LDS_BYTES - 16, "LDS ring of the tall tile");
DEV void phaseF(const Params& p, int layer, unsigned char* smem) {
    const bool with_ctx = layer < DEPTH - 1; const int ncol = D_MODEL / 128, nrow = NTOK / F_ROWS;
    const int tid = tid_(), wid = tid >> 6, lane = tid & 63, r = lane & 15, quad = lane >> 4;
    const int lc8 = g2_lc(tid) * 8;
    const WorkRange wr = xcd_range(nrow * ncol, bid_());
    for (int t = wr.lo; t < wr.hi; t += wr.step) {
        int rt, ct;
        if ((nrow & 7) == 0) { const int rpg = nrow >> 3; const int rg = t / (ncol * rpg), q = t % (ncol * rpg); ct = q / rpg; rt = rg * rpg + q % rpg; } else { rt = t / ncol; ct = t % ncol; }
        const int row0 = rt * F_ROWS, col0 = ct * 128; const int b = row0 / TT, s0 = row0 % TT;
        if (!with_ctx && s0 + F_ROWS <= CTX) continue;
        const bf16_t* abase = p.CAT + (size_t)(row0 + (tid >> 2)) * MIX_OUT + lc8;
        const bf16_t* bbase = p.WoutT + ((size_t)layer * D_MODEL + col0 + (tid >> 2)) * MIX_OUT + lc8;
        constexpr int JMIX = F_NA / 256;
        const bf16_t* mbase = (F_NA % 256 != 0 && tid < F_NA - 256 * JMIX) ? abase + (size_t)JMIX * 64 * MIX_OUT : bbase + (256 * JMIX - F_NA) / 4 * MIX_OUT;
        f32x4 acc[FM_T][2];
#pragma unroll
        for (int m = 0; m < FM_T; ++m) { acc[m][0] = f32x4{0.f, 0.f, 0.f, 0.f}; acc[m][1] = f32x4{0.f, 0.f, 0.f, 0.f}; }
        unsigned char* dst0 = smem + tid * 16;
        auto issue = [&](int kt, int slot) {
            unsigned char* d = dst0 + slot * F_STAGE;
#pragma unroll
            for (int j = 0; j < F_NJ; ++j) {
                if (256 * j + 255 < F_NA) glds16(abase + (size_t)j * 64 * MIX_OUT + kt * 32, d + j * 4096);
                else if (j == JMIX && F_NA % 256 != 0) glds16(mbase + kt * 32, d + j * 4096);
                else if (256 * j + 255 < F_NCH) glds16(bbase + (256 * j - F_NA) / 4 * MIX_OUT + kt * 32, d + j * 4096);
                else if (tid + 256 * j < F_NCH) glds16(bbase + (256 * j - F_NA) / 4 * MIX_OUT + kt * 32, d + j * 4096);
            }
        };
        constexpr int nkt = MIX_OUT / 32;
        RAW_BARRIER();
        issue(0, 0); issue(1, 1);
        const int pco = (quad ^ g2_h((r >> 2) & 3)) * 16;
        const unsigned char* afr = smem + r * 64 + pco;
        const unsigned char* bfr = smem + F_NA * 16 + (wid * 32 + r) * 64 + pco;
        int slot = 0;
        for (int kt = 0; kt < nkt; ++kt) {
            if (kt + 1 < nkt) wait_vm<6>(); else wait_vm<0>();
            RAW_BARRIER();
            if (kt + 2 < nkt) { int ns = slot + 2; if (ns >= 3) ns -= 3; issue(kt + 2, ns); }
            const unsigned char* as = afr + slot * F_STAGE; const unsigned char* bs = bfr + slot * F_STAGE;
            Frag b0, b1; b0.q = *(const u32x4*)bs; b1.q = *(const u32x4*)(bs + 16 * 64);
#ifndef CPU_EMU
            __builtin_amdgcn_s_setprio(1);
#endif
#pragma unroll
            for (int m = 0; m < FM_T; ++m) {
                Frag af; af.q = *(const u32x4*)(as + m * 16 * 64);
                acc[m][0] = mfma16(b0.v, af.v, acc[m][0]); acc[m][1] = mfma16(b1.v, af.v, acc[m][1]);
            }
#ifndef CPU_EMU
            __builtin_amdgcn_s_setprio(0);
#endif
            if (++slot == 3) slot = 0;
        }
        const float* gl = p.MOD + ((size_t)layer * (BATCH + 1) + b) * 6 * D_MODEL + 2 * D_MODEL; const float* gc = p.MOD + ((size_t)layer * (BATCH + 1) + BATCH) * 6 * D_MODEL + 2 * D_MODEL;
#pragma unroll
        for (int n = 0; n < 2; ++n) {
            const int col = col0 + wid * 32 + n * 16 + quad * 4; const f32x4 g_l = *(const f32x4*)(gl + col), g_c = *(const f32x4*)(gc + col);
#pragma unroll
            for (int m = 0; m < FM_T; ++m) {
                const int s = s0 + m * 16 + r; const bool isc = s < CTX;
                if (with_ctx || !isc) { u32x2* x = (u32x2*)(p.X + (size_t)(row0 + m * 16 + r) * D_MODEL + col); *x = pk4(ALPHA * bf4(*x) + (isc ? g_c : g_l) * acc[m][n]); }
                if ((m & 3) == 3) SCHED_BARRIER();
            }
        }
    }
}

constexpr int NV4 = D_MODEL / 256;
DEV void phaseG(const Params& p, int layer, unsigned char* smem) {
    const bool with_ctx = layer < DEPTH - 1;
    const int tid = tid_(); const int wid = tid >> 6, lane = tid & 63; const int bid = bid_();
    const float* lg = p.ln_g + (size_t)(layer * 2) * D_MODEL; const float* lb = p.ln_b + (size_t)(layer * 2) * D_MODEL;
    const float* wr = p.WrT + (size_t)layer * NR * D_MODEL;
    int* lcnt = (int*)smem; int* lbase = lcnt + 32; int* rec = lbase + 32;
    const int half = gridDim.x * 4, stride = half * 2;
    const int nit = (NTOK - bid * 4 + stride - 1) / stride;
    __syncthreads();
    if (tid < 32) lcnt[tid] = 0;
    for (int i = tid; i < nit * 8; i += 256) rec[i * 8] = -1;
    __syncthreads();
    int tok0 = bid * 4 + wid;
    for (int it = 0; tok0 < NTOK; tok0 += stride, ++it) {
        f32x4 v[2][NV4]; int tk[2]; bool ok[2]; const float* mod[2];
#pragma unroll
        for (int u = 0; u < 2; ++u) {
            const int tl = imin(tok0 + u * half, NTOK - 1);
#pragma unroll
            for (int i = 0; i < NV4; ++i) v[u][i] = bf4(*(const u32x2*)(p.X + (size_t)tl * D_MODEL + (i * 64 + lane) * 4));
            const int t = tok0 + u * half; const int tc = imin(t, NTOK - 1); const int b = tc / TT, sq = tc % TT;
            tk[u] = tc; ok[u] = (t < NTOK) && (with_ctx || sq >= CTX);
            mod[u] = p.MOD + ((size_t)layer * (BATCH + 1) + (sq < CTX ? BATCH : b)) * 6 * D_MODEL;
        }
        float mu[2], rs[2];
#pragma unroll
        for (int u = 0; u < 2; ++u) { float sum = 0.f;
#pragma unroll
            for (int i = 0; i < NV4; ++i) sum += v[u][i].x + v[u][i].y + v[u][i].z + v[u][i].w;
            mu[u] = sum; }
        { mu[0] = wsum(mu[0]); mu[1] = wsum(mu[1]); }
#pragma unroll
        for (int u = 0; u < 2; ++u) { mu[u] *= (1.f / D_MODEL); float var = 0.f;
#pragma unroll
            for (int i = 0; i < NV4; ++i) { float a = v[u][i].x - mu[u], bq = v[u][i].y - mu[u], c = v[u][i].z - mu[u], d = v[u][i].w - mu[u]; var += a * a + bq * bq + c * c + d * d; }
            rs[u] = var; }
        { rs[0] = wsum(rs[0]); rs[1] = wsum(rs[1]); }
        f32x4 hv[2][NV4];
#pragma unroll
        for (int u = 0; u < 2; ++u) {
            rs[u] = 1.f / sqrtf(rs[u] * (1.f / D_MODEL) + EPS);
            if (lane == 0 && ok[u]) { p.STAT[tk[u] * 2] = mu[u]; p.STAT[tk[u] * 2 + 1] = rs[u]; }
#pragma unroll
            for (int i = 0; i < NV4; ++i) {
                const int k = (i * 64 + lane) * 4;
                const f32x4 g4 = *(const f32x4*)(lg + k), b4 = *(const f32x4*)(lb + k), sh = *(const f32x4*)(mod[u] + 3 * D_MODEL + k), sc = *(const f32x4*)(mod[u] + 4 * D_MODEL + k);
                const f32x4 x1 = (v[u][i] - mu[u]) * rs[u] * g4 + b4;
                hv[u][i] = x1 * (1.f + sc) + sh;
                if (ok[u]) { u32x2 o; o.x = pack2(hv[u][i].x, hv[u][i].y); o.y = pack2(hv[u][i].z, hv[u][i].w); *(u32x2*)(p.H + (size_t)tk[u] * D_MODEL + k) = o; }
            }
        }
        float gl[2][NG];
#pragma unroll
        for (int j = 0; j < NG; ++j) {
#pragma unroll
            for (int u = 0; u < 2; ++u) { float a = 0.f;
#pragma unroll
                for (int i = 0; i < NV4; ++i) { const f32x4 w4 = *(const f32x4*)(wr + (size_t)j * D_MODEL + (i * 64 + lane) * 4); a += hv[u][i].x * w4.x + hv[u][i].y * w4.y + hv[u][i].z * w4.z + hv[u][i].w * w4.w; }
                gl[u][j] = a; }
        }
#pragma unroll
        for (int j = 0; j < NG; ++j) { gl[0][j] = wsum(gl[0][j]); gl[1][j] = wsum(gl[1][j]); }
        int gi[2]; float gw[2]; float ev[2][EPG];
#pragma unroll
        for (int u = 0; u < 2; ++u) {
#pragma unroll
            for (int j = 0; j < NG; ++j) gl[u][j] += p.moe_b_group[layer * NG + j];
            int g = 0; float gm = gl[u][0];
#pragma unroll
            for (int j = 1; j < NG; ++j) if (gl[u][j] > gm) { gm = gl[u][j]; g = j; }
            float gs = 0.f;
#pragma unroll
            for (int j = 0; j < NG; ++j) gs += expf(gl[u][j] - gm);
            gi[u] = g; gw[u] = 1.f / gs;
            const float* wre = wr + (size_t)(NG + g * EPG) * D_MODEL;
#pragma unroll
            for (int j = 0; j < EPG; ++j) { float a = 0.f;
#pragma unroll
                for (int i = 0; i < NV4; ++i) { const f32x4 w4 = *(const f32x4*)(wre + (size_t)j * D_MODEL + (i * 64 + lane) * 4); a += hv[u][i].x * w4.x + hv[u][i].y * w4.y + hv[u][i].z * w4.z + hv[u][i].w * w4.w; }
                ev[u][j] = a; }
        }
#pragma unroll
        for (int j = 0; j < EPG; ++j) { ev[0][j] = wsum(ev[0][j]); ev[1][j] = wsum(ev[1][j]); }
#pragma unroll
        for (int u = 0; u < 2; ++u) {
#pragma unroll
            for (int j = 0; j < EPG; ++j) ev[u][j] += p.moe_b_router[layer * NE + gi[u] * EPG + j];
            int i1 = 0; float v1 = ev[u][0];
#pragma unroll
            for (int j = 1; j < EPG; ++j) if (ev[u][j] > v1) { v1 = ev[u][j]; i1 = j; }
            int i2 = -1; float v2 = -3.0e38f;
#pragma unroll
            for (int j = 0; j < EPG; ++j) if (j != i1 && ev[u][j] > v2) { v2 = ev[u][j]; i2 = j; }
            const float e2 = expf(v2 - v1); const float w1 = gw[u] / (1.f + e2), w2 = gw[u] * e2 / (1.f + e2);
            if (lane == 0 && ok[u]) {
                const int ea = gi[u] * EPG + i1, eb = gi[u] * EPG + i2;
                const int ra = atomicAdd(lcnt + ea, 1), rb = atomicAdd(lcnt + eb, 1);
                int* rc = rec + ((it * 2 + u) * 4 + wid) * 8;
                rc[0] = tk[u]; rc[1] = ea; rc[2] = eb; rc[3] = ra; rc[4] = rb; rc[5] = (int)__float_as_uint(w1); rc[6] = (int)__float_as_uint(w2);
            }
        }
    }
    __syncthreads();
    if (tid < 32) { const int c = lcnt[tid]; lbase[tid] = c ? atomicAdd(p.CNT + (layer * NE + tid) * 32, c) : 0; }
    __syncthreads();
    for (int i = tid; i < nit * 8; i += 256) {
        const int* rc = rec + i * 8; const int tk = rc[0];
        if (tk >= 0) {
            const int ea = rc[1], eb = rc[2]; const int pa = lbase[ea] + rc[3], pb = lbase[eb] + rc[4];
            p.LIST[(size_t)ea * NTOK + pa] = tk * 2; p.LISTW[(size_t)ea * NTOK + pa] = __uint_as_float((unsigned)rc[5]);
            p.LIST[(size_t)eb * NTOK + pb] = tk * 2 + 1; p.LISTW[(size_t)eb * NTOK + pb] = __uint_as_float((unsigned)rc[6]);
        }
    }
}

struct EpGU {
    const Params& p; int slot0, nvalid, col0;
    DEV void nat(f32x4 (&acc)[4][4], int wr, int wc, int lane) {
        const int r = lane & 15, quad = lane >> 4; const int j0 = (col0 + wc * 64) >> 1;
#pragma unroll
        for (int m = 0; m < 4; ++m) {
            const int rl = wr * 64 + m * 16 + r;
            if (rl < nvalid) {
                bf16_t* d = p.ACT + (size_t)(slot0 + rl) * D_EXPERT + j0 + quad * 4;
#pragma unroll
                for (int n = 0; n < 2; ++n) {
                    u32x2 w; w.x = pack2(siluf(acc[m][n][0]) * acc[m][n + 2][0], siluf(acc[m][n][1]) * acc[m][n + 2][1]);
                    w.y = pack2(siluf(acc[m][n][2]) * acc[m][n + 2][2], siluf(acc[m][n][3]) * acc[m][n + 2][3]);
                    *(u32x2*)(d + n * 16) = w;
                }
            }
        }
    }
    DEV void operator()(f32x4 (&acc)[4][4], int wr, int wc, int lane) {
        const int r = lane & 15, quad = lane >> 4; const int j0 = (col0 + wc * 64) >> 1;
#pragma unroll
        for (int m = 0; m < 4; ++m)
#pragma unroll
            for (int j = 0; j < 4; ++j) {
                const int rl = wr * 64 + m * 16 + quad * 4 + j;
                if (rl < nvalid) {
                    bf16_t* d = p.ACT + (size_t)(slot0 + rl) * D_EXPERT + j0 + r;
                    d[0] = f2bf(siluf(acc[m][0][j]) * acc[m][2][j]); d[16] = f2bf(siluf(acc[m][1][j]) * acc[m][3][j]);
                }
            }
    }
};
struct EpDown {
    const Params& p; const float* lw; const int* lp; int nvalid, col0;
    DEV void nat(f32x4 (&acc)[4][4], int wr, int wc, int lane) {
        const int r = lane & 15, quad = lane >> 4;
#pragma unroll
        for (int m = 0; m < 4; ++m) {
            const int rl = wr * 64 + m * 16 + r;
            if (rl < nvalid) {
                const float w = lw[rl]; bf16_t* d = p.YS + (size_t)lp[rl] * D_MODEL + col0 + wc * 64 + quad * 4;
#pragma unroll
                for (int n = 0; n < 4; ++n) { u32x2 o; o.x = pack2(w * acc[m][n][0], w * acc[m][n][1]); o.y = pack2(w * acc[m][n][2], w * acc[m][n][3]); *(u32x2*)(d + n * 16) = o; }
            }
        }
    }
    DEV void operator()(f32x4 (&acc)[4][4], int wr, int wc, int lane) {}
};
template <bool DOWN>
DEV void phaseHI(const Params& p, int layer, unsigned char* smem) {
    int* tpre = (int*)(smem + 74 * 1024); int* sbase = tpre + 40;
    const int tid = tid_(); const int bid = bid_();
    __syncthreads();
    if (tid == 0) {
        int ta = 0, sa = 0;
        for (int e = 0; e < NE; ++e) { const int c = p.CNT[(layer * NE + e) * 32]; tpre[e] = ta; sbase[e] = sa; ta += (c + 127) >> 7; sa += c; }
        tpre[NE] = ta;
        if (bid == 0 && !DOWN) for (int e = 0; e < NE; ++e) p.BASE[e] = sbase[e];
    }
    __syncthreads();
    const int ncol = DOWN ? D_MODEL / 256 : 2 * D_EXPERT / 256; const int ntile = tpre[NE] * ncol;
    const int trow = tid >> 2, lc8 = g2_lc(tid) * 8;
    const WorkRange wr = xcd_range(ntile, bid);
    for (int t = wr.lo; t < wr.hi; t += wr.step) {
        int e = 0;
        for (int q = 1; q < NE; ++q) if (tpre[q] * ncol <= t) e = q;
        const int nrt = tpre[e + 1] - tpre[e]; const int q2 = t - tpre[e] * ncol; const int ct = q2 / nrt, rt = q2 % nrt;
        const int cnt = p.CNT[(layer * NE + e) * 32]; const int nvalid = imin(128, cnt - rt * 128); const int slot0 = sbase[e] + rt * 128;
        if (!DOWN) {
            const int* list = p.LIST + (size_t)e * NTOK + rt * 128;
            const int r0 = imin(trow, nvalid - 1), r1 = imin(64 + trow, nvalid - 1);
            const bf16_t* a0 = p.H + (size_t)(list[r0] >> 1) * D_MODEL + lc8; const bf16_t* a1 = p.H + (size_t)(list[r1] >> 1) * D_MODEL + lc8;
            const bf16_t* bw = p.Wgu + ((size_t)(layer * NE + e) * 2 * D_EXPERT + ct * 256 + trow) * D_MODEL + lc8;
            EpGU ep{p, slot0, nvalid, ct * 256};
            gemm_tile2<2, true>(smem, a0, a1, bw, D_MODEL, D_MODEL / 32, ep);
        } else {
            const bf16_t* a0 = p.ACT + (size_t)(slot0 + trow) * D_EXPERT + lc8;
            const bf16_t* bw = p.WdT + ((size_t)(layer * NE + e) * D_MODEL + ct * 256 + trow) * D_EXPERT + lc8;
            EpDown ep{p, p.LISTW + (size_t)e * NTOK + rt * 128, p.LIST + (size_t)e * NTOK + rt * 128, nvalid, ct * 256};
            gemm_tile2<2, true>(smem, a0, a0 + (size_t)64 * D_EXPERT, bw, D_EXPERT, D_EXPERT / 32, ep);
        }
    }
}

DEV void phaseJ(const Params& p, int layer) {
    const bool with_ctx = layer < DEPTH - 1; const bool last = layer == DEPTH - 1;
    const int wid = tid_() >> 6, lane = tid_() & 63;
    const float* lg1 = p.ln_g + (size_t)(layer * 2) * D_MODEL; const float* lb1 = p.ln_b + (size_t)(layer * 2) * D_MODEL;
    const float* lg = p.ln_g + (size_t)(layer * 2 + 1) * D_MODEL; const float* lb = p.ln_b + (size_t)(layer * 2 + 1) * D_MODEL;
    const int stride = gridDim.x * 4;
    int tok = bid_() * 4 + wid;
    u32x2 xn[NV4], an[NV4], cn[NV4]; float mun = 0.f, rsn = 0.f;
    if (tok < NTOK) {
#pragma unroll
        for (int i = 0; i < NV4; ++i) {
            const int k = (i * 64 + lane) * 4;
            xn[i] = *(const u32x2*)(p.X + (size_t)tok * D_MODEL + k); an[i] = *(const u32x2*)(p.YS + (size_t)(tok * 2) * D_MODEL + k); cn[i] = *(const u32x2*)(p.YS + (size_t)(tok * 2 + 1) * D_MODEL + k);
        }
        mun = p.STAT[tok * 2]; rsn = p.STAT[tok * 2 + 1];
    }
    for (; tok < NTOK; tok += stride) {
        u32x2 x[NV4], a[NV4], c[NV4]; const float mu1 = mun, rs1 = rsn;
#pragma unroll
        for (int i = 0; i < NV4; ++i) { x[i] = xn[i]; a[i] = an[i]; c[i] = cn[i]; }
        const int tn = tok + stride;
        if (tn < NTOK) {
#pragma unroll
            for (int i = 0; i < NV4; ++i) {
                const int k = (i * 64 + lane) * 4;
                xn[i] = *(const u32x2*)(p.X + (size_t)tn * D_MODEL + k); an[i] = *(const u32x2*)(p.YS + (size_t)(tn * 2) * D_MODEL + k); cn[i] = *(const u32x2*)(p.YS + (size_t)(tn * 2 + 1) * D_MODEL + k);
            }
            mun = p.STAT[tn * 2]; rsn = p.STAT[tn * 2 + 1];
        }
        const int b = tok / TT, s = tok % TT; if (!with_ctx && s < CTX) continue;
        const int bb = s < CTX ? BATCH : b; const float* gate = p.MOD + ((size_t)layer * (BATCH + 1) + bb) * 6 * D_MODEL + 5 * D_MODEL;
        f32x4 v[NV4]; float sum = 0.f;
#pragma unroll
        for (int i = 0; i < NV4; ++i) {
            const int k = (i * 64 + lane) * 4; const f32x4 g = *(const f32x4*)(gate + k), g1 = *(const f32x4*)(lg1 + k), b1 = *(const f32x4*)(lb1 + k);
            const f32x4 x1 = (bf4(x[i]) - mu1) * rs1 * g1 + b1;
            v[i] = ALPHA * x1 + g * (bf4(a[i]) + bf4(c[i]));
            sum += v[i].x + v[i].y + v[i].z + v[i].w;
        }
        const float mu = wsum(sum) * (1.f / D_MODEL); float var = 0.f;
#pragma unroll
        for (int i = 0; i < NV4; ++i) { float a0 = v[i].x - mu, bq = v[i].y - mu, c0 = v[i].z - mu, d = v[i].w - mu; var += a0 * a0 + bq * bq + c0 * c0 + d * d; }
        const float rs = 1.f / sqrtf(wsum(var) * (1.f / D_MODEL) + EPS);
        float* dst = p.out + ((size_t)b * SEQ + (s - CTX)) * D_MODEL; bf16_t* dx = p.X + (size_t)tok * D_MODEL;
#pragma unroll
        for (int i = 0; i < NV4; ++i) {
            const int k = (i * 64 + lane) * 4; const f32x4 g4 = *(const f32x4*)(lg + k), b4 = *(const f32x4*)(lb + k);
            f32x4 o; o.x = (v[i].x - mu) * rs * g4.x + b4.x; o.y = (v[i].y - mu) * rs * g4.y + b4.y; o.z = (v[i].z - mu) * rs * g4.z + b4.z; o.w = (v[i].w - mu) * rs * g4.w + b4.w;
            if (last) *(f32x4*)(dst + k) = o; else *(u32x2*)(dx + k) = pk4(o);
            if (!last) {
                const float* mn = p.MOD + ((size_t)(layer + 1) * (BATCH + 1) + bb) * 6 * D_MODEL;
                const f32x4 sh = *(const f32x4*)(mn + k), sc = *(const f32x4*)(mn + D_MODEL + k);
                u32x2 hq; hq.x = pack2(o.x * (1.f + sc.x) + sh.x, o.y * (1.f + sc.y) + sh.y); hq.y = pack2(o.z * (1.f + sc.z) + sh.z, o.w * (1.f + sc.w) + sh.w);
                *(u32x2*)(p.HIN + (size_t)tok * D_MODEL + k) = hq;
            }
        }
    }
}

constexpr int PH_PER_LAYER = 10;
constexpr int NPHASE = 2 + DEPTH * PH_PER_LAYER;
DEV void run_phase(const Params& p, int ph, unsigned char* smem) {
    if (ph == 0) { phase0(p, smem); return; }
    if (ph == 1) { phase0b(p); return; }
    const int layer = (ph - 2) / PH_PER_LAYER, sub = (ph - 2) % PH_PER_LAYER;
    switch (sub) {
        case 0: phaseA(p, layer, smem); break;
        case 1: if (!(layer & 1)) phaseB(p, layer); break;
        case 2: phaseC(p, layer, smem); break;
        case 3: phaseD(p, layer); break;
        case 4: phaseE(p, layer, smem); break;
        case 5: phaseF(p, layer, smem); break;
        case 6: phaseG(p, layer, smem); break;
        case 7: phaseHI<false>(p, layer, smem); break;
        case 8: phaseHI<true>(p, layer, smem); break;
        default: phaseJ(p, layer); break;
    }
}
DEV bool phase_is_empty(int ph) { if (ph < 2) return false; return ((ph - 2) % PH_PER_LAYER) == 1 && (((ph - 2) / PH_PER_LAYER) & 1); }

struct Carver { char* base; size_t off; template <class T> T* take(size_t n) { off = (off + 255) & ~(size_t)255; T* r = (T*)(base + off); off += n * sizeof(T); return r; } };
static void make_params(Params& p, void* const* d_in, void* d_out, void* d_ws) {
    const float** in = (const float**)d_in;
    p.x = in[0]; p.c = in[1]; p.ctx = in[2]; p.c_ctx = in[3]; p.w_mod = in[4]; p.b_mod = in[5]; p.ln_g = in[6]; p.ln_b = in[7];
    p.ev_w_in = in[8]; p.ev_w_out = in[9]; p.ev_lambda = in[10]; p.ev_subln_g = in[11]; p.ev_conv_w = in[12]; p.ev_conv_b = in[13];
    p.ev_gate_b = in[14]; p.ev_mnorm_g = in[15]; p.od_w_in = in[16]; p.od_w_out = in[17]; p.od_decay = in[18]; p.od_qk_g = in[19];
    p.moe_w_group = in[20]; p.moe_b_group = in[21]; p.moe_w_router = in[22]; p.moe_b_router = in[23]; p.moe_w_gate = in[24]; p.moe_w_up = in[25]; p.moe_w_down = in[26];
    p.out = (float*)d_out;
    Carver cv{(char*)d_ws, 0};
    p.X = cv.take<bf16_t>((size_t)NTOK * D_MODEL);
    p.MOD = cv.take<float>((size_t)DEPTH * (BATCH + 1) * 6 * D_MODEL);
    p.ROPE = cv.take<float>(64 * 16 * 2); p.LAM = cv.take<float>(4);
    p.WrT = cv.take<float>((size_t)DEPTH * NR * D_MODEL);
    p.CNT = cv.take<int>(DEPTH * NE * 32); p.BASE = cv.take<int>(NE); p.BAR = cv.take<unsigned>(4096);
    p.WinE = cv.take<bf16_t>((size_t)2 * EVEN_INP * D_MODEL); p.WinO = cv.take<bf16_t>((size_t)2 * ODD_IN * D_MODEL);
    p.WoutT = cv.take<bf16_t>((size_t)DEPTH * D_MODEL * MIX_OUT);
    p.Wgu = cv.take<bf16_t>((size_t)DEPTH * NE * 2 * D_EXPERT * D_MODEL); p.WdT = cv.take<bf16_t>((size_t)DEPTH * NE * D_MODEL * D_EXPERT);
    p.STAT = cv.take<float>((size_t)NTOK * 2);
    p.CAT = cv.take<bf16_t>((size_t)NTOK * 1024); p.HIN = cv.take<bf16_t>((size_t)NTOK * D_MODEL);
    p.LIST = cv.take<int>((size_t)NE * NTOK); p.LISTW = cv.take<float>((size_t)NE * NTOK); p.TOKSLOT = cv.take<int>((size_t)NTOK * 2);
    const size_t mix0 = cv.off;
    p.Q1 = cv.take<bf16_t>((size_t)NTOK * 512); p.K1 = cv.take<bf16_t>((size_t)NTOK * 512); p.V1T = cv.take<bf16_t>((size_t)NTOK * 512);
    p.PM = cv.take<bf16_t>((size_t)NTOK * 1024); p.V2T = cv.take<bf16_t>((size_t)NTOK * 512); p.OG = cv.take<bf16_t>((size_t)NTOK * 512);
    p.G = cv.take<float>((size_t)NTOK * 16);
    p.Q2 = cv.take<bf16_t>((size_t)NTOK * 512); p.K2 = cv.take<bf16_t>((size_t)NTOK * 512); p.K2T = cv.take<bf16_t>((size_t)NTOK * 512);
    p.DC = cv.take<bf16_t>((size_t)NCHAIN * NCH * EVR * 128); p.CP = cv.take<bf16_t>((size_t)NCHAIN * NCH * EVR * 128);
    p.BC = cv.take<float>((size_t)NCHAIN * TT); p.AT = cv.take<float>((size_t)NCHAIN * TT); p.MT = cv.take<float>((size_t)NCHAIN * TT); p.MS = cv.take<float>((size_t)NCHAIN * NCH * 4);
    cv.off = mix0;
    p.H = cv.take<bf16_t>((size_t)NTOK * D_MODEL); p.ACT = cv.take<bf16_t>((size_t)(2 * NTOK + 128) * D_EXPERT); p.YS = cv.take<bf16_t>((size_t)2 * NTOK * D_MODEL);
}

#ifndef CPU_EMU
#define XB_TMO      128
#define XB_XCNT(j)  (256  + 64 * (j))
#define XB_XSUB(j)  (1280 + 64 * (j))
#define XB_XGEN(j)  (2304 + 64 * (j))
#define XB_TOP      3328
#define XB_TOPGEN   3392
#define XCD_BAR_WORDS 3456
#define XB_SPIN_CAP (1u << 20)
#define LAS __attribute__((address_space(3)))
__device__ __forceinline__ unsigned xb_ld(unsigned* p)              { return __hip_atomic_load(p, __ATOMIC_RELAXED, __HIP_MEMORY_SCOPE_AGENT); }
__device__ __forceinline__ unsigned xb_add(unsigned* p, unsigned v) { return __hip_atomic_fetch_add(p, v, __ATOMIC_RELAXED, __HIP_MEMORY_SCOPE_AGENT); }
__device__ __forceinline__ unsigned xb_xcc_id() { return (unsigned)__builtin_amdgcn_s_getreg((3 << 11) | 20) & 0xFu; }
#define XB_SPIN(cond, bar) do { unsigned _sp = 0; while (cond) { __builtin_amdgcn_s_sleep(1); \
    if ((++_sp & 255u) == 0u) { if (xb_ld(&(bar)[XB_TMO])) break; if (_sp > XB_SPIN_CAP) { atomicAdd(&(bar)[XB_TMO], 1u); break; } } } } while (0)
struct XcdBarrier { unsigned* bar; unsigned x; volatile LAS unsigned* st; };
__device__ __forceinline__ XcdBarrier xcd_barrier_post(unsigned* bar, volatile LAS unsigned* st) {
    XcdBarrier b; b.bar = bar; b.x = xb_xcc_id(); b.st = st;
    if (threadIdx.x == 0) (void)xb_add(&bar[XB_XCNT(b.x)], 1u);
    return b;
}
__device__ __forceinline__ void xcd_barrier_complete(unsigned* bar, unsigned x, unsigned& nloc, unsigned& nx) {
    const unsigned G = gridDim.x * gridDim.y * gridDim.z;
    unsigned sum, cnt, mine, sp = 0u;
    for (;;) {
        sum = 0u; cnt = 0u; mine = 0u;
#pragma unroll
        for (unsigned j = 0; j < 16; ++j) { const unsigned c = xb_ld(&bar[XB_XCNT(j)]); sum += c; cnt += (c > 0u) ? 1u : 0u; mine = (j == x) ? c : mine; }
        if (sum == G) break;
        __builtin_amdgcn_s_sleep(1);
        if ((++sp & 255u) == 0u) { if (xb_ld(&bar[XB_TMO])) break; if (sp > XB_SPIN_CAP) { atomicAdd(&bar[XB_TMO], 1u); break; } }
    }
    nloc = mine > 0u ? mine : 1u; nx = cnt > 0u ? cnt : 1u;
}
__device__ __forceinline__ void xcd_barrier(const XcdBarrier& b) {
    asm volatile("s_waitcnt vmcnt(0)" ::: "memory");
    __syncthreads();
    if (threadIdx.x == 0) {
        unsigned* bar = b.bar;
        __builtin_amdgcn_s_waitcnt(0);
        unsigned nloc = b.st[0], nx = b.st[1];
        if (nloc == 0u) { xcd_barrier_complete(bar, b.x, nloc, nx); b.st[0] = nloc; b.st[1] = nx; }
        const unsigned old = xb_add(&bar[XB_XSUB(b.x)], 1u);
        const unsigned gen = old / nloc;
        if (old + 1u == (gen + 1u) * nloc) {
            __builtin_amdgcn_fence(__ATOMIC_RELEASE, "agent");
            asm volatile("s_waitcnt vmcnt(0)" ::: "memory");
            const unsigned og = xb_add(&bar[XB_TOP], 1u);
            const unsigned tg = og / nx;
            if (og + 1u == (tg + 1u) * nx) xb_add(&bar[XB_TOPGEN], 1u);
            else XB_SPIN(xb_ld(&bar[XB_TOPGEN]) == tg, bar);
            __builtin_amdgcn_fence(__ATOMIC_ACQUIRE, "agent");
            xb_add(&bar[XB_XGEN(b.x)], 1u);
            asm volatile("s_waitcnt vmcnt(0)" ::: "memory");
        } else {
            XB_SPIN(xb_ld(&bar[XB_XGEN(b.x)]) == gen, bar);
            __builtin_amdgcn_fence(__ATOMIC_ACQUIRE, "agent");
            asm volatile("s_waitcnt vmcnt(0)" ::: "memory");
        }
    }
    __syncthreads();
}

__global__ void __launch_bounds__(NTHREADS, 2) fwd_megakernel(Params p) {
    __shared__ __attribute__((aligned(16))) unsigned char smem[LDS_BYTES];
    cg::grid_group grid = cg::this_grid();
    volatile LAS unsigned* xst = (volatile LAS unsigned*)(smem + LDS_BYTES - 16);
    if (threadIdx.x == 0) { xst[0] = 0u; xst[1] = 0u; }
    __syncthreads();
    const XcdBarrier xb = xcd_barrier_post(p.BAR, xst);
    grid.sync();
#ifdef PROBE_TS
    unsigned long long ts_acc = 0ull;
#endif
    for (int ph = 0; ph < NPHASE; ++ph) {
        if (phase_is_empty(ph)) continue;
#ifdef PROBE_TS
        const int psub_ = ph == 0 ? 10 : ph == 1 ? 11 : (ph - 2) % PH_PER_LAYER;
        const unsigned long long ts0 = __builtin_amdgcn_s_memrealtime();
#endif
#if defined(__HIP_DEVICE_COMPILE__)
        const __attribute__((address_space(4))) Params* pp = (const __attribute__((address_space(4))) Params*)__builtin_amdgcn_kernarg_segment_ptr();
        asm volatile("" : "+s"(pp));
        const Params q = *pp;
        run_phase(q, ph, smem);
#ifdef DBL_MASK
        { const int sub_ = ph == 0 ? 10 : ph == 1 ? 11 : (ph - 2) % PH_PER_LAYER; if ((DBL_MASK >> sub_) & 1) run_phase(q, ph, smem); }
#endif
#else
        run_phase(p, ph, smem);
#endif
#ifdef PROBE_TS
        const unsigned long long ts1 = __builtin_amdgcn_s_memrealtime();
        xcd_barrier(xb);
        const unsigned long long ts2 = __builtin_amdgcn_s_memrealtime();
        if (PROBE_TS == 100) ts_acc += ts2 - ts1; else if (psub_ == PROBE_TS) ts_acc += ts2 - ts0;
#else
        if (ph + 1 < NPHASE) xcd_barrier(xb);
#endif
    }
#ifdef PROBE_TS
    if (blockIdx.x == 0) { const int np = (int)(ts_acc / 100ull); for (int i = threadIdx.x; i < np; i += NTHREADS) p.out[i] += 1.0f; }
#endif
}

extern "C" void kernel_launch(void* const* d_in, const int* in_sizes, int n_in, void* d_out, int out_size, void* d_ws, size_t ws_size, hipStream_t stream) {
    static int grid_blocks = 0;
    if (!grid_blocks) {
        int dev = 0, cus = 0, per_cu = 0;
        (void)hipGetDevice(&dev); (void)hipDeviceGetAttribute(&cus, hipDeviceAttributeMultiprocessorCount, dev);
        (void)hipOccupancyMaxActiveBlocksPerMultiprocessor(&per_cu, fwd_megakernel, NTHREADS, 0);
        if (per_cu > 2) per_cu = 2;
        if (per_cu < 1) per_cu = 1;
        grid_blocks = cus * per_cu;
    }
    Params p; memset(&p, 0, sizeof(p));
    make_params(p, d_in, d_out, d_ws);
    (void)hipMemsetAsync(p.BAR, 0, 4096 * sizeof(unsigned), stream);
    void* args[] = {&p};
    hipError_t e = hipLaunchCooperativeKernel((void*)fwd_megakernel, dim3(grid_blocks), dim3(NTHREADS), args, 0, stream);
    if (e != hipSuccess) fprintf(stderr, "cooperative launch failed: %s (grid %d)\n", hipGetErrorString(e), grid_blocks);
}
#endif

#if defined(DIAG_KERNELS) && !defined(CPU_EMU)
template <int SUB, int ODD>
__global__ void __launch_bounds__(NTHREADS, 2) k_diag(Params p, int l2) {
    __shared__ __attribute__((aligned(16))) unsigned char smem[LDS_BYTES];
    const int layer = l2 * 2 + ODD;
    if (SUB == 100) { phase0(p, smem); return; }
    if (SUB == 0) phaseA(p, layer, smem);
    if (SUB == 1) phaseB(p, layer);
    if (SUB == 20) { for (int it = bid_(); it < 100; it += gridDim.x) { if (ODD) attn_gqa_item(p, it, (bf16_t*)smem); else attn_diff_item(p, layer, it, (bf16_t*)smem); } }
    if (SUB == 21) { for (int it = bid_(); it < 100; it += gridDim.x) { if (ODD) rec_dc_item<64, false>(p, it, (bf16_t*)smem); else rec_dc_item<128, true>(p, it, (bf16_t*)smem); } }
    if (SUB == 3) phaseD(p, layer);
    if (SUB == 4) phaseE(p, layer, smem);
    if (SUB == 5) phaseF(p, layer, smem);
    if (SUB == 6) phaseG(p, layer, smem);
    if (SUB == 7) phaseHI<false>(p, layer, smem);
    if (SUB == 8) phaseHI<true>(p, layer, smem);
    if (SUB == 9) phaseJ(p, layer);
}
template __global__ void k_diag<100, 0>(Params, int);
template __global__ void k_diag<0, 0>(Params, int);
template __global__ void k_diag<0, 1>(Params, int);
template __global__ void k_diag<1, 0>(Params, int);
template __global__ void k_diag<20, 0>(Params, int);
template __global__ void k_diag<20, 1>(Params, int);
template __global__ void k_diag<21, 0>(Params, int);
template __global__ void k_diag<21, 1>(Params, int);
template __global__ void k_diag<3, 0>(Params, int);
template __global__ void k_diag<4, 0>(Params, int);
template __global__ void k_diag<4, 1>(Params, int);
template __global__ void k_diag<5, 0>(Params, int);
template __global__ void k_diag<6, 0>(Params, int);
template __global__ void k_diag<7, 0>(Params, int);
template __global__ void k_diag<8, 0>(Params, int);
template __global__ void k_diag<9, 0>(Params, int);
#endif
```

```cpp
#ifdef CPU_EMU
#include "emu.h"
#else
#include <hip/hip_runtime.h>
#include <hip/hip_cooperative_groups.h>
#include <cstdio>
#include <cstdint>
#include <cstring>
namespace cg = cooperative_groups;
#endif

#define DEV __device__ __forceinline__
#ifdef CPU_EMU
#define SCHED_BARRIER() do {} while (0)
#else
#define SCHED_BARRIER() __builtin_amdgcn_sched_barrier(0)
#endif
#ifdef CPU_EMU
static inline void glds16(const void* g, void* l) { memcpy(l, g, 16); }
template <int N> static inline void wait_vm() {}
#define RAW_BARRIER() __syncthreads()
#else
__device__ __forceinline__ void glds16(const void* g, void* l) {
    __builtin_amdgcn_global_load_lds((const __attribute__((address_space(1))) unsigned*)g, (__attribute__((address_space(3))) unsigned*)l, 16, 0, 0);
}
template <int N> __device__ __forceinline__ void wait_vm() { asm volatile("s_waitcnt vmcnt(%0)" ::"n"(N) : "memory"); }
#define RAW_BARRIER() do { asm volatile("s_waitcnt lgkmcnt(0)" ::: "memory"); __builtin_amdgcn_s_barrier(); } while (0)
#endif
#ifdef CPU_EMU
static inline int tid_() { return (int)threadIdx.x; }
static inline int bid_() { return (int)blockIdx.x; }
#else
__device__ __forceinline__ int tid_() { int t = threadIdx.x; asm volatile("" : "+v"(t)); return t; }
__device__ __forceinline__ int bid_() { int b = blockIdx.x; asm volatile("" : "+s"(b)); return b; }
#endif

#ifdef CPU_EMU_SMALL
constexpr int D_MODEL = 256, BATCH = 2, SEQ = 256, CTX = 256, D_EXPERT = 128;
#else
constexpr int D_MODEL = 1024, BATCH = 4, SEQ = 4096, CTX = 256, D_EXPERT = 512;
#endif
constexpr int DEPTH = 4, GRID_W = 64, CH = 128;
constexpr int TT = CTX + SEQ, NTOK = BATCH * TT, NCH = TT / CH, NCC = CTX / CH;
constexpr float EPS = 1e-5f;
constexpr float ALPHA = 1.6817928305074290f;
constexpr int HA = 4, HB = 4, HC = 4, HD = 8, HKV = 2;
constexpr int EVEN_IN = 3600, EVEN_INP = 3840, ODD_IN = 2304, MIX_OUT = 1024;
constexpr int NG = 4, EPG = 8, NE = 32, NR = NG + NE;
constexpr int NTHREADS = 256;
constexpr int LDS_BYTES = 76 * 1024;
constexpr int NCHAIN = BATCH * 4 * 2;
constexpr int EVR = 144;

typedef unsigned short bf16_t;
typedef short bf16x8 __attribute__((ext_vector_type(8)));
typedef float f32x4 __attribute__((ext_vector_type(4)));
typedef unsigned u32x4 __attribute__((ext_vector_type(4)));
typedef unsigned u32x2 __attribute__((ext_vector_type(2)));
union Frag { bf16x8 v; u32x4 q; u32x2 d[2]; unsigned u[4]; };
DEV int imin(int a, int b) { return a < b ? a : b; }

#ifdef CPU_EMU
DEV bf16_t f2bf(float f) { unsigned u = __float_as_uint(f); u += 0x7FFFu + ((u >> 16) & 1u); return (bf16_t)(u >> 16); }
DEV unsigned pack2(float a, float b) { return (unsigned)f2bf(a) | ((unsigned)f2bf(b) << 16); }
#else
typedef __bf16 hwbf16x2 __attribute__((ext_vector_type(2)));
typedef float hwf32x2 __attribute__((ext_vector_type(2)));
DEV unsigned pack2(float a, float b) { hwf32x2 v = {a, b}; hwbf16x2 h = __builtin_convertvector(v, hwbf16x2); return __builtin_bit_cast(unsigned, h); }
DEV bf16_t f2bf(float f) { return (bf16_t)(pack2(f, 0.f) & 0xFFFFu); }
#endif
DEV float bf2f(bf16_t h) { return __uint_as_float(((unsigned)h) << 16); }
DEV f32x4 bf4(u32x2 v) { return f32x4{__uint_as_float(v.x << 16), __uint_as_float(v.x & 0xFFFF0000u), __uint_as_float(v.y << 16), __uint_as_float(v.y & 0xFFFF0000u)}; }
DEV u32x2 pk4(f32x4 v) { u32x2 o; o.x = pack2(v.x, v.y); o.y = pack2(v.z, v.w); return o; }
DEV float siluf(float x) { return x / (1.0f + __expf(-x)); }
DEV float sigmf(float x) { return 1.0f / (1.0f + __expf(-x)); }
DEV float logsigf(float x) { return (x >= 0.f) ? -log1pf(expf(-x)) : x - log1pf(expf(x)); }
#ifdef CPU_EMU
DEV float rowred_add(float v) { v += __shfl_xor(v, 1); v += __shfl_xor(v, 2); v += __shfl_xor(v, 4); v += __shfl_xor(v, 8); return v; }
DEV float rowred_max(float v) { v = fmaxf(v, __shfl_xor(v, 1)); v = fmaxf(v, __shfl_xor(v, 2)); v = fmaxf(v, __shfl_xor(v, 4)); v = fmaxf(v, __shfl_xor(v, 8)); return v; }
DEV float lane_read(float v, int src, int lane) { return __shfl(v, src); }
DEV float lane_up(float v, int d, int lane) { return __shfl_up(v, d); }
#else
template <int CTRL> DEV float dppf(float v) { return __uint_as_float((unsigned)__builtin_amdgcn_update_dpp(0, (int)__float_as_uint(v), CTRL, 0xF, 0xF, true)); }
DEV float rowred_add(float v) { v += dppf<0xB1>(v); v += dppf<0x4E>(v); v += dppf<0x141>(v); v += dppf<0x140>(v); return v; }
DEV float rowred_max(float v) { v = fmaxf(v, dppf<0xB1>(v)); v = fmaxf(v, dppf<0x4E>(v)); v = fmaxf(v, dppf<0x141>(v)); v = fmaxf(v, dppf<0x140>(v)); return v; }
DEV float lane_read(float v, int src, int lane) { return __uint_as_float((unsigned)__builtin_amdgcn_ds_bpermute((src & 63) << 2, (int)__float_as_uint(v))); }
DEV float lane_up(float v, int d, int lane) { const float o = __uint_as_float((unsigned)__builtin_amdgcn_ds_bpermute(((lane - d) & 63) << 2, (int)__float_as_uint(v))); return lane >= d ? o : v; }
#endif
#ifdef CPU_EMU
DEV float xch16(float v) { return __shfl_xor(v, 16); }
DEV float xch32(float v) { return __shfl_xor(v, 32); }
#else
typedef unsigned hwu2 __attribute__((ext_vector_type(2)));
DEV void xpair16(float v, float& a, float& b) { const unsigned u = __float_as_uint(v); hwu2 r = __builtin_amdgcn_permlane16_swap(u, u, false, false); a = __uint_as_float(r.x); b = __uint_as_float(r.y); }
DEV void xpair32(float v, float& a, float& b) { const unsigned u = __float_as_uint(v); hwu2 r = __builtin_amdgcn_permlane32_swap(u, u, false, false); a = __uint_as_float(r.x); b = __uint_as_float(r.y); }
#endif
DEV float xmax16(float v) {
#ifdef CPU_EMU
    return fmaxf(v, xch16(v));
#else
    float a, b; xpair16(v, a, b); return fmaxf(a, b);
#endif
}
DEV float xmax32(float v) {
#ifdef CPU_EMU
    return fmaxf(v, xch32(v));
#else
    float a, b; xpair32(v, a, b); return fmaxf(a, b);
#endif
}
DEV float xadd16(float v) {
#ifdef CPU_EMU
    return v + xch16(v);
#else
    float a, b; xpair16(v, a, b); return a + b;
#endif
}
DEV float xadd32(float v) {
#ifdef CPU_EMU
    return v + xch32(v);
#else
    float a, b; xpair32(v, a, b); return a + b;
#endif
}
DEV float wsum(float v) { v = rowred_add(v); v = xadd16(v); return xadd32(v); }
DEV float wmax(float v) { v = rowred_max(v); v = xmax16(v); return xmax32(v); }
DEV f32x4 mfma16(bf16x8 a, bf16x8 b, f32x4 c) { return __builtin_amdgcn_mfma_f32_16x16x32_bf16(a, b, c, 0, 0, 0); }

struct WorkRange { int lo, hi, step; };
DEV WorkRange xcd_range(int T, int bid) {
    WorkRange w; const int G = gridDim.x;
    if ((G & 7) == 0) { const int x = bid & 7, k = bid >> 3; w.lo = (int)(((long long)x * T) >> 3) + k; w.hi = (int)(((long long)(x + 1) * T) >> 3); w.step = G >> 3; }
    else { w.lo = bid; w.hi = T; w.step = G; }
    return w;
}
DEV void dense_tile(int t, int nrow, int ncol, int& rt, int& ct) {
    if ((nrow & 7) == 0) { const int rpg = nrow >> 3; const int rg = t / (ncol * rpg), q = t % (ncol * rpg); ct = q / rpg; rt = rg * rpg + q % rpg; }
    else { rt = t / ncol; ct = t % ncol; }
}

struct Params {
    const float *x, *c, *ctx, *c_ctx, *w_mod, *b_mod, *ln_g, *ln_b, *ev_w_in, *ev_w_out, *ev_lambda, *ev_subln_g, *ev_conv_w, *ev_conv_b,
        *ev_gate_b, *ev_mnorm_g, *od_w_in, *od_w_out, *od_decay, *od_qk_g, *moe_w_group, *moe_b_group, *moe_w_router, *moe_b_router,
        *moe_w_gate, *moe_w_up, *moe_w_down;
    float* out;
    bf16_t* X;
    float *MOD, *ROPE, *LAM, *WrT;
    int* CNT; unsigned* BAR;
    bf16_t *WinE, *WinO, *WoutT, *Wgu, *WdT;
    bf16_t *Q1, *K1, *V1T;
    bf16_t *PM, *V2T, *OG;
    float* G;
    bf16_t *Q2, *K2, *K2T;
    bf16_t* CAT;
    bf16_t *DC, *CP;
    float *BC, *AT, *MT, *MS;
    bf16_t *H, *ACT, *HIN, *YS; float* STAT;
    int *LIST, *TOKSLOT, *BASE; float *LISTW;
};

constexpr int GLD = 72;
constexpr int GT = 128 * GLD;

struct BLoadW {
    const bf16_t* base; int ld; u32x4 r[4];
    DEV void fetch(int kt, int tid) {
#pragma unroll
        for (int i = 0; i < 4; ++i) { int c = tid + 256 * i, row = c >> 3, kc = c & 7; r[i] = *(const u32x4*)(base + (size_t)row * ld + kt * 64 + kc * 8); }
    }
    DEV void commit(bf16_t* S, int tid) {
#pragma unroll
        for (int i = 0; i < 4; ++i) { int c = tid + 256 * i, row = c >> 3, kc = c & 7; *(u32x4*)(S + row * GLD + kc * 8) = r[i]; }
    }
};
struct ALoadB {
    const bf16_t* base; int ld; u32x4 r[4];
    DEV void fetch(int kt, int tid) {
#pragma unroll
        for (int i = 0; i < 4; ++i) { int c = tid + 256 * i, row = c >> 3, kc = c & 7; r[i] = *(const u32x4*)(base + (size_t)row * ld + kt * 64 + kc * 8); }
    }
    DEV void commit(bf16_t* S, int tid) {
#pragma unroll
        for (int i = 0; i < 4; ++i) { int c = tid + 256 * i, row = c >> 3, kc = c & 7; *(u32x4*)(S + row * GLD + kc * 8) = r[i]; }
    }
};
struct ALoadG {
    const bf16_t* H; const int* list; int nvalid; u32x4 r[4];
    DEV void fetch(int kt, int tid) {
#pragma unroll
        for (int i = 0; i < 4; ++i) {
            int c = tid + 256 * i, row = c >> 3, kc = c & 7; int rr = row < nvalid ? row : nvalid - 1; int tok = list[rr];
            r[i] = *(const u32x4*)(H + (size_t)tok * D_MODEL + kt * 64 + kc * 8);
        }
    }
    DEV void commit(bf16_t* S, int tid) {
#pragma unroll
        for (int i = 0; i < 4; ++i) { int c = tid + 256 * i, row = c >> 3, kc = c & 7; *(u32x4*)(S + row * GLD + kc * 8) = r[i]; }
    }
};
struct ALoadX {
    const float* base; const float *sc, *sh; f32x4 r[8]; f32x4 s4, h4;
    DEV void fetch(int kt, int tid) {
        int kc = tid & 15;
        s4 = *(const f32x4*)(sc + kt * 64 + kc * 4); h4 = *(const f32x4*)(sh + kt * 64 + kc * 4);
#pragma unroll
        for (int i = 0; i < 8; ++i) { int row = (tid >> 4) + 16 * i; r[i] = *(const f32x4*)(base + (size_t)row * D_MODEL + kt * 64 + kc * 4); }
    }
    DEV void commit(bf16_t* S, int tid) {
        int kc = tid & 15;
#pragma unroll
        for (int i = 0; i < 8; ++i) {
            int row = (tid >> 4) + 16 * i;
            u32x2 o; o.x = pack2(r[i].x * (1.f + s4.x) + h4.x, r[i].y * (1.f + s4.y) + h4.y); o.y = pack2(r[i].z * (1.f + s4.z) + h4.z, r[i].w * (1.f + s4.w) + h4.w);
            *(u32x2*)(S + row * GLD + kc * 4) = o;
        }
    }
};

template <class AL, class BL, class EP>
DEV void gemm_tile(bf16_t* sm, AL& al, BL& bl, int nkt, EP& ep) {
    const int tid = tid_(), wid = tid >> 6, lane = tid & 63, wr = wid >> 1, wc = wid & 1, r = lane & 15, quad = lane >> 4;
    bf16_t* As = sm; bf16_t* Bs = sm + 2 * GT;
    f32x4 acc[4][4];
#pragma unroll
    for (int m = 0; m < 4; ++m)
#pragma unroll
        for (int n = 0; n < 4; ++n) acc[m][n] = f32x4{0.f, 0.f, 0.f, 0.f};
    al.fetch(0, tid); bl.fetch(0, tid); al.commit(As, tid); bl.commit(Bs, tid);
    __syncthreads();
    for (int kt = 0; kt < nkt; ++kt) {
        const int cur = kt & 1;
        if (kt + 1 < nkt) { al.fetch(kt + 1, tid); bl.fetch(kt + 1, tid); }
        const bf16_t* Ac = As + cur * GT + (wr * 64 + r) * GLD + quad * 8;
        const bf16_t* Bc = Bs + cur * GT + (wc * 64 + r) * GLD + quad * 8;
#pragma unroll
        for (int ks = 0; ks < 2; ++ks) {
            Frag a[4], b[4];
#pragma unroll
            for (int m = 0; m < 4; ++m) a[m].q = *(const u32x4*)(Ac + m * 16 * GLD + ks * 32);
#pragma unroll
            for (int n = 0; n < 4; ++n) b[n].q = *(const u32x4*)(Bc + n * 16 * GLD + ks * 32);
#pragma unroll
            for (int m = 0; m < 4; ++m)
#pragma unroll
                for (int n = 0; n < 4; ++n) acc[m][n] = mfma16(a[m].v, b[n].v, acc[m][n]);
        }
        if (kt + 1 < nkt) { al.commit(As + (cur ^ 1) * GT, tid); bl.commit(Bs + (cur ^ 1) * GT, tid); }
        __syncthreads();
    }
    ep(acc, wr, wc, lane);
}


DEV int g2_h(int g) { return (0x78 >> (2 * g)) & 3; }
template <int NH> struct G2 { static constexpr int BROWS = 128 * NH, STAGE = 8192 + BROWS * 64, NST = (NH == 2 ? 3 : 4), LPS = 2 + 2 * NH; };

template <int NH, bool TR, class EP>
DEV void gemm_tile2(unsigned char* sm, const bf16_t* a0, const bf16_t* a1, const bf16_t* bb, int ldb, int nkt, EP& ep) {
    constexpr int STAGE = G2<NH>::STAGE, NST = G2<NH>::NST, LPS = G2<NH>::LPS;
    const int tid = tid_(), wid = tid >> 6, lane = tid & 63, wr = wid >> 1, wc = wid & 1, r = lane & 15, quad = lane >> 4;
    f32x4 acc[NH][4][4];
#pragma unroll
    for (int h = 0; h < NH; ++h)
#pragma unroll
        for (int m = 0; m < 4; ++m)
#pragma unroll
            for (int n = 0; n < 4; ++n) acc[h][m][n] = f32x4{0.f, 0.f, 0.f, 0.f};
    unsigned char* dst0 = sm + tid * 16;
    auto issue = [&](int kt, int slot) {
        unsigned char* d = dst0 + slot * STAGE;
        glds16(a0 + kt * 32, d); glds16(a1 + kt * 32, d + 4096);
#pragma unroll
        for (int j = 0; j < 2 * NH; ++j) glds16(bb + (size_t)j * 64 * ldb + kt * 32, d + 8192 + j * 4096);
    };
    RAW_BARRIER();
#pragma unroll
    for (int st = 0; st < NST - 1; ++st) if (st < nkt) issue(st, st);
    const int pco = (quad ^ g2_h((r >> 2) & 3)) * 16;
    const unsigned char* afr = sm + (wr * 64 + r) * 64 + pco;
    const unsigned char* bfr = sm + 8192 + (wc * 64 * NH + r) * 64 + pco;
    int slot = 0;
    for (int kt = 0; kt < nkt; ++kt) {
        const int rem = nkt - 1 - kt;
        if (NST == 3) { if (rem >= 1) wait_vm<LPS>(); else wait_vm<0>(); }
        else { if (rem >= 2) wait_vm<2 * LPS>(); else if (rem == 1) wait_vm<LPS>(); else wait_vm<0>(); }
        RAW_BARRIER();
        if (kt + NST - 1 < nkt) { int ns = slot + NST - 1; if (ns >= NST) ns -= NST; issue(kt + NST - 1, ns); }
        const unsigned char* as = afr + slot * STAGE; const unsigned char* bs = bfr + slot * STAGE;
        Frag a[4];
#pragma unroll
        for (int m = 0; m < 4; ++m) a[m].q = *(const u32x4*)(as + m * 16 * 64);
#ifndef CPU_EMU
        __builtin_amdgcn_s_setprio(1);
#endif
#pragma unroll
        for (int h = 0; h < NH; ++h) {
            Frag b[4];
#pragma unroll
            for (int n = 0; n < 4; ++n) b[n].q = *(const u32x4*)(bs + (h * 64 + n * 16) * 64);
#pragma unroll
            for (int m = 0; m < 4; ++m)
#pragma unroll
                for (int n = 0; n < 4; ++n) acc[h][m][n] = TR ? mfma16(b[n].v, a[m].v, acc[h][m][n]) : mfma16(a[m].v, b[n].v, acc[h][m][n]);
        }
#ifndef CPU_EMU
        __builtin_amdgcn_s_setprio(0);
#endif
        if (++slot == NST) slot = 0;
    }
#pragma unroll
    for (int h = 0; h < NH; ++h) { if (TR) ep.nat(acc[h], wr, wc * NH + h, lane); else ep(acc[h], wr, wc * NH + h, lane); }
}
DEV int g2_lc(int tid) { return (tid & 3) ^ g2_h((tid >> 4) & 3); }

struct ConvJob { const float* src; bf16_t* dst; int ldsrc, N, K, k0, n0, mapkind; };
DEV void conv_load(const ConvJob& j, int tid, f32x4 (&v)[4]) {
#pragma unroll
    for (int i = 0; i < 4; ++i) {
        const int kk = (tid >> 4) + 16 * i, n = j.n0 + 4 * (tid & 15);
        v[i] = f32x4{0.f, 0.f, 0.f, 0.f};
        if (n + 3 < j.N) v[i] = *(const f32x4*)(j.src + (size_t)(j.k0 + kk) * j.ldsrc + n);
    }
}
DEV void conv_store(float* T, const ConvJob& j, int tid, const f32x4 (&v)[4]) {
    __syncthreads();
#pragma unroll
    for (int i = 0; i < 4; ++i) {
        const int kk = (tid >> 4) + 16 * i, n4 = tid & 15;
        T[(4 * n4 + 0) * 65 + kk] = v[i].x; T[(4 * n4 + 1) * 65 + kk] = v[i].y; T[(4 * n4 + 2) * 65 + kk] = v[i].z; T[(4 * n4 + 3) * 65 + kk] = v[i].w;
    }
    __syncthreads();
    const int nl = tid >> 2, ks = (tid & 3) * 16; const int n = j.n0 + nl; int dr = n;
    if (j.mapkind == 1) dr = (n >> 5) * 64 + (n & 31); else if (j.mapkind == 2) dr = (n >> 5) * 64 + 32 + (n & 31);
    const float* t = T + nl * 65 + ks;
    u32x4 o0, o1;
    o0.x = pack2(t[0], t[1]); o0.y = pack2(t[2], t[3]); o0.z = pack2(t[4], t[5]); o0.w = pack2(t[6], t[7]);
    o1.x = pack2(t[8], t[9]); o1.y = pack2(t[10], t[11]); o1.z = pack2(t[12], t[13]); o1.w = pack2(t[14], t[15]);
    bf16_t* d = j.dst + (size_t)dr * j.K + j.k0 + ks;
    *(u32x4*)d = o0; *(u32x4*)(d + 8) = o1;
}
constexpr int P0_NMOD = DEPTH * 6 * D_MODEL / 64;
constexpr int P0_NCOPY = NTOK / 64;
constexpr int T_EIN = (D_MODEL / 64) * (EVEN_INP / 64), T_OIN = (D_MODEL / 64) * (ODD_IN / 64), T_OUT = (MIX_OUT / 64) * (D_MODEL / 64);
constexpr int T_GU = (D_MODEL / 64) * (D_EXPERT / 64), T_DN = (D_EXPERT / 64) * (D_MODEL / 64);
constexpr int P0_C0 = P0_NMOD + P0_NCOPY + 1 + DEPTH;
constexpr int P0_C1 = 2 * T_EIN, P0_C2 = P0_C1 + 2 * T_OIN, P0_C3 = P0_C2 + DEPTH * T_OUT, P0_C4 = P0_C3 + DEPTH * NE * 2 * T_GU, P0_C5 = P0_C4 + DEPTH * NE * T_DN;
DEV ConvJob conv_job(const Params& p, int t) {
    ConvJob j;
    if (t < P0_C1) {
        const int i = t / T_EIN, tt = t % T_EIN; const int nt = tt % (EVEN_INP / 64), kt = tt / (EVEN_INP / 64);
        j.src = p.ev_w_in + (size_t)i * D_MODEL * EVEN_IN; j.ldsrc = EVEN_IN; j.N = EVEN_IN; j.K = D_MODEL; j.k0 = kt * 64; j.n0 = nt * 64; j.dst = p.WinE + (size_t)i * EVEN_INP * D_MODEL; j.mapkind = 0;
    } else if (t < P0_C2) {
        const int q = t - P0_C1, i = q / T_OIN, tt = q % T_OIN; const int nt = tt % (ODD_IN / 64), kt = tt / (ODD_IN / 64);
        j.src = p.od_w_in + (size_t)i * D_MODEL * ODD_IN; j.ldsrc = ODD_IN; j.N = ODD_IN; j.K = D_MODEL; j.k0 = kt * 64; j.n0 = nt * 64; j.dst = p.WinO + (size_t)i * ODD_IN * D_MODEL; j.mapkind = 0;
    } else if (t < P0_C3) {
        const int q = t - P0_C2, layer = q / T_OUT, tt = q % T_OUT; const int nt = tt % (D_MODEL / 64), kt = tt / (D_MODEL / 64);
        j.src = (layer & 1) ? p.od_w_out + (size_t)(layer >> 1) * MIX_OUT * D_MODEL : p.ev_w_out + (size_t)(layer >> 1) * MIX_OUT * D_MODEL;
        j.ldsrc = D_MODEL; j.N = D_MODEL; j.K = MIX_OUT; j.k0 = kt * 64; j.n0 = nt * 64; j.dst = p.WoutT + (size_t)layer * D_MODEL * MIX_OUT; j.mapkind = 0;
    } else if (t < P0_C4) {
        const int q = t - P0_C3, le = q / (2 * T_GU); int tt = q % (2 * T_GU); const int up = tt / T_GU; tt %= T_GU; const int nt = tt % (D_EXPERT / 64), kt = tt / (D_EXPERT / 64);
        j.src = (up ? p.moe_w_up : p.moe_w_gate) + (size_t)le * D_MODEL * D_EXPERT; j.ldsrc = D_EXPERT; j.N = D_EXPERT; j.K = D_MODEL; j.k0 = kt * 64; j.n0 = nt * 64;
        j.dst = p.Wgu + (size_t)le * 2 * D_EXPERT * D_MODEL; j.mapkind = 1 + up;
    } else {
        const int q = t - P0_C4, le = q / T_DN, tt = q % T_DN; const int nt = tt % (D_MODEL / 64), kt = tt / (D_MODEL / 64);
        j.src = p.moe_w_down + (size_t)le * D_EXPERT * D_MODEL; j.ldsrc = D_MODEL; j.N = D_MODEL; j.K = D_EXPERT; j.k0 = kt * 64; j.n0 = nt * 64; j.dst = p.WdT + (size_t)le * D_MODEL * D_EXPERT; j.mapkind = 0;
    }
    return j;
}

DEV void phase0(const Params& p, unsigned char* smem) {
    const int tid = tid_(); const int bid = bid_();
    float* fs = (float*)smem;
    for (int task = bid; task < P0_C0; task += gridDim.x) {
        if (task < P0_NMOD) {
            __syncthreads();
            for (int i = tid; i < (BATCH + 1) * D_MODEL; i += 256) { int bb = i / D_MODEL, k = i % D_MODEL; float v = bb < BATCH ? p.c[bb * D_MODEL + k] : p.c_ctx[k]; fs[i] = v / (1.f + expf(-v)); }
            __syncthreads();
            const int col = task * 64 + (tid & 63), kg = tid >> 6; const int layer = col / (6 * D_MODEL), j = col % (6 * D_MODEL);
            const float* w = p.w_mod + (size_t)layer * D_MODEL * 6 * D_MODEL + j;
            float acc[BATCH + 1];
#pragma unroll
            for (int bb = 0; bb <= BATCH; ++bb) acc[bb] = 0.f;
#pragma unroll 16
            for (int k = kg * (D_MODEL / 4); k < (kg + 1) * (D_MODEL / 4); ++k) {
                float wv = w[(size_t)k * 6 * D_MODEL];
#pragma unroll
                for (int bb = 0; bb <= BATCH; ++bb) acc[bb] += fs[bb * D_MODEL + k] * wv;
            }
            float* red = fs + (BATCH + 1) * D_MODEL;
#pragma unroll
            for (int bb = 0; bb <= BATCH; ++bb) red[(kg * (BATCH + 1) + bb) * 64 + (tid & 63)] = acc[bb];
            __syncthreads();
            if (tid < 64) {
                const float bm = p.b_mod[layer * 6 * D_MODEL + j];
#pragma unroll
                for (int bb = 0; bb <= BATCH; ++bb) {
                    const float sacc = red[(0 * (BATCH + 1) + bb) * 64 + tid] + red[(1 * (BATCH + 1) + bb) * 64 + tid] + red[(2 * (BATCH + 1) + bb) * 64 + tid] + red[(3 * (BATCH + 1) + bb) * 64 + tid];
                    p.MOD[((size_t)layer * (BATCH + 1) + bb) * 6 * D_MODEL + j] = sacc + bm;
                }
            }
        } else if (task < P0_NMOD + P0_NCOPY) {
            int r0 = (task - P0_NMOD) * 64;
            for (int i = tid; i < 64 * D_MODEL / 4; i += 256) {
                int row = r0 + i / (D_MODEL / 4), c4 = i % (D_MODEL / 4); int b = row / TT, s = row % TT;
                const float* src = s < CTX ? p.ctx + ((size_t)b * CTX + s) * D_MODEL : p.x + ((size_t)b * SEQ + (s - CTX)) * D_MODEL;
                *(u32x2*)(p.X + (size_t)row * D_MODEL + c4 * 4) = pk4(*(const f32x4*)(src + c4 * 4));

            }
        } else if (task == P0_NMOD + P0_NCOPY) {
            for (int i = tid; i < 64 * 16; i += 256) {
                int pos = i / 16, f = i % 16;
                double th = 1.0; for (int q = 0; q < f; ++q) th *= 0.5623413251903490804;
                double t2 = th * th, cs = 1.0, sn = th, tc = 1.0, ts = th;
                for (int n = 1; n < 14; ++n) { tc *= -t2 / ((2 * n - 1) * (2 * n)); ts *= -t2 / ((2 * n) * (2 * n + 1)); cs += tc; sn += ts; }
                double c = 1.0, s = 0.0;
                for (int q = 0; q < pos; ++q) { double cn = c * cs - s * sn, sn2 = s * cs + c * sn; c = cn; s = sn2; }
                p.ROPE[i * 2] = (float)c; p.ROPE[i * 2 + 1] = (float)s;
            }
            if (tid < 2) {
                const float* lp = p.ev_lambda + tid * 4 * 64; float s01 = 0.f, s23 = 0.f;
                for (int k = 0; k < 64; ++k) { s01 += lp[k] * lp[64 + k]; s23 += lp[128 + k] * lp[192 + k]; }
                float lam_init = 0.8f - 0.6f * expf(-0.3f * (float)(2 * tid));
                p.LAM[tid] = expf(s01) - expf(s23) + lam_init;
            }
            for (int i = tid; i < DEPTH * NE * 32; i += 256) p.CNT[i] = 0;
        } else {
            int layer = task - (P0_NMOD + P0_NCOPY + 1);
            for (int i = tid; i < NR * D_MODEL; i += 256) {
                int j = i / D_MODEL, k = i % D_MODEL;
                float v = j < NG ? p.moe_w_group[((size_t)layer * D_MODEL + k) * NG + j] : p.moe_w_router[((size_t)layer * D_MODEL + k) * NE + (j - NG)];
                p.WrT[(size_t)layer * NR * D_MODEL + i] = v;
            }
        }
    }
    {
        const int G = gridDim.x; int t = bid;
        ConvJob j0, j1, j2; f32x4 v0[4], v1[4], v2[4];
        const bool h0 = t < P0_C5, h1 = t + G < P0_C5;
        if (h0) { j0 = conv_job(p, t); conv_load(j0, tid, v0); } else { j0 = conv_job(p, 0); }
        if (h1) { j1 = conv_job(p, t + G); conv_load(j1, tid, v1); } else { j1 = j0; }
        j2 = j1;
        while (t < P0_C5) {
            const bool h2 = t + 2 * G < P0_C5;
            if (h2) { j2 = conv_job(p, t + 2 * G); conv_load(j2, tid, v2); }
            conv_store(fs, j0, tid, v0);
            j0 = j1; j1 = j2;
#pragma unroll
            for (int i = 0; i < 4; ++i) { v0[i] = v1[i]; v1[i] = v2[i]; }
            t += G;
        }
    }
}

DEV int chunk_of(int dir, int sp) { return dir == 0 ? sp : (sp < NCC ? NCC - 1 - sp : NCC + (NCH - 1 - sp)); }
DEV int sp_of(int dir, int u) { return dir == 0 ? u : (u < NCC ? NCC - 1 - u : NCC + (NCH - 1 - u)); }

template <bool RET>
DEV void gate_chain(const Params& p, int layer, int chain) {
    const int lane = tid_() & 63;
    const int dir = chain & 1, h = (chain >> 1) & 3, b = chain >> 3;
    float lg = 0.f;
    if (RET) lg = logsigf(p.od_decay[((layer >> 1) * 2 + dir) * HC + h]);
    float mprev = 0.f;
    for (int sp = 0; sp < NCH; ++sp) {
        const int u = chunk_of(dir, sp); const int sbase = u * CH;
        int i0 = 2 * lane, i1 = 2 * lane + 1;
        int s0 = dir ? sbase + 127 - i0 : sbase + i0, s1 = dir ? sbase + 127 - i1 : sbase + i1;
        float lf0, lf1, li0, li1;
        if (RET) { lf0 = lf1 = lg; li0 = li1 = 0.f; }
        else {
            const float* g0 = p.G + ((size_t)b * TT + s0) * 16; const float* g1 = p.G + ((size_t)b * TT + s1) * 16;
            li0 = g0[(2 * dir) * 4 + h]; li1 = g1[(2 * dir) * 4 + h];
            lf0 = logsigf(g0[(2 * dir + 1) * 4 + h]); lf1 = logsigf(g1[(2 * dir + 1) * 4 + h]);
        }
        float ps = lf0 + lf1;
        for (int d = 1; d < 64; d <<= 1) { float o = lane_up(ps, d, lane); if (lane >= d) ps += o; }
        float b1 = ps, b0 = ps - lf1;
        float bend = lane_read(ps, 63, lane);
        float a0 = li0 - b0, a1 = li1 - b1;
        float pm = fmaxf(a0, a1);
        float mx = pm;
        for (int d = 1; d < 64; d <<= 1) { float o = lane_up(mx, d, lane); if (lane >= d) mx = fmaxf(mx, o); }
        float pmx_prev = lane_up(mx, 1, lane); if (lane == 0) pmx_prev = -3.0e38f;
        float pm0 = fmaxf(pmx_prev, a0), pm1 = mx;
        float amax = lane_read(mx, 63, lane);
        float mnew, carry, mt0, mt1;
        if (RET) { mnew = 0.f; carry = __expf(bend); mt0 = mt1 = 0.f; }
        else { mnew = fmaxf(bend + mprev, bend + amax); carry = __expf(bend + mprev - mnew); mt0 = b0 + fmaxf(mprev, pm0); mt1 = b1 + fmaxf(mprev, pm1); }
        size_t o = (size_t)chain * TT;
        p.BC[o + s0] = b0; p.BC[o + s1] = b1; p.AT[o + s0] = a0; p.AT[o + s1] = a1; p.MT[o + s0] = mt0; p.MT[o + s1] = mt1;
        if (lane == 0) { float* ms = p.MS + ((size_t)chain * NCH + sp) * 4; ms[0] = mprev; ms[1] = mnew; ms[2] = bend; ms[3] = carry; }
        mprev = mnew;
    }
}

struct EpInEven {
    const Params& p; int layer, row0, col0;
    DEV void nat(f32x4 (&acc)[4][4], int wr, int wc, int lane) {
        const int r = lane & 15, quad = lane >> 4;
        const int c0 = col0 + wc * 64, rowb = row0 + wr * 64;
        const int b = row0 / TT; const int sb = rowb - b * TT; const bool lat = sb >= CTX;
        if (c0 < 1024) {
            bf16_t* dst = c0 < 512 ? p.Q1 : p.K1; const int cc = c0 & 511;
#pragma unroll
            for (int m = 0; m < 4; ++m) {
                const int row = rowb + m * 16 + r;
                f32x4 v0 = acc[m][0], v1 = acc[m][1], v2 = acc[m][2], v3 = acc[m][3];
                if (lat) {
                    const int t = sb + m * 16 + r - CTX; const int pr = t / GRID_W, pc = t % GRID_W;
                    const f32x4 ra = *(const f32x4*)(p.ROPE + (pr * 16 + quad * 4) * 2), rb = *(const f32x4*)(p.ROPE + (pr * 16 + quad * 4) * 2 + 4);
                    const f32x4 ca = *(const f32x4*)(p.ROPE + (pc * 16 + quad * 4) * 2), cb = *(const f32x4*)(p.ROPE + (pc * 16 + quad * 4) * 2 + 4);
                    const f32x4 cr = f32x4{ra[0], ra[2], rb[0], rb[2]}, sr = f32x4{ra[1], ra[3], rb[1], rb[3]};
                    const f32x4 cq = f32x4{ca[0], ca[2], cb[0], cb[2]}, sq = f32x4{ca[1], ca[3], cb[1], cb[3]};
                    const f32x4 o0 = v0 * cr - v2 * sr, o2 = v0 * sr + v2 * cr, o1 = v1 * cq - v3 * sq, o3 = v1 * sq + v3 * cq;
                    v0 = o0; v1 = o1; v2 = o2; v3 = o3;
                }
                bf16_t* d = dst + (size_t)row * 512 + cc + quad * 4;
                u32x2 w; w.x = pack2(v0[0], v0[1]); w.y = pack2(v0[2], v0[3]); *(u32x2*)d = w;
                w.x = pack2(v1[0], v1[1]); w.y = pack2(v1[2], v1[3]); *(u32x2*)(d + 16) = w;
                w.x = pack2(v2[0], v2[1]); w.y = pack2(v2[2], v2[3]); *(u32x2*)(d + 32) = w;
                w.x = pack2(v3[0], v3[1]); w.y = pack2(v3[2], v3[3]); *(u32x2*)(d + 48) = w;
            }
        } else if (c0 < 3584) {
            const bool pm = c0 < 2560; bf16_t* dst = pm ? p.PM : p.OG; const int ld = pm ? 1024 : 512; const int cc = pm ? c0 - 1536 : c0 - 3072;
#pragma unroll
            for (int m = 0; m < 4; ++m) {
                bf16_t* d = dst + (size_t)(rowb + m * 16 + r) * ld + cc + quad * 4;
#pragma unroll
                for (int n = 0; n < 4; ++n) { u32x2 w; w.x = pack2(acc[m][n][0], acc[m][n][1]); w.y = pack2(acc[m][n][2], acc[m][n][3]); *(u32x2*)(d + n * 16) = w; }
            }
        } else if (c0 == 3584) {
            const f32x4 gb = *(const f32x4*)(p.ev_gate_b + (layer >> 1) * 16 + quad * 4);
#pragma unroll
            for (int m = 0; m < 4; ++m) *(f32x4*)(p.G + (size_t)(rowb + m * 16 + r) * 16 + quad * 4) = acc[m][0] + gb;
        }
    }
    DEV void operator()(f32x4 (&acc)[4][4], int wr, int wc, int lane) {
        const int r = lane & 15, quad = lane >> 4;
        const int c0 = col0 + wc * 64, rowb = row0 + wr * 64;
        const int b = row0 / TT; const int sb = rowb - b * TT; const bool lat = sb >= CTX;
        if (c0 < 1024) {
            bf16_t* dst = c0 < 512 ? p.Q1 : p.K1; const int cc = c0 & 511;
#pragma unroll
            for (int m = 0; m < 4; ++m)
#pragma unroll
                for (int j = 0; j < 4; ++j) {
                    const int row = rowb + m * 16 + quad * 4 + j;
                    float v0 = acc[m][0][j], v1 = acc[m][1][j], v2 = acc[m][2][j], v3 = acc[m][3][j];
                    if (lat) {
                        const int t = sb + m * 16 + quad * 4 + j - CTX; const int pr = t / GRID_W, pc = t % GRID_W;
                        const float cr = p.ROPE[(pr * 16 + r) * 2], sr = p.ROPE[(pr * 16 + r) * 2 + 1], cq = p.ROPE[(pc * 16 + r) * 2], sq = p.ROPE[(pc * 16 + r) * 2 + 1];
                        float o0 = v0 * cr - v2 * sr, o2 = v0 * sr + v2 * cr, o1 = v1 * cq - v3 * sq, o3 = v1 * sq + v3 * cq;
                        v0 = o0; v1 = o1; v2 = o2; v3 = o3;
                    }
                    bf16_t* d = dst + (size_t)row * 512 + cc + r;
                    d[0] = f2bf(v0); d[16] = f2bf(v1); d[32] = f2bf(v2); d[48] = f2bf(v3);
                }
        } else if (c0 < 1536 || (c0 >= 2560 && c0 < 3072)) {
            const bool at = c0 < 1536; const int cc = at ? c0 - 1024 : c0 - 2560; const int h = cc >> 7, e0 = (cc & 127);
            bf16_t* dst = (at ? p.V1T : p.V2T) + ((size_t)(b * 4 + h) * 128) * TT;
#pragma unroll
            for (int m = 0; m < 4; ++m)
#pragma unroll
                for (int n = 0; n < 4; ++n) {
                    u32x2 o; o.x = pack2(acc[m][n][0], acc[m][n][1]); o.y = pack2(acc[m][n][2], acc[m][n][3]);
                    *(u32x2*)(dst + (size_t)(e0 + n * 16 + r) * TT + sb + m * 16 + quad * 4) = o;
                }
        } else if (c0 < 2560 || (c0 >= 3072 && c0 < 3584)) {
            const bool pm = c0 < 2560; bf16_t* dst = pm ? p.PM : p.OG; const int ld = pm ? 1024 : 512; const int cc = pm ? c0 - 1536 : c0 - 3072;
#pragma unroll
            for (int m = 0; m < 4; ++m)
#pragma unroll
                for (int j = 0; j < 4; ++j) {
                    const int row = rowb + m * 16 + quad * 4 + j; bf16_t* d = dst + (size_t)row * ld + cc + r;
                    d[0] = f2bf(acc[m][0][j]); d[16] = f2bf(acc[m][1][j]); d[32] = f2bf(acc[m][2][j]); d[48] = f2bf(acc[m][3][j]);
                }
        } else if (c0 == 3584) {
            const float gb = p.ev_gate_b[(layer >> 1) * 16 + r];
#pragma unroll
            for (int m = 0; m < 4; ++m)
#pragma unroll
                for (int j = 0; j < 4; ++j) { const int row = rowb + m * 16 + quad * 4 + j; p.G[(size_t)row * 16 + r] = acc[m][0][j] + gb; }
        }
    }
};

struct EpInOdd {
    const Params& p; int layer, row0, col0;
    DEV void nat(f32x4 (&acc)[4][4], int wr, int wc, int lane) {
        const int r = lane & 15, quad = lane >> 4;
        const int c0 = col0 + wc * 64, rowb = row0 + wr * 64;
        const int b = row0 / TT; const int sb = rowb - b * TT; const bool lat = sb >= CTX;
        if (c0 < 512 || (c0 >= 1024 && c0 < 1536)) {
            bf16_t* dst; int ld, cc; float scl = 1.f;
            if (c0 < 256) { dst = p.Q2; ld = 256; cc = c0; } else if (c0 < 512) { dst = p.K2; ld = 256; cc = c0 - 256; scl = 0.125f; } else { dst = p.OG; ld = 512; cc = c0 - 1024; }
#pragma unroll
            for (int m = 0; m < 4; ++m) {
                bf16_t* d = dst + (size_t)(rowb + m * 16 + r) * ld + cc + quad * 4;
#pragma unroll
                for (int n = 0; n < 4; ++n) { u32x2 w; w.x = pack2(acc[m][n][0] * scl, acc[m][n][1] * scl); w.y = pack2(acc[m][n][2] * scl, acc[m][n][3] * scl); *(u32x2*)(d + n * 16) = w; }
            }
        } else if (c0 >= 1536 && c0 < 2176) {
            const bool isq = c0 < 2048; bf16_t* dst = isq ? p.Q1 : p.K1; const int ld = isq ? 512 : 128; const int cc = isq ? c0 - 1536 : c0 - 2048;
            const float* g = p.od_qk_g + ((layer >> 1) * 2 + (isq ? 0 : 1)) * 64 + quad * 4;
            const f32x4 g0 = *(const f32x4*)g, g1 = *(const f32x4*)(g + 16), g2 = *(const f32x4*)(g + 32), g3 = *(const f32x4*)(g + 48);
#pragma unroll
            for (int m = 0; m < 4; ++m) {
                const int row = rowb + m * 16 + r;
                f32x4 v0 = acc[m][0], v1 = acc[m][1], v2 = acc[m][2], v3 = acc[m][3];
                float ss = 0.f;
#pragma unroll
                for (int j = 0; j < 4; ++j) ss += v0[j] * v0[j] + v1[j] * v1[j] + v2[j] * v2[j] + v3[j] * v3[j];
                ss = xadd16(ss); ss = xadd32(ss);
                const float rs = 1.0f / sqrtf(ss * (1.f / 64.f) + EPS);
                v0 = v0 * rs * g0; v1 = v1 * rs * g1; v2 = v2 * rs * g2; v3 = v3 * rs * g3;
                if (lat) {
                    const int t = sb + m * 16 + r - CTX; const int pr = t / GRID_W, pc = t % GRID_W;
                    const f32x4 ra = *(const f32x4*)(p.ROPE + (pr * 16 + quad * 4) * 2), rb = *(const f32x4*)(p.ROPE + (pr * 16 + quad * 4) * 2 + 4);
                    const f32x4 ca = *(const f32x4*)(p.ROPE + (pc * 16 + quad * 4) * 2), cb = *(const f32x4*)(p.ROPE + (pc * 16 + quad * 4) * 2 + 4);
                    const f32x4 cr = f32x4{ra[0], ra[2], rb[0], rb[2]}, sr = f32x4{ra[1], ra[3], rb[1], rb[3]};
                    const f32x4 cq = f32x4{ca[0], ca[2], cb[0], cb[2]}, sq = f32x4{ca[1], ca[3], cb[1], cb[3]};
                    const f32x4 o0 = v0 * cr - v2 * sr, o2 = v0 * sr + v2 * cr, o1 = v1 * cq - v3 * sq, o3 = v1 * sq + v3 * cq;
                    v0 = o0; v1 = o1; v2 = o2; v3 = o3;
                }
                bf16_t* d = dst + (size_t)row * ld + cc + quad * 4;
                u32x2 w; w.x = pack2(v0[0], v0[1]); w.y = pack2(v0[2], v0[3]); *(u32x2*)d = w;
                w.x = pack2(v1[0], v1[1]); w.y = pack2(v1[2], v1[3]); *(u32x2*)(d + 16) = w;
                w.x = pack2(v2[0], v2[1]); w.y = pack2(v2[2], v2[3]); *(u32x2*)(d + 32) = w;
                w.x = pack2(v3[0], v3[1]); w.y = pack2(v3[2], v3[3]); *(u32x2*)(d + 48) = w;
            }
        }
    }
    DEV void operator()(f32x4 (&acc)[4][4], int wr, int wc, int lane) {
        const int r = lane & 15, quad = lane >> 4;
        const int c0 = col0 + wc * 64, rowb = row0 + wr * 64;
        const int b = row0 / TT; const int sb = rowb - b * TT; const bool lat = sb >= CTX;
        if (c0 < 512 || (c0 >= 1024 && c0 < 1536)) {
            bf16_t* dst; int ld, cc; float scl = 1.f;
            if (c0 < 256) { dst = p.Q2; ld = 256; cc = c0; } else if (c0 < 512) { dst = p.K2; ld = 256; cc = c0 - 256; scl = 0.125f; } else { dst = p.OG; ld = 512; cc = c0 - 1024; }
#pragma unroll
            for (int m = 0; m < 4; ++m)
#pragma unroll
                for (int j = 0; j < 4; ++j) {
                    const int row = rowb + m * 16 + quad * 4 + j; bf16_t* d = dst + (size_t)row * ld + cc + r;
                    d[0] = f2bf(acc[m][0][j] * scl); d[16] = f2bf(acc[m][1][j] * scl); d[32] = f2bf(acc[m][2][j] * scl); d[48] = f2bf(acc[m][3][j] * scl);
                }
        } else if (c0 < 1024) {
            const int cc = c0 - 512; const int h = cc >> 7, e0 = cc & 127; bf16_t* dst = p.V2T + ((size_t)(b * 4 + h) * 128) * TT;
#pragma unroll
            for (int m = 0; m < 4; ++m)
#pragma unroll
                for (int n = 0; n < 4; ++n) {
                    u32x2 o; o.x = pack2(acc[m][n][0], acc[m][n][1]); o.y = pack2(acc[m][n][2], acc[m][n][3]);
                    *(u32x2*)(dst + (size_t)(e0 + n * 16 + r) * TT + sb + m * 16 + quad * 4) = o;
                }
        } else if (c0 < 2176) {
            const bool isq = c0 < 2048; bf16_t* dst = isq ? p.Q1 : p.K1; const int ld = isq ? 512 : 128; const int cc = isq ? c0 - 1536 : c0 - 2048;
            const float* g = p.od_qk_g + ((layer >> 1) * 2 + (isq ? 0 : 1)) * 64;
            const float g0 = g[r], g1 = g[16 + r], g2 = g[32 + r], g3 = g[48 + r];
#pragma unroll
            for (int m = 0; m < 4; ++m)
#pragma unroll
                for (int j = 0; j < 4; ++j) {
                    const int row = rowb + m * 16 + quad * 4 + j;
                    float v0 = acc[m][0][j], v1 = acc[m][1][j], v2 = acc[m][2][j], v3 = acc[m][3][j];
                    float ss = v0 * v0 + v1 * v1 + v2 * v2 + v3 * v3;
                    ss = rowred_add(ss);
                    const float rs = 1.0f / sqrtf(ss * (1.f / 64.f) + EPS);
                    v0 *= rs * g0; v1 *= rs * g1; v2 *= rs * g2; v3 *= rs * g3;
                    if (lat) {
                        const int t = sb + m * 16 + quad * 4 + j - CTX; const int pr = t / GRID_W, pc = t % GRID_W;
                        const float cr = p.ROPE[(pr * 16 + r) * 2], sr = p.ROPE[(pr * 16 + r) * 2 + 1], cq = p.ROPE[(pc * 16 + r) * 2], sq = p.ROPE[(pc * 16 + r) * 2 + 1];
                        float o0 = v0 * cr - v2 * sr, o2 = v0 * sr + v2 * cr, o1 = v1 * cq - v3 * sq, o3 = v1 * sq + v3 * cq;
                        v0 = o0; v1 = o1; v2 = o2; v3 = o3;
                    }
                    bf16_t* d = dst + (size_t)row * ld + cc + r;
                    d[0] = f2bf(v0); d[16] = f2bf(v1); d[32] = f2bf(v2); d[48] = f2bf(v3);
                }
        } else {
            const int kv = (c0 - 2176) >> 6; bf16_t* dst = p.V1T + ((size_t)(b * HKV + kv) * 64) * TT;
#pragma unroll
            for (int m = 0; m < 4; ++m)
#pragma unroll
                for (int n = 0; n < 4; ++n) {
                    u32x2 o; o.x = pack2(acc[m][n][0], acc[m][n][1]); o.y = pack2(acc[m][n][2], acc[m][n][3]);
                    *(u32x2*)(dst + (size_t)(n * 16 + r) * TT + sb + m * 16 + quad * 4) = o;
                }
        }
    }
};

DEV void phaseA(const Params& p, int layer, unsigned char* smem) {
    const bool odd = layer & 1;
    const int ncol = odd ? ODD_IN / 256 : EVEN_INP / 256; const int nrow = NTOK / 128;
    const bf16_t* W = odd ? p.WinO + (size_t)(layer >> 1) * ODD_IN * D_MODEL : p.WinE + (size_t)(layer >> 1) * EVEN_INP * D_MODEL;
    const int bid = bid_(); const int tid = tid_(); const int trow = tid >> 2, lc8 = g2_lc(tid) * 8;
    if (odd && bid < NCHAIN && tid < 64) gate_chain<true>(p, layer, bid);
    const WorkRange wr = xcd_range(nrow * ncol, bid);
    for (int t = wr.lo; t < wr.hi; t += wr.step) {
        int rt, ct; dense_tile(t, nrow, ncol, rt, ct); const int row0 = rt * 128, col0 = ct * 256;
        const bf16_t* a0 = p.HIN + (size_t)(row0 + trow) * D_MODEL + lc8;
        const bf16_t* bb = W + (size_t)(col0 + trow) * D_MODEL + lc8;
        if (odd) {
            EpInOdd ep{p, layer, row0, col0};
            if (ct == 2 || ct == 3 || ct == 8) gemm_tile2<2, false>(smem, a0, a0 + (size_t)64 * D_MODEL, bb, D_MODEL, D_MODEL / 32, ep);
            else gemm_tile2<2, true>(smem, a0, a0 + (size_t)64 * D_MODEL, bb, D_MODEL, D_MODEL / 32, ep);
        } else {
            EpInEven ep{p, layer, row0, col0};
            if (ct == 4 || ct == 5 || ct == 10 || ct == 11) gemm_tile2<2, false>(smem, a0, a0 + (size_t)64 * D_MODEL, bb, D_MODEL, D_MODEL / 32, ep);
            else gemm_tile2<2, true>(smem, a0, a0 + (size_t)64 * D_MODEL, bb, D_MODEL, D_MODEL / 32, ep);
        }
    }
#ifdef PROBE_GEMM
    {
        Params q = p; bf16_t* scr = (bf16_t*)p.DC;
        q.Q1 = scr; q.K1 = scr; q.V1T = scr; q.PM = scr; q.V2T = scr; q.OG = scr; q.G = (float*)scr; q.Q2 = scr; q.K2 = scr;
        for (int t = wr.lo; t < wr.hi; t += wr.step) {
            int rt, ct; dense_tile(t, nrow, ncol, rt, ct); const int row0 = rt * 128, col0 = ct * 256;
            const bf16_t* a0 = p.HIN + (size_t)(row0 + trow) * D_MODEL + lc8;
            const bf16_t* bb = W + (size_t)(col0 + trow) * D_MODEL + lc8;
            const int erow0 = (PROBE_GEMM == 2) ? (row0 % TT >= CTX ? CTX : 0) : row0;
            if (odd) {
                EpInOdd ep{q, layer, erow0, col0};
                if (ct == 2 || ct == 3 || ct == 8) gemm_tile2<2, false>(smem, a0, a0 + (size_t)64 * D_MODEL, bb, D_MODEL, D_MODEL / 32, ep);
                else gemm_tile2<2, true>(smem, a0, a0 + (size_t)64 * D_MODEL, bb, D_MODEL, D_MODEL / 32, ep);
            } else {
                EpInEven ep{q, layer, erow0, col0};
                if (ct == 4 || ct == 5 || ct == 10 || ct == 11) gemm_tile2<2, false>(smem, a0, a0 + (size_t)64 * D_MODEL, bb, D_MODEL, D_MODEL / 32, ep);
                else gemm_tile2<2, true>(smem, a0, a0 + (size_t)64 * D_MODEL, bb, D_MODEL, D_MODEL / 32, ep);
            }
        }
    }
#endif
}
DEV void phase0b(const Params& p) {
    const int total = NTOK * (D_MODEL / 4);
    for (int idx = bid_() * 256 + tid_(); idx < total; idx += gridDim.x * 256) {
        const int row = idx / (D_MODEL / 4), k = (idx % (D_MODEL / 4)) * 4; const int b = row / TT, sq = row % TT; const int bb = sq < CTX ? BATCH : b;
        const float* mod = p.MOD + (size_t)bb * 6 * D_MODEL;
        const f32x4 x = bf4(*(const u32x2*)(p.X + (size_t)row * D_MODEL + k)), sh = *(const f32x4*)(mod + k), sc = *(const f32x4*)(mod + D_MODEL + k);
        u32x2 o; o.x = pack2(x.x * (1.f + sc.x) + sh.x, x.y * (1.f + sc.y) + sh.y); o.y = pack2(x.z * (1.f + sc.z) + sh.z, x.w * (1.f + sc.w) + sh.w);
        *(u32x2*)(p.HIN + (size_t)row * D_MODEL + k) = o;
    }
}

DEV void phaseB(const Params& p, int layer) {
    const int tid = tid_();
    const int bid = bid_();
    if (bid < NCHAIN && tid < 64) gate_chain<false>(p, layer, bid);
    const float* cw = p.ev_conv_w + (size_t)(layer >> 1) * 3 * 1024; const float* cb = p.ev_conv_b + (size_t)(layer >> 1) * 1024;
    const int total = NTOK * 128;
    for (int idx = bid * 256 + tid; idx < total; idx += gridDim.x * 256) {
        const int row = idx >> 7, cg8 = (idx & 127) * 8; const int b = row / TT, s = row % TT;
        const bool hasp = (s != 0) && (s != CTX), hasn = (s != CTX - 1) && (s != TT - 1);
        Frag xm, x0, xp; x0.q = *(const u32x4*)(p.PM + (size_t)row * 1024 + cg8);
        xm.q = u32x4{0u, 0u, 0u, 0u}; xp.q = u32x4{0u, 0u, 0u, 0u};
        if (hasp) xm.q = *(const u32x4*)(p.PM + (size_t)(row - 1) * 1024 + cg8);
        if (hasn) xp.q = *(const u32x4*)(p.PM + (size_t)(row + 1) * 1024 + cg8);
        float y[8];
#pragma unroll
        for (int i = 0; i < 8; ++i) {
            const int ch = cg8 + i;
            float v = cb[ch] + bf2f((bf16_t)xm.v[i]) * cw[ch] + bf2f((bf16_t)x0.v[i]) * cw[1024 + ch] + bf2f((bf16_t)xp.v[i]) * cw[2048 + ch];
            y[i] = siluf(v);
        }
        if (cg8 < 512) {
            u32x4 o; o.x = pack2(y[0], y[1]); o.y = pack2(y[2], y[3]); o.z = pack2(y[4], y[5]); o.w = pack2(y[6], y[7]);
            *(u32x4*)(p.Q2 + (size_t)row * 512 + cg8) = o;
        } else {
            const float sc = 0.08838834764831845f;
#pragma unroll
            for (int i = 0; i < 8; ++i) y[i] *= sc;
            u32x4 o; o.x = pack2(y[0], y[1]); o.y = pack2(y[2], y[3]); o.z = pack2(y[4], y[5]); o.w = pack2(y[6], y[7]);
            const int kc = cg8 - 512; *(u32x4*)(p.K2 + (size_t)row * 512 + kc) = o;
        }
    }
}

constexpr int KLD1 = 136, KLD0 = 72, VLD = 72;
template <int NC, int DV, int QT>
struct AttnState { f32x4 O[NC][DV / 16][QT]; f32x4 L[NC][QT]; float m[NC][QT]; };

DEV float max3f(float a, float b, float c) {
#ifdef CPU_EMU
    return fmaxf(fmaxf(a, b), c);
#else
    float d; asm("v_max3_f32 %0, %1, %2, %3" : "=v"(d) : "v"(a), "v"(b), "v"(c)); return d;
#endif
}
DEV float max2f(float a, float b) {
#ifdef CPU_EMU
    return fmaxf(a, b);
#else
    float d; asm("v_max_f32 %0, %1, %2" : "=v"(d) : "v"(a), "v"(b)); return d;
#endif
}
DEV bool wave_any(bool pr) {
#ifdef CPU_EMU
    int v = pr ? 1 : 0; for (int m = 1; m < 64; m <<= 1) v |= __shfl_xor(v, m); return v != 0;
#else
    return __builtin_amdgcn_ballot_w64(pr) != 0;
#endif
}

template <int NC, int DV, int QT, int KW>
DEV void attn_core(bf16_t* sm, const bf16_t* Kg, int ldk, const bf16_t* VTg, int nkeys, const Frag (&qf)[NC][2][QT], AttnState<NC, DV, QT>& st, float sc2, int koff) {
    constexpr int KLD = KW + 8;
    constexpr int NKR = KW / 32, NVR = DV / 32;
    constexpr int KBUF = 64 * KLD, VBUF = DV * VLD;
    constexpr float TH = 6.0f;
    const float isc2 = 1.0f / sc2;
    const int tid = tid_(), lane = tid & 63, r = lane & 15, quad = lane >> 4;
    u32x4 kreg[NKR], vreg[NVR];
    constexpr int VTPR = 8 / NVR;
    const bf16_t* kp = Kg + (size_t)(tid >> 2) * ldk + (tid & 3) * NKR * 8;
    const bf16_t* vp0 = VTg + (size_t)(tid / VTPR) * TT + (tid % VTPR) * NVR * 8;
    const int klo = (tid >> 2) * KLD + (tid & 3) * NKR * 8;
    const int nt = nkeys >> 6;
    Frag ones; ones.u[0] = ones.u[1] = ones.u[2] = ones.u[3] = 0x3F803F80u;
    auto loadK = [&]() {
#pragma unroll
        for (int i = 0; i < NKR; ++i) kreg[i] = *(const u32x4*)(kp + i * 8);
        kp += (size_t)64 * ldk; };
    auto loadV = [&]() {
#pragma unroll
        for (int i = 0; i < NVR; ++i) vreg[i] = *(const u32x4*)(vp0 + i * 8);
        vp0 += 64; };
    auto storeK = [&](int buf) {
#pragma unroll
        for (int i = 0; i < NKR; ++i) *(u32x4*)(sm + buf * KBUF + klo + i * 8) = kreg[i]; };
    auto storeV = [&](int buf) {
        bf16_t* vrow = sm + buf * VBUF + 2 * KBUF + (tid / VTPR) * VLD;
#pragma unroll
        for (int i = 0; i < NVR; ++i) {
            const int c = (tid % VTPR) * NVR + i;
#pragma unroll
            for (int hh = 0; hh < 2; ++hh) {
                const int g = 2 * c + hh; const int blk = g >> 3, g32 = g & 7; const int pos = blk * 32 + (2 * (g32 & 3) + (g32 >> 2)) * 4;
                u32x2 w; w.x = hh ? vreg[i].z : vreg[i].x; w.y = hh ? vreg[i].w : vreg[i].y;
                *(u32x2*)(vrow + pos) = w;
            }
        } };
    float al[QT], thr[QT], mxs[QT]; bool resc = false;
#pragma unroll
    for (int qt = 0; qt < QT; ++qt) { al[qt] = 1.f; thr[qt] = 0.f; mxs[qt] = 0.f; }
    auto sm_step = [&](int k, f32x4 (&sn)[4][QT], Frag (&pfn)[QT][2], const bool force) {
        if (k < QT) {
            const int qt = k;
            float mx = max3f(sn[0][qt][0], sn[0][qt][1], sn[0][qt][2]);
            mx = max3f(mx, sn[0][qt][3], sn[1][qt][0]); mx = max3f(mx, sn[1][qt][1], sn[1][qt][2]); mx = max3f(mx, sn[1][qt][3], sn[2][qt][0]);
            mx = max3f(mx, sn[2][qt][1], sn[2][qt][2]); mx = max3f(mx, sn[2][qt][3], sn[3][qt][0]); mx = max3f(mx, sn[3][qt][1], sn[3][qt][2]);
            mxs[qt] = max2f(mx, sn[3][qt][3]);
        } else if (k == QT) {
            bool need = false;
#pragma unroll
            for (int qt = 0; qt < QT; ++qt) need = need || (mxs[qt] > thr[qt]);
            if (force || wave_any(need)) {
#pragma unroll
                for (int qt = 0; qt < QT; ++qt) {
                    float mx = xmax16(mxs[qt]); mx = xmax32(mx);
                    const float mn = fmaxf(st.m[0][qt], mx * sc2);
                    al[qt] *= __builtin_amdgcn_exp2f(st.m[0][qt] - mn);
                    st.m[0][qt] = mn; thr[qt] = (mn + TH) * isc2;
                }
                resc = true;
            }
        } else if (k <= 5 * QT) {
            const int qt = (k - QT - 1) >> 2, kt = (k - QT - 1) & 3; const float mn = st.m[0][qt];
#pragma unroll
            for (int jj = 0; jj < 4; ++jj) sn[kt][qt][jj] = __builtin_amdgcn_exp2f(sn[kt][qt][jj] * sc2 - mn);
        } else if (k <= 7 * QT) {
            const int qt = (k - 5 * QT - 1) >> 1, kk = (k - 5 * QT - 1) & 1;
            pfn[qt][kk].u[0] = pack2(sn[2 * kk][qt][0], sn[2 * kk][qt][1]); pfn[qt][kk].u[1] = pack2(sn[2 * kk][qt][2], sn[2 * kk][qt][3]);
            pfn[qt][kk].u[2] = pack2(sn[2 * kk + 1][qt][0], sn[2 * kk + 1][qt][1]); pfn[qt][kk].u[3] = pack2(sn[2 * kk + 1][qt][2], sn[2 * kk + 1][qt][3]);
#ifndef CPU_EMU
            asm volatile("" : "+v"(pfn[qt][kk].u[0]), "+v"(pfn[qt][kk].u[1]), "+v"(pfn[qt][kk].u[2]), "+v"(pfn[qt][kk].u[3]));
#endif
        }
    };
    constexpr int NSM = 7 * QT + 1;
    auto rescale = [&]() {
        if (resc) {
#pragma unroll
            for (int qt = 0; qt < QT; ++qt) {
#pragma unroll
                for (int et = 0; et < DV / 16; ++et) { st.O[0][et][qt][0] *= al[qt]; st.O[0][et][qt][1] *= al[qt]; st.O[0][et][qt][2] *= al[qt]; st.O[0][et][qt][3] *= al[qt]; }
                st.L[0][qt][0] *= al[qt]; st.L[0][qt][1] *= al[qt]; st.L[0][qt][2] *= al[qt]; st.L[0][qt][3] *= al[qt];
                al[qt] = 1.f;
            }
            resc = false;
        }
    };
    auto pv = [&](int buf, const Frag (&pf)[QT][2]) {
        const bf16_t* Vs = sm + 2 * KBUF + buf * VBUF;
#pragma unroll
        for (int kk = 0; kk < 2; ++kk)
#pragma unroll
            for (int qt = 0; qt < QT; ++qt) st.L[0][qt] = mfma16(ones.v, pf[qt][kk].v, st.L[0][qt]);
#pragma unroll
        for (int et = 0; et < DV / 16; ++et) {
#pragma unroll
            for (int kk = 0; kk < 2; ++kk) {
                Frag vf; vf.q = *(const u32x4*)(Vs + (et * 16 + r) * VLD + kk * 32 + quad * 8);
#pragma unroll
                for (int qt = 0; qt < QT; ++qt) st.O[0][et][qt] = mfma16(vf.v, pf[qt][kk].v, st.O[0][et][qt]);
            }
        } };
    Frag pfa[QT][2], pfb[QT][2];
    loadK();
    __syncthreads();
    storeK(0);
    loadK();
    loadV();
    __syncthreads();
    {
        f32x4 s0[4][QT];
        const bf16_t* Ks = sm;
#pragma unroll
        for (int kt = 0; kt < 4; ++kt) {
            Frag ka0, ka1;
            ka0.q = *(const u32x4*)(Ks + (kt * 16 + r) * KLD + koff + quad * 8);
            ka1.q = *(const u32x4*)(Ks + (kt * 16 + r) * KLD + koff + 32 + quad * 8);
#pragma unroll
            for (int qt = 0; qt < QT; ++qt) {
                f32x4 z = f32x4{0.f, 0.f, 0.f, 0.f};
                z = mfma16(ka0.v, qf[0][0][qt].v, z); z = mfma16(ka1.v, qf[0][1][qt].v, z); s0[kt][qt] = z;
            }
        }
#pragma unroll
        for (int k = 0; k < NSM; ++k) sm_step(k, s0, pfa, true);
    }
    storeK(1);
    storeV(0);
    __syncthreads();
    auto body = [&](const int par, const Frag (&pin)[QT][2], Frag (&pout)[QT][2]) {
        f32x4 sn[4][QT];
        rescale();
        {
            const bf16_t* Ks = sm + ((par + 1) & 1) * KBUF + r * KLD + koff + quad * 8;
            Frag ka[2][2];
            ka[0][0].q = *(const u32x4*)(Ks); ka[0][1].q = *(const u32x4*)(Ks + 32);
#pragma unroll
            for (int kt = 0; kt < 4; ++kt) {
                if (kt < 3) { ka[(kt + 1) & 1][0].q = *(const u32x4*)(Ks + (kt + 1) * 16 * KLD); ka[(kt + 1) & 1][1].q = *(const u32x4*)(Ks + (kt + 1) * 16 * KLD + 32); }
#pragma unroll
                for (int qt = 0; qt < QT; ++qt) {
                    f32x4 z = f32x4{0.f, 0.f, 0.f, 0.f};
                    z = mfma16(ka[kt & 1][0].v, qf[0][0][qt].v, z);
                    z = mfma16(ka[kt & 1][1].v, qf[0][1][qt].v, z); sn[kt][qt] = z;
                }
                if (kt < 2) {
#pragma unroll
                    for (int qt = 0; qt < QT; ++qt) st.L[0][qt] = mfma16(ones.v, pin[qt][kt].v, st.L[0][qt]);
                }
                SCHED_BARRIER();
            }
        }
        {
            const bf16_t* Vs = sm + 2 * KBUF + (par & 1) * VBUF + r * VLD + quad * 8;
            constexpr int NPV = (DV / 16) * 2; constexpr int SPP = (NSM + NPV - 1) / NPV;
            Frag vf[2];
            vf[0].q = *(const u32x4*)Vs;
#pragma unroll
            for (int i = 0; i < NPV; ++i) {
                const int et = i >> 1, kk = i & 1;
                if (i + 1 < NPV) vf[(i + 1) & 1].q = *(const u32x4*)(Vs + ((i + 1) >> 1) * 16 * VLD + ((i + 1) & 1) * 32);
#pragma unroll
                for (int qt = 0; qt < QT; ++qt) st.O[0][et][qt] = mfma16(vf[i & 1].v, pin[qt][kk].v, st.O[0][et][qt]);
#pragma unroll
                for (int q = 0; q < SPP; ++q) sm_step(i * SPP + q, sn, pout, false);
                SCHED_BARRIER();
            }
        }
    };
    int j = 0;
    for (; j + 2 < nt; j += 2) {
        loadK(); loadV();
        body(0, pfa, pfb);
        storeK(0); storeV(1);
        __syncthreads();
        loadK(); loadV();
        body(1, pfb, pfa);
        storeK(1); storeV(0);
        __syncthreads();
    }
    loadV(); body(0, pfa, pfb); storeV(1); __syncthreads();
    rescale();
    pv(1, pfb);
    __syncthreads();
}

DEV void attn_diff_item(const Params& p, int layer, int item, bf16_t* sm) {
    const int nqb = TT / 64; const int qb = item % nqb, h = (item / nqb) % HA, b = item / (nqb * HA);
    const int tid = tid_(), wid = tid >> 6, lane = tid & 63, r = lane & 15, quad = lane >> 4;
    const int comp = wid & 1, rg = wid >> 1;
    const int s0 = qb * 64; const bool ctxq = s0 < CTX; const int nkeys = ctxq ? CTX : TT;
    Frag qf[1][2][2];
#pragma unroll
    for (int ks = 0; ks < 2; ++ks)
#pragma unroll
        for (int qt = 0; qt < 2; ++qt) qf[0][ks][qt].q = *(const u32x4*)(p.Q1 + ((size_t)b * TT + s0 + rg * 32 + qt * 16 + r) * 512 + h * 128 + comp * 64 + ks * 32 + quad * 8);
    AttnState<1, 128, 2> st;
#pragma unroll
    for (int qt = 0; qt < 2; ++qt) {
        st.m[0][qt] = -1.0e30f; st.L[0][qt] = f32x4{0.f, 0.f, 0.f, 0.f};
#pragma unroll
        for (int et = 0; et < 8; ++et) st.O[0][et][qt] = f32x4{0.f, 0.f, 0.f, 0.f};
    }
    attn_core<1, 128, 2, 128>(sm, p.K1 + (size_t)b * TT * 512 + h * 128, 512, p.V1T + ((size_t)(b * HA + h) * 128) * TT, nkeys, qf, st, 0.125f * 1.4426950408889634f, comp * 64);
    const float lam = p.LAM[layer >> 1]; const float lam_init = 0.8f - 0.6f * expf(-0.3f * (float)layer);
    const float* sg = p.ev_subln_g + (layer >> 1) * 128;
    f32x4* xo = (f32x4*)sm;
    __syncthreads();
    if (comp == 1) {
#pragma unroll
        for (int qt = 0; qt < 2; ++qt) {
            const float i2 = lam / st.L[0][qt][0];
#pragma unroll
            for (int et = 0; et < 8; ++et) xo[((rg * 2 + qt) * 8 + et) * 64 + lane] = f32x4{st.O[0][et][qt][0] * i2, st.O[0][et][qt][1] * i2, st.O[0][et][qt][2] * i2, st.O[0][et][qt][3] * i2};
        }
    }
    __syncthreads();
    if (comp == 0) {
#pragma unroll
        for (int qt = 0; qt < 2; ++qt) {
            const float i1 = 1.f / st.L[0][qt][0];
            float ss = 0.f; f32x4 o[8];
#pragma unroll
            for (int et = 0; et < 8; ++et) {
                const f32x4 x2 = xo[((rg * 2 + qt) * 8 + et) * 64 + lane];
#pragma unroll
                for (int j = 0; j < 4; ++j) { float v = st.O[0][et][qt][j] * i1 - x2[j]; o[et][j] = v; ss += v * v; }
            }
            ss = xadd16(ss); ss = xadd32(ss);
            const float rs = (1.f - lam_init) / sqrtf(ss * (1.f / 128.f) + EPS);
            bf16_t* dst = p.CAT + ((size_t)b * TT + s0 + rg * 32 + qt * 16 + r) * 1024 + h * 128;
#pragma unroll
            for (int et = 0; et < 8; ++et) {
                const int e = et * 16 + quad * 4;
                u32x2 w; w.x = pack2(o[et][0] * rs * sg[e], o[et][1] * rs * sg[e + 1]); w.y = pack2(o[et][2] * rs * sg[e + 2], o[et][3] * rs * sg[e + 3]);
                *(u32x2*)(dst + e) = w;
            }
        }
    }
}

DEV void attn_gqa_item(const Params& p, int item, bf16_t* sm) {
    const int nqb = TT / 32; const int qb = item % nqb, kv = (item / nqb) % HKV, b = item / (nqb * HKV);
    const int tid = tid_(), wid = tid >> 6, lane = tid & 63, r = lane & 15, quad = lane >> 4;
    const int s0 = qb * 32; const bool ctxq = s0 < CTX; const int nkeys = ctxq ? CTX : TT; const int hq = kv * 4 + wid;
    Frag qf[1][2][2];
#pragma unroll
    for (int ks = 0; ks < 2; ++ks)
#pragma unroll
        for (int qt = 0; qt < 2; ++qt) qf[0][ks][qt].q = *(const u32x4*)(p.Q1 + ((size_t)b * TT + s0 + qt * 16 + r) * 512 + hq * 64 + ks * 32 + quad * 8);
    AttnState<1, 64, 2> st;
#pragma unroll
    for (int qt = 0; qt < 2; ++qt) {
        st.m[0][qt] = -1.0e30f; st.L[0][qt] = f32x4{0.f, 0.f, 0.f, 0.f};
#pragma unroll
        for (int et = 0; et < 4; ++et) st.O[0][et][qt] = f32x4{0.f, 0.f, 0.f, 0.f};
    }
    attn_core<1, 64, 2, 64>(sm, p.K1 + (size_t)b * TT * 128 + kv * 64, 128, p.V1T + ((size_t)(b * HKV + kv) * 64) * TT, nkeys, qf, st, 0.125f * 1.4426950408889634f, 0);
#pragma unroll
    for (int qt = 0; qt < 2; ++qt) {
        const float il = 1.f / st.L[0][qt][0];
        bf16_t* dst = p.CAT + ((size_t)b * TT + s0 + qt * 16 + r) * 1024 + 512 + hq * 64;
#pragma unroll
        for (int et = 0; et < 4; ++et) {
            const int e = et * 16 + quad * 4;
            u32x2 w; w.x = pack2(st.O[0][et][qt][0] * il, st.O[0][et][qt][1] * il); w.y = pack2(st.O[0][et][qt][2] * il, st.O[0][et][qt][3] * il);
            *(u32x2*)(dst + e) = w;
        }
    }
}

template <int DK, bool NRM>
DEV void rec_dc_item(const Params& p, int item, bf16_t* sm) {
    constexpr int ET = NRM ? 9 : 8; constexpr int ER = NRM ? EVR : 128; constexpr int SLD = 136;
    const int chain = item / NCH, sp = item % NCH; const int dir = chain & 1, h = (chain >> 1) & 3, b = chain >> 3;
    const int u = chunk_of(dir, sp), sbase = u * CH;
    const int tid = tid_(), wid = tid >> 6, lane = tid & 63, r = lane & 15, quad = lane >> 4;
    bf16_t* Vs = sm; bf16_t* Ks = sm + 128 * SLD; float* wk = (float*)(sm + 128 * SLD + DK * SLD);
    __syncthreads();
    const float* ms = p.MS + ((size_t)chain * NCH + sp) * 4;
    if (tid < 128) wk[tid] = __expf(ms[2] + p.AT[(size_t)chain * TT + sbase + tid] - ms[1]);
    const bf16_t* vt = p.V2T + ((size_t)(b * 4 + h) * 128) * TT + sbase;
    for (int c = tid; c < 128 * 16; c += 256) { int row = c >> 4, kc = c & 15; *(u32x4*)(Vs + row * SLD + kc * 8) = *(const u32x4*)(vt + (size_t)row * TT + kc * 8); }
    __syncthreads();
    const bf16_t* kg = p.K2 + ((size_t)b * TT + sbase) * (4 * DK) + h * DK;
    for (int c = tid; c < 128 * (DK / 8); c += 256) {
        const int sl = c & 127, dc8 = (c >> 7) * 8; Frag f; f.q = *(const u32x4*)(kg + (size_t)sl * (4 * DK) + dc8);
        const float w = wk[sl];
#pragma unroll
        for (int i = 0; i < 8; ++i) Ks[(dc8 + i) * SLD + sl] = f2bf(bf2f((bf16_t)f.v[i]) * w);
    }
    __syncthreads();
    constexpr int NTW = DK / 64;
    f32x4 acc[ET][NTW];
#pragma unroll
    for (int et = 0; et < ET; ++et)
#pragma unroll
        for (int n = 0; n < NTW; ++n) acc[et][n] = f32x4{0.f, 0.f, 0.f, 0.f};
#pragma unroll
    for (int ks = 0; ks < 4; ++ks) {
        Frag bf[NTW];
#pragma unroll
        for (int n = 0; n < NTW; ++n) bf[n].q = *(const u32x4*)(Ks + ((wid + 4 * n) * 16 + r) * SLD + ks * 32 + quad * 8);
#pragma unroll
        for (int et = 0; et < ET; ++et) {
            Frag af;
            if (et < 8) af.q = *(const u32x4*)(Vs + (et * 16 + r) * SLD + ks * 32 + quad * 8);
            else { const unsigned one = (r == 0) ? 0x3F803F80u : 0u; af.q = u32x4{one, one, one, one}; }
#pragma unroll
            for (int n = 0; n < NTW; ++n) acc[et][n] = mfma16(af.v, bf[n].v, acc[et][n]);
        }
    }
    bf16_t* dc = p.DC + ((size_t)chain * NCH + sp) * ER * DK;
#pragma unroll
    for (int et = 0; et < ET; ++et)
#pragma unroll
        for (int n = 0; n < NTW; ++n)
#pragma unroll
            for (int j = 0; j < 4; ++j) dc[(size_t)(et * 16 + quad * 4 + j) * DK + (wid + 4 * n) * 16 + r] = f2bf(acc[et][n][j]);
}

template <int DK, bool NRM>
DEV void rec_scan(const Params& p) {
    constexpr int ER = NRM ? EVR : 128;
    const int total = NCHAIN * ER * DK;
    for (int idx = bid_() * 256 + tid_(); idx < total; idx += gridDim.x * 256) {
        const int chain = idx / (ER * DK), el = idx % (ER * DK);
        float c = 0.f;
        for (int sp = 0; sp < NCH; ++sp) {
            const size_t o = ((size_t)chain * NCH + sp) * ER * DK + el;
            p.CP[o] = f2bf(c);
            c = p.MS[((size_t)chain * NCH + sp) * 4 + 3] * c + bf2f(p.DC[o]);
        }
    }
}

template <int DK, bool NRM>
DEV void rec_out_item(const Params& p, int layer, int item, bf16_t* sm) {
    constexpr int ET = NRM ? 9 : 8; constexpr int ER = NRM ? EVR : 128; constexpr int KLD = DK + 8; constexpr int SLD = 136; constexpr int NKS = DK / 32;
    const int half = item & 1, u = (item >> 1) % NCH, h = ((item >> 1) / NCH) & 3, b = (item >> 1) / (NCH * 4);
    const int tid = tid_(), wid = tid >> 6, lane = tid & 63, r = lane & 15, quad = lane >> 4;
    const int sbase = u * CH; const int tl = half * 64 + wid * 16 + r;
    const size_t rowt = (size_t)b * TT + sbase + tl; const int tq = tl - quad * 4;
    bf16_t* RA = sm; bf16_t* Vs = sm + ER * KLD; float* as_ = (float*)(Vs + 128 * SLD);
    __syncthreads();
    const bf16_t* kg = p.K2 + ((size_t)b * TT + sbase) * (4 * DK) + h * DK;
    for (int c = tid; c < 128 * (DK / 8); c += 256) { int row = c / (DK / 8), kc = c % (DK / 8); *(u32x4*)(RA + row * KLD + kc * 8) = *(const u32x4*)(kg + (size_t)row * (4 * DK) + kc * 8); }
    const int chain0 = (b * 4 + h) * 2;
    as_[tid] = p.AT[(size_t)(chain0 + (tid >> 7)) * TT + sbase + (tid & 127)];
    Frag qf[NKS];
#pragma unroll
    for (int ks = 0; ks < NKS; ++ks) qf[ks].q = *(const u32x4*)(p.Q2 + rowt * (4 * DK) + h * DK + ks * 32 + quad * 8);
    __syncthreads();
    f32x4 sT[8];
#pragma unroll
    for (int st = 0; st < 8; ++st) {
        if ((st & 1) == 0) SCHED_BARRIER();
        f32x4 z = f32x4{0.f, 0.f, 0.f, 0.f};
#pragma unroll
        for (int ks = 0; ks < NKS; ++ks) { Frag ka; ka.q = *(const u32x4*)(RA + (st * 16 + r) * KLD + ks * 32 + quad * 8); z = mfma16(ka.v, qf[ks].v, z); }
        sT[st] = z;
    }
    __syncthreads();
    const bf16_t* vt = p.V2T + ((size_t)(b * 4 + h) * 128) * TT + sbase;
    for (int c = tid; c < 128 * 16; c += 256) { int row = c >> 4, kc = c & 15; *(u32x4*)(Vs + row * SLD + kc * 8) = *(const u32x4*)(vt + (size_t)row * TT + kc * 8); }
    f32x4 hs[8];
#pragma unroll
    for (int et = 0; et < 8; ++et) hs[et] = f32x4{0.f, 0.f, 0.f, 0.f};
#pragma unroll 1
    for (int dir = 0; dir < 2; ++dir) {
        const int chain = chain0 + dir; const int sp = sp_of(dir, u);
        if (dir) __syncthreads();
        const bf16_t* cp = p.CP + ((size_t)chain * NCH + sp) * ER * DK;
        for (int c = tid; c < ER * (DK / 8); c += 256) { int row = c / (DK / 8), kc = c % (DK / 8); *(u32x4*)(RA + row * KLD + kc * 8) = *(const u32x4*)(cp + (size_t)row * DK + kc * 8); }
        __syncthreads();
        const float bt = p.BC[(size_t)chain * TT + sbase + tl], mt = p.MT[(size_t)chain * TT + sbase + tl];
        const float mprev = p.MS[((size_t)chain * NCH + sp) * 4];
        const float winter = __expf(bt + mprev - mt); const float ct = bt - mt;
        f32x4 acc[ET];
#pragma unroll
        for (int et = 0; et < ET; ++et) {
            if ((et & 1) == 0) SCHED_BARRIER();
            f32x4 z = f32x4{0.f, 0.f, 0.f, 0.f};
#pragma unroll
            for (int ks = 0; ks < NKS; ++ks) { Frag ca; ca.q = *(const u32x4*)(RA + (et * 16 + r) * KLD + ks * 32 + quad * 8); z = mfma16(ca.v, qf[ks].v, z); }
            acc[et] = f32x4{z[0] * winter, z[1] * winter, z[2] * winter, z[3] * winter};
        }
#pragma unroll
        for (int kk = 0; kk < 4; ++kk) {
            SCHED_BARRIER();
            Frag pf;
#pragma unroll
            for (int hf = 0; hf < 2; ++hf) {
                const int st = 2 * kk + hf; float w[4];
#pragma unroll
                for (int j = 0; j < 4; ++j) {
                    const int s = st * 16 + quad * 4 + j; const bool ok = dir ? ((st * 16 + j) >= tq) : ((st * 16 + j) <= tq);
                    w[j] = ok ? sT[st][j] * __expf(ct + as_[dir * 128 + s]) : 0.f;
                }
                pf.u[2 * hf] = pack2(w[0], w[1]); pf.u[2 * hf + 1] = pack2(w[2], w[3]);
            }
#pragma unroll
            for (int et = 0; et < ET; ++et) {
                Frag vf;
                if (et < 8) { const bf16_t* vp = Vs + (et * 16 + r) * SLD + kk * 32 + quad * 4; vf.d[0] = *(const u32x2*)vp; vf.d[1] = *(const u32x2*)(vp + 16); }
                else { const unsigned one = (r == 0) ? 0x3F803F80u : 0u; vf.q = u32x4{one, one, one, one}; }
                acc[et] = mfma16(vf.v, pf.v, acc[et]);
            }
        }
        if (NRM) {
            float den = lane_read(acc[ET - 1][0], r, lane);
            const float dn = 1.f / fmaxf(fabsf(den), __expf(-mt));
#pragma unroll
            for (int et = 0; et < 8; ++et) { hs[et][0] += acc[et][0] * dn; hs[et][1] += acc[et][1] * dn; hs[et][2] += acc[et][2] * dn; hs[et][3] += acc[et][3] * dn; }
        } else {
#pragma unroll
            for (int et = 0; et < 8; ++et) { hs[et][0] += acc[et][0]; hs[et][1] += acc[et][1]; hs[et][2] += acc[et][2]; hs[et][3] += acc[et][3]; }
        }
    }
    if (NRM) {
        const bf16_t* og = p.OG + rowt * 512 + h * 128; const float* g = p.ev_mnorm_g + (layer >> 1) * 512 + h * 128;
        float sum = 0.f;
#pragma unroll
        for (int et = 0; et < 8; ++et) {
            const u32x2 gq = *(const u32x2*)(og + et * 16 + quad * 4);
            hs[et][0] *= sigmf(bf2f((bf16_t)(gq.x & 0xFFFF))); hs[et][1] *= sigmf(bf2f((bf16_t)(gq.x >> 16)));
            hs[et][2] *= sigmf(bf2f((bf16_t)(gq.y & 0xFFFF))); hs[et][3] *= sigmf(bf2f((bf16_t)(gq.y >> 16)));
            sum += hs[et][0] + hs[et][1] + hs[et][2] + hs[et][3];
        }
        sum = xadd16(sum); sum = xadd32(sum);
        const float mu = sum * (1.f / 128.f); float var = 0.f;
#pragma unroll
        for (int et = 0; et < 8; ++et)
#pragma unroll
            for (int j = 0; j < 4; ++j) { float d = hs[et][j] - mu; var += d * d; }
        var = xadd16(var); var = xadd32(var);
        const float rs = 1.f / sqrtf(var * (1.f / 128.f) + EPS);
        bf16_t* dst = p.CAT + rowt * 1024 + 512 + h * 128;
#pragma unroll
        for (int et = 0; et < 8; ++et) {
            const int e = et * 16 + quad * 4;
            u32x2 w; w.x = pack2((hs[et][0] - mu) * rs * g[e], (hs[et][1] - mu) * rs * g[e + 1]); w.y = pack2((hs[et][2] - mu) * rs * g[e + 2], (hs[et][3] - mu) * rs * g[e + 3]);
            *(u32x2*)(dst + e) = w;
        }
    } else {
        const bf16_t* og = p.OG + rowt * 512 + h * 128;
        float ss = 0.f;
#pragma unroll
        for (int et = 0; et < 8; ++et)
#pragma unroll
            for (int j = 0; j < 4; ++j) ss += hs[et][j] * hs[et][j];
        ss = xadd16(ss); ss = xadd32(ss);
        const float rs = 1.f / sqrtf(ss * (1.f / 128.f) + EPS);
        bf16_t* dst = p.CAT + rowt * 1024 + h * 128;
#pragma unroll
        for (int et = 0; et < 8; ++et) {
            const int e = et * 16 + quad * 4; const u32x2 gq = *(const u32x2*)(og + e);
            u32x2 w; w.x = pack2(hs[et][0] * rs * siluf(bf2f((bf16_t)(gq.x & 0xFFFF))), hs[et][1] * rs * siluf(bf2f((bf16_t)(gq.x >> 16))));
            w.y = pack2(hs[et][2] * rs * siluf(bf2f((bf16_t)(gq.y & 0xFFFF))), hs[et][3] * rs * siluf(bf2f((bf16_t)(gq.y >> 16))));
            *(u32x2*)(dst + e) = w;
        }
    }
}

DEV void phaseC(const Params& p, int layer, unsigned char* smem) {
    const bool odd = layer & 1; const bool with_ctx = layer < DEPTH - 1;
    bf16_t* sm = (bf16_t*)smem;
    const int nqb_l = odd ? SEQ / 32 : SEQ / 64, nqb_c = odd ? CTX / 32 : CTX / 64; const int nh = odd ? HKV : HA;
    const int n_lat = BATCH * nh * nqb_l, n_ctx = with_ctx ? BATCH * nh * nqb_c : 0; const int n_dc = NCHAIN * NCH;
    for (int it = bid_(); it < n_lat + n_ctx + n_dc; it += gridDim.x) {
        if (it < n_lat + n_ctx) {
            int qb, bh;
            if (it < n_lat) {
                const int nbh = BATCH * nh;
                if ((nbh & 7) == 0 && (gridDim.x & 7) == 0) { const int x = it & 7, j = it >> 3; bh = (j / nqb_l) * 8 + x; qb = nqb_c + j % nqb_l; }
                else { qb = nqb_c + it % nqb_l; bh = it / nqb_l; }
            } else { int i2 = it - n_lat; qb = i2 % nqb_c; bh = i2 / nqb_c; }
            const int item = bh * (nqb_l + nqb_c) + qb;
            if (odd) attn_gqa_item(p, item, sm); else attn_diff_item(p, layer, item, sm);
        } else {
            const int item = it - n_lat - n_ctx;
            if (odd) rec_dc_item<64, false>(p, item, sm); else rec_dc_item<128, true>(p, item, sm);
        }
    }
}
DEV void phaseD(const Params& p, int layer) { if (layer & 1) rec_scan<64, false>(p); else rec_scan<128, true>(p); }
DEV void phaseE(const Params& p, int layer, unsigned char* smem) {
    const bool odd = layer & 1; const bool with_ctx = layer < DEPTH - 1;
    const int n = BATCH * 4 * NCH * 2;
    for (int it = bid_(); it < n; it += gridDim.x) {
        const int u = (it >> 1) % NCH; if (!with_ctx && u < NCC) continue;
        if (odd) rec_out_item<64, false>(p, layer, it, (bf16_t*)smem); else rec_out_item<128, true>(p, layer, it, (bf16_t*)smem);
    }
}

#ifdef CPU_EMU_SMALL
constexpr int FM_T = 16;
#else
constexpr int FM_T = 17;
#endif
constexpr int F_ROWS = 16 * FM_T, F_NA = 4 * F_ROWS, F_NCH = F_NA + 512, F_STAGE = F_NCH * 16, F_NJ = (F_NCH + 255) / 256;
static_assert(NTOK % F_ROWS == 0 && TT % F_ROWS == 0, "tall output-projection tiles must not straddle sequences");
static_assert(3 * F_STAGE <= LDS_BYTES - 16, "LDS ring of the tall tile");
DEV void phaseF(const Params& p, int layer, unsigned char* smem) {
    const bool with_ctx = layer < DEPTH - 1; const int ncol = D_MODEL / 128, nrow = NTOK / F_ROWS;
    const int tid = tid_(), wid = tid >> 6, lane = tid & 63, r = lane & 15, quad = lane >> 4;
    const int lc8 = g2_lc(tid) * 8;
    const WorkRange wr = xcd_range(nrow * ncol, bid_());
    for (int t = wr.lo; t < wr.hi; t += wr.step) {
        int rt, ct;
        if ((nrow & 7) == 0) { const int rpg = nrow >> 3; const int rg = t / (ncol * rpg), q = t % (ncol * rpg); ct = q / rpg; rt = rg * rpg + q % rpg; } else { rt = t / ncol; ct = t % ncol; }
        const int row0 = rt * F_ROWS, col0 = ct * 128; const int b = row0 / TT, s0 = row0 % TT;
        if (!with_ctx && s0 + F_ROWS <= CTX) continue;
        const bf16_t* abase = p.CAT + (size_t)(row0 + (tid >> 2)) * MIX_OUT + lc8;
        const bf16_t* bbase = p.WoutT + ((size_t)layer * D_MODEL + col0 + (tid >> 2)) * MIX_OUT + lc8;
        constexpr int JMIX = F_NA / 256;
        const bf16_t* mbase = (F_NA % 256 != 0 && tid < F_NA - 256 * JMIX) ? abase + (size_t)JMIX * 64 * MIX_OUT : bbase + (256 * JMIX - F_NA) / 4 * MIX_OUT;
        f32x4 acc[FM_T][2];
#pragma unroll
        for (int m = 0; m < FM_T; ++m) { acc[m][0] = f32x4{0.f, 0.f, 0.f, 0.f}; acc[m][1] = f32x4{0.f, 0.f, 0.f, 0.f}; }
        unsigned char* dst0 = smem + tid * 16;
        auto issue = [&](int kt, int slot) {
            unsigned char* d = dst0 + slot * F_STAGE;
#pragma unroll
            for (int j = 0; j < F_NJ; ++j) {
                if (256 * j + 255 < F_NA) glds16(abase + (size_t)j * 64 * MIX_OUT + kt * 32, d + j * 4096);
                else if (j == JMIX && F_NA % 256 != 0) glds16(mbase + kt * 32, d + j * 4096);
                else if (256 * j + 255 < F_NCH) glds16(bbase + (256 * j - F_NA) / 4 * MIX_OUT + kt * 32, d + j * 4096);
                else if (tid + 256 * j < F_NCH) glds16(bbase + (256 * j - F_NA) / 4 * MIX_OUT + kt * 32, d + j * 4096);
            }
        };
        constexpr int nkt = MIX_OUT / 32;
        RAW_BARRIER();
        issue(0, 0); issue(1, 1);
        const int pco = (quad ^ g2_h((r >> 2) & 3)) * 16;
        const unsigned char* afr = smem + r * 64 + pco;
        const unsigned char* bfr = smem + F_NA * 16 + (wid * 32 + r) * 64 + pco;
        int slot = 0;
        for (int kt = 0; kt < nkt; ++kt) {
            if (kt + 1 < nkt) wait_vm<6>(); else wait_vm<0>();
            RAW_BARRIER();
            if (kt + 2 < nkt) { int ns = slot + 2; if (ns >= 3) ns -= 3; issue(kt + 2, ns); }
            const unsigned char* as = afr + slot * F_STAGE; const unsigned char* bs = bfr + slot * F_STAGE;
            Frag b0, b1; b0.q = *(const u32x4*)bs; b1.q = *(const u32x4*)(bs + 16 * 64);
#ifndef CPU_EMU
            __builtin_amdgcn_s_setprio(1);
#endif
#pragma unroll
            for (int m = 0; m < FM_T; ++m) {
                Frag af; af.q = *(const u32x4*)(as + m * 16 * 64);
                acc[m][0] = mfma16(b0.v, af.v, acc[m][0]); acc[m][1] = mfma16(b1.v, af.v, acc[m][1]);
            }
#ifndef CPU_EMU
            __builtin_amdgcn_s_setprio(0);
#endif
            if (++slot == 3) slot = 0;
        }
        const float* gl = p.MOD + ((size_t)layer * (BATCH + 1) + b) * 6 * D_MODEL + 2 * D_MODEL; const float* gc = p.MOD + ((size_t)layer * (BATCH + 1) + BATCH) * 6 * D_MODEL + 2 * D_MODEL;
#pragma unroll
        for (int n = 0; n < 2; ++n) {
            const int col = col0 + wid * 32 + n * 16 + quad * 4; const f32x4 g_l = *(const f32x4*)(gl + col), g_c = *(const f32x4*)(gc + col);
#pragma unroll
            for (int m = 0; m < FM_T; ++m) {
                const int s = s0 + m * 16 + r; const bool isc = s < CTX;
                if (with_ctx || !isc) { u32x2* x = (u32x2*)(p.X + (size_t)(row0 + m * 16 + r) * D_MODEL + col); *x = pk4(ALPHA * bf4(*x) + (isc ? g_c : g_l) * acc[m][n]); }
                if ((m & 3) == 3) SCHED_BARRIER();
            }
        }
    }
}

constexpr int NV4 = D_MODEL / 256;
DEV void phaseG(const Params& p, int layer, unsigned char* smem) {
    const bool with_ctx = layer < DEPTH - 1;
    const int tid = tid_(); const int wid = tid >> 6, lane = tid & 63; const int bid = bid_();
    const float* lg = p.ln_g + (size_t)(layer * 2) * D_MODEL; const float* lb = p.ln_b + (size_t)(layer * 2) * D_MODEL;
    const float* wr = p.WrT + (size_t)layer * NR * D_MODEL;
    int* lcnt = (int*)smem; int* lbase = lcnt + 32; int* rec = lbase + 32;
    const int half = gridDim.x * 4, stride = half * 2;
    const int nit = (NTOK - bid * 4 + stride - 1) / stride;
    __syncthreads();
    if (tid < 32) lcnt[tid] = 0;
    for (int i = tid; i < nit * 8; i += 256) rec[i * 8] = -1;
    __syncthreads();
    int tok0 = bid * 4 + wid;
    u32x2 xq[2][NV4];
    auto ldx = [&](int t0) {
#pragma unroll
        for (int u = 0; u < 2; ++u) {
            const int tl = imin(t0 + u * half, NTOK - 1);
#pragma unroll
            for (int i = 0; i < NV4; ++i) xq[u][i] = *(const u32x2*)(p.X + (size_t)tl * D_MODEL + (i * 64 + lane) * 4);
        } };
    if (tok0 < NTOK) ldx(tok0);
    for (int it = 0; tok0 < NTOK; tok0 += stride, ++it) {
        f32x4 v[2][NV4]; int tk[2]; bool ok[2]; const float* mod[2];
#pragma unroll
        for (int u = 0; u < 2; ++u)
#pragma unroll
            for (int i = 0; i < NV4; ++i) v[u][i] = bf4(xq[u][i]);
        if (tok0 + stride < NTOK) ldx(tok0 + stride);
#pragma unroll
        for (int u = 0; u < 2; ++u) {
            const int t = tok0 + u * half; const int tc = imin(t, NTOK - 1); const int b = tc / TT, sq = tc % TT;
            tk[u] = tc; ok[u] = (t < NTOK) && (with_ctx || sq >= CTX);
            mod[u] = p.MOD + ((size_t)layer * (BATCH + 1) + (sq < CTX ? BATCH : b)) * 6 * D_MODEL;
        }
        float mu[2], rs[2];
#pragma unroll
        for (int u = 0; u < 2; ++u) { float sum = 0.f;
#pragma unroll
            for (int i = 0; i < NV4; ++i) sum += v[u][i].x + v[u][i].y + v[u][i].z + v[u][i].w;
            mu[u] = sum; }
        { mu[0] = wsum(mu[0]); mu[1] = wsum(mu[1]); }
#pragma unroll
        for (int u = 0; u < 2; ++u) { mu[u] *= (1.f / D_MODEL); float var = 0.f;
#pragma unroll
            for (int i = 0; i < NV4; ++i) { float a = v[u][i].x - mu[u], bq = v[u][i].y - mu[u], c = v[u][i].z - mu[u], d = v[u][i].w - mu[u]; var += a * a + bq * bq + c * c + d * d; }
            rs[u] = var; }
        { rs[0] = wsum(rs[0]); rs[1] = wsum(rs[1]); }
        f32x4 hv[2][NV4];
#pragma unroll
        for (int u = 0; u < 2; ++u) {
            rs[u] = 1.f / sqrtf(rs[u] * (1.f / D_MODEL) + EPS);
            if (lane == 0 && ok[u]) { p.STAT[tk[u] * 2] = mu[u]; p.STAT[tk[u] * 2 + 1] = rs[u]; }
#pragma unroll
            for (int i = 0; i < NV4; ++i) {
                const int k = (i * 64 + lane) * 4;
                const f32x4 g4 = *(const f32x4*)(lg + k), b4 = *(const f32x4*)(lb + k), sh = *(const f32x4*)(mod[u] + 3 * D_MODEL + k), sc = *(const f32x4*)(mod[u] + 4 * D_MODEL + k);
                const f32x4 x1 = (v[u][i] - mu[u]) * rs[u] * g4 + b4;
                hv[u][i] = x1 * (1.f + sc) + sh;
                if (ok[u]) { u32x2 o; o.x = pack2(hv[u][i].x, hv[u][i].y); o.y = pack2(hv[u][i].z, hv[u][i].w); *(u32x2*)(p.H + (size_t)tk[u] * D_MODEL + k) = o; }
            }
        }
        float gl[2][NG];
#pragma unroll
        for (int j = 0; j < NG; ++j) {
#pragma unroll
            for (int u = 0; u < 2; ++u) { float a = 0.f;
#pragma unroll
                for (int i = 0; i < NV4; ++i) { const f32x4 w4 = *(const f32x4*)(wr + (size_t)j * D_MODEL + (i * 64 + lane) * 4); a += hv[u][i].x * w4.x + hv[u][i].y * w4.y + hv[u][i].z * w4.z + hv[u][i].w * w4.w; }
                gl[u][j] = a; }
        }
#pragma unroll
        for (int j = 0; j < NG; ++j) { gl[0][j] = wsum(gl[0][j]); gl[1][j] = wsum(gl[1][j]); }
        int gi[2]; float gw[2]; float ev[2][EPG];
#pragma unroll
        for (int u = 0; u < 2; ++u) {
#pragma unroll
            for (int j = 0; j < NG; ++j) gl[u][j] += p.moe_b_group[layer * NG + j];
            int g = 0; float gm = gl[u][0];
#pragma unroll
            for (int j = 1; j < NG; ++j) if (gl[u][j] > gm) { gm = gl[u][j]; g = j; }
            float gs = 0.f;
#pragma unroll
            for (int j = 0; j < NG; ++j) gs += expf(gl[u][j] - gm);
            gi[u] = g; gw[u] = 1.f / gs;
            const float* wre = wr + (size_t)(NG + g * EPG) * D_MODEL;
#pragma unroll
            for (int j = 0; j < EPG; ++j) { float a = 0.f;
#pragma unroll
                for (int i = 0; i < NV4; ++i) { const f32x4 w4 = *(const f32x4*)(wre + (size_t)j * D_MODEL + (i * 64 + lane) * 4); a += hv[u][i].x * w4.x + hv[u][i].y * w4.y + hv[u][i].z * w4.z + hv[u][i].w * w4.w; }
                ev[u][j] = a; }
        }
#pragma unroll
        for (int j = 0; j < EPG; ++j) { ev[0][j] = wsum(ev[0][j]); ev[1][j] = wsum(ev[1][j]); }
#pragma unroll
        for (int u = 0; u < 2; ++u) {
#pragma unroll
            for (int j = 0; j < EPG; ++j) ev[u][j] += p.moe_b_router[layer * NE + gi[u] * EPG + j];
            int i1 = 0; float v1 = ev[u][0];
#pragma unroll
            for (int j = 1; j < EPG; ++j) if (ev[u][j] > v1) { v1 = ev[u][j]; i1 = j; }
            int i2 = -1; float v2 = -3.0e38f;
#pragma unroll
            for (int j = 0; j < EPG; ++j) if (j != i1 && ev[u][j] > v2) { v2 = ev[u][j]; i2 = j; }
            const float e2 = expf(v2 - v1); const float w1 = gw[u] / (1.f + e2), w2 = gw[u] * e2 / (1.f + e2);
            if (lane == 0 && ok[u]) {
                const int ea = gi[u] * EPG + i1, eb = gi[u] * EPG + i2;
                const int ra = atomicAdd(lcnt + ea, 1), rb = atomicAdd(lcnt + eb, 1);
                int* rc = rec + ((it * 2 + u) * 4 + wid) * 8;
                rc[0] = tk[u]; rc[1] = ea; rc[2] = eb; rc[3] = ra; rc[4] = rb; rc[5] = (int)__float_as_uint(w1); rc[6] = (int)__float_as_uint(w2);
            }
        }
    }
    __syncthreads();
    if (tid < 32) { const int c = lcnt[tid]; lbase[tid] = c ? atomicAdd(p.CNT + (layer * NE + tid) * 32, c) : 0; }
    __syncthreads();
    for (int i = tid; i < nit * 8; i += 256) {
        const int* rc = rec + i * 8; const int tk = rc[0];
        if (tk >= 0) {
            const int ea = rc[1], eb = rc[2]; const int pa = lbase[ea] + rc[3], pb = lbase[eb] + rc[4];
            p.LIST[(size_t)ea * NTOK + pa] = tk * 2; p.LISTW[(size_t)ea * NTOK + pa] = __uint_as_float((unsigned)rc[5]);
            p.LIST[(size_t)eb * NTOK + pb] = tk * 2 + 1; p.LISTW[(size_t)eb * NTOK + pb] = __uint_as_float((unsigned)rc[6]);
        }
    }
}

struct EpGU {
    const Params& p; int slot0, nvalid, col0;
    DEV void nat(f32x4 (&acc)[4][4], int wr, int wc, int lane) {
        const int r = lane & 15, quad = lane >> 4; const int j0 = (col0 + wc * 64) >> 1;
#pragma unroll
        for (int m = 0; m < 4; ++m) {
            const int rl = wr * 64 + m * 16 + r;
            if (rl < nvalid) {
                bf16_t* d = p.ACT + (size_t)(slot0 + rl) * D_EXPERT + j0 + quad * 4;
#pragma unroll
                for (int n = 0; n < 2; ++n) {
                    u32x2 w; w.x = pack2(siluf(acc[m][n][0]) * acc[m][n + 2][0], siluf(acc[m][n][1]) * acc[m][n + 2][1]);
                    w.y = pack2(siluf(acc[m][n][2]) * acc[m][n + 2][2], siluf(acc[m][n][3]) * acc[m][n + 2][3]);
                    *(u32x2*)(d + n * 16) = w;
                }
            }
        }
    }
    DEV void operator()(f32x4 (&acc)[4][4], int wr, int wc, int lane) {
        const int r = lane & 15, quad = lane >> 4; const int j0 = (col0 + wc * 64) >> 1;
#pragma unroll
        for (int m = 0; m < 4; ++m)
#pragma unroll
            for (int j = 0; j < 4; ++j) {
                const int rl = wr * 64 + m * 16 + quad * 4 + j;
                if (rl < nvalid) {
                    bf16_t* d = p.ACT + (size_t)(slot0 + rl) * D_EXPERT + j0 + r;
                    d[0] = f2bf(siluf(acc[m][0][j]) * acc[m][2][j]); d[16] = f2bf(siluf(acc[m][1][j]) * acc[m][3][j]);
                }
            }
    }
};
struct EpDown {
    const Params& p; const float* lw; const int* lp; int nvalid, col0;
    DEV void nat(f32x4 (&acc)[4][4], int wr, int wc, int lane) {
        const int r = lane & 15, quad = lane >> 4;
#pragma unroll
        for (int m = 0; m < 4; ++m) {
            const int rl = wr * 64 + m * 16 + r;
            if (rl < nvalid) {
                const float w = lw[rl]; bf16_t* d = p.YS + (size_t)lp[rl] * D_MODEL + col0 + wc * 64 + quad * 4;
#pragma unroll
                for (int n = 0; n < 4; ++n) { u32x2 o; o.x = pack2(w * acc[m][n][0], w * acc[m][n][1]); o.y = pack2(w * acc[m][n][2], w * acc[m][n][3]); *(u32x2*)(d + n * 16) = o; }
            }
        }
    }
    DEV void operator()(f32x4 (&acc)[4][4], int wr, int wc, int lane) {}
};
template <bool DOWN>
DEV void phaseHI(const Params& p, int layer, unsigned char* smem) {
    int* tpre = (int*)(smem + 74 * 1024); int* sbase = tpre + 40;
    const int tid = tid_(); const int bid = bid_();
    __syncthreads();
    if (tid == 0) {
        int ta = 0, sa = 0;
        for (int e = 0; e < NE; ++e) { const int c = p.CNT[(layer * NE + e) * 32]; tpre[e] = ta; sbase[e] = sa; ta += (c + 127) >> 7; sa += c; }
        tpre[NE] = ta;
        if (bid == 0 && !DOWN) for (int e = 0; e < NE; ++e) p.BASE[e] = sbase[e];
    }
    __syncthreads();
    const int ncol = DOWN ? D_MODEL / 256 : 2 * D_EXPERT / 256; const int ntile = tpre[NE] * ncol;
    const int trow = tid >> 2, lc8 = g2_lc(tid) * 8;
    const WorkRange wr = xcd_range(ntile, bid);
    for (int t = wr.lo; t < wr.hi; t += wr.step) {
        int e = 0;
        for (int q = 1; q < NE; ++q) if (tpre[q] * ncol <= t) e = q;
        const int nrt = tpre[e + 1] - tpre[e]; const int q2 = t - tpre[e] * ncol; const int ct = q2 / nrt, rt = q2 % nrt;
        const int cnt = p.CNT[(layer * NE + e) * 32]; const int nvalid = imin(128, cnt - rt * 128); const int slot0 = sbase[e] + rt * 128;
        if (!DOWN) {
            const int* list = p.LIST + (size_t)e * NTOK + rt * 128;
            const int r0 = imin(trow, nvalid - 1), r1 = imin(64 + trow, nvalid - 1);
            const bf16_t* a0 = p.H + (size_t)(list[r0] >> 1) * D_MODEL + lc8; const bf16_t* a1 = p.H + (size_t)(list[r1] >> 1) * D_MODEL + lc8;
            const bf16_t* bw = p.Wgu + ((size_t)(layer * NE + e) * 2 * D_EXPERT + ct * 256 + trow) * D_MODEL + lc8;
            EpGU ep{p, slot0, nvalid, ct * 256};
            gemm_tile2<2, true>(smem, a0, a1, bw, D_MODEL, D_MODEL / 32, ep);
        } else {
            const bf16_t* a0 = p.ACT + (size_t)(slot0 + trow) * D_EXPERT + lc8;
            const bf16_t* bw = p.WdT + ((size_t)(layer * NE + e) * D_MODEL + ct * 256 + trow) * D_EXPERT + lc8;
            EpDown ep{p, p.LISTW + (size_t)e * NTOK + rt * 128, p.LIST + (size_t)e * NTOK + rt * 128, nvalid, ct * 256};
            gemm_tile2<2, true>(smem, a0, a0 + (size_t)64 * D_EXPERT, bw, D_EXPERT, D_EXPERT / 32, ep);
        }
    }
}

DEV void phaseJ(const Params& p, int layer) {
    const bool with_ctx = layer < DEPTH - 1; const bool last = layer == DEPTH - 1;
    const int wid = tid_() >> 6, lane = tid_() & 63;
    const float* lg1 = p.ln_g + (size_t)(layer * 2) * D_MODEL; const float* lb1 = p.ln_b + (size_t)(layer * 2) * D_MODEL;
    const float* lg = p.ln_g + (size_t)(layer * 2 + 1) * D_MODEL; const float* lb = p.ln_b + (size_t)(layer * 2 + 1) * D_MODEL;
    const int stride = gridDim.x * 4;
    int tok = bid_() * 4 + wid;
    u32x2 xn[NV4], an[NV4], cn[NV4]; float mun = 0.f, rsn = 0.f;
    if (tok < NTOK) {
#pragma unroll
        for (int i = 0; i < NV4; ++i) {
            const int k = (i * 64 + lane) * 4;
            xn[i] = *(const u32x2*)(p.X + (size_t)tok * D_MODEL + k); an[i] = *(const u32x2*)(p.YS + (size_t)(tok * 2) * D_MODEL + k); cn[i] = *(const u32x2*)(p.YS + (size_t)(tok * 2 + 1) * D_MODEL + k);
        }
        mun = p.STAT[tok * 2]; rsn = p.STAT[tok * 2 + 1];
    }
    for (; tok < NTOK; tok += stride) {
        u32x2 x[NV4], a[NV4], c[NV4]; const float mu1 = mun, rs1 = rsn;
#pragma unroll
        for (int i = 0; i < NV4; ++i) { x[i] = xn[i]; a[i] = an[i]; c[i] = cn[i]; }
        const int tn = tok + stride;
        if (tn < NTOK) {
#pragma unroll
            for (int i = 0; i < NV4; ++i) {
                const int k = (i * 64 + lane) * 4;
                xn[i] = *(const u32x2*)(p.X + (size_t)tn * D_MODEL + k); an[i] = *(const u32x2*)(p.YS + (size_t)(tn * 2) * D_MODEL + k); cn[i] = *(const u32x2*)(p.YS + (size_t)(tn * 2 + 1) * D_MODEL + k);
            }
            mun = p.STAT[tn * 2]; rsn = p.STAT[tn * 2 + 1];
        }
        const int b = tok / TT, s = tok % TT; if (!with_ctx && s < CTX) continue;
        const int bb = s < CTX ? BATCH : b; const float* gate = p.MOD + ((size_t)layer * (BATCH + 1) + bb) * 6 * D_MODEL + 5 * D_MODEL;
        f32x4 v[NV4]; float sum = 0.f;
#pragma unroll
        for (int i = 0; i < NV4; ++i) {
            const int k = (i * 64 + lane) * 4; const f32x4 g = *(const f32x4*)(gate + k), g1 = *(const f32x4*)(lg1 + k), b1 = *(const f32x4*)(lb1 + k);
            const f32x4 x1 = (bf4(x[i]) - mu1) * rs1 * g1 + b1;
            v[i] = ALPHA * x1 + g * (bf4(a[i]) + bf4(c[i]));
            sum += v[i].x + v[i].y + v[i].z + v[i].w;
        }
        const float mu = wsum(sum) * (1.f / D_MODEL); float var = 0.f;
#pragma unroll
        for (int i = 0; i < NV4; ++i) { float a0 = v[i].x - mu, bq = v[i].y - mu, c0 = v[i].z - mu, d = v[i].w - mu; var += a0 * a0 + bq * bq + c0 * c0 + d * d; }
        const float rs = 1.f / sqrtf(wsum(var) * (1.f / D_MODEL) + EPS);
        float* dst = p.out + ((size_t)b * SEQ + (s - CTX)) * D_MODEL; bf16_t* dx = p.X + (size_t)tok * D_MODEL;
#pragma unroll
        for (int i = 0; i < NV4; ++i) {
            const int k = (i * 64 + lane) * 4; const f32x4 g4 = *(const f32x4*)(lg + k), b4 = *(const f32x4*)(lb + k);
            f32x4 o; o.x = (v[i].x - mu) * rs * g4.x + b4.x; o.y = (v[i].y - mu) * rs * g4.y + b4.y; o.z = (v[i].z - mu) * rs * g4.z + b4.z; o.w = (v[i].w - mu) * rs * g4.w + b4.w;
            if (last) *(f32x4*)(dst + k) = o; else *(u32x2*)(dx + k) = pk4(o);
            if (!last) {
                const float* mn = p.MOD + ((size_t)(layer + 1) * (BATCH + 1) + bb) * 6 * D_MODEL;
                const f32x4 sh = *(const f32x4*)(mn + k), sc = *(const f32x4*)(mn + D_MODEL + k);
                u32x2 hq; hq.x = pack2(o.x * (1.f + sc.x) + sh.x, o.y * (1.f + sc.y) + sh.y); hq.y = pack2(o.z * (1.f + sc.z) + sh.z, o.w * (1.f + sc.w) + sh.w);
                *(u32x2*)(p.HIN + (size_t)tok * D_MODEL + k) = hq;
            }
        }
    }
}

constexpr int PH_PER_LAYER = 10;
constexpr int NPHASE = 2 + DEPTH * PH_PER_LAYER;
DEV void run_phase(const Params& p, int ph, unsigned char* smem) {
    if (ph == 0) { phase0(p, smem); return; }
    if (ph == 1) { phase0b(p); return; }
    const int layer = (ph - 2) / PH_PER_LAYER, sub = (ph - 2) % PH_PER_LAYER;
    switch (sub) {
        case 0: phaseA(p, layer, smem); break;
        case 1: if (!(layer & 1)) phaseB(p, layer); break;
        case 2: phaseC(p, layer, smem); break;
        case 3: phaseD(p, layer); break;
        case 4: phaseE(p, layer, smem); break;
        case 5: phaseF(p, layer, smem); break;
        case 6: phaseG(p, layer, smem); break;
        case 7: phaseHI<false>(p, layer, smem); break;
        case 8: phaseHI<true>(p, layer, smem); break;
        default: phaseJ(p, layer); break;
    }
}
DEV bool phase_is_empty(int ph) { if (ph < 2) return false; return ((ph - 2) % PH_PER_LAYER) == 1 && (((ph - 2) / PH_PER_LAYER) & 1); }

struct Carver { char* base; size_t off; template <class T> T* take(size_t n) { off = (off + 255) & ~(size_t)255; T* r = (T*)(base + off); off += n * sizeof(T); return r; } };
static void make_params(Params& p, void* const* d_in, void* d_out, void* d_ws) {
    const float** in = (const float**)d_in;
    p.x = in[0]; p.c = in[1]; p.ctx = in[2]; p.c_ctx = in[3]; p.w_mod = in[4]; p.b_mod = in[5]; p.ln_g = in[6]; p.ln_b = in[7];
    p.ev_w_in = in[8]; p.ev_w_out = in[9]; p.ev_lambda = in[10]; p.ev_subln_g = in[11]; p.ev_conv_w = in[12]; p.ev_conv_b = in[13];
    p.ev_gate_b = in[14]; p.ev_mnorm_g = in[15]; p.od_w_in = in[16]; p.od_w_out = in[17]; p.od_decay = in[18]; p.od_qk_g = in[19];
    p.moe_w_group = in[20]; p.moe_b_group = in[21]; p.moe_w_router = in[22]; p.moe_b_router = in[23]; p.moe_w_gate = in[24]; p.moe_w_up = in[25]; p.moe_w_down = in[26];
    p.out = (float*)d_out;
    Carver cv{(char*)d_ws, 0};
    p.X = cv.take<bf16_t>((size_t)NTOK * D_MODEL);
    p.MOD = cv.take<float>((size_t)DEPTH * (BATCH + 1) * 6 * D_MODEL);
    p.ROPE = cv.take<float>(64 * 16 * 2); p.LAM = cv.take<float>(4);
    p.WrT = cv.take<float>((size_t)DEPTH * NR * D_MODEL);
    p.CNT = cv.take<int>(DEPTH * NE * 32); p.BASE = cv.take<int>(NE); p.BAR = cv.take<unsigned>(4096);
    p.WinE = cv.take<bf16_t>((size_t)2 * EVEN_INP * D_MODEL); p.WinO = cv.take<bf16_t>((size_t)2 * ODD_IN * D_MODEL);
    p.WoutT = cv.take<bf16_t>((size_t)DEPTH * D_MODEL * MIX_OUT);
    p.Wgu = cv.take<bf16_t>((size_t)DEPTH * NE * 2 * D_EXPERT * D_MODEL); p.WdT = cv.take<bf16_t>((size_t)DEPTH * NE * D_MODEL * D_EXPERT);
    p.STAT = cv.take<float>((size_t)NTOK * 2);
    p.CAT = cv.take<bf16_t>((size_t)NTOK * 1024); p.HIN = cv.take<bf16_t>((size_t)NTOK * D_MODEL);
    p.LIST = cv.take<int>((size_t)NE * NTOK); p.LISTW = cv.take<float>((size_t)NE * NTOK); p.TOKSLOT = cv.take<int>((size_t)NTOK * 2);
    const size_t mix0 = cv.off;
    p.Q1 = cv.take<bf16_t>((size_t)NTOK * 512); p.K1 = cv.take<bf16_t>((size_t)NTOK * 512); p.V1T = cv.take<bf16_t>((size_t)NTOK * 512);
    p.PM = cv.take<bf16_t>((size_t)NTOK * 1024); p.V2T = cv.take<bf16_t>((size_t)NTOK * 512); p.OG = cv.take<bf16_t>((size_t)NTOK * 512);
    p.G = cv.take<float>((size_t)NTOK * 16);
    p.Q2 = cv.take<bf16_t>((size_t)NTOK * 512); p.K2 = cv.take<bf16_t>((size_t)NTOK * 512); p.K2T = cv.take<bf16_t>((size_t)NTOK * 512);
    p.DC = cv.take<bf16_t>((size_t)NCHAIN * NCH * EVR * 128); p.CP = cv.take<bf16_t>((size_t)NCHAIN * NCH * EVR * 128);
    p.BC = cv.take<float>((size_t)NCHAIN * TT); p.AT = cv.take<float>((size_t)NCHAIN * TT); p.MT = cv.take<float>((size_t)NCHAIN * TT); p.MS = cv.take<float>((size_t)NCHAIN * NCH * 4);
    cv.off = mix0;
    p.H = cv.take<bf16_t>((size_t)NTOK * D_MODEL); p.ACT = cv.take<bf16_t>((size_t)(2 * NTOK + 128) * D_EXPERT); p.YS = cv.take<bf16_t>((size_t)2 * NTOK * D_MODEL);
}

#ifndef CPU_EMU
#define XB_TMO      128
#define XB_XCNT(j)  (256  + 64 * (j))
#define XB_XSUB(j)  (1280 + 64 * (j))
#define XB_XGEN(j)  (2304 + 64 * (j))
#define XB_TOP      3328
#define XB_TOPGEN   3392
#define XCD_BAR_WORDS 3456
#define XB_SPIN_CAP (1u << 20)
#define LAS __attribute__((address_space(3)))
__device__ __forceinline__ unsigned xb_ld(unsigned* p)              { return __hip_atomic_load(p, __ATOMIC_RELAXED, __HIP_MEMORY_SCOPE_AGENT); }
__device__ __forceinline__ unsigned xb_add(unsigned* p, unsigned v) { return __hip_atomic_fetch_add(p, v, __ATOMIC_RELAXED, __HIP_MEMORY_SCOPE_AGENT); }
__device__ __forceinline__ unsigned xb_xcc_id() { return (unsigned)__builtin_amdgcn_s_getreg((3 << 11) | 20) & 0xFu; }
#define XB_SPIN(cond, bar) do { unsigned _sp = 0; while (cond) { __builtin_amdgcn_s_sleep(1); \
    if ((++_sp & 255u) == 0u) { if (xb_ld(&(bar)[XB_TMO])) break; if (_sp > XB_SPIN_CAP) { atomicAdd(&(bar)[XB_TMO], 1u); break; } } } } while (0)
struct XcdBarrier { unsigned* bar; unsigned x; volatile LAS unsigned* st; };
__device__ __forceinline__ XcdBarrier xcd_barrier_post(unsigned* bar, volatile LAS unsigned* st) {
    XcdBarrier b; b.bar = bar; b.x = xb_xcc_id(); b.st = st;
    if (threadIdx.x == 0) (void)xb_add(&bar[XB_XCNT(b.x)], 1u);
    return b;
}
__device__ __forceinline__ void xcd_barrier_complete(unsigned* bar, unsigned x, unsigned& nloc, unsigned& nx) {
    const unsigned G = gridDim.x * gridDim.y * gridDim.z;
    unsigned sum, cnt, mine, sp = 0u;
    for (;;) {
        sum = 0u; cnt = 0u; mine = 0u;
#pragma unroll
        for (unsigned j = 0; j < 16; ++j) { const unsigned c = xb_ld(&bar[XB_XCNT(j)]); sum += c; cnt += (c > 0u) ? 1u : 0u; mine = (j == x) ? c : mine; }
        if (sum == G) break;
        __builtin_amdgcn_s_sleep(1);
        if ((++sp & 255u) == 0u) { if (xb_ld(&bar[XB_TMO])) break; if (sp > XB_SPIN_CAP) { atomicAdd(&bar[XB_TMO], 1u); break; } }
    }
    nloc = mine > 0u ? mine : 1u; nx = cnt > 0u ? cnt : 1u;
}
__device__ __forceinline__ void xcd_barrier(const XcdBarrier& b) {
    asm volatile("s_waitcnt vmcnt(0)" ::: "memory");
    __syncthreads();
    if (threadIdx.x == 0) {
        unsigned* bar = b.bar;
        __builtin_amdgcn_s_waitcnt(0);
        unsigned nloc = b.st[0], nx = b.st[1];
        if (nloc == 0u) { xcd_barrier_complete(bar, b.x, nloc, nx); b.st[0] = nloc; b.st[1] = nx; }
        const unsigned old = xb_add(&bar[XB_XSUB(b.x)], 1u);
        const unsigned gen = old / nloc;
        if (old + 1u == (gen + 1u) * nloc) {
            __builtin_amdgcn_fence(__ATOMIC_RELEASE, "agent");
            asm volatile("s_waitcnt vmcnt(0)" ::: "memory");
            const unsigned og = xb_add(&bar[XB_TOP], 1u);
            const unsigned tg = og / nx;
            if (og + 1u == (tg + 1u) * nx) xb_add(&bar[XB_TOPGEN], 1u);
            else XB_SPIN(xb_ld(&bar[XB_TOPGEN]) == tg, bar);
            __builtin_amdgcn_fence(__ATOMIC_ACQUIRE, "agent");
            xb_add(&bar[XB_XGEN(b.x)], 1u);
            asm volatile("s_waitcnt vmcnt(0)" ::: "memory");
        } else {
            XB_SPIN(xb_ld(&bar[XB_XGEN(b.x)]) == gen, bar);
            __builtin_amdgcn_fence(__ATOMIC_ACQUIRE, "agent");
            asm volatile("s_waitcnt vmcnt(0)" ::: "memory");
        }
    }
    __syncthreads();
}

__global__ void __launch_bounds__(NTHREADS, 2) fwd_megakernel(Params p) {
    __shared__ __attribute__((aligned(16))) unsigned char smem[LDS_BYTES];
    cg::grid_group grid = cg::this_grid();
    volatile LAS unsigned* xst = (volatile LAS unsigned*)(smem + LDS_BYTES - 16);
    if (threadIdx.x == 0) { xst[0] = 0u; xst[1] = 0u; }
    __syncthreads();
    const XcdBarrier xb = xcd_barrier_post(p.BAR, xst);
    grid.sync();
#ifdef PROBE_TS
    unsigned long long ts_acc = 0ull;
#endif
    for (int ph = 0; ph < NPHASE; ++ph) {
        if (phase_is_empty(ph)) continue;
#ifdef PROBE_TS
        const int psub_ = ph == 0 ? 10 : ph == 1 ? 11 : (ph - 2) % PH_PER_LAYER;
        const unsigned long long ts0 = __builtin_amdgcn_s_memrealtime();
#endif
#if defined(__HIP_DEVICE_COMPILE__)
        const __attribute__((address_space(4))) Params* pp = (const __attribute__((address_space(4))) Params*)__builtin_amdgcn_kernarg_segment_ptr();
        asm volatile("" : "+s"(pp));
        const Params q = *pp;
        run_phase(q, ph, smem);
#ifdef DBL_MASK
        { const int sub_ = ph == 0 ? 10 : ph == 1 ? 11 : (ph - 2) % PH_PER_LAYER; if ((DBL_MASK >> sub_) & 1) run_phase(q, ph, smem); }
#endif
#else
        run_phase(p, ph, smem);
#endif
#ifdef PROBE_TS
        const unsigned long long ts1 = __builtin_amdgcn_s_memrealtime();
        xcd_barrier(xb);
        const unsigned long long ts2 = __builtin_amdgcn_s_memrealtime();
        if (PROBE_TS == 100) ts_acc += ts2 - ts1; else if (psub_ == PROBE_TS) ts_acc += ts2 - ts0;
#else
        if (ph + 1 < NPHASE) xcd_barrier(xb);
#endif
    }
#ifdef PROBE_TS
    if (blockIdx.x == 0) { const int np = (int)(ts_acc / 100ull); for (int i = threadIdx.x; i < np; i += NTHREADS) p.out[i] += 1.0f; }
#endif
}

extern "C" void kernel_launch(void* const* d_in, const int* in_sizes, int n_in, void* d_out, int out_size, void* d_ws, size_t ws_size, hipStream_t stream) {
    static int grid_blocks = 0;
    if (!grid_blocks) {
        int dev = 0, cus = 0, per_cu = 0;
        (void)hipGetDevice(&dev); (void)hipDeviceGetAttribute(&cus, hipDeviceAttributeMultiprocessorCount, dev);
        (void)hipOccupancyMaxActiveBlocksPerMultiprocessor(&per_cu, fwd_megakernel, NTHREADS, 0);
        if (per_cu > 2) per_cu = 2;
        if (per_cu < 1) per_cu = 1;
        grid_blocks = cus * per_cu;
    }
    Params p; memset(&p, 0, sizeof(p));
    make_params(p, d_in, d_out, d_ws);
    (void)hipMemsetAsync(p.BAR, 0, 4096 * sizeof(unsigned), stream);
    void* args[] = {&p};
    hipError_t e = hipLaunchCooperativeKernel((void*)fwd_megakernel, dim3(grid_blocks), dim3(NTHREADS), args, 0, stream);
    if (e != hipSuccess) fprintf(stderr, "cooperative launch failed: %s (grid %d)\n", hipGetErrorString(e), grid_blocks);
}
#endif

#if defined(DIAG_KERNELS) && !defined(CPU_EMU)
template <int SUB, int ODD>
__global__ void __launch_bounds__(NTHREADS, 2) k_diag(Params p, int l2) {
    __shared__ __attribute__((aligned(16))) unsigned char smem[LDS_BYTES];
    const int layer = l2 * 2 + ODD;
    if (SUB == 100) { phase0(p, smem); return; }
    if (SUB == 0) phaseA(p, layer, smem);
    if (SUB == 1) phaseB(p, layer);
    if (SUB == 20) { for (int it = bid_(); it < 100; it += gridDim.x) { if (ODD) attn_gqa_item(p, it, (bf16_t*)smem); else attn_diff_item(p, layer, it, (bf16_t*)smem); } }
    if (SUB == 21) { for (int it = bid_(); it < 100; it += gridDim.x) { if (ODD) rec_dc_item<64, false>(p, it, (bf16_t*)smem); else rec_dc_item<128, true>(p, it, (bf16_t*)smem); } }
    if (SUB == 3) phaseD(p, layer);
    if (SUB == 4) phaseE(p, layer, smem);
    if (SUB == 5) phaseF(p, layer, smem);
    if (SUB == 6) phaseG(p, layer, smem);
    if (SUB == 7) phaseHI<false>(p, layer, smem);
    if (SUB == 8) phaseHI<true>(p, layer, smem);
    if (SUB == 9) phaseJ(p, layer);
}
template __global__ void k_diag<100, 0>(Params, int);
template __global__ void k_diag<0, 0>(Params, int);
template __global__ void k_diag<0, 1>(Params, int);
template __global__ void k_diag<1, 0>(Params, int);
template __global__ void k_diag<20, 0>(Params, int);
template __global__ void k_diag<20, 1>(Params, int);
template __global__ void k_diag<21, 0>(Params, int);
template __global__ void k_diag<21, 1>(Params, int);
template __global__ void k_diag<3, 0>(Params, int);
template __global__ void k_diag<4, 0>(Params, int);
template __global__ void k_diag<4, 1>(Params, int);
template __global__ void k_diag<5, 0>(Params, int);
template __global__ void k_diag<6, 0>(Params, int);
template __global__ void k_diag<7, 0>(Params, int);
template __global__ void k_diag<8, 0>(Params, int);
template __global__ void k_diag<9, 0>(Params, int);
#endif
```

```cpp
#ifdef CPU_EMU
#include "emu.h"
#else
#include <hip/hip_runtime.h>
#include <hip/hip_cooperative_groups.h>
#include <cstdio>
#include <cstdint>
#include <cstring>
namespace cg = cooperative_groups;
#endif

#define DEV __device__ __forceinline__
#ifdef CPU_EMU
#define SCHED_BARRIER() do {} while (0)
#else
#define SCHED_BARRIER() __builtin_amdgcn_sched_barrier(0)
#endif
#ifdef CPU_EMU
static inline void glds16(const void* g, void* l) { memcpy(l, g, 16); }
template <int N> static inline void wait_vm() {}
#define RAW_BARRIER() __syncthreads()
#else
__device__ __forceinline__ void glds16(const void* g, void* l) {
    __builtin_amdgcn_global_load_lds((const __attribute__((address_space(1))) unsigned*)g, (__attribute__((address_space(3))) unsigned*)l, 16, 0, 0);
}
template <int N> __device__ __forceinline__ void wait_vm() { asm volatile("s_waitcnt vmcnt(%0)" ::"n"(N) : "memory"); }
#define RAW_BARRIER() do { asm volatile("s_waitcnt lgkmcnt(0)" ::: "memory"); __builtin_amdgcn_s_barrier(); } while (0)
#endif
#ifdef CPU_EMU
static inline int tid_() { return (int)threadIdx.x; }
static inline int bid_() { return (int)blockIdx.x; }
#else
__device__ __forceinline__ int tid_() { int t = threadIdx.x; asm volatile("" : "+v"(t)); return t; }
__device__ __forceinline__ int bid_() { int b = blockIdx.x; asm volatile("" : "+s"(b)); return b; }
#endif

#ifdef CPU_EMU_SMALL
constexpr int D_MODEL = 256, BATCH = 2, SEQ = 256, CTX = 256, D_EXPERT = 128;
#else
constexpr int D_MODEL = 1024, BATCH = 4, SEQ = 4096, CTX = 256, D_EXPERT = 512;
#endif
constexpr int DEPTH = 4, GRID_W = 64, CH = 128;
constexpr int TT = CTX + SEQ, NTOK = BATCH * TT, NCH = TT / CH, NCC = CTX / CH;
constexpr float EPS = 1e-5f;
constexpr float ALPHA = 1.6817928305074290f;
constexpr int HA = 4, HB = 4, HC = 4, HD = 8, HKV = 2;
constexpr int EVEN_IN = 3600, EVEN_INP = 3840, ODD_IN = 2304, MIX_OUT = 1024;
constexpr int NG = 4, EPG = 8, NE = 32, NR = NG + NE;
constexpr int NTHREADS = 256;
constexpr int LDS_BYTES = 76 * 1024;
constexpr int NCHAIN = BATCH * 4 * 2;
constexpr int EVR = 144;

typedef unsigned short bf16_t;
typedef short bf16x8 __attribute__((ext_vector_type(8)));
typedef float f32x4 __attribute__((ext_vector_type(4)));
typedef unsigned u32x4 __attribute__((ext_vector_type(4)));
typedef unsigned u32x2 __attribute__((ext_vector_type(2)));
union Frag { bf16x8 v; u32x4 q; u32x2 d[2]; unsigned u[4]; };
DEV int imin(int a, int b) { return a < b ? a : b; }

#ifdef CPU_EMU
DEV bf16_t f2bf(float f) { unsigned u = __float_as_uint(f); u += 0x7FFFu + ((u >> 16) & 1u); return (bf16_t)(u >> 16); }
DEV unsigned pack2(float a, float b) { return (unsigned)f2bf(a) | ((unsigned)f2bf(b) << 16); }
#else
typedef __bf16 hwbf16x2 __attribute__((ext_vector_type(2)));
typedef float hwf32x2 __attribute__((ext_vector_type(2)));
DEV unsigned pack2(float a, float b) { hwf32x2 v = {a, b}; hwbf16x2 h = __builtin_convertvector(v, hwbf16x2); return __builtin_bit_cast(unsigned, h); }
DEV bf16_t f2bf(float f) { return (bf16_t)(pack2(f, 0.f) & 0xFFFFu); }
#endif
DEV float bf2f(bf16_t h) { return __uint_as_float(((unsigned)h) << 16); }
DEV f32x4 bf4(u32x2 v) { return f32x4{__uint_as_float(v.x << 16), __uint_as_float(v.x & 0xFFFF0000u), __uint_as_float(v.y << 16), __uint_as_float(v.y & 0xFFFF0000u)}; }
DEV u32x2 pk4(f32x4 v) { u32x2 o; o.x = pack2(v.x, v.y); o.y = pack2(v.z, v.w); return o; }
DEV float siluf(float x) { return x / (1.0f + __expf(-x)); }
DEV float sigmf(float x) { return 1.0f / (1.0f + __expf(-x)); }
DEV float logsigf(float x) { return (x >= 0.f) ? -log1pf(expf(-x)) : x - log1pf(expf(x)); }
#ifdef CPU_EMU
DEV float rowred_add(float v) { v += __shfl_xor(v, 1); v += __shfl_xor(v, 2); v += __shfl_xor(v, 4); v += __shfl_xor(v, 8); return v; }
DEV float rowred_max(float v) { v = fmaxf(v, __shfl_xor(v, 1)); v = fmaxf(v, __shfl_xor(v, 2)); v = fmaxf(v, __shfl_xor(v, 4)); v = fmaxf(v, __shfl_xor(v, 8)); return v; }
DEV float lane_read(float v, int src, int lane) { return __shfl(v, src); }
DEV float lane_up(float v, int d, int lane) { return __shfl_up(v, d); }
#else
template <int CTRL> DEV float dppf(float v) { return __uint_as_float((unsigned)__builtin_amdgcn_update_dpp(0, (int)__float_as_uint(v), CTRL, 0xF, 0xF, true)); }
DEV float rowred_add(float v) { v += dppf<0xB1>(v); v += dppf<0x4E>(v); v += dppf<0x141>(v); v += dppf<0x140>(v); return v; }
DEV float rowred_max(float v) { v = fmaxf(v, dppf<0xB1>(v)); v = fmaxf(v, dppf<0x4E>(v)); v = fmaxf(v, dppf<0x141>(v)); v = fmaxf(v, dppf<0x140>(v)); return v; }
DEV float lane_read(float v, int src, int lane) { return __uint_as_float((unsigned)__builtin_amdgcn_ds_bpermute((src & 63) << 2, (int)__float_as_uint(v))); }
DEV float lane_up(float v, int d, int lane) { const float o = __uint_as_float((unsigned)__builtin_amdgcn_ds_bpermute(((lane - d) & 63) << 2, (int)__float_as_uint(v))); return lane >= d ? o : v; }
#endif
#ifdef CPU_EMU
DEV float xch16(float v) { return __shfl_xor(v, 16); }
DEV float xch32(float v) { return __shfl_xor(v, 32); }
#else
typedef unsigned hwu2 __attribute__((ext_vector_type(2)));
DEV void xpair16(float v, float& a, float& b) { const unsigned u = __float_as_uint(v); hwu2 r = __builtin_amdgcn_permlane16_swap(u, u, false, false); a = __uint_as_float(r.x); b = __uint_as_float(r.y); }
DEV void xpair32(float v, float& a, float& b) { const unsigned u = __float_as_uint(v); hwu2 r = __builtin_amdgcn_permlane32_swap(u, u, false, false); a = __uint_as_float(r.x); b = __uint_as_float(r.y); }
#endif
DEV float xmax16(float v) {
#ifdef CPU_EMU
    return fmaxf(v, xch16(v));
#else
    float a, b; xpair16(v, a, b); return fmaxf(a, b);
#endif
}
DEV float xmax32(float v) {
#ifdef CPU_EMU
    return fmaxf(v, xch32(v));
#else
    float a, b; xpair32(v, a, b); return fmaxf(a, b);
#endif
}
DEV float xadd16(float v) {
#ifdef CPU_EMU
    return v + xch16(v);
#else
    float a, b; xpair16(v, a, b); return a + b;
#endif
}
DEV float xadd32(float v) {
#ifdef CPU_EMU
    return v + xch32(v);
#else
    float a, b; xpair32(v, a, b); return a + b;
#endif
}
DEV float wsum(float v) { v = rowred_add(v); v = xadd16(v); return xadd32(v); }
DEV float wmax(float v) { v = rowred_max(v); v = xmax16(v); return xmax32(v); }
DEV f32x4 mfma16(bf16x8 a, bf16x8 b, f32x4 c) { return __builtin_amdgcn_mfma_f32_16x16x32_bf16(a, b, c, 0, 0, 0); }

struct WorkRange { int lo, hi, step; };
DEV WorkRange xcd_range(int T, int bid) {
    WorkRange w; const int G = gridDim.x;
    if ((G & 7) == 0) { const int x = bid & 7, k = bid >> 3; w.lo = (int)(((long long)x * T) >> 3) + k; w.hi = (int)(((long long)(x + 1) * T) >> 3); w.step = G >> 3; }
    else { w.lo = bid; w.hi = T; w.step = G; }
    return w;
}
DEV void dense_tile(int t, int nrow, int ncol, int& rt, int& ct) {
    if ((nrow & 7) == 0) { const int rpg = nrow >> 3; const int rg = t / (ncol * rpg), q = t % (ncol * rpg); ct = q / rpg; rt = rg * rpg + q % rpg; }
    else { rt = t / ncol; ct = t % ncol; }
}

struct Params {
    const float *x, *c, *ctx, *c_ctx, *w_mod, *b_mod, *ln_g, *ln_b, *ev_w_in, *ev_w_out, *ev_lambda, *ev_subln_g, *ev_conv_w, *ev_conv_b,
        *ev_gate_b, *ev_mnorm_g, *od_w_in, *od_w_out, *od_decay, *od_qk_g, *moe_w_group, *moe_b_group, *moe_w_router, *moe_b_router,
        *moe_w_gate, *moe_w_up, *moe_w_down;
    float* out;
    bf16_t* X;
    float *MOD, *ROPE, *LAM, *WrT;
    int* CNT; unsigned* BAR;
    bf16_t *WinE, *WinO, *WoutT, *Wgu, *WdT;
    bf16_t *Q1, *K1, *V1T;
    bf16_t *PM, *V2T, *OG;
    float* G;
    bf16_t *Q2, *K2, *K2T;
    bf16_t* CAT;
    bf16_t *DC, *CP;
    float *BC, *AT, *MT, *MS, *CH2;
    bf16_t *H, *ACT, *HIN, *YS; float* STAT;
    int *LIST, *TOKSLOT, *BASE; float *LISTW;
};

constexpr int GLD = 72;
constexpr int GT = 128 * GLD;

struct BLoadW {
    const bf16_t* base; int ld; u32x4 r[4];
    DEV void fetch(int kt, int tid) {
#pragma unroll
        for (int i = 0; i < 4; ++i) { int c = tid + 256 * i, row = c >> 3, kc = c & 7; r[i] = *(const u32x4*)(base + (size_t)row * ld + kt * 64 + kc * 8); }
    }
    DEV void commit(bf16_t* S, int tid) {
#pragma unroll
        for (int i = 0; i < 4; ++i) { int c = tid + 256 * i, row = c >> 3, kc = c & 7; *(u32x4*)(S + row * GLD + kc * 8) = r[i]; }
    }
};
struct ALoadB {
    const bf16_t* base; int ld; u32x4 r[4];
    DEV void fetch(int kt, int tid) {
#pragma unroll
        for (int i = 0; i < 4; ++i) { int c = tid + 256 * i, row = c >> 3, kc = c & 7; r[i] = *(const u32x4*)(base + (size_t)row * ld + kt * 64 + kc * 8); }
    }
    DEV void commit(bf16_t* S, int tid) {
#pragma unroll
        for (int i = 0; i < 4; ++i) { int c = tid + 256 * i, row = c >> 3, kc = c & 7; *(u32x4*)(S + row * GLD + kc * 8) = r[i]; }
    }
};
struct ALoadG {
    const bf16_t* H; const int* list; int nvalid; u32x4 r[4];
    DEV void fetch(int kt, int tid) {
#pragma unroll
        for (int i = 0; i < 4; ++i) {
            int c = tid + 256 * i, row = c >> 3, kc = c & 7; int rr = row < nvalid ? row : nvalid - 1; int tok = list[rr];
            r[i] = *(const u32x4*)(H + (size_t)tok * D_MODEL + kt * 64 + kc * 8);
        }
    }
    DEV void commit(bf16_t* S, int tid) {
#pragma unroll
        for (int i = 0; i < 4; ++i) { int c = tid + 256 * i, row = c >> 3, kc = c & 7; *(u32x4*)(S + row * GLD + kc * 8) = r[i]; }
    }
};
struct ALoadX {
    const float* base; const float *sc, *sh; f32x4 r[8]; f32x4 s4, h4;
    DEV void fetch(int kt, int tid) {
        int kc = tid & 15;
        s4 = *(const f32x4*)(sc + kt * 64 + kc * 4); h4 = *(const f32x4*)(sh + kt * 64 + kc * 4);
#pragma unroll
        for (int i = 0; i < 8; ++i) { int row = (tid >> 4) + 16 * i; r[i] = *(const f32x4*)(base + (size_t)row * D_MODEL + kt * 64 + kc * 4); }
    }
    DEV void commit(bf16_t* S, int tid) {
        int kc = tid & 15;
#pragma unroll
        for (int i = 0; i < 8; ++i) {
            int row = (tid >> 4) + 16 * i;
            u32x2 o; o.x = pack2(r[i].x * (1.f + s4.x) + h4.x, r[i].y * (1.f + s4.y) + h4.y); o.y = pack2(r[i].z * (1.f + s4.z) + h4.z, r[i].w * (1.f + s4.w) + h4.w);
            *(u32x2*)(S + row * GLD + kc * 4) = o;
        }
    }
};

template <class AL, class BL, class EP>
DEV void gemm_tile(bf16_t* sm, AL& al, BL& bl, int nkt, EP& ep) {
    const int tid = tid_(), wid = tid >> 6, lane = tid & 63, wr = wid >> 1, wc = wid & 1, r = lane & 15, quad = lane >> 4;
    bf16_t* As = sm; bf16_t* Bs = sm + 2 * GT;
    f32x4 acc[4][4];
#pragma unroll
    for (int m = 0; m < 4; ++m)
#pragma unroll
        for (int n = 0; n < 4; ++n) acc[m][n] = f32x4{0.f, 0.f, 0.f, 0.f};
    al.fetch(0, tid); bl.fetch(0, tid); al.commit(As, tid); bl.commit(Bs, tid);
    __syncthreads();
    for (int kt = 0; kt < nkt; ++kt) {
        const int cur = kt & 1;
        if (kt + 1 < nkt) { al.fetch(kt + 1, tid); bl.fetch(kt + 1, tid); }
        const bf16_t* Ac = As + cur * GT + (wr * 64 + r) * GLD + quad * 8;
        const bf16_t* Bc = Bs + cur * GT + (wc * 64 + r) * GLD + quad * 8;
#pragma unroll
        for (int ks = 0; ks < 2; ++ks) {
            Frag a[4], b[4];
#pragma unroll
            for (int m = 0; m < 4; ++m) a[m].q = *(const u32x4*)(Ac + m * 16 * GLD + ks * 32);
#pragma unroll
            for (int n = 0; n < 4; ++n) b[n].q = *(const u32x4*)(Bc + n * 16 * GLD + ks * 32);
#pragma unroll
            for (int m = 0; m < 4; ++m)
#pragma unroll
                for (int n = 0; n < 4; ++n) acc[m][n] = mfma16(a[m].v, b[n].v, acc[m][n]);
        }
        if (kt + 1 < nkt) { al.commit(As + (cur ^ 1) * GT, tid); bl.commit(Bs + (cur ^ 1) * GT, tid); }
        __syncthreads();
    }
    ep(acc, wr, wc, lane);
}


DEV int g2_h(int g) { return (0x78 >> (2 * g)) & 3; }
template <int NH> struct G2 { static constexpr int BROWS = 128 * NH, STAGE = 8192 + BROWS * 64, NST = (NH == 2 ? 3 : 4), LPS = 2 + 2 * NH; };

template <int NH, bool TR, class EP>
DEV void gemm_tile2(unsigned char* sm, const bf16_t* a0, const bf16_t* a1, const bf16_t* bb, int ldb, int nkt, EP& ep) {
    constexpr int STAGE = G2<NH>::STAGE, NST = G2<NH>::NST, LPS = G2<NH>::LPS;
    const int tid = tid_(), wid = tid >> 6, lane = tid & 63, wr = wid >> 1, wc = wid & 1, r = lane & 15, quad = lane >> 4;
    f32x4 acc[NH][4][4];
#pragma unroll
    for (int h = 0; h < NH; ++h)
#pragma unroll
        for (int m = 0; m < 4; ++m)
#pragma unroll
            for (int n = 0; n < 4; ++n) acc[h][m][n] = f32x4{0.f, 0.f, 0.f, 0.f};
    unsigned char* dst0 = sm + tid * 16;
    auto issue = [&](int kt, int slot) {
        unsigned char* d = dst0 + slot * STAGE;
        glds16(a0 + kt * 32, d); glds16(a1 + kt * 32, d + 4096);
#pragma unroll
        for (int j = 0; j < 2 * NH; ++j) glds16(bb + (size_t)j * 64 * ldb + kt * 32, d + 8192 + j * 4096);
    };
    RAW_BARRIER();
#pragma unroll
    for (int st = 0; st < NST - 1; ++st) if (st < nkt) issue(st, st);
    const int pco = (quad ^ g2_h((r >> 2) & 3)) * 16;
    const unsigned char* afr = sm + (wr * 64 + r) * 64 + pco;
    const unsigned char* bfr = sm + 8192 + (wc * 64 * NH + r) * 64 + pco;
    int slot = 0;
    for (int kt = 0; kt < nkt; ++kt) {
        const int rem = nkt - 1 - kt;
        if (NST == 3) { if (rem >= 1) wait_vm<LPS>(); else wait_vm<0>(); }
        else { if (rem >= 2) wait_vm<2 * LPS>(); else if (rem == 1) wait_vm<LPS>(); else wait_vm<0>(); }
        RAW_BARRIER();
        if (kt + NST - 1 < nkt) { int ns = slot + NST - 1; if (ns >= NST) ns -= NST; issue(kt + NST - 1, ns); }
        const unsigned char* as = afr + slot * STAGE; const unsigned char* bs = bfr + slot * STAGE;
        Frag a[4];
#pragma unroll
        for (int m = 0; m < 4; ++m) a[m].q = *(const u32x4*)(as + m * 16 * 64);
#ifndef CPU_EMU
        __builtin_amdgcn_s_setprio(1);
#endif
#pragma unroll
        for (int h = 0; h < NH; ++h) {
            Frag b[4];
#pragma unroll
            for (int n = 0; n < 4; ++n) b[n].q = *(const u32x4*)(bs + (h * 64 + n * 16) * 64);
#pragma unroll
            for (int m = 0; m < 4; ++m)
#pragma unroll
                for (int n = 0; n < 4; ++n) acc[h][m][n] = TR ? mfma16(b[n].v, a[m].v, acc[h][m][n]) : mfma16(a[m].v, b[n].v, acc[h][m][n]);
        }
#ifndef CPU_EMU
        __builtin_amdgcn_s_setprio(0);
#endif
        if (++slot == NST) slot = 0;
    }
#pragma unroll
    for (int h = 0; h < NH; ++h) { if (TR) ep.nat(acc[h], wr, wc * NH + h, lane); else ep(acc[h], wr, wc * NH + h, lane); }
}
DEV int g2_lc(int tid) { return (tid & 3) ^ g2_h((tid >> 4) & 3); }

struct ConvJob { const float* src; bf16_t* dst; int ldsrc, N, K, k0, n0, mapkind; };
DEV void conv_load(const ConvJob& j, int tid, f32x4 (&v)[4]) {
#pragma unroll
    for (int i = 0; i < 4; ++i) {
        const int kk = (tid >> 4) + 16 * i, n = j.n0 + 4 * (tid & 15);
        v[i] = f32x4{0.f, 0.f, 0.f, 0.f};
        if (n + 3 < j.N) v[i] = *(const f32x4*)(j.src + (size_t)(j.k0 + kk) * j.ldsrc + n);
    }
}
DEV void conv_store(float* T, const ConvJob& j, int tid, const f32x4 (&v)[4]) {
    __syncthreads();
#pragma unroll
    for (int i = 0; i < 4; ++i) {
        const int kk = (tid >> 4) + 16 * i, n4 = tid & 15;
        T[(4 * n4 + 0) * 65 + kk] = v[i].x; T[(4 * n4 + 1) * 65 + kk] = v[i].y; T[(4 * n4 + 2) * 65 + kk] = v[i].z; T[(4 * n4 + 3) * 65 + kk] = v[i].w;
    }
    __syncthreads();
    const int nl = tid >> 2, ks = (tid & 3) * 16; const int n = j.n0 + nl; int dr = n;
    if (j.mapkind == 1) dr = (n >> 5) * 64 + (n & 31); else if (j.mapkind == 2) dr = (n >> 5) * 64 + 32 + (n & 31);
    const float* t = T + nl * 65 + ks;
    u32x4 o0, o1;
    o0.x = pack2(t[0], t[1]); o0.y = pack2(t[2], t[3]); o0.z = pack2(t[4], t[5]); o0.w = pack2(t[6], t[7]);
    o1.x = pack2(t[8], t[9]); o1.y = pack2(t[10], t[11]); o1.z = pack2(t[12], t[13]); o1.w = pack2(t[14], t[15]);
    bf16_t* d = j.dst + (size_t)dr * j.K + j.k0 + ks;
    *(u32x4*)d = o0; *(u32x4*)(d + 8) = o1;
}
constexpr int P0_NMOD = DEPTH * 6 * D_MODEL / 64;
constexpr int P0_NCOPY = NTOK / 64;
constexpr int T_EIN = (D_MODEL / 64) * (EVEN_INP / 64), T_OIN = (D_MODEL / 64) * (ODD_IN / 64), T_OUT = (MIX_OUT / 64) * (D_MODEL / 64);
constexpr int T_GU = (D_MODEL / 64) * (D_EXPERT / 64), T_DN = (D_EXPERT / 64) * (D_MODEL / 64);
constexpr int P0_C0 = P0_NMOD + P0_NCOPY + 1 + DEPTH;
constexpr int P0_C1 = 2 * T_EIN, P0_C2 = P0_C1 + 2 * T_OIN, P0_C3 = P0_C2 + DEPTH * T_OUT, P0_C4 = P0_C3 + DEPTH * NE * 2 * T_GU, P0_C5 = P0_C4 + DEPTH * NE * T_DN;
DEV ConvJob conv_job(const Params& p, int t) {
    ConvJob j;
    if (t < P0_C1) {
        const int i = t / T_EIN, tt = t % T_EIN; const int nt = tt % (EVEN_INP / 64), kt = tt / (EVEN_INP / 64);
        j.src = p.ev_w_in + (size_t)i * D_MODEL * EVEN_IN; j.ldsrc = EVEN_IN; j.N = EVEN_IN; j.K = D_MODEL; j.k0 = kt * 64; j.n0 = nt * 64; j.dst = p.WinE + (size_t)i * EVEN_INP * D_MODEL; j.mapkind = 0;
    } else if (t < P0_C2) {
        const int q = t - P0_C1, i = q / T_OIN, tt = q % T_OIN; const int nt = tt % (ODD_IN / 64), kt = tt / (ODD_IN / 64);
        j.src = p.od_w_in + (size_t)i * D_MODEL * ODD_IN; j.ldsrc = ODD_IN; j.N = ODD_IN; j.K = D_MODEL; j.k0 = kt * 64; j.n0 = nt * 64; j.dst = p.WinO + (size_t)i * ODD_IN * D_MODEL; j.mapkind = 0;
    } else if (t < P0_C3) {
        const int q = t - P0_C2, layer = q / T_OUT, tt = q % T_OUT; const int nt = tt % (D_MODEL / 64), kt = tt / (D_MODEL / 64);
        j.src = (layer & 1) ? p.od_w_out + (size_t)(layer >> 1) * MIX_OUT * D_MODEL : p.ev_w_out + (size_t)(layer >> 1) * MIX_OUT * D_MODEL;
        j.ldsrc = D_MODEL; j.N = D_MODEL; j.K = MIX_OUT; j.k0 = kt * 64; j.n0 = nt * 64; j.dst = p.WoutT + (size_t)layer * D_MODEL * MIX_OUT; j.mapkind = 0;
    } else if (t < P0_C4) {
        const int q = t - P0_C3, le = q / (2 * T_GU); int tt = q % (2 * T_GU); const int up = tt / T_GU; tt %= T_GU; const int nt = tt % (D_EXPERT / 64), kt = tt / (D_EXPERT / 64);
        j.src = (up ? p.moe_w_up : p.moe_w_gate) + (size_t)le * D_MODEL * D_EXPERT; j.ldsrc = D_EXPERT; j.N = D_EXPERT; j.K = D_MODEL; j.k0 = kt * 64; j.n0 = nt * 64;
        j.dst = p.Wgu + (size_t)le * 2 * D_EXPERT * D_MODEL; j.mapkind = 1 + up;
    } else {
        const int q = t - P0_C4, le = q / T_DN, tt = q % T_DN; const int nt = tt % (D_MODEL / 64), kt = tt / (D_MODEL / 64);
        j.src = p.moe_w_down + (size_t)le * D_EXPERT * D_MODEL; j.ldsrc = D_MODEL; j.N = D_MODEL; j.K = D_EXPERT; j.k0 = kt * 64; j.n0 = nt * 64; j.dst = p.WdT + (size_t)le * D_MODEL * D_EXPERT; j.mapkind = 0;
    }
    return j;
}

DEV void phase0(const Params& p, unsigned char* smem) {
    const int tid = tid_(); const int bid = bid_();
    float* fs = (float*)smem;
    for (int task = bid; task < P0_C0; task += gridDim.x) {
        if (task < P0_NMOD) {
            __syncthreads();
            for (int i = tid; i < (BATCH + 1) * D_MODEL; i += 256) { int bb = i / D_MODEL, k = i % D_MODEL; float v = bb < BATCH ? p.c[bb * D_MODEL + k] : p.c_ctx[k]; fs[i] = v / (1.f + expf(-v)); }
            __syncthreads();
            const int col = task * 64 + (tid & 63), kg = tid >> 6; const int layer = col / (6 * D_MODEL), j = col % (6 * D_MODEL);
            const float* w = p.w_mod + (size_t)layer * D_MODEL * 6 * D_MODEL + j;
            float acc[BATCH + 1];
#pragma unroll
            for (int bb = 0; bb <= BATCH; ++bb) acc[bb] = 0.f;
#pragma unroll 16
            for (int k = kg * (D_MODEL / 4); k < (kg + 1) * (D_MODEL / 4); ++k) {
                float wv = w[(size_t)k * 6 * D_MODEL];
#pragma unroll
                for (int bb = 0; bb <= BATCH; ++bb) acc[bb] += fs[bb * D_MODEL + k] * wv;
            }
            float* red = fs + (BATCH + 1) * D_MODEL;
#pragma unroll
            for (int bb = 0; bb <= BATCH; ++bb) red[(kg * (BATCH + 1) + bb) * 64 + (tid & 63)] = acc[bb];
            __syncthreads();
            if (tid < 64) {
                const float bm = p.b_mod[layer * 6 * D_MODEL + j];
#pragma unroll
                for (int bb = 0; bb <= BATCH; ++bb) {
                    const float sacc = red[(0 * (BATCH + 1) + bb) * 64 + tid] + red[(1 * (BATCH + 1) + bb) * 64 + tid] + red[(2 * (BATCH + 1) + bb) * 64 + tid] + red[(3 * (BATCH + 1) + bb) * 64 + tid];
                    p.MOD[((size_t)layer * (BATCH + 1) + bb) * 6 * D_MODEL + j] = sacc + bm;
                }
            }
        } else if (task < P0_NMOD + P0_NCOPY) {
            int r0 = (task - P0_NMOD) * 64;
            for (int i = tid; i < 64 * D_MODEL / 4; i += 256) {
                int row = r0 + i / (D_MODEL / 4), c4 = i % (D_MODEL / 4); int b = row / TT, s = row % TT;
                const float* src = s < CTX ? p.ctx + ((size_t)b * CTX + s) * D_MODEL : p.x + ((size_t)b * SEQ + (s - CTX)) * D_MODEL;
                *(u32x2*)(p.X + (size_t)row * D_MODEL + c4 * 4) = pk4(*(const f32x4*)(src + c4 * 4));

            }
        } else if (task == P0_NMOD + P0_NCOPY) {
            for (int i = tid; i < 64 * 16; i += 256) {
                int pos = i / 16, f = i % 16;
                double th = 1.0; for (int q = 0; q < f; ++q) th *= 0.5623413251903490804;
                double t2 = th * th, cs = 1.0, sn = th, tc = 1.0, ts = th;
                for (int n = 1; n < 14; ++n) { tc *= -t2 / ((2 * n - 1) * (2 * n)); ts *= -t2 / ((2 * n) * (2 * n + 1)); cs += tc; sn += ts; }
                double c = 1.0, s = 0.0;
                for (int q = 0; q < pos; ++q) { double cn = c * cs - s * sn, sn2 = s * cs + c * sn; c = cn; s = sn2; }
                p.ROPE[i * 2] = (float)c; p.ROPE[i * 2 + 1] = (float)s;
            }
            if (tid < 2) {
                const float* lp = p.ev_lambda + tid * 4 * 64; float s01 = 0.f, s23 = 0.f;
                for (int k = 0; k < 64; ++k) { s01 += lp[k] * lp[64 + k]; s23 += lp[128 + k] * lp[192 + k]; }
                float lam_init = 0.8f - 0.6f * expf(-0.3f * (float)(2 * tid));
                p.LAM[tid] = expf(s01) - expf(s23) + lam_init;
            }
            for (int i = tid; i < DEPTH * NE * 32; i += 256) p.CNT[i] = 0;
        } else {
            int layer = task - (P0_NMOD + P0_NCOPY + 1);
            for (int i = tid; i < NR * D_MODEL; i += 256) {
                int j = i / D_MODEL, k = i % D_MODEL;
                float v = j < NG ? p.moe_w_group[((size_t)layer * D_MODEL + k) * NG + j] : p.moe_w_router[((size_t)layer * D_MODEL + k) * NE + (j - NG)];
                p.WrT[(size_t)layer * NR * D_MODEL + i] = v;
            }
        }
    }
    {
        const int G = gridDim.x; int t = bid;
        ConvJob j0, j1, j2; f32x4 v0[4], v1[4], v2[4];
        const bool h0 = t < P0_C5, h1 = t + G < P0_C5;
        if (h0) { j0 = conv_job(p, t); conv_load(j0, tid, v0); } else { j0 = conv_job(p, 0); }
        if (h1) { j1 = conv_job(p, t + G); conv_load(j1, tid, v1); } else { j1 = j0; }
        j2 = j1;
        while (t < P0_C5) {
            const bool h2 = t + 2 * G < P0_C5;
            if (h2) { j2 = conv_job(p, t + 2 * G); conv_load(j2, tid, v2); }
            conv_store(fs, j0, tid, v0);
            j0 = j1; j1 = j2;
#pragma unroll
            for (int i = 0; i < 4; ++i) { v0[i] = v1[i]; v1[i] = v2[i]; }
            t += G;
        }
    }
}

DEV int chunk_of(int dir, int sp) { return dir == 0 ? sp : (sp < NCC ? NCC - 1 - sp : NCC + (NCH - 1 - sp)); }
DEV int sp_of(int dir, int u) { return dir == 0 ? u : (u < NCC ? NCC - 1 - u : NCC + (NCH - 1 - u)); }

template <bool RET>
DEV void gate_chain(const Params& p, int layer, int chain) {
    const int lane = tid_() & 63;
    const int dir = chain & 1, h = (chain >> 1) & 3, b = chain >> 3;
    float lg = 0.f;
    if (RET) lg = logsigf(p.od_decay[((layer >> 1) * 2 + dir) * HC + h]);
    float mprev = 0.f;
    for (int sp = 0; sp < NCH; ++sp) {
        const int u = chunk_of(dir, sp); const int sbase = u * CH;
        int i0 = 2 * lane, i1 = 2 * lane + 1;
        int s0 = dir ? sbase + 127 - i0 : sbase + i0, s1 = dir ? sbase + 127 - i1 : sbase + i1;
        float lf0, lf1, li0, li1;
        if (RET) { lf0 = lf1 = lg; li0 = li1 = 0.f; }
        else {
            const float* g0 = p.G + ((size_t)b * TT + s0) * 16; const float* g1 = p.G + ((size_t)b * TT + s1) * 16;
            li0 = g0[(2 * dir) * 4 + h]; li1 = g1[(2 * dir) * 4 + h];
            lf0 = logsigf(g0[(2 * dir + 1) * 4 + h]); lf1 = logsigf(g1[(2 * dir + 1) * 4 + h]);
        }
        float ps = lf0 + lf1;
        for (int d = 1; d < 64; d <<= 1) { float o = lane_up(ps, d, lane); if (lane >= d) ps += o; }
        float b1 = ps, b0 = ps - lf1;
        float bend = lane_read(ps, 63, lane);
        float a0 = li0 - b0, a1 = li1 - b1;
        float pm = fmaxf(a0, a1);
        float mx = pm;
        for (int d = 1; d < 64; d <<= 1) { float o = lane_up(mx, d, lane); if (lane >= d) mx = fmaxf(mx, o); }
        float pmx_prev = lane_up(mx, 1, lane); if (lane == 0) pmx_prev = -3.0e38f;
        float pm0 = fmaxf(pmx_prev, a0), pm1 = mx;
        float amax = lane_read(mx, 63, lane);
        float mnew, carry, mt0, mt1;
        if (RET) { mnew = 0.f; carry = __expf(bend); mt0 = mt1 = 0.f; }
        else { mnew = fmaxf(bend + mprev, bend + amax); carry = __expf(bend + mprev - mnew); mt0 = b0 + fmaxf(mprev, pm0); mt1 = b1 + fmaxf(mprev, pm1); }
        size_t o = (size_t)chain * TT;
        p.BC[o + s0] = b0; p.BC[o + s1] = b1; p.AT[o + s0] = a0; p.AT[o + s1] = a1; p.MT[o + s0] = mt0; p.MT[o + s1] = mt1;
        if (lane == 0) { float* ms = p.MS + ((size_t)chain * NCH + sp) * 4; ms[0] = mprev; ms[1] = mnew; ms[2] = bend; ms[3] = carry; }
        mprev = mnew;
    }
}

struct EpInEven {
    const Params& p; int layer, row0, col0;
    DEV void nat(f32x4 (&acc)[4][4], int wr, int wc, int lane) {
        const int r = lane & 15, quad = lane >> 4;
        const int c0 = col0 + wc * 64, rowb = row0 + wr * 64;
        const int b = row0 / TT; const int sb = rowb - b * TT; const bool lat = sb >= CTX;
        if (c0 < 1024) {
            bf16_t* dst = c0 < 512 ? p.Q1 : p.K1; const int cc = c0 & 511;
#pragma unroll
            for (int m = 0; m < 4; ++m) {
                const int row = rowb + m * 16 + r;
                f32x4 v0 = acc[m][0], v1 = acc[m][1], v2 = acc[m][2], v3 = acc[m][3];
                if (lat) {
                    const int t = sb + m * 16 + r - CTX; const int pr = t / GRID_W, pc = t % GRID_W;
                    const f32x4 ra = *(const f32x4*)(p.ROPE + (pr * 16 + quad * 4) * 2), rb = *(const f32x4*)(p.ROPE + (pr * 16 + quad * 4) * 2 + 4);
                    const f32x4 ca = *(const f32x4*)(p.ROPE + (pc * 16 + quad * 4) * 2), cb = *(const f32x4*)(p.ROPE + (pc * 16 + quad * 4) * 2 + 4);
                    const f32x4 cr = f32x4{ra[0], ra[2], rb[0], rb[2]}, sr = f32x4{ra[1], ra[3], rb[1], rb[3]};
                    const f32x4 cq = f32x4{ca[0], ca[2], cb[0], cb[2]}, sq = f32x4{ca[1], ca[3], cb[1], cb[3]};
                    const f32x4 o0 = v0 * cr - v2 * sr, o2 = v0 * sr + v2 * cr, o1 = v1 * cq - v3 * sq, o3 = v1 * sq + v3 * cq;
                    v0 = o0; v1 = o1; v2 = o2; v3 = o3;
                }
                bf16_t* d = dst + (size_t)row * 512 + cc + quad * 4;
                u32x2 w; w.x = pack2(v0[0], v0[1]); w.y = pack2(v0[2], v0[3]); *(u32x2*)d = w;
                w.x = pack2(v1[0], v1[1]); w.y = pack2(v1[2], v1[3]); *(u32x2*)(d + 16) = w;
                w.x = pack2(v2[0], v2[1]); w.y = pack2(v2[2], v2[3]); *(u32x2*)(d + 32) = w;
                w.x = pack2(v3[0], v3[1]); w.y = pack2(v3[2], v3[3]); *(u32x2*)(d + 48) = w;
            }
        } else if (c0 < 3584) {
            const bool pm = c0 < 2560; bf16_t* dst = pm ? p.PM : p.OG; const int ld = pm ? 1024 : 512; const int cc = pm ? c0 - 1536 : c0 - 3072;
#pragma unroll
            for (int m = 0; m < 4; ++m) {
                bf16_t* d = dst + (size_t)(rowb + m * 16 + r) * ld + cc + quad * 4;
#pragma unroll
                for (int n = 0; n < 4; ++n) { u32x2 w; w.x = pack2(acc[m][n][0], acc[m][n][1]); w.y = pack2(acc[m][n][2], acc[m][n][3]); *(u32x2*)(d + n * 16) = w; }
            }
        } else if (c0 == 3584) {
            const f32x4 gb = *(const f32x4*)(p.ev_gate_b + (layer >> 1) * 16 + quad * 4);
#pragma unroll
            for (int m = 0; m < 4; ++m) *(f32x4*)(p.G + (size_t)(rowb + m * 16 + r) * 16 + quad * 4) = acc[m][0] + gb;
        }
    }
    DEV void operator()(f32x4 (&acc)[4][4], int wr, int wc, int lane) {
        const int r = lane & 15, quad = lane >> 4;
        const int c0 = col0 + wc * 64, rowb = row0 + wr * 64;
        const int b = row0 / TT; const int sb = rowb - b * TT; const bool lat = sb >= CTX;
        if (c0 < 1024) {
            bf16_t* dst = c0 < 512 ? p.Q1 : p.K1; const int cc = c0 & 511;
#pragma unroll
            for (int m = 0; m < 4; ++m)
#pragma unroll
                for (int j = 0; j < 4; ++j) {
                    const int row = rowb + m * 16 + quad * 4 + j;
                    float v0 = acc[m][0][j], v1 = acc[m][1][j], v2 = acc[m][2][j], v3 = acc[m][3][j];
                    if (lat) {
                        const int t = sb + m * 16 + quad * 4 + j - CTX; const int pr = t / GRID_W, pc = t % GRID_W;
                        const float cr = p.ROPE[(pr * 16 + r) * 2], sr = p.ROPE[(pr * 16 + r) * 2 + 1], cq = p.ROPE[(pc * 16 + r) * 2], sq = p.ROPE[(pc * 16 + r) * 2 + 1];
                        float o0 = v0 * cr - v2 * sr, o2 = v0 * sr + v2 * cr, o1 = v1 * cq - v3 * sq, o3 = v1 * sq + v3 * cq;
                        v0 = o0; v1 = o1; v2 = o2; v3 = o3;
                    }
                    bf16_t* d = dst + (size_t)row * 512 + cc + r;
                    d[0] = f2bf(v0); d[16] = f2bf(v1); d[32] = f2bf(v2); d[48] = f2bf(v3);
                }
        } else if (c0 < 1536 || (c0 >= 2560 && c0 < 3072)) {
            const bool at = c0 < 1536; const int cc = at ? c0 - 1024 : c0 - 2560; const int h = cc >> 7, e0 = (cc & 127);
            bf16_t* dst = (at ? p.V1T : p.V2T) + ((size_t)(b * 4 + h) * 128) * TT;
#pragma unroll
            for (int m = 0; m < 4; ++m)
#pragma unroll
                for (int n = 0; n < 4; ++n) {
                    u32x2 o; o.x = pack2(acc[m][n][0], acc[m][n][1]); o.y = pack2(acc[m][n][2], acc[m][n][3]);
                    *(u32x2*)(dst + (size_t)(e0 + n * 16 + r) * TT + sb + m * 16 + quad * 4) = o;
                }
        } else if (c0 < 2560 || (c0 >= 3072 && c0 < 3584)) {
            const bool pm = c0 < 2560; bf16_t* dst = pm ? p.PM : p.OG; const int ld = pm ? 1024 : 512; const int cc = pm ? c0 - 1536 : c0 - 3072;
#pragma unroll
            for (int m = 0; m < 4; ++m)
#pragma unroll
                for (int j = 0; j < 4; ++j) {
                    const int row = rowb + m * 16 + quad * 4 + j; bf16_t* d = dst + (size_t)row * ld + cc + r;
                    d[0] = f2bf(acc[m][0][j]); d[16] = f2bf(acc[m][1][j]); d[32] = f2bf(acc[m][2][j]); d[48] = f2bf(acc[m][3][j]);
                }
        } else if (c0 == 3584) {
            const float gb = p.ev_gate_b[(layer >> 1) * 16 + r];
#pragma unroll
            for (int m = 0; m < 4; ++m)
#pragma unroll
                for (int j = 0; j < 4; ++j) { const int row = rowb + m * 16 + quad * 4 + j; p.G[(size_t)row * 16 + r] = acc[m][0][j] + gb; }
        }
    }
};

struct EpInOdd {
    const Params& p; int layer, row0, col0;
    DEV void nat(f32x4 (&acc)[4][4], int wr, int wc, int lane) {
        const int r = lane & 15, quad = lane >> 4;
        const int c0 = col0 + wc * 64, rowb = row0 + wr * 64;
        const int b = row0 / TT; const int sb = rowb - b * TT; const bool lat = sb >= CTX;
        if (c0 < 512 || (c0 >= 1024 && c0 < 1536)) {
            bf16_t* dst; int ld, cc; float scl = 1.f;
            if (c0 < 256) { dst = p.Q2; ld = 256; cc = c0; } else if (c0 < 512) { dst = p.K2; ld = 256; cc = c0 - 256; scl = 0.125f; } else { dst = p.OG; ld = 512; cc = c0 - 1024; }
#pragma unroll
            for (int m = 0; m < 4; ++m) {
                bf16_t* d = dst + (size_t)(rowb + m * 16 + r) * ld + cc + quad * 4;
#pragma unroll
                for (int n = 0; n < 4; ++n) { u32x2 w; w.x = pack2(acc[m][n][0] * scl, acc[m][n][1] * scl); w.y = pack2(acc[m][n][2] * scl, acc[m][n][3] * scl); *(u32x2*)(d + n * 16) = w; }
            }
        } else if (c0 >= 1536 && c0 < 2176) {
            const bool isq = c0 < 2048; bf16_t* dst = isq ? p.Q1 : p.K1; const int ld = isq ? 512 : 128; const int cc = isq ? c0 - 1536 : c0 - 2048;
            const float* g = p.od_qk_g + ((layer >> 1) * 2 + (isq ? 0 : 1)) * 64 + quad * 4;
            const f32x4 g0 = *(const f32x4*)g, g1 = *(const f32x4*)(g + 16), g2 = *(const f32x4*)(g + 32), g3 = *(const f32x4*)(g + 48);
#pragma unroll
            for (int m = 0; m < 4; ++m) {
                const int row = rowb + m * 16 + r;
                f32x4 v0 = acc[m][0], v1 = acc[m][1], v2 = acc[m][2], v3 = acc[m][3];
                float ss = 0.f;
#pragma unroll
                for (int j = 0; j < 4; ++j) ss += v0[j] * v0[j] + v1[j] * v1[j] + v2[j] * v2[j] + v3[j] * v3[j];
                ss = xadd16(ss); ss = xadd32(ss);
                const float rs = 1.0f / sqrtf(ss * (1.f / 64.f) + EPS);
                v0 = v0 * rs * g0; v1 = v1 * rs * g1; v2 = v2 * rs * g2; v3 = v3 * rs * g3;
                if (lat) {
                    const int t = sb + m * 16 + r - CTX; const int pr = t / GRID_W, pc = t % GRID_W;
                    const f32x4 ra = *(const f32x4*)(p.ROPE + (pr * 16 + quad * 4) * 2), rb = *(const f32x4*)(p.ROPE + (pr * 16 + quad * 4) * 2 + 4);
                    const f32x4 ca = *(const f32x4*)(p.ROPE + (pc * 16 + quad * 4) * 2), cb = *(const f32x4*)(p.ROPE + (pc * 16 + quad * 4) * 2 + 4);
                    const f32x4 cr = f32x4{ra[0], ra[2], rb[0], rb[2]}, sr = f32x4{ra[1], ra[3], rb[1], rb[3]};
                    const f32x4 cq = f32x4{ca[0], ca[2], cb[0], cb[2]}, sq = f32x4{ca[1], ca[3], cb[1], cb[3]};
                    const f32x4 o0 = v0 * cr - v2 * sr, o2 = v0 * sr + v2 * cr, o1 = v1 * cq - v3 * sq, o3 = v1 * sq + v3 * cq;
                    v0 = o0; v1 = o1; v2 = o2; v3 = o3;
                }
                bf16_t* d = dst + (size_t)row * ld + cc + quad * 4;
                u32x2 w; w.x = pack2(v0[0], v0[1]); w.y = pack2(v0[2], v0[3]); *(u32x2*)d = w;
                w.x = pack2(v1[0], v1[1]); w.y = pack2(v1[2], v1[3]); *(u32x2*)(d + 16) = w;
                w.x = pack2(v2[0], v2[1]); w.y = pack2(v2[2], v2[3]); *(u32x2*)(d + 32) = w;
                w.x = pack2(v3[0], v3[1]); w.y = pack2(v3[2], v3[3]); *(u32x2*)(d + 48) = w;
            }
        }
    }
    DEV void operator()(f32x4 (&acc)[4][4], int wr, int wc, int lane) {
        const int r = lane & 15, quad = lane >> 4;
        const int c0 = col0 + wc * 64, rowb = row0 + wr * 64;
        const int b = row0 / TT; const int sb = rowb - b * TT; const bool lat = sb >= CTX;
        if (c0 < 512 || (c0 >= 1024 && c0 < 1536)) {
            bf16_t* dst; int ld, cc; float scl = 1.f;
            if (c0 < 256) { dst = p.Q2; ld = 256; cc = c0; } else if (c0 < 512) { dst = p.K2; ld = 256; cc = c0 - 256; scl = 0.125f; } else { dst = p.OG; ld = 512; cc = c0 - 1024; }
#pragma unroll
            for (int m = 0; m < 4; ++m)
#pragma unroll
                for (int j = 0; j < 4; ++j) {
                    const int row = rowb + m * 16 + quad * 4 + j; bf16_t* d = dst + (size_t)row * ld + cc + r;
                    d[0] = f2bf(acc[m][0][j] * scl); d[16] = f2bf(acc[m][1][j] * scl); d[32] = f2bf(acc[m][2][j] * scl); d[48] = f2bf(acc[m][3][j] * scl);
                }
        } else if (c0 < 1024) {
            const int cc = c0 - 512; const int h = cc >> 7, e0 = cc & 127; bf16_t* dst = p.V2T + ((size_t)(b * 4 + h) * 128) * TT;
#pragma unroll
            for (int m = 0; m < 4; ++m)
#pragma unroll
                for (int n = 0; n < 4; ++n) {
                    u32x2 o; o.x = pack2(acc[m][n][0], acc[m][n][1]); o.y = pack2(acc[m][n][2], acc[m][n][3]);
                    *(u32x2*)(dst + (size_t)(e0 + n * 16 + r) * TT + sb + m * 16 + quad * 4) = o;
                }
        } else if (c0 < 2176) {
            const bool isq = c0 < 2048; bf16_t* dst = isq ? p.Q1 : p.K1; const int ld = isq ? 512 : 128; const int cc = isq ? c0 - 1536 : c0 - 2048;
            const float* g = p.od_qk_g + ((layer >> 1) * 2 + (isq ? 0 : 1)) * 64;
            const float g0 = g[r], g1 = g[16 + r], g2 = g[32 + r], g3 = g[48 + r];
#pragma unroll
            for (int m = 0; m < 4; ++m)
#pragma unroll
                for (int j = 0; j < 4; ++j) {
                    const int row = rowb + m * 16 + quad * 4 + j;
                    float v0 = acc[m][0][j], v1 = acc[m][1][j], v2 = acc[m][2][j], v3 = acc[m][3][j];
                    float ss = v0 * v0 + v1 * v1 + v2 * v2 + v3 * v3;
                    ss = rowred_add(ss);
                    const float rs = 1.0f / sqrtf(ss * (1.f / 64.f) + EPS);
                    v0 *= rs * g0; v1 *= rs * g1; v2 *= rs * g2; v3 *= rs * g3;
                    if (lat) {
                        const int t = sb + m * 16 + quad * 4 + j - CTX; const int pr = t / GRID_W, pc = t % GRID_W;
                        const float cr = p.ROPE[(pr * 16 + r) * 2], sr = p.ROPE[(pr * 16 + r) * 2 + 1], cq = p.ROPE[(pc * 16 + r) * 2], sq = p.ROPE[(pc * 16 + r) * 2 + 1];
                        float o0 = v0 * cr - v2 * sr, o2 = v0 * sr + v2 * cr, o1 = v1 * cq - v3 * sq, o3 = v1 * sq + v3 * cq;
                        v0 = o0; v1 = o1; v2 = o2; v3 = o3;
                    }
                    bf16_t* d = dst + (size_t)row * ld + cc + r;
                    d[0] = f2bf(v0); d[16] = f2bf(v1); d[32] = f2bf(v2); d[48] = f2bf(v3);
                }
        } else {
            const int kv = (c0 - 2176) >> 6; bf16_t* dst = p.V1T + ((size_t)(b * HKV + kv) * 64) * TT;
#pragma unroll
            for (int m = 0; m < 4; ++m)
#pragma unroll
                for (int n = 0; n < 4; ++n) {
                    u32x2 o; o.x = pack2(acc[m][n][0], acc[m][n][1]); o.y = pack2(acc[m][n][2], acc[m][n][3]);
                    *(u32x2*)(dst + (size_t)(n * 16 + r) * TT + sb + m * 16 + quad * 4) = o;
                }
        }
    }
};

DEV void phaseA(const Params& p, int layer, unsigned char* smem) {
    const bool odd = layer & 1;
    const int ncol = odd ? ODD_IN / 256 : EVEN_INP / 256; const int nrow = NTOK / 128;
    const bf16_t* W = odd ? p.WinO + (size_t)(layer >> 1) * ODD_IN * D_MODEL : p.WinE + (size_t)(layer >> 1) * EVEN_INP * D_MODEL;
    const int bid = bid_(); const int tid = tid_(); const int trow = tid >> 2, lc8 = g2_lc(tid) * 8;
    if (odd && bid < NCHAIN && tid < 64) gate_chain<true>(p, layer, bid);
    const WorkRange wr = xcd_range(nrow * ncol, bid);
    for (int t = wr.lo; t < wr.hi; t += wr.step) {
        int rt, ct; dense_tile(t, nrow, ncol, rt, ct); const int row0 = rt * 128, col0 = ct * 256;
        const bf16_t* a0 = p.HIN + (size_t)(row0 + trow) * D_MODEL + lc8;
        const bf16_t* bb = W + (size_t)(col0 + trow) * D_MODEL + lc8;
        if (odd) {
            EpInOdd ep{p, layer, row0, col0};
            if (ct == 2 || ct == 3 || ct == 8) gemm_tile2<2, false>(smem, a0, a0 + (size_t)64 * D_MODEL, bb, D_MODEL, D_MODEL / 32, ep);
            else gemm_tile2<2, true>(smem, a0, a0 + (size_t)64 * D_MODEL, bb, D_MODEL, D_MODEL / 32, ep);
        } else {
            EpInEven ep{p, layer, row0, col0};
            if (ct == 4 || ct == 5 || ct == 10 || ct == 11) gemm_tile2<2, false>(smem, a0, a0 + (size_t)64 * D_MODEL, bb, D_MODEL, D_MODEL / 32, ep);
            else gemm_tile2<2, true>(smem, a0, a0 + (size_t)64 * D_MODEL, bb, D_MODEL, D_MODEL / 32, ep);
        }
    }
#ifdef PROBE_GEMM
    {
        Params q = p; bf16_t* scr = (bf16_t*)p.DC;
        q.Q1 = scr; q.K1 = scr; q.V1T = scr; q.PM = scr; q.V2T = scr; q.OG = scr; q.G = (float*)scr; q.Q2 = scr; q.K2 = scr;
        for (int t = wr.lo; t < wr.hi; t += wr.step) {
            int rt, ct; dense_tile(t, nrow, ncol, rt, ct); const int row0 = rt * 128, col0 = ct * 256;
            const bf16_t* a0 = p.HIN + (size_t)(row0 + trow) * D_MODEL + lc8;
            const bf16_t* bb = W + (size_t)(col0 + trow) * D_MODEL + lc8;
            const int erow0 = (PROBE_GEMM == 2) ? (row0 % TT >= CTX ? CTX : 0) : row0;
            if (odd) {
                EpInOdd ep{q, layer, erow0, col0};
                if (ct == 2 || ct == 3 || ct == 8) gemm_tile2<2, false>(smem, a0, a0 + (size_t)64 * D_MODEL, bb, D_MODEL, D_MODEL / 32, ep);
                else gemm_tile2<2, true>(smem, a0, a0 + (size_t)64 * D_MODEL, bb, D_MODEL, D_MODEL / 32, ep);
            } else {
                EpInEven ep{q, layer, erow0, col0};
                if (ct == 4 || ct == 5 || ct == 10 || ct == 11) gemm_tile2<2, false>(smem, a0, a0 + (size_t)64 * D_MODEL, bb, D_MODEL, D_MODEL / 32, ep);
                else gemm_tile2<2, true>(smem, a0, a0 + (size_t)64 * D_MODEL, bb, D_MODEL, D_MODEL / 32, ep);
            }
        }
    }
#endif
}
DEV void phase0b(const Params& p) {
    const int total = NTOK * (D_MODEL / 4);
    for (int idx = bid_() * 256 + tid_(); idx < total; idx += gridDim.x * 256) {
        const int row = idx / (D_MODEL / 4), k = (idx % (D_MODEL / 4)) * 4; const int b = row / TT, sq = row % TT; const int bb = sq < CTX ? BATCH : b;
        const float* mod = p.MOD + (size_t)bb * 6 * D_MODEL;
        const f32x4 x = bf4(*(const u32x2*)(p.X + (size_t)row * D_MODEL + k)), sh = *(const f32x4*)(mod + k), sc = *(const f32x4*)(mod + D_MODEL + k);
        u32x2 o; o.x = pack2(x.x * (1.f + sc.x) + sh.x, x.y * (1.f + sc.y) + sh.y); o.y = pack2(x.z * (1.f + sc.z) + sh.z, x.w * (1.f + sc.w) + sh.w);
        *(u32x2*)(p.HIN + (size_t)row * D_MODEL + k) = o;
    }
}

static_assert(NCH <= 64, "chunk summaries of a chain are scanned by one wave");
DEV void gate_chunk(const Params& p, int chain, int sp, int lane) {
    const int dir = chain & 1, h = (chain >> 1) & 3, b = chain >> 3;
    const int u = chunk_of(dir, sp); const int sbase = u * CH;
    const int i0 = 2 * lane, i1 = 2 * lane + 1;
    const int s0 = dir ? sbase + 127 - i0 : sbase + i0, s1 = dir ? sbase + 127 - i1 : sbase + i1;
    const float* g0 = p.G + ((size_t)b * TT + s0) * 16; const float* g1 = p.G + ((size_t)b * TT + s1) * 16;
    const float li0 = g0[(2 * dir) * 4 + h], li1 = g1[(2 * dir) * 4 + h];
    const float lf0 = logsigf(g0[(2 * dir + 1) * 4 + h]), lf1 = logsigf(g1[(2 * dir + 1) * 4 + h]);
    float ps = lf0 + lf1;
    for (int d = 1; d < 64; d <<= 1) { float o = lane_up(ps, d, lane); if (lane >= d) ps += o; }
    const float b1 = ps, b0 = ps - lf1;
    const float bend = lane_read(ps, 63, lane);
    const float a0 = li0 - b0, a1 = li1 - b1;
    float mx = fmaxf(a0, a1);
    for (int d = 1; d < 64; d <<= 1) { float o = lane_up(mx, d, lane); if (lane >= d) mx = fmaxf(mx, o); }
    float pmx_prev = lane_up(mx, 1, lane); if (lane == 0) pmx_prev = -3.0e38f;
    const float pm0 = fmaxf(pmx_prev, a0), pm1 = mx;
    const float amax = lane_read(mx, 63, lane);
    const size_t o = (size_t)chain * TT;
    p.BC[o + s0] = b0; p.BC[o + s1] = b1; p.AT[o + s0] = a0; p.AT[o + s1] = a1; p.MT[o + s0] = pm0; p.MT[o + s1] = pm1;
    if (lane == 0) { float* c2 = p.CH2 + ((size_t)chain * NCH + sp) * 2; c2[0] = bend; c2[1] = amax; }
}
DEV void phaseB(const Params& p, int layer) {
    const int tid = tid_();
    const int bid = bid_();
    for (int t = bid * 4 + (tid >> 6); t < NCHAIN * NCH; t += gridDim.x * 4) gate_chunk(p, t / NCH, t % NCH, tid & 63);
    const float* cw = p.ev_conv_w + (size_t)(layer >> 1) * 3 * 1024; const float* cb = p.ev_conv_b + (size_t)(layer >> 1) * 1024;
    const int total = NTOK * 128;
    for (int idx = bid * 256 + tid; idx < total; idx += gridDim.x * 256) {
        const int row = idx >> 7, cg8 = (idx & 127) * 8; const int b = row / TT, s = row % TT;
        const bool hasp = (s != 0) && (s != CTX), hasn = (s != CTX - 1) && (s != TT - 1);
        Frag xm, x0, xp; x0.q = *(const u32x4*)(p.PM + (size_t)row * 1024 + cg8);
        xm.q = u32x4{0u, 0u, 0u, 0u}; xp.q = u32x4{0u, 0u, 0u, 0u};
        if (hasp) xm.q = *(const u32x4*)(p.PM + (size_t)(row - 1) * 1024 + cg8);
        if (hasn) xp.q = *(const u32x4*)(p.PM + (size_t)(row + 1) * 1024 + cg8);
        float y[8];
#pragma unroll
        for (int i = 0; i < 8; ++i) {
            const int ch = cg8 + i;
            float v = cb[ch] + bf2f((bf16_t)xm.v[i]) * cw[ch] + bf2f((bf16_t)x0.v[i]) * cw[1024 + ch] + bf2f((bf16_t)xp.v[i]) * cw[2048 + ch];
            y[i] = siluf(v);
        }
        if (cg8 < 512) {
            u32x4 o; o.x = pack2(y[0], y[1]); o.y = pack2(y[2], y[3]); o.z = pack2(y[4], y[5]); o.w = pack2(y[6], y[7]);
            *(u32x4*)(p.Q2 + (size_t)row * 512 + cg8) = o;
        } else {
            const float sc = 0.08838834764831845f;
#pragma unroll
            for (int i = 0; i < 8; ++i) y[i] *= sc;
            u32x4 o; o.x = pack2(y[0], y[1]); o.y = pack2(y[2], y[3]); o.z = pack2(y[4], y[5]); o.w = pack2(y[6], y[7]);
            const int kc = cg8 - 512; *(u32x4*)(p.K2 + (size_t)row * 512 + kc) = o;
        }
    }
}

constexpr int KLD1 = 136, KLD0 = 72, VLD = 72;
template <int NC, int DV, int QT>
struct AttnState { f32x4 O[NC][DV / 16][QT]; f32x4 L[NC][QT]; float m[NC][QT]; };

DEV float max3f(float a, float b, float c) {
#ifdef CPU_EMU
    return fmaxf(fmaxf(a, b), c);
#else
    float d; asm("v_max3_f32 %0, %1, %2, %3" : "=v"(d) : "v"(a), "v"(b), "v"(c)); return d;
#endif
}
DEV float max2f(float a, float b) {
#ifdef CPU_EMU
    return fmaxf(a, b);
#else
    float d; asm("v_max_f32 %0, %1, %2" : "=v"(d) : "v"(a), "v"(b)); return d;
#endif
}
DEV bool wave_any(bool pr) {
#ifdef CPU_EMU
    int v = pr ? 1 : 0; for (int m = 1; m < 64; m <<= 1) v |= __shfl_xor(v, m); return v != 0;
#else
    return __builtin_amdgcn_ballot_w64(pr) != 0;
#endif
}

template <int NC, int DV, int QT, int KW>
DEV void attn_core(bf16_t* sm, const bf16_t* Kg, int ldk, const bf16_t* VTg, int nkeys, const Frag (&qf)[NC][2][QT], AttnState<NC, DV, QT>& st, float sc2, int koff) {
    constexpr int KLD = KW + 8;
    constexpr int NKR = KW / 32, NVR = DV / 32;
    constexpr int KBUF = 64 * KLD, VBUF = DV * VLD;
    constexpr float TH = 6.0f;
    const float isc2 = 1.0f / sc2;
    const int tid = tid_(), lane = tid & 63, r = lane & 15, quad = lane >> 4;
    u32x4 kreg[NKR], vreg[NVR];
    constexpr int VTPR = 8 / NVR;
    const bf16_t* kp = Kg + (size_t)(tid >> 2) * ldk + (tid & 3) * NKR * 8;
    const bf16_t* vp0 = VTg + (size_t)(tid / VTPR) * TT + (tid % VTPR) * NVR * 8;
    const int klo = (tid >> 2) * KLD + (tid & 3) * NKR * 8;
    const int nt = nkeys >> 6;
    Frag ones; ones.u[0] = ones.u[1] = ones.u[2] = ones.u[3] = 0x3F803F80u;
    auto loadK = [&]() {
#pragma unroll
        for (int i = 0; i < NKR; ++i) kreg[i] = *(const u32x4*)(kp + i * 8);
        kp += (size_t)64 * ldk; };
    auto loadV = [&]() {
#pragma unroll
        for (int i = 0; i < NVR; ++i) vreg[i] = *(const u32x4*)(vp0 + i * 8);
        vp0 += 64; };
    auto storeK = [&](int buf) {
#pragma unroll
        for (int i = 0; i < NKR; ++i) *(u32x4*)(sm + buf * KBUF + klo + i * 8) = kreg[i]; };
    auto storeV = [&](int buf) {
        bf16_t* vrow = sm + buf * VBUF + 2 * KBUF + (tid / VTPR) * VLD;
#pragma unroll
        for (int i = 0; i < NVR; ++i) {
            const int c = (tid % VTPR) * NVR + i;
#pragma unroll
            for (int hh = 0; hh < 2; ++hh) {
                const int g = 2 * c + hh; const int blk = g >> 3, g32 = g & 7; const int pos = blk * 32 + (2 * (g32 & 3) + (g32 >> 2)) * 4;
                u32x2 w; w.x = hh ? vreg[i].z : vreg[i].x; w.y = hh ? vreg[i].w : vreg[i].y;
                *(u32x2*)(vrow + pos) = w;
            }
        } };
    float al[QT], thr[QT], mxs[QT]; bool resc = false;
#pragma unroll
    for (int qt = 0; qt < QT; ++qt) { al[qt] = 1.f; thr[qt] = 0.f; mxs[qt] = 0.f; }
    auto sm_step = [&](int k, f32x4 (&sn)[4][QT], Frag (&pfn)[QT][2], const bool force) {
        if (k < QT) {
            const int qt = k;
            float mx = max3f(sn[0][qt][0], sn[0][qt][1], sn[0][qt][2]);
            mx = max3f(mx, sn[0][qt][3], sn[1][qt][0]); mx = max3f(mx, sn[1][qt][1], sn[1][qt][2]); mx = max3f(mx, sn[1][qt][3], sn[2][qt][0]);
            mx = max3f(mx, sn[2][qt][1], sn[2][qt][2]); mx = max3f(mx, sn[2][qt][3], sn[3][qt][0]); mx = max3f(mx, sn[3][qt][1], sn[3][qt][2]);
            mxs[qt] = max2f(mx, sn[3][qt][3]);
        } else if (k == QT) {
            bool need = false;
#pragma unroll
            for (int qt = 0; qt < QT; ++qt) need = need || (mxs[qt] > thr[qt]);
            if (force || wave_any(need)) {
#pragma unroll
                for (int qt = 0; qt < QT; ++qt) {
                    float mx = xmax16(mxs[qt]); mx = xmax32(mx);
                    const float mn = fmaxf(st.m[0][qt], mx * sc2);
                    al[qt] *= __builtin_amdgcn_exp2f(st.m[0][qt] - mn);
                    st.m[0][qt] = mn; thr[qt] = (mn + TH) * isc2;
                }
                resc = true;
            }
        } else if (k <= 5 * QT) {
            const int qt = (k - QT - 1) >> 2, kt = (k - QT - 1) & 3; const float mn = st.m[0][qt];
#pragma unroll
            for (int jj = 0; jj < 4; ++jj) sn[kt][qt][jj] = __builtin_amdgcn_exp2f(sn[kt][qt][jj] * sc2 - mn);
        } else if (k <= 7 * QT) {
            const int qt = (k - 5 * QT - 1) >> 1, kk = (k - 5 * QT - 1) & 1;
            pfn[qt][kk].u[0] = pack2(sn[2 * kk][qt][0], sn[2 * kk][qt][1]); pfn[qt][kk].u[1] = pack2(sn[2 * kk][qt][2], sn[2 * kk][qt][3]);
            pfn[qt][kk].u[2] = pack2(sn[2 * kk + 1][qt][0], sn[2 * kk + 1][qt][1]); pfn[qt][kk].u[3] = pack2(sn[2 * kk + 1][qt][2], sn[2 * kk + 1][qt][3]);
#ifndef CPU_EMU
            asm volatile("" : "+v"(pfn[qt][kk].u[0]), "+v"(pfn[qt][kk].u[1]), "+v"(pfn[qt][kk].u[2]), "+v"(pfn[qt][kk].u[3]));
#endif
        }
    };
    constexpr int NSM = 7 * QT + 1;
    auto rescale = [&]() {
        if (resc) {
#pragma unroll
            for (int qt = 0; qt < QT; ++qt) {
#pragma unroll
                for (int et = 0; et < DV / 16; ++et) { st.O[0][et][qt][0] *= al[qt]; st.O[0][et][qt][1] *= al[qt]; st.O[0][et][qt][2] *= al[qt]; st.O[0][et][qt][3] *= al[qt]; }
                st.L[0][qt][0] *= al[qt]; st.L[0][qt][1] *= al[qt]; st.L[0][qt][2] *= al[qt]; st.L[0][qt][3] *= al[qt];
                al[qt] = 1.f;
            }
            resc = false;
        }
    };
    auto pv = [&](int buf, const Frag (&pf)[QT][2]) {
        const bf16_t* Vs = sm + 2 * KBUF + buf * VBUF;
#pragma unroll
        for (int kk = 0; kk < 2; ++kk)
#pragma unroll
            for (int qt = 0; qt < QT; ++qt) st.L[0][qt] = mfma16(ones.v, pf[qt][kk].v, st.L[0][qt]);
#pragma unroll
        for (int et = 0; et < DV / 16; ++et) {
#pragma unroll
            for (int kk = 0; kk < 2; ++kk) {
                Frag vf; vf.q = *(const u32x4*)(Vs + (et * 16 + r) * VLD + kk * 32 + quad * 8);
#pragma unroll
                for (int qt = 0; qt < QT; ++qt) st.O[0][et][qt] = mfma16(vf.v, pf[qt][kk].v, st.O[0][et][qt]);
            }
        } };
    Frag pfa[QT][2], pfb[QT][2];
    loadK();
    __syncthreads();
    storeK(0);
    loadK();
    loadV();
    __syncthreads();
    {
        f32x4 s0[4][QT];
        const bf16_t* Ks = sm;
#pragma unroll
        for (int kt = 0; kt < 4; ++kt) {
            Frag ka0, ka1;
            ka0.q = *(const u32x4*)(Ks + (kt * 16 + r) * KLD + koff + quad * 8);
            ka1.q = *(const u32x4*)(Ks + (kt * 16 + r) * KLD + koff + 32 + quad * 8);
#pragma unroll
            for (int qt = 0; qt < QT; ++qt) {
                f32x4 z = f32x4{0.f, 0.f, 0.f, 0.f};
                z = mfma16(ka0.v, qf[0][0][qt].v, z); z = mfma16(ka1.v, qf[0][1][qt].v, z); s0[kt][qt] = z;
            }
        }
#pragma unroll
        for (int k = 0; k < NSM; ++k) sm_step(k, s0, pfa, true);
    }
    storeK(1);
    storeV(0);
    __syncthreads();
    auto body = [&](const int par, const Frag (&pin)[QT][2], Frag (&pout)[QT][2]) {
        f32x4 sn[4][QT];
        rescale();
        {
            const bf16_t* Ks = sm + ((par + 1) & 1) * KBUF + r * KLD + koff + quad * 8;
            Frag ka[2][2];
            ka[0][0].q = *(const u32x4*)(Ks); ka[0][1].q = *(const u32x4*)(Ks + 32);
#pragma unroll
            for (int kt = 0; kt < 4; ++kt) {
                if (kt < 3) { ka[(kt + 1) & 1][0].q = *(const u32x4*)(Ks + (kt + 1) * 16 * KLD); ka[(kt + 1) & 1][1].q = *(const u32x4*)(Ks + (kt + 1) * 16 * KLD + 32); }
#pragma unroll
                for (int qt = 0; qt < QT; ++qt) {
                    f32x4 z = f32x4{0.f, 0.f, 0.f, 0.f};
                    z = mfma16(ka[kt & 1][0].v, qf[0][0][qt].v, z);
                    z = mfma16(ka[kt & 1][1].v, qf[0][1][qt].v, z); sn[kt][qt] = z;
                }
                if (kt < 2) {
#pragma unroll
                    for (int qt = 0; qt < QT; ++qt) st.L[0][qt] = mfma16(ones.v, pin[qt][kt].v, st.L[0][qt]);
                }
                SCHED_BARRIER();
            }
        }
        {
            const bf16_t* Vs = sm + 2 * KBUF + (par & 1) * VBUF + r * VLD + quad * 8;
            constexpr int NPV = (DV / 16) * 2; constexpr int SPP = (NSM + NPV - 1) / NPV;
            Frag vf[2];
            vf[0].q = *(const u32x4*)Vs;
#pragma unroll
            for (int i = 0; i < NPV; ++i) {
                const int et = i >> 1, kk = i & 1;
                if (i + 1 < NPV) vf[(i + 1) & 1].q = *(const u32x4*)(Vs + ((i + 1) >> 1) * 16 * VLD + ((i + 1) & 1) * 32);
#pragma unroll
                for (int qt = 0; qt < QT; ++qt) st.O[0][et][qt] = mfma16(vf[i & 1].v, pin[qt][kk].v, st.O[0][et][qt]);
#pragma unroll
                for (int q = 0; q < SPP; ++q) sm_step(i * SPP + q, sn, pout, false);
                SCHED_BARRIER();
            }
        }
    };
    int j = 0;
    for (; j + 2 < nt; j += 2) {
        loadK(); loadV();
        body(0, pfa, pfb);
        storeK(0); storeV(1);
        __syncthreads();
        loadK(); loadV();
        body(1, pfb, pfa);
        storeK(1); storeV(0);
        __syncthreads();
    }
    loadV(); body(0, pfa, pfb); storeV(1); __syncthreads();
    rescale();
    pv(1, pfb);
    __syncthreads();
}

DEV void attn_diff_item(const Params& p, int layer, int item, bf16_t* sm) {
    const int nqb = TT / 64; const int qb = item % nqb, h = (item / nqb) % HA, b = item / (nqb * HA);
    const int tid = tid_(), wid = tid >> 6, lane = tid & 63, r = lane & 15, quad = lane >> 4;
    const int comp = wid & 1, rg = wid >> 1;
    const int s0 = qb * 64; const bool ctxq = s0 < CTX; const int nkeys = ctxq ? CTX : TT;
    Frag qf[1][2][2];
#pragma unroll
    for (int ks = 0; ks < 2; ++ks)
#pragma unroll
        for (int qt = 0; qt < 2; ++qt) qf[0][ks][qt].q = *(const u32x4*)(p.Q1 + ((size_t)b * TT + s0 + rg * 32 + qt * 16 + r) * 512 + h * 128 + comp * 64 + ks * 32 + quad * 8);
    AttnState<1, 128, 2> st;
#pragma unroll
    for (int qt = 0; qt < 2; ++qt) {
        st.m[0][qt] = -1.0e30f; st.L[0][qt] = f32x4{0.f, 0.f, 0.f, 0.f};
#pragma unroll
        for (int et = 0; et < 8; ++et) st.O[0][et][qt] = f32x4{0.f, 0.f, 0.f, 0.f};
    }
    attn_core<1, 128, 2, 128>(sm, p.K1 + (size_t)b * TT * 512 + h * 128, 512, p.V1T + ((size_t)(b * HA + h) * 128) * TT, nkeys, qf, st, 0.125f * 1.4426950408889634f, comp * 64);
    const float lam = p.LAM[layer >> 1]; const float lam_init = 0.8f - 0.6f * expf(-0.3f * (float)layer);
    const float* sg = p.ev_subln_g + (layer >> 1) * 128;
    f32x4* xo = (f32x4*)sm;
    __syncthreads();
    if (comp == 1) {
#pragma unroll
        for (int qt = 0; qt < 2; ++qt) {
            const float i2 = lam / st.L[0][qt][0];
#pragma unroll
            for (int et = 0; et < 8; ++et) xo[((rg * 2 + qt) * 8 + et) * 64 + lane] = f32x4{st.O[0][et][qt][0] * i2, st.O[0][et][qt][1] * i2, st.O[0][et][qt][2] * i2, st.O[0][et][qt][3] * i2};
        }
    }
    __syncthreads();
    if (comp == 0) {
#pragma unroll
        for (int qt = 0; qt < 2; ++qt) {
            const float i1 = 1.f / st.L[0][qt][0];
            float ss = 0.f; f32x4 o[8];
#pragma unroll
            for (int et = 0; et < 8; ++et) {
                const f32x4 x2 = xo[((rg * 2 + qt) * 8 + et) * 64 + lane];
#pragma unroll
                for (int j = 0; j < 4; ++j) { float v = st.O[0][et][qt][j] * i1 - x2[j]; o[et][j] = v; ss += v * v; }
            }
            ss = xadd16(ss); ss = xadd32(ss);
            const float rs = (1.f - lam_init) / sqrtf(ss * (1.f / 128.f) + EPS);
            bf16_t* dst = p.CAT + ((size_t)b * TT + s0 + rg * 32 + qt * 16 + r) * 1024 + h * 128;
#pragma unroll
            for (int et = 0; et < 8; ++et) {
                const int e = et * 16 + quad * 4;
                u32x2 w; w.x = pack2(o[et][0] * rs * sg[e], o[et][1] * rs * sg[e + 1]); w.y = pack2(o[et][2] * rs * sg[e + 2], o[et][3] * rs * sg[e + 3]);
                *(u32x2*)(dst + e) = w;
            }
        }
    }
}

DEV void attn_gqa_item(const Params& p, int item, bf16_t* sm) {
    const int nqb = TT / 32; const int qb = item % nqb, kv = (item / nqb) % HKV, b = item / (nqb * HKV);
    const int tid = tid_(), wid = tid >> 6, lane = tid & 63, r = lane & 15, quad = lane >> 4;
    const int s0 = qb * 32; const bool ctxq = s0 < CTX; const int nkeys = ctxq ? CTX : TT; const int hq = kv * 4 + wid;
    Frag qf[1][2][2];
#pragma unroll
    for (int ks = 0; ks < 2; ++ks)
#pragma unroll
        for (int qt = 0; qt < 2; ++qt) qf[0][ks][qt].q = *(const u32x4*)(p.Q1 + ((size_t)b * TT + s0 + qt * 16 + r) * 512 + hq * 64 + ks * 32 + quad * 8);
    AttnState<1, 64, 2> st;
#pragma unroll
    for (int qt = 0; qt < 2; ++qt) {
        st.m[0][qt] = -1.0e30f; st.L[0][qt] = f32x4{0.f, 0.f, 0.f, 0.f};
#pragma unroll
        for (int et = 0; et < 4; ++et) st.O[0][et][qt] = f32x4{0.f, 0.f, 0.f, 0.f};
    }
    attn_core<1, 64, 2, 64>(sm, p.K1 + (size_t)b * TT * 128 + kv * 64, 128, p.V1T + ((size_t)(b * HKV + kv) * 64) * TT, nkeys, qf, st, 0.125f * 1.4426950408889634f, 0);
#pragma unroll
    for (int qt = 0; qt < 2; ++qt) {
        const float il = 1.f / st.L[0][qt][0];
        bf16_t* dst = p.CAT + ((size_t)b * TT + s0 + qt * 16 + r) * 1024 + 512 + hq * 64;
#pragma unroll
        for (int et = 0; et < 4; ++et) {
            const int e = et * 16 + quad * 4;
            u32x2 w; w.x = pack2(st.O[0][et][qt][0] * il, st.O[0][et][qt][1] * il); w.y = pack2(st.O[0][et][qt][2] * il, st.O[0][et][qt][3] * il);
            *(u32x2*)(dst + e) = w;
        }
    }
}

template <int DK, bool NRM>
DEV void rec_dc_item(const Params& p, int item, bf16_t* sm) {
    constexpr int ET = NRM ? 9 : 8; constexpr int ER = NRM ? EVR : 128; constexpr int SLD = 136;
    const int chain = item / NCH, sp = item % NCH; const int dir = chain & 1, h = (chain >> 1) & 3, b = chain >> 3;
    const int u = chunk_of(dir, sp), sbase = u * CH;
    const int tid = tid_(), wid = tid >> 6, lane = tid & 63, r = lane & 15, quad = lane >> 4;
    bf16_t* Vs = sm; bf16_t* Ks = sm + 128 * SLD; float* wk = (float*)(sm + 128 * SLD + DK * SLD);
    __syncthreads();
    float ms1, ms2;
    if (NRM) {
        const float* c2 = p.CH2 + (size_t)chain * NCH * 2;
        const float be = lane < NCH ? c2[lane * 2] : 0.f, am = lane < NCH ? c2[lane * 2 + 1] : 0.f;
        float m = 0.f, mp = 0.f, bq = 0.f;
        for (int q = 0; q <= sp; ++q) { bq = lane_read(be, q, lane); const float aq = lane_read(am, q, lane); mp = m; m = fmaxf(bq + m, bq + aq); }
        ms1 = m; ms2 = bq;
        if (tid == 0) { float* mo = p.MS + ((size_t)chain * NCH + sp) * 4; mo[0] = mp; mo[1] = m; mo[2] = bq; mo[3] = __expf(bq + mp - m); }
    } else { const float* ms = p.MS + ((size_t)chain * NCH + sp) * 4; ms1 = ms[1]; ms2 = ms[2]; }
    if (tid < 128) wk[tid] = __expf(ms2 + p.AT[(size_t)chain * TT + sbase + tid] - ms1);
    const bf16_t* vt = p.V2T + ((size_t)(b * 4 + h) * 128) * TT + sbase;
    for (int c = tid; c < 128 * 16; c += 256) { int row = c >> 4, kc = c & 15; *(u32x4*)(Vs + row * SLD + kc * 8) = *(const u32x4*)(vt + (size_t)row * TT + kc * 8); }
    __syncthreads();
    const bf16_t* kg = p.K2 + ((size_t)b * TT + sbase) * (4 * DK) + h * DK;
    for (int c = tid; c < 128 * (DK / 8); c += 256) {
        const int sl = c & 127, dc8 = (c >> 7) * 8; Frag f; f.q = *(const u32x4*)(kg + (size_t)sl * (4 * DK) + dc8);
        const float w = wk[sl];
#pragma unroll
        for (int i = 0; i < 8; ++i) Ks[(dc8 + i) * SLD + sl] = f2bf(bf2f((bf16_t)f.v[i]) * w);
    }
    __syncthreads();
    constexpr int NTW = DK / 64;
    f32x4 acc[ET][NTW];
#pragma unroll
    for (int et = 0; et < ET; ++et)
#pragma unroll
        for (int n = 0; n < NTW; ++n) acc[et][n] = f32x4{0.f, 0.f, 0.f, 0.f};
#pragma unroll
    for (int ks = 0; ks < 4; ++ks) {
        Frag bf[NTW];
#pragma unroll
        for (int n = 0; n < NTW; ++n) bf[n].q = *(const u32x4*)(Ks + ((wid + 4 * n) * 16 + r) * SLD + ks * 32 + quad * 8);
#pragma unroll
        for (int et = 0; et < ET; ++et) {
            Frag af;
            if (et < 8) af.q = *(const u32x4*)(Vs + (et * 16 + r) * SLD + ks * 32 + quad * 8);
            else { const unsigned one = (r == 0) ? 0x3F803F80u : 0u; af.q = u32x4{one, one, one, one}; }
#pragma unroll
            for (int n = 0; n < NTW; ++n) acc[et][n] = mfma16(af.v, bf[n].v, acc[et][n]);
        }
    }
    bf16_t* dc = p.DC + ((size_t)chain * NCH + sp) * ER * DK;
#pragma unroll
    for (int et = 0; et < ET; ++et)
#pragma unroll
        for (int n = 0; n < NTW; ++n)
#pragma unroll
            for (int j = 0; j < 4; ++j) dc[(size_t)(et * 16 + quad * 4 + j) * DK + (wid + 4 * n) * 16 + r] = f2bf(acc[et][n][j]);
}

template <int DK, bool NRM>
DEV void rec_scan(const Params& p) {
    constexpr int ER = NRM ? EVR : 128;
    const int total = NCHAIN * ER * DK;
    for (int idx = bid_() * 256 + tid_(); idx < total; idx += gridDim.x * 256) {
        const int chain = idx / (ER * DK), el = idx % (ER * DK);
        float c = 0.f;
        for (int sp = 0; sp < NCH; ++sp) {
            const size_t o = ((size_t)chain * NCH + sp) * ER * DK + el;
            p.CP[o] = f2bf(c);
            c = p.MS[((size_t)chain * NCH + sp) * 4 + 3] * c + bf2f(p.DC[o]);
        }
    }
}

template <int DK, bool NRM>
DEV void rec_out_item(const Params& p, int layer, int item, bf16_t* sm) {
    constexpr int ET = NRM ? 9 : 8; constexpr int ER = NRM ? EVR : 128; constexpr int KLD = DK + 8; constexpr int SLD = 136; constexpr int NKS = DK / 32;
    const int half = item & 1, u = (item >> 1) % NCH, h = ((item >> 1) / NCH) & 3, b = (item >> 1) / (NCH * 4);
    const int tid = tid_(), wid = tid >> 6, lane = tid & 63, r = lane & 15, quad = lane >> 4;
    const int sbase = u * CH; const int tl = half * 64 + wid * 16 + r;
    const size_t rowt = (size_t)b * TT + sbase + tl; const int tq = tl - quad * 4;
    bf16_t* RA = sm; bf16_t* Vs = sm + ER * KLD; float* as_ = (float*)(Vs + 128 * SLD);
    __syncthreads();
    const bf16_t* kg = p.K2 + ((size_t)b * TT + sbase) * (4 * DK) + h * DK;
    for (int c = tid; c < 128 * (DK / 8); c += 256) { int row = c / (DK / 8), kc = c % (DK / 8); *(u32x4*)(RA + row * KLD + kc * 8) = *(const u32x4*)(kg + (size_t)row * (4 * DK) + kc * 8); }
    const int chain0 = (b * 4 + h) * 2;
    as_[tid] = p.AT[(size_t)(chain0 + (tid >> 7)) * TT + sbase + (tid & 127)];
    Frag qf[NKS];
#pragma unroll
    for (int ks = 0; ks < NKS; ++ks) qf[ks].q = *(const u32x4*)(p.Q2 + rowt * (4 * DK) + h * DK + ks * 32 + quad * 8);
    __syncthreads();
    f32x4 sT[8];
#pragma unroll
    for (int st = 0; st < 8; ++st) {
        if ((st & 1) == 0) SCHED_BARRIER();
        f32x4 z = f32x4{0.f, 0.f, 0.f, 0.f};
#pragma unroll
        for (int ks = 0; ks < NKS; ++ks) { Frag ka; ka.q = *(const u32x4*)(RA + (st * 16 + r) * KLD + ks * 32 + quad * 8); z = mfma16(ka.v, qf[ks].v, z); }
        sT[st] = z;
    }
    __syncthreads();
    const bf16_t* vt = p.V2T + ((size_t)(b * 4 + h) * 128) * TT + sbase;
    for (int c = tid; c < 128 * 16; c += 256) { int row = c >> 4, kc = c & 15; *(u32x4*)(Vs + row * SLD + kc * 8) = *(const u32x4*)(vt + (size_t)row * TT + kc * 8); }
    f32x4 hs[8];
#pragma unroll
    for (int et = 0; et < 8; ++et) hs[et] = f32x4{0.f, 0.f, 0.f, 0.f};
#pragma unroll 1
    for (int dir = 0; dir < 2; ++dir) {
        const int chain = chain0 + dir; const int sp = sp_of(dir, u);
        if (dir) __syncthreads();
        const bf16_t* cp = p.CP + ((size_t)chain * NCH + sp) * ER * DK;
        for (int c = tid; c < ER * (DK / 8); c += 256) { int row = c / (DK / 8), kc = c % (DK / 8); *(u32x4*)(RA + row * KLD + kc * 8) = *(const u32x4*)(cp + (size_t)row * DK + kc * 8); }
        __syncthreads();
        const float mprev = p.MS[((size_t)chain * NCH + sp) * 4];
        const float bt = p.BC[(size_t)chain * TT + sbase + tl], mtr = p.MT[(size_t)chain * TT + sbase + tl];
        const float mt = NRM ? bt + fmaxf(mprev, mtr) : mtr;
        const float winter = __expf(bt + mprev - mt); const float ct = bt - mt;
        f32x4 acc[ET];
#pragma unroll
        for (int et = 0; et < ET; ++et) {
            if ((et & 1) == 0) SCHED_BARRIER();
            f32x4 z = f32x4{0.f, 0.f, 0.f, 0.f};
#pragma unroll
            for (int ks = 0; ks < NKS; ++ks) { Frag ca; ca.q = *(const u32x4*)(RA + (et * 16 + r) * KLD + ks * 32 + quad * 8); z = mfma16(ca.v, qf[ks].v, z); }
            acc[et] = f32x4{z[0] * winter, z[1] * winter, z[2] * winter, z[3] * winter};
        }
#pragma unroll
        for (int kk = 0; kk < 4; ++kk) {
            SCHED_BARRIER();
            Frag pf;
#pragma unroll
            for (int hf = 0; hf < 2; ++hf) {
                const int st = 2 * kk + hf; float w[4];
#pragma unroll
                for (int j = 0; j < 4; ++j) {
                    const int s = st * 16 + quad * 4 + j; const bool ok = dir ? ((st * 16 + j) >= tq) : ((st * 16 + j) <= tq);
                    w[j] = ok ? sT[st][j] * __expf(ct + as_[dir * 128 + s]) : 0.f;
                }
                pf.u[2 * hf] = pack2(w[0], w[1]); pf.u[2 * hf + 1] = pack2(w[2], w[3]);
            }
#pragma unroll
            for (int et = 0; et < ET; ++et) {
                Frag vf;
                if (et < 8) { const bf16_t* vp = Vs + (et * 16 + r) * SLD + kk * 32 + quad * 4; vf.d[0] = *(const u32x2*)vp; vf.d[1] = *(const u32x2*)(vp + 16); }
                else { const unsigned one = (r == 0) ? 0x3F803F80u : 0u; vf.q = u32x4{one, one, one, one}; }
                acc[et] = mfma16(vf.v, pf.v, acc[et]);
            }
        }
        if (NRM) {
            float den = lane_read(acc[ET - 1][0], r, lane);
            const float dn = 1.f / fmaxf(fabsf(den), __expf(-mt));
#pragma unroll
            for (int et = 0; et < 8; ++et) { hs[et][0] += acc[et][0] * dn; hs[et][1] += acc[et][1] * dn; hs[et][2] += acc[et][2] * dn; hs[et][3] += acc[et][3] * dn; }
        } else {
#pragma unroll
            for (int et = 0; et < 8; ++et) { hs[et][0] += acc[et][0]; hs[et][1] += acc[et][1]; hs[et][2] += acc[et][2]; hs[et][3] += acc[et][3]; }
        }
    }
    if (NRM) {
        const bf16_t* og = p.OG + rowt * 512 + h * 128; const float* g = p.ev_mnorm_g + (layer >> 1) * 512 + h * 128;
        float sum = 0.f;
#pragma unroll
        for (int et = 0; et < 8; ++et) {
            const u32x2 gq = *(const u32x2*)(og + et * 16 + quad * 4);
            hs[et][0] *= sigmf(bf2f((bf16_t)(gq.x & 0xFFFF))); hs[et][1] *= sigmf(bf2f((bf16_t)(gq.x >> 16)));
            hs[et][2] *= sigmf(bf2f((bf16_t)(gq.y & 0xFFFF))); hs[et][3] *= sigmf(bf2f((bf16_t)(gq.y >> 16)));
            sum += hs[et][0] + hs[et][1] + hs[et][2] + hs[et][3];
        }
        sum = xadd16(sum); sum = xadd32(sum);
        const float mu = sum * (1.f / 128.f); float var = 0.f;
#pragma unroll
        for (int et = 0; et < 8; ++et)
#pragma unroll
            for (int j = 0; j < 4; ++j) { float d = hs[et][j] - mu; var += d * d; }
        var = xadd16(var); var = xadd32(var);
        const float rs = 1.f / sqrtf(var * (1.f / 128.f) + EPS);
        bf16_t* dst = p.CAT + rowt * 1024 + 512 + h * 128;
#pragma unroll
        for (int et = 0; et < 8; ++et) {
            const int e = et * 16 + quad * 4;
            u32x2 w; w.x = pack2((hs[et][0] - mu) * rs * g[e], (hs[et][1] - mu) * rs * g[e + 1]); w.y = pack2((hs[et][2] - mu) * rs * g[e + 2], (hs[et][3] - mu) * rs * g[e + 3]);
            *(u32x2*)(dst + e) = w;
        }
    } else {
        const bf16_t* og = p.OG + rowt * 512 + h * 128;
        float ss = 0.f;
#pragma unroll
        for (int et = 0; et < 8; ++et)
#pragma unroll
            for (int j = 0; j < 4; ++j) ss += hs[et][j] * hs[et][j];
        ss = xadd16(ss); ss = xadd32(ss);
        const float rs = 1.f / sqrtf(ss * (1.f / 128.f) + EPS);
        bf16_t* dst = p.CAT + rowt * 1024 + h * 128;
#pragma unroll
        for (int et = 0; et < 8; ++et) {
            const int e = et * 16 + quad * 4; const u32x2 gq = *(const u32x2*)(og + e);
            u32x2 w; w.x = pack2(hs[et][0] * rs * siluf(bf2f((bf16_t)(gq.x & 0xFFFF))), hs[et][1] * rs * siluf(bf2f((bf16_t)(gq.x >> 16))));
            w.y = pack2(hs[et][2] * rs * siluf(bf2f((bf16_t)(gq.y & 0xFFFF))), hs[et][3] * rs * siluf(bf2f((bf16_t)(gq.y >> 16))));
            *(u32x2*)(dst + e) = w;
        }
    }
}

DEV void phaseC(const Params& p, int layer, unsigned char* smem) {
    const bool odd = layer & 1; const bool with_ctx = layer < DEPTH - 1;
    bf16_t* sm = (bf16_t*)smem;
    const int nqb_l = odd ? SEQ / 32 : SEQ / 64, nqb_c = odd ? CTX / 32 : CTX / 64; const int nh = odd ? HKV : HA;
    const int n_lat = BATCH * nh * nqb_l, n_ctx = with_ctx ? BATCH * nh * nqb_c : 0; const int n_dc = NCHAIN * NCH;
    for (int it = bid_(); it < n_lat + n_ctx + n_dc; it += gridDim.x) {
        if (it < n_lat + n_ctx) {
            int qb, bh;
            if (it < n_lat) {
                const int nbh = BATCH * nh;
                if ((nbh & 7) == 0 && (gridDim.x & 7) == 0) { const int x = it & 7, j = it >> 3; bh = (j / nqb_l) * 8 + x; qb = nqb_c + j % nqb_l; }
                else { qb = nqb_c + it % nqb_l; bh = it / nqb_l; }
            } else { int i2 = it - n_lat; qb = i2 % nqb_c; bh = i2 / nqb_c; }
            const int item = bh * (nqb_l + nqb_c) + qb;
            if (odd) attn_gqa_item(p, item, sm); else attn_diff_item(p, layer, item, sm);
        } else {
            const int item = it - n_lat - n_ctx;
            if (odd) rec_dc_item<64, false>(p, item, sm); else rec_dc_item<128, true>(p, item, sm);
        }
    }
}
DEV void phaseD(const Params& p, int layer) { if (layer & 1) rec_scan<64, false>(p); else rec_scan<128, true>(p); }
DEV void phaseE(const Params& p, int layer, unsigned char* smem) {
    const bool odd = layer & 1; const bool with_ctx = layer < DEPTH - 1;
    const int n = BATCH * 4 * NCH * 2;
    for (int it = bid_(); it < n; it += gridDim.x) {
        const int u = (it >> 1) % NCH; if (!with_ctx && u < NCC) continue;
        if (odd) rec_out_item<64, false>(p, layer, it, (bf16_t*)smem); else rec_out_item<128, true>(p, layer, it, (bf16_t*)smem);
    }
}

#ifdef CPU_EMU_SMALL
constexpr int FM_T = 16;
#else
constexpr int FM_T = 17;
#endif
constexpr int F_ROWS = 16 * FM_T, F_NA = 4 * F_ROWS, F_NCH = F_NA + 512, F_STAGE = F_NCH * 16, F_NJ = (F_NCH + 255) / 256;
static_assert(NTOK % F_ROWS == 0 && TT % F_ROWS == 0, "tall output-projection tiles must not straddle sequences");
static_assert(3 * F_STAGE <= LDS_BYTES - 16, "LDS ring of the tall tile");
DEV void phaseF(const Params& p, int layer, unsigned char* smem) {
    const bool with_ctx = layer < DEPTH - 1; const int ncol = D_MODEL / 128, nrow = NTOK / F_ROWS;
    const int tid = tid_(), wid = tid >> 6, lane = tid & 63, r = lane & 15, quad = lane >> 4;
    const int lc8 = g2_lc(tid) * 8;
    const WorkRange wr = xcd_range(nrow * ncol, bid_());
    for (int t = wr.lo; t < wr.hi; t += wr.step) {
        int rt, ct;
        if ((nrow & 7) == 0) { const int rpg = nrow >> 3; const int rg = t / (ncol * rpg), q = t % (ncol * rpg); ct = q / rpg; rt = rg * rpg + q % rpg; } else { rt = t / ncol; ct = t % ncol; }
        const int row0 = rt * F_ROWS, col0 = ct * 128; const int b = row0 / TT, s0 = row0 % TT;
        if (!with_ctx && s0 + F_ROWS <= CTX) continue;
        const bf16_t* abase = p.CAT + (size_t)(row0 + (tid >> 2)) * MIX_OUT + lc8;
        const bf16_t* bbase = p.WoutT + ((size_t)layer * D_MODEL + col0 + (tid >> 2)) * MIX_OUT + lc8;
        constexpr int JMIX = F_NA / 256;
        const bf16_t* mbase = (F_NA % 256 != 0 && tid < F_NA - 256 * JMIX) ? abase + (size_t)JMIX * 64 * MIX_OUT : bbase + (256 * JMIX - F_NA) / 4 * MIX_OUT;
        f32x4 acc[FM_T][2];
#pragma unroll
        for (int m = 0; m < FM_T; ++m) { acc[m][0] = f32x4{0.f, 0.f, 0.f, 0.f}; acc[m][1] = f32x4{0.f, 0.f, 0.f, 0.f}; }
        unsigned char* dst0 = smem + tid * 16;
        auto issue = [&](int kt, int slot) {
            unsigned char* d = dst0 + slot * F_STAGE;
#pragma unroll
            for (int j = 0; j < F_NJ; ++j) {
                if (256 * j + 255 < F_NA) glds16(abase + (size_t)j * 64 * MIX_OUT + kt * 32, d + j * 4096);
                else if (j == JMIX && F_NA % 256 != 0) glds16(mbase + kt * 32, d + j * 4096);
                else if (256 * j + 255 < F_NCH) glds16(bbase + (256 * j - F_NA) / 4 * MIX_OUT + kt * 32, d + j * 4096);
                else if (tid + 256 * j < F_NCH) glds16(bbase + (256 * j - F_NA) / 4 * MIX_OUT + kt * 32, d + j * 4096);
            }
        };
        constexpr int nkt = MIX_OUT / 32;
        RAW_BARRIER();
        issue(0, 0); issue(1, 1);
        const int pco = (quad ^ g2_h((r >> 2) & 3)) * 16;
        const unsigned char* afr = smem + r * 64 + pco;
        const unsigned char* bfr = smem + F_NA * 16 + (wid * 32 + r) * 64 + pco;
        int slot = 0;
        for (int kt = 0; kt < nkt; ++kt) {
            if (kt + 1 < nkt) wait_vm<6>(); else wait_vm<0>();
            RAW_BARRIER();
            if (kt + 2 < nkt) { int ns = slot + 2; if (ns >= 3) ns -= 3; issue(kt + 2, ns); }
            const unsigned char* as = afr + slot * F_STAGE; const unsigned char* bs = bfr + slot * F_STAGE;
            Frag b0, b1; b0.q = *(const u32x4*)bs; b1.q = *(const u32x4*)(bs + 16 * 64);
#ifndef CPU_EMU
            __builtin_amdgcn_s_setprio(1);
#endif
#pragma unroll
            for (int m = 0; m < FM_T; ++m) {
                Frag af; af.q = *(const u32x4*)(as + m * 16 * 64);
                acc[m][0] = mfma16(b0.v, af.v, acc[m][0]); acc[m][1] = mfma16(b1.v, af.v, acc[m][1]);
            }
#ifndef CPU_EMU
            __builtin_amdgcn_s_setprio(0);
#endif
            if (++slot == 3) slot = 0;
        }
        const float* gl = p.MOD + ((size_t)layer * (BATCH + 1) + b) * 6 * D_MODEL + 2 * D_MODEL; const float* gc = p.MOD + ((size_t)layer * (BATCH + 1) + BATCH) * 6 * D_MODEL + 2 * D_MODEL;
#pragma unroll
        for (int n = 0; n < 2; ++n) {
            const int col = col0 + wid * 32 + n * 16 + quad * 4; const f32x4 g_l = *(const f32x4*)(gl + col), g_c = *(const f32x4*)(gc + col);
#pragma unroll
            for (int m = 0; m < FM_T; ++m) {
                const int s = s0 + m * 16 + r; const bool isc = s < CTX;
                if (with_ctx || !isc) { u32x2* x = (u32x2*)(p.X + (size_t)(row0 + m * 16 + r) * D_MODEL + col); *x = pk4(ALPHA * bf4(*x) + (isc ? g_c : g_l) * acc[m][n]); }
                if ((m & 3) == 3) SCHED_BARRIER();
            }
        }
    }
}

constexpr int NV4 = D_MODEL / 256;
DEV void phaseG(const Params& p, int layer, unsigned char* smem) {
    const bool with_ctx = layer < DEPTH - 1;
    const int tid = tid_(); const int wid = tid >> 6, lane = tid & 63; const int bid = bid_();
    const float* lg = p.ln_g + (size_t)(layer * 2) * D_MODEL; const float* lb = p.ln_b + (size_t)(layer * 2) * D_MODEL;
    const float* wr = p.WrT + (size_t)layer * NR * D_MODEL;
    int* lcnt = (int*)smem; int* lbase = lcnt + 32; int* rec = lbase + 32;
    const int half = gridDim.x * 4, stride = half * 2;
    const int nit = (NTOK - bid * 4 + stride - 1) / stride;
    __syncthreads();
    if (tid < 32) lcnt[tid] = 0;
    for (int i = tid; i < nit * 8; i += 256) rec[i * 8] = -1;
    __syncthreads();
    int tok0 = bid * 4 + wid;
    u32x2 xq[2][NV4];
    auto ldx = [&](int t0) {
#pragma unroll
        for (int u = 0; u < 2; ++u) {
            const int tl = imin(t0 + u * half, NTOK - 1);
#pragma unroll
            for (int i = 0; i < NV4; ++i) xq[u][i] = *(const u32x2*)(p.X + (size_t)tl * D_MODEL + (i * 64 + lane) * 4);
        } };
    if (tok0 < NTOK) ldx(tok0);
    for (int it = 0; tok0 < NTOK; tok0 += stride, ++it) {
        f32x4 v[2][NV4]; int tk[2]; bool ok[2]; const float* mod[2];
#pragma unroll
        for (int u = 0; u < 2; ++u)
#pragma unroll
            for (int i = 0; i < NV4; ++i) v[u][i] = bf4(xq[u][i]);
        if (tok0 + stride < NTOK) ldx(tok0 + stride);
#pragma unroll
        for (int u = 0; u < 2; ++u) {
            const int t = tok0 + u * half; const int tc = imin(t, NTOK - 1); const int b = tc / TT, sq = tc % TT;
            tk[u] = tc; ok[u] = (t < NTOK) && (with_ctx || sq >= CTX);
            mod[u] = p.MOD + ((size_t)layer * (BATCH + 1) + (sq < CTX ? BATCH : b)) * 6 * D_MODEL;
        }
        float mu[2], rs[2];
#pragma unroll
        for (int u = 0; u < 2; ++u) { float sum = 0.f;
#pragma unroll
            for (int i = 0; i < NV4; ++i) sum += v[u][i].x + v[u][i].y + v[u][i].z + v[u][i].w;
            mu[u] = sum; }
        { mu[0] = wsum(mu[0]); mu[1] = wsum(mu[1]); }
#pragma unroll
        for (int u = 0; u < 2; ++u) { mu[u] *= (1.f / D_MODEL); float var = 0.f;
#pragma unroll
            for (int i = 0; i < NV4; ++i) { float a = v[u][i].x - mu[u], bq = v[u][i].y - mu[u], c = v[u][i].z - mu[u], d = v[u][i].w - mu[u]; var += a * a + bq * bq + c * c + d * d; }
            rs[u] = var; }
        { rs[0] = wsum(rs[0]); rs[1] = wsum(rs[1]); }
        f32x4 hv[2][NV4];
#pragma unroll
        for (int u = 0; u < 2; ++u) {
            rs[u] = 1.f / sqrtf(rs[u] * (1.f / D_MODEL) + EPS);
            if (lane == 0 && ok[u]) { p.STAT[tk[u] * 2] = mu[u]; p.STAT[tk[u] * 2 + 1] = rs[u]; }
#pragma unroll
            for (int i = 0; i < NV4; ++i) {
                const int k = (i * 64 + lane) * 4;
                const f32x4 g4 = *(const f32x4*)(lg + k), b4 = *(const f32x4*)(lb + k), sh = *(const f32x4*)(mod[u] + 3 * D_MODEL + k), sc = *(const f32x4*)(mod[u] + 4 * D_MODEL + k);
                const f32x4 x1 = (v[u][i] - mu[u]) * rs[u] * g4 + b4;
                hv[u][i] = x1 * (1.f + sc) + sh;
                if (ok[u]) { u32x2 o; o.x = pack2(hv[u][i].x, hv[u][i].y); o.y = pack2(hv[u][i].z, hv[u][i].w); *(u32x2*)(p.H + (size_t)tk[u] * D_MODEL + k) = o; }
            }
        }
        float gl[2][NG];
#pragma unroll
        for (int j = 0; j < NG; ++j) {
#pragma unroll
            for (int u = 0; u < 2; ++u) { float a = 0.f;
#pragma unroll
                for (int i = 0; i < NV4; ++i) { const f32x4 w4 = *(const f32x4*)(wr + (size_t)j * D_MODEL + (i * 64 + lane) * 4); a += hv[u][i].x * w4.x + hv[u][i].y * w4.y + hv[u][i].z * w4.z + hv[u][i].w * w4.w; }
                gl[u][j] = a; }
        }
#pragma unroll
        for (int j = 0; j < NG; ++j) { gl[0][j] = wsum(gl[0][j]); gl[1][j] = wsum(gl[1][j]); }
        int gi[2]; float gw[2]; float ev[2][EPG];
#pragma unroll
        for (int u = 0; u < 2; ++u) {
#pragma unroll
            for (int j = 0; j < NG; ++j) gl[u][j] += p.moe_b_group[layer * NG + j];
            int g = 0; float gm = gl[u][0];
#pragma unroll
            for (int j = 1; j < NG; ++j) if (gl[u][j] > gm) { gm = gl[u][j]; g = j; }
            float gs = 0.f;
#pragma unroll
            for (int j = 0; j < NG; ++j) gs += expf(gl[u][j] - gm);
            gi[u] = g; gw[u] = 1.f / gs;
            const float* wre = wr + (size_t)(NG + g * EPG) * D_MODEL;
#pragma unroll
            for (int j = 0; j < EPG; ++j) { float a = 0.f;
#pragma unroll
                for (int i = 0; i < NV4; ++i) { const f32x4 w4 = *(const f32x4*)(wre + (size_t)j * D_MODEL + (i * 64 + lane) * 4); a += hv[u][i].x * w4.x + hv[u][i].y * w4.y + hv[u][i].z * w4.z + hv[u][i].w * w4.w; }
                ev[u][j] = a; }
        }
#pragma unroll
        for (int j = 0; j < EPG; ++j) { ev[0][j] = wsum(ev[0][j]); ev[1][j] = wsum(ev[1][j]); }
#pragma unroll
        for (int u = 0; u < 2; ++u) {
#pragma unroll
            for (int j = 0; j < EPG; ++j) ev[u][j] += p.moe_b_router[layer * NE + gi[u] * EPG + j];
            int i1 = 0; float v1 = ev[u][0];
#pragma unroll
            for (int j = 1; j < EPG; ++j) if (ev[u][j] > v1) { v1 = ev[u][j]; i1 = j; }
            int i2 = -1; float v2 = -3.0e38f;
#pragma unroll
            for (int j = 0; j < EPG; ++j) if (j != i1 && ev[u][j] > v2) { v2 = ev[u][j]; i2 = j; }
            const float e2 = expf(v2 - v1); const float w1 = gw[u] / (1.f + e2), w2 = gw[u] * e2 / (1.f + e2);
            if (lane == 0 && ok[u]) {
                const int ea = gi[u] * EPG + i1, eb = gi[u] * EPG + i2;
                const int ra = atomicAdd(lcnt + ea, 1), rb = atomicAdd(lcnt + eb, 1);
                int* rc = rec + ((it * 2 + u) * 4 + wid) * 8;
                rc[0] = tk[u]; rc[1] = ea; rc[2] = eb; rc[3] = ra; rc[4] = rb; rc[5] = (int)__float_as_uint(w1); rc[6] = (int)__float_as_uint(w2);
            }
        }
    }
    __syncthreads();
    if (tid < 32) { const int c = lcnt[tid]; lbase[tid] = c ? atomicAdd(p.CNT + (layer * NE + tid) * 32, c) : 0; }
    __syncthreads();
    for (int i = tid; i < nit * 8; i += 256) {
        const int* rc = rec + i * 8; const int tk = rc[0];
        if (tk >= 0) {
            const int ea = rc[1], eb = rc[2]; const int pa = lbase[ea] + rc[3], pb = lbase[eb] + rc[4];
            p.LIST[(size_t)ea * NTOK + pa] = tk * 2; p.LISTW[(size_t)ea * NTOK + pa] = __uint_as_float((unsigned)rc[5]);
            p.LIST[(size_t)eb * NTOK + pb] = tk * 2 + 1; p.LISTW[(size_t)eb * NTOK + pb] = __uint_as_float((unsigned)rc[6]);
        }
    }
}

struct EpGU {
    const Params& p; int slot0, nvalid, col0;
    DEV void nat(f32x4 (&acc)[4][4], int wr, int wc, int lane) {
        const int r = lane & 15, quad = lane >> 4; const int j0 = (col0 + wc * 64) >> 1;
#pragma unroll
        for (int m = 0; m < 4; ++m) {
            const int rl = wr * 64 + m * 16 + r;
            if (rl < nvalid) {
                bf16_t* d = p.ACT + (size_t)(slot0 + rl) * D_EXPERT + j0 + quad * 4;
#pragma unroll
                for (int n = 0; n < 2; ++n) {
                    u32x2 w; w.x = pack2(siluf(acc[m][n][0]) * acc[m][n + 2][0], siluf(acc[m][n][1]) * acc[m][n + 2][1]);
                    w.y = pack2(siluf(acc[m][n][2]) * acc[m][n + 2][2], siluf(acc[m][n][3]) * acc[m][n + 2][3]);
                    *(u32x2*)(d + n * 16) = w;
                }
            }
        }
    }
    DEV void operator()(f32x4 (&acc)[4][4], int wr, int wc, int lane) {
        const int r = lane & 15, quad = lane >> 4; const int j0 = (col0 + wc * 64) >> 1;
#pragma unroll
        for (int m = 0; m < 4; ++m)
#pragma unroll
            for (int j = 0; j < 4; ++j) {
                const int rl = wr * 64 + m * 16 + quad * 4 + j;
                if (rl < nvalid) {
                    bf16_t* d = p.ACT + (size_t)(slot0 + rl) * D_EXPERT + j0 + r;
                    d[0] = f2bf(siluf(acc[m][0][j]) * acc[m][2][j]); d[16] = f2bf(siluf(acc[m][1][j]) * acc[m][3][j]);
                }
            }
    }
};
struct EpDown {
    const Params& p; const float* lw; const int* lp; int nvalid, col0;
    DEV void nat(f32x4 (&acc)[4][4], int wr, int wc, int lane) {
        const int r = lane & 15, quad = lane >> 4;
#pragma unroll
        for (int m = 0; m < 4; ++m) {
            const int rl = wr * 64 + m * 16 + r;
            if (rl < nvalid) {
                const float w = lw[rl]; bf16_t* d = p.YS + (size_t)lp[rl] * D_MODEL + col0 + wc * 64 + quad * 4;
#pragma unroll
                for (int n = 0; n < 4; ++n) { u32x2 o; o.x = pack2(w * acc[m][n][0], w * acc[m][n][1]); o.y = pack2(w * acc[m][n][2], w * acc[m][n][3]); *(u32x2*)(d + n * 16) = o; }
            }
        }
    }
    DEV void operator()(f32x4 (&acc)[4][4], int wr, int wc, int lane) {}
};
template <bool DOWN>
DEV void phaseHI(const Params& p, int layer, unsigned char* smem) {
    int* tpre = (int*)(smem + 74 * 1024); int* sbase = tpre + 40;
    const int tid = tid_(); const int bid = bid_();
    __syncthreads();
    if (tid == 0) {
        int ta = 0, sa = 0;
        for (int e = 0; e < NE; ++e) { const int c = p.CNT[(layer * NE + e) * 32]; tpre[e] = ta; sbase[e] = sa; ta += (c + 127) >> 7; sa += c; }
        tpre[NE] = ta;
        if (bid == 0 && !DOWN) for (int e = 0; e < NE; ++e) p.BASE[e] = sbase[e];
    }
    __syncthreads();
    const int ncol = DOWN ? D_MODEL / 256 : 2 * D_EXPERT / 256; const int ntile = tpre[NE] * ncol;
    const int trow = tid >> 2, lc8 = g2_lc(tid) * 8;
    const WorkRange wr = xcd_range(ntile, bid);
    for (int t = wr.lo; t < wr.hi; t += wr.step) {
        int e = 0;
        for (int q = 1; q < NE; ++q) if (tpre[q] * ncol <= t) e = q;
        const int nrt = tpre[e + 1] - tpre[e]; const int q2 = t - tpre[e] * ncol; const int ct = q2 / nrt, rt = q2 % nrt;
        const int cnt = p.CNT[(layer * NE + e) * 32]; const int nvalid = imin(128, cnt - rt * 128); const int slot0 = sbase[e] + rt * 128;
        if (!DOWN) {
            const int* list = p.LIST + (size_t)e * NTOK + rt * 128;
            const int r0 = imin(trow, nvalid - 1), r1 = imin(64 + trow, nvalid - 1);
            const bf16_t* a0 = p.H + (size_t)(list[r0] >> 1) * D_MODEL + lc8; const bf16_t* a1 = p.H + (size_t)(list[r1] >> 1) * D_MODEL + lc8;
            const bf16_t* bw = p.Wgu + ((size_t)(layer * NE + e) * 2 * D_EXPERT + ct * 256 + trow) * D_MODEL + lc8;
            EpGU ep{p, slot0, nvalid, ct * 256};
            gemm_tile2<2, true>(smem, a0, a1, bw, D_MODEL, D_MODEL / 32, ep);
        } else {
            const bf16_t* a0 = p.ACT + (size_t)(slot0 + trow) * D_EXPERT + lc8;
            const bf16_t* bw = p.WdT + ((size_t)(layer * NE + e) * D_MODEL + ct * 256 + trow) * D_EXPERT + lc8;
            EpDown ep{p, p.LISTW + (size_t)e * NTOK + rt * 128, p.LIST + (size_t)e * NTOK + rt * 128, nvalid, ct * 256};
            gemm_tile2<2, true>(smem, a0, a0 + (size_t)64 * D_EXPERT, bw, D_EXPERT, D_EXPERT / 32, ep);
        }
    }
}

DEV void phaseJ(const Params& p, int layer) {
    const bool with_ctx = layer < DEPTH - 1; const bool last = layer == DEPTH - 1;
    const int wid = tid_() >> 6, lane = tid_() & 63;
    const float* lg1 = p.ln_g + (size_t)(layer * 2) * D_MODEL; const float* lb1 = p.ln_b + (size_t)(layer * 2) * D_MODEL;
    const float* lg = p.ln_g + (size_t)(layer * 2 + 1) * D_MODEL; const float* lb = p.ln_b + (size_t)(layer * 2 + 1) * D_MODEL;
    const int stride = gridDim.x * 4;
    int tok = bid_() * 4 + wid;
    u32x2 xn[NV4], an[NV4], cn[NV4]; float mun = 0.f, rsn = 0.f;
    if (tok < NTOK) {
#pragma unroll
        for (int i = 0; i < NV4; ++i) {
            const int k = (i * 64 + lane) * 4;
            xn[i] = *(const u32x2*)(p.X + (size_t)tok * D_MODEL + k); an[i] = *(const u32x2*)(p.YS + (size_t)(tok * 2) * D_MODEL + k); cn[i] = *(const u32x2*)(p.YS + (size_t)(tok * 2 + 1) * D_MODEL + k);
        }
        mun = p.STAT[tok * 2]; rsn = p.STAT[tok * 2 + 1];
    }
    for (; tok < NTOK; tok += stride) {
        u32x2 x[NV4], a[NV4], c[NV4]; const float mu1 = mun, rs1 = rsn;
#pragma unroll
        for (int i = 0; i < NV4; ++i) { x[i] = xn[i]; a[i] = an[i]; c[i] = cn[i]; }
        const int tn = tok + stride;
        if (tn < NTOK) {
#pragma unroll
            for (int i = 0; i < NV4; ++i) {
                const int k = (i * 64 + lane) * 4;
                xn[i] = *(const u32x2*)(p.X + (size_t)tn * D_MODEL + k); an[i] = *(const u32x2*)(p.YS + (size_t)(tn * 2) * D_MODEL + k); cn[i] = *(const u32x2*)(p.YS + (size_t)(tn * 2 + 1) * D_MODEL + k);
            }
            mun = p.STAT[tn * 2]; rsn = p.STAT[tn * 2 + 1];
        }
        const int b = tok / TT, s = tok % TT; if (!with_ctx && s < CTX) continue;
        const int bb = s < CTX ? BATCH : b; const float* gate = p.MOD + ((size_t)layer * (BATCH + 1) + bb) * 6 * D_MODEL + 5 * D_MODEL;
        f32x4 v[NV4]; float sum = 0.f;
#pragma unroll
        for (int i = 0; i < NV4; ++i) {
            const int k = (i * 64 + lane) * 4; const f32x4 g = *(const f32x4*)(gate + k), g1 = *(const f32x4*)(lg1 + k), b1 = *(const f32x4*)(lb1 + k);
            const f32x4 x1 = (bf4(x[i]) - mu1) * rs1 * g1 + b1;
            v[i] = ALPHA * x1 + g * (bf4(a[i]) + bf4(c[i]));
            sum += v[i].x + v[i].y + v[i].z + v[i].w;
        }
        const float mu = wsum(sum) * (1.f / D_MODEL); float var = 0.f;
#pragma unroll
        for (int i = 0; i < NV4; ++i) { float a0 = v[i].x - mu, bq = v[i].y - mu, c0 = v[i].z - mu, d = v[i].w - mu; var += a0 * a0 + bq * bq + c0 * c0 + d * d; }
        const float rs = 1.f / sqrtf(wsum(var) * (1.f / D_MODEL) + EPS);
        float* dst = p.out + ((size_t)b * SEQ + (s - CTX)) * D_MODEL; bf16_t* dx = p.X + (size_t)tok * D_MODEL;
#pragma unroll
        for (int i = 0; i < NV4; ++i) {
            const int k = (i * 64 + lane) * 4; const f32x4 g4 = *(const f32x4*)(lg + k), b4 = *(const f32x4*)(lb + k);
            f32x4 o; o.x = (v[i].x - mu) * rs * g4.x + b4.x; o.y = (v[i].y - mu) * rs * g4.y + b4.y; o.z = (v[i].z - mu) * rs * g4.z + b4.z; o.w = (v[i].w - mu) * rs * g4.w + b4.w;
            if (last) *(f32x4*)(dst + k) = o; else *(u32x2*)(dx + k) = pk4(o);
            if (!last) {
                const float* mn = p.MOD + ((size_t)(layer + 1) * (BATCH + 1) + bb) * 6 * D_MODEL;
                const f32x4 sh = *(const f32x4*)(mn + k), sc = *(const f32x4*)(mn + D_MODEL + k);
                u32x2 hq; hq.x = pack2(o.x * (1.f + sc.x) + sh.x, o.y * (1.f + sc.y) + sh.y); hq.y = pack2(o.z * (1.f + sc.z) + sh.z, o.w * (1.f + sc.w) + sh.w);
                *(u32x2*)(p.HIN + (size_t)tok * D_MODEL + k) = hq;
            }
        }
    }
}

constexpr int PH_PER_LAYER = 10;
constexpr int NPHASE = 2 + DEPTH * PH_PER_LAYER;
DEV void run_phase(const Params& p, int ph, unsigned char* smem) {
    if (ph == 0) { phase0(p, smem); return; }
    if (ph == 1) { phase0b(p); return; }
    const int layer = (ph - 2) / PH_PER_LAYER, sub = (ph - 2) % PH_PER_LAYER;
    switch (sub) {
        case 0: phaseA(p, layer, smem); break;
        case 1: if (!(layer & 1)) phaseB(p, layer); break;
        case 2: phaseC(p, layer, smem); break;
        case 3: phaseD(p, layer); break;
        case 4: phaseE(p, layer, smem); break;
        case 5: phaseF(p, layer, smem); break;
        case 6: phaseG(p, layer, smem); break;
        case 7: phaseHI<false>(p, layer, smem); break;
        case 8: phaseHI<true>(p, layer, smem); break;
        default: phaseJ(p, layer); break;
    }
}
DEV bool phase_is_empty(int ph) { if (ph < 2) return false; return ((ph - 2) % PH_PER_LAYER) == 1 && (((ph - 2) / PH_PER_LAYER) & 1); }

struct Carver { char* base; size_t off; template <class T> T* take(size_t n) { off = (off + 255) & ~(size_t)255; T* r = (T*)(base + off); off += n * sizeof(T); return r; } };
static void make_params(Params& p, void* const* d_in, void* d_out, void* d_ws) {
    const float** in = (const float**)d_in;
    p.x = in[0]; p.c = in[1]; p.ctx = in[2]; p.c_ctx = in[3]; p.w_mod = in[4]; p.b_mod = in[5]; p.ln_g = in[6]; p.ln_b = in[7];
    p.ev_w_in = in[8]; p.ev_w_out = in[9]; p.ev_lambda = in[10]; p.ev_subln_g = in[11]; p.ev_conv_w = in[12]; p.ev_conv_b = in[13];
    p.ev_gate_b = in[14]; p.ev_mnorm_g = in[15]; p.od_w_in = in[16]; p.od_w_out = in[17]; p.od_decay = in[18]; p.od_qk_g = in[19];
    p.moe_w_group = in[20]; p.moe_b_group = in[21]; p.moe_w_router = in[22]; p.moe_b_router = in[23]; p.moe_w_gate = in[24]; p.moe_w_up = in[25]; p.moe_w_down = in[26];
    p.out = (float*)d_out;
    Carver cv{(char*)d_ws, 0};
    p.X = cv.take<bf16_t>((size_t)NTOK * D_MODEL);
    p.MOD = cv.take<float>((size_t)DEPTH * (BATCH + 1) * 6 * D_MODEL);
    p.ROPE = cv.take<float>(64 * 16 * 2); p.LAM = cv.take<float>(4);
    p.WrT = cv.take<float>((size_t)DEPTH * NR * D_MODEL);
    p.CNT = cv.take<int>(DEPTH * NE * 32); p.BASE = cv.take<int>(NE); p.BAR = cv.take<unsigned>(4096);
    p.WinE = cv.take<bf16_t>((size_t)2 * EVEN_INP * D_MODEL); p.WinO = cv.take<bf16_t>((size_t)2 * ODD_IN * D_MODEL);
    p.WoutT = cv.take<bf16_t>((size_t)DEPTH * D_MODEL * MIX_OUT);
    p.Wgu = cv.take<bf16_t>((size_t)DEPTH * NE * 2 * D_EXPERT * D_MODEL); p.WdT = cv.take<bf16_t>((size_t)DEPTH * NE * D_MODEL * D_EXPERT);
    p.STAT = cv.take<float>((size_t)NTOK * 2);
    p.CAT = cv.take<bf16_t>((size_t)NTOK * 1024); p.HIN = cv.take<bf16_t>((size_t)NTOK * D_MODEL);
    p.LIST = cv.take<int>((size_t)NE * NTOK); p.LISTW = cv.take<float>((size_t)NE * NTOK); p.TOKSLOT = cv.take<int>((size_t)NTOK * 2);
    const size_t mix0 = cv.off;
    p.Q1 = cv.take<bf16_t>((size_t)NTOK * 512); p.K1 = cv.take<bf16_t>((size_t)NTOK * 512); p.V1T = cv.take<bf16_t>((size_t)NTOK * 512);
    p.PM = cv.take<bf16_t>((size_t)NTOK * 1024); p.V2T = cv.take<bf16_t>((size_t)NTOK * 512); p.OG = cv.take<bf16_t>((size_t)NTOK * 512);
    p.G = cv.take<float>((size_t)NTOK * 16);
    p.Q2 = cv.take<bf16_t>((size_t)NTOK * 512); p.K2 = cv.take<bf16_t>((size_t)NTOK * 512); p.K2T = cv.take<bf16_t>((size_t)NTOK * 512);
    p.DC = cv.take<bf16_t>((size_t)NCHAIN * NCH * EVR * 128); p.CP = cv.take<bf16_t>((size_t)NCHAIN * NCH * EVR * 128);
    p.BC = cv.take<float>((size_t)NCHAIN * TT); p.AT = cv.take<float>((size_t)NCHAIN * TT); p.MT = cv.take<float>((size_t)NCHAIN * TT); p.MS = cv.take<float>((size_t)NCHAIN * NCH * 4); p.CH2 = cv.take<float>((size_t)NCHAIN * NCH * 2);
    cv.off = mix0;
    p.H = cv.take<bf16_t>((size_t)NTOK * D_MODEL); p.ACT = cv.take<bf16_t>((size_t)(2 * NTOK + 128) * D_EXPERT); p.YS = cv.take<bf16_t>((size_t)2 * NTOK * D_MODEL);
}

#ifndef CPU_EMU
#define XB_TMO      128
#define XB_XCNT(j)  (256  + 64 * (j))
#define XB_XSUB(j)  (1280 + 64 * (j))
#define XB_XGEN(j)  (2304 + 64 * (j))
#define XB_TOP      3328
#define XB_TOPGEN   3392
#define XCD_BAR_WORDS 3456
#define XB_SPIN_CAP (1u << 20)
#define LAS __attribute__((address_space(3)))
__device__ __forceinline__ unsigned xb_ld(unsigned* p)              { return __hip_atomic_load(p, __ATOMIC_RELAXED, __HIP_MEMORY_SCOPE_AGENT); }
__device__ __forceinline__ unsigned xb_add(unsigned* p, unsigned v) { return __hip_atomic_fetch_add(p, v, __ATOMIC_RELAXED, __HIP_MEMORY_SCOPE_AGENT); }
__device__ __forceinline__ unsigned xb_xcc_id() { return (unsigned)__builtin_amdgcn_s_getreg((3 << 11) | 20) & 0xFu; }
#define XB_SPIN(cond, bar) do { unsigned _sp = 0; while (cond) { __builtin_amdgcn_s_sleep(1); \
    if ((++_sp & 255u) == 0u) { if (xb_ld(&(bar)[XB_TMO])) break; if (_sp > XB_SPIN_CAP) { atomicAdd(&(bar)[XB_TMO], 1u); break; } } } } while (0)
struct XcdBarrier { unsigned* bar; unsigned x; volatile LAS unsigned* st; };
__device__ __forceinline__ XcdBarrier xcd_barrier_post(unsigned* bar, volatile LAS unsigned* st) {
    XcdBarrier b; b.bar = bar; b.x = xb_xcc_id(); b.st = st;
    if (threadIdx.x == 0) (void)xb_add(&bar[XB_XCNT(b.x)], 1u);
    return b;
}
__device__ __forceinline__ void xcd_barrier_complete(unsigned* bar, unsigned x, unsigned& nloc, unsigned& nx) {
    const unsigned G = gridDim.x * gridDim.y * gridDim.z;
    unsigned sum, cnt, mine, sp = 0u;
    for (;;) {
        sum = 0u; cnt = 0u; mine = 0u;
#pragma unroll
        for (unsigned j = 0; j < 16; ++j) { const unsigned c = xb_ld(&bar[XB_XCNT(j)]); sum += c; cnt += (c > 0u) ? 1u : 0u; mine = (j == x) ? c : mine; }
        if (sum == G) break;
        __builtin_amdgcn_s_sleep(1);
        if ((++sp & 255u) == 0u) { if (xb_ld(&bar[XB_TMO])) break; if (sp > XB_SPIN_CAP) { atomicAdd(&bar[XB_TMO], 1u); break; } }
    }
    nloc = mine > 0u ? mine : 1u; nx = cnt > 0u ? cnt : 1u;
}
__device__ __forceinline__ void xcd_barrier(const XcdBarrier& b) {
    asm volatile("s_waitcnt vmcnt(0)" ::: "memory");
    __syncthreads();
    if (threadIdx.x == 0) {
        unsigned* bar = b.bar;
        __builtin_amdgcn_s_waitcnt(0);
        unsigned nloc = b.st[0], nx = b.st[1];
        if (nloc == 0u) { xcd_barrier_complete(bar, b.x, nloc, nx); b.st[0] = nloc; b.st[1] = nx; }
        const unsigned old = xb_add(&bar[XB_XSUB(b.x)], 1u);
        const unsigned gen = old / nloc;
        if (old + 1u == (gen + 1u) * nloc) {
            __builtin_amdgcn_fence(__ATOMIC_RELEASE, "agent");
            asm volatile("s_waitcnt vmcnt(0)" ::: "memory");
            const unsigned og = xb_add(&bar[XB_TOP], 1u);
            const unsigned tg = og / nx;
            if (og + 1u == (tg + 1u) * nx) xb_add(&bar[XB_TOPGEN], 1u);
            else XB_SPIN(xb_ld(&bar[XB_TOPGEN]) == tg, bar);
            __builtin_amdgcn_fence(__ATOMIC_ACQUIRE, "agent");
            xb_add(&bar[XB_XGEN(b.x)], 1u);
            asm volatile("s_waitcnt vmcnt(0)" ::: "memory");
        } else {
            XB_SPIN(xb_ld(&bar[XB_XGEN(b.x)]) == gen, bar);
            __builtin_amdgcn_fence(__ATOMIC_ACQUIRE, "agent");
            asm volatile("s_waitcnt vmcnt(0)" ::: "memory");
        }
    }
    __syncthreads();
}

__global__ void __launch_bounds__(NTHREADS, 2) fwd_megakernel(Params p) {
    __shared__ __attribute__((aligned(16))) unsigned char smem[LDS_BYTES];
    cg::grid_group grid = cg::this_grid();
    volatile LAS unsigned* xst = (volatile LAS unsigned*)(smem + LDS_BYTES - 16);
    if (threadIdx.x == 0) { xst[0] = 0u; xst[1] = 0u; }
    __syncthreads();
    const XcdBarrier xb = xcd_barrier_post(p.BAR, xst);
    grid.sync();
#ifdef PROBE_TS
    unsigned long long ts_acc = 0ull;
#endif
    for (int ph = 0; ph < NPHASE; ++ph) {
        if (phase_is_empty(ph)) continue;
#ifdef PROBE_TS
        const int psub_ = ph == 0 ? 10 : ph == 1 ? 11 : (ph - 2) % PH_PER_LAYER;
        const unsigned long long ts0 = __builtin_amdgcn_s_memrealtime();
#endif
#if defined(__HIP_DEVICE_COMPILE__)
        const __attribute__((address_space(4))) Params* pp = (const __attribute__((address_space(4))) Params*)__builtin_amdgcn_kernarg_segment_ptr();
        asm volatile("" : "+s"(pp));
        const Params q = *pp;
        run_phase(q, ph, smem);
#ifdef DBL_MASK
        { const int sub_ = ph == 0 ? 10 : ph == 1 ? 11 : (ph - 2) % PH_PER_LAYER; if ((DBL_MASK >> sub_) & 1) run_phase(q, ph, smem); }
#endif
#else
        run_phase(p, ph, smem);
#endif
#ifdef PROBE_TS
        const unsigned long long ts1 = __builtin_amdgcn_s_memrealtime();
        xcd_barrier(xb);
        const unsigned long long ts2 = __builtin_amdgcn_s_memrealtime();
        if (PROBE_TS == 100) ts_acc += ts2 - ts1; else if (psub_ == PROBE_TS) ts_acc += ts2 - ts0;
#else
        if (ph + 1 < NPHASE) xcd_barrier(xb);
#endif
    }
#ifdef PROBE_TS
    if (blockIdx.x == 0) { const int np = (int)(ts_acc / 100ull); for (int i = threadIdx.x; i < np; i += NTHREADS) p.out[i] += 1.0f; }
#endif
}

extern "C" void kernel_launch(void* const* d_in, const int* in_sizes, int n_in, void* d_out, int out_size, void* d_ws, size_t ws_size, hipStream_t stream) {
    static int grid_blocks = 0;
    if (!grid_blocks) {
        int dev = 0, cus = 0, per_cu = 0;
        (void)hipGetDevice(&dev); (void)hipDeviceGetAttribute(&cus, hipDeviceAttributeMultiprocessorCount, dev);
        (void)hipOccupancyMaxActiveBlocksPerMultiprocessor(&per_cu, fwd_megakernel, NTHREADS, 0);
        if (per_cu > 2) per_cu = 2;
        if (per_cu < 1) per_cu = 1;
        grid_blocks = cus * per_cu;
    }
    Params p; memset(&p, 0, sizeof(p));
    make_params(p, d_in, d_out, d_ws);
    (void)hipMemsetAsync(p.BAR, 0, 4096 * sizeof(unsigned), stream);
    void* args[] = {&p};
    hipError_t e = hipLaunchCooperativeKernel((void*)fwd_megakernel, dim3(grid_blocks), dim3(NTHREADS), args, 0, stream);
    if (e != hipSuccess) fprintf(stderr, "cooperative launch failed: %s (grid %d)\n", hipGetErrorString(e), grid_blocks);
}
#endif

#if defined(DIAG_KERNELS) && !defined(CPU_EMU)
template <int SUB, int ODD>
__global__ void __launch_bounds__(NTHREADS, 2) k_diag(Params p, int l2) {
    __shared__ __attribute__((aligned(16))) unsigned char smem[LDS_BYTES];
    const int layer = l2 * 2 + ODD;
    if (SUB == 100) { phase0(p, smem); return; }
    if (SUB == 0) phaseA(p, layer, smem);
    if (SUB == 1) phaseB(p, layer);
    if (SUB == 20) { for (int it = bid_(); it < 100; it += gridDim.x) { if (ODD) attn_gqa_item(p, it, (bf16_t*)smem); else attn_diff_item(p, layer, it, (bf16_t*)smem); } }
    if (SUB == 21) { for (int it = bid_(); it < 100; it += gridDim.x) { if (ODD) rec_dc_item<64, false>(p, it, (bf16_t*)smem); else rec_dc_item<128, true>(p, it, (bf16_t*)smem); } }
    if (SUB == 3) phaseD(p, layer);
    if (SUB == 4) phaseE(p, layer, smem);
    if (SUB == 5) phaseF(p, layer, smem);
    if (SUB == 6) phaseG(p, layer, smem);
    if (SUB == 7) phaseHI<false>(p, layer, smem);
    if (SUB == 8) phaseHI<true>(p, layer, smem);
    if (SUB == 9) phaseJ(p, layer);
}
template __global__ void k_diag<100, 0>(Params, int);
template __global__ void k_diag<0, 0>(Params, int);
template __global__ void k_diag<0, 1>(Params, int);
template __global__ void k_diag<1, 0>(Params, int);
template __global__ void k_diag<20, 0>(Params, int);
template __global__ void k_diag<20, 1>(Params, int);
template __global__ void k_diag<21, 0>(Params, int);
template __global__ void k_diag<21, 1>(Params, int);
template __global__ void k_diag<3, 0>(Params, int);
template __global__ void k_diag<4, 0>(Params, int);
template __global__ void k_diag<4, 1>(Params, int);
template __global__ void k_diag<5, 0>(Params, int);
template __global__ void k_diag<6, 0>(Params, int);
template __global__ void k_diag<7, 0>(Params, int);
template __global__ void k_diag<8, 0>(Params, int);
template __global__ void k_diag<9, 0>(Params, int);
#endif
```

```cpp
#ifdef CPU_EMU
#include "emu.h"
#else
#include <hip/hip_runtime.h>
#include <hip/hip_cooperative_groups.h>
#include <cstdio>
#include <cstdint>
#include <cstring>
namespace cg = cooperative_groups;
#endif

#define DEV __device__ __forceinline__
#ifdef CPU_EMU
#define SCHED_BARRIER() do {} while (0)
#else
#define SCHED_BARRIER() __builtin_amdgcn_sched_barrier(0)
#endif
#ifdef CPU_EMU
static inline void glds16(const void* g, void* l) { memcpy(l, g, 16); }
template <int N> static inline void wait_vm() {}
#define RAW_BARRIER() __syncthreads()
#else
__device__ __forceinline__ void glds16(const void* g, void* l) {
    __builtin_amdgcn_global_load_lds((const __attribute__((address_space(1))) unsigned*)g, (__attribute__((address_space(3))) unsigned*)l, 16, 0, 0);
}
template <int N> __device__ __forceinline__ void wait_vm() { asm volatile("s_waitcnt vmcnt(%0)" ::"n"(N) : "memory"); }
#define RAW_BARRIER() do { asm volatile("s_waitcnt lgkmcnt(0)" ::: "memory"); __builtin_amdgcn_s_barrier(); } while (0)
#endif
#ifdef CPU_EMU
static inline int tid_() { return (int)threadIdx.x; }
static inline int bid_() { return (int)blockIdx.x; }
#else
__device__ __forceinline__ int tid_() { int t = threadIdx.x; asm volatile("" : "+v"(t)); return t; }
__device__ __forceinline__ int bid_() { int b = blockIdx.x; asm volatile("" : "+s"(b)); return b; }
#endif

#ifdef CPU_EMU_SMALL
constexpr int D_MODEL = 256, BATCH = 2, SEQ = 256, CTX = 256, D_EXPERT = 128;
#else
constexpr int D_MODEL = 1024, BATCH = 4, SEQ = 4096, CTX = 256, D_EXPERT = 512;
#endif
constexpr int DEPTH = 4, GRID_W = 64, CH = 128;
constexpr int TT = CTX + SEQ, NTOK = BATCH * TT, NCH = TT / CH, NCC = CTX / CH;
constexpr float EPS = 1e-5f;
constexpr float ALPHA = 1.6817928305074290f;
constexpr int HA = 4, HB = 4, HC = 4, HD = 8, HKV = 2;
constexpr int EVEN_IN = 3600, EVEN_INP = 3840, ODD_IN = 2304, MIX_OUT = 1024;
constexpr int NG = 4, EPG = 8, NE = 32, NR = NG + NE;
constexpr int NTHREADS = 256;
constexpr int LDS_BYTES = 76 * 1024;
constexpr int NCHAIN = BATCH * 4 * 2;
constexpr int EVR = 144;

typedef unsigned short bf16_t;
typedef short bf16x8 __attribute__((ext_vector_type(8)));
typedef float f32x4 __attribute__((ext_vector_type(4)));
typedef unsigned u32x4 __attribute__((ext_vector_type(4)));
typedef unsigned u32x2 __attribute__((ext_vector_type(2)));
union Frag { bf16x8 v; u32x4 q; u32x2 d[2]; unsigned u[4]; };
DEV int imin(int a, int b) { return a < b ? a : b; }

#ifdef CPU_EMU
DEV bf16_t f2bf(float f) { unsigned u = __float_as_uint(f); u += 0x7FFFu + ((u >> 16) & 1u); return (bf16_t)(u >> 16); }
DEV unsigned pack2(float a, float b) { return (unsigned)f2bf(a) | ((unsigned)f2bf(b) << 16); }
#else
typedef __bf16 hwbf16x2 __attribute__((ext_vector_type(2)));
typedef float hwf32x2 __attribute__((ext_vector_type(2)));
DEV unsigned pack2(float a, float b) { hwf32x2 v = {a, b}; hwbf16x2 h = __builtin_convertvector(v, hwbf16x2); return __builtin_bit_cast(unsigned, h); }
DEV bf16_t f2bf(float f) { return (bf16_t)(pack2(f, 0.f) & 0xFFFFu); }
#endif
DEV float bf2f(bf16_t h) { return __uint_as_float(((unsigned)h) << 16); }
DEV f32x4 bf4(u32x2 v) { return f32x4{__uint_as_float(v.x << 16), __uint_as_float(v.x & 0xFFFF0000u), __uint_as_float(v.y << 16), __uint_as_float(v.y & 0xFFFF0000u)}; }
DEV u32x2 pk4(f32x4 v) { u32x2 o; o.x = pack2(v.x, v.y); o.y = pack2(v.z, v.w); return o; }
DEV float siluf(float x) { return x / (1.0f + __expf(-x)); }
DEV float sigmf(float x) { return 1.0f / (1.0f + __expf(-x)); }
DEV float logsigf(float x) { return (x >= 0.f) ? -log1pf(expf(-x)) : x - log1pf(expf(x)); }
#ifdef CPU_EMU
DEV float rowred_add(float v) { v += __shfl_xor(v, 1); v += __shfl_xor(v, 2); v += __shfl_xor(v, 4); v += __shfl_xor(v, 8); return v; }
DEV float rowred_max(float v) { v = fmaxf(v, __shfl_xor(v, 1)); v = fmaxf(v, __shfl_xor(v, 2)); v = fmaxf(v, __shfl_xor(v, 4)); v = fmaxf(v, __shfl_xor(v, 8)); return v; }
DEV float lane_read(float v, int src, int lane) { return __shfl(v, src); }
DEV float lane_up(float v, int d, int lane) { return __shfl_up(v, d); }
#else
template <int CTRL> DEV float dppf(float v) { return __uint_as_float((unsigned)__builtin_amdgcn_update_dpp(0, (int)__float_as_uint(v), CTRL, 0xF, 0xF, true)); }
DEV float rowred_add(float v) { v += dppf<0xB1>(v); v += dppf<0x4E>(v); v += dppf<0x141>(v); v += dppf<0x140>(v); return v; }
DEV float rowred_max(float v) { v = fmaxf(v, dppf<0xB1>(v)); v = fmaxf(v, dppf<0x4E>(v)); v = fmaxf(v, dppf<0x141>(v)); v = fmaxf(v, dppf<0x140>(v)); return v; }
DEV float lane_read(float v, int src, int lane) { return __uint_as_float((unsigned)__builtin_amdgcn_ds_bpermute((src & 63) << 2, (int)__float_as_uint(v))); }
DEV float lane_up(float v, int d, int lane) { const float o = __uint_as_float((unsigned)__builtin_amdgcn_ds_bpermute(((lane - d) & 63) << 2, (int)__float_as_uint(v))); return lane >= d ? o : v; }
#endif
#ifdef CPU_EMU
DEV float xch16(float v) { return __shfl_xor(v, 16); }
DEV float xch32(float v) { return __shfl_xor(v, 32); }
#else
typedef unsigned hwu2 __attribute__((ext_vector_type(2)));
DEV void xpair16(float v, float& a, float& b) { const unsigned u = __float_as_uint(v); hwu2 r = __builtin_amdgcn_permlane16_swap(u, u, false, false); a = __uint_as_float(r.x); b = __uint_as_float(r.y); }
DEV void xpair32(float v, float& a, float& b) { const unsigned u = __float_as_uint(v); hwu2 r = __builtin_amdgcn_permlane32_swap(u, u, false, false); a = __uint_as_float(r.x); b = __uint_as_float(r.y); }
#endif
DEV float xmax16(float v) {
#ifdef CPU_EMU
    return fmaxf(v, xch16(v));
#else
    float a, b; xpair16(v, a, b); return fmaxf(a, b);
#endif
}
DEV float xmax32(float v) {
#ifdef CPU_EMU
    return fmaxf(v, xch32(v));
#else
    float a, b; xpair32(v, a, b); return fmaxf(a, b);
#endif
}
DEV float xadd16(float v) {
#ifdef CPU_EMU
    return v + xch16(v);
#else
    float a, b; xpair16(v, a, b); return a + b;
#endif
}
DEV float xadd32(float v) {
#ifdef CPU_EMU
    return v + xch32(v);
#else
    float a, b; xpair32(v, a, b); return a + b;
#endif
}
DEV float wsum(float v) { v = rowred_add(v); v = xadd16(v); return xadd32(v); }
DEV float wmax(float v) { v = rowred_max(v); v = xmax16(v); return xmax32(v); }
DEV f32x4 mfma16(bf16x8 a, bf16x8 b, f32x4 c) { return __builtin_amdgcn_mfma_f32_16x16x32_bf16(a, b, c, 0, 0, 0); }

struct WorkRange { int lo, hi, step; };
DEV WorkRange xcd_range(int T, int bid) {
    WorkRange w; const int G = gridDim.x;
    if ((G & 7) == 0) { const int x = bid & 7, k = bid >> 3; w.lo = (int)(((long long)x * T) >> 3) + k; w.hi = (int)(((long long)(x + 1) * T) >> 3); w.step = G >> 3; }
    else { w.lo = bid; w.hi = T; w.step = G; }
    return w;
}
DEV void dense_tile(int t, int nrow, int ncol, int& rt, int& ct) {
    if ((nrow & 7) == 0) { const int rpg = nrow >> 3; const int rg = t / (ncol * rpg), q = t % (ncol * rpg); ct = q / rpg; rt = rg * rpg + q % rpg; }
    else { rt = t / ncol; ct = t % ncol; }
}

struct Params {
    const float *x, *c, *ctx, *c_ctx, *w_mod, *b_mod, *ln_g, *ln_b, *ev_w_in, *ev_w_out, *ev_lambda, *ev_subln_g, *ev_conv_w, *ev_conv_b,
        *ev_gate_b, *ev_mnorm_g, *od_w_in, *od_w_out, *od_decay, *od_qk_g, *moe_w_group, *moe_b_group, *moe_w_router, *moe_b_router,
        *moe_w_gate, *moe_w_up, *moe_w_down;
    float* out;
    bf16_t* X;
    float *MOD, *ROPE, *LAM, *WrT;
    int* CNT; unsigned* BAR;
    bf16_t *WinE, *WinO, *WoutT, *Wgu, *WdT;
    bf16_t *Q1, *K1, *V1T;
    bf16_t *PM, *V2T, *OG;
    float* G;
    bf16_t *Q2, *K2, *K2T;
    bf16_t* CAT;
    bf16_t *DC, *CP;
    float *BC, *AT, *MT, *MS, *CH2;
    bf16_t *H, *ACT, *HIN, *YS; float* STAT;
    int *LIST, *TOKSLOT, *BASE; float *LISTW;
};

constexpr int GLD = 72;
constexpr int GT = 128 * GLD;

struct BLoadW {
    const bf16_t* base; int ld; u32x4 r[4];
    DEV void fetch(int kt, int tid) {
#pragma unroll
        for (int i = 0; i < 4; ++i) { int c = tid + 256 * i, row = c >> 3, kc = c & 7; r[i] = *(const u32x4*)(base + (size_t)row * ld + kt * 64 + kc * 8); }
    }
    DEV void commit(bf16_t* S, int tid) {
#pragma unroll
        for (int i = 0; i < 4; ++i) { int c = tid + 256 * i, row = c >> 3, kc = c & 7; *(u32x4*)(S + row * GLD + kc * 8) = r[i]; }
    }
};
struct ALoadB {
    const bf16_t* base; int ld; u32x4 r[4];
    DEV void fetch(int kt, int tid) {
#pragma unroll
        for (int i = 0; i < 4; ++i) { int c = tid + 256 * i, row = c >> 3, kc = c & 7; r[i] = *(const u32x4*)(base + (size_t)row * ld + kt * 64 + kc * 8); }
    }
    DEV void commit(bf16_t* S, int tid) {
#pragma unroll
        for (int i = 0; i < 4; ++i) { int c = tid + 256 * i, row = c >> 3, kc = c & 7; *(u32x4*)(S + row * GLD + kc * 8) = r[i]; }
    }
};
struct ALoadG {
    const bf16_t* H; const int* list; int nvalid; u32x4 r[4];
    DEV void fetch(int kt, int tid) {
#pragma unroll
        for (int i = 0; i < 4; ++i) {
            int c = tid + 256 * i, row = c >> 3, kc = c & 7; int rr = row < nvalid ? row : nvalid - 1; int tok = list[rr];
            r[i] = *(const u32x4*)(H + (size_t)tok * D_MODEL + kt * 64 + kc * 8);
        }
    }
    DEV void commit(bf16_t* S, int tid) {
#pragma unroll
        for (int i = 0; i < 4; ++i) { int c = tid + 256 * i, row = c >> 3, kc = c & 7; *(u32x4*)(S + row * GLD + kc * 8) = r[i]; }
    }
};
struct ALoadX {
    const float* base; const float *sc, *sh; f32x4 r[8]; f32x4 s4, h4;
    DEV void fetch(int kt, int tid) {
        int kc = tid & 15;
        s4 = *(const f32x4*)(sc + kt * 64 + kc * 4); h4 = *(const f32x4*)(sh + kt * 64 + kc * 4);
#pragma unroll
        for (int i = 0; i < 8; ++i) { int row = (tid >> 4) + 16 * i; r[i] = *(const f32x4*)(base + (size_t)row * D_MODEL + kt * 64 + kc * 4); }
    }
    DEV void commit(bf16_t* S, int tid) {
        int kc = tid & 15;
#pragma unroll
        for (int i = 0; i < 8; ++i) {
            int row = (tid >> 4) + 16 * i;
            u32x2 o; o.x = pack2(r[i].x * (1.f + s4.x) + h4.x, r[i].y * (1.f + s4.y) + h4.y); o.y = pack2(r[i].z * (1.f + s4.z) + h4.z, r[i].w * (1.f + s4.w) + h4.w);
            *(u32x2*)(S + row * GLD + kc * 4) = o;
        }
    }
};

template <class AL, class BL, class EP>
DEV void gemm_tile(bf16_t* sm, AL& al, BL& bl, int nkt, EP& ep) {
    const int tid = tid_(), wid = tid >> 6, lane = tid & 63, wr = wid >> 1, wc = wid & 1, r = lane & 15, quad = lane >> 4;
    bf16_t* As = sm; bf16_t* Bs = sm + 2 * GT;
    f32x4 acc[4][4];
#pragma unroll
    for (int m = 0; m < 4; ++m)
#pragma unroll
        for (int n = 0; n < 4; ++n) acc[m][n] = f32x4{0.f, 0.f, 0.f, 0.f};
    al.fetch(0, tid); bl.fetch(0, tid); al.commit(As, tid); bl.commit(Bs, tid);
    __syncthreads();
    for (int kt = 0; kt < nkt; ++kt) {
        const int cur = kt & 1;
        if (kt + 1 < nkt) { al.fetch(kt + 1, tid); bl.fetch(kt + 1, tid); }
        const bf16_t* Ac = As + cur * GT + (wr * 64 + r) * GLD + quad * 8;
        const bf16_t* Bc = Bs + cur * GT + (wc * 64 + r) * GLD + quad * 8;
#pragma unroll
        for (int ks = 0; ks < 2; ++ks) {
            Frag a[4], b[4];
#pragma unroll
            for (int m = 0; m < 4; ++m) a[m].q = *(const u32x4*)(Ac + m * 16 * GLD + ks * 32);
#pragma unroll
            for (int n = 0; n < 4; ++n) b[n].q = *(const u32x4*)(Bc + n * 16 * GLD + ks * 32);
#pragma unroll
            for (int m = 0; m < 4; ++m)
#pragma unroll
                for (int n = 0; n < 4; ++n) acc[m][n] = mfma16(a[m].v, b[n].v, acc[m][n]);
        }
        if (kt + 1 < nkt) { al.commit(As + (cur ^ 1) * GT, tid); bl.commit(Bs + (cur ^ 1) * GT, tid); }
        __syncthreads();
    }
    ep(acc, wr, wc, lane);
}


DEV int g2_h(int g) { return (0x78 >> (2 * g)) & 3; }
template <int NH> struct G2 { static constexpr int BROWS = 128 * NH, STAGE = 8192 + BROWS * 64, NST = (NH == 2 ? 3 : 4), LPS = 2 + 2 * NH; };

template <int NH, bool TR, class EP>
DEV void gemm_tile2(unsigned char* sm, const bf16_t* a0, const bf16_t* a1, const bf16_t* bb, int ldb, int nkt, EP& ep) {
    constexpr int STAGE = G2<NH>::STAGE, NST = G2<NH>::NST, LPS = G2<NH>::LPS;
    const int tid = tid_(), wid = tid >> 6, lane = tid & 63, wr = wid >> 1, wc = wid & 1, r = lane & 15, quad = lane >> 4;
    f32x4 acc[NH][4][4];
#pragma unroll
    for (int h = 0; h < NH; ++h)
#pragma unroll
        for (int m = 0; m < 4; ++m)
#pragma unroll
            for (int n = 0; n < 4; ++n) acc[h][m][n] = f32x4{0.f, 0.f, 0.f, 0.f};
    unsigned char* dst0 = sm + tid * 16;
    auto issue = [&](int kt, int slot) {
        unsigned char* d = dst0 + slot * STAGE;
        glds16(a0 + kt * 32, d); glds16(a1 + kt * 32, d + 4096);
#pragma unroll
        for (int j = 0; j < 2 * NH; ++j) glds16(bb + (size_t)j * 64 * ldb + kt * 32, d + 8192 + j * 4096);
    };
    RAW_BARRIER();
#pragma unroll
    for (int st = 0; st < NST - 1; ++st) if (st < nkt) issue(st, st);
    const int pco = (quad ^ g2_h((r >> 2) & 3)) * 16;
    const unsigned char* afr = sm + (wr * 64 + r) * 64 + pco;
    const unsigned char* bfr = sm + 8192 + (wc * 64 * NH + r) * 64 + pco;
    int slot = 0;
    for (int kt = 0; kt < nkt; ++kt) {
        const int rem = nkt - 1 - kt;
        if (NST == 3) { if (rem >= 1) wait_vm<LPS>(); else wait_vm<0>(); }
        else { if (rem >= 2) wait_vm<2 * LPS>(); else if (rem == 1) wait_vm<LPS>(); else wait_vm<0>(); }
        RAW_BARRIER();
        if (kt + NST - 1 < nkt) { int ns = slot + NST - 1; if (ns >= NST) ns -= NST; issue(kt + NST - 1, ns); }
        const unsigned char* as = afr + slot * STAGE; const unsigned char* bs = bfr + slot * STAGE;
        Frag a[4];
#pragma unroll
        for (int m = 0; m < 4; ++m) a[m].q = *(const u32x4*)(as + m * 16 * 64);
#ifndef CPU_EMU
        __builtin_amdgcn_s_setprio(1);
#endif
#pragma unroll
        for (int h = 0; h < NH; ++h) {
            Frag b[4];
#pragma unroll
            for (int n = 0; n < 4; ++n) b[n].q = *(const u32x4*)(bs + (h * 64 + n * 16) * 64);
#pragma unroll
            for (int m = 0; m < 4; ++m)
#pragma unroll
                for (int n = 0; n < 4; ++n) acc[h][m][n] = TR ? mfma16(b[n].v, a[m].v, acc[h][m][n]) : mfma16(a[m].v, b[n].v, acc[h][m][n]);
        }
#ifndef CPU_EMU
        __builtin_amdgcn_s_setprio(0);
#endif
        if (++slot == NST) slot = 0;
    }
#pragma unroll
    for (int h = 0; h < NH; ++h) { if (TR) ep.nat(acc[h], wr, wc * NH + h, lane); else ep(acc[h], wr, wc * NH + h, lane); }
}
DEV int g2_lc(int tid) { return (tid & 3) ^ g2_h((tid >> 4) & 3); }

struct ConvJob { const float* src; bf16_t* dst; int ldsrc, N, K, k0, n0, mapkind; };
DEV void conv_load(const ConvJob& j, int tid, f32x4 (&v)[4]) {
#pragma unroll
    for (int i = 0; i < 4; ++i) {
        const int kk = (tid >> 4) + 16 * i, n = j.n0 + 4 * (tid & 15);
        v[i] = f32x4{0.f, 0.f, 0.f, 0.f};
        if (n + 3 < j.N) v[i] = *(const f32x4*)(j.src + (size_t)(j.k0 + kk) * j.ldsrc + n);
    }
}
DEV void conv_store(float* T, const ConvJob& j, int tid, const f32x4 (&v)[4]) {
    __syncthreads();
#pragma unroll
    for (int i = 0; i < 4; ++i) {
        const int kk = (tid >> 4) + 16 * i, n4 = tid & 15;
        T[(4 * n4 + 0) * 65 + kk] = v[i].x; T[(4 * n4 + 1) * 65 + kk] = v[i].y; T[(4 * n4 + 2) * 65 + kk] = v[i].z; T[(4 * n4 + 3) * 65 + kk] = v[i].w;
    }
    __syncthreads();
    const int nl = tid >> 2, ks = (tid & 3) * 16; const int n = j.n0 + nl; int dr = n;
    if (j.mapkind == 1) dr = (n >> 5) * 64 + (n & 31); else if (j.mapkind == 2) dr = (n >> 5) * 64 + 32 + (n & 31);
    const float* t = T + nl * 65 + ks;
    u32x4 o0, o1;
    o0.x = pack2(t[0], t[1]); o0.y = pack2(t[2], t[3]); o0.z = pack2(t[4], t[5]); o0.w = pack2(t[6], t[7]);
    o1.x = pack2(t[8], t[9]); o1.y = pack2(t[10], t[11]); o1.z = pack2(t[12], t[13]); o1.w = pack2(t[14], t[15]);
    bf16_t* d = j.dst + (size_t)dr * j.K + j.k0 + ks;
    *(u32x4*)d = o0; *(u32x4*)(d + 8) = o1;
}
constexpr int P0_NMOD = DEPTH * 6 * D_MODEL / 64;
constexpr int P0_NCOPY = NTOK / 64;
constexpr int T_EIN = (D_MODEL / 64) * (EVEN_INP / 64), T_OIN = (D_MODEL / 64) * (ODD_IN / 64), T_OUT = (MIX_OUT / 64) * (D_MODEL / 64);
constexpr int T_GU = (D_MODEL / 64) * (D_EXPERT / 64), T_DN = (D_EXPERT / 64) * (D_MODEL / 64);
constexpr int P0_C0 = P0_NMOD + P0_NCOPY + 1 + DEPTH;
constexpr int P0_C1 = 2 * T_EIN, P0_C2 = P0_C1 + 2 * T_OIN, P0_C3 = P0_C2 + DEPTH * T_OUT, P0_C4 = P0_C3 + DEPTH * NE * 2 * T_GU, P0_C5 = P0_C4 + DEPTH * NE * T_DN;
DEV ConvJob conv_job(const Params& p, int t) {
    ConvJob j;
    if (t < P0_C1) {
        const int i = t / T_EIN, tt = t % T_EIN; const int nt = tt % (EVEN_INP / 64), kt = tt / (EVEN_INP / 64);
        j.src = p.ev_w_in + (size_t)i * D_MODEL * EVEN_IN; j.ldsrc = EVEN_IN; j.N = EVEN_IN; j.K = D_MODEL; j.k0 = kt * 64; j.n0 = nt * 64; j.dst = p.WinE + (size_t)i * EVEN_INP * D_MODEL; j.mapkind = 0;
    } else if (t < P0_C2) {
        const int q = t - P0_C1, i = q / T_OIN, tt = q % T_OIN; const int nt = tt % (ODD_IN / 64), kt = tt / (ODD_IN / 64);
        j.src = p.od_w_in + (size_t)i * D_MODEL * ODD_IN; j.ldsrc = ODD_IN; j.N = ODD_IN; j.K = D_MODEL; j.k0 = kt * 64; j.n0 = nt * 64; j.dst = p.WinO + (size_t)i * ODD_IN * D_MODEL; j.mapkind = 0;
    } else if (t < P0_C3) {
        const int q = t - P0_C2, layer = q / T_OUT, tt = q % T_OUT; const int nt = tt % (D_MODEL / 64), kt = tt / (D_MODEL / 64);
        j.src = (layer & 1) ? p.od_w_out + (size_t)(layer >> 1) * MIX_OUT * D_MODEL : p.ev_w_out + (size_t)(layer >> 1) * MIX_OUT * D_MODEL;
        j.ldsrc = D_MODEL; j.N = D_MODEL; j.K = MIX_OUT; j.k0 = kt * 64; j.n0 = nt * 64; j.dst = p.WoutT + (size_t)layer * D_MODEL * MIX_OUT; j.mapkind = 0;
    } else if (t < P0_C4) {
        const int q = t - P0_C3, le = q / (2 * T_GU); int tt = q % (2 * T_GU); const int up = tt / T_GU; tt %= T_GU; const int nt = tt % (D_EXPERT / 64), kt = tt / (D_EXPERT / 64);
        j.src = (up ? p.moe_w_up : p.moe_w_gate) + (size_t)le * D_MODEL * D_EXPERT; j.ldsrc = D_EXPERT; j.N = D_EXPERT; j.K = D_MODEL; j.k0 = kt * 64; j.n0 = nt * 64;
        j.dst = p.Wgu + (size_t)le * 2 * D_EXPERT * D_MODEL; j.mapkind = 1 + up;
    } else {
        const int q = t - P0_C4, le = q / T_DN, tt = q % T_DN; const int nt = tt % (D_MODEL / 64), kt = tt / (D_MODEL / 64);
        j.src = p.moe_w_down + (size_t)le * D_EXPERT * D_MODEL; j.ldsrc = D_MODEL; j.N = D_MODEL; j.K = D_EXPERT; j.k0 = kt * 64; j.n0 = nt * 64; j.dst = p.WdT + (size_t)le * D_MODEL * D_EXPERT; j.mapkind = 0;
    }
    return j;
}

DEV void phase0(const Params& p, unsigned char* smem) {
    const int tid = tid_(); const int bid = bid_();
    float* fs = (float*)smem;
    for (int task = bid; task < P0_C0; task += gridDim.x) {
        if (task < P0_NMOD) {
            __syncthreads();
            for (int i = tid; i < (BATCH + 1) * D_MODEL; i += 256) { int bb = i / D_MODEL, k = i % D_MODEL; float v = bb < BATCH ? p.c[bb * D_MODEL + k] : p.c_ctx[k]; fs[i] = v / (1.f + expf(-v)); }
            __syncthreads();
            const int col = task * 64 + (tid & 63), kg = tid >> 6; const int layer = col / (6 * D_MODEL), j = col % (6 * D_MODEL);
            const float* w = p.w_mod + (size_t)layer * D_MODEL * 6 * D_MODEL + j;
            float acc[BATCH + 1];
#pragma unroll
            for (int bb = 0; bb <= BATCH; ++bb) acc[bb] = 0.f;
#pragma unroll 16
            for (int k = kg * (D_MODEL / 4); k < (kg + 1) * (D_MODEL / 4); ++k) {
                float wv = w[(size_t)k * 6 * D_MODEL];
#pragma unroll
                for (int bb = 0; bb <= BATCH; ++bb) acc[bb] += fs[bb * D_MODEL + k] * wv;
            }
            float* red = fs + (BATCH + 1) * D_MODEL;
#pragma unroll
            for (int bb = 0; bb <= BATCH; ++bb) red[(kg * (BATCH + 1) + bb) * 64 + (tid & 63)] = acc[bb];
            __syncthreads();
            if (tid < 64) {
                const float bm = p.b_mod[layer * 6 * D_MODEL + j];
#pragma unroll
                for (int bb = 0; bb <= BATCH; ++bb) {
                    const float sacc = red[(0 * (BATCH + 1) + bb) * 64 + tid] + red[(1 * (BATCH + 1) + bb) * 64 + tid] + red[(2 * (BATCH + 1) + bb) * 64 + tid] + red[(3 * (BATCH + 1) + bb) * 64 + tid];
                    p.MOD[((size_t)layer * (BATCH + 1) + bb) * 6 * D_MODEL + j] = sacc + bm;
                }
            }
        } else if (task < P0_NMOD + P0_NCOPY) {
            int r0 = (task - P0_NMOD) * 64;
            for (int i = tid; i < 64 * D_MODEL / 4; i += 256) {
                int row = r0 + i / (D_MODEL / 4), c4 = i % (D_MODEL / 4); int b = row / TT, s = row % TT;
                const float* src = s < CTX ? p.ctx + ((size_t)b * CTX + s) * D_MODEL : p.x + ((size_t)b * SEQ + (s - CTX)) * D_MODEL;
                *(u32x2*)(p.X + (size_t)row * D_MODEL + c4 * 4) = pk4(*(const f32x4*)(src + c4 * 4));

            }
        } else if (task == P0_NMOD + P0_NCOPY) {
            for (int i = tid; i < 64 * 16; i += 256) {
                int pos = i / 16, f = i % 16;
                double th = 1.0; for (int q = 0; q < f; ++q) th *= 0.5623413251903490804;
                double t2 = th * th, cs = 1.0, sn = th, tc = 1.0, ts = th;
                for (int n = 1; n < 14; ++n) { tc *= -t2 / ((2 * n - 1) * (2 * n)); ts *= -t2 / ((2 * n) * (2 * n + 1)); cs += tc; sn += ts; }
                double c = 1.0, s = 0.0;
                for (int q = 0; q < pos; ++q) { double cn = c * cs - s * sn, sn2 = s * cs + c * sn; c = cn; s = sn2; }
                p.ROPE[i * 2] = (float)c; p.ROPE[i * 2 + 1] = (float)s;
            }
            if (tid < 2) {
                const float* lp = p.ev_lambda + tid * 4 * 64; float s01 = 0.f, s23 = 0.f;
                for (int k = 0; k < 64; ++k) { s01 += lp[k] * lp[64 + k]; s23 += lp[128 + k] * lp[192 + k]; }
                float lam_init = 0.8f - 0.6f * expf(-0.3f * (float)(2 * tid));
                p.LAM[tid] = expf(s01) - expf(s23) + lam_init;
            }
            for (int i = tid; i < DEPTH * NE * 32; i += 256) p.CNT[i] = 0;
        } else {
            int layer = task - (P0_NMOD + P0_NCOPY + 1);
            for (int i = tid; i < NR * D_MODEL; i += 256) {
                int j = i / D_MODEL, k = i % D_MODEL;
                float v = j < NG ? p.moe_w_group[((size_t)layer * D_MODEL + k) * NG + j] : p.moe_w_router[((size_t)layer * D_MODEL + k) * NE + (j - NG)];
                p.WrT[(size_t)layer * NR * D_MODEL + i] = v;
            }
        }
    }
    {
        const int G = gridDim.x; int t = bid;
        ConvJob j0, j1, j2; f32x4 v0[4], v1[4], v2[4];
        const bool h0 = t < P0_C5, h1 = t + G < P0_C5;
        if (h0) { j0 = conv_job(p, t); conv_load(j0, tid, v0); } else { j0 = conv_job(p, 0); }
        if (h1) { j1 = conv_job(p, t + G); conv_load(j1, tid, v1); } else { j1 = j0; }
        j2 = j1;
        while (t < P0_C5) {
            const bool h2 = t + 2 * G < P0_C5;
            if (h2) { j2 = conv_job(p, t + 2 * G); conv_load(j2, tid, v2); }
            conv_store(fs, j0, tid, v0);
            j0 = j1; j1 = j2;
#pragma unroll
            for (int i = 0; i < 4; ++i) { v0[i] = v1[i]; v1[i] = v2[i]; }
            t += G;
        }
    }
}

DEV int chunk_of(int dir, int sp) { return dir == 0 ? sp : (sp < NCC ? NCC - 1 - sp : NCC + (NCH - 1 - sp)); }
DEV int sp_of(int dir, int u) { return dir == 0 ? u : (u < NCC ? NCC - 1 - u : NCC + (NCH - 1 - u)); }

template <bool RET>
DEV void gate_chain(const Params& p, int layer, int chain) {
    const int lane = tid_() & 63;
    const int dir = chain & 1, h = (chain >> 1) & 3, b = chain >> 3;
    float lg = 0.f;
    if (RET) lg = logsigf(p.od_decay[((layer >> 1) * 2 + dir) * HC + h]);
    float mprev = 0.f;
    for (int sp = 0; sp < NCH; ++sp) {
        const int u = chunk_of(dir, sp); const int sbase = u * CH;
        int i0 = 2 * lane, i1 = 2 * lane + 1;
        int s0 = dir ? sbase + 127 - i0 : sbase + i0, s1 = dir ? sbase + 127 - i1 : sbase + i1;
        float lf0, lf1, li0, li1;
        if (RET) { lf0 = lf1 = lg; li0 = li1 = 0.f; }
        else {
            const float* g0 = p.G + ((size_t)b * TT + s0) * 16; const float* g1 = p.G + ((size_t)b * TT + s1) * 16;
            li0 = g0[(2 * dir) * 4 + h]; li1 = g1[(2 * dir) * 4 + h];
            lf0 = logsigf(g0[(2 * dir + 1) * 4 + h]); lf1 = logsigf(g1[(2 * dir + 1) * 4 + h]);
        }
        float ps = lf0 + lf1;
        for (int d = 1; d < 64; d <<= 1) { float o = lane_up(ps, d, lane); if (lane >= d) ps += o; }
        float b1 = ps, b0 = ps - lf1;
        float bend = lane_read(ps, 63, lane);
        float a0 = li0 - b0, a1 = li1 - b1;
        float pm = fmaxf(a0, a1);
        float mx = pm;
        for (int d = 1; d < 64; d <<= 1) { float o = lane_up(mx, d, lane); if (lane >= d) mx = fmaxf(mx, o); }
        float pmx_prev = lane_up(mx, 1, lane); if (lane == 0) pmx_prev = -3.0e38f;
        float pm0 = fmaxf(pmx_prev, a0), pm1 = mx;
        float amax = lane_read(mx, 63, lane);
        float mnew, carry, mt0, mt1;
        if (RET) { mnew = 0.f; carry = __expf(bend); mt0 = mt1 = 0.f; }
        else { mnew = fmaxf(bend + mprev, bend + amax); carry = __expf(bend + mprev - mnew); mt0 = b0 + fmaxf(mprev, pm0); mt1 = b1 + fmaxf(mprev, pm1); }
        size_t o = (size_t)chain * TT;
        p.BC[o + s0] = b0; p.BC[o + s1] = b1; p.AT[o + s0] = a0; p.AT[o + s1] = a1; p.MT[o + s0] = mt0; p.MT[o + s1] = mt1;
        if (lane == 0) { float* ms = p.MS + ((size_t)chain * NCH + sp) * 4; ms[0] = mprev; ms[1] = mnew; ms[2] = bend; ms[3] = carry; }
        mprev = mnew;
    }
}

struct EpInEven {
    const Params& p; int layer, row0, col0;
    DEV void nat(f32x4 (&acc)[4][4], int wr, int wc, int lane) {
        const int r = lane & 15, quad = lane >> 4;
        const int c0 = col0 + wc * 64, rowb = row0 + wr * 64;
        const int b = row0 / TT; const int sb = rowb - b * TT; const bool lat = sb >= CTX;
        if (c0 < 1024) {
            bf16_t* dst = c0 < 512 ? p.Q1 : p.K1; const int cc = c0 & 511;
#pragma unroll
            for (int m = 0; m < 4; ++m) {
                const int row = rowb + m * 16 + r;
                f32x4 v0 = acc[m][0], v1 = acc[m][1], v2 = acc[m][2], v3 = acc[m][3];
                if (lat) {
                    const int t = sb + m * 16 + r - CTX; const int pr = t / GRID_W, pc = t % GRID_W;
                    const f32x4 ra = *(const f32x4*)(p.ROPE + (pr * 16 + quad * 4) * 2), rb = *(const f32x4*)(p.ROPE + (pr * 16 + quad * 4) * 2 + 4);
                    const f32x4 ca = *(const f32x4*)(p.ROPE + (pc * 16 + quad * 4) * 2), cb = *(const f32x4*)(p.ROPE + (pc * 16 + quad * 4) * 2 + 4);
                    const f32x4 cr = f32x4{ra[0], ra[2], rb[0], rb[2]}, sr = f32x4{ra[1], ra[3], rb[1], rb[3]};
                    const f32x4 cq = f32x4{ca[0], ca[2], cb[0], cb[2]}, sq = f32x4{ca[1], ca[3], cb[1], cb[3]};
                    const f32x4 o0 = v0 * cr - v2 * sr, o2 = v0 * sr + v2 * cr, o1 = v1 * cq - v3 * sq, o3 = v1 * sq + v3 * cq;
                    v0 = o0; v1 = o1; v2 = o2; v3 = o3;
                }
                bf16_t* d = dst + (size_t)row * 512 + cc + quad * 4;
                u32x2 w; w.x = pack2(v0[0], v0[1]); w.y = pack2(v0[2], v0[3]); *(u32x2*)d = w;
                w.x = pack2(v1[0], v1[1]); w.y = pack2(v1[2], v1[3]); *(u32x2*)(d + 16) = w;
                w.x = pack2(v2[0], v2[1]); w.y = pack2(v2[2], v2[3]); *(u32x2*)(d + 32) = w;
                w.x = pack2(v3[0], v3[1]); w.y = pack2(v3[2], v3[3]); *(u32x2*)(d + 48) = w;
            }
        } else if (c0 < 3584) {
            const bool pm = c0 < 2560; bf16_t* dst = pm ? p.PM : p.OG; const int ld = pm ? 1024 : 512; const int cc = pm ? c0 - 1536 : c0 - 3072;
#pragma unroll
            for (int m = 0; m < 4; ++m) {
                bf16_t* d = dst + (size_t)(rowb + m * 16 + r) * ld + cc + quad * 4;
#pragma unroll
                for (int n = 0; n < 4; ++n) { u32x2 w; w.x = pack2(acc[m][n][0], acc[m][n][1]); w.y = pack2(acc[m][n][2], acc[m][n][3]); *(u32x2*)(d + n * 16) = w; }
            }
        } else if (c0 == 3584) {
            const f32x4 gb = *(const f32x4*)(p.ev_gate_b + (layer >> 1) * 16 + quad * 4);
#pragma unroll
            for (int m = 0; m < 4; ++m) *(f32x4*)(p.G + (size_t)(rowb + m * 16 + r) * 16 + quad * 4) = acc[m][0] + gb;
        }
    }
    DEV void operator()(f32x4 (&acc)[4][4], int wr, int wc, int lane) {
        const int r = lane & 15, quad = lane >> 4;
        const int c0 = col0 + wc * 64, rowb = row0 + wr * 64;
        const int b = row0 / TT; const int sb = rowb - b * TT; const bool lat = sb >= CTX;
        if (c0 < 1024) {
            bf16_t* dst = c0 < 512 ? p.Q1 : p.K1; const int cc = c0 & 511;
#pragma unroll
            for (int m = 0; m < 4; ++m)
#pragma unroll
                for (int j = 0; j < 4; ++j) {
                    const int row = rowb + m * 16 + quad * 4 + j;
                    float v0 = acc[m][0][j], v1 = acc[m][1][j], v2 = acc[m][2][j], v3 = acc[m][3][j];
                    if (lat) {
                        const int t = sb + m * 16 + quad * 4 + j - CTX; const int pr = t / GRID_W, pc = t % GRID_W;
                        const float cr = p.ROPE[(pr * 16 + r) * 2], sr = p.ROPE[(pr * 16 + r) * 2 + 1], cq = p.ROPE[(pc * 16 + r) * 2], sq = p.ROPE[(pc * 16 + r) * 2 + 1];
                        float o0 = v0 * cr - v2 * sr, o2 = v0 * sr + v2 * cr, o1 = v1 * cq - v3 * sq, o3 = v1 * sq + v3 * cq;
                        v0 = o0; v1 = o1; v2 = o2; v3 = o3;
                    }
                    bf16_t* d = dst + (size_t)row * 512 + cc + r;
                    d[0] = f2bf(v0); d[16] = f2bf(v1); d[32] = f2bf(v2); d[48] = f2bf(v3);
                }
        } else if (c0 < 1536 || (c0 >= 2560 && c0 < 3072)) {
            const bool at = c0 < 1536; const int cc = at ? c0 - 1024 : c0 - 2560; const int h = cc >> 7, e0 = (cc & 127);
            bf16_t* dst = (at ? p.V1T : p.V2T) + ((size_t)(b * 4 + h) * 128) * TT;
#pragma unroll
            for (int m = 0; m < 4; ++m)
#pragma unroll
                for (int n = 0; n < 4; ++n) {
                    u32x2 o; o.x = pack2(acc[m][n][0], acc[m][n][1]); o.y = pack2(acc[m][n][2], acc[m][n][3]);
                    *(u32x2*)(dst + (size_t)(e0 + n * 16 + r) * TT + sb + m * 16 + quad * 4) = o;
                }
        } else if (c0 < 2560 || (c0 >= 3072 && c0 < 3584)) {
            const bool pm = c0 < 2560; bf16_t* dst = pm ? p.PM : p.OG; const int ld = pm ? 1024 : 512; const int cc = pm ? c0 - 1536 : c0 - 3072;
#pragma unroll
            for (int m = 0; m < 4; ++m)
#pragma unroll
                for (int j = 0; j < 4; ++j) {
                    const int row = rowb + m * 16 + quad * 4 + j; bf16_t* d = dst + (size_t)row * ld + cc + r;
                    d[0] = f2bf(acc[m][0][j]); d[16] = f2bf(acc[m][1][j]); d[32] = f2bf(acc[m][2][j]); d[48] = f2bf(acc[m][3][j]);
                }
        } else if (c0 == 3584) {
            const float gb = p.ev_gate_b[(layer >> 1) * 16 + r];
#pragma unroll
            for (int m = 0; m < 4; ++m)
#pragma unroll
                for (int j = 0; j < 4; ++j) { const int row = rowb + m * 16 + quad * 4 + j; p.G[(size_t)row * 16 + r] = acc[m][0][j] + gb; }
        }
    }
};

struct EpInOdd {
    const Params& p; int layer, row0, col0;
    DEV void nat(f32x4 (&acc)[4][4], int wr, int wc, int lane) {
        const int r = lane & 15, quad = lane >> 4;
        const int c0 = col0 + wc * 64, rowb = row0 + wr * 64;
        const int b = row0 / TT; const int sb = rowb - b * TT; const bool lat = sb >= CTX;
        if (c0 < 512 || (c0 >= 1024 && c0 < 1536)) {
            bf16_t* dst; int ld, cc; float scl = 1.f;
            if (c0 < 256) { dst = p.Q2; ld = 256; cc = c0; } else if (c0 < 512) { dst = p.K2; ld = 256; cc = c0 - 256; scl = 0.125f; } else { dst = p.OG; ld = 512; cc = c0 - 1024; }
#pragma unroll
            for (int m = 0; m < 4; ++m) {
                bf16_t* d = dst + (size_t)(rowb + m * 16 + r) * ld + cc + quad * 4;
#pragma unroll
                for (int n = 0; n < 4; ++n) { u32x2 w; w.x = pack2(acc[m][n][0] * scl, acc[m][n][1] * scl); w.y = pack2(acc[m][n][2] * scl, acc[m][n][3] * scl); *(u32x2*)(d + n * 16) = w; }
            }
        } else if (c0 >= 1536 && c0 < 2176) {
            const bool isq = c0 < 2048; bf16_t* dst = isq ? p.Q1 : p.K1; const int ld = isq ? 512 : 128; const int cc = isq ? c0 - 1536 : c0 - 2048;
            const float* g = p.od_qk_g + ((layer >> 1) * 2 + (isq ? 0 : 1)) * 64 + quad * 4;
            const f32x4 g0 = *(const f32x4*)g, g1 = *(const f32x4*)(g + 16), g2 = *(const f32x4*)(g + 32), g3 = *(const f32x4*)(g + 48);
#pragma unroll
            for (int m = 0; m < 4; ++m) {
                const int row = rowb + m * 16 + r;
                f32x4 v0 = acc[m][0], v1 = acc[m][1], v2 = acc[m][2], v3 = acc[m][3];
                float ss = 0.f;
#pragma unroll
                for (int j = 0; j < 4; ++j) ss += v0[j] * v0[j] + v1[j] * v1[j] + v2[j] * v2[j] + v3[j] * v3[j];
                ss = xadd16(ss); ss = xadd32(ss);
                const float rs = 1.0f / sqrtf(ss * (1.f / 64.f) + EPS);
                v0 = v0 * rs * g0; v1 = v1 * rs * g1; v2 = v2 * rs * g2; v3 = v3 * rs * g3;
                if (lat) {
                    const int t = sb + m * 16 + r - CTX; const int pr = t / GRID_W, pc = t % GRID_W;
                    const f32x4 ra = *(const f32x4*)(p.ROPE + (pr * 16 + quad * 4) * 2), rb = *(const f32x4*)(p.ROPE + (pr * 16 + quad * 4) * 2 + 4);
                    const f32x4 ca = *(const f32x4*)(p.ROPE + (pc * 16 + quad * 4) * 2), cb = *(const f32x4*)(p.ROPE + (pc * 16 + quad * 4) * 2 + 4);
                    const f32x4 cr = f32x4{ra[0], ra[2], rb[0], rb[2]}, sr = f32x4{ra[1], ra[3], rb[1], rb[3]};
                    const f32x4 cq = f32x4{ca[0], ca[2], cb[0], cb[2]}, sq = f32x4{ca[1], ca[3], cb[1], cb[3]};
                    const f32x4 o0 = v0 * cr - v2 * sr, o2 = v0 * sr + v2 * cr, o1 = v1 * cq - v3 * sq, o3 = v1 * sq + v3 * cq;
                    v0 = o0; v1 = o1; v2 = o2; v3 = o3;
                }
                bf16_t* d = dst + (size_t)row * ld + cc + quad * 4;
                u32x2 w; w.x = pack2(v0[0], v0[1]); w.y = pack2(v0[2], v0[3]); *(u32x2*)d = w;
                w.x = pack2(v1[0], v1[1]); w.y = pack2(v1[2], v1[3]); *(u32x2*)(d + 16) = w;
                w.x = pack2(v2[0], v2[1]); w.y = pack2(v2[2], v2[3]); *(u32x2*)(d + 32) = w;
                w.x = pack2(v3[0], v3[1]); w.y = pack2(v3[2], v3[3]); *(u32x2*)(d + 48) = w;
            }
        }
    }
    DEV void operator()(f32x4 (&acc)[4][4], int wr, int wc, int lane) {
        const int r = lane & 15, quad = lane >> 4;
        const int c0 = col0 + wc * 64, rowb = row0 + wr * 64;
        const int b = row0 / TT; const int sb = rowb - b * TT; const bool lat = sb >= CTX;
        if (c0 < 512 || (c0 >= 1024 && c0 < 1536)) {
            bf16_t* dst; int ld, cc; float scl = 1.f;
            if (c0 < 256) { dst = p.Q2; ld = 256; cc = c0; } else if (c0 < 512) { dst = p.K2; ld = 256; cc = c0 - 256; scl = 0.125f; } else { dst = p.OG; ld = 512; cc = c0 - 1024; }
#pragma unroll
            for (int m = 0; m < 4; ++m)
#pragma unroll
                for (int j = 0; j < 4; ++j) {
                    const int row = rowb + m * 16 + quad * 4 + j; bf16_t* d = dst + (size_t)row * ld + cc + r;
                    d[0] = f2bf(acc[m][0][j] * scl); d[16] = f2bf(acc[m][1][j] * scl); d[32] = f2bf(acc[m][2][j] * scl); d[48] = f2bf(acc[m][3][j] * scl);
                }
        } else if (c0 < 1024) {
            const int cc = c0 - 512; const int h = cc >> 7, e0 = cc & 127; bf16_t* dst = p.V2T + ((size_t)(b * 4 + h) * 128) * TT;
#pragma unroll
            for (int m = 0; m < 4; ++m)
#pragma unroll
                for (int n = 0; n < 4; ++n) {
                    u32x2 o; o.x = pack2(acc[m][n][0], acc[m][n][1]); o.y = pack2(acc[m][n][2], acc[m][n][3]);
                    *(u32x2*)(dst + (size_t)(e0 + n * 16 + r) * TT + sb + m * 16 + quad * 4) = o;
                }
        } else if (c0 < 2176) {
            const bool isq = c0 < 2048; bf16_t* dst = isq ? p.Q1 : p.K1; const int ld = isq ? 512 : 128; const int cc = isq ? c0 - 1536 : c0 - 2048;
            const float* g = p.od_qk_g + ((layer >> 1) * 2 + (isq ? 0 : 1)) * 64;
            const float g0 = g[r], g1 = g[16 + r], g2 = g[32 + r], g3 = g[48 + r];
#pragma unroll
            for (int m = 0; m < 4; ++m)
#pragma unroll
                for (int j = 0; j < 4; ++j) {
                    const int row = rowb + m * 16 + quad * 4 + j;
                    float v0 = acc[m][0][j], v1 = acc[m][1][j], v2 = acc[m][2][j], v3 = acc[m][3][j];
                    float ss = v0 * v0 + v1 * v1 + v2 * v2 + v3 * v3;
                    ss = rowred_add(ss);
                    const float rs = 1.0f / sqrtf(ss * (1.f / 64.f) + EPS);
                    v0 *= rs * g0; v1 *= rs * g1; v2 *= rs * g2; v3 *= rs * g3;
                    if (lat) {
                        const int t = sb + m * 16 + quad * 4 + j - CTX; const int pr = t / GRID_W, pc = t % GRID_W;
                        const float cr = p.ROPE[(pr * 16 + r) * 2], sr = p.ROPE[(pr * 16 + r) * 2 + 1], cq = p.ROPE[(pc * 16 + r) * 2], sq = p.ROPE[(pc * 16 + r) * 2 + 1];
                        float o0 = v0 * cr - v2 * sr, o2 = v0 * sr + v2 * cr, o1 = v1 * cq - v3 * sq, o3 = v1 * sq + v3 * cq;
                        v0 = o0; v1 = o1; v2 = o2; v3 = o3;
                    }
                    bf16_t* d = dst + (size_t)row * ld + cc + r;
                    d[0] = f2bf(v0); d[16] = f2bf(v1); d[32] = f2bf(v2); d[48] = f2bf(v3);
                }
        } else {
            const int kv = (c0 - 2176) >> 6; bf16_t* dst = p.V1T + ((size_t)(b * HKV + kv) * 64) * TT;
#pragma unroll
            for (int m = 0; m < 4; ++m)
#pragma unroll
                for (int n = 0; n < 4; ++n) {
                    u32x2 o; o.x = pack2(acc[m][n][0], acc[m][n][1]); o.y = pack2(acc[m][n][2], acc[m][n][3]);
                    *(u32x2*)(dst + (size_t)(n * 16 + r) * TT + sb + m * 16 + quad * 4) = o;
                }
        }
    }
};

DEV void phaseA(const Params& p, int layer, unsigned char* smem) {
    const bool odd = layer & 1;
    const int ncol = odd ? ODD_IN / 256 : EVEN_INP / 256; const int nrow = NTOK / 128;
    const bf16_t* W = odd ? p.WinO + (size_t)(layer >> 1) * ODD_IN * D_MODEL : p.WinE + (size_t)(layer >> 1) * EVEN_INP * D_MODEL;
    const int bid = bid_(); const int tid = tid_(); const int trow = tid >> 2, lc8 = g2_lc(tid) * 8;
    if (odd) {
        for (int t = bid * 4 + (tid >> 6); t < NCHAIN * NCH; t += gridDim.x * 4) {
            const int chain = t / NCH, sp = t % NCH, lane = tid & 63; const int dir = chain & 1, h = (chain >> 1) & 3;
            const float lg = logsigf(p.od_decay[((layer >> 1) * 2 + dir) * HC + h]);
            const int sbase = chunk_of(dir, sp) * CH; const int i0 = 2 * lane, i1 = 2 * lane + 1;
            const int s0 = dir ? sbase + 127 - i0 : sbase + i0, s1 = dir ? sbase + 127 - i1 : sbase + i1;
            const float b0 = lg * (float)(i0 + 1), b1 = lg * (float)(i1 + 1), bend = lg * (float)CH;
            const size_t o = (size_t)chain * TT;
            p.BC[o + s0] = b0; p.BC[o + s1] = b1; p.AT[o + s0] = -b0; p.AT[o + s1] = -b1; p.MT[o + s0] = 0.f; p.MT[o + s1] = 0.f;
            if (lane == 0) { float* ms = p.MS + ((size_t)chain * NCH + sp) * 4; ms[0] = 0.f; ms[1] = 0.f; ms[2] = bend; ms[3] = __expf(bend); }
        }
    }
    const WorkRange wr = xcd_range(nrow * ncol, bid);
    for (int t = wr.lo; t < wr.hi; t += wr.step) {
        int rt, ct; dense_tile(t, nrow, ncol, rt, ct); const int row0 = rt * 128, col0 = ct * 256;
        const bf16_t* a0 = p.HIN + (size_t)(row0 + trow) * D_MODEL + lc8;
        const bf16_t* bb = W + (size_t)(col0 + trow) * D_MODEL + lc8;
        if (odd) {
            EpInOdd ep{p, layer, row0, col0};
            if (ct == 2 || ct == 3 || ct == 8) gemm_tile2<2, false>(smem, a0, a0 + (size_t)64 * D_MODEL, bb, D_MODEL, D_MODEL / 32, ep);
            else gemm_tile2<2, true>(smem, a0, a0 + (size_t)64 * D_MODEL, bb, D_MODEL, D_MODEL / 32, ep);
        } else {
            EpInEven ep{p, layer, row0, col0};
            if (ct == 4 || ct == 5 || ct == 10 || ct == 11) gemm_tile2<2, false>(smem, a0, a0 + (size_t)64 * D_MODEL, bb, D_MODEL, D_MODEL / 32, ep);
            else gemm_tile2<2, true>(smem, a0, a0 + (size_t)64 * D_MODEL, bb, D_MODEL, D_MODEL / 32, ep);
        }
    }
#ifdef PROBE_GEMM
    {
        Params q = p; bf16_t* scr = (bf16_t*)p.DC;
        q.Q1 = scr; q.K1 = scr; q.V1T = scr; q.PM = scr; q.V2T = scr; q.OG = scr; q.G = (float*)scr; q.Q2 = scr; q.K2 = scr;
        for (int t = wr.lo; t < wr.hi; t += wr.step) {
            int rt, ct; dense_tile(t, nrow, ncol, rt, ct); const int row0 = rt * 128, col0 = ct * 256;
            const bf16_t* a0 = p.HIN + (size_t)(row0 + trow) * D_MODEL + lc8;
            const bf16_t* bb = W + (size_t)(col0 + trow) * D_MODEL + lc8;
            const int erow0 = (PROBE_GEMM == 2) ? (row0 % TT >= CTX ? CTX : 0) : row0;
            if (odd) {
                EpInOdd ep{q, layer, erow0, col0};
                if (ct == 2 || ct == 3 || ct == 8) gemm_tile2<2, false>(smem, a0, a0 + (size_t)64 * D_MODEL, bb, D_MODEL, D_MODEL / 32, ep);
                else gemm_tile2<2, true>(smem, a0, a0 + (size_t)64 * D_MODEL, bb, D_MODEL, D_MODEL / 32, ep);
            } else {
                EpInEven ep{q, layer, erow0, col0};
                if (ct == 4 || ct == 5 || ct == 10 || ct == 11) gemm_tile2<2, false>(smem, a0, a0 + (size_t)64 * D_MODEL, bb, D_MODEL, D_MODEL / 32, ep);
                else gemm_tile2<2, true>(smem, a0, a0 + (size_t)64 * D_MODEL, bb, D_MODEL, D_MODEL / 32, ep);
            }
        }
    }
#endif
}
DEV void phase0b(const Params& p) {
    const int total = NTOK * (D_MODEL / 4);
    for (int idx = bid_() * 256 + tid_(); idx < total; idx += gridDim.x * 256) {
        const int row = idx / (D_MODEL / 4), k = (idx % (D_MODEL / 4)) * 4; const int b = row / TT, sq = row % TT; const int bb = sq < CTX ? BATCH : b;
        const float* mod = p.MOD + (size_t)bb * 6 * D_MODEL;
        const f32x4 x = bf4(*(const u32x2*)(p.X + (size_t)row * D_MODEL + k)), sh = *(const f32x4*)(mod + k), sc = *(const f32x4*)(mod + D_MODEL + k);
        u32x2 o; o.x = pack2(x.x * (1.f + sc.x) + sh.x, x.y * (1.f + sc.y) + sh.y); o.y = pack2(x.z * (1.f + sc.z) + sh.z, x.w * (1.f + sc.w) + sh.w);
        *(u32x2*)(p.HIN + (size_t)row * D_MODEL + k) = o;
    }
}

static_assert(NCH <= 64, "chunk summaries of a chain are scanned by one wave");
DEV void gate_chunk(const Params& p, int chain, int sp, int lane) {
    const int dir = chain & 1, h = (chain >> 1) & 3, b = chain >> 3;
    const int u = chunk_of(dir, sp); const int sbase = u * CH;
    const int i0 = 2 * lane, i1 = 2 * lane + 1;
    const int s0 = dir ? sbase + 127 - i0 : sbase + i0, s1 = dir ? sbase + 127 - i1 : sbase + i1;
    const float* g0 = p.G + ((size_t)b * TT + s0) * 16; const float* g1 = p.G + ((size_t)b * TT + s1) * 16;
    const float li0 = g0[(2 * dir) * 4 + h], li1 = g1[(2 * dir) * 4 + h];
    const float lf0 = logsigf(g0[(2 * dir + 1) * 4 + h]), lf1 = logsigf(g1[(2 * dir + 1) * 4 + h]);
    float ps = lf0 + lf1;
    for (int d = 1; d < 64; d <<= 1) { float o = lane_up(ps, d, lane); if (lane >= d) ps += o; }
    const float b1 = ps, b0 = ps - lf1;
    const float bend = lane_read(ps, 63, lane);
    const float a0 = li0 - b0, a1 = li1 - b1;
    float mx = fmaxf(a0, a1);
    for (int d = 1; d < 64; d <<= 1) { float o = lane_up(mx, d, lane); if (lane >= d) mx = fmaxf(mx, o); }
    float pmx_prev = lane_up(mx, 1, lane); if (lane == 0) pmx_prev = -3.0e38f;
    const float pm0 = fmaxf(pmx_prev, a0), pm1 = mx;
    const float amax = lane_read(mx, 63, lane);
    const size_t o = (size_t)chain * TT;
    p.BC[o + s0] = b0; p.BC[o + s1] = b1; p.AT[o + s0] = a0; p.AT[o + s1] = a1; p.MT[o + s0] = pm0; p.MT[o + s1] = pm1;
    if (lane == 0) { float* c2 = p.CH2 + ((size_t)chain * NCH + sp) * 2; c2[0] = bend; c2[1] = amax; }
}
DEV void phaseB(const Params& p, int layer) {
    const int tid = tid_();
    const int bid = bid_();
    for (int t = bid * 4 + (tid >> 6); t < NCHAIN * NCH; t += gridDim.x * 4) gate_chunk(p, t / NCH, t % NCH, tid & 63);
    const float* cw = p.ev_conv_w + (size_t)(layer >> 1) * 3 * 1024; const float* cb = p.ev_conv_b + (size_t)(layer >> 1) * 1024;
    const int total = NTOK * 128;
    for (int idx = bid * 256 + tid; idx < total; idx += gridDim.x * 256) {
        const int row = idx >> 7, cg8 = (idx & 127) * 8; const int b = row / TT, s = row % TT;
        const bool hasp = (s != 0) && (s != CTX), hasn = (s != CTX - 1) && (s != TT - 1);
        Frag xm, x0, xp; x0.q = *(const u32x4*)(p.PM + (size_t)row * 1024 + cg8);
        xm.q = u32x4{0u, 0u, 0u, 0u}; xp.q = u32x4{0u, 0u, 0u, 0u};
        if (hasp) xm.q = *(const u32x4*)(p.PM + (size_t)(row - 1) * 1024 + cg8);
        if (hasn) xp.q = *(const u32x4*)(p.PM + (size_t)(row + 1) * 1024 + cg8);
        float y[8];
#pragma unroll
        for (int i = 0; i < 8; ++i) {
            const int ch = cg8 + i;
            float v = cb[ch] + bf2f((bf16_t)xm.v[i]) * cw[ch] + bf2f((bf16_t)x0.v[i]) * cw[1024 + ch] + bf2f((bf16_t)xp.v[i]) * cw[2048 + ch];
            y[i] = siluf(v);
        }
        if (cg8 < 512) {
            u32x4 o; o.x = pack2(y[0], y[1]); o.y = pack2(y[2], y[3]); o.z = pack2(y[4], y[5]); o.w = pack2(y[6], y[7]);
            *(u32x4*)(p.Q2 + (size_t)row * 512 + cg8) = o;
        } else {
            const float sc = 0.08838834764831845f;
#pragma unroll
            for (int i = 0; i < 8; ++i) y[i] *= sc;
            u32x4 o; o.x = pack2(y[0], y[1]); o.y = pack2(y[2], y[3]); o.z = pack2(y[4], y[5]); o.w = pack2(y[6], y[7]);
            const int kc = cg8 - 512; *(u32x4*)(p.K2 + (size_t)row * 512 + kc) = o;
        }
    }
}

constexpr int KLD1 = 136, KLD0 = 72, VLD = 72;
template <int NC, int DV, int QT>
struct AttnState { f32x4 O[NC][DV / 16][QT]; f32x4 L[NC][QT]; float m[NC][QT]; };

DEV float max3f(float a, float b, float c) {
#ifdef CPU_EMU
    return fmaxf(fmaxf(a, b), c);
#else
    float d; asm("v_max3_f32 %0, %1, %2, %3" : "=v"(d) : "v"(a), "v"(b), "v"(c)); return d;
#endif
}
DEV float max2f(float a, float b) {
#ifdef CPU_EMU
    return fmaxf(a, b);
#else
    float d; asm("v_max_f32 %0, %1, %2" : "=v"(d) : "v"(a), "v"(b)); return d;
#endif
}
DEV bool wave_any(bool pr) {
#ifdef CPU_EMU
    int v = pr ? 1 : 0; for (int m = 1; m < 64; m <<= 1) v |= __shfl_xor(v, m); return v != 0;
#else
    return __builtin_amdgcn_ballot_w64(pr) != 0;
#endif
}

template <int NC, int DV, int QT, int KW>
DEV void attn_core(bf16_t* sm, const bf16_t* Kg, int ldk, const bf16_t* VTg, int nkeys, const Frag (&qf)[NC][2][QT], AttnState<NC, DV, QT>& st, float sc2, int koff) {
    constexpr int KLD = KW + 8;
    constexpr int NKR = KW / 32, NVR = DV / 32;
    constexpr int KBUF = 64 * KLD, VBUF = DV * VLD;
    constexpr float TH = 6.0f;
    const float isc2 = 1.0f / sc2;
    const int tid = tid_(), lane = tid & 63, r = lane & 15, quad = lane >> 4;
    u32x4 kreg[NKR], vreg[NVR];
    constexpr int VTPR = 8 / NVR;
    const bf16_t* kp = Kg + (size_t)(tid >> 2) * ldk + (tid & 3) * NKR * 8;
    const bf16_t* vp0 = VTg + (size_t)(tid / VTPR) * TT + (tid % VTPR) * NVR * 8;
    const int klo = (tid >> 2) * KLD + (tid & 3) * NKR * 8;
    const int nt = nkeys >> 6;
    Frag ones; ones.u[0] = ones.u[1] = ones.u[2] = ones.u[3] = 0x3F803F80u;
    auto loadK = [&]() {
#pragma unroll
        for (int i = 0; i < NKR; ++i) kreg[i] = *(const u32x4*)(kp + i * 8);
        kp += (size_t)64 * ldk; };
    auto loadV = [&]() {
#pragma unroll
        for (int i = 0; i < NVR; ++i) vreg[i] = *(const u32x4*)(vp0 + i * 8);
        vp0 += 64; };
    auto storeK = [&](int buf) {
#pragma unroll
        for (int i = 0; i < NKR; ++i) *(u32x4*)(sm + buf * KBUF + klo + i * 8) = kreg[i]; };
    auto storeV = [&](int buf) {
        bf16_t* vrow = sm + buf * VBUF + 2 * KBUF + (tid / VTPR) * VLD;
#pragma unroll
        for (int i = 0; i < NVR; ++i) {
            const int c = (tid % VTPR) * NVR + i;
#pragma unroll
            for (int hh = 0; hh < 2; ++hh) {
                const int g = 2 * c + hh; const int blk = g >> 3, g32 = g & 7; const int pos = blk * 32 + (2 * (g32 & 3) + (g32 >> 2)) * 4;
                u32x2 w; w.x = hh ? vreg[i].z : vreg[i].x; w.y = hh ? vreg[i].w : vreg[i].y;
                *(u32x2*)(vrow + pos) = w;
            }
        } };
    float al[QT], thr[QT], mxs[QT]; bool resc = false;
#pragma unroll
    for (int qt = 0; qt < QT; ++qt) { al[qt] = 1.f; thr[qt] = 0.f; mxs[qt] = 0.f; }
    auto sm_step = [&](int k, f32x4 (&sn)[4][QT], Frag (&pfn)[QT][2], const bool force) {
        if (k < QT) {
            const int qt = k;
            float mx = max3f(sn[0][qt][0], sn[0][qt][1], sn[0][qt][2]);
            mx = max3f(mx, sn[0][qt][3], sn[1][qt][0]); mx = max3f(mx, sn[1][qt][1], sn[1][qt][2]); mx = max3f(mx, sn[1][qt][3], sn[2][qt][0]);
            mx = max3f(mx, sn[2][qt][1], sn[2][qt][2]); mx = max3f(mx, sn[2][qt][3], sn[3][qt][0]); mx = max3f(mx, sn[3][qt][1], sn[3][qt][2]);
            mxs[qt] = max2f(mx, sn[3][qt][3]);
        } else if (k == QT) {
            bool need = false;
#pragma unroll
            for (int qt = 0; qt < QT; ++qt) need = need || (mxs[qt] > thr[qt]);
            if (force || wave_any(need)) {
#pragma unroll
                for (int qt = 0; qt < QT; ++qt) {
                    float mx = xmax16(mxs[qt]); mx = xmax32(mx);
                    const float mn = fmaxf(st.m[0][qt], mx * sc2);
                    al[qt] *= __builtin_amdgcn_exp2f(st.m[0][qt] - mn);
                    st.m[0][qt] = mn; thr[qt] = (mn + TH) * isc2;
                }
                resc = true;
            }
        } else if (k <= 5 * QT) {
            const int qt = (k - QT - 1) >> 2, kt = (k - QT - 1) & 3; const float mn = st.m[0][qt];
#pragma unroll
            for (int jj = 0; jj < 4; ++jj) sn[kt][qt][jj] = __builtin_amdgcn_exp2f(sn[kt][qt][jj] * sc2 - mn);
        } else if (k <= 7 * QT) {
            const int qt = (k - 5 * QT - 1) >> 1, kk = (k - 5 * QT - 1) & 1;
            pfn[qt][kk].u[0] = pack2(sn[2 * kk][qt][0], sn[2 * kk][qt][1]); pfn[qt][kk].u[1] = pack2(sn[2 * kk][qt][2], sn[2 * kk][qt][3]);
            pfn[qt][kk].u[2] = pack2(sn[2 * kk + 1][qt][0], sn[2 * kk + 1][qt][1]); pfn[qt][kk].u[3] = pack2(sn[2 * kk + 1][qt][2], sn[2 * kk + 1][qt][3]);
#ifndef CPU_EMU
            asm volatile("" : "+v"(pfn[qt][kk].u[0]), "+v"(pfn[qt][kk].u[1]), "+v"(pfn[qt][kk].u[2]), "+v"(pfn[qt][kk].u[3]));
#endif
        }
    };
    constexpr int NSM = 7 * QT + 1;
    auto rescale = [&]() {
        if (resc) {
#pragma unroll
            for (int qt = 0; qt < QT; ++qt) {
#pragma unroll
                for (int et = 0; et < DV / 16; ++et) { st.O[0][et][qt][0] *= al[qt]; st.O[0][et][qt][1] *= al[qt]; st.O[0][et][qt][2] *= al[qt]; st.O[0][et][qt][3] *= al[qt]; }
                st.L[0][qt][0] *= al[qt]; st.L[0][qt][1] *= al[qt]; st.L[0][qt][2] *= al[qt]; st.L[0][qt][3] *= al[qt];
                al[qt] = 1.f;
            }
            resc = false;
        }
    };
    auto pv = [&](int buf, const Frag (&pf)[QT][2]) {
        const bf16_t* Vs = sm + 2 * KBUF + buf * VBUF;
#pragma unroll
        for (int kk = 0; kk < 2; ++kk)
#pragma unroll
            for (int qt = 0; qt < QT; ++qt) st.L[0][qt] = mfma16(ones.v, pf[qt][kk].v, st.L[0][qt]);
#pragma unroll
        for (int et = 0; et < DV / 16; ++et) {
#pragma unroll
            for (int kk = 0; kk < 2; ++kk) {
                Frag vf; vf.q = *(const u32x4*)(Vs + (et * 16 + r) * VLD + kk * 32 + quad * 8);
#pragma unroll
                for (int qt = 0; qt < QT; ++qt) st.O[0][et][qt] = mfma16(vf.v, pf[qt][kk].v, st.O[0][et][qt]);
            }
        } };
    Frag pfa[QT][2], pfb[QT][2];
    loadK();
    __syncthreads();
    storeK(0);
    loadK();
    loadV();
    __syncthreads();
    {
        f32x4 s0[4][QT];
        const bf16_t* Ks = sm;
#pragma unroll
        for (int kt = 0; kt < 4; ++kt) {
            Frag ka0, ka1;
            ka0.q = *(const u32x4*)(Ks + (kt * 16 + r) * KLD + koff + quad * 8);
            ka1.q = *(const u32x4*)(Ks + (kt * 16 + r) * KLD + koff + 32 + quad * 8);
#pragma unroll
            for (int qt = 0; qt < QT; ++qt) {
                f32x4 z = f32x4{0.f, 0.f, 0.f, 0.f};
                z = mfma16(ka0.v, qf[0][0][qt].v, z); z = mfma16(ka1.v, qf[0][1][qt].v, z); s0[kt][qt] = z;
            }
        }
#pragma unroll
        for (int k = 0; k < NSM; ++k) sm_step(k, s0, pfa, true);
    }
    storeK(1);
    storeV(0);
    __syncthreads();
    auto body = [&](const int par, const Frag (&pin)[QT][2], Frag (&pout)[QT][2]) {
        f32x4 sn[4][QT];
        rescale();
        {
            const bf16_t* Ks = sm + ((par + 1) & 1) * KBUF + r * KLD + koff + quad * 8;
            Frag ka[2][2];
            ka[0][0].q = *(const u32x4*)(Ks); ka[0][1].q = *(const u32x4*)(Ks + 32);
#pragma unroll
            for (int kt = 0; kt < 4; ++kt) {
                if (kt < 3) { ka[(kt + 1) & 1][0].q = *(const u32x4*)(Ks + (kt + 1) * 16 * KLD); ka[(kt + 1) & 1][1].q = *(const u32x4*)(Ks + (kt + 1) * 16 * KLD + 32); }
#pragma unroll
                for (int qt = 0; qt < QT; ++qt) {
                    f32x4 z = f32x4{0.f, 0.f, 0.f, 0.f};
                    z = mfma16(ka[kt & 1][0].v, qf[0][0][qt].v, z);
                    z = mfma16(ka[kt & 1][1].v, qf[0][1][qt].v, z); sn[kt][qt] = z;
                }
                if (kt < 2) {
#pragma unroll
                    for (int qt = 0; qt < QT; ++qt) st.L[0][qt] = mfma16(ones.v, pin[qt][kt].v, st.L[0][qt]);
                }
                SCHED_BARRIER();
            }
        }
        {
            const bf16_t* Vs = sm + 2 * KBUF + (par & 1) * VBUF + r * VLD + quad * 8;
            constexpr int NPV = (DV / 16) * 2; constexpr int SPP = (NSM + NPV - 1) / NPV;
            Frag vf[2];
            vf[0].q = *(const u32x4*)Vs;
#pragma unroll
            for (int i = 0; i < NPV; ++i) {
                const int et = i >> 1, kk = i & 1;
                if (i + 1 < NPV) vf[(i + 1) & 1].q = *(const u32x4*)(Vs + ((i + 1) >> 1) * 16 * VLD + ((i + 1) & 1) * 32);
#pragma unroll
                for (int qt = 0; qt < QT; ++qt) st.O[0][et][qt] = mfma16(vf[i & 1].v, pin[qt][kk].v, st.O[0][et][qt]);
#pragma unroll
                for (int q = 0; q < SPP; ++q) sm_step(i * SPP + q, sn, pout, false);
                SCHED_BARRIER();
            }
        }
    };
    int j = 0;
    for (; j + 2 < nt; j += 2) {
        loadK(); loadV();
        body(0, pfa, pfb);
        storeK(0); storeV(1);
        __syncthreads();
        loadK(); loadV();
        body(1, pfb, pfa);
        storeK(1); storeV(0);
        __syncthreads();
    }
    loadV(); body(0, pfa, pfb); storeV(1); __syncthreads();
    rescale();
    pv(1, pfb);
    __syncthreads();
}

DEV void attn_diff_item(const Params& p, int layer, int item, bf16_t* sm) {
    const int nqb = TT / 64; const int qb = item % nqb, h = (item / nqb) % HA, b = item / (nqb * HA);
    const int tid = tid_(), wid = tid >> 6, lane = tid & 63, r = lane & 15, quad = lane >> 4;
    const int comp = wid & 1, rg = wid >> 1;
    const int s0 = qb * 64; const bool ctxq = s0 < CTX; const int nkeys = ctxq ? CTX : TT;
    Frag qf[1][2][2];
#pragma unroll
    for (int ks = 0; ks < 2; ++ks)
#pragma unroll
        for (int qt = 0; qt < 2; ++qt) qf[0][ks][qt].q = *(const u32x4*)(p.Q1 + ((size_t)b * TT + s0 + rg * 32 + qt * 16 + r) * 512 + h * 128 + comp * 64 + ks * 32 + quad * 8);
    AttnState<1, 128, 2> st;
#pragma unroll
    for (int qt = 0; qt < 2; ++qt) {
        st.m[0][qt] = -1.0e30f; st.L[0][qt] = f32x4{0.f, 0.f, 0.f, 0.f};
#pragma unroll
        for (int et = 0; et < 8; ++et) st.O[0][et][qt] = f32x4{0.f, 0.f, 0.f, 0.f};
    }
    attn_core<1, 128, 2, 128>(sm, p.K1 + (size_t)b * TT * 512 + h * 128, 512, p.V1T + ((size_t)(b * HA + h) * 128) * TT, nkeys, qf, st, 0.125f * 1.4426950408889634f, comp * 64);
    const float lam = p.LAM[layer >> 1]; const float lam_init = 0.8f - 0.6f * expf(-0.3f * (float)layer);
    const float* sg = p.ev_subln_g + (layer >> 1) * 128;
    f32x4* xo = (f32x4*)sm;
    __syncthreads();
    if (comp == 1) {
#pragma unroll
        for (int qt = 0; qt < 2; ++qt) {
            const float i2 = lam / st.L[0][qt][0];
#pragma unroll
            for (int et = 0; et < 8; ++et) xo[((rg * 2 + qt) * 8 + et) * 64 + lane] = f32x4{st.O[0][et][qt][0] * i2, st.O[0][et][qt][1] * i2, st.O[0][et][qt][2] * i2, st.O[0][et][qt][3] * i2};
        }
    }
    __syncthreads();
    if (comp == 0) {
#pragma unroll
        for (int qt = 0; qt < 2; ++qt) {
            const float i1 = 1.f / st.L[0][qt][0];
            float ss = 0.f; f32x4 o[8];
#pragma unroll
            for (int et = 0; et < 8; ++et) {
                const f32x4 x2 = xo[((rg * 2 + qt) * 8 + et) * 64 + lane];
#pragma unroll
                for (int j = 0; j < 4; ++j) { float v = st.O[0][et][qt][j] * i1 - x2[j]; o[et][j] = v; ss += v * v; }
            }
            ss = xadd16(ss); ss = xadd32(ss);
            const float rs = (1.f - lam_init) / sqrtf(ss * (1.f / 128.f) + EPS);
            bf16_t* dst = p.CAT + ((size_t)b * TT + s0 + rg * 32 + qt * 16 + r) * 1024 + h * 128;
#pragma unroll
            for (int et = 0; et < 8; ++et) {
                const int e = et * 16 + quad * 4;
                u32x2 w; w.x = pack2(o[et][0] * rs * sg[e], o[et][1] * rs * sg[e + 1]); w.y = pack2(o[et][2] * rs * sg[e + 2], o[et][3] * rs * sg[e + 3]);
                *(u32x2*)(dst + e) = w;
            }
        }
    }
}

DEV void attn_gqa_item(const Params& p, int item, bf16_t* sm) {
    const int nqb = TT / 32; const int qb = item % nqb, kv = (item / nqb) % HKV, b = item / (nqb * HKV);
    const int tid = tid_(), wid = tid >> 6, lane = tid & 63, r = lane & 15, quad = lane >> 4;
    const int s0 = qb * 32; const bool ctxq = s0 < CTX; const int nkeys = ctxq ? CTX : TT; const int hq = kv * 4 + wid;
    Frag qf[1][2][2];
#pragma unroll
    for (int ks = 0; ks < 2; ++ks)
#pragma unroll
        for (int qt = 0; qt < 2; ++qt) qf[0][ks][qt].q = *(const u32x4*)(p.Q1 + ((size_t)b * TT + s0 + qt * 16 + r) * 512 + hq * 64 + ks * 32 + quad * 8);
    AttnState<1, 64, 2> st;
#pragma unroll
    for (int qt = 0; qt < 2; ++qt) {
        st.m[0][qt] = -1.0e30f; st.L[0][qt] = f32x4{0.f, 0.f, 0.f, 0.f};
#pragma unroll
        for (int et = 0; et < 4; ++et) st.O[0][et][qt] = f32x4{0.f, 0.f, 0.f, 0.f};
    }
    attn_core<1, 64, 2, 64>(sm, p.K1 + (size_t)b * TT * 128 + kv * 64, 128, p.V1T + ((size_t)(b * HKV + kv) * 64) * TT, nkeys, qf, st, 0.125f * 1.4426950408889634f, 0);
#pragma unroll
    for (int qt = 0; qt < 2; ++qt) {
        const float il = 1.f / st.L[0][qt][0];
        bf16_t* dst = p.CAT + ((size_t)b * TT + s0 + qt * 16 + r) * 1024 + 512 + hq * 64;
#pragma unroll
        for (int et = 0; et < 4; ++et) {
            const int e = et * 16 + quad * 4;
            u32x2 w; w.x = pack2(st.O[0][et][qt][0] * il, st.O[0][et][qt][1] * il); w.y = pack2(st.O[0][et][qt][2] * il, st.O[0][et][qt][3] * il);
            *(u32x2*)(dst + e) = w;
        }
    }
}

template <int DK, bool NRM>
DEV void rec_dc_item(const Params& p, int item, bf16_t* sm) {
    constexpr int ET = NRM ? 9 : 8; constexpr int ER = NRM ? EVR : 128; constexpr int SLD = 136;
    const int chain = item / NCH, sp = item % NCH; const int dir = chain & 1, h = (chain >> 1) & 3, b = chain >> 3;
    const int u = chunk_of(dir, sp), sbase = u * CH;
    const int tid = tid_(), wid = tid >> 6, lane = tid & 63, r = lane & 15, quad = lane >> 4;
    bf16_t* Vs = sm; bf16_t* Ks = sm + 128 * SLD; float* wk = (float*)(sm + 128 * SLD + DK * SLD);
    __syncthreads();
    float ms1, ms2;
    if (NRM) {
        const float* c2 = p.CH2 + (size_t)chain * NCH * 2;
        const float be = lane < NCH ? c2[lane * 2] : 0.f, am = lane < NCH ? c2[lane * 2 + 1] : 0.f;
        float m = 0.f, mp = 0.f, bq = 0.f;
        for (int q = 0; q <= sp; ++q) { bq = lane_read(be, q, lane); const float aq = lane_read(am, q, lane); mp = m; m = fmaxf(bq + m, bq + aq); }
        ms1 = m; ms2 = bq;
        if (tid == 0) { float* mo = p.MS + ((size_t)chain * NCH + sp) * 4; mo[0] = mp; mo[1] = m; mo[2] = bq; mo[3] = __expf(bq + mp - m); }
    } else { const float* ms = p.MS + ((size_t)chain * NCH + sp) * 4; ms1 = ms[1]; ms2 = ms[2]; }
    if (tid < 128) wk[tid] = __expf(ms2 + p.AT[(size_t)chain * TT + sbase + tid] - ms1);
    const bf16_t* vt = p.V2T + ((size_t)(b * 4 + h) * 128) * TT + sbase;
    for (int c = tid; c < 128 * 16; c += 256) { int row = c >> 4, kc = c & 15; *(u32x4*)(Vs + row * SLD + kc * 8) = *(const u32x4*)(vt + (size_t)row * TT + kc * 8); }
    __syncthreads();
    const bf16_t* kg = p.K2 + ((size_t)b * TT + sbase) * (4 * DK) + h * DK;
    for (int c = tid; c < 128 * (DK / 8); c += 256) {
        const int sl = c & 127, dc8 = (c >> 7) * 8; Frag f; f.q = *(const u32x4*)(kg + (size_t)sl * (4 * DK) + dc8);
        const float w = wk[sl];
#pragma unroll
        for (int i = 0; i < 8; ++i) Ks[(dc8 + i) * SLD + sl] = f2bf(bf2f((bf16_t)f.v[i]) * w);
    }
    __syncthreads();
    constexpr int NTW = DK / 64;
    f32x4 acc[ET][NTW];
#pragma unroll
    for (int et = 0; et < ET; ++et)
#pragma unroll
        for (int n = 0; n < NTW; ++n) acc[et][n] = f32x4{0.f, 0.f, 0.f, 0.f};
#pragma unroll
    for (int ks = 0; ks < 4; ++ks) {
        Frag bf[NTW];
#pragma unroll
        for (int n = 0; n < NTW; ++n) bf[n].q = *(const u32x4*)(Ks + ((wid + 4 * n) * 16 + r) * SLD + ks * 32 + quad * 8);
#pragma unroll
        for (int et = 0; et < ET; ++et) {
            Frag af;
            if (et < 8) af.q = *(const u32x4*)(Vs + (et * 16 + r) * SLD + ks * 32 + quad * 8);
            else { const unsigned one = (r == 0) ? 0x3F803F80u : 0u; af.q = u32x4{one, one, one, one}; }
#pragma unroll
            for (int n = 0; n < NTW; ++n) acc[et][n] = mfma16(af.v, bf[n].v, acc[et][n]);
        }
    }
    bf16_t* dc = p.DC + ((size_t)chain * NCH + sp) * ER * DK;
#pragma unroll
    for (int et = 0; et < ET; ++et)
#pragma unroll
        for (int n = 0; n < NTW; ++n)
#pragma unroll
            for (int j = 0; j < 4; ++j) dc[(size_t)(et * 16 + quad * 4 + j) * DK + (wid + 4 * n) * 16 + r] = f2bf(acc[et][n][j]);
}

template <int DK, bool NRM>
DEV void rec_scan(const Params& p) {
    constexpr int ER = NRM ? EVR : 128; constexpr int EPC = ER * DK; constexpr int PD = 4;
    const int total = NCHAIN * (EPC / 8);
    for (int idx = bid_() * 256 + tid_(); idx < total; idx += gridDim.x * 256) {
        const int chain = idx / (EPC / 8), el = (idx % (EPC / 8)) * 8;
        const bf16_t* dc = p.DC + (size_t)chain * NCH * EPC + el; bf16_t* cp = p.CP + (size_t)chain * NCH * EPC + el;
        const float* ms = p.MS + (size_t)chain * NCH * 4 + 3;
        float c[8];
#pragma unroll
        for (int i = 0; i < 8; ++i) c[i] = 0.f;
        u32x4 q[PD]; float cr[PD];
#pragma unroll
        for (int i = 0; i < PD; ++i) if (i < NCH) { q[i] = *(const u32x4*)(dc + (size_t)i * EPC); cr[i] = ms[i * 4]; }
#pragma unroll 1
        for (int g = 0; g < NCH; g += PD)
#pragma unroll
        for (int i = 0; i < PD; ++i) {
            const int sp = g + i; if (sp >= NCH) break;
            const u32x4 d = q[i]; const float car = cr[i];
            if (sp + PD < NCH) { q[i] = *(const u32x4*)(dc + (size_t)(sp + PD) * EPC); cr[i] = ms[(sp + PD) * 4]; }
            u32x4 o; o.x = pack2(c[0], c[1]); o.y = pack2(c[2], c[3]); o.z = pack2(c[4], c[5]); o.w = pack2(c[6], c[7]);
            *(u32x4*)(cp + (size_t)sp * EPC) = o;
            c[0] = car * c[0] + __uint_as_float(d.x << 16); c[1] = car * c[1] + __uint_as_float(d.x & 0xFFFF0000u);
            c[2] = car * c[2] + __uint_as_float(d.y << 16); c[3] = car * c[3] + __uint_as_float(d.y & 0xFFFF0000u);
            c[4] = car * c[4] + __uint_as_float(d.z << 16); c[5] = car * c[5] + __uint_as_float(d.z & 0xFFFF0000u);
            c[6] = car * c[6] + __uint_as_float(d.w << 16); c[7] = car * c[7] + __uint_as_float(d.w & 0xFFFF0000u);
        }
    }
}

template <int DK, bool NRM>
DEV void rec_out_item(const Params& p, int layer, int item, bf16_t* sm) {
    constexpr int ET = NRM ? 9 : 8; constexpr int ER = NRM ? EVR : 128; constexpr int KLD = DK + 8; constexpr int SLD = 136; constexpr int NKS = DK / 32;
    const int half = item & 1, u = (item >> 1) % NCH, h = ((item >> 1) / NCH) & 3, b = (item >> 1) / (NCH * 4);
    const int tid = tid_(), wid = tid >> 6, lane = tid & 63, r = lane & 15, quad = lane >> 4;
    const int sbase = u * CH; const int tl = half * 64 + wid * 16 + r;
    const size_t rowt = (size_t)b * TT + sbase + tl; const int tq = tl - quad * 4;
    bf16_t* RA = sm; bf16_t* Vs = sm + ER * KLD; float* as_ = (float*)(Vs + 128 * SLD);
    __syncthreads();
    const bf16_t* kg = p.K2 + ((size_t)b * TT + sbase) * (4 * DK) + h * DK;
    for (int c = tid; c < 128 * (DK / 8); c += 256) { int row = c / (DK / 8), kc = c % (DK / 8); *(u32x4*)(RA + row * KLD + kc * 8) = *(const u32x4*)(kg + (size_t)row * (4 * DK) + kc * 8); }
    const int chain0 = (b * 4 + h) * 2;
    as_[tid] = p.AT[(size_t)(chain0 + (tid >> 7)) * TT + sbase + (tid & 127)];
    Frag qf[NKS];
#pragma unroll
    for (int ks = 0; ks < NKS; ++ks) qf[ks].q = *(const u32x4*)(p.Q2 + rowt * (4 * DK) + h * DK + ks * 32 + quad * 8);
    __syncthreads();
    f32x4 sT[8];
#pragma unroll
    for (int st = 0; st < 8; ++st) {
        if ((st & 1) == 0) SCHED_BARRIER();
        f32x4 z = f32x4{0.f, 0.f, 0.f, 0.f};
#pragma unroll
        for (int ks = 0; ks < NKS; ++ks) { Frag ka; ka.q = *(const u32x4*)(RA + (st * 16 + r) * KLD + ks * 32 + quad * 8); z = mfma16(ka.v, qf[ks].v, z); }
        sT[st] = z;
    }
    __syncthreads();
    const bf16_t* vt = p.V2T + ((size_t)(b * 4 + h) * 128) * TT + sbase;
    for (int c = tid; c < 128 * 16; c += 256) { int row = c >> 4, kc = c & 15; *(u32x4*)(Vs + row * SLD + kc * 8) = *(const u32x4*)(vt + (size_t)row * TT + kc * 8); }
    f32x4 hs[8];
#pragma unroll
    for (int et = 0; et < 8; ++et) hs[et] = f32x4{0.f, 0.f, 0.f, 0.f};
#pragma unroll 1
    for (int dir = 0; dir < 2; ++dir) {
        const int chain = chain0 + dir; const int sp = sp_of(dir, u);
        if (dir) __syncthreads();
        const bf16_t* cp = p.CP + ((size_t)chain * NCH + sp) * ER * DK;
        for (int c = tid; c < ER * (DK / 8); c += 256) { int row = c / (DK / 8), kc = c % (DK / 8); *(u32x4*)(RA + row * KLD + kc * 8) = *(const u32x4*)(cp + (size_t)row * DK + kc * 8); }
        __syncthreads();
        const float mprev = p.MS[((size_t)chain * NCH + sp) * 4];
        const float bt = p.BC[(size_t)chain * TT + sbase + tl], mtr = p.MT[(size_t)chain * TT + sbase + tl];
        const float mt = NRM ? bt + fmaxf(mprev, mtr) : mtr;
        const float winter = __expf(bt + mprev - mt); const float ct = bt - mt;
        f32x4 acc[ET];
#pragma unroll
        for (int et = 0; et < ET; ++et) {
            if ((et & 1) == 0) SCHED_BARRIER();
            f32x4 z = f32x4{0.f, 0.f, 0.f, 0.f};
#pragma unroll
            for (int ks = 0; ks < NKS; ++ks) { Frag ca; ca.q = *(const u32x4*)(RA + (et * 16 + r) * KLD + ks * 32 + quad * 8); z = mfma16(ca.v, qf[ks].v, z); }
            acc[et] = f32x4{z[0] * winter, z[1] * winter, z[2] * winter, z[3] * winter};
        }
#pragma unroll
        for (int kk = 0; kk < 4; ++kk) {
            SCHED_BARRIER();
            Frag pf;
#pragma unroll
            for (int hf = 0; hf < 2; ++hf) {
                const int st = 2 * kk + hf; float w[4];
#pragma unroll
                for (int j = 0; j < 4; ++j) {
                    const int s = st * 16 + quad * 4 + j; const bool ok = dir ? ((st * 16 + j) >= tq) : ((st * 16 + j) <= tq);
                    w[j] = ok ? sT[st][j] * __expf(ct + as_[dir * 128 + s]) : 0.f;
                }
                pf.u[2 * hf] = pack2(w[0], w[1]); pf.u[2 * hf + 1] = pack2(w[2], w[3]);
            }
#pragma unroll
            for (int et = 0; et < ET; ++et) {
                Frag vf;
                if (et < 8) { const bf16_t* vp = Vs + (et * 16 + r) * SLD + kk * 32 + quad * 4; vf.d[0] = *(const u32x2*)vp; vf.d[1] = *(const u32x2*)(vp + 16); }
                else { const unsigned one = (r == 0) ? 0x3F803F80u : 0u; vf.q = u32x4{one, one, one, one}; }
                acc[et] = mfma16(vf.v, pf.v, acc[et]);
            }
        }
        if (NRM) {
            float den = lane_read(acc[ET - 1][0], r, lane);
            const float dn = 1.f / fmaxf(fabsf(den), __expf(-mt));
#pragma unroll
            for (int et = 0; et < 8; ++et) { hs[et][0] += acc[et][0] * dn; hs[et][1] += acc[et][1] * dn; hs[et][2] += acc[et][2] * dn; hs[et][3] += acc[et][3] * dn; }
        } else {
#pragma unroll
            for (int et = 0; et < 8; ++et) { hs[et][0] += acc[et][0]; hs[et][1] += acc[et][1]; hs[et][2] += acc[et][2]; hs[et][3] += acc[et][3]; }
        }
    }
    if (NRM) {
        const bf16_t* og = p.OG + rowt * 512 + h * 128; const float* g = p.ev_mnorm_g + (layer >> 1) * 512 + h * 128;
        float sum = 0.f;
#pragma unroll
        for (int et = 0; et < 8; ++et) {
            const u32x2 gq = *(const u32x2*)(og + et * 16 + quad * 4);
            hs[et][0] *= sigmf(bf2f((bf16_t)(gq.x & 0xFFFF))); hs[et][1] *= sigmf(bf2f((bf16_t)(gq.x >> 16)));
            hs[et][2] *= sigmf(bf2f((bf16_t)(gq.y & 0xFFFF))); hs[et][3] *= sigmf(bf2f((bf16_t)(gq.y >> 16)));
            sum += hs[et][0] + hs[et][1] + hs[et][2] + hs[et][3];
        }
        sum = xadd16(sum); sum = xadd32(sum);
        const float mu = sum * (1.f / 128.f); float var = 0.f;
#pragma unroll
        for (int et = 0; et < 8; ++et)
#pragma unroll
            for (int j = 0; j < 4; ++j) { float d = hs[et][j] - mu; var += d * d; }
        var = xadd16(var); var = xadd32(var);
        const float rs = 1.f / sqrtf(var * (1.f / 128.f) + EPS);
        bf16_t* dst = p.CAT + rowt * 1024 + 512 + h * 128;
#pragma unroll
        for (int et = 0; et < 8; ++et) {
            const int e = et * 16 + quad * 4;
            u32x2 w; w.x = pack2((hs[et][0] - mu) * rs * g[e], (hs[et][1] - mu) * rs * g[e + 1]); w.y = pack2((hs[et][2] - mu) * rs * g[e + 2], (hs[et][3] - mu) * rs * g[e + 3]);
            *(u32x2*)(dst + e) = w;
        }
    } else {
        const bf16_t* og = p.OG + rowt * 512 + h * 128;
        float ss = 0.f;
#pragma unroll
        for (int et = 0; et < 8; ++et)
#pragma unroll
            for (int j = 0; j < 4; ++j) ss += hs[et][j] * hs[et][j];
        ss = xadd16(ss); ss = xadd32(ss);
        const float rs = 1.f / sqrtf(ss * (1.f / 128.f) + EPS);
        bf16_t* dst = p.CAT + rowt * 1024 + h * 128;
#pragma unroll
        for (int et = 0; et < 8; ++et) {
            const int e = et * 16 + quad * 4; const u32x2 gq = *(const u32x2*)(og + e);
            u32x2 w; w.x = pack2(hs[et][0] * rs * siluf(bf2f((bf16_t)(gq.x & 0xFFFF))), hs[et][1] * rs * siluf(bf2f((bf16_t)(gq.x >> 16))));
            w.y = pack2(hs[et][2] * rs * siluf(bf2f((bf16_t)(gq.y & 0xFFFF))), hs[et][3] * rs * siluf(bf2f((bf16_t)(gq.y >> 16))));
            *(u32x2*)(dst + e) = w;
        }
    }
}

DEV void phaseC(const Params& p, int layer, unsigned char* smem) {
    const bool odd = layer & 1; const bool with_ctx = layer < DEPTH - 1;
    bf16_t* sm = (bf16_t*)smem;
    const int nqb_l = odd ? SEQ / 32 : SEQ / 64, nqb_c = odd ? CTX / 32 : CTX / 64; const int nh = odd ? HKV : HA;
    const int n_lat = BATCH * nh * nqb_l, n_ctx = with_ctx ? BATCH * nh * nqb_c : 0; const int n_dc = NCHAIN * NCH;
    for (int it = bid_(); it < n_lat + n_ctx + n_dc; it += gridDim.x) {
        if (it < n_lat + n_ctx) {
            int qb, bh;
            if (it < n_lat) {
                const int nbh = BATCH * nh;
                if ((nbh & 7) == 0 && (gridDim.x & 7) == 0) { const int x = it & 7, j = it >> 3; bh = (j / nqb_l) * 8 + x; qb = nqb_c + j % nqb_l; }
                else { qb = nqb_c + it % nqb_l; bh = it / nqb_l; }
            } else { int i2 = it - n_lat; qb = i2 % nqb_c; bh = i2 / nqb_c; }
            const int item = bh * (nqb_l + nqb_c) + qb;
            if (odd) attn_gqa_item(p, item, sm); else attn_diff_item(p, layer, item, sm);
        } else {
            const int item = it - n_lat - n_ctx;
            if (odd) rec_dc_item<64, false>(p, item, sm); else rec_dc_item<128, true>(p, item, sm);
        }
    }
}
DEV void phaseD(const Params& p, int layer) { if (layer & 1) rec_scan<64, false>(p); else rec_scan<128, true>(p); }
DEV void phaseE(const Params& p, int layer, unsigned char* smem) {
    const bool odd = layer & 1; const bool with_ctx = layer < DEPTH - 1;
    const int n = BATCH * 4 * NCH * 2;
    for (int it = bid_(); it < n; it += gridDim.x) {
        const int u = (it >> 1) % NCH; if (!with_ctx && u < NCC) continue;
        if (odd) rec_out_item<64, false>(p, layer, it, (bf16_t*)smem); else rec_out_item<128, true>(p, layer, it, (bf16_t*)smem);
    }
}

#ifdef CPU_EMU_SMALL
constexpr int FM_T = 16;
#else
constexpr int FM_T = 17;
#endif
constexpr int F_ROWS = 16 * FM_T, F_NA = 4 * F_ROWS, F_NCH = F_NA + 512, F_STAGE = F_NCH * 16, F_NJ = (F_NCH + 255) / 256;
static_assert(NTOK % F_ROWS == 0 && TT % F_ROWS == 0, "tall output-projection tiles must not straddle sequences");
static_assert(3 * F_STAGE <= LDS_BYTES - 16, "LDS ring of the tall tile");
DEV void phaseF(const Params& p, int layer, unsigned char* smem) {
    const bool with_ctx = layer < DEPTH - 1; const int ncol = D_MODEL / 128, nrow = NTOK / F_ROWS;
    const int tid = tid_(), wid = tid >> 6, lane = tid & 63, r = lane & 15, quad = lane >> 4;
    const int lc8 = g2_lc(tid) * 8;
    const WorkRange wr = xcd_range(nrow * ncol, bid_());
    for (int t = wr.lo; t < wr.hi; t += wr.step) {
        int rt, ct;
        if ((nrow & 7) == 0) { const int rpg = nrow >> 3; const int rg = t / (ncol * rpg), q = t % (ncol * rpg); ct = q / rpg; rt = rg * rpg + q % rpg; } else { rt = t / ncol; ct = t % ncol; }
        const int row0 = rt * F_ROWS, col0 = ct * 128; const int b = row0 / TT, s0 = row0 % TT;
        if (!with_ctx && s0 + F_ROWS <= CTX) continue;
        const bf16_t* abase = p.CAT + (size_t)(row0 + (tid >> 2)) * MIX_OUT + lc8;
        const bf16_t* bbase = p.WoutT + ((size_t)layer * D_MODEL + col0 + (tid >> 2)) * MIX_OUT + lc8;
        constexpr int JMIX = F_NA / 256;
        const bf16_t* mbase = (F_NA % 256 != 0 && tid < F_NA - 256 * JMIX) ? abase + (size_t)JMIX * 64 * MIX_OUT : bbase + (256 * JMIX - F_NA) / 4 * MIX_OUT;
        f32x4 acc[FM_T][2];
#pragma unroll
        for (int m = 0; m < FM_T; ++m) { acc[m][0] = f32x4{0.f, 0.f, 0.f, 0.f}; acc[m][1] = f32x4{0.f, 0.f, 0.f, 0.f}; }
        unsigned char* dst0 = smem + tid * 16;
        auto issue = [&](int kt, int slot) {
            unsigned char* d = dst0 + slot * F_STAGE;
#pragma unroll
            for (int j = 0; j < F_NJ; ++j) {
                if (256 * j + 255 < F_NA) glds16(abase + (size_t)j * 64 * MIX_OUT + kt * 32, d + j * 4096);
                else if (j == JMIX && F_NA % 256 != 0) glds16(mbase + kt * 32, d + j * 4096);
                else if (256 * j + 255 < F_NCH) glds16(bbase + (256 * j - F_NA) / 4 * MIX_OUT + kt * 32, d + j * 4096);
                else if (tid + 256 * j < F_NCH) glds16(bbase + (256 * j - F_NA) / 4 * MIX_OUT + kt * 32, d + j * 4096);
            }
        };
        constexpr int nkt = MIX_OUT / 32;
        RAW_BARRIER();
        issue(0, 0); issue(1, 1);
        const int pco = (quad ^ g2_h((r >> 2) & 3)) * 16;
        const unsigned char* afr = smem + r * 64 + pco;
        const unsigned char* bfr = smem + F_NA * 16 + (wid * 32 + r) * 64 + pco;
        int slot = 0;
        for (int kt = 0; kt < nkt; ++kt) {
            if (kt + 1 < nkt) wait_vm<6>(); else wait_vm<0>();
            RAW_BARRIER();
            if (kt + 2 < nkt) { int ns = slot + 2; if (ns >= 3) ns -= 3; issue(kt + 2, ns); }
            const unsigned char* as = afr + slot * F_STAGE; const unsigned char* bs = bfr + slot * F_STAGE;
            Frag b0, b1; b0.q = *(const u32x4*)bs; b1.q = *(const u32x4*)(bs + 16 * 64);
#ifndef CPU_EMU
            __builtin_amdgcn_s_setprio(1);
#endif
#pragma unroll
            for (int m = 0; m < FM_T; ++m) {
                Frag af; af.q = *(const u32x4*)(as + m * 16 * 64);
                acc[m][0] = mfma16(b0.v, af.v, acc[m][0]); acc[m][1] = mfma16(b1.v, af.v, acc[m][1]);
            }
#ifndef CPU_EMU
            __builtin_amdgcn_s_setprio(0);
#endif
            if (++slot == 3) slot = 0;
        }
        const float* gl = p.MOD + ((size_t)layer * (BATCH + 1) + b) * 6 * D_MODEL + 2 * D_MODEL; const float* gc = p.MOD + ((size_t)layer * (BATCH + 1) + BATCH) * 6 * D_MODEL + 2 * D_MODEL;
#pragma unroll
        for (int n = 0; n < 2; ++n) {
            const int col = col0 + wid * 32 + n * 16 + quad * 4; const f32x4 g_l = *(const f32x4*)(gl + col), g_c = *(const f32x4*)(gc + col);
#pragma unroll
            for (int m = 0; m < FM_T; ++m) {
                const int s = s0 + m * 16 + r; const bool isc = s < CTX;
                if (with_ctx || !isc) { u32x2* x = (u32x2*)(p.X + (size_t)(row0 + m * 16 + r) * D_MODEL + col); *x = pk4(ALPHA * bf4(*x) + (isc ? g_c : g_l) * acc[m][n]); }
                if ((m & 3) == 3) SCHED_BARRIER();
            }
        }
    }
}

constexpr int NV4 = D_MODEL / 256;
DEV void phaseG(const Params& p, int layer, unsigned char* smem) {
    const bool with_ctx = layer < DEPTH - 1;
    const int tid = tid_(); const int wid = tid >> 6, lane = tid & 63; const int bid = bid_();
    const float* lg = p.ln_g + (size_t)(layer * 2) * D_MODEL; const float* lb = p.ln_b + (size_t)(layer * 2) * D_MODEL;
    const float* wr = p.WrT + (size_t)layer * NR * D_MODEL;
    int* lcnt = (int*)smem; int* lbase = lcnt + 32; int* rec = lbase + 32;
    const int half = gridDim.x * 4, stride = half * 2;
    const int nit = (NTOK - bid * 4 + stride - 1) / stride;
    __syncthreads();
    if (tid < 32) lcnt[tid] = 0;
    for (int i = tid; i < nit * 8; i += 256) rec[i * 8] = -1;
    __syncthreads();
    int tok0 = bid * 4 + wid;
    u32x2 xq[2][NV4];
    auto ldx = [&](int t0) {
#pragma unroll
        for (int u = 0; u < 2; ++u) {
            const int tl = imin(t0 + u * half, NTOK - 1);
#pragma unroll
            for (int i = 0; i < NV4; ++i) xq[u][i] = *(const u32x2*)(p.X + (size_t)tl * D_MODEL + (i * 64 + lane) * 4);
        } };
    if (tok0 < NTOK) ldx(tok0);
    for (int it = 0; tok0 < NTOK; tok0 += stride, ++it) {
        f32x4 v[2][NV4]; int tk[2]; bool ok[2]; const float* mod[2];
#pragma unroll
        for (int u = 0; u < 2; ++u)
#pragma unroll
            for (int i = 0; i < NV4; ++i) v[u][i] = bf4(xq[u][i]);
        if (tok0 + stride < NTOK) ldx(tok0 + stride);
#pragma unroll
        for (int u = 0; u < 2; ++u) {
            const int t = tok0 + u * half; const int tc = imin(t, NTOK - 1); const int b = tc / TT, sq = tc % TT;
            tk[u] = tc; ok[u] = (t < NTOK) && (with_ctx || sq >= CTX);
            mod[u] = p.MOD + ((size_t)layer * (BATCH + 1) + (sq < CTX ? BATCH : b)) * 6 * D_MODEL;
        }
        float mu[2], rs[2];
#pragma unroll
        for (int u = 0; u < 2; ++u) { float sum = 0.f;
#pragma unroll
            for (int i = 0; i < NV4; ++i) sum += v[u][i].x + v[u][i].y + v[u][i].z + v[u][i].w;
            mu[u] = sum; }
        { mu[0] = wsum(mu[0]); mu[1] = wsum(mu[1]); }
#pragma unroll
        for (int u = 0; u < 2; ++u) { mu[u] *= (1.f / D_MODEL); float var = 0.f;
#pragma unroll
            for (int i = 0; i < NV4; ++i) { float a = v[u][i].x - mu[u], bq = v[u][i].y - mu[u], c = v[u][i].z - mu[u], d = v[u][i].w - mu[u]; var += a * a + bq * bq + c * c + d * d; }
            rs[u] = var; }
        { rs[0] = wsum(rs[0]); rs[1] = wsum(rs[1]); }
        f32x4 hv[2][NV4];
#pragma unroll
        for (int u = 0; u < 2; ++u) {
            rs[u] = 1.f / sqrtf(rs[u] * (1.f / D_MODEL) + EPS);
            if (lane == 0 && ok[u]) { p.STAT[tk[u] * 2] = mu[u]; p.STAT[tk[u] * 2 + 1] = rs[u]; }
#pragma unroll
            for (int i = 0; i < NV4; ++i) {
                const int k = (i * 64 + lane) * 4;
                const f32x4 g4 = *(const f32x4*)(lg + k), b4 = *(const f32x4*)(lb + k), sh = *(const f32x4*)(mod[u] + 3 * D_MODEL + k), sc = *(const f32x4*)(mod[u] + 4 * D_MODEL + k);
                const f32x4 x1 = (v[u][i] - mu[u]) * rs[u] * g4 + b4;
                hv[u][i] = x1 * (1.f + sc) + sh;
                if (ok[u]) { u32x2 o; o.x = pack2(hv[u][i].x, hv[u][i].y); o.y = pack2(hv[u][i].z, hv[u][i].w); *(u32x2*)(p.H + (size_t)tk[u] * D_MODEL + k) = o; }
            }
        }
        float gl[2][NG];
#pragma unroll
        for (int j = 0; j < NG; ++j) {
#pragma unroll
            for (int u = 0; u < 2; ++u) { float a = 0.f;
#pragma unroll
                for (int i = 0; i < NV4; ++i) { const f32x4 w4 = *(const f32x4*)(wr + (size_t)j * D_MODEL + (i * 64 + lane) * 4); a += hv[u][i].x * w4.x + hv[u][i].y * w4.y + hv[u][i].z * w4.z + hv[u][i].w * w4.w; }
                gl[u][j] = a; }
        }
#pragma unroll
        for (int j = 0; j < NG; ++j) { gl[0][j] = wsum(gl[0][j]); gl[1][j] = wsum(gl[1][j]); }
        int gi[2]; float gw[2]; float ev[2][EPG];
#pragma unroll
        for (int u = 0; u < 2; ++u) {
#pragma unroll
            for (int j = 0; j < NG; ++j) gl[u][j] += p.moe_b_group[layer * NG + j];
            int g = 0; float gm = gl[u][0];
#pragma unroll
            for (int j = 1; j < NG; ++j) if (gl[u][j] > gm) { gm = gl[u][j]; g = j; }
            float gs = 0.f;
#pragma unroll
            for (int j = 0; j < NG; ++j) gs += expf(gl[u][j] - gm);
            gi[u] = g; gw[u] = 1.f / gs;
            const float* wre = wr + (size_t)(NG + g * EPG) * D_MODEL;
#pragma unroll
            for (int j = 0; j < EPG; ++j) { float a = 0.f;
#pragma unroll
                for (int i = 0; i < NV4; ++i) { const f32x4 w4 = *(const f32x4*)(wre + (size_t)j * D_MODEL + (i * 64 + lane) * 4); a += hv[u][i].x * w4.x + hv[u][i].y * w4.y + hv[u][i].z * w4.z + hv[u][i].w * w4.w; }
                ev[u][j] = a; }
        }
#pragma unroll
        for (int j = 0; j < EPG; ++j) { ev[0][j] = wsum(ev[0][j]); ev[1][j] = wsum(ev[1][j]); }
#pragma unroll
        for (int u = 0; u < 2; ++u) {
#pragma unroll
            for (int j = 0; j < EPG; ++j) ev[u][j] += p.moe_b_router[layer * NE + gi[u] * EPG + j];
            int i1 = 0; float v1 = ev[u][0];
#pragma unroll
            for (int j = 1; j < EPG; ++j) if (ev[u][j] > v1) { v1 = ev[u][j]; i1 = j; }
            int i2 = -1; float v2 = -3.0e38f;
#pragma unroll
            for (int j = 0; j < EPG; ++j) if (j != i1 && ev[u][j] > v2) { v2 = ev[u][j]; i2 = j; }
            const float e2 = expf(v2 - v1); const float w1 = gw[u] / (1.f + e2), w2 = gw[u] * e2 / (1.f + e2);
            if (lane == 0 && ok[u]) {
                const int ea = gi[u] * EPG + i1, eb = gi[u] * EPG + i2;
                const int ra = atomicAdd(lcnt + ea, 1), rb = atomicAdd(lcnt + eb, 1);
                int* rc = rec + ((it * 2 + u) * 4 + wid) * 8;
                rc[0] = tk[u]; rc[1] = ea; rc[2] = eb; rc[3] = ra; rc[4] = rb; rc[5] = (int)__float_as_uint(w1); rc[6] = (int)__float_as_uint(w2);
            }
        }
    }
    __syncthreads();
    if (tid < 32) { const int c = lcnt[tid]; lbase[tid] = c ? atomicAdd(p.CNT + (layer * NE + tid) * 32, c) : 0; }
    __syncthreads();
    for (int i = tid; i < nit * 8; i += 256) {
        const int* rc = rec + i * 8; const int tk = rc[0];
        if (tk >= 0) {
            const int ea = rc[1], eb = rc[2]; const int pa = lbase[ea] + rc[3], pb = lbase[eb] + rc[4];
            p.LIST[(size_t)ea * NTOK + pa] = tk * 2; p.LISTW[(size_t)ea * NTOK + pa] = __uint_as_float((unsigned)rc[5]);
            p.LIST[(size_t)eb * NTOK + pb] = tk * 2 + 1; p.LISTW[(size_t)eb * NTOK + pb] = __uint_as_float((unsigned)rc[6]);
        }
    }
}

struct EpGU {
    const Params& p; int slot0, nvalid, col0;
    DEV void nat(f32x4 (&acc)[4][4], int wr, int wc, int lane) {
        const int r = lane & 15, quad = lane >> 4; const int j0 = (col0 + wc * 64) >> 1;
#pragma unroll
        for (int m = 0; m < 4; ++m) {
            const int rl = wr * 64 + m * 16 + r;
            if (rl < nvalid) {
                bf16_t* d = p.ACT + (size_t)(slot0 + rl) * D_EXPERT + j0 + quad * 4;
#pragma unroll
                for (int n = 0; n < 2; ++n) {
                    u32x2 w; w.x = pack2(siluf(acc[m][n][0]) * acc[m][n + 2][0], siluf(acc[m][n][1]) * acc[m][n + 2][1]);
                    w.y = pack2(siluf(acc[m][n][2]) * acc[m][n + 2][2], siluf(acc[m][n][3]) * acc[m][n + 2][3]);
                    *(u32x2*)(d + n * 16) = w;
                }
            }
        }
    }
    DEV void operator()(f32x4 (&acc)[4][4], int wr, int wc, int lane) {
        const int r = lane & 15, quad = lane >> 4; const int j0 = (col0 + wc * 64) >> 1;
#pragma unroll
        for (int m = 0; m < 4; ++m)
#pragma unroll
            for (int j = 0; j < 4; ++j) {
                const int rl = wr * 64 + m * 16 + quad * 4 + j;
                if (rl < nvalid) {
                    bf16_t* d = p.ACT + (size_t)(slot0 + rl) * D_EXPERT + j0 + r;
                    d[0] = f2bf(siluf(acc[m][0][j]) * acc[m][2][j]); d[16] = f2bf(siluf(acc[m][1][j]) * acc[m][3][j]);
                }
            }
    }
};
struct EpDown {
    const Params& p; const float* lw; const int* lp; int nvalid, col0;
    DEV void nat(f32x4 (&acc)[4][4], int wr, int wc, int lane) {
        const int r = lane & 15, quad = lane >> 4;
#pragma unroll
        for (int m = 0; m < 4; ++m) {
            const int rl = wr * 64 + m * 16 + r;
            if (rl < nvalid) {
                const float w = lw[rl]; bf16_t* d = p.YS + (size_t)lp[rl] * D_MODEL + col0 + wc * 64 + quad * 4;
#pragma unroll
                for (int n = 0; n < 4; ++n) { u32x2 o; o.x = pack2(w * acc[m][n][0], w * acc[m][n][1]); o.y = pack2(w * acc[m][n][2], w * acc[m][n][3]); *(u32x2*)(d + n * 16) = o; }
            }
        }
    }
    DEV void operator()(f32x4 (&acc)[4][4], int wr, int wc, int lane) {}
};
template <bool DOWN>
DEV void phaseHI(const Params& p, int layer, unsigned char* smem) {
    int* tpre = (int*)(smem + 74 * 1024); int* sbase = tpre + 40;
    const int tid = tid_(); const int bid = bid_();
    __syncthreads();
    if (tid == 0) {
        int ta = 0, sa = 0;
        for (int e = 0; e < NE; ++e) { const int c = p.CNT[(layer * NE + e) * 32]; tpre[e] = ta; sbase[e] = sa; ta += (c + 127) >> 7; sa += c; }
        tpre[NE] = ta;
        if (bid == 0 && !DOWN) for (int e = 0; e < NE; ++e) p.BASE[e] = sbase[e];
    }
    __syncthreads();
    const int ncol = DOWN ? D_MODEL / 256 : 2 * D_EXPERT / 256; const int ntile = tpre[NE] * ncol;
    const int trow = tid >> 2, lc8 = g2_lc(tid) * 8;
    const WorkRange wr = xcd_range(ntile, bid);
    for (int t = wr.lo; t < wr.hi; t += wr.step) {
        int e = 0;
        for (int q = 1; q < NE; ++q) if (tpre[q] * ncol <= t) e = q;
        const int nrt = tpre[e + 1] - tpre[e]; const int q2 = t - tpre[e] * ncol; const int ct = q2 / nrt, rt = q2 % nrt;
        const int cnt = p.CNT[(layer * NE + e) * 32]; const int nvalid = imin(128, cnt - rt * 128); const int slot0 = sbase[e] + rt * 128;
        if (!DOWN) {
            const int* list = p.LIST + (size_t)e * NTOK + rt * 128;
            const int r0 = imin(trow, nvalid - 1), r1 = imin(64 + trow, nvalid - 1);
            const bf16_t* a0 = p.H + (size_t)(list[r0] >> 1) * D_MODEL + lc8; const bf16_t* a1 = p.H + (size_t)(list[r1] >> 1) * D_MODEL + lc8;
            const bf16_t* bw = p.Wgu + ((size_t)(layer * NE + e) * 2 * D_EXPERT + ct * 256 + trow) * D_MODEL + lc8;
            EpGU ep{p, slot0, nvalid, ct * 256};
            gemm_tile2<2, true>(smem, a0, a1, bw, D_MODEL, D_MODEL / 32, ep);
        } else {
            const bf16_t* a0 = p.ACT + (size_t)(slot0 + trow) * D_EXPERT + lc8;
            const bf16_t* bw = p.WdT + ((size_t)(layer * NE + e) * D_MODEL + ct * 256 + trow) * D_EXPERT + lc8;
            EpDown ep{p, p.LISTW + (size_t)e * NTOK + rt * 128, p.LIST + (size_t)e * NTOK + rt * 128, nvalid, ct * 256};
            gemm_tile2<2, true>(smem, a0, a0 + (size_t)64 * D_EXPERT, bw, D_EXPERT, D_EXPERT / 32, ep);
        }
    }
}

DEV void phaseJ(const Params& p, int layer) {
    const bool with_ctx = layer < DEPTH - 1; const bool last = layer == DEPTH - 1;
    const int wid = tid_() >> 6, lane = tid_() & 63;
    const float* lg1 = p.ln_g + (size_t)(layer * 2) * D_MODEL; const float* lb1 = p.ln_b + (size_t)(layer * 2) * D_MODEL;
    const float* lg = p.ln_g + (size_t)(layer * 2 + 1) * D_MODEL; const float* lb = p.ln_b + (size_t)(layer * 2 + 1) * D_MODEL;
    const int stride = gridDim.x * 4;
    int tok = bid_() * 4 + wid;
    u32x2 xn[NV4], an[NV4], cn[NV4]; float mun = 0.f, rsn = 0.f;
    if (tok < NTOK) {
#pragma unroll
        for (int i = 0; i < NV4; ++i) {
            const int k = (i * 64 + lane) * 4;
            xn[i] = *(const u32x2*)(p.X + (size_t)tok * D_MODEL + k); an[i] = *(const u32x2*)(p.YS + (size_t)(tok * 2) * D_MODEL + k); cn[i] = *(const u32x2*)(p.YS + (size_t)(tok * 2 + 1) * D_MODEL + k);
        }
        mun = p.STAT[tok * 2]; rsn = p.STAT[tok * 2 + 1];
    }
    for (; tok < NTOK; tok += stride) {
        u32x2 x[NV4], a[NV4], c[NV4]; const float mu1 = mun, rs1 = rsn;
#pragma unroll
        for (int i = 0; i < NV4; ++i) { x[i] = xn[i]; a[i] = an[i]; c[i] = cn[i]; }
        const int tn = tok + stride;
        if (tn < NTOK) {
#pragma unroll
            for (int i = 0; i < NV4; ++i) {
                const int k = (i * 64 + lane) * 4;
                xn[i] = *(const u32x2*)(p.X + (size_t)tn * D_MODEL + k); an[i] = *(const u32x2*)(p.YS + (size_t)(tn * 2) * D_MODEL + k); cn[i] = *(const u32x2*)(p.YS + (size_t)(tn * 2 + 1) * D_MODEL + k);
            }
            mun = p.STAT[tn * 2]; rsn = p.STAT[tn * 2 + 1];
        }
        const int b = tok / TT, s = tok % TT; if (!with_ctx && s < CTX) continue;
        const int bb = s < CTX ? BATCH : b; const float* gate = p.MOD + ((size_t)layer * (BATCH + 1) + bb) * 6 * D_MODEL + 5 * D_MODEL;
        f32x4 v[NV4]; float sum = 0.f;
#pragma unroll
        for (int i = 0; i < NV4; ++i) {
            const int k = (i * 64 + lane) * 4; const f32x4 g = *(const f32x4*)(gate + k), g1 = *(const f32x4*)(lg1 + k), b1 = *(const f32x4*)(lb1 + k);
            const f32x4 x1 = (bf4(x[i]) - mu1) * rs1 * g1 + b1;
            v[i] = ALPHA * x1 + g * (bf4(a[i]) + bf4(c[i]));
            sum += v[i].x + v[i].y + v[i].z + v[i].w;
        }
        const float mu = wsum(sum) * (1.f / D_MODEL); float var = 0.f;
#pragma unroll
        for (int i = 0; i < NV4; ++i) { float a0 = v[i].x - mu, bq = v[i].y - mu, c0 = v[i].z - mu, d = v[i].w - mu; var += a0 * a0 + bq * bq + c0 * c0 + d * d; }
        const float rs = 1.f / sqrtf(wsum(var) * (1.f / D_MODEL) + EPS);
        float* dst = p.out + ((size_t)b * SEQ + (s - CTX)) * D_MODEL; bf16_t* dx = p.X + (size_t)tok * D_MODEL;
#pragma unroll
        for (int i = 0; i < NV4; ++i) {
            const int k = (i * 64 + lane) * 4; const f32x4 g4 = *(const f32x4*)(lg + k), b4 = *(const f32x4*)(lb + k);
            f32x4 o; o.x = (v[i].x - mu) * rs * g4.x + b4.x; o.y = (v[i].y - mu) * rs * g4.y + b4.y; o.z = (v[i].z - mu) * rs * g4.z + b4.z; o.w = (v[i].w - mu) * rs * g4.w + b4.w;
            if (last) *(f32x4*)(dst + k) = o; else *(u32x2*)(dx + k) = pk4(o);
            if (!last) {
                const float* mn = p.MOD + ((size_t)(layer + 1) * (BATCH + 1) + bb) * 6 * D_MODEL;
                const f32x4 sh = *(const f32x4*)(mn + k), sc = *(const f32x4*)(mn + D_MODEL + k);
                u32x2 hq; hq.x = pack2(o.x * (1.f + sc.x) + sh.x, o.y * (1.f + sc.y) + sh.y); hq.y = pack2(o.z * (1.f + sc.z) + sh.z, o.w * (1.f + sc.w) + sh.w);
                *(u32x2*)(p.HIN + (size_t)tok * D_MODEL + k) = hq;
            }
        }
    }
}

constexpr int PH_PER_LAYER = 10;
constexpr int NPHASE = 2 + DEPTH * PH_PER_LAYER;
DEV void run_phase(const Params& p, int ph, unsigned char* smem) {
    if (ph == 0) { phase0(p, smem); return; }
    if (ph == 1) { phase0b(p); return; }
    const int layer = (ph - 2) / PH_PER_LAYER, sub = (ph - 2) % PH_PER_LAYER;
    switch (sub) {
        case 0: phaseA(p, layer, smem); break;
        case 1: if (!(layer & 1)) phaseB(p, layer); break;
        case 2: phaseC(p, layer, smem); break;
        case 3: phaseD(p, layer); break;
        case 4: phaseE(p, layer, smem); break;
        case 5: phaseF(p, layer, smem); break;
        case 6: phaseG(p, layer, smem); break;
        case 7: phaseHI<false>(p, layer, smem); break;
        case 8: phaseHI<true>(p, layer, smem); break;
        default: phaseJ(p, layer); break;
    }
}
DEV bool phase_is_empty(int ph) { if (ph < 2) return false; return ((ph - 2) % PH_PER_LAYER) == 1 && (((ph - 2) / PH_PER_LAYER) & 1); }

struct Carver { char* base; size_t off; template <class T> T* take(size_t n) { off = (off + 255) & ~(size_t)255; T* r = (T*)(base + off); off += n * sizeof(T); return r; } };
static void make_params(Params& p, void* const* d_in, void* d_out, void* d_ws) {
    const float** in = (const float**)d_in;
    p.x = in[0]; p.c = in[1]; p.ctx = in[2]; p.c_ctx = in[3]; p.w_mod = in[4]; p.b_mod = in[5]; p.ln_g = in[6]; p.ln_b = in[7];
    p.ev_w_in = in[8]; p.ev_w_out = in[9]; p.ev_lambda = in[10]; p.ev_subln_g = in[11]; p.ev_conv_w = in[12]; p.ev_conv_b = in[13];
    p.ev_gate_b = in[14]; p.ev_mnorm_g = in[15]; p.od_w_in = in[16]; p.od_w_out = in[17]; p.od_decay = in[18]; p.od_qk_g = in[19];
    p.moe_w_group = in[20]; p.moe_b_group = in[21]; p.moe_w_router = in[22]; p.moe_b_router = in[23]; p.moe_w_gate = in[24]; p.moe_w_up = in[25]; p.moe_w_down = in[26];
    p.out = (float*)d_out;
    Carver cv{(char*)d_ws, 0};
    p.X = cv.take<bf16_t>((size_t)NTOK * D_MODEL);
    p.MOD = cv.take<float>((size_t)DEPTH * (BATCH + 1) * 6 * D_MODEL);
    p.ROPE = cv.take<float>(64 * 16 * 2); p.LAM = cv.take<float>(4);
    p.WrT = cv.take<float>((size_t)DEPTH * NR * D_MODEL);
    p.CNT = cv.take<int>(DEPTH * NE * 32); p.BASE = cv.take<int>(NE); p.BAR = cv.take<unsigned>(4096);
    p.WinE = cv.take<bf16_t>((size_t)2 * EVEN_INP * D_MODEL); p.WinO = cv.take<bf16_t>((size_t)2 * ODD_IN * D_MODEL);
    p.WoutT = cv.take<bf16_t>((size_t)DEPTH * D_MODEL * MIX_OUT);
    p.Wgu = cv.take<bf16_t>((size_t)DEPTH * NE * 2 * D_EXPERT * D_MODEL); p.WdT = cv.take<bf16_t>((size_t)DEPTH * NE * D_MODEL * D_EXPERT);
    p.STAT = cv.take<float>((size_t)NTOK * 2);
    p.CAT = cv.take<bf16_t>((size_t)NTOK * 1024); p.HIN = cv.take<bf16_t>((size_t)NTOK * D_MODEL);
    p.LIST = cv.take<int>((size_t)NE * NTOK); p.LISTW = cv.take<float>((size_t)NE * NTOK); p.TOKSLOT = cv.take<int>((size_t)NTOK * 2);
    const size_t mix0 = cv.off;
    p.Q1 = cv.take<bf16_t>((size_t)NTOK * 512); p.K1 = cv.take<bf16_t>((size_t)NTOK * 512); p.V1T = cv.take<bf16_t>((size_t)NTOK * 512);
    p.PM = cv.take<bf16_t>((size_t)NTOK * 1024); p.V2T = cv.take<bf16_t>((size_t)NTOK * 512); p.OG = cv.take<bf16_t>((size_t)NTOK * 512);
    p.G = cv.take<float>((size_t)NTOK * 16);
    p.Q2 = cv.take<bf16_t>((size_t)NTOK * 512); p.K2 = cv.take<bf16_t>((size_t)NTOK * 512); p.K2T = cv.take<bf16_t>((size_t)NTOK * 512);
    p.DC = cv.take<bf16_t>((size_t)NCHAIN * NCH * EVR * 128); p.CP = cv.take<bf16_t>((size_t)NCHAIN * NCH * EVR * 128);
    p.BC = cv.take<float>((size_t)NCHAIN * TT); p.AT = cv.take<float>((size_t)NCHAIN * TT); p.MT = cv.take<float>((size_t)NCHAIN * TT); p.MS = cv.take<float>((size_t)NCHAIN * NCH * 4); p.CH2 = cv.take<float>((size_t)NCHAIN * NCH * 2);
    cv.off = mix0;
    p.H = cv.take<bf16_t>((size_t)NTOK * D_MODEL); p.ACT = cv.take<bf16_t>((size_t)(2 * NTOK + 128) * D_EXPERT); p.YS = cv.take<bf16_t>((size_t)2 * NTOK * D_MODEL);
}

#ifndef CPU_EMU
#define XB_TMO      128
#define XB_XCNT(j)  (256  + 64 * (j))
#define XB_XSUB(j)  (1280 + 64 * (j))
#define XB_XGEN(j)  (2304 + 64 * (j))
#define XB_TOP      3328
#define XB_TOPGEN   3392
#define XCD_BAR_WORDS 3456
#define XB_SPIN_CAP (1u << 20)
#define LAS __attribute__((address_space(3)))
__device__ __forceinline__ unsigned xb_ld(unsigned* p)              { return __hip_atomic_load(p, __ATOMIC_RELAXED, __HIP_MEMORY_SCOPE_AGENT); }
__device__ __forceinline__ unsigned xb_add(unsigned* p, unsigned v) { return __hip_atomic_fetch_add(p, v, __ATOMIC_RELAXED, __HIP_MEMORY_SCOPE_AGENT); }
__device__ __forceinline__ unsigned xb_xcc_id() { return (unsigned)__builtin_amdgcn_s_getreg((3 << 11) | 20) & 0xFu; }
#define XB_SPIN(cond, bar) do { unsigned _sp = 0; while (cond) { __builtin_amdgcn_s_sleep(1); \
    if ((++_sp & 255u) == 0u) { if (xb_ld(&(bar)[XB_TMO])) break; if (_sp > XB_SPIN_CAP) { atomicAdd(&(bar)[XB_TMO], 1u); break; } } } } while (0)
struct XcdBarrier { unsigned* bar; unsigned x; volatile LAS unsigned* st; };
__device__ __forceinline__ XcdBarrier xcd_barrier_post(unsigned* bar, volatile LAS unsigned* st) {
    XcdBarrier b; b.bar = bar; b.x = xb_xcc_id(); b.st = st;
    if (threadIdx.x == 0) (void)xb_add(&bar[XB_XCNT(b.x)], 1u);
    return b;
}
__device__ __forceinline__ void xcd_barrier_complete(unsigned* bar, unsigned x, unsigned& nloc, unsigned& nx) {
    const unsigned G = gridDim.x * gridDim.y * gridDim.z;
    unsigned sum, cnt, mine, sp = 0u;
    for (;;) {
        sum = 0u; cnt = 0u; mine = 0u;
#pragma unroll
        for (unsigned j = 0; j < 16; ++j) { const unsigned c = xb_ld(&bar[XB_XCNT(j)]); sum += c; cnt += (c > 0u) ? 1u : 0u; mine = (j == x) ? c : mine; }
        if (sum == G) break;
        __builtin_amdgcn_s_sleep(1);
        if ((++sp & 255u) == 0u) { if (xb_ld(&bar[XB_TMO])) break; if (sp > XB_SPIN_CAP) { atomicAdd(&bar[XB_TMO], 1u); break; } }
    }
    nloc = mine > 0u ? mine : 1u; nx = cnt > 0u ? cnt : 1u;
}
__device__ __forceinline__ void xcd_barrier(const XcdBarrier& b) {
    asm volatile("s_waitcnt vmcnt(0)" ::: "memory");
    __syncthreads();
    if (threadIdx.x == 0) {
        unsigned* bar = b.bar;
        __builtin_amdgcn_s_waitcnt(0);
        unsigned nloc = b.st[0], nx = b.st[1];
        if (nloc == 0u) { xcd_barrier_complete(bar, b.x, nloc, nx); b.st[0] = nloc; b.st[1] = nx; }
        const unsigned old = xb_add(&bar[XB_XSUB(b.x)], 1u);
        const unsigned gen = old / nloc;
        if (old + 1u == (gen + 1u) * nloc) {
            __builtin_amdgcn_fence(__ATOMIC_RELEASE, "agent");
            asm volatile("s_waitcnt vmcnt(0)" ::: "memory");
            const unsigned og = xb_add(&bar[XB_TOP], 1u);
            const unsigned tg = og / nx;
            if (og + 1u == (tg + 1u) * nx) xb_add(&bar[XB_TOPGEN], 1u);
            else XB_SPIN(xb_ld(&bar[XB_TOPGEN]) == tg, bar);
            __builtin_amdgcn_fence(__ATOMIC_ACQUIRE, "agent");
            xb_add(&bar[XB_XGEN(b.x)], 1u);
            asm volatile("s_waitcnt vmcnt(0)" ::: "memory");
        } else {
            XB_SPIN(xb_ld(&bar[XB_XGEN(b.x)]) == gen, bar);
            __builtin_amdgcn_fence(__ATOMIC_ACQUIRE, "agent");
            asm volatile("s_waitcnt vmcnt(0)" ::: "memory");
        }
    }
    __syncthreads();
}

__global__ void __launch_bounds__(NTHREADS, 2) fwd_megakernel(Params p) {
    __shared__ __attribute__((aligned(16))) unsigned char smem[LDS_BYTES];
    cg::grid_group grid = cg::this_grid();
    volatile LAS unsigned* xst = (volatile LAS unsigned*)(smem + LDS_BYTES - 16);
    if (threadIdx.x == 0) { xst[0] = 0u; xst[1] = 0u; }
    __syncthreads();
    const XcdBarrier xb = xcd_barrier_post(p.BAR, xst);
    grid.sync();
#ifdef PROBE_TS
    unsigned long long ts_acc = 0ull;
#endif
    for (int ph = 0; ph < NPHASE; ++ph) {
        if (phase_is_empty(ph)) continue;
#ifdef PROBE_TS
        const int psub_ = ph == 0 ? 10 : ph == 1 ? 11 : (ph - 2) % PH_PER_LAYER;
        const unsigned long long ts0 = __builtin_amdgcn_s_memrealtime();
#endif
#if defined(__HIP_DEVICE_COMPILE__)
        const __attribute__((address_space(4))) Params* pp = (const __attribute__((address_space(4))) Params*)__builtin_amdgcn_kernarg_segment_ptr();
        asm volatile("" : "+s"(pp));
        const Params q = *pp;
        run_phase(q, ph, smem);
#ifdef DBL_MASK
        { const int sub_ = ph == 0 ? 10 : ph == 1 ? 11 : (ph - 2) % PH_PER_LAYER; if ((DBL_MASK >> sub_) & 1) run_phase(q, ph, smem); }
#endif
#else
        run_phase(p, ph, smem);
#endif
#ifdef PROBE_TS
        const unsigned long long ts1 = __builtin_amdgcn_s_memrealtime();
        xcd_barrier(xb);
        const unsigned long long ts2 = __builtin_amdgcn_s_memrealtime();
        if (PROBE_TS == 100) ts_acc += ts2 - ts1; else if (psub_ == PROBE_TS) ts_acc += ts2 - ts0;
#else
        if (ph + 1 < NPHASE) xcd_barrier(xb);
#endif
    }
#ifdef PROBE_TS
    if (blockIdx.x == 0) { const int np = (int)(ts_acc / 100ull); for (int i = threadIdx.x; i < np; i += NTHREADS) p.out[i] += 1.0f; }
#endif
}

extern "C" void kernel_launch(void* const* d_in, const int* in_sizes, int n_in, void* d_out, int out_size, void* d_ws, size_t ws_size, hipStream_t stream) {
    static int grid_blocks = 0;
    if (!grid_blocks) {
        int dev = 0, cus = 0, per_cu = 0;
        (void)hipGetDevice(&dev); (void)hipDeviceGetAttribute(&cus, hipDeviceAttributeMultiprocessorCount, dev);
        (void)hipOccupancyMaxActiveBlocksPerMultiprocessor(&per_cu, fwd_megakernel, NTHREADS, 0);
        if (per_cu > 2) per_cu = 2;
        if (per_cu < 1) per_cu = 1;
        grid_blocks = cus * per_cu;
    }
    Params p; memset(&p, 0, sizeof(p));
    make_params(p, d_in, d_out, d_ws);
    (void)hipMemsetAsync(p.BAR, 0, 4096 * sizeof(unsigned), stream);
    void* args[] = {&p};
    hipError_t e = hipLaunchCooperativeKernel((void*)fwd_megakernel, dim3(grid_blocks), dim3(NTHREADS), args, 0, stream);
    if (e != hipSuccess) fprintf(stderr, "cooperative launch failed: %s (grid %d)\n", hipGetErrorString(e), grid_blocks);
}
#endif

#if defined(DIAG_KERNELS) && !defined(CPU_EMU)
template <int SUB, int ODD>
__global__ void __launch_bounds__(NTHREADS, 2) k_diag(Params p, int l2) {
    __shared__ __attribute__((aligned(16))) unsigned char smem[LDS_BYTES];
    const int layer = l2 * 2 + ODD;
    if (SUB == 100) { phase0(p, smem); return; }
    if (SUB == 0) phaseA(p, layer, smem);
    if (SUB == 1) phaseB(p, layer);
    if (SUB == 20) { for (int it = bid_(); it < 100; it += gridDim.x) { if (ODD) attn_gqa_item(p, it, (bf16_t*)smem); else attn_diff_item(p, layer, it, (bf16_t*)smem); } }
    if (SUB == 21) { for (int it = bid_(); it < 100; it += gridDim.x) { if (ODD) rec_dc_item<64, false>(p, it, (bf16_t*)smem); else rec_dc_item<128, true>(p, it, (bf16_t*)smem); } }
    if (SUB == 3) phaseD(p, layer);
    if (SUB == 4) phaseE(p, layer, smem);
    if (SUB == 5) phaseF(p, layer, smem);
    if (SUB == 6) phaseG(p, layer, smem);
    if (SUB == 7) phaseHI<false>(p, layer, smem);
    if (SUB == 8) phaseHI<true>(p, layer, smem);
    if (SUB == 9) phaseJ(p, layer);
}
template __global__ void k_diag<100, 0>(Params, int);
template __global__ void k_diag<0, 0>(Params, int);
template __global__ void k_diag<0, 1>(Params, int);
template __global__ void k_diag<1, 0>(Params, int);
template __global__ void k_diag<20, 0>(Params, int);
template __global__ void k_diag<20, 1>(Params, int);
template __global__ void k_diag<21, 0>(Params, int);
template __global__ void k_diag<21, 1>(Params, int);
template __global__ void k_diag<3, 0>(Params, int);
template __global__ void k_diag<4, 0>(Params, int);
template __global__ void k_diag<4, 1>(Params, int);
template __global__ void k_diag<5, 0>(Params, int);
template __global__ void k_diag<6, 0>(Params, int);
template __global__ void k_diag<7, 0>(Params, int);
template __global__ void k_diag<8, 0>(Params, int);
template __global__ void k_diag<9, 0>(Params, int);
#endif
```

```cpp
#ifdef CPU_EMU
#include "emu.h"
#else
#include <hip/hip_runtime.h>
#include <hip/hip_cooperative_groups.h>
#include <cstdio>
#include <cstdint>
#include <cstring>
namespace cg = cooperative_groups;
#endif

#define DEV __device__ __forceinline__
#ifdef CPU_EMU
#define SCHED_BARRIER() do {} while (0)
#else
#define SCHED_BARRIER() __builtin_amdgcn_sched_barrier(0)
#endif
#ifdef CPU_EMU
static inline void glds16(const void* g, void* l) { memcpy(l, g, 16); }
template <int N> static inline void wait_vm() {}
#define RAW_BARRIER() __syncthreads()
#else
__device__ __forceinline__ void glds16(const void* g, void* l) {
    __builtin_amdgcn_global_load_lds((const __attribute__((address_space(1))) unsigned*)g, (__attribute__((address_space(3))) unsigned*)l, 16, 0, 0);
}
template <int N> __device__ __forceinline__ void wait_vm() { asm volatile("s_waitcnt vmcnt(%0)" ::"n"(N) : "memory"); }
#define RAW_BARRIER() do { asm volatile("s_waitcnt lgkmcnt(0)" ::: "memory"); __builtin_amdgcn_s_barrier(); } while (0)
#endif
#ifdef CPU_EMU
static inline int tid_() { return (int)threadIdx.x; }
static inline int bid_() { return (int)blockIdx.x; }
#else
__device__ __forceinline__ int tid_() { int t = threadIdx.x; asm volatile("" : "+v"(t)); return t; }
__device__ __forceinline__ int bid_() { int b = blockIdx.x; asm volatile("" : "+s"(b)); return b; }
#endif

#ifdef CPU_EMU_SMALL
constexpr int D_MODEL = 256, BATCH = 2, SEQ = 256, CTX = 256, D_EXPERT = 128;
#else
constexpr int D_MODEL = 1024, BATCH = 4, SEQ = 4096, CTX = 256, D_EXPERT = 512;
#endif
constexpr int DEPTH = 4, GRID_W = 64, CH = 128;
constexpr int TT = CTX + SEQ, NTOK = BATCH * TT, NCH = TT / CH, NCC = CTX / CH;
constexpr float EPS = 1e-5f;
constexpr float ALPHA = 1.6817928305074290f;
constexpr int HA = 4, HB = 4, HC = 4, HD = 8, HKV = 2;
constexpr int EVEN_IN = 3600, EVEN_INP = 3840, ODD_IN = 2304, MIX_OUT = 1024;
constexpr int NG = 4, EPG = 8, NE = 32, NR = NG + NE;
constexpr int NTHREADS = 256;
constexpr int LDS_BYTES = 76 * 1024;
constexpr int NCHAIN = BATCH * 4 * 2;
constexpr int EVR = 144;

typedef unsigned short bf16_t;
typedef short bf16x8 __attribute__((ext_vector_type(8)));
typedef float f32x4 __attribute__((ext_vector_type(4)));
typedef unsigned u32x4 __attribute__((ext_vector_type(4)));
typedef unsigned u32x2 __attribute__((ext_vector_type(2)));
union Frag { bf16x8 v; u32x4 q; u32x2 d[2]; unsigned u[4]; };
DEV int imin(int a, int b) { return a < b ? a : b; }

#ifdef CPU_EMU
DEV bf16_t f2bf(float f) { unsigned u = __float_as_uint(f); u += 0x7FFFu + ((u >> 16) & 1u); return (bf16_t)(u >> 16); }
DEV unsigned pack2(float a, float b) { return (unsigned)f2bf(a) | ((unsigned)f2bf(b) << 16); }
#else
typedef __bf16 hwbf16x2 __attribute__((ext_vector_type(2)));
typedef float hwf32x2 __attribute__((ext_vector_type(2)));
DEV unsigned pack2(float a, float b) { hwf32x2 v = {a, b}; hwbf16x2 h = __builtin_convertvector(v, hwbf16x2); return __builtin_bit_cast(unsigned, h); }
DEV bf16_t f2bf(float f) { return (bf16_t)(pack2(f, 0.f) & 0xFFFFu); }
#endif
DEV float bf2f(bf16_t h) { return __uint_as_float(((unsigned)h) << 16); }
DEV f32x4 bf4(u32x2 v) { return f32x4{__uint_as_float(v.x << 16), __uint_as_float(v.x & 0xFFFF0000u), __uint_as_float(v.y << 16), __uint_as_float(v.y & 0xFFFF0000u)}; }
DEV u32x2 pk4(f32x4 v) { u32x2 o; o.x = pack2(v.x, v.y); o.y = pack2(v.z, v.w); return o; }
DEV float siluf(float x) { return x / (1.0f + __expf(-x)); }
DEV float sigmf(float x) { return 1.0f / (1.0f + __expf(-x)); }
DEV float logsigf(float x) { return (x >= 0.f) ? -log1pf(expf(-x)) : x - log1pf(expf(x)); }
#ifdef CPU_EMU
DEV float rowred_add(float v) { v += __shfl_xor(v, 1); v += __shfl_xor(v, 2); v += __shfl_xor(v, 4); v += __shfl_xor(v, 8); return v; }
DEV float rowred_max(float v) { v = fmaxf(v, __shfl_xor(v, 1)); v = fmaxf(v, __shfl_xor(v, 2)); v = fmaxf(v, __shfl_xor(v, 4)); v = fmaxf(v, __shfl_xor(v, 8)); return v; }
DEV float lane_read(float v, int src, int lane) { return __shfl(v, src); }
DEV float lane_up(float v, int d, int lane) { return __shfl_up(v, d); }
#else
template <int CTRL> DEV float dppf(float v) { return __uint_as_float((unsigned)__builtin_amdgcn_update_dpp(0, (int)__float_as_uint(v), CTRL, 0xF, 0xF, true)); }
DEV float rowred_add(float v) { v += dppf<0xB1>(v); v += dppf<0x4E>(v); v += dppf<0x141>(v); v += dppf<0x140>(v); return v; }
DEV float rowred_max(float v) { v = fmaxf(v, dppf<0xB1>(v)); v = fmaxf(v, dppf<0x4E>(v)); v = fmaxf(v, dppf<0x141>(v)); v = fmaxf(v, dppf<0x140>(v)); return v; }
DEV float lane_read(float v, int src, int lane) { return __uint_as_float((unsigned)__builtin_amdgcn_ds_bpermute((src & 63) << 2, (int)__float_as_uint(v))); }
DEV float lane_up(float v, int d, int lane) { const float o = __uint_as_float((unsigned)__builtin_amdgcn_ds_bpermute(((lane - d) & 63) << 2, (int)__float_as_uint(v))); return lane >= d ? o : v; }
#endif
#ifdef CPU_EMU
DEV float xch16(float v) { return __shfl_xor(v, 16); }
DEV float xch32(float v) { return __shfl_xor(v, 32); }
#else
typedef unsigned hwu2 __attribute__((ext_vector_type(2)));
DEV void xpair16(float v, float& a, float& b) { const unsigned u = __float_as_uint(v); hwu2 r = __builtin_amdgcn_permlane16_swap(u, u, false, false); a = __uint_as_float(r.x); b = __uint_as_float(r.y); }
DEV void xpair32(float v, float& a, float& b) { const unsigned u = __float_as_uint(v); hwu2 r = __builtin_amdgcn_permlane32_swap(u, u, false, false); a = __uint_as_float(r.x); b = __uint_as_float(r.y); }
#endif
DEV float xmax16(float v) {
#ifdef CPU_EMU
    return fmaxf(v, xch16(v));
#else
    float a, b; xpair16(v, a, b); return fmaxf(a, b);
#endif
}
DEV float xmax32(float v) {
#ifdef CPU_EMU
    return fmaxf(v, xch32(v));
#else
    float a, b; xpair32(v, a, b); return fmaxf(a, b);
#endif
}
DEV float xadd16(float v) {
#ifdef CPU_EMU
    return v + xch16(v);
#else
    float a, b; xpair16(v, a, b); return a + b;
#endif
}
DEV float xadd32(float v) {
#ifdef CPU_EMU
    return v + xch32(v);
#else
    float a, b; xpair32(v, a, b); return a + b;
#endif
}
DEV float wsum(float v) { v = rowred_add(v); v = xadd16(v); return xadd32(v); }
DEV float wmax(float v) { v = rowred_max(v); v = xmax16(v); return xmax32(v); }
DEV f32x4 mfma16(bf16x8 a, bf16x8 b, f32x4 c) { return __builtin_amdgcn_mfma_f32_16x16x32_bf16(a, b, c, 0, 0, 0); }

struct WorkRange { int lo, hi, step; };
DEV WorkRange xcd_range(int T, int bid) {
    WorkRange w; const int G = gridDim.x;
    if ((G & 7) == 0) { const int x = bid & 7, k = bid >> 3; w.lo = (int)(((long long)x * T) >> 3) + k; w.hi = (int)(((long long)(x + 1) * T) >> 3); w.step = G >> 3; }
    else { w.lo = bid; w.hi = T; w.step = G; }
    return w;
}
DEV void dense_tile(int t, int nrow, int ncol, int& rt, int& ct) {
    if ((nrow & 7) == 0) { const int rpg = nrow >> 3; const int rg = t / (ncol * rpg), q = t % (ncol * rpg); ct = q / rpg; rt = rg * rpg + q % rpg; }
    else { rt = t / ncol; ct = t % ncol; }
}

struct Params {
    const float *x, *c, *ctx, *c_ctx, *w_mod, *b_mod, *ln_g, *ln_b, *ev_w_in, *ev_w_out, *ev_lambda, *ev_subln_g, *ev_conv_w, *ev_conv_b,
        *ev_gate_b, *ev_mnorm_g, *od_w_in, *od_w_out, *od_decay, *od_qk_g, *moe_w_group, *moe_b_group, *moe_w_router, *moe_b_router,
        *moe_w_gate, *moe_w_up, *moe_w_down;
    float* out;
    bf16_t* X;
    float *MOD, *ROPE, *LAM, *WrT;
    int* CNT; unsigned* BAR;
    bf16_t *WinE, *WinO, *WoutT, *Wgu, *WdT;
    bf16_t *Q1, *K1, *V1T;
    bf16_t *PM, *V2T, *OG;
    float* G;
    bf16_t *Q2, *K2, *K2T;
    bf16_t* CAT;
    bf16_t *DC, *CP;
    float *BC, *AT, *MT, *MS, *CH2;
    bf16_t *H, *ACT, *HIN, *YS; float* STAT;
    int *LIST, *TOKSLOT, *BASE; float *LISTW;
};

constexpr int GLD = 72;
constexpr int GT = 128 * GLD;

struct BLoadW {
    const bf16_t* base; int ld; u32x4 r[4];
    DEV void fetch(int kt, int tid) {
#pragma unroll
        for (int i = 0; i < 4; ++i) { int c = tid + 256 * i, row = c >> 3, kc = c & 7; r[i] = *(const u32x4*)(base + (size_t)row * ld + kt * 64 + kc * 8); }
    }
    DEV void commit(bf16_t* S, int tid) {
#pragma unroll
        for (int i = 0; i < 4; ++i) { int c = tid + 256 * i, row = c >> 3, kc = c & 7; *(u32x4*)(S + row * GLD + kc * 8) = r[i]; }
    }
};
struct ALoadB {
    const bf16_t* base; int ld; u32x4 r[4];
    DEV void fetch(int kt, int tid) {
#pragma unroll
        for (int i = 0; i < 4; ++i) { int c = tid + 256 * i, row = c >> 3, kc = c & 7; r[i] = *(const u32x4*)(base + (size_t)row * ld + kt * 64 + kc * 8); }
    }
    DEV void commit(bf16_t* S, int tid) {
#pragma unroll
        for (int i = 0; i < 4; ++i) { int c = tid + 256 * i, row = c >> 3, kc = c & 7; *(u32x4*)(S + row * GLD + kc * 8) = r[i]; }
    }
};
struct ALoadG {
    const bf16_t* H; const int* list; int nvalid; u32x4 r[4];
    DEV void fetch(int kt, int tid) {
#pragma unroll
        for (int i = 0; i < 4; ++i) {
            int c = tid + 256 * i, row = c >> 3, kc = c & 7; int rr = row < nvalid ? row : nvalid - 1; int tok = list[rr];
            r[i] = *(const u32x4*)(H + (size_t)tok * D_MODEL + kt * 64 + kc * 8);
        }
    }
    DEV void commit(bf16_t* S, int tid) {
#pragma unroll
        for (int i = 0; i < 4; ++i) { int c = tid + 256 * i, row = c >> 3, kc = c & 7; *(u32x4*)(S + row * GLD + kc * 8) = r[i]; }
    }
};
struct ALoadX {
    const float* base; const float *sc, *sh; f32x4 r[8]; f32x4 s4, h4;
    DEV void fetch(int kt, int tid) {
        int kc = tid & 15;
        s4 = *(const f32x4*)(sc + kt * 64 + kc * 4); h4 = *(const f32x4*)(sh + kt * 64 + kc * 4);
#pragma unroll
        for (int i = 0; i < 8; ++i) { int row = (tid >> 4) + 16 * i; r[i] = *(const f32x4*)(base + (size_t)row * D_MODEL + kt * 64 + kc * 4); }
    }
    DEV void commit(bf16_t* S, int tid) {
        int kc = tid & 15;
#pragma unroll
        for (int i = 0; i < 8; ++i) {
            int row = (tid >> 4) + 16 * i;
            u32x2 o; o.x = pack2(r[i].x * (1.f + s4.x) + h4.x, r[i].y * (1.f + s4.y) + h4.y); o.y = pack2(r[i].z * (1.f + s4.z) + h4.z, r[i].w * (1.f + s4.w) + h4.w);
            *(u32x2*)(S + row * GLD + kc * 4) = o;
        }
    }
};

template <class AL, class BL, class EP>
DEV void gemm_tile(bf16_t* sm, AL& al, BL& bl, int nkt, EP& ep) {
    const int tid = tid_(), wid = tid >> 6, lane = tid & 63, wr = wid >> 1, wc = wid & 1, r = lane & 15, quad = lane >> 4;
    bf16_t* As = sm; bf16_t* Bs = sm + 2 * GT;
    f32x4 acc[4][4];
#pragma unroll
    for (int m = 0; m < 4; ++m)
#pragma unroll
        for (int n = 0; n < 4; ++n) acc[m][n] = f32x4{0.f, 0.f, 0.f, 0.f};
    al.fetch(0, tid); bl.fetch(0, tid); al.commit(As, tid); bl.commit(Bs, tid);
    __syncthreads();
    for (int kt = 0; kt < nkt; ++kt) {
        const int cur = kt & 1;
        if (kt + 1 < nkt) { al.fetch(kt + 1, tid); bl.fetch(kt + 1, tid); }
        const bf16_t* Ac = As + cur * GT + (wr * 64 + r) * GLD + quad * 8;
        const bf16_t* Bc = Bs + cur * GT + (wc * 64 + r) * GLD + quad * 8;
#pragma unroll
        for (int ks = 0; ks < 2; ++ks) {
            Frag a[4], b[4];
#pragma unroll
            for (int m = 0; m < 4; ++m) a[m].q = *(const u32x4*)(Ac + m * 16 * GLD + ks * 32);
#pragma unroll
            for (int n = 0; n < 4; ++n) b[n].q = *(const u32x4*)(Bc + n * 16 * GLD + ks * 32);
#pragma unroll
            for (int m = 0; m < 4; ++m)
#pragma unroll
                for (int n = 0; n < 4; ++n) acc[m][n] = mfma16(a[m].v, b[n].v, acc[m][n]);
        }
        if (kt + 1 < nkt) { al.commit(As + (cur ^ 1) * GT, tid); bl.commit(Bs + (cur ^ 1) * GT, tid); }
        __syncthreads();
    }
    ep(acc, wr, wc, lane);
}


DEV int g2_h(int g) { return (0x78 >> (2 * g)) & 3; }
template <int NH> struct G2 { static constexpr int BROWS = 128 * NH, STAGE = 8192 + BROWS * 64, NST = (NH == 2 ? 3 : 4), LPS = 2 + 2 * NH; };

template <int NH, bool TR, class EP>
DEV void gemm_tile2(unsigned char* sm, const bf16_t* a0, const bf16_t* a1, const bf16_t* bb, int ldb, int nkt, EP& ep) {
    constexpr int STAGE = G2<NH>::STAGE, NST = G2<NH>::NST, LPS = G2<NH>::LPS;
    const int tid = tid_(), wid = tid >> 6, lane = tid & 63, wr = wid >> 1, wc = wid & 1, r = lane & 15, quad = lane >> 4;
    f32x4 acc[NH][4][4];
#pragma unroll
    for (int h = 0; h < NH; ++h)
#pragma unroll
        for (int m = 0; m < 4; ++m)
#pragma unroll
            for (int n = 0; n < 4; ++n) acc[h][m][n] = f32x4{0.f, 0.f, 0.f, 0.f};
    unsigned char* dst0 = sm + tid * 16;
    auto issue = [&](int kt, int slot) {
        unsigned char* d = dst0 + slot * STAGE;
        glds16(a0 + kt * 32, d); glds16(a1 + kt * 32, d + 4096);
#pragma unroll
        for (int j = 0; j < 2 * NH; ++j) glds16(bb + (size_t)j * 64 * ldb + kt * 32, d + 8192 + j * 4096);
    };
    RAW_BARRIER();
#pragma unroll
    for (int st = 0; st < NST - 1; ++st) if (st < nkt) issue(st, st);
    const int pco = (quad ^ g2_h((r >> 2) & 3)) * 16;
    const unsigned char* afr = sm + (wr * 64 + r) * 64 + pco;
    const unsigned char* bfr = sm + 8192 + (wc * 64 * NH + r) * 64 + pco;
    int slot = 0;
    for (int kt = 0; kt < nkt; ++kt) {
        const int rem = nkt - 1 - kt;
        if (NST == 3) { if (rem >= 1) wait_vm<LPS>(); else wait_vm<0>(); }
        else { if (rem >= 2) wait_vm<2 * LPS>(); else if (rem == 1) wait_vm<LPS>(); else wait_vm<0>(); }
        RAW_BARRIER();
        if (kt + NST - 1 < nkt) { int ns = slot + NST - 1; if (ns >= NST) ns -= NST; issue(kt + NST - 1, ns); }
        const unsigned char* as = afr + slot * STAGE; const unsigned char* bs = bfr + slot * STAGE;
        Frag a[4];
#pragma unroll
        for (int m = 0; m < 4; ++m) a[m].q = *(const u32x4*)(as + m * 16 * 64);
#ifndef CPU_EMU
        __builtin_amdgcn_s_setprio(1);
#endif
#pragma unroll
        for (int h = 0; h < NH; ++h) {
            Frag b[4];
#pragma unroll
            for (int n = 0; n < 4; ++n) b[n].q = *(const u32x4*)(bs + (h * 64 + n * 16) * 64);
#pragma unroll
            for (int m = 0; m < 4; ++m)
#pragma unroll
                for (int n = 0; n < 4; ++n) acc[h][m][n] = TR ? mfma16(b[n].v, a[m].v, acc[h][m][n]) : mfma16(a[m].v, b[n].v, acc[h][m][n]);
        }
#ifndef CPU_EMU
        __builtin_amdgcn_s_setprio(0);
#endif
        if (++slot == NST) slot = 0;
    }
#pragma unroll
    for (int h = 0; h < NH; ++h) { if (TR) ep.nat(acc[h], wr, wc * NH + h, lane); else ep(acc[h], wr, wc * NH + h, lane); }
}
DEV int g2_lc(int tid) { return (tid & 3) ^ g2_h((tid >> 4) & 3); }

struct ConvJob { const float* src; bf16_t* dst; int ldsrc, N, K, k0, n0, mapkind; };
DEV void conv_load(const ConvJob& j, int tid, f32x4 (&v)[4]) {
#pragma unroll
    for (int i = 0; i < 4; ++i) {
        const int kk = (tid >> 4) + 16 * i, n = j.n0 + 4 * (tid & 15);
        v[i] = f32x4{0.f, 0.f, 0.f, 0.f};
        if (n + 3 < j.N) v[i] = *(const f32x4*)(j.src + (size_t)(j.k0 + kk) * j.ldsrc + n);
    }
}
DEV void conv_store(float* T, const ConvJob& j, int tid, const f32x4 (&v)[4]) {
    __syncthreads();
#pragma unroll
    for (int i = 0; i < 4; ++i) {
        const int kk = (tid >> 4) + 16 * i, n4 = tid & 15;
        T[(4 * n4 + 0) * 65 + kk] = v[i].x; T[(4 * n4 + 1) * 65 + kk] = v[i].y; T[(4 * n4 + 2) * 65 + kk] = v[i].z; T[(4 * n4 + 3) * 65 + kk] = v[i].w;
    }
    __syncthreads();
    const int nl = tid >> 2, ks = (tid & 3) * 16; const int n = j.n0 + nl; int dr = n;
    if (j.mapkind == 1) dr = (n >> 5) * 64 + (n & 31); else if (j.mapkind == 2) dr = (n >> 5) * 64 + 32 + (n & 31);
    const float* t = T + nl * 65 + ks;
    u32x4 o0, o1;
    o0.x = pack2(t[0], t[1]); o0.y = pack2(t[2], t[3]); o0.z = pack2(t[4], t[5]); o0.w = pack2(t[6], t[7]);
    o1.x = pack2(t[8], t[9]); o1.y = pack2(t[10], t[11]); o1.z = pack2(t[12], t[13]); o1.w = pack2(t[14], t[15]);
    bf16_t* d = j.dst + (size_t)dr * j.K + j.k0 + ks;
    *(u32x4*)d = o0; *(u32x4*)(d + 8) = o1;
}
constexpr int P0_NMOD = DEPTH * 6 * D_MODEL / 64;
constexpr int P0_NCOPY = NTOK / 64;
constexpr int T_EIN = (D_MODEL / 64) * (EVEN_INP / 64), T_OIN = (D_MODEL / 64) * (ODD_IN / 64), T_OUT = (MIX_OUT / 64) * (D_MODEL / 64);
constexpr int T_GU = (D_MODEL / 64) * (D_EXPERT / 64), T_DN = (D_EXPERT / 64) * (D_MODEL / 64);
constexpr int P0_C0 = P0_NMOD + P0_NCOPY + 1 + DEPTH;
constexpr int P0_C1 = 2 * T_EIN, P0_C2 = P0_C1 + 2 * T_OIN, P0_C3 = P0_C2 + DEPTH * T_OUT, P0_C4 = P0_C3 + DEPTH * NE * 2 * T_GU, P0_C5 = P0_C4 + DEPTH * NE * T_DN;
DEV ConvJob conv_job(const Params& p, int t) {
    ConvJob j;
    if (t < P0_C1) {
        const int i = t / T_EIN, tt = t % T_EIN; const int nt = tt % (EVEN_INP / 64), kt = tt / (EVEN_INP / 64);
        j.src = p.ev_w_in + (size_t)i * D_MODEL * EVEN_IN; j.ldsrc = EVEN_IN; j.N = EVEN_IN; j.K = D_MODEL; j.k0 = kt * 64; j.n0 = nt * 64; j.dst = p.WinE + (size_t)i * EVEN_INP * D_MODEL; j.mapkind = 0;
    } else if (t < P0_C2) {
        const int q = t - P0_C1, i = q / T_OIN, tt = q % T_OIN; const int nt = tt % (ODD_IN / 64), kt = tt / (ODD_IN / 64);
        j.src = p.od_w_in + (size_t)i * D_MODEL * ODD_IN; j.ldsrc = ODD_IN; j.N = ODD_IN; j.K = D_MODEL; j.k0 = kt * 64; j.n0 = nt * 64; j.dst = p.WinO + (size_t)i * ODD_IN * D_MODEL; j.mapkind = 0;
    } else if (t < P0_C3) {
        const int q = t - P0_C2, layer = q / T_OUT, tt = q % T_OUT; const int nt = tt % (D_MODEL / 64), kt = tt / (D_MODEL / 64);
        j.src = (layer & 1) ? p.od_w_out + (size_t)(layer >> 1) * MIX_OUT * D_MODEL : p.ev_w_out + (size_t)(layer >> 1) * MIX_OUT * D_MODEL;
        j.ldsrc = D_MODEL; j.N = D_MODEL; j.K = MIX_OUT; j.k0 = kt * 64; j.n0 = nt * 64; j.dst = p.WoutT + (size_t)layer * D_MODEL * MIX_OUT; j.mapkind = 0;
    } else if (t < P0_C4) {
        const int q = t - P0_C3, le = q / (2 * T_GU); int tt = q % (2 * T_GU); const int up = tt / T_GU; tt %= T_GU; const int nt = tt % (D_EXPERT / 64), kt = tt / (D_EXPERT / 64);
        j.src = (up ? p.moe_w_up : p.moe_w_gate) + (size_t)le * D_MODEL * D_EXPERT; j.ldsrc = D_EXPERT; j.N = D_EXPERT; j.K = D_MODEL; j.k0 = kt * 64; j.n0 = nt * 64;
        j.dst = p.Wgu + (size_t)le * 2 * D_EXPERT * D_MODEL; j.mapkind = 1 + up;
    } else {
        const int q = t - P0_C4, le = q / T_DN, tt = q % T_DN; const int nt = tt % (D_MODEL / 64), kt = tt / (D_MODEL / 64);
        j.src = p.moe_w_down + (size_t)le * D_EXPERT * D_MODEL; j.ldsrc = D_MODEL; j.N = D_MODEL; j.K = D_EXPERT; j.k0 = kt * 64; j.n0 = nt * 64; j.dst = p.WdT + (size_t)le * D_MODEL * D_EXPERT; j.mapkind = 0;
    }
    return j;
}

DEV void phase0(const Params& p, unsigned char* smem) {
    const int tid = tid_(); const int bid = bid_();
    float* fs = (float*)smem;
    for (int task = bid; task < P0_C0; task += gridDim.x) {
        if (task < P0_NMOD) {
            __syncthreads();
            for (int i = tid; i < (BATCH + 1) * D_MODEL; i += 256) { int bb = i / D_MODEL, k = i % D_MODEL; float v = bb < BATCH ? p.c[bb * D_MODEL + k] : p.c_ctx[k]; fs[i] = v / (1.f + expf(-v)); }
            __syncthreads();
            const int col = task * 64 + (tid & 63), kg = tid >> 6; const int layer = col / (6 * D_MODEL), j = col % (6 * D_MODEL);
            const float* w = p.w_mod + (size_t)layer * D_MODEL * 6 * D_MODEL + j;
            float acc[BATCH + 1];
#pragma unroll
            for (int bb = 0; bb <= BATCH; ++bb) acc[bb] = 0.f;
#pragma unroll 16
            for (int k = kg * (D_MODEL / 4); k < (kg + 1) * (D_MODEL / 4); ++k) {
                float wv = w[(size_t)k * 6 * D_MODEL];
#pragma unroll
                for (int bb = 0; bb <= BATCH; ++bb) acc[bb] += fs[bb * D_MODEL + k] * wv;
            }
            float* red = fs + (BATCH + 1) * D_MODEL;
#pragma unroll
            for (int bb = 0; bb <= BATCH; ++bb) red[(kg * (BATCH + 1) + bb) * 64 + (tid & 63)] = acc[bb];
            __syncthreads();
            if (tid < 64) {
                const float bm = p.b_mod[layer * 6 * D_MODEL + j];
#pragma unroll
                for (int bb = 0; bb <= BATCH; ++bb) {
                    const float sacc = red[(0 * (BATCH + 1) + bb) * 64 + tid] + red[(1 * (BATCH + 1) + bb) * 64 + tid] + red[(2 * (BATCH + 1) + bb) * 64 + tid] + red[(3 * (BATCH + 1) + bb) * 64 + tid];
                    p.MOD[((size_t)layer * (BATCH + 1) + bb) * 6 * D_MODEL + j] = sacc + bm;
                }
            }
        } else if (task < P0_NMOD + P0_NCOPY) {
            int r0 = (task - P0_NMOD) * 64;
            for (int i = tid; i < 64 * D_MODEL / 4; i += 256) {
                int row = r0 + i / (D_MODEL / 4), c4 = i % (D_MODEL / 4); int b = row / TT, s = row % TT;
                const float* src = s < CTX ? p.ctx + ((size_t)b * CTX + s) * D_MODEL : p.x + ((size_t)b * SEQ + (s - CTX)) * D_MODEL;
                *(u32x2*)(p.X + (size_t)row * D_MODEL + c4 * 4) = pk4(*(const f32x4*)(src + c4 * 4));

            }
        } else if (task == P0_NMOD + P0_NCOPY) {
            for (int i = tid; i < 64 * 16; i += 256) {
                int pos = i / 16, f = i % 16;
                double th = 1.0; for (int q = 0; q < f; ++q) th *= 0.5623413251903490804;
                double t2 = th * th, cs = 1.0, sn = th, tc = 1.0, ts = th;
                for (int n = 1; n < 14; ++n) { tc *= -t2 / ((2 * n - 1) * (2 * n)); ts *= -t2 / ((2 * n) * (2 * n + 1)); cs += tc; sn += ts; }
                double c = 1.0, s = 0.0;
                for (int q = 0; q < pos; ++q) { double cn = c * cs - s * sn, sn2 = s * cs + c * sn; c = cn; s = sn2; }
                p.ROPE[i * 2] = (float)c; p.ROPE[i * 2 + 1] = (float)s;
            }
            if (tid < 2) {
                const float* lp = p.ev_lambda + tid * 4 * 64; float s01 = 0.f, s23 = 0.f;
                for (int k = 0; k < 64; ++k) { s01 += lp[k] * lp[64 + k]; s23 += lp[128 + k] * lp[192 + k]; }
                float lam_init = 0.8f - 0.6f * expf(-0.3f * (float)(2 * tid));
                p.LAM[tid] = expf(s01) - expf(s23) + lam_init;
            }
            for (int i = tid; i < DEPTH * NE * 32; i += 256) p.CNT[i] = 0;
        } else {
            int layer = task - (P0_NMOD + P0_NCOPY + 1);
            for (int i = tid; i < NR * D_MODEL; i += 256) {
                int j = i / D_MODEL, k = i % D_MODEL;
                float v = j < NG ? p.moe_w_group[((size_t)layer * D_MODEL + k) * NG + j] : p.moe_w_router[((size_t)layer * D_MODEL + k) * NE + (j - NG)];
                p.WrT[(size_t)layer * NR * D_MODEL + i] = v;
            }
        }
    }
    {
        const int G = gridDim.x; int t = bid;
        ConvJob j0, j1, j2; f32x4 v0[4], v1[4], v2[4];
        const bool h0 = t < P0_C5, h1 = t + G < P0_C5;
        if (h0) { j0 = conv_job(p, t); conv_load(j0, tid, v0); } else { j0 = conv_job(p, 0); }
        if (h1) { j1 = conv_job(p, t + G); conv_load(j1, tid, v1); } else { j1 = j0; }
        j2 = j1;
        while (t < P0_C5) {
            const bool h2 = t + 2 * G < P0_C5;
            if (h2) { j2 = conv_job(p, t + 2 * G); conv_load(j2, tid, v2); }
            conv_store(fs, j0, tid, v0);
            j0 = j1; j1 = j2;
#pragma unroll
            for (int i = 0; i < 4; ++i) { v0[i] = v1[i]; v1[i] = v2[i]; }
            t += G;
        }
    }
}

DEV int chunk_of(int dir, int sp) { return dir == 0 ? sp : (sp < NCC ? NCC - 1 - sp : NCC + (NCH - 1 - sp)); }
DEV int sp_of(int dir, int u) { return dir == 0 ? u : (u < NCC ? NCC - 1 - u : NCC + (NCH - 1 - u)); }

template <bool RET>
DEV void gate_chain(const Params& p, int layer, int chain) {
    const int lane = tid_() & 63;
    const int dir = chain & 1, h = (chain >> 1) & 3, b = chain >> 3;
    float lg = 0.f;
    if (RET) lg = logsigf(p.od_decay[((layer >> 1) * 2 + dir) * HC + h]);
    float mprev = 0.f;
    for (int sp = 0; sp < NCH; ++sp) {
        const int u = chunk_of(dir, sp); const int sbase = u * CH;
        int i0 = 2 * lane, i1 = 2 * lane + 1;
        int s0 = dir ? sbase + 127 - i0 : sbase + i0, s1 = dir ? sbase + 127 - i1 : sbase + i1;
        float lf0, lf1, li0, li1;
        if (RET) { lf0 = lf1 = lg; li0 = li1 = 0.f; }
        else {
            const float* g0 = p.G + ((size_t)b * TT + s0) * 16; const float* g1 = p.G + ((size_t)b * TT + s1) * 16;
            li0 = g0[(2 * dir) * 4 + h]; li1 = g1[(2 * dir) * 4 + h];
            lf0 = logsigf(g0[(2 * dir + 1) * 4 + h]); lf1 = logsigf(g1[(2 * dir + 1) * 4 + h]);
        }
        float ps = lf0 + lf1;
        for (int d = 1; d < 64; d <<= 1) { float o = lane_up(ps, d, lane); if (lane >= d) ps += o; }
        float b1 = ps, b0 = ps - lf1;
        float bend = lane_read(ps, 63, lane);
        float a0 = li0 - b0, a1 = li1 - b1;
        float pm = fmaxf(a0, a1);
        float mx = pm;
        for (int d = 1; d < 64; d <<= 1) { float o = lane_up(mx, d, lane); if (lane >= d) mx = fmaxf(mx, o); }
        float pmx_prev = lane_up(mx, 1, lane); if (lane == 0) pmx_prev = -3.0e38f;
        float pm0 = fmaxf(pmx_prev, a0), pm1 = mx;
        float amax = lane_read(mx, 63, lane);
        float mnew, carry, mt0, mt1;
        if (RET) { mnew = 0.f; carry = __expf(bend); mt0 = mt1 = 0.f; }
        else { mnew = fmaxf(bend + mprev, bend + amax); carry = __expf(bend + mprev - mnew); mt0 = b0 + fmaxf(mprev, pm0); mt1 = b1 + fmaxf(mprev, pm1); }
        size_t o = (size_t)chain * TT;
        p.BC[o + s0] = b0; p.BC[o + s1] = b1; p.AT[o + s0] = a0; p.AT[o + s1] = a1; p.MT[o + s0] = mt0; p.MT[o + s1] = mt1;
        if (lane == 0) { float* ms = p.MS + ((size_t)chain * NCH + sp) * 4; ms[0] = mprev; ms[1] = mnew; ms[2] = bend; ms[3] = carry; }
        mprev = mnew;
    }
}

struct EpInEven {
    const Params& p; int layer, row0, col0;
    DEV void nat(f32x4 (&acc)[4][4], int wr, int wc, int lane) {
        const int r = lane & 15, quad = lane >> 4;
        const int c0 = col0 + wc * 64, rowb = row0 + wr * 64;
        const int b = row0 / TT; const int sb = rowb - b * TT; const bool lat = sb >= CTX;
        if (c0 < 1024) {
            bf16_t* dst = c0 < 512 ? p.Q1 : p.K1; const int cc = c0 & 511;
#pragma unroll
            for (int m = 0; m < 4; ++m) {
                const int row = rowb + m * 16 + r;
                f32x4 v0 = acc[m][0], v1 = acc[m][1], v2 = acc[m][2], v3 = acc[m][3];
                if (lat) {
                    const int t = sb + m * 16 + r - CTX; const int pr = t / GRID_W, pc = t % GRID_W;
                    const f32x4 ra = *(const f32x4*)(p.ROPE + (pr * 16 + quad * 4) * 2), rb = *(const f32x4*)(p.ROPE + (pr * 16 + quad * 4) * 2 + 4);
                    const f32x4 ca = *(const f32x4*)(p.ROPE + (pc * 16 + quad * 4) * 2), cb = *(const f32x4*)(p.ROPE + (pc * 16 + quad * 4) * 2 + 4);
                    const f32x4 cr = f32x4{ra[0], ra[2], rb[0], rb[2]}, sr = f32x4{ra[1], ra[3], rb[1], rb[3]};
                    const f32x4 cq = f32x4{ca[0], ca[2], cb[0], cb[2]}, sq = f32x4{ca[1], ca[3], cb[1], cb[3]};
                    const f32x4 o0 = v0 * cr - v2 * sr, o2 = v0 * sr + v2 * cr, o1 = v1 * cq - v3 * sq, o3 = v1 * sq + v3 * cq;
                    v0 = o0; v1 = o1; v2 = o2; v3 = o3;
                }
                bf16_t* d = dst + (size_t)row * 512 + cc + quad * 4;
                u32x2 w; w.x = pack2(v0[0], v0[1]); w.y = pack2(v0[2], v0[3]); *(u32x2*)d = w;
                w.x = pack2(v1[0], v1[1]); w.y = pack2(v1[2], v1[3]); *(u32x2*)(d + 16) = w;
                w.x = pack2(v2[0], v2[1]); w.y = pack2(v2[2], v2[3]); *(u32x2*)(d + 32) = w;
                w.x = pack2(v3[0], v3[1]); w.y = pack2(v3[2], v3[3]); *(u32x2*)(d + 48) = w;
            }
        } else if (c0 < 3584) {
            const bool pm = c0 < 2560; bf16_t* dst = pm ? p.PM : p.OG; const int ld = pm ? 1024 : 512; const int cc = pm ? c0 - 1536 : c0 - 3072;
#pragma unroll
            for (int m = 0; m < 4; ++m) {
                bf16_t* d = dst + (size_t)(rowb + m * 16 + r) * ld + cc + quad * 4;
#pragma unroll
                for (int n = 0; n < 4; ++n) { u32x2 w; w.x = pack2(acc[m][n][0], acc[m][n][1]); w.y = pack2(acc[m][n][2], acc[m][n][3]); *(u32x2*)(d + n * 16) = w; }
            }
        } else if (c0 == 3584) {
            const f32x4 gb = *(const f32x4*)(p.ev_gate_b + (layer >> 1) * 16 + quad * 4);
#pragma unroll
            for (int m = 0; m < 4; ++m) *(f32x4*)(p.G + (size_t)(rowb + m * 16 + r) * 16 + quad * 4) = acc[m][0] + gb;
        }
    }
    DEV void operator()(f32x4 (&acc)[4][4], int wr, int wc, int lane) {
        const int r = lane & 15, quad = lane >> 4;
        const int c0 = col0 + wc * 64, rowb = row0 + wr * 64;
        const int b = row0 / TT; const int sb = rowb - b * TT; const bool lat = sb >= CTX;
        if (c0 < 1024) {
            bf16_t* dst = c0 < 512 ? p.Q1 : p.K1; const int cc = c0 & 511;
#pragma unroll
            for (int m = 0; m < 4; ++m)
#pragma unroll
                for (int j = 0; j < 4; ++j) {
                    const int row = rowb + m * 16 + quad * 4 + j;
                    float v0 = acc[m][0][j], v1 = acc[m][1][j], v2 = acc[m][2][j], v3 = acc[m][3][j];
                    if (lat) {
                        const int t = sb + m * 16 + quad * 4 + j - CTX; const int pr = t / GRID_W, pc = t % GRID_W;
                        const float cr = p.ROPE[(pr * 16 + r) * 2], sr = p.ROPE[(pr * 16 + r) * 2 + 1], cq = p.ROPE[(pc * 16 + r) * 2], sq = p.ROPE[(pc * 16 + r) * 2 + 1];
                        float o0 = v0 * cr - v2 * sr, o2 = v0 * sr + v2 * cr, o1 = v1 * cq - v3 * sq, o3 = v1 * sq + v3 * cq;
                        v0 = o0; v1 = o1; v2 = o2; v3 = o3;
                    }
                    bf16_t* d = dst + (size_t)row * 512 + cc + r;
                    d[0] = f2bf(v0); d[16] = f2bf(v1); d[32] = f2bf(v2); d[48] = f2bf(v3);
                }
        } else if (c0 < 1536 || (c0 >= 2560 && c0 < 3072)) {
            const bool at = c0 < 1536; const int cc = at ? c0 - 1024 : c0 - 2560; const int h = cc >> 7, e0 = (cc & 127);
            bf16_t* dst = (at ? p.V1T : p.V2T) + ((size_t)(b * 4 + h) * 128) * TT;
#pragma unroll
            for (int m = 0; m < 4; ++m)
#pragma unroll
                for (int n = 0; n < 4; ++n) {
                    u32x2 o; o.x = pack2(acc[m][n][0], acc[m][n][1]); o.y = pack2(acc[m][n][2], acc[m][n][3]);
                    *(u32x2*)(dst + (size_t)(e0 + n * 16 + r) * TT + sb + m * 16 + quad * 4) = o;
                }
        } else if (c0 < 2560 || (c0 >= 3072 && c0 < 3584)) {
            const bool pm = c0 < 2560; bf16_t* dst = pm ? p.PM : p.OG; const int ld = pm ? 1024 : 512; const int cc = pm ? c0 - 1536 : c0 - 3072;
#pragma unroll
            for (int m = 0; m < 4; ++m)
#pragma unroll
                for (int j = 0; j < 4; ++j) {
                    const int row = rowb + m * 16 + quad * 4 + j; bf16_t* d = dst + (size_t)row * ld + cc + r;
                    d[0] = f2bf(acc[m][0][j]); d[16] = f2bf(acc[m][1][j]); d[32] = f2bf(acc[m][2][j]); d[48] = f2bf(acc[m][3][j]);
                }
        } else if (c0 == 3584) {
            const float gb = p.ev_gate_b[(layer >> 1) * 16 + r];
#pragma unroll
            for (int m = 0; m < 4; ++m)
#pragma unroll
                for (int j = 0; j < 4; ++j) { const int row = rowb + m * 16 + quad * 4 + j; p.G[(size_t)row * 16 + r] = acc[m][0][j] + gb; }
        }
    }
};

struct EpInOdd {
    const Params& p; int layer, row0, col0;
    DEV void nat(f32x4 (&acc)[4][4], int wr, int wc, int lane) {
        const int r = lane & 15, quad = lane >> 4;
        const int c0 = col0 + wc * 64, rowb = row0 + wr * 64;
        const int b = row0 / TT; const int sb = rowb - b * TT; const bool lat = sb >= CTX;
        if (c0 < 512 || (c0 >= 1024 && c0 < 1536)) {
            bf16_t* dst; int ld, cc; float scl = 1.f;
            if (c0 < 256) { dst = p.Q2; ld = 256; cc = c0; } else if (c0 < 512) { dst = p.K2; ld = 256; cc = c0 - 256; scl = 0.125f; } else { dst = p.OG; ld = 512; cc = c0 - 1024; }
#pragma unroll
            for (int m = 0; m < 4; ++m) {
                bf16_t* d = dst + (size_t)(rowb + m * 16 + r) * ld + cc + quad * 4;
#pragma unroll
                for (int n = 0; n < 4; ++n) { u32x2 w; w.x = pack2(acc[m][n][0] * scl, acc[m][n][1] * scl); w.y = pack2(acc[m][n][2] * scl, acc[m][n][3] * scl); *(u32x2*)(d + n * 16) = w; }
            }
        } else if (c0 >= 1536 && c0 < 2176) {
            const bool isq = c0 < 2048; bf16_t* dst = isq ? p.Q1 : p.K1; const int ld = isq ? 512 : 128; const int cc = isq ? c0 - 1536 : c0 - 2048;
            const float* g = p.od_qk_g + ((layer >> 1) * 2 + (isq ? 0 : 1)) * 64 + quad * 4;
            const f32x4 g0 = *(const f32x4*)g, g1 = *(const f32x4*)(g + 16), g2 = *(const f32x4*)(g + 32), g3 = *(const f32x4*)(g + 48);
#pragma unroll
            for (int m = 0; m < 4; ++m) {
                const int row = rowb + m * 16 + r;
                f32x4 v0 = acc[m][0], v1 = acc[m][1], v2 = acc[m][2], v3 = acc[m][3];
                float ss = 0.f;
#pragma unroll
                for (int j = 0; j < 4; ++j) ss += v0[j] * v0[j] + v1[j] * v1[j] + v2[j] * v2[j] + v3[j] * v3[j];
                ss = xadd16(ss); ss = xadd32(ss);
                const float rs = 1.0f / sqrtf(ss * (1.f / 64.f) + EPS);
                v0 = v0 * rs * g0; v1 = v1 * rs * g1; v2 = v2 * rs * g2; v3 = v3 * rs * g3;
                if (lat) {
                    const int t = sb + m * 16 + r - CTX; const int pr = t / GRID_W, pc = t % GRID_W;
                    const f32x4 ra = *(const f32x4*)(p.ROPE + (pr * 16 + quad * 4) * 2), rb = *(const f32x4*)(p.ROPE + (pr * 16 + quad * 4) * 2 + 4);
                    const f32x4 ca = *(const f32x4*)(p.ROPE + (pc * 16 + quad * 4) * 2), cb = *(const f32x4*)(p.ROPE + (pc * 16 + quad * 4) * 2 + 4);
                    const f32x4 cr = f32x4{ra[0], ra[2], rb[0], rb[2]}, sr = f32x4{ra[1], ra[3], rb[1], rb[3]};
                    const f32x4 cq = f32x4{ca[0], ca[2], cb[0], cb[2]}, sq = f32x4{ca[1], ca[3], cb[1], cb[3]};
                    const f32x4 o0 = v0 * cr - v2 * sr, o2 = v0 * sr + v2 * cr, o1 = v1 * cq - v3 * sq, o3 = v1 * sq + v3 * cq;
                    v0 = o0; v1 = o1; v2 = o2; v3 = o3;
                }
                bf16_t* d = dst + (size_t)row * ld + cc + quad * 4;
                u32x2 w; w.x = pack2(v0[0], v0[1]); w.y = pack2(v0[2], v0[3]); *(u32x2*)d = w;
                w.x = pack2(v1[0], v1[1]); w.y = pack2(v1[2], v1[3]); *(u32x2*)(d + 16) = w;
                w.x = pack2(v2[0], v2[1]); w.y = pack2(v2[2], v2[3]); *(u32x2*)(d + 32) = w;
                w.x = pack2(v3[0], v3[1]); w.y = pack2(v3[2], v3[3]); *(u32x2*)(d + 48) = w;
            }
        }
    }
    DEV void operator()(f32x4 (&acc)[4][4], int wr, int wc, int lane) {
        const int r = lane & 15, quad = lane >> 4;
        const int c0 = col0 + wc * 64, rowb = row0 + wr * 64;
        const int b = row0 / TT; const int sb = rowb - b * TT; const bool lat = sb >= CTX;
        if (c0 < 512 || (c0 >= 1024 && c0 < 1536)) {
            bf16_t* dst; int ld, cc; float scl = 1.f;
            if (c0 < 256) { dst = p.Q2; ld = 256; cc = c0; } else if (c0 < 512) { dst = p.K2; ld = 256; cc = c0 - 256; scl = 0.125f; } else { dst = p.OG; ld = 512; cc = c0 - 1024; }
#pragma unroll
            for (int m = 0; m < 4; ++m)
#pragma unroll
                for (int j = 0; j < 4; ++j) {
                    const int row = rowb + m * 16 + quad * 4 + j; bf16_t* d = dst + (size_t)row * ld + cc + r;
                    d[0] = f2bf(acc[m][0][j] * scl); d[16] = f2bf(acc[m][1][j] * scl); d[32] = f2bf(acc[m][2][j] * scl); d[48] = f2bf(acc[m][3][j] * scl);
                }
        } else if (c0 < 1024) {
            const int cc = c0 - 512; const int h = cc >> 7, e0 = cc & 127; bf16_t* dst = p.V2T + ((size_t)(b * 4 + h) * 128) * TT;
#pragma unroll
            for (int m = 0; m < 4; ++m)
#pragma unroll
                for (int n = 0; n < 4; ++n) {
                    u32x2 o; o.x = pack2(acc[m][n][0], acc[m][n][1]); o.y = pack2(acc[m][n][2], acc[m][n][3]);
                    *(u32x2*)(dst + (size_t)(e0 + n * 16 + r) * TT + sb + m * 16 + quad * 4) = o;
                }
        } else if (c0 < 2176) {
            const bool isq = c0 < 2048; bf16_t* dst = isq ? p.Q1 : p.K1; const int ld = isq ? 512 : 128; const int cc = isq ? c0 - 1536 : c0 - 2048;
            const float* g = p.od_qk_g + ((layer >> 1) * 2 + (isq ? 0 : 1)) * 64;
            const float g0 = g[r], g1 = g[16 + r], g2 = g[32 + r], g3 = g[48 + r];
#pragma unroll
            for (int m = 0; m < 4; ++m)
#pragma unroll
                for (int j = 0; j < 4; ++j) {
                    const int row = rowb + m * 16 + quad * 4 + j;
                    float v0 = acc[m][0][j], v1 = acc[m][1][j], v2 = acc[m][2][j], v3 = acc[m][3][j];
                    float ss = v0 * v0 + v1 * v1 + v2 * v2 + v3 * v3;
                    ss = rowred_add(ss);
                    const float rs = 1.0f / sqrtf(ss * (1.f / 64.f) + EPS);
                    v0 *= rs * g0; v1 *= rs * g1; v2 *= rs * g2; v3 *= rs * g3;
                    if (lat) {
                        const int t = sb + m * 16 + quad * 4 + j - CTX; const int pr = t / GRID_W, pc = t % GRID_W;
                        const float cr = p.ROPE[(pr * 16 + r) * 2], sr = p.ROPE[(pr * 16 + r) * 2 + 1], cq = p.ROPE[(pc * 16 + r) * 2], sq = p.ROPE[(pc * 16 + r) * 2 + 1];
                        float o0 = v0 * cr - v2 * sr, o2 = v0 * sr + v2 * cr, o1 = v1 * cq - v3 * sq, o3 = v1 * sq + v3 * cq;
                        v0 = o0; v1 = o1; v2 = o2; v3 = o3;
                    }
                    bf16_t* d = dst + (size_t)row * ld + cc + r;
                    d[0] = f2bf(v0); d[16] = f2bf(v1); d[32] = f2bf(v2); d[48] = f2bf(v3);
                }
        } else {
            const int kv = (c0 - 2176) >> 6; bf16_t* dst = p.V1T + ((size_t)(b * HKV + kv) * 64) * TT;
#pragma unroll
            for (int m = 0; m < 4; ++m)
#pragma unroll
                for (int n = 0; n < 4; ++n) {
                    u32x2 o; o.x = pack2(acc[m][n][0], acc[m][n][1]); o.y = pack2(acc[m][n][2], acc[m][n][3]);
                    *(u32x2*)(dst + (size_t)(n * 16 + r) * TT + sb + m * 16 + quad * 4) = o;
                }
        }
    }
};

DEV void phaseA(const Params& p, int layer, unsigned char* smem) {
    const bool odd = layer & 1;
    const int ncol = odd ? ODD_IN / 256 : EVEN_INP / 256; const int nrow = NTOK / 128;
    const bf16_t* W = odd ? p.WinO + (size_t)(layer >> 1) * ODD_IN * D_MODEL : p.WinE + (size_t)(layer >> 1) * EVEN_INP * D_MODEL;
    const int bid = bid_(); const int tid = tid_(); const int trow = tid >> 2, lc8 = g2_lc(tid) * 8;
    if (odd) {
        for (int t = bid * 4 + (tid >> 6); t < NCHAIN * NCH; t += gridDim.x * 4) {
            const int chain = t / NCH, sp = t % NCH, lane = tid & 63; const int dir = chain & 1, h = (chain >> 1) & 3;
            const float lg = logsigf(p.od_decay[((layer >> 1) * 2 + dir) * HC + h]);
            const int sbase = chunk_of(dir, sp) * CH; const int i0 = 2 * lane, i1 = 2 * lane + 1;
            const int s0 = dir ? sbase + 127 - i0 : sbase + i0, s1 = dir ? sbase + 127 - i1 : sbase + i1;
            const float b0 = lg * (float)(i0 + 1), b1 = lg * (float)(i1 + 1), bend = lg * (float)CH;
            const size_t o = (size_t)chain * TT;
            p.BC[o + s0] = b0; p.BC[o + s1] = b1; p.AT[o + s0] = -b0; p.AT[o + s1] = -b1; p.MT[o + s0] = 0.f; p.MT[o + s1] = 0.f;
            if (lane == 0) { float* ms = p.MS + ((size_t)chain * NCH + sp) * 4; ms[0] = 0.f; ms[1] = 0.f; ms[2] = bend; ms[3] = __expf(bend); }
        }
    }
    const WorkRange wr = xcd_range(nrow * ncol, bid);
    for (int t = wr.lo; t < wr.hi; t += wr.step) {
        int rt, ct; dense_tile(t, nrow, ncol, rt, ct); const int row0 = rt * 128, col0 = ct * 256;
        const bf16_t* a0 = p.HIN + (size_t)(row0 + trow) * D_MODEL + lc8;
        const bf16_t* bb = W + (size_t)(col0 + trow) * D_MODEL + lc8;
        if (odd) {
            EpInOdd ep{p, layer, row0, col0};
            if (ct == 2 || ct == 3 || ct == 8) gemm_tile2<2, false>(smem, a0, a0 + (size_t)64 * D_MODEL, bb, D_MODEL, D_MODEL / 32, ep);
            else gemm_tile2<2, true>(smem, a0, a0 + (size_t)64 * D_MODEL, bb, D_MODEL, D_MODEL / 32, ep);
        } else {
            EpInEven ep{p, layer, row0, col0};
            if (ct == 4 || ct == 5 || ct == 10 || ct == 11) gemm_tile2<2, false>(smem, a0, a0 + (size_t)64 * D_MODEL, bb, D_MODEL, D_MODEL / 32, ep);
            else gemm_tile2<2, true>(smem, a0, a0 + (size_t)64 * D_MODEL, bb, D_MODEL, D_MODEL / 32, ep);
        }
    }
#ifdef PROBE_GEMM
    {
        Params q = p; bf16_t* scr = (bf16_t*)p.DC;
        q.Q1 = scr; q.K1 = scr; q.V1T = scr; q.PM = scr; q.V2T = scr; q.OG = scr; q.G = (float*)scr; q.Q2 = scr; q.K2 = scr;
        for (int t = wr.lo; t < wr.hi; t += wr.step) {
            int rt, ct; dense_tile(t, nrow, ncol, rt, ct); const int row0 = rt * 128, col0 = ct * 256;
            const bf16_t* a0 = p.HIN + (size_t)(row0 + trow) * D_MODEL + lc8;
            const bf16_t* bb = W + (size_t)(col0 + trow) * D_MODEL + lc8;
            const int erow0 = (PROBE_GEMM == 2) ? (row0 % TT >= CTX ? CTX : 0) : row0;
            if (odd) {
                EpInOdd ep{q, layer, erow0, col0};
                if (ct == 2 || ct == 3 || ct == 8) gemm_tile2<2, false>(smem, a0, a0 + (size_t)64 * D_MODEL, bb, D_MODEL, D_MODEL / 32, ep);
                else gemm_tile2<2, true>(smem, a0, a0 + (size_t)64 * D_MODEL, bb, D_MODEL, D_MODEL / 32, ep);
            } else {
                EpInEven ep{q, layer, erow0, col0};
                if (ct == 4 || ct == 5 || ct == 10 || ct == 11) gemm_tile2<2, false>(smem, a0, a0 + (size_t)64 * D_MODEL, bb, D_MODEL, D_MODEL / 32, ep);
                else gemm_tile2<2, true>(smem, a0, a0 + (size_t)64 * D_MODEL, bb, D_MODEL, D_MODEL / 32, ep);
            }
        }
    }
#endif
}
DEV void phase0b(const Params& p) {
    const int total = NTOK * (D_MODEL / 4);
    for (int idx = bid_() * 256 + tid_(); idx < total; idx += gridDim.x * 256) {
        const int row = idx / (D_MODEL / 4), k = (idx % (D_MODEL / 4)) * 4; const int b = row / TT, sq = row % TT; const int bb = sq < CTX ? BATCH : b;
        const float* mod = p.MOD + (size_t)bb * 6 * D_MODEL;
        const f32x4 x = bf4(*(const u32x2*)(p.X + (size_t)row * D_MODEL + k)), sh = *(const f32x4*)(mod + k), sc = *(const f32x4*)(mod + D_MODEL + k);
        u32x2 o; o.x = pack2(x.x * (1.f + sc.x) + sh.x, x.y * (1.f + sc.y) + sh.y); o.y = pack2(x.z * (1.f + sc.z) + sh.z, x.w * (1.f + sc.w) + sh.w);
        *(u32x2*)(p.HIN + (size_t)row * D_MODEL + k) = o;
    }
}

static_assert(NCH <= 64, "chunk summaries of a chain are scanned by one wave");
DEV void gate_chunk(const Params& p, int chain, int sp, int lane) {
    const int dir = chain & 1, h = (chain >> 1) & 3, b = chain >> 3;
    const int u = chunk_of(dir, sp); const int sbase = u * CH;
    const int i0 = 2 * lane, i1 = 2 * lane + 1;
    const int s0 = dir ? sbase + 127 - i0 : sbase + i0, s1 = dir ? sbase + 127 - i1 : sbase + i1;
    const float* g0 = p.G + ((size_t)b * TT + s0) * 16; const float* g1 = p.G + ((size_t)b * TT + s1) * 16;
    const float li0 = g0[(2 * dir) * 4 + h], li1 = g1[(2 * dir) * 4 + h];
    const float lf0 = logsigf(g0[(2 * dir + 1) * 4 + h]), lf1 = logsigf(g1[(2 * dir + 1) * 4 + h]);
    float ps = lf0 + lf1;
    for (int d = 1; d < 64; d <<= 1) { float o = lane_up(ps, d, lane); if (lane >= d) ps += o; }
    const float b1 = ps, b0 = ps - lf1;
    const float bend = lane_read(ps, 63, lane);
    const float a0 = li0 - b0, a1 = li1 - b1;
    float mx = fmaxf(a0, a1);
    for (int d = 1; d < 64; d <<= 1) { float o = lane_up(mx, d, lane); if (lane >= d) mx = fmaxf(mx, o); }
    float pmx_prev = lane_up(mx, 1, lane); if (lane == 0) pmx_prev = -3.0e38f;
    const float pm0 = fmaxf(pmx_prev, a0), pm1 = mx;
    const float amax = lane_read(mx, 63, lane);
    const size_t o = (size_t)chain * TT;
    p.BC[o + s0] = b0; p.BC[o + s1] = b1; p.AT[o + s0] = a0; p.AT[o + s1] = a1; p.MT[o + s0] = pm0; p.MT[o + s1] = pm1;
    if (lane == 0) { float* c2 = p.CH2 + ((size_t)chain * NCH + sp) * 2; c2[0] = bend; c2[1] = amax; }
}
DEV void phaseB(const Params& p, int layer) {
    const int tid = tid_();
    const int bid = bid_();
    for (int t = bid * 4 + (tid >> 6); t < NCHAIN * NCH; t += gridDim.x * 4) gate_chunk(p, t / NCH, t % NCH, tid & 63);
    const float* cw = p.ev_conv_w + (size_t)(layer >> 1) * 3 * 1024; const float* cb = p.ev_conv_b + (size_t)(layer >> 1) * 1024;
    const int total = NTOK * 128;
    for (int idx = bid * 256 + tid; idx < total; idx += gridDim.x * 256) {
        const int row = idx >> 7, cg8 = (idx & 127) * 8; const int b = row / TT, s = row % TT;
        const bool hasp = (s != 0) && (s != CTX), hasn = (s != CTX - 1) && (s != TT - 1);
        Frag xm, x0, xp; x0.q = *(const u32x4*)(p.PM + (size_t)row * 1024 + cg8);
        xm.q = u32x4{0u, 0u, 0u, 0u}; xp.q = u32x4{0u, 0u, 0u, 0u};
        if (hasp) xm.q = *(const u32x4*)(p.PM + (size_t)(row - 1) * 1024 + cg8);
        if (hasn) xp.q = *(const u32x4*)(p.PM + (size_t)(row + 1) * 1024 + cg8);
        float y[8];
#pragma unroll
        for (int i = 0; i < 8; ++i) {
            const int ch = cg8 + i;
            float v = cb[ch] + bf2f((bf16_t)xm.v[i]) * cw[ch] + bf2f((bf16_t)x0.v[i]) * cw[1024 + ch] + bf2f((bf16_t)xp.v[i]) * cw[2048 + ch];
            y[i] = siluf(v);
        }
        if (cg8 < 512) {
            u32x4 o; o.x = pack2(y[0], y[1]); o.y = pack2(y[2], y[3]); o.z = pack2(y[4], y[5]); o.w = pack2(y[6], y[7]);
            *(u32x4*)(p.Q2 + (size_t)row * 512 + cg8) = o;
        } else {
            const float sc = 0.08838834764831845f;
#pragma unroll
            for (int i = 0; i < 8; ++i) y[i] *= sc;
            u32x4 o; o.x = pack2(y[0], y[1]); o.y = pack2(y[2], y[3]); o.z = pack2(y[4], y[5]); o.w = pack2(y[6], y[7]);
            const int kc = cg8 - 512; *(u32x4*)(p.K2 + (size_t)row * 512 + kc) = o;
        }
    }
}

constexpr int KLD1 = 136, KLD0 = 72, VLD = 72;
template <int NC, int DV, int QT>
struct AttnState { f32x4 O[NC][DV / 16][QT]; f32x4 L[NC][QT]; float m[NC][QT]; };

DEV float max3f(float a, float b, float c) {
#ifdef CPU_EMU
    return fmaxf(fmaxf(a, b), c);
#else
    float d; asm("v_max3_f32 %0, %1, %2, %3" : "=v"(d) : "v"(a), "v"(b), "v"(c)); return d;
#endif
}
DEV float max2f(float a, float b) {
#ifdef CPU_EMU
    return fmaxf(a, b);
#else
    float d; asm("v_max_f32 %0, %1, %2" : "=v"(d) : "v"(a), "v"(b)); return d;
#endif
}
DEV bool wave_any(bool pr) {
#ifdef CPU_EMU
    int v = pr ? 1 : 0; for (int m = 1; m < 64; m <<= 1) v |= __shfl_xor(v, m); return v != 0;
#else
    return __builtin_amdgcn_ballot_w64(pr) != 0;
#endif
}

template <int NC, int DV, int QT, int KW>
DEV void attn_core(bf16_t* sm, const bf16_t* Kg, int ldk, const bf16_t* VTg, int nkeys, const Frag (&qf)[NC][2][QT], AttnState<NC, DV, QT>& st, float sc2, int koff) {
    constexpr int KLD = KW + 8;
    constexpr int NKR = KW / 32, NVR = DV / 32;
    constexpr int KBUF = 64 * KLD, VBUF = DV * VLD;
    constexpr float TH = 6.0f;
    const float isc2 = 1.0f / sc2;
    const int tid = tid_(), lane = tid & 63, r = lane & 15, quad = lane >> 4;
    u32x4 kreg[NKR], vreg[NVR];
    constexpr int VTPR = 8 / NVR;
    const bf16_t* kp = Kg + (size_t)(tid >> 2) * ldk + (tid & 3) * NKR * 8;
    const bf16_t* vp0 = VTg + (size_t)(tid / VTPR) * TT + (tid % VTPR) * NVR * 8;
    const int klo = (tid >> 2) * KLD + (tid & 3) * NKR * 8;
    const int nt = nkeys >> 6;
    Frag ones; ones.u[0] = ones.u[1] = ones.u[2] = ones.u[3] = 0x3F803F80u;
    auto loadK = [&]() {
#pragma unroll
        for (int i = 0; i < NKR; ++i) kreg[i] = *(const u32x4*)(kp + i * 8);
        kp += (size_t)64 * ldk; };
    auto loadV = [&]() {
#pragma unroll
        for (int i = 0; i < NVR; ++i) vreg[i] = *(const u32x4*)(vp0 + i * 8);
        vp0 += 64; };
    auto storeK = [&](int buf) {
#pragma unroll
        for (int i = 0; i < NKR; ++i) *(u32x4*)(sm + buf * KBUF + klo + i * 8) = kreg[i]; };
    auto storeV = [&](int buf) {
        bf16_t* vrow = sm + buf * VBUF + 2 * KBUF + (tid / VTPR) * VLD;
#pragma unroll
        for (int i = 0; i < NVR; ++i) {
            const int c = (tid % VTPR) * NVR + i;
#pragma unroll
            for (int hh = 0; hh < 2; ++hh) {
                const int g = 2 * c + hh; const int blk = g >> 3, g32 = g & 7; const int pos = blk * 32 + (2 * (g32 & 3) + (g32 >> 2)) * 4;
                u32x2 w; w.x = hh ? vreg[i].z : vreg[i].x; w.y = hh ? vreg[i].w : vreg[i].y;
                *(u32x2*)(vrow + pos) = w;
            }
        } };
    float al[QT], thr[QT], mxs[QT]; bool resc = false;
#pragma unroll
    for (int qt = 0; qt < QT; ++qt) { al[qt] = 1.f; thr[qt] = 0.f; mxs[qt] = 0.f; }
    auto sm_step = [&](int k, f32x4 (&sn)[4][QT], Frag (&pfn)[QT][2], const bool force) {
        if (k < QT) {
            const int qt = k;
            float mx = max3f(sn[0][qt][0], sn[0][qt][1], sn[0][qt][2]);
            mx = max3f(mx, sn[0][qt][3], sn[1][qt][0]); mx = max3f(mx, sn[1][qt][1], sn[1][qt][2]); mx = max3f(mx, sn[1][qt][3], sn[2][qt][0]);
            mx = max3f(mx, sn[2][qt][1], sn[2][qt][2]); mx = max3f(mx, sn[2][qt][3], sn[3][qt][0]); mx = max3f(mx, sn[3][qt][1], sn[3][qt][2]);
            mxs[qt] = max2f(mx, sn[3][qt][3]);
        } else if (k == QT) {
            bool need = false;
#pragma unroll
            for (int qt = 0; qt < QT; ++qt) need = need || (mxs[qt] > thr[qt]);
            if (force || wave_any(need)) {
#pragma unroll
                for (int qt = 0; qt < QT; ++qt) {
                    float mx = xmax16(mxs[qt]); mx = xmax32(mx);
                    const float mn = fmaxf(st.m[0][qt], mx * sc2);
                    al[qt] *= __builtin_amdgcn_exp2f(st.m[0][qt] - mn);
                    st.m[0][qt] = mn; thr[qt] = (mn + TH) * isc2;
                }
                resc = true;
            }
        } else if (k <= 5 * QT) {
            const int qt = (k - QT - 1) >> 2, kt = (k - QT - 1) & 3; const float mn = st.m[0][qt];
#pragma unroll
            for (int jj = 0; jj < 4; ++jj) sn[kt][qt][jj] = __builtin_amdgcn_exp2f(sn[kt][qt][jj] * sc2 - mn);
        } else if (k <= 7 * QT) {
            const int qt = (k - 5 * QT - 1) >> 1, kk = (k - 5 * QT - 1) & 1;
            pfn[qt][kk].u[0] = pack2(sn[2 * kk][qt][0], sn[2 * kk][qt][1]); pfn[qt][kk].u[1] = pack2(sn[2 * kk][qt][2], sn[2 * kk][qt][3]);
            pfn[qt][kk].u[2] = pack2(sn[2 * kk + 1][qt][0], sn[2 * kk + 1][qt][1]); pfn[qt][kk].u[3] = pack2(sn[2 * kk + 1][qt][2], sn[2 * kk + 1][qt][3]);
#ifndef CPU_EMU
            asm volatile("" : "+v"(pfn[qt][kk].u[0]), "+v"(pfn[qt][kk].u[1]), "+v"(pfn[qt][kk].u[2]), "+v"(pfn[qt][kk].u[3]));
#endif
        }
    };
    constexpr int NSM = 7 * QT + 1;
    auto rescale = [&]() {
        if (resc) {
#pragma unroll
            for (int qt = 0; qt < QT; ++qt) {
#pragma unroll
                for (int et = 0; et < DV / 16; ++et) { st.O[0][et][qt][0] *= al[qt]; st.O[0][et][qt][1] *= al[qt]; st.O[0][et][qt][2] *= al[qt]; st.O[0][et][qt][3] *= al[qt]; }
                st.L[0][qt][0] *= al[qt]; st.L[0][qt][1] *= al[qt]; st.L[0][qt][2] *= al[qt]; st.L[0][qt][3] *= al[qt];
                al[qt] = 1.f;
            }
            resc = false;
        }
    };
    auto pv = [&](int buf, const Frag (&pf)[QT][2]) {
        const bf16_t* Vs = sm + 2 * KBUF + buf * VBUF;
#pragma unroll
        for (int kk = 0; kk < 2; ++kk)
#pragma unroll
            for (int qt = 0; qt < QT; ++qt) st.L[0][qt] = mfma16(ones.v, pf[qt][kk].v, st.L[0][qt]);
#pragma unroll
        for (int et = 0; et < DV / 16; ++et) {
#pragma unroll
            for (int kk = 0; kk < 2; ++kk) {
                Frag vf; vf.q = *(const u32x4*)(Vs + (et * 16 + r) * VLD + kk * 32 + quad * 8);
#pragma unroll
                for (int qt = 0; qt < QT; ++qt) st.O[0][et][qt] = mfma16(vf.v, pf[qt][kk].v, st.O[0][et][qt]);
            }
        } };
    Frag pfa[QT][2], pfb[QT][2];
    loadK();
    __syncthreads();
    storeK(0);
    loadK();
    loadV();
    __syncthreads();
    {
        f32x4 s0[4][QT];
        const bf16_t* Ks = sm;
#pragma unroll
        for (int kt = 0; kt < 4; ++kt) {
            Frag ka0, ka1;
            ka0.q = *(const u32x4*)(Ks + (kt * 16 + r) * KLD + koff + quad * 8);
            ka1.q = *(const u32x4*)(Ks + (kt * 16 + r) * KLD + koff + 32 + quad * 8);
#pragma unroll
            for (int qt = 0; qt < QT; ++qt) {
                f32x4 z = f32x4{0.f, 0.f, 0.f, 0.f};
                z = mfma16(ka0.v, qf[0][0][qt].v, z); z = mfma16(ka1.v, qf[0][1][qt].v, z); s0[kt][qt] = z;
            }
        }
#pragma unroll
        for (int k = 0; k < NSM; ++k) sm_step(k, s0, pfa, true);
    }
    storeK(1);
    storeV(0);
    __syncthreads();
    auto body = [&](const int par, const Frag (&pin)[QT][2], Frag (&pout)[QT][2]) {
        f32x4 sn[4][QT];
        rescale();
        {
            const bf16_t* Ks = sm + ((par + 1) & 1) * KBUF + r * KLD + koff + quad * 8;
            Frag ka[2][2];
            ka[0][0].q = *(const u32x4*)(Ks); ka[0][1].q = *(const u32x4*)(Ks + 32);
#pragma unroll
            for (int kt = 0; kt < 4; ++kt) {
                if (kt < 3) { ka[(kt + 1) & 1][0].q = *(const u32x4*)(Ks + (kt + 1) * 16 * KLD); ka[(kt + 1) & 1][1].q = *(const u32x4*)(Ks + (kt + 1) * 16 * KLD + 32); }
#pragma unroll
                for (int qt = 0; qt < QT; ++qt) {
                    f32x4 z = f32x4{0.f, 0.f, 0.f, 0.f};
                    z = mfma16(ka[kt & 1][0].v, qf[0][0][qt].v, z);
                    z = mfma16(ka[kt & 1][1].v, qf[0][1][qt].v, z); sn[kt][qt] = z;
                }
                if (kt < 2) {
#pragma unroll
                    for (int qt = 0; qt < QT; ++qt) st.L[0][qt] = mfma16(ones.v, pin[qt][kt].v, st.L[0][qt]);
                }
                SCHED_BARRIER();
            }
        }
        {
            const bf16_t* Vs = sm + 2 * KBUF + (par & 1) * VBUF + r * VLD + quad * 8;
            constexpr int NPV = (DV / 16) * 2; constexpr int SPP = (NSM + NPV - 1) / NPV;
            Frag vf[2];
            vf[0].q = *(const u32x4*)Vs;
#pragma unroll
            for (int i = 0; i < NPV; ++i) {
                const int et = i >> 1, kk = i & 1;
                if (i + 1 < NPV) vf[(i + 1) & 1].q = *(const u32x4*)(Vs + ((i + 1) >> 1) * 16 * VLD + ((i + 1) & 1) * 32);
#pragma unroll
                for (int qt = 0; qt < QT; ++qt) st.O[0][et][qt] = mfma16(vf[i & 1].v, pin[qt][kk].v, st.O[0][et][qt]);
#pragma unroll
                for (int q = 0; q < SPP; ++q) sm_step(i * SPP + q, sn, pout, false);
                SCHED_BARRIER();
            }
        }
    };
    int j = 0;
    for (; j + 2 < nt; j += 2) {
        loadK(); loadV();
        body(0, pfa, pfb);
        storeK(0); storeV(1);
        __syncthreads();
        loadK(); loadV();
        body(1, pfb, pfa);
        storeK(1); storeV(0);
        __syncthreads();
    }
    loadV(); body(0, pfa, pfb); storeV(1); __syncthreads();
    rescale();
    pv(1, pfb);
    __syncthreads();
}

DEV void attn_diff_item(const Params& p, int layer, int item, bf16_t* sm) {
    const int nqb = TT / 64; const int qb = item % nqb, h = (item / nqb) % HA, b = item / (nqb * HA);
    const int tid = tid_(), wid = tid >> 6, lane = tid & 63, r = lane & 15, quad = lane >> 4;
    const int comp = wid & 1, rg = wid >> 1;
    const int s0 = qb * 64; const bool ctxq = s0 < CTX; const int nkeys = ctxq ? CTX : TT;
    Frag qf[1][2][2];
#pragma unroll
    for (int ks = 0; ks < 2; ++ks)
#pragma unroll
        for (int qt = 0; qt < 2; ++qt) qf[0][ks][qt].q = *(const u32x4*)(p.Q1 + ((size_t)b * TT + s0 + rg * 32 + qt * 16 + r) * 512 + h * 128 + comp * 64 + ks * 32 + quad * 8);
    AttnState<1, 128, 2> st;
#pragma unroll
    for (int qt = 0; qt < 2; ++qt) {
        st.m[0][qt] = -1.0e30f; st.L[0][qt] = f32x4{0.f, 0.f, 0.f, 0.f};
#pragma unroll
        for (int et = 0; et < 8; ++et) st.O[0][et][qt] = f32x4{0.f, 0.f, 0.f, 0.f};
    }
    attn_core<1, 128, 2, 128>(sm, p.K1 + (size_t)b * TT * 512 + h * 128, 512, p.V1T + ((size_t)(b * HA + h) * 128) * TT, nkeys, qf, st, 0.125f * 1.4426950408889634f, comp * 64);
    const float lam = p.LAM[layer >> 1]; const float lam_init = 0.8f - 0.6f * expf(-0.3f * (float)layer);
    const float* sg = p.ev_subln_g + (layer >> 1) * 128;
    f32x4* xo = (f32x4*)sm;
    __syncthreads();
    if (comp == 1) {
#pragma unroll
        for (int qt = 0; qt < 2; ++qt) {
            const float i2 = lam / st.L[0][qt][0];
#pragma unroll
            for (int et = 0; et < 8; ++et) xo[((rg * 2 + qt) * 8 + et) * 64 + lane] = f32x4{st.O[0][et][qt][0] * i2, st.O[0][et][qt][1] * i2, st.O[0][et][qt][2] * i2, st.O[0][et][qt][3] * i2};
        }
    }
    __syncthreads();
    if (comp == 0) {
#pragma unroll
        for (int qt = 0; qt < 2; ++qt) {
            const float i1 = 1.f / st.L[0][qt][0];
            float ss = 0.f; f32x4 o[8];
#pragma unroll
            for (int et = 0; et < 8; ++et) {
                const f32x4 x2 = xo[((rg * 2 + qt) * 8 + et) * 64 + lane];
#pragma unroll
                for (int j = 0; j < 4; ++j) { float v = st.O[0][et][qt][j] * i1 - x2[j]; o[et][j] = v; ss += v * v; }
            }
            ss = xadd16(ss); ss = xadd32(ss);
            const float rs = (1.f - lam_init) / sqrtf(ss * (1.f / 128.f) + EPS);
            bf16_t* dst = p.CAT + ((size_t)b * TT + s0 + rg * 32 + qt * 16 + r) * 1024 + h * 128;
#pragma unroll
            for (int et = 0; et < 8; ++et) {
                const int e = et * 16 + quad * 4;
                u32x2 w; w.x = pack2(o[et][0] * rs * sg[e], o[et][1] * rs * sg[e + 1]); w.y = pack2(o[et][2] * rs * sg[e + 2], o[et][3] * rs * sg[e + 3]);
                *(u32x2*)(dst + e) = w;
            }
        }
    }
}

DEV void attn_gqa_item(const Params& p, int item, bf16_t* sm) {
    const int nqb = TT / 32; const int qb = item % nqb, kv = (item / nqb) % HKV, b = item / (nqb * HKV);
    const int tid = tid_(), wid = tid >> 6, lane = tid & 63, r = lane & 15, quad = lane >> 4;
    const int s0 = qb * 32; const bool ctxq = s0 < CTX; const int nkeys = ctxq ? CTX : TT; const int hq = kv * 4 + wid;
    Frag qf[1][2][2];
#pragma unroll
    for (int ks = 0; ks < 2; ++ks)
#pragma unroll
        for (int qt = 0; qt < 2; ++qt) qf[0][ks][qt].q = *(const u32x4*)(p.Q1 + ((size_t)b * TT + s0 + qt * 16 + r) * 512 + hq * 64 + ks * 32 + quad * 8);
    AttnState<1, 64, 2> st;
#pragma unroll
    for (int qt = 0; qt < 2; ++qt) {
        st.m[0][qt] = -1.0e30f; st.L[0][qt] = f32x4{0.f, 0.f, 0.f, 0.f};
#pragma unroll
        for (int et = 0; et < 4; ++et) st.O[0][et][qt] = f32x4{0.f, 0.f, 0.f, 0.f};
    }
    attn_core<1, 64, 2, 64>(sm, p.K1 + (size_t)b * TT * 128 + kv * 64, 128, p.V1T + ((size_t)(b * HKV + kv) * 64) * TT, nkeys, qf, st, 0.125f * 1.4426950408889634f, 0);
#pragma unroll
    for (int qt = 0; qt < 2; ++qt) {
        const float il = 1.f / st.L[0][qt][0];
        bf16_t* dst = p.CAT + ((size_t)b * TT + s0 + qt * 16 + r) * 1024 + 512 + hq * 64;
#pragma unroll
        for (int et = 0; et < 4; ++et) {
            const int e = et * 16 + quad * 4;
            u32x2 w; w.x = pack2(st.O[0][et][qt][0] * il, st.O[0][et][qt][1] * il); w.y = pack2(st.O[0][et][qt][2] * il, st.O[0][et][qt][3] * il);
            *(u32x2*)(dst + e) = w;
        }
    }
}

template <int DK, bool NRM>
DEV void rec_dc_item(const Params& p, int item, bf16_t* sm) {
    constexpr int ET = NRM ? 9 : 8; constexpr int ER = NRM ? EVR : 128; constexpr int SLD = 136;
    const int chain = item / NCH, sp = item % NCH; const int dir = chain & 1, h = (chain >> 1) & 3, b = chain >> 3;
    const int u = chunk_of(dir, sp), sbase = u * CH;
    const int tid = tid_(), wid = tid >> 6, lane = tid & 63, r = lane & 15, quad = lane >> 4;
    bf16_t* Vs = sm; bf16_t* Ks = sm + 128 * SLD; float* wk = (float*)(sm + 128 * SLD + DK * SLD);
    __syncthreads();
    float ms1, ms2;
    if (NRM) {
        const float* c2 = p.CH2 + (size_t)chain * NCH * 2;
        const float be = lane < NCH ? c2[lane * 2] : 0.f, am = lane < NCH ? c2[lane * 2 + 1] : 0.f;
        float m = 0.f, mp = 0.f, bq = 0.f;
        for (int q = 0; q <= sp; ++q) { bq = lane_read(be, q, lane); const float aq = lane_read(am, q, lane); mp = m; m = fmaxf(bq + m, bq + aq); }
        ms1 = m; ms2 = bq;
        if (tid == 0) { float* mo = p.MS + ((size_t)chain * NCH + sp) * 4; mo[0] = mp; mo[1] = m; mo[2] = bq; mo[3] = __expf(bq + mp - m); }
    } else { const float* ms = p.MS + ((size_t)chain * NCH + sp) * 4; ms1 = ms[1]; ms2 = ms[2]; }
    if (tid < 128) wk[tid] = __expf(ms2 + p.AT[(size_t)chain * TT + sbase + tid] - ms1);
    const bf16_t* kg = p.K2 + ((size_t)b * TT + sbase) * (4 * DK) + h * DK;
    constexpr int NKC = 128 * (DK / 8) / 256;
    Frag kpre[NKC];
#pragma unroll
    for (int i = 0; i < NKC; ++i) { const int c = tid + 256 * i; const int sl = c & 127, dc8 = (c >> 7) * 8; kpre[i].q = *(const u32x4*)(kg + (size_t)sl * (4 * DK) + dc8); }
    const bf16_t* vt = p.V2T + ((size_t)(b * 4 + h) * 128) * TT + sbase;
    for (int c = tid; c < 128 * 16; c += 256) { int row = c >> 4, kc = c & 15; *(u32x4*)(Vs + row * SLD + kc * 8) = *(const u32x4*)(vt + (size_t)row * TT + kc * 8); }
    __syncthreads();
#pragma unroll
    for (int ii = 0; ii < NKC; ++ii) {
        const int c = tid + 256 * ii; const int sl = c & 127, dc8 = (c >> 7) * 8; const Frag f = kpre[ii];
        const float w = wk[sl];
#pragma unroll
        for (int i = 0; i < 8; ++i) Ks[(dc8 + i) * SLD + sl] = f2bf(bf2f((bf16_t)f.v[i]) * w);
    }
    __syncthreads();
    constexpr int NTW = DK / 64;
    f32x4 acc[ET][NTW];
#pragma unroll
    for (int et = 0; et < ET; ++et)
#pragma unroll
        for (int n = 0; n < NTW; ++n) acc[et][n] = f32x4{0.f, 0.f, 0.f, 0.f};
#pragma unroll
    for (int ks = 0; ks < 4; ++ks) {
        Frag bf[NTW];
#pragma unroll
        for (int n = 0; n < NTW; ++n) bf[n].q = *(const u32x4*)(Ks + ((wid + 4 * n) * 16 + r) * SLD + ks * 32 + quad * 8);
#pragma unroll
        for (int et = 0; et < ET; ++et) {
            Frag af;
            if (et < 8) af.q = *(const u32x4*)(Vs + (et * 16 + r) * SLD + ks * 32 + quad * 8);
            else { const unsigned one = (r == 0) ? 0x3F803F80u : 0u; af.q = u32x4{one, one, one, one}; }
#pragma unroll
            for (int n = 0; n < NTW; ++n) acc[et][n] = mfma16(bf[n].v, af.v, acc[et][n]);
        }
    }
    bf16_t* dc = p.DC + ((size_t)chain * NCH + sp) * ER * DK;
#pragma unroll
    for (int et = 0; et < ET; ++et)
#pragma unroll
        for (int n = 0; n < NTW; ++n) {
            u32x2 w; w.x = pack2(acc[et][n][0], acc[et][n][1]); w.y = pack2(acc[et][n][2], acc[et][n][3]);
            *(u32x2*)(dc + (size_t)(et * 16 + r) * DK + (wid + 4 * n) * 16 + quad * 4) = w;
        }
}

template <int DK, bool NRM>
DEV void rec_scan(const Params& p) {
    constexpr int ER = NRM ? EVR : 128; constexpr int EPC = ER * DK; constexpr int PD = 4;
    const int total = NCHAIN * (EPC / 8);
    for (int idx = bid_() * 256 + tid_(); idx < total; idx += gridDim.x * 256) {
        const int chain = idx / (EPC / 8), el = (idx % (EPC / 8)) * 8;
        const bf16_t* dc = p.DC + (size_t)chain * NCH * EPC + el; bf16_t* cp = p.CP + (size_t)chain * NCH * EPC + el;
        const float* ms = p.MS + (size_t)chain * NCH * 4 + 3;
        float c[8];
#pragma unroll
        for (int i = 0; i < 8; ++i) c[i] = 0.f;
        u32x4 q[PD]; float cr[PD];
#pragma unroll
        for (int i = 0; i < PD; ++i) if (i < NCH) { q[i] = *(const u32x4*)(dc + (size_t)i * EPC); cr[i] = ms[i * 4]; }
#pragma unroll 1
        for (int g = 0; g < NCH; g += PD)
#pragma unroll
        for (int i = 0; i < PD; ++i) {
            const int sp = g + i; if (sp >= NCH) break;
            const u32x4 d = q[i]; const float car = cr[i];
            if (sp + PD < NCH) { q[i] = *(const u32x4*)(dc + (size_t)(sp + PD) * EPC); cr[i] = ms[(sp + PD) * 4]; }
            u32x4 o; o.x = pack2(c[0], c[1]); o.y = pack2(c[2], c[3]); o.z = pack2(c[4], c[5]); o.w = pack2(c[6], c[7]);
            *(u32x4*)(cp + (size_t)sp * EPC) = o;
            c[0] = car * c[0] + __uint_as_float(d.x << 16); c[1] = car * c[1] + __uint_as_float(d.x & 0xFFFF0000u);
            c[2] = car * c[2] + __uint_as_float(d.y << 16); c[3] = car * c[3] + __uint_as_float(d.y & 0xFFFF0000u);
            c[4] = car * c[4] + __uint_as_float(d.z << 16); c[5] = car * c[5] + __uint_as_float(d.z & 0xFFFF0000u);
            c[6] = car * c[6] + __uint_as_float(d.w << 16); c[7] = car * c[7] + __uint_as_float(d.w & 0xFFFF0000u);
        }
    }
}

template <int DK, bool NRM>
DEV void rec_out_item(const Params& p, int layer, int item, bf16_t* sm) {
    constexpr int ET = NRM ? 9 : 8; constexpr int ER = NRM ? EVR : 128; constexpr int KLD = DK + 8; constexpr int SLD = 136; constexpr int NKS = DK / 32;
    const int half = item & 1, u = (item >> 1) % NCH, h = ((item >> 1) / NCH) & 3, b = (item >> 1) / (NCH * 4);
    const int tid = tid_(), wid = tid >> 6, lane = tid & 63, r = lane & 15, quad = lane >> 4;
    const int sbase = u * CH; const int tl = half * 64 + wid * 16 + r;
    const size_t rowt = (size_t)b * TT + sbase + tl; const int tq = tl - quad * 4;
    bf16_t* RA = sm; bf16_t* Vs = sm + ER * KLD; float* as_ = (float*)(Vs + 128 * SLD);
    __syncthreads();
    const bf16_t* kg = p.K2 + ((size_t)b * TT + sbase) * (4 * DK) + h * DK;
    for (int c = tid; c < 128 * (DK / 8); c += 256) { int row = c / (DK / 8), kc = c % (DK / 8); *(u32x4*)(RA + row * KLD + kc * 8) = *(const u32x4*)(kg + (size_t)row * (4 * DK) + kc * 8); }
    const int chain0 = (b * 4 + h) * 2;
    as_[tid] = p.AT[(size_t)(chain0 + (tid >> 7)) * TT + sbase + (tid & 127)];
    Frag qf[NKS];
#pragma unroll
    for (int ks = 0; ks < NKS; ++ks) qf[ks].q = *(const u32x4*)(p.Q2 + rowt * (4 * DK) + h * DK + ks * 32 + quad * 8);
    const bf16_t* vt = p.V2T + ((size_t)(b * 4 + h) * 128) * TT + sbase;
    u32x4 vpre[8];
#pragma unroll
    for (int i = 0; i < 8; ++i) { const int c = tid + 256 * i; const int row = c >> 4, kc = c & 15; vpre[i] = *(const u32x4*)(vt + (size_t)row * TT + kc * 8); }
    constexpr int NCPC = ER * (DK / 8), NCPI = (NCPC + 255) / 256;
    u32x4 cpre[NCPI];
    {
        const bf16_t* cp0 = p.CP + ((size_t)chain0 * NCH + sp_of(0, u)) * ER * DK;
#pragma unroll
        for (int i = 0; i < NCPI; ++i) { const int c = tid + 256 * i; if (c < NCPC) { const int row = c / (DK / 8), kc = c % (DK / 8); cpre[i] = *(const u32x4*)(cp0 + (size_t)row * DK + kc * 8); } }
    }
    __syncthreads();
    f32x4 sT[8];
#pragma unroll
    for (int st = 0; st < 8; ++st) {
        if ((st & 1) == 0) SCHED_BARRIER();
        f32x4 z = f32x4{0.f, 0.f, 0.f, 0.f};
#pragma unroll
        for (int ks = 0; ks < NKS; ++ks) { Frag ka; ka.q = *(const u32x4*)(RA + (st * 16 + r) * KLD + ks * 32 + quad * 8); z = mfma16(ka.v, qf[ks].v, z); }
        sT[st] = z;
    }
    __syncthreads();
#pragma unroll
    for (int i = 0; i < 8; ++i) { const int c = tid + 256 * i; const int row = c >> 4, kc = c & 15; *(u32x4*)(Vs + row * SLD + kc * 8) = vpre[i]; }
    f32x4 hs[8];
#pragma unroll
    for (int et = 0; et < 8; ++et) hs[et] = f32x4{0.f, 0.f, 0.f, 0.f};
#pragma unroll 1
    for (int dir = 0; dir < 2; ++dir) {
        const int chain = chain0 + dir; const int sp = sp_of(dir, u);
        if (dir) __syncthreads();
#pragma unroll
        for (int i = 0; i < NCPI; ++i) { const int c = tid + 256 * i; if (c < NCPC) { const int row = c / (DK / 8), kc = c % (DK / 8); *(u32x4*)(RA + row * KLD + kc * 8) = cpre[i]; } }
        __syncthreads();
        if (dir == 0) {
            const bf16_t* cp1 = p.CP + ((size_t)(chain0 + 1) * NCH + sp_of(1, u)) * ER * DK;
#pragma unroll
            for (int i = 0; i < NCPI; ++i) { const int c = tid + 256 * i; if (c < NCPC) { const int row = c / (DK / 8), kc = c % (DK / 8); cpre[i] = *(const u32x4*)(cp1 + (size_t)row * DK + kc * 8); } }
        }
        const float mprev = p.MS[((size_t)chain * NCH + sp) * 4];
        const float bt = p.BC[(size_t)chain * TT + sbase + tl], mtr = p.MT[(size_t)chain * TT + sbase + tl];
        const float mt = NRM ? bt + fmaxf(mprev, mtr) : mtr;
        const float winter = __expf(bt + mprev - mt); const float ct = bt - mt;
        f32x4 acc[ET];
#pragma unroll
        for (int et = 0; et < ET; ++et) {
            if ((et & 1) == 0) SCHED_BARRIER();
            f32x4 z = f32x4{0.f, 0.f, 0.f, 0.f};
#pragma unroll
            for (int ks = 0; ks < NKS; ++ks) { Frag ca; ca.q = *(const u32x4*)(RA + (et * 16 + r) * KLD + ks * 32 + quad * 8); z = mfma16(ca.v, qf[ks].v, z); }
            acc[et] = f32x4{z[0] * winter, z[1] * winter, z[2] * winter, z[3] * winter};
        }
#pragma unroll
        for (int kk = 0; kk < 4; ++kk) {
            SCHED_BARRIER();
            Frag pf;
#pragma unroll
            for (int hf = 0; hf < 2; ++hf) {
                const int st = 2 * kk + hf; float w[4];
#pragma unroll
                for (int j = 0; j < 4; ++j) {
                    const int s = st * 16 + quad * 4 + j; const bool ok = dir ? ((st * 16 + j) >= tq) : ((st * 16 + j) <= tq);
                    w[j] = ok ? sT[st][j] * __expf(ct + as_[dir * 128 + s]) : 0.f;
                }
                pf.u[2 * hf] = pack2(w[0], w[1]); pf.u[2 * hf + 1] = pack2(w[2], w[3]);
            }
#pragma unroll
            for (int et = 0; et < ET; ++et) {
                Frag vf;
                if (et < 8) { const bf16_t* vp = Vs + (et * 16 + r) * SLD + kk * 32 + quad * 4; vf.d[0] = *(const u32x2*)vp; vf.d[1] = *(const u32x2*)(vp + 16); }
                else { const unsigned one = (r == 0) ? 0x3F803F80u : 0u; vf.q = u32x4{one, one, one, one}; }
                acc[et] = mfma16(vf.v, pf.v, acc[et]);
            }
        }
        if (NRM) {
            float den = lane_read(acc[ET - 1][0], r, lane);
            const float dn = 1.f / fmaxf(fabsf(den), __expf(-mt));
#pragma unroll
            for (int et = 0; et < 8; ++et) { hs[et][0] += acc[et][0] * dn; hs[et][1] += acc[et][1] * dn; hs[et][2] += acc[et][2] * dn; hs[et][3] += acc[et][3] * dn; }
        } else {
#pragma unroll
            for (int et = 0; et < 8; ++et) { hs[et][0] += acc[et][0]; hs[et][1] += acc[et][1]; hs[et][2] += acc[et][2]; hs[et][3] += acc[et][3]; }
        }
    }
    if (NRM) {
        const bf16_t* og = p.OG + rowt * 512 + h * 128; const float* g = p.ev_mnorm_g + (layer >> 1) * 512 + h * 128;
        float sum = 0.f;
#pragma unroll
        for (int et = 0; et < 8; ++et) {
            const u32x2 gq = *(const u32x2*)(og + et * 16 + quad * 4);
            hs[et][0] *= sigmf(bf2f((bf16_t)(gq.x & 0xFFFF))); hs[et][1] *= sigmf(bf2f((bf16_t)(gq.x >> 16)));
            hs[et][2] *= sigmf(bf2f((bf16_t)(gq.y & 0xFFFF))); hs[et][3] *= sigmf(bf2f((bf16_t)(gq.y >> 16)));
            sum += hs[et][0] + hs[et][1] + hs[et][2] + hs[et][3];
        }
        sum = xadd16(sum); sum = xadd32(sum);
        const float mu = sum * (1.f / 128.f); float var = 0.f;
#pragma unroll
        for (int et = 0; et < 8; ++et)
#pragma unroll
            for (int j = 0; j < 4; ++j) { float d = hs[et][j] - mu; var += d * d; }
        var = xadd16(var); var = xadd32(var);
        const float rs = 1.f / sqrtf(var * (1.f / 128.f) + EPS);
        bf16_t* dst = p.CAT + rowt * 1024 + 512 + h * 128;
#pragma unroll
        for (int et = 0; et < 8; ++et) {
            const int e = et * 16 + quad * 4;
            u32x2 w; w.x = pack2((hs[et][0] - mu) * rs * g[e], (hs[et][1] - mu) * rs * g[e + 1]); w.y = pack2((hs[et][2] - mu) * rs * g[e + 2], (hs[et][3] - mu) * rs * g[e + 3]);
            *(u32x2*)(dst + e) = w;
        }
    } else {
        const bf16_t* og = p.OG + rowt * 512 + h * 128;
        float ss = 0.f;
#pragma unroll
        for (int et = 0; et < 8; ++et)
#pragma unroll
            for (int j = 0; j < 4; ++j) ss += hs[et][j] * hs[et][j];
        ss = xadd16(ss); ss = xadd32(ss);
        const float rs = 1.f / sqrtf(ss * (1.f / 128.f) + EPS);
        bf16_t* dst = p.CAT + rowt * 1024 + h * 128;
#pragma unroll
        for (int et = 0; et < 8; ++et) {
            const int e = et * 16 + quad * 4; const u32x2 gq = *(const u32x2*)(og + e);
            u32x2 w; w.x = pack2(hs[et][0] * rs * siluf(bf2f((bf16_t)(gq.x & 0xFFFF))), hs[et][1] * rs * siluf(bf2f((bf16_t)(gq.x >> 16))));
            w.y = pack2(hs[et][2] * rs * siluf(bf2f((bf16_t)(gq.y & 0xFFFF))), hs[et][3] * rs * siluf(bf2f((bf16_t)(gq.y >> 16))));
            *(u32x2*)(dst + e) = w;
        }
    }
}

DEV void phaseC(const Params& p, int layer, unsigned char* smem) {
    const bool odd = layer & 1; const bool with_ctx = layer < DEPTH - 1;
    bf16_t* sm = (bf16_t*)smem;
    const int nqb_l = odd ? SEQ / 32 : SEQ / 64, nqb_c = odd ? CTX / 32 : CTX / 64; const int nh = odd ? HKV : HA;
    const int n_lat = BATCH * nh * nqb_l, n_ctx = with_ctx ? BATCH * nh * nqb_c : 0; const int n_dc = NCHAIN * NCH;
    for (int it = bid_(); it < n_lat + n_ctx + n_dc; it += gridDim.x) {
        if (it < n_lat + n_ctx) {
            int qb, bh;
            if (it < n_lat) {
                const int nbh = BATCH * nh;
                if ((nbh & 7) == 0 && (gridDim.x & 7) == 0) { const int x = it & 7, j = it >> 3; bh = (j / nqb_l) * 8 + x; qb = nqb_c + j % nqb_l; }
                else { qb = nqb_c + it % nqb_l; bh = it / nqb_l; }
            } else { int i2 = it - n_lat; qb = i2 % nqb_c; bh = i2 / nqb_c; }
            const int item = bh * (nqb_l + nqb_c) + qb;
            if (odd) attn_gqa_item(p, item, sm); else attn_diff_item(p, layer, item, sm);
        } else {
            const int item = it - n_lat - n_ctx;
            if (odd) rec_dc_item<64, false>(p, item, sm); else rec_dc_item<128, true>(p, item, sm);
        }
    }
}
DEV void phaseD(const Params& p, int layer) { if (layer & 1) rec_scan<64, false>(p); else rec_scan<128, true>(p); }
DEV void phaseE(const Params& p, int layer, unsigned char* smem) {
    const bool odd = layer & 1; const bool with_ctx = layer < DEPTH - 1;
    const int n = BATCH * 4 * NCH * 2;
    for (int it = bid_(); it < n; it += gridDim.x) {
        const int u = (it >> 1) % NCH; if (!with_ctx && u < NCC) continue;
        if (odd) rec_out_item<64, false>(p, layer, it, (bf16_t*)smem); else rec_out_item<128, true>(p, layer, it, (bf16_t*)smem);
    }
}

#ifdef CPU_EMU_SMALL
constexpr int FM_T = 16;
#else
constexpr int FM_T = 17;
#endif
constexpr int F_ROWS = 16 * FM_T, F_NA = 4 * F_ROWS, F_NCH = F_NA + 512, F_STAGE = F_NCH * 16, F_NJ = (F_NCH + 255) / 256;
static_assert(NTOK % F_ROWS == 0 && TT % F_ROWS == 0, "tall output-projection tiles must not straddle sequences");
static_assert(3 * F_STAGE <= LDS_BYTES - 16, "LDS ring of the tall tile");
DEV void phaseF(const Params& p, int layer, unsigned char* smem) {
    const bool with_ctx = layer < DEPTH - 1; const int ncol = D_MODEL / 128, nrow = NTOK / F_ROWS;
    const int tid = tid_(), wid = tid >> 6, lane = tid & 63, r = lane & 15, quad = lane >> 4;
    const int lc8 = g2_lc(tid) * 8;
    const WorkRange wr = xcd_range(nrow * ncol, bid_());
    for (int t = wr.lo; t < wr.hi; t += wr.step) {
        int rt, ct;
        if ((nrow & 7) == 0) { const int rpg = nrow >> 3; const int rg = t / (ncol * rpg), q = t % (ncol * rpg); ct = q / rpg; rt = rg * rpg + q % rpg; } else { rt = t / ncol; ct = t % ncol; }
        const int row0 = rt * F_ROWS, col0 = ct * 128; const int b = row0 / TT, s0 = row0 % TT;
        if (!with_ctx && s0 + F_ROWS <= CTX) continue;
        const bf16_t* abase = p.CAT + (size_t)(row0 + (tid >> 2)) * MIX_OUT + lc8;
        const bf16_t* bbase = p.WoutT + ((size_t)layer * D_MODEL + col0 + (tid >> 2)) * MIX_OUT + lc8;
        constexpr int JMIX = F_NA / 256;
        const bf16_t* mbase = (F_NA % 256 != 0 && tid < F_NA - 256 * JMIX) ? abase + (size_t)JMIX * 64 * MIX_OUT : bbase + (256 * JMIX - F_NA) / 4 * MIX_OUT;
        f32x4 acc[FM_T][2];
#pragma unroll
        for (int m = 0; m < FM_T; ++m) { acc[m][0] = f32x4{0.f, 0.f, 0.f, 0.f}; acc[m][1] = f32x4{0.f, 0.f, 0.f, 0.f}; }
        unsigned char* dst0 = smem + tid * 16;
        auto issue = [&](int kt, int slot) {
            unsigned char* d = dst0 + slot * F_STAGE;
#pragma unroll
            for (int j = 0; j < F_NJ; ++j) {
                if (256 * j + 255 < F_NA) glds16(abase + (size_t)j * 64 * MIX_OUT + kt * 32, d + j * 4096);
                else if (j == JMIX && F_NA % 256 != 0) glds16(mbase + kt * 32, d + j * 4096);
                else if (256 * j + 255 < F_NCH) glds16(bbase + (256 * j - F_NA) / 4 * MIX_OUT + kt * 32, d + j * 4096);
                else if (tid + 256 * j < F_NCH) glds16(bbase + (256 * j - F_NA) / 4 * MIX_OUT + kt * 32, d + j * 4096);
            }
        };
        constexpr int nkt = MIX_OUT / 32;
        RAW_BARRIER();
        issue(0, 0); issue(1, 1);
        const int pco = (quad ^ g2_h((r >> 2) & 3)) * 16;
        const unsigned char* afr = smem + r * 64 + pco;
        const unsigned char* bfr = smem + F_NA * 16 + (wid * 32 + r) * 64 + pco;
        int slot = 0;
        for (int kt = 0; kt < nkt; ++kt) {
            if (kt + 1 < nkt) wait_vm<6>(); else wait_vm<0>();
            RAW_BARRIER();
            if (kt + 2 < nkt) { int ns = slot + 2; if (ns >= 3) ns -= 3; issue(kt + 2, ns); }
            const unsigned char* as = afr + slot * F_STAGE; const unsigned char* bs = bfr + slot * F_STAGE;
            Frag b0, b1; b0.q = *(const u32x4*)bs; b1.q = *(const u32x4*)(bs + 16 * 64);
#ifndef CPU_EMU
            __builtin_amdgcn_s_setprio(1);
#endif
#pragma unroll
            for (int m = 0; m < FM_T; ++m) {
                Frag af; af.q = *(const u32x4*)(as + m * 16 * 64);
                acc[m][0] = mfma16(b0.v, af.v, acc[m][0]); acc[m][1] = mfma16(b1.v, af.v, acc[m][1]);
            }
#ifndef CPU_EMU
            __builtin_amdgcn_s_setprio(0);
#endif
            if (++slot == 3) slot = 0;
        }
        const float* gl = p.MOD + ((size_t)layer * (BATCH + 1) + b) * 6 * D_MODEL + 2 * D_MODEL; const float* gc = p.MOD + ((size_t)layer * (BATCH + 1) + BATCH) * 6 * D_MODEL + 2 * D_MODEL;
#pragma unroll
        for (int n = 0; n < 2; ++n) {
            const int col = col0 + wid * 32 + n * 16 + quad * 4; const f32x4 g_l = *(const f32x4*)(gl + col), g_c = *(const f32x4*)(gc + col);
#pragma unroll
            for (int m = 0; m < FM_T; ++m) {
                const int s = s0 + m * 16 + r; const bool isc = s < CTX;
                if (with_ctx || !isc) { u32x2* x = (u32x2*)(p.X + (size_t)(row0 + m * 16 + r) * D_MODEL + col); *x = pk4(ALPHA * bf4(*x) + (isc ? g_c : g_l) * acc[m][n]); }
                if ((m & 3) == 3) SCHED_BARRIER();
            }
        }
    }
}

constexpr int NV4 = D_MODEL / 256;
DEV void phaseG(const Params& p, int layer, unsigned char* smem) {
    const bool with_ctx = layer < DEPTH - 1;
    const int tid = tid_(); const int wid = tid >> 6, lane = tid & 63; const int bid = bid_();
    const float* lg = p.ln_g + (size_t)(layer * 2) * D_MODEL; const float* lb = p.ln_b + (size_t)(layer * 2) * D_MODEL;
    const float* wr = p.WrT + (size_t)layer * NR * D_MODEL;
    int* lcnt = (int*)smem; int* lbase = lcnt + 32; int* rec = lbase + 32;
    const int half = gridDim.x * 4, stride = half * 2;
    const int nit = (NTOK - bid * 4 + stride - 1) / stride;
    __syncthreads();
    if (tid < 32) lcnt[tid] = 0;
    for (int i = tid; i < nit * 8; i += 256) rec[i * 8] = -1;
    __syncthreads();
    int tok0 = bid * 4 + wid;
    u32x2 xq[2][NV4];
    auto ldx = [&](int t0) {
#pragma unroll
        for (int u = 0; u < 2; ++u) {
            const int tl = imin(t0 + u * half, NTOK - 1);
#pragma unroll
            for (int i = 0; i < NV4; ++i) xq[u][i] = *(const u32x2*)(p.X + (size_t)tl * D_MODEL + (i * 64 + lane) * 4);
        } };
    if (tok0 < NTOK) ldx(tok0);
    for (int it = 0; tok0 < NTOK; tok0 += stride, ++it) {
        f32x4 v[2][NV4]; int tk[2]; bool ok[2]; const float* mod[2];
#pragma unroll
        for (int u = 0; u < 2; ++u)
#pragma unroll
            for (int i = 0; i < NV4; ++i) v[u][i] = bf4(xq[u][i]);
        if (tok0 + stride < NTOK) ldx(tok0 + stride);
#pragma unroll
        for (int u = 0; u < 2; ++u) {
            const int t = tok0 + u * half; const int tc = imin(t, NTOK - 1); const int b = tc / TT, sq = tc % TT;
            tk[u] = tc; ok[u] = (t < NTOK) && (with_ctx || sq >= CTX);
            mod[u] = p.MOD + ((size_t)layer * (BATCH + 1) + (sq < CTX ? BATCH : b)) * 6 * D_MODEL;
        }
        float mu[2], rs[2];
#pragma unroll
        for (int u = 0; u < 2; ++u) { float sum = 0.f;
#pragma unroll
            for (int i = 0; i < NV4; ++i) sum += v[u][i].x + v[u][i].y + v[u][i].z + v[u][i].w;
            mu[u] = sum; }
        { mu[0] = wsum(mu[0]); mu[1] = wsum(mu[1]); }
#pragma unroll
        for (int u = 0; u < 2; ++u) { mu[u] *= (1.f / D_MODEL); float var = 0.f;
#pragma unroll
            for (int i = 0; i < NV4; ++i) { float a = v[u][i].x - mu[u], bq = v[u][i].y - mu[u], c = v[u][i].z - mu[u], d = v[u][i].w - mu[u]; var += a * a + bq * bq + c * c + d * d; }
            rs[u] = var; }
        { rs[0] = wsum(rs[0]); rs[1] = wsum(rs[1]); }
        f32x4 hv[2][NV4];
#pragma unroll
        for (int u = 0; u < 2; ++u) {
            rs[u] = 1.f / sqrtf(rs[u] * (1.f / D_MODEL) + EPS);
            if (lane == 0 && ok[u]) { p.STAT[tk[u] * 2] = mu[u]; p.STAT[tk[u] * 2 + 1] = rs[u]; }
#pragma unroll
            for (int i = 0; i < NV4; ++i) {
                const int k = (i * 64 + lane) * 4;
                const f32x4 g4 = *(const f32x4*)(lg + k), b4 = *(const f32x4*)(lb + k), sh = *(const f32x4*)(mod[u] + 3 * D_MODEL + k), sc = *(const f32x4*)(mod[u] + 4 * D_MODEL + k);
                const f32x4 x1 = (v[u][i] - mu[u]) * rs[u] * g4 + b4;
                hv[u][i] = x1 * (1.f + sc) + sh;
                if (ok[u]) { u32x2 o; o.x = pack2(hv[u][i].x, hv[u][i].y); o.y = pack2(hv[u][i].z, hv[u][i].w); *(u32x2*)(p.H + (size_t)tk[u] * D_MODEL + k) = o; }
            }
        }
        float gl[2][NG];
#pragma unroll
        for (int j = 0; j < NG; ++j) {
#pragma unroll
            for (int u = 0; u < 2; ++u) { float a = 0.f;
#pragma unroll
                for (int i = 0; i < NV4; ++i) { const f32x4 w4 = *(const f32x4*)(wr + (size_t)j * D_MODEL + (i * 64 + lane) * 4); a += hv[u][i].x * w4.x + hv[u][i].y * w4.y + hv[u][i].z * w4.z + hv[u][i].w * w4.w; }
                gl[u][j] = a; }
        }
#pragma unroll
        for (int j = 0; j < NG; ++j) { gl[0][j] = wsum(gl[0][j]); gl[1][j] = wsum(gl[1][j]); }
        int gi[2]; float gw[2]; float ev[2][EPG];
#pragma unroll
        for (int u = 0; u < 2; ++u) {
#pragma unroll
            for (int j = 0; j < NG; ++j) gl[u][j] += p.moe_b_group[layer * NG + j];
            int g = 0; float gm = gl[u][0];
#pragma unroll
            for (int j = 1; j < NG; ++j) if (gl[u][j] > gm) { gm = gl[u][j]; g = j; }
            float gs = 0.f;
#pragma unroll
            for (int j = 0; j < NG; ++j) gs += expf(gl[u][j] - gm);
            gi[u] = g; gw[u] = 1.f / gs;
            const float* wre = wr + (size_t)(NG + g * EPG) * D_MODEL;
#pragma unroll
            for (int j = 0; j < EPG; ++j) { float a = 0.f;
#pragma unroll
                for (int i = 0; i < NV4; ++i) { const f32x4 w4 = *(const f32x4*)(wre + (size_t)j * D_MODEL + (i * 64 + lane) * 4); a += hv[u][i].x * w4.x + hv[u][i].y * w4.y + hv[u][i].z * w4.z + hv[u][i].w * w4.w; }
                ev[u][j] = a; }
        }
#pragma unroll
        for (int j = 0; j < EPG; ++j) { ev[0][j] = wsum(ev[0][j]); ev[1][j] = wsum(ev[1][j]); }
#pragma unroll
        for (int u = 0; u < 2; ++u) {
#pragma unroll
            for (int j = 0; j < EPG; ++j) ev[u][j] += p.moe_b_router[layer * NE + gi[u] * EPG + j];
            int i1 = 0; float v1 = ev[u][0];
#pragma unroll
            for (int j = 1; j < EPG; ++j) if (ev[u][j] > v1) { v1 = ev[u][j]; i1 = j; }
            int i2 = -1; float v2 = -3.0e38f;
#pragma unroll
            for (int j = 0; j < EPG; ++j) if (j != i1 && ev[u][j] > v2) { v2 = ev[u][j]; i2 = j; }
            const float e2 = expf(v2 - v1); const float w1 = gw[u] / (1.f + e2), w2 = gw[u] * e2 / (1.f + e2);
            if (lane == 0 && ok[u]) {
                const int ea = gi[u] * EPG + i1, eb = gi[u] * EPG + i2;
                const int ra = atomicAdd(lcnt + ea, 1), rb = atomicAdd(lcnt + eb, 1);
                int* rc = rec + ((it * 2 + u) * 4 + wid) * 8;
                rc[0] = tk[u]; rc[1] = ea; rc[2] = eb; rc[3] = ra; rc[4] = rb; rc[5] = (int)__float_as_uint(w1); rc[6] = (int)__float_as_uint(w2);
            }
        }
    }
    __syncthreads();
    if (tid < 32) { const int c = lcnt[tid]; lbase[tid] = c ? atomicAdd(p.CNT + (layer * NE + tid) * 32, c) : 0; }
    __syncthreads();
    for (int i = tid; i < nit * 8; i += 256) {
        const int* rc = rec + i * 8; const int tk = rc[0];
        if (tk >= 0) {
            const int ea = rc[1], eb = rc[2]; const int pa = lbase[ea] + rc[3], pb = lbase[eb] + rc[4];
            p.LIST[(size_t)ea * NTOK + pa] = tk * 2; p.LISTW[(size_t)ea * NTOK + pa] = __uint_as_float((unsigned)rc[5]);
            p.LIST[(size_t)eb * NTOK + pb] = tk * 2 + 1; p.LISTW[(size_t)eb * NTOK + pb] = __uint_as_float((unsigned)rc[6]);
        }
    }
}

struct EpGU {
    const Params& p; int slot0, nvalid, col0;
    DEV void nat(f32x4 (&acc)[4][4], int wr, int wc, int lane) {
        const int r = lane & 15, quad = lane >> 4; const int j0 = (col0 + wc * 64) >> 1;
#pragma unroll
        for (int m = 0; m < 4; ++m) {
            const int rl = wr * 64 + m * 16 + r;
            if (rl < nvalid) {
                bf16_t* d = p.ACT + (size_t)(slot0 + rl) * D_EXPERT + j0 + quad * 4;
#pragma unroll
                for (int n = 0; n < 2; ++n) {
                    u32x2 w; w.x = pack2(siluf(acc[m][n][0]) * acc[m][n + 2][0], siluf(acc[m][n][1]) * acc[m][n + 2][1]);
                    w.y = pack2(siluf(acc[m][n][2]) * acc[m][n + 2][2], siluf(acc[m][n][3]) * acc[m][n + 2][3]);
                    *(u32x2*)(d + n * 16) = w;
                }
            }
        }
    }
    DEV void operator()(f32x4 (&acc)[4][4], int wr, int wc, int lane) {
        const int r = lane & 15, quad = lane >> 4; const int j0 = (col0 + wc * 64) >> 1;
#pragma unroll
        for (int m = 0; m < 4; ++m)
#pragma unroll
            for (int j = 0; j < 4; ++j) {
                const int rl = wr * 64 + m * 16 + quad * 4 + j;
                if (rl < nvalid) {
                    bf16_t* d = p.ACT + (size_t)(slot0 + rl) * D_EXPERT + j0 + r;
                    d[0] = f2bf(siluf(acc[m][0][j]) * acc[m][2][j]); d[16] = f2bf(siluf(acc[m][1][j]) * acc[m][3][j]);
                }
            }
    }
};
struct EpDown {
    const Params& p; const float* lw; const int* lp; int nvalid, col0;
    DEV void nat(f32x4 (&acc)[4][4], int wr, int wc, int lane) {
        const int r = lane & 15, quad = lane >> 4;
#pragma unroll
        for (int m = 0; m < 4; ++m) {
            const int rl = wr * 64 + m * 16 + r;
            if (rl < nvalid) {
                const float w = lw[rl]; bf16_t* d = p.YS + (size_t)lp[rl] * D_MODEL + col0 + wc * 64 + quad * 4;
#pragma unroll
                for (int n = 0; n < 4; ++n) { u32x2 o; o.x = pack2(w * acc[m][n][0], w * acc[m][n][1]); o.y = pack2(w * acc[m][n][2], w * acc[m][n][3]); *(u32x2*)(d + n * 16) = o; }
            }
        }
    }
    DEV void operator()(f32x4 (&acc)[4][4], int wr, int wc, int lane) {}
};
template <bool DOWN>
DEV void phaseHI(const Params& p, int layer, unsigned char* smem) {
    int* tpre = (int*)(smem + 74 * 1024); int* sbase = tpre + 40;
    const int tid = tid_(); const int bid = bid_();
    __syncthreads();
    if (tid == 0) {
        int ta = 0, sa = 0;
        for (int e = 0; e < NE; ++e) { const int c = p.CNT[(layer * NE + e) * 32]; tpre[e] = ta; sbase[e] = sa; ta += (c + 127) >> 7; sa += c; }
        tpre[NE] = ta;
        if (bid == 0 && !DOWN) for (int e = 0; e < NE; ++e) p.BASE[e] = sbase[e];
    }
    __syncthreads();
    const int ncol = DOWN ? D_MODEL / 256 : 2 * D_EXPERT / 256; const int ntile = tpre[NE] * ncol;
    const int trow = tid >> 2, lc8 = g2_lc(tid) * 8;
    const WorkRange wr = xcd_range(ntile, bid);
    for (int t = wr.lo; t < wr.hi; t += wr.step) {
        int e = 0;
        for (int q = 1; q < NE; ++q) if (tpre[q] * ncol <= t) e = q;
        const int nrt = tpre[e + 1] - tpre[e]; const int q2 = t - tpre[e] * ncol; const int ct = q2 / nrt, rt = q2 % nrt;
        const int cnt = p.CNT[(layer * NE + e) * 32]; const int nvalid = imin(128, cnt - rt * 128); const int slot0 = sbase[e] + rt * 128;
        if (!DOWN) {
            const int* list = p.LIST + (size_t)e * NTOK + rt * 128;
            const int r0 = imin(trow, nvalid - 1), r1 = imin(64 + trow, nvalid - 1);
            const bf16_t* a0 = p.H + (size_t)(list[r0] >> 1) * D_MODEL + lc8; const bf16_t* a1 = p.H + (size_t)(list[r1] >> 1) * D_MODEL + lc8;
            const bf16_t* bw = p.Wgu + ((size_t)(layer * NE + e) * 2 * D_EXPERT + ct * 256 + trow) * D_MODEL + lc8;
            EpGU ep{p, slot0, nvalid, ct * 256};
            gemm_tile2<2, true>(smem, a0, a1, bw, D_MODEL, D_MODEL / 32, ep);
        } else {
            const bf16_t* a0 = p.ACT + (size_t)(slot0 + trow) * D_EXPERT + lc8;
            const bf16_t* bw = p.WdT + ((size_t)(layer * NE + e) * D_MODEL + ct * 256 + trow) * D_EXPERT + lc8;
            EpDown ep{p, p.LISTW + (size_t)e * NTOK + rt * 128, p.LIST + (size_t)e * NTOK + rt * 128, nvalid, ct * 256};
            gemm_tile2<2, true>(smem, a0, a0 + (size_t)64 * D_EXPERT, bw, D_EXPERT, D_EXPERT / 32, ep);
        }
    }
}

DEV void phaseJ(const Params& p, int layer) {
    const bool with_ctx = layer < DEPTH - 1; const bool last = layer == DEPTH - 1;
    const int wid = tid_() >> 6, lane = tid_() & 63;
    const float* lg1 = p.ln_g + (size_t)(layer * 2) * D_MODEL; const float* lb1 = p.ln_b + (size_t)(layer * 2) * D_MODEL;
    const float* lg = p.ln_g + (size_t)(layer * 2 + 1) * D_MODEL; const float* lb = p.ln_b + (size_t)(layer * 2 + 1) * D_MODEL;
    const int stride = gridDim.x * 4;
    int tok = bid_() * 4 + wid;
    u32x2 xn[NV4], an[NV4], cn[NV4]; float mun = 0.f, rsn = 0.f;
    if (tok < NTOK) {
#pragma unroll
        for (int i = 0; i < NV4; ++i) {
            const int k = (i * 64 + lane) * 4;
            xn[i] = *(const u32x2*)(p.X + (size_t)tok * D_MODEL + k); an[i] = *(const u32x2*)(p.YS + (size_t)(tok * 2) * D_MODEL + k); cn[i] = *(const u32x2*)(p.YS + (size_t)(tok * 2 + 1) * D_MODEL + k);
        }
        mun = p.STAT[tok * 2]; rsn = p.STAT[tok * 2 + 1];
    }
    for (; tok < NTOK; tok += stride) {
        u32x2 x[NV4], a[NV4], c[NV4]; const float mu1 = mun, rs1 = rsn;
#pragma unroll
        for (int i = 0; i < NV4; ++i) { x[i] = xn[i]; a[i] = an[i]; c[i] = cn[i]; }
        const int tn = tok + stride;
        if (tn < NTOK) {
#pragma unroll
            for (int i = 0; i < NV4; ++i) {
                const int k = (i * 64 + lane) * 4;
                xn[i] = *(const u32x2*)(p.X + (size_t)tn * D_MODEL + k); an[i] = *(const u32x2*)(p.YS + (size_t)(tn * 2) * D_MODEL + k); cn[i] = *(const u32x2*)(p.YS + (size_t)(tn * 2 + 1) * D_MODEL + k);
            }
            mun = p.STAT[tn * 2]; rsn = p.STAT[tn * 2 + 1];
        }
        const int b = tok / TT, s = tok % TT; if (!with_ctx && s < CTX) continue;
        const int bb = s < CTX ? BATCH : b; const float* gate = p.MOD + ((size_t)layer * (BATCH + 1) + bb) * 6 * D_MODEL + 5 * D_MODEL;
        f32x4 v[NV4]; float sum = 0.f;
#pragma unroll
        for (int i = 0; i < NV4; ++i) {
            const int k = (i * 64 + lane) * 4; const f32x4 g = *(const f32x4*)(gate + k), g1 = *(const f32x4*)(lg1 + k), b1 = *(const f32x4*)(lb1 + k);
            const f32x4 x1 = (bf4(x[i]) - mu1) * rs1 * g1 + b1;
            v[i] = ALPHA * x1 + g * (bf4(a[i]) + bf4(c[i]));
            sum += v[i].x + v[i].y + v[i].z + v[i].w;
        }
        const float mu = wsum(sum) * (1.f / D_MODEL); float var = 0.f;
#pragma unroll
        for (int i = 0; i < NV4; ++i) { float a0 = v[i].x - mu, bq = v[i].y - mu, c0 = v[i].z - mu, d = v[i].w - mu; var += a0 * a0 + bq * bq + c0 * c0 + d * d; }
        const float rs = 1.f / sqrtf(wsum(var) * (1.f / D_MODEL) + EPS);
        float* dst = p.out + ((size_t)b * SEQ + (s - CTX)) * D_MODEL; bf16_t* dx = p.X + (size_t)tok * D_MODEL;
#pragma unroll
        for (int i = 0; i < NV4; ++i) {
            const int k = (i * 64 + lane) * 4; const f32x4 g4 = *(const f32x4*)(lg + k), b4 = *(const f32x4*)(lb + k);
            f32x4 o; o.x = (v[i].x - mu) * rs * g4.x + b4.x; o.y = (v[i].y - mu) * rs * g4.y + b4.y; o.z = (v[i].z - mu) * rs * g4.z + b4.z; o.w = (v[i].w - mu) * rs * g4.w + b4.w;
            if (last) *(f32x4*)(dst + k) = o; else *(u32x2*)(dx + k) = pk4(o);
            if (!last) {
                const float* mn = p.MOD + ((size_t)(layer + 1) * (BATCH + 1) + bb) * 6 * D_MODEL;
                const f32x4 sh = *(const f32x4*)(mn + k), sc = *(const f32x4*)(mn + D_MODEL + k);
                u32x2 hq; hq.x = pack2(o.x * (1.f + sc.x) + sh.x, o.y * (1.f + sc.y) + sh.y); hq.y = pack2(o.z * (1.f + sc.z) + sh.z, o.w * (1.f + sc.w) + sh.w);
                *(u32x2*)(p.HIN + (size_t)tok * D_MODEL + k) = hq;
            }
        }
    }
}

constexpr int PH_PER_LAYER = 10;
constexpr int NPHASE = 2 + DEPTH * PH_PER_LAYER;
DEV void run_phase(const Params& p, int ph, unsigned char* smem) {
    if (ph == 0) { phase0(p, smem); return; }
    if (ph == 1) { phase0b(p); return; }
    const int layer = (ph - 2) / PH_PER_LAYER, sub = (ph - 2) % PH_PER_LAYER;
    switch (sub) {
        case 0: phaseA(p, layer, smem); break;
        case 1: if (!(layer & 1)) phaseB(p, layer); break;
        case 2: phaseC(p, layer, smem); break;
        case 3: phaseD(p, layer); break;
        case 4: phaseE(p, layer, smem); break;
        case 5: phaseF(p, layer, smem); break;
        case 6: phaseG(p, layer, smem); break;
        case 7: phaseHI<false>(p, layer, smem); break;
        case 8: phaseHI<true>(p, layer, smem); break;
        default: phaseJ(p, layer); break;
    }
}
DEV bool phase_is_empty(int ph) { if (ph < 2) return false; return ((ph - 2) % PH_PER_LAYER) == 1 && (((ph - 2) / PH_PER_LAYER) & 1); }

struct Carver { char* base; size_t off; template <class T> T* take(size_t n) { off = (off + 255) & ~(size_t)255; T* r = (T*)(base + off); off += n * sizeof(T); return r; } };
static void make_params(Params& p, void* const* d_in, void* d_out, void* d_ws) {
    const float** in = (const float**)d_in;
    p.x = in[0]; p.c = in[1]; p.ctx = in[2]; p.c_ctx = in[3]; p.w_mod = in[4]; p.b_mod = in[5]; p.ln_g = in[6]; p.ln_b = in[7];
    p.ev_w_in = in[8]; p.ev_w_out = in[9]; p.ev_lambda = in[10]; p.ev_subln_g = in[11]; p.ev_conv_w = in[12]; p.ev_conv_b = in[13];
    p.ev_gate_b = in[14]; p.ev_mnorm_g = in[15]; p.od_w_in = in[16]; p.od_w_out = in[17]; p.od_decay = in[18]; p.od_qk_g = in[19];
    p.moe_w_group = in[20]; p.moe_b_group = in[21]; p.moe_w_router = in[22]; p.moe_b_router = in[23]; p.moe_w_gate = in[24]; p.moe_w_up = in[25]; p.moe_w_down = in[26];
    p.out = (float*)d_out;
    Carver cv{(char*)d_ws, 0};
    p.X = cv.take<bf16_t>((size_t)NTOK * D_MODEL);
    p.MOD = cv.take<float>((size_t)DEPTH * (BATCH + 1) * 6 * D_MODEL);
    p.ROPE = cv.take<float>(64 * 16 * 2); p.LAM = cv.take<float>(4);
    p.WrT = cv.take<float>((size_t)DEPTH * NR * D_MODEL);
    p.CNT = cv.take<int>(DEPTH * NE * 32); p.BASE = cv.take<int>(NE); p.BAR = cv.take<unsigned>(4096);
    p.WinE = cv.take<bf16_t>((size_t)2 * EVEN_INP * D_MODEL); p.WinO = cv.take<bf16_t>((size_t)2 * ODD_IN * D_MODEL);
    p.WoutT = cv.take<bf16_t>((size_t)DEPTH * D_MODEL * MIX_OUT);
    p.Wgu = cv.take<bf16_t>((size_t)DEPTH * NE * 2 * D_EXPERT * D_MODEL); p.WdT = cv.take<bf16_t>((size_t)DEPTH * NE * D_MODEL * D_EXPERT);
    p.STAT = cv.take<float>((size_t)NTOK * 2);
    p.CAT = cv.take<bf16_t>((size_t)NTOK * 1024); p.HIN = cv.take<bf16_t>((size_t)NTOK * D_MODEL);
    p.LIST = cv.take<int>((size_t)NE * NTOK); p.LISTW = cv.take<float>((size_t)NE * NTOK); p.TOKSLOT = cv.take<int>((size_t)NTOK * 2);
    const size_t mix0 = cv.off;
    p.Q1 = cv.take<bf16_t>((size_t)NTOK * 512); p.K1 = cv.take<bf16_t>((size_t)NTOK * 512); p.V1T = cv.take<bf16_t>((size_t)NTOK * 512);
    p.PM = cv.take<bf16_t>((size_t)NTOK * 1024); p.V2T = cv.take<bf16_t>((size_t)NTOK * 512); p.OG = cv.take<bf16_t>((size_t)NTOK * 512);
    p.G = cv.take<float>((size_t)NTOK * 16);
    p.Q2 = cv.take<bf16_t>((size_t)NTOK * 512); p.K2 = cv.take<bf16_t>((size_t)NTOK * 512); p.K2T = cv.take<bf16_t>((size_t)NTOK * 512);
    p.DC = cv.take<bf16_t>((size_t)NCHAIN * NCH * EVR * 128); p.CP = cv.take<bf16_t>((size_t)NCHAIN * NCH * EVR * 128);
    p.BC = cv.take<float>((size_t)NCHAIN * TT); p.AT = cv.take<float>((size_t)NCHAIN * TT); p.MT = cv.take<float>((size_t)NCHAIN * TT); p.MS = cv.take<float>((size_t)NCHAIN * NCH * 4); p.CH2 = cv.take<float>((size_t)NCHAIN * NCH * 2);
    cv.off = mix0;
    p.H = cv.take<bf16_t>((size_t)NTOK * D_MODEL); p.ACT = cv.take<bf16_t>((size_t)(2 * NTOK + 128) * D_EXPERT); p.YS = cv.take<bf16_t>((size_t)2 * NTOK * D_MODEL);
}

#ifndef CPU_EMU
#define XB_TMO      128
#define XB_XCNT(j)  (256  + 64 * (j))
#define XB_XSUB(j)  (1280 + 64 * (j))
#define XB_XGEN(j)  (2304 + 64 * (j))
#define XB_TOP      3328
#define XB_TOPGEN   3392
#define XCD_BAR_WORDS 3456
#define XB_SPIN_CAP (1u << 20)
#define LAS __attribute__((address_space(3)))
__device__ __forceinline__ unsigned xb_ld(unsigned* p)              { return __hip_atomic_load(p, __ATOMIC_RELAXED, __HIP_MEMORY_SCOPE_AGENT); }
__device__ __forceinline__ unsigned xb_add(unsigned* p, unsigned v) { return __hip_atomic_fetch_add(p, v, __ATOMIC_RELAXED, __HIP_MEMORY_SCOPE_AGENT); }
__device__ __forceinline__ unsigned xb_xcc_id() { return (unsigned)__builtin_amdgcn_s_getreg((3 << 11) | 20) & 0xFu; }
#define XB_SPIN(cond, bar) do { unsigned _sp = 0; while (cond) { __builtin_amdgcn_s_sleep(1); \
    if ((++_sp & 255u) == 0u) { if (xb_ld(&(bar)[XB_TMO])) break; if (_sp > XB_SPIN_CAP) { atomicAdd(&(bar)[XB_TMO], 1u); break; } } } } while (0)
struct XcdBarrier { unsigned* bar; unsigned x; volatile LAS unsigned* st; };
__device__ __forceinline__ XcdBarrier xcd_barrier_post(unsigned* bar, volatile LAS unsigned* st) {
    XcdBarrier b; b.bar = bar; b.x = xb_xcc_id(); b.st = st;
    if (threadIdx.x == 0) (void)xb_add(&bar[XB_XCNT(b.x)], 1u);
    return b;
}
__device__ __forceinline__ void xcd_barrier_complete(unsigned* bar, unsigned x, unsigned& nloc, unsigned& nx) {
    const unsigned G = gridDim.x * gridDim.y * gridDim.z;
    unsigned sum, cnt, mine, sp = 0u;
    for (;;) {
        sum = 0u; cnt = 0u; mine = 0u;
#pragma unroll
        for (unsigned j = 0; j < 16; ++j) { const unsigned c = xb_ld(&bar[XB_XCNT(j)]); sum += c; cnt += (c > 0u) ? 1u : 0u; mine = (j == x) ? c : mine; }
        if (sum == G) break;
        __builtin_amdgcn_s_sleep(1);
        if ((++sp & 255u) == 0u) { if (xb_ld(&bar[XB_TMO])) break; if (sp > XB_SPIN_CAP) { atomicAdd(&bar[XB_TMO], 1u); break; } }
    }
    nloc = mine > 0u ? mine : 1u; nx = cnt > 0u ? cnt : 1u;
}
__device__ __forceinline__ void xcd_barrier(const XcdBarrier& b) {
    asm volatile("s_waitcnt vmcnt(0)" ::: "memory");
    __syncthreads();
    if (threadIdx.x == 0) {
        unsigned* bar = b.bar;
        __builtin_amdgcn_s_waitcnt(0);
        unsigned nloc = b.st[0], nx = b.st[1];
        if (nloc == 0u) { xcd_barrier_complete(bar, b.x, nloc, nx); b.st[0] = nloc; b.st[1] = nx; }
        const unsigned old = xb_add(&bar[XB_XSUB(b.x)], 1u);
        const unsigned gen = old / nloc;
        if (old + 1u == (gen + 1u) * nloc) {
            __builtin_amdgcn_fence(__ATOMIC_RELEASE, "agent");
            asm volatile("s_waitcnt vmcnt(0)" ::: "memory");
            const unsigned og = xb_add(&bar[XB_TOP], 1u);
            const unsigned tg = og / nx;
            if (og + 1u == (tg + 1u) * nx) xb_add(&bar[XB_TOPGEN], 1u);
            else XB_SPIN(xb_ld(&bar[XB_TOPGEN]) == tg, bar);
            __builtin_amdgcn_fence(__ATOMIC_ACQUIRE, "agent");
            xb_add(&bar[XB_XGEN(b.x)], 1u);
            asm volatile("s_waitcnt vmcnt(0)" ::: "memory");
        } else {
            XB_SPIN(xb_ld(&bar[XB_XGEN(b.x)]) == gen, bar);
            __builtin_amdgcn_fence(__ATOMIC_ACQUIRE, "agent");
            asm volatile("s_waitcnt vmcnt(0)" ::: "memory");
        }
    }
    __syncthreads();
}

__global__ void __launch_bounds__(NTHREADS, 2) fwd_megakernel(Params p) {
    __shared__ __attribute__((aligned(16))) unsigned char smem[LDS_BYTES];
    cg::grid_group grid = cg::this_grid();
    volatile LAS unsigned* xst = (volatile LAS unsigned*)(smem + LDS_BYTES - 16);
    if (threadIdx.x == 0) { xst[0] = 0u; xst[1] = 0u; }
    __syncthreads();
    const XcdBarrier xb = xcd_barrier_post(p.BAR, xst);
    grid.sync();
#ifdef PROBE_TS
    unsigned long long ts_acc = 0ull;
#endif
    for (int ph = 0; ph < NPHASE; ++ph) {
        if (phase_is_empty(ph)) continue;
#ifdef PROBE_TS
        const int psub_ = ph == 0 ? 10 : ph == 1 ? 11 : (ph - 2) % PH_PER_LAYER;
        const unsigned long long ts0 = __builtin_amdgcn_s_memrealtime();
#endif
#if defined(__HIP_DEVICE_COMPILE__)
        const __attribute__((address_space(4))) Params* pp = (const __attribute__((address_space(4))) Params*)__builtin_amdgcn_kernarg_segment_ptr();
        asm volatile("" : "+s"(pp));
        const Params q = *pp;
        run_phase(q, ph, smem);
#ifdef DBL_MASK
        { const int sub_ = ph == 0 ? 10 : ph == 1 ? 11 : (ph - 2) % PH_PER_LAYER; if ((DBL_MASK >> sub_) & 1) run_phase(q, ph, smem); }
#endif
#else
        run_phase(p, ph, smem);
#endif
#ifdef PROBE_TS
        const unsigned long long ts1 = __builtin_amdgcn_s_memrealtime();
        xcd_barrier(xb);
        const unsigned long long ts2 = __builtin_amdgcn_s_memrealtime();
        if (PROBE_TS == 100) ts_acc += ts2 - ts1; else if (psub_ == PROBE_TS) ts_acc += ts2 - ts0;
#else
        if (ph + 1 < NPHASE) xcd_barrier(xb);
#endif
    }
#ifdef PROBE_TS
    if (blockIdx.x == 0) { const int np = (int)(ts_acc / 100ull); for (int i = threadIdx.x; i < np; i += NTHREADS) p.out[i] += 1.0f; }
#endif
}

extern "C" void kernel_launch(void* const* d_in, const int* in_sizes, int n_in, void* d_out, int out_size, void* d_ws, size_t ws_size, hipStream_t stream) {
    static int grid_blocks = 0;
    if (!grid_blocks) {
        int dev = 0, cus = 0, per_cu = 0;
        (void)hipGetDevice(&dev); (void)hipDeviceGetAttribute(&cus, hipDeviceAttributeMultiprocessorCount, dev);
        (void)hipOccupancyMaxActiveBlocksPerMultiprocessor(&per_cu, fwd_megakernel, NTHREADS, 0);
        if (per_cu > 2) per_cu = 2;
        if (per_cu < 1) per_cu = 1;
        grid_blocks = cus * per_cu;
    }
    Params p; memset(&p, 0, sizeof(p));
    make_params(p, d_in, d_out, d_ws);
    (void)hipMemsetAsync(p.BAR, 0, 4096 * sizeof(unsigned), stream);
    void* args[] = {&p};
    hipError_t e = hipLaunchCooperativeKernel((void*)fwd_megakernel, dim3(grid_blocks), dim3(NTHREADS), args, 0, stream);
    if (e != hipSuccess) fprintf(stderr, "cooperative launch failed: %s (grid %d)\n", hipGetErrorString(e), grid_blocks);
}
#endif

#if defined(DIAG_KERNELS) && !defined(CPU_EMU)
template <int SUB, int ODD>
__global__ void __launch_bounds__(NTHREADS, 2) k_diag(Params p, int l2) {
    __shared__ __attribute__((aligned(16))) unsigned char smem[LDS_BYTES];
    const int layer = l2 * 2 + ODD;
    if (SUB == 100) { phase0(p, smem); return; }
    if (SUB == 0) phaseA(p, layer, smem);
    if (SUB == 1) phaseB(p, layer);
    if (SUB == 20) { for (int it = bid_(); it < 100; it += gridDim.x) { if (ODD) attn_gqa_item(p, it, (bf16_t*)smem); else attn_diff_item(p, layer, it, (bf16_t*)smem); } }
    if (SUB == 21) { for (int it = bid_(); it < 100; it += gridDim.x) { if (ODD) rec_dc_item<64, false>(p, it, (bf16_t*)smem); else rec_dc_item<128, true>(p, it, (bf16_t*)smem); } }
    if (SUB == 3) phaseD(p, layer);
    if (SUB == 4) phaseE(p, layer, smem);
    if (SUB == 5) phaseF(p, layer, smem);
    if (SUB == 6) phaseG(p, layer, smem);
    if (SUB == 7) phaseHI<false>(p, layer, smem);
    if (SUB == 8) phaseHI<true>(p, layer, smem);
    if (SUB == 9) phaseJ(p, layer);
}
template __global__ void k_diag<100, 0>(Params, int);
template __global__ void k_diag<0, 0>(Params, int);
template __global__ void k_diag<0, 1>(Params, int);
template __global__ void k_diag<1, 0>(Params, int);
template __global__ void k_diag<20, 0>(Params, int);
template __global__ void k_diag<20, 1>(Params, int);
template __global__ void k_diag<21, 0>(Params, int);
template __global__ void k_diag<21, 1>(Params, int);
template __global__ void k_diag<3, 0>(Params, int);
template __global__ void k_diag<4, 0>(Params, int);
template __global__ void k_diag<4, 1>(Params, int);
template __global__ void k_diag<5, 0>(Params, int);
template __global__ void k_diag<6, 0>(Params, int);
template __global__ void k_diag<7, 0>(Params, int);
template __global__ void k_diag<8, 0>(Params, int);
template __global__ void k_diag<9, 0>(Params, int);
#endif
```

```cpp
#ifdef CPU_EMU
#include "emu.h"
#else
#include <hip/hip_runtime.h>
#include <hip/hip_cooperative_groups.h>
#include <cstdio>
#include <cstdint>
#include <cstring>
namespace cg = cooperative_groups;
#endif

#define DEV __device__ __forceinline__
#ifdef CPU_EMU
#define SCHED_BARRIER() do {} while (0)
#else
#define SCHED_BARRIER() __builtin_amdgcn_sched_barrier(0)
#endif
#ifdef CPU_EMU
static inline void glds16(const void* g, void* l) { memcpy(l, g, 16); }
template <int N> static inline void wait_vm() {}
#define RAW_BARRIER() __syncthreads()
#else
__device__ __forceinline__ void glds16(const void* g, void* l) {
    __builtin_amdgcn_global_load_lds((const __attribute__((address_space(1))) unsigned*)g, (__attribute__((address_space(3))) unsigned*)l, 16, 0, 0);
}
template <int N> __device__ __forceinline__ void wait_vm() { asm volatile("s_waitcnt vmcnt(%0)" ::"n"(N) : "memory"); }
#define RAW_BARRIER() do { asm volatile("s_waitcnt lgkmcnt(0)" ::: "memory"); __builtin_amdgcn_s_barrier(); } while (0)
#endif
#ifdef CPU_EMU
static inline int tid_() { return (int)threadIdx.x; }
static inline int bid_() { return (int)blockIdx.x; }
#else
__device__ __forceinline__ int tid_() { int t = threadIdx.x; asm volatile("" : "+v"(t)); return t; }
__device__ __forceinline__ int bid_() { int b = blockIdx.x; asm volatile("" : "+s"(b)); return b; }
#endif

#ifdef CPU_EMU_SMALL
constexpr int D_MODEL = 256, BATCH = 2, SEQ = 256, CTX = 256, D_EXPERT = 128;
#else
constexpr int D_MODEL = 1024, BATCH = 4, SEQ = 4096, CTX = 256, D_EXPERT = 512;
#endif
constexpr int DEPTH = 4, GRID_W = 64, CH = 128;
constexpr int TT = CTX + SEQ, NTOK = BATCH * TT, NCH = TT / CH, NCC = CTX / CH;
constexpr float EPS = 1e-5f;
constexpr float ALPHA = 1.6817928305074290f;
constexpr int HA = 4, HB = 4, HC = 4, HD = 8, HKV = 2;
constexpr int EVEN_IN = 3600, EVEN_INP = 3840, ODD_IN = 2304, MIX_OUT = 1024;
constexpr int NG = 4, EPG = 8, NE = 32, NR = NG + NE;
constexpr int NTHREADS = 256;
constexpr int LDS_BYTES = 76 * 1024;
constexpr int NCHAIN = BATCH * 4 * 2;
constexpr int EVR = 144;

typedef unsigned short bf16_t;
typedef short bf16x8 __attribute__((ext_vector_type(8)));
typedef float f32x4 __attribute__((ext_vector_type(4)));
typedef unsigned u32x4 __attribute__((ext_vector_type(4)));
typedef unsigned u32x2 __attribute__((ext_vector_type(2)));
union Frag { bf16x8 v; u32x4 q; u32x2 d[2]; unsigned u[4]; };
DEV int imin(int a, int b) { return a < b ? a : b; }

#ifdef CPU_EMU
DEV bf16_t f2bf(float f) { unsigned u = __float_as_uint(f); u += 0x7FFFu + ((u >> 16) & 1u); return (bf16_t)(u >> 16); }
DEV unsigned pack2(float a, float b) { return (unsigned)f2bf(a) | ((unsigned)f2bf(b) << 16); }
#else
typedef __bf16 hwbf16x2 __attribute__((ext_vector_type(2)));
typedef float hwf32x2 __attribute__((ext_vector_type(2)));
DEV unsigned pack2(float a, float b) { hwf32x2 v = {a, b}; hwbf16x2 h = __builtin_convertvector(v, hwbf16x2); return __builtin_bit_cast(unsigned, h); }
DEV bf16_t f2bf(float f) { return (bf16_t)(pack2(f, 0.f) & 0xFFFFu); }
#endif
DEV float bf2f(bf16_t h) { return __uint_as_float(((unsigned)h) << 16); }
DEV f32x4 bf4(u32x2 v) { return f32x4{__uint_as_float(v.x << 16), __uint_as_float(v.x & 0xFFFF0000u), __uint_as_float(v.y << 16), __uint_as_float(v.y & 0xFFFF0000u)}; }
DEV u32x2 pk4(f32x4 v) { u32x2 o; o.x = pack2(v.x, v.y); o.y = pack2(v.z, v.w); return o; }
DEV float siluf(float x) { return x / (1.0f + __expf(-x)); }
DEV float sigmf(float x) { return 1.0f / (1.0f + __expf(-x)); }
DEV float logsigf(float x) { return (x >= 0.f) ? -log1pf(expf(-x)) : x - log1pf(expf(x)); }
#ifdef CPU_EMU
DEV float rowred_add(float v) { v += __shfl_xor(v, 1); v += __shfl_xor(v, 2); v += __shfl_xor(v, 4); v += __shfl_xor(v, 8); return v; }
DEV float rowred_max(float v) { v = fmaxf(v, __shfl_xor(v, 1)); v = fmaxf(v, __shfl_xor(v, 2)); v = fmaxf(v, __shfl_xor(v, 4)); v = fmaxf(v, __shfl_xor(v, 8)); return v; }
DEV float lane_read(float v, int src, int lane) { return __shfl(v, src); }
DEV float lane_up(float v, int d, int lane) { return __shfl_up(v, d); }
#else
template <int CTRL> DEV float dppf(float v) { return __uint_as_float((unsigned)__builtin_amdgcn_update_dpp(0, (int)__float_as_uint(v), CTRL, 0xF, 0xF, true)); }
DEV float rowred_add(float v) { v += dppf<0xB1>(v); v += dppf<0x4E>(v); v += dppf<0x141>(v); v += dppf<0x140>(v); return v; }
DEV float rowred_max(float v) { v = fmaxf(v, dppf<0xB1>(v)); v = fmaxf(v, dppf<0x4E>(v)); v = fmaxf(v, dppf<0x141>(v)); v = fmaxf(v, dppf<0x140>(v)); return v; }
DEV float lane_read(float v, int src, int lane) { return __uint_as_float((unsigned)__builtin_amdgcn_ds_bpermute((src & 63) << 2, (int)__float_as_uint(v))); }
DEV float lane_up(float v, int d, int lane) { const float o = __uint_as_float((unsigned)__builtin_amdgcn_ds_bpermute(((lane - d) & 63) << 2, (int)__float_as_uint(v))); return lane >= d ? o : v; }
#endif
#ifdef CPU_EMU
DEV float xch16(float v) { return __shfl_xor(v, 16); }
DEV float xch32(float v) { return __shfl_xor(v, 32); }
#else
typedef unsigned hwu2 __attribute__((ext_vector_type(2)));
DEV void xpair16(float v, float& a, float& b) { const unsigned u = __float_as_uint(v); hwu2 r = __builtin_amdgcn_permlane16_swap(u, u, false, false); a = __uint_as_float(r.x); b = __uint_as_float(r.y); }
DEV void xpair32(float v, float& a, float& b) { const unsigned u = __float_as_uint(v); hwu2 r = __builtin_amdgcn_permlane32_swap(u, u, false, false); a = __uint_as_float(r.x); b = __uint_as_float(r.y); }
#endif
DEV float xmax16(float v) {
#ifdef CPU_EMU
    return fmaxf(v, xch16(v));
#else
    float a, b; xpair16(v, a, b); return fmaxf(a, b);
#endif
}
DEV float xmax32(float v) {
#ifdef CPU_EMU
    return fmaxf(v, xch32(v));
#else
    float a, b; xpair32(v, a, b); return fmaxf(a, b);
#endif
}
DEV float xadd16(float v) {
#ifdef CPU_EMU
    return v + xch16(v);
#else
    float a, b; xpair16(v, a, b); return a + b;
#endif
}
DEV float xadd32(float v) {
#ifdef CPU_EMU
    return v + xch32(v);
#else
    float a, b; xpair32(v, a, b); return a + b;
#endif
}
DEV float wsum(float v) { v = rowred_add(v); v = xadd16(v); return xadd32(v); }
DEV float wmax(float v) { v = rowred_max(v); v = xmax16(v); return xmax32(v); }
DEV f32x4 mfma16(bf16x8 a, bf16x8 b, f32x4 c) { return __builtin_amdgcn_mfma_f32_16x16x32_bf16(a, b, c, 0, 0, 0); }

struct WorkRange { int lo, hi, step; };
DEV WorkRange xcd_range(int T, int bid) {
    WorkRange w; const int G = gridDim.x;
    if ((G & 7) == 0) { const int x = bid & 7, k = bid >> 3; w.lo = (int)(((long long)x * T) >> 3) + k; w.hi = (int)(((long long)(x + 1) * T) >> 3); w.step = G >> 3; }
    else { w.lo = bid; w.hi = T; w.step = G; }
    return w;
}
DEV void dense_tile(int t, int nrow, int ncol, int& rt, int& ct) {
    if ((nrow & 7) == 0) { const int rpg = nrow >> 3; const int rg = t / (ncol * rpg), q = t % (ncol * rpg); ct = q / rpg; rt = rg * rpg + q % rpg; }
    else { rt = t / ncol; ct = t % ncol; }
}

struct Params {
    const float *x, *c, *ctx, *c_ctx, *w_mod, *b_mod, *ln_g, *ln_b, *ev_w_in, *ev_w_out, *ev_lambda, *ev_subln_g, *ev_conv_w, *ev_conv_b,
        *ev_gate_b, *ev_mnorm_g, *od_w_in, *od_w_out, *od_decay, *od_qk_g, *moe_w_group, *moe_b_group, *moe_w_router, *moe_b_router,
        *moe_w_gate, *moe_w_up, *moe_w_down;
    float* out;
    bf16_t* X;
    float *MOD, *ROPE, *LAM, *WrT;
    int* CNT; unsigned* BAR;
    bf16_t *WinE, *WinO, *WoutT, *Wgu, *WdT;
    bf16_t *Q1, *K1, *V1T;
    bf16_t *PM, *V2T, *OG;
    float* G;
    bf16_t *Q2, *K2, *K2T;
    bf16_t* CAT;
    bf16_t *DC, *CP;
    float *BC, *AT, *MT, *MS, *CH2;
    bf16_t *H, *ACT, *HIN, *YS; float* STAT;
    int *LIST, *TOKSLOT, *BASE; float *LISTW;
};

constexpr int GLD = 72;
constexpr int GT = 128 * GLD;

struct BLoadW {
    const bf16_t* base; int ld; u32x4 r[4];
    DEV void fetch(int kt, int tid) {
#pragma unroll
        for (int i = 0; i < 4; ++i) { int c = tid + 256 * i, row = c >> 3, kc = c & 7; r[i] = *(const u32x4*)(base + (size_t)row * ld + kt * 64 + kc * 8); }
    }
    DEV void commit(bf16_t* S, int tid) {
#pragma unroll
        for (int i = 0; i < 4; ++i) { int c = tid + 256 * i, row = c >> 3, kc = c & 7; *(u32x4*)(S + row * GLD + kc * 8) = r[i]; }
    }
};
struct ALoadB {
    const bf16_t* base; int ld; u32x4 r[4];
    DEV void fetch(int kt, int tid) {
#pragma unroll
        for (int i = 0; i < 4; ++i) { int c = tid + 256 * i, row = c >> 3, kc = c & 7; r[i] = *(const u32x4*)(base + (size_t)row * ld + kt * 64 + kc * 8); }
    }
    DEV void commit(bf16_t* S, int tid) {
#pragma unroll
        for (int i = 0; i < 4; ++i) { int c = tid + 256 * i, row = c >> 3, kc = c & 7; *(u32x4*)(S + row * GLD + kc * 8) = r[i]; }
    }
};
struct ALoadG {
    const bf16_t* H; const int* list; int nvalid; u32x4 r[4];
    DEV void fetch(int kt, int tid) {
#pragma unroll
        for (int i = 0; i < 4; ++i) {
            int c = tid + 256 * i, row = c >> 3, kc = c & 7; int rr = row < nvalid ? row : nvalid - 1; int tok = list[rr];
            r[i] = *(const u32x4*)(H + (size_t)tok * D_MODEL + kt * 64 + kc * 8);
        }
    }
    DEV void commit(bf16_t* S, int tid) {
#pragma unroll
        for (int i = 0; i < 4; ++i) { int c = tid + 256 * i, row = c >> 3, kc = c & 7; *(u32x4*)(S + row * GLD + kc * 8) = r[i]; }
    }
};
struct ALoadX {
    const float* base; const float *sc, *sh; f32x4 r[8]; f32x4 s4, h4;
    DEV void fetch(int kt, int tid) {
        int kc = tid & 15;
        s4 = *(const f32x4*)(sc + kt * 64 + kc * 4); h4 = *(const f32x4*)(sh + kt * 64 + kc * 4);
#pragma unroll
        for (int i = 0; i < 8; ++i) { int row = (tid >> 4) + 16 * i; r[i] = *(const f32x4*)(base + (size_t)row * D_MODEL + kt * 64 + kc * 4); }
    }
    DEV void commit(bf16_t* S, int tid) {
        int kc = tid & 15;
#pragma unroll
        for (int i = 0; i < 8; ++i) {
            int row = (tid >> 4) + 16 * i;
            u32x2 o; o.x = pack2(r[i].x * (1.f + s4.x) + h4.x, r[i].y * (1.f + s4.y) + h4.y); o.y = pack2(r[i].z * (1.f + s4.z) + h4.z, r[i].w * (1.f + s4.w) + h4.w);
            *(u32x2*)(S + row * GLD + kc * 4) = o;
        }
    }
};

template <class AL, class BL, class EP>
DEV void gemm_tile(bf16_t* sm, AL& al, BL& bl, int nkt, EP& ep) {
    const int tid = tid_(), wid = tid >> 6, lane = tid & 63, wr = wid >> 1, wc = wid & 1, r = lane & 15, quad = lane >> 4;
    bf16_t* As = sm; bf16_t* Bs = sm + 2 * GT;
    f32x4 acc[4][4];
#pragma unroll
    for (int m = 0; m < 4; ++m)
#pragma unroll
        for (int n = 0; n < 4; ++n) acc[m][n] = f32x4{0.f, 0.f, 0.f, 0.f};
    al.fetch(0, tid); bl.fetch(0, tid); al.commit(As, tid); bl.commit(Bs, tid);
    __syncthreads();
    for (int kt = 0; kt < nkt; ++kt) {
        const int cur = kt & 1;
        if (kt + 1 < nkt) { al.fetch(kt + 1, tid); bl.fetch(kt + 1, tid); }
        const bf16_t* Ac = As + cur * GT + (wr * 64 + r) * GLD + quad * 8;
        const bf16_t* Bc = Bs + cur * GT + (wc * 64 + r) * GLD + quad * 8;
#pragma unroll
        for (int ks = 0; ks < 2; ++ks) {
            Frag a[4], b[4];
#pragma unroll
            for (int m = 0; m < 4; ++m) a[m].q = *(const u32x4*)(Ac + m * 16 * GLD + ks * 32);
#pragma unroll
            for (int n = 0; n < 4; ++n) b[n].q = *(const u32x4*)(Bc + n * 16 * GLD + ks * 32);
#pragma unroll
            for (int m = 0; m < 4; ++m)
#pragma unroll
                for (int n = 0; n < 4; ++n) acc[m][n] = mfma16(a[m].v, b[n].v, acc[m][n]);
        }
        if (kt + 1 < nkt) { al.commit(As + (cur ^ 1) * GT, tid); bl.commit(Bs + (cur ^ 1) * GT, tid); }
        __syncthreads();
    }
    ep(acc, wr, wc, lane);
}


DEV int g2_h(int g) { return (0x78 >> (2 * g)) & 3; }
template <int NH> struct G2 { static constexpr int BROWS = 128 * NH, STAGE = 8192 + BROWS * 64, NST = (NH == 2 ? 3 : 4), LPS = 2 + 2 * NH; };

template <int NH, bool TR, class EP>
DEV void gemm_tile2(unsigned char* sm, const bf16_t* a0, const bf16_t* a1, const bf16_t* bb, int ldb, int nkt, EP& ep) {
    constexpr int STAGE = G2<NH>::STAGE, NST = G2<NH>::NST, LPS = G2<NH>::LPS;
    const int tid = tid_(), wid = tid >> 6, lane = tid & 63, wr = wid >> 1, wc = wid & 1, r = lane & 15, quad = lane >> 4;
    f32x4 acc[NH][4][4];
#pragma unroll
    for (int h = 0; h < NH; ++h)
#pragma unroll
        for (int m = 0; m < 4; ++m)
#pragma unroll
            for (int n = 0; n < 4; ++n) acc[h][m][n] = f32x4{0.f, 0.f, 0.f, 0.f};
    unsigned char* dst0 = sm + tid * 16;
    auto issue = [&](int kt, int slot) {
        unsigned char* d = dst0 + slot * STAGE;
        glds16(a0 + kt * 32, d); glds16(a1 + kt * 32, d + 4096);
#pragma unroll
        for (int j = 0; j < 2 * NH; ++j) glds16(bb + (size_t)j * 64 * ldb + kt * 32, d + 8192 + j * 4096);
    };
    RAW_BARRIER();
#pragma unroll
    for (int st = 0; st < NST - 1; ++st) if (st < nkt) issue(st, st);
    const int pco = (quad ^ g2_h((r >> 2) & 3)) * 16;
    const unsigned char* afr = sm + (wr * 64 + r) * 64 + pco;
    const unsigned char* bfr = sm + 8192 + (wc * 64 * NH + r) * 64 + pco;
    int slot = 0;
    for (int kt = 0; kt < nkt; ++kt) {
        const int rem = nkt - 1 - kt;
        if (NST == 3) { if (rem >= 1) wait_vm<LPS>(); else wait_vm<0>(); }
        else { if (rem >= 2) wait_vm<2 * LPS>(); else if (rem == 1) wait_vm<LPS>(); else wait_vm<0>(); }
        RAW_BARRIER();
        if (kt + NST - 1 < nkt) { int ns = slot + NST - 1; if (ns >= NST) ns -= NST; issue(kt + NST - 1, ns); }
        const unsigned char* as = afr + slot * STAGE; const unsigned char* bs = bfr + slot * STAGE;
        Frag a[4];
#pragma unroll
        for (int m = 0; m < 4; ++m) a[m].q = *(const u32x4*)(as + m * 16 * 64);
#ifndef CPU_EMU
        __builtin_amdgcn_s_setprio(1);
#endif
#pragma unroll
        for (int h = 0; h < NH; ++h) {
            Frag b[4];
#pragma unroll
            for (int n = 0; n < 4; ++n) b[n].q = *(const u32x4*)(bs + (h * 64 + n * 16) * 64);
#pragma unroll
            for (int m = 0; m < 4; ++m)
#pragma unroll
                for (int n = 0; n < 4; ++n) acc[h][m][n] = TR ? mfma16(b[n].v, a[m].v, acc[h][m][n]) : mfma16(a[m].v, b[n].v, acc[h][m][n]);
        }
#ifndef CPU_EMU
        __builtin_amdgcn_s_setprio(0);
#endif
        if (++slot == NST) slot = 0;
    }
#pragma unroll
    for (int h = 0; h < NH; ++h) { if (TR) ep.nat(acc[h], wr, wc * NH + h, lane); else ep(acc[h], wr, wc * NH + h, lane); }
}
DEV int g2_lc(int tid) { return (tid & 3) ^ g2_h((tid >> 4) & 3); }

struct ConvJob { const float* src; bf16_t* dst; int ldsrc, N, K, k0, n0, mapkind; };
DEV void conv_load(const ConvJob& j, int tid, f32x4 (&v)[4]) {
#pragma unroll
    for (int i = 0; i < 4; ++i) {
        const int kk = (tid >> 4) + 16 * i, n = j.n0 + 4 * (tid & 15);
        v[i] = f32x4{0.f, 0.f, 0.f, 0.f};
        if (n + 3 < j.N) v[i] = *(const f32x4*)(j.src + (size_t)(j.k0 + kk) * j.ldsrc + n);
    }
}
DEV void conv_store(float* T, const ConvJob& j, int tid, const f32x4 (&v)[4]) {
    __syncthreads();
#pragma unroll
    for (int i = 0; i < 4; ++i) {
        const int kk = (tid >> 4) + 16 * i, n4 = tid & 15;
        T[(4 * n4 + 0) * 65 + kk] = v[i].x; T[(4 * n4 + 1) * 65 + kk] = v[i].y; T[(4 * n4 + 2) * 65 + kk] = v[i].z; T[(4 * n4 + 3) * 65 + kk] = v[i].w;
    }
    __syncthreads();
    const int nl = tid >> 2, ks = (tid & 3) * 16; const int n = j.n0 + nl; int dr = n;
    if (j.mapkind == 1) dr = (n >> 5) * 64 + (n & 31); else if (j.mapkind == 2) dr = (n >> 5) * 64 + 32 + (n & 31);
    const float* t = T + nl * 65 + ks;
    u32x4 o0, o1;
    o0.x = pack2(t[0], t[1]); o0.y = pack2(t[2], t[3]); o0.z = pack2(t[4], t[5]); o0.w = pack2(t[6], t[7]);
    o1.x = pack2(t[8], t[9]); o1.y = pack2(t[10], t[11]); o1.z = pack2(t[12], t[13]); o1.w = pack2(t[14], t[15]);
    bf16_t* d = j.dst + (size_t)dr * j.K + j.k0 + ks;
    *(u32x4*)d = o0; *(u32x4*)(d + 8) = o1;
}
constexpr int P0_NMOD = DEPTH * 6 * D_MODEL / 64;
constexpr int P0_NCOPY = NTOK / 64;
constexpr int T_EIN = (D_MODEL / 64) * (EVEN_INP / 64), T_OIN = (D_MODEL / 64) * (ODD_IN / 64), T_OUT = (MIX_OUT / 64) * (D_MODEL / 64);
constexpr int T_GU = (D_MODEL / 64) * (D_EXPERT / 64), T_DN = (D_EXPERT / 64) * (D_MODEL / 64);
constexpr int P0_C0 = P0_NMOD + P0_NCOPY + 1 + DEPTH;
constexpr int P0_C1 = 2 * T_EIN, P0_C2 = P0_C1 + 2 * T_OIN, P0_C3 = P0_C2 + DEPTH * T_OUT, P0_C4 = P0_C3 + DEPTH * NE * 2 * T_GU, P0_C5 = P0_C4 + DEPTH * NE * T_DN;
DEV ConvJob conv_job(const Params& p, int t) {
    ConvJob j;
    if (t < P0_C1) {
        const int i = t / T_EIN, tt = t % T_EIN; const int nt = tt % (EVEN_INP / 64), kt = tt / (EVEN_INP / 64);
        j.src = p.ev_w_in + (size_t)i * D_MODEL * EVEN_IN; j.ldsrc = EVEN_IN; j.N = EVEN_IN; j.K = D_MODEL; j.k0 = kt * 64; j.n0 = nt * 64; j.dst = p.WinE + (size_t)i * EVEN_INP * D_MODEL; j.mapkind = 0;
    } else if (t < P0_C2) {
        const int q = t - P0_C1, i = q / T_OIN, tt = q % T_OIN; const int nt = tt % (ODD_IN / 64), kt = tt / (ODD_IN / 64);
        j.src = p.od_w_in + (size_t)i * D_MODEL * ODD_IN; j.ldsrc = ODD_IN; j.N = ODD_IN; j.K = D_MODEL; j.k0 = kt * 64; j.n0 = nt * 64; j.dst = p.WinO + (size_t)i * ODD_IN * D_MODEL; j.mapkind = 0;
    } else if (t < P0_C3) {
        const int q = t - P0_C2, layer = q / T_OUT, tt = q % T_OUT; const int nt = tt % (D_MODEL / 64), kt = tt / (D_MODEL / 64);
        j.src = (layer & 1) ? p.od_w_out + (size_t)(layer >> 1) * MIX_OUT * D_MODEL : p.ev_w_out + (size_t)(layer >> 1) * MIX_OUT * D_MODEL;
        j.ldsrc = D_MODEL; j.N = D_MODEL; j.K = MIX_OUT; j.k0 = kt * 64; j.n0 = nt * 64; j.dst = p.WoutT + (size_t)layer * D_MODEL * MIX_OUT; j.mapkind = 0;
    } else if (t < P0_C4) {
        const int q = t - P0_C3, le = q / (2 * T_GU); int tt = q % (2 * T_GU); const int up = tt / T_GU; tt %= T_GU; const int nt = tt % (D_EXPERT / 64), kt = tt / (D_EXPERT / 64);
        j.src = (up ? p.moe_w_up : p.moe_w_gate) + (size_t)le * D_MODEL * D_EXPERT; j.ldsrc = D_EXPERT; j.N = D_EXPERT; j.K = D_MODEL; j.k0 = kt * 64; j.n0 = nt * 64;
        j.dst = p.Wgu + (size_t)le * 2 * D_EXPERT * D_MODEL; j.mapkind = 1 + up;
    } else {
        const int q = t - P0_C4, le = q / T_DN, tt = q % T_DN; const int nt = tt % (D_MODEL / 64), kt = tt / (D_MODEL / 64);
        j.src = p.moe_w_down + (size_t)le * D_EXPERT * D_MODEL; j.ldsrc = D_MODEL; j.N = D_MODEL; j.K = D_EXPERT; j.k0 = kt * 64; j.n0 = nt * 64; j.dst = p.WdT + (size_t)le * D_MODEL * D_EXPERT; j.mapkind = 0;
    }
    return j;
}

DEV void phase0(const Params& p, unsigned char* smem) {
    const int tid = tid_(); const int bid = bid_();
    float* fs = (float*)smem;
    for (int task = bid; task < P0_C0; task += gridDim.x) {
        if (task < P0_NMOD) {
            __syncthreads();
            for (int i = tid; i < (BATCH + 1) * D_MODEL; i += 256) { int bb = i / D_MODEL, k = i % D_MODEL; float v = bb < BATCH ? p.c[bb * D_MODEL + k] : p.c_ctx[k]; fs[i] = v / (1.f + expf(-v)); }
            __syncthreads();
            const int col = task * 64 + (tid & 63), kg = tid >> 6; const int layer = col / (6 * D_MODEL), j = col % (6 * D_MODEL);
            const float* w = p.w_mod + (size_t)layer * D_MODEL * 6 * D_MODEL + j;
            float acc[BATCH + 1];
#pragma unroll
            for (int bb = 0; bb <= BATCH; ++bb) acc[bb] = 0.f;
#pragma unroll 16
            for (int k = kg * (D_MODEL / 4); k < (kg + 1) * (D_MODEL / 4); ++k) {
                float wv = w[(size_t)k * 6 * D_MODEL];
#pragma unroll
                for (int bb = 0; bb <= BATCH; ++bb) acc[bb] += fs[bb * D_MODEL + k] * wv;
            }
            float* red = fs + (BATCH + 1) * D_MODEL;
#pragma unroll
            for (int bb = 0; bb <= BATCH; ++bb) red[(kg * (BATCH + 1) + bb) * 64 + (tid & 63)] = acc[bb];
            __syncthreads();
            if (tid < 64) {
                const float bm = p.b_mod[layer * 6 * D_MODEL + j];
#pragma unroll
                for (int bb = 0; bb <= BATCH; ++bb) {
                    const float sacc = red[(0 * (BATCH + 1) + bb) * 64 + tid] + red[(1 * (BATCH + 1) + bb) * 64 + tid] + red[(2 * (BATCH + 1) + bb) * 64 + tid] + red[(3 * (BATCH + 1) + bb) * 64 + tid];
                    p.MOD[((size_t)layer * (BATCH + 1) + bb) * 6 * D_MODEL + j] = sacc + bm;
                }
            }
        } else if (task < P0_NMOD + P0_NCOPY) {
            int r0 = (task - P0_NMOD) * 64;
            for (int i = tid; i < 64 * D_MODEL / 4; i += 256) {
                int row = r0 + i / (D_MODEL / 4), c4 = i % (D_MODEL / 4); int b = row / TT, s = row % TT;
                const float* src = s < CTX ? p.ctx + ((size_t)b * CTX + s) * D_MODEL : p.x + ((size_t)b * SEQ + (s - CTX)) * D_MODEL;
                *(u32x2*)(p.X + (size_t)row * D_MODEL + c4 * 4) = pk4(*(const f32x4*)(src + c4 * 4));

            }
        } else if (task == P0_NMOD + P0_NCOPY) {
            for (int i = tid; i < 64 * 16; i += 256) {
                int pos = i / 16, f = i % 16;
                double th = 1.0; for (int q = 0; q < f; ++q) th *= 0.5623413251903490804;
                double t2 = th * th, cs = 1.0, sn = th, tc = 1.0, ts = th;
                for (int n = 1; n < 14; ++n) { tc *= -t2 / ((2 * n - 1) * (2 * n)); ts *= -t2 / ((2 * n) * (2 * n + 1)); cs += tc; sn += ts; }
                double c = 1.0, s = 0.0;
                for (int q = 0; q < pos; ++q) { double cn = c * cs - s * sn, sn2 = s * cs + c * sn; c = cn; s = sn2; }
                p.ROPE[i * 2] = (float)c; p.ROPE[i * 2 + 1] = (float)s;
            }
            if (tid < 2) {
                const float* lp = p.ev_lambda + tid * 4 * 64; float s01 = 0.f, s23 = 0.f;
                for (int k = 0; k < 64; ++k) { s01 += lp[k] * lp[64 + k]; s23 += lp[128 + k] * lp[192 + k]; }
                float lam_init = 0.8f - 0.6f * expf(-0.3f * (float)(2 * tid));
                p.LAM[tid] = expf(s01) - expf(s23) + lam_init;
            }
            for (int i = tid; i < DEPTH * NE * 32; i += 256) p.CNT[i] = 0;
        } else {
            int layer = task - (P0_NMOD + P0_NCOPY + 1);
            for (int i = tid; i < NR * D_MODEL; i += 256) {
                int j = i / D_MODEL, k = i % D_MODEL;
                float v = j < NG ? p.moe_w_group[((size_t)layer * D_MODEL + k) * NG + j] : p.moe_w_router[((size_t)layer * D_MODEL + k) * NE + (j - NG)];
                p.WrT[(size_t)layer * NR * D_MODEL + i] = v;
            }
        }
    }
    {
        const int G = gridDim.x; int t = bid;
        ConvJob j0, j1, j2; f32x4 v0[4], v1[4], v2[4];
        const bool h0 = t < P0_C5, h1 = t + G < P0_C5;
        if (h0) { j0 = conv_job(p, t); conv_load(j0, tid, v0); } else { j0 = conv_job(p, 0); }
        if (h1) { j1 = conv_job(p, t + G); conv_load(j1, tid, v1); } else { j1 = j0; }
        j2 = j1;
        while (t < P0_C5) {
            const bool h2 = t + 2 * G < P0_C5;
            if (h2) { j2 = conv_job(p, t + 2 * G); conv_load(j2, tid, v2); }
            conv_store(fs, j0, tid, v0);
            j0 = j1; j1 = j2;
#pragma unroll
            for (int i = 0; i < 4; ++i) { v0[i] = v1[i]; v1[i] = v2[i]; }
            t += G;
        }
    }
}

DEV int chunk_of(int dir, int sp) { return dir == 0 ? sp : (sp < NCC ? NCC - 1 - sp : NCC + (NCH - 1 - sp)); }
DEV int sp_of(int dir, int u) { return dir == 0 ? u : (u < NCC ? NCC - 1 - u : NCC + (NCH - 1 - u)); }

template <bool RET>
DEV void gate_chain(const Params& p, int layer, int chain) {
    const int lane = tid_() & 63;
    const int dir = chain & 1, h = (chain >> 1) & 3, b = chain >> 3;
    float lg = 0.f;
    if (RET) lg = logsigf(p.od_decay[((layer >> 1) * 2 + dir) * HC + h]);
    float mprev = 0.f;
    for (int sp = 0; sp < NCH; ++sp) {
        const int u = chunk_of(dir, sp); const int sbase = u * CH;
        int i0 = 2 * lane, i1 = 2 * lane + 1;
        int s0 = dir ? sbase + 127 - i0 : sbase + i0, s1 = dir ? sbase + 127 - i1 : sbase + i1;
        float lf0, lf1, li0, li1;
        if (RET) { lf0 = lf1 = lg; li0 = li1 = 0.f; }
        else {
            const float* g0 = p.G + ((size_t)b * TT + s0) * 16; const float* g1 = p.G + ((size_t)b * TT + s1) * 16;
            li0 = g0[(2 * dir) * 4 + h]; li1 = g1[(2 * dir) * 4 + h];
            lf0 = logsigf(g0[(2 * dir + 1) * 4 + h]); lf1 = logsigf(g1[(2 * dir + 1) * 4 + h]);
        }
        float ps = lf0 + lf1;
        for (int d = 1; d < 64; d <<= 1) { float o = lane_up(ps, d, lane); if (lane >= d) ps += o; }
        float b1 = ps, b0 = ps - lf1;
        float bend = lane_read(ps, 63, lane);
        float a0 = li0 - b0, a1 = li1 - b1;
        float pm = fmaxf(a0, a1);
        float mx = pm;
        for (int d = 1; d < 64; d <<= 1) { float o = lane_up(mx, d, lane); if (lane >= d) mx = fmaxf(mx, o); }
        float pmx_prev = lane_up(mx, 1, lane); if (lane == 0) pmx_prev = -3.0e38f;
        float pm0 = fmaxf(pmx_prev, a0), pm1 = mx;
        float amax = lane_read(mx, 63, lane);
        float mnew, carry, mt0, mt1;
        if (RET) { mnew = 0.f; carry = __expf(bend); mt0 = mt1 = 0.f; }
        else { mnew = fmaxf(bend + mprev, bend + amax); carry = __expf(bend + mprev - mnew); mt0 = b0 + fmaxf(mprev, pm0); mt1 = b1 + fmaxf(mprev, pm1); }
        size_t o = (size_t)chain * TT;
        p.BC[o + s0] = b0; p.BC[o + s1] = b1; p.AT[o + s0] = a0; p.AT[o + s1] = a1; p.MT[o + s0] = mt0; p.MT[o + s1] = mt1;
        if (lane == 0) { float* ms = p.MS + ((size_t)chain * NCH + sp) * 4; ms[0] = mprev; ms[1] = mnew; ms[2] = bend; ms[3] = carry; }
        mprev = mnew;
    }
}

struct EpInEven {
    const Params& p; int layer, row0, col0;
    DEV void nat(f32x4 (&acc)[4][4], int wr, int wc, int lane) {
        const int r = lane & 15, quad = lane >> 4;
        const int c0 = col0 + wc * 64, rowb = row0 + wr * 64;
        const int b = row0 / TT; const int sb = rowb - b * TT; const bool lat = sb >= CTX;
        if (c0 < 1024) {
            bf16_t* dst = c0 < 512 ? p.Q1 : p.K1; const int cc = c0 & 511;
#pragma unroll
            for (int m = 0; m < 4; ++m) {
                const int row = rowb + m * 16 + r;
                f32x4 v0 = acc[m][0], v1 = acc[m][1], v2 = acc[m][2], v3 = acc[m][3];
                if (lat) {
                    const int t = sb + m * 16 + r - CTX; const int pr = t / GRID_W, pc = t % GRID_W;
                    const f32x4 ra = *(const f32x4*)(p.ROPE + (pr * 16 + quad * 4) * 2), rb = *(const f32x4*)(p.ROPE + (pr * 16 + quad * 4) * 2 + 4);
                    const f32x4 ca = *(const f32x4*)(p.ROPE + (pc * 16 + quad * 4) * 2), cb = *(const f32x4*)(p.ROPE + (pc * 16 + quad * 4) * 2 + 4);
                    const f32x4 cr = f32x4{ra[0], ra[2], rb[0], rb[2]}, sr = f32x4{ra[1], ra[3], rb[1], rb[3]};
                    const f32x4 cq = f32x4{ca[0], ca[2], cb[0], cb[2]}, sq = f32x4{ca[1], ca[3], cb[1], cb[3]};
                    const f32x4 o0 = v0 * cr - v2 * sr, o2 = v0 * sr + v2 * cr, o1 = v1 * cq - v3 * sq, o3 = v1 * sq + v3 * cq;
                    v0 = o0; v1 = o1; v2 = o2; v3 = o3;
                }
                bf16_t* d = dst + (size_t)row * 512 + cc + quad * 4;
                u32x2 w; w.x = pack2(v0[0], v0[1]); w.y = pack2(v0[2], v0[3]); *(u32x2*)d = w;
                w.x = pack2(v1[0], v1[1]); w.y = pack2(v1[2], v1[3]); *(u32x2*)(d + 16) = w;
                w.x = pack2(v2[0], v2[1]); w.y = pack2(v2[2], v2[3]); *(u32x2*)(d + 32) = w;
                w.x = pack2(v3[0], v3[1]); w.y = pack2(v3[2], v3[3]); *(u32x2*)(d + 48) = w;
            }
        } else if (c0 < 3584) {
            const bool pm = c0 < 2560; bf16_t* dst = pm ? p.PM : p.OG; const int ld = pm ? 1024 : 512; const int cc = pm ? c0 - 1536 : c0 - 3072;
#pragma unroll
            for (int m = 0; m < 4; ++m) {
                bf16_t* d = dst + (size_t)(rowb + m * 16 + r) * ld + cc + quad * 4;
#pragma unroll
                for (int n = 0; n < 4; ++n) { u32x2 w; w.x = pack2(acc[m][n][0], acc[m][n][1]); w.y = pack2(acc[m][n][2], acc[m][n][3]); *(u32x2*)(d + n * 16) = w; }
            }
        } else if (c0 == 3584) {
            const f32x4 gb = *(const f32x4*)(p.ev_gate_b + (layer >> 1) * 16 + quad * 4);
#pragma unroll
            for (int m = 0; m < 4; ++m) *(f32x4*)(p.G + (size_t)(rowb + m * 16 + r) * 16 + quad * 4) = acc[m][0] + gb;
        }
    }
    DEV void operator()(f32x4 (&acc)[4][4], int wr, int wc, int lane) {
        const int r = lane & 15, quad = lane >> 4;
        const int c0 = col0 + wc * 64, rowb = row0 + wr * 64;
        const int b = row0 / TT; const int sb = rowb - b * TT; const bool lat = sb >= CTX;
        if (c0 < 1024) {
            bf16_t* dst = c0 < 512 ? p.Q1 : p.K1; const int cc = c0 & 511;
#pragma unroll
            for (int m = 0; m < 4; ++m)
#pragma unroll
                for (int j = 0; j < 4; ++j) {
                    const int row = rowb + m * 16 + quad * 4 + j;
                    float v0 = acc[m][0][j], v1 = acc[m][1][j], v2 = acc[m][2][j], v3 = acc[m][3][j];
                    if (lat) {
                        const int t = sb + m * 16 + quad * 4 + j - CTX; const int pr = t / GRID_W, pc = t % GRID_W;
                        const float cr = p.ROPE[(pr * 16 + r) * 2], sr = p.ROPE[(pr * 16 + r) * 2 + 1], cq = p.ROPE[(pc * 16 + r) * 2], sq = p.ROPE[(pc * 16 + r) * 2 + 1];
                        float o0 = v0 * cr - v2 * sr, o2 = v0 * sr + v2 * cr, o1 = v1 * cq - v3 * sq, o3 = v1 * sq + v3 * cq;
                        v0 = o0; v1 = o1; v2 = o2; v3 = o3;
                    }
                    bf16_t* d = dst + (size_t)row * 512 + cc + r;
                    d[0] = f2bf(v0); d[16] = f2bf(v1); d[32] = f2bf(v2); d[48] = f2bf(v3);
                }
        } else if (c0 < 1536 || (c0 >= 2560 && c0 < 3072)) {
            const bool at = c0 < 1536; const int cc = at ? c0 - 1024 : c0 - 2560; const int h = cc >> 7, e0 = (cc & 127);
            bf16_t* dst = (at ? p.V1T : p.V2T) + ((size_t)(b * 4 + h) * 128) * TT;
#pragma unroll
            for (int m = 0; m < 4; ++m)
#pragma unroll
                for (int n = 0; n < 4; ++n) {
                    u32x2 o; o.x = pack2(acc[m][n][0], acc[m][n][1]); o.y = pack2(acc[m][n][2], acc[m][n][3]);
                    *(u32x2*)(dst + (size_t)(e0 + n * 16 + r) * TT + sb + m * 16 + quad * 4) = o;
                }
        } else if (c0 < 2560 || (c0 >= 3072 && c0 < 3584)) {
            const bool pm = c0 < 2560; bf16_t* dst = pm ? p.PM : p.OG; const int ld = pm ? 1024 : 512; const int cc = pm ? c0 - 1536 : c0 - 3072;
#pragma unroll
            for (int m = 0; m < 4; ++m)
#pragma unroll
                for (int j = 0; j < 4; ++j) {
                    const int row = rowb + m * 16 + quad * 4 + j; bf16_t* d = dst + (size_t)row * ld + cc + r;
                    d[0] = f2bf(acc[m][0][j]); d[16] = f2bf(acc[m][1][j]); d[32] = f2bf(acc[m][2][j]); d[48] = f2bf(acc[m][3][j]);
                }
        } else if (c0 == 3584) {
            const float gb = p.ev_gate_b[(layer >> 1) * 16 + r];
#pragma unroll
            for (int m = 0; m < 4; ++m)
#pragma unroll
                for (int j = 0; j < 4; ++j) { const int row = rowb + m * 16 + quad * 4 + j; p.G[(size_t)row * 16 + r] = acc[m][0][j] + gb; }
        }
    }
};

struct EpInOdd {
    const Params& p; int layer, row0, col0;
    DEV void nat(f32x4 (&acc)[4][4], int wr, int wc, int lane) {
        const int r = lane & 15, quad = lane >> 4;
        const int c0 = col0 + wc * 64, rowb = row0 + wr * 64;
        const int b = row0 / TT; const int sb = rowb - b * TT; const bool lat = sb >= CTX;
        if (c0 < 512 || (c0 >= 1024 && c0 < 1536)) {
            bf16_t* dst; int ld, cc; float scl = 1.f;
            if (c0 < 256) { dst = p.Q2; ld = 256; cc = c0; } else if (c0 < 512) { dst = p.K2; ld = 256; cc = c0 - 256; scl = 0.125f; } else { dst = p.OG; ld = 512; cc = c0 - 1024; }
#pragma unroll
            for (int m = 0; m < 4; ++m) {
                bf16_t* d = dst + (size_t)(rowb + m * 16 + r) * ld + cc + quad * 4;
#pragma unroll
                for (int n = 0; n < 4; ++n) { u32x2 w; w.x = pack2(acc[m][n][0] * scl, acc[m][n][1] * scl); w.y = pack2(acc[m][n][2] * scl, acc[m][n][3] * scl); *(u32x2*)(d + n * 16) = w; }
            }
        } else if (c0 >= 1536 && c0 < 2176) {
            const bool isq = c0 < 2048; bf16_t* dst = isq ? p.Q1 : p.K1; const int ld = isq ? 512 : 128; const int cc = isq ? c0 - 1536 : c0 - 2048;
            const float* g = p.od_qk_g + ((layer >> 1) * 2 + (isq ? 0 : 1)) * 64 + quad * 4;
            const f32x4 g0 = *(const f32x4*)g, g1 = *(const f32x4*)(g + 16), g2 = *(const f32x4*)(g + 32), g3 = *(const f32x4*)(g + 48);
#pragma unroll
            for (int m = 0; m < 4; ++m) {
                const int row = rowb + m * 16 + r;
                f32x4 v0 = acc[m][0], v1 = acc[m][1], v2 = acc[m][2], v3 = acc[m][3];
                float ss = 0.f;
#pragma unroll
                for (int j = 0; j < 4; ++j) ss += v0[j] * v0[j] + v1[j] * v1[j] + v2[j] * v2[j] + v3[j] * v3[j];
                ss = xadd16(ss); ss = xadd32(ss);
                const float rs = 1.0f / sqrtf(ss * (1.f / 64.f) + EPS);
                v0 = v0 * rs * g0; v1 = v1 * rs * g1; v2 = v2 * rs * g2; v3 = v3 * rs * g3;
                if (lat) {
                    const int t = sb + m * 16 + r - CTX; const int pr = t / GRID_W, pc = t % GRID_W;
                    const f32x4 ra = *(const f32x4*)(p.ROPE + (pr * 16 + quad * 4) * 2), rb = *(const f32x4*)(p.ROPE + (pr * 16 + quad * 4) * 2 + 4);
                    const f32x4 ca = *(const f32x4*)(p.ROPE + (pc * 16 + quad * 4) * 2), cb = *(const f32x4*)(p.ROPE + (pc * 16 + quad * 4) * 2 + 4);
                    const f32x4 cr = f32x4{ra[0], ra[2], rb[0], rb[2]}, sr = f32x4{ra[1], ra[3], rb[1], rb[3]};
                    const f32x4 cq = f32x4{ca[0], ca[2], cb[0], cb[2]}, sq = f32x4{ca[1], ca[3], cb[1], cb[3]};
                    const f32x4 o0 = v0 * cr - v2 * sr, o2 = v0 * sr + v2 * cr, o1 = v1 * cq - v3 * sq, o3 = v1 * sq + v3 * cq;
                    v0 = o0; v1 = o1; v2 = o2; v3 = o3;
                }
                bf16_t* d = dst + (size_t)row * ld + cc + quad * 4;
                u32x2 w; w.x = pack2(v0[0], v0[1]); w.y = pack2(v0[2], v0[3]); *(u32x2*)d = w;
                w.x = pack2(v1[0], v1[1]); w.y = pack2(v1[2], v1[3]); *(u32x2*)(d + 16) = w;
                w.x = pack2(v2[0], v2[1]); w.y = pack2(v2[2], v2[3]); *(u32x2*)(d + 32) = w;
                w.x = pack2(v3[0], v3[1]); w.y = pack2(v3[2], v3[3]); *(u32x2*)(d + 48) = w;
            }
        }
    }
    DEV void operator()(f32x4 (&acc)[4][4], int wr, int wc, int lane) {
        const int r = lane & 15, quad = lane >> 4;
        const int c0 = col0 + wc * 64, rowb = row0 + wr * 64;
        const int b = row0 / TT; const int sb = rowb - b * TT; const bool lat = sb >= CTX;
        if (c0 < 512 || (c0 >= 1024 && c0 < 1536)) {
            bf16_t* dst; int ld, cc; float scl = 1.f;
            if (c0 < 256) { dst = p.Q2; ld = 256; cc = c0; } else if (c0 < 512) { dst = p.K2; ld = 256; cc = c0 - 256; scl = 0.125f; } else { dst = p.OG; ld = 512; cc = c0 - 1024; }
#pragma unroll
            for (int m = 0; m < 4; ++m)
#pragma unroll
                for (int j = 0; j < 4; ++j) {
                    const int row = rowb + m * 16 + quad * 4 + j; bf16_t* d = dst + (size_t)row * ld + cc + r;
                    d[0] = f2bf(acc[m][0][j] * scl); d[16] = f2bf(acc[m][1][j] * scl); d[32] = f2bf(acc[m][2][j] * scl); d[48] = f2bf(acc[m][3][j] * scl);
                }
        } else if (c0 < 1024) {
            const int cc = c0 - 512; const int h = cc >> 7, e0 = cc & 127; bf16_t* dst = p.V2T + ((size_t)(b * 4 + h) * 128) * TT;
#pragma unroll
            for (int m = 0; m < 4; ++m)
#pragma unroll
                for (int n = 0; n < 4; ++n) {
                    u32x2 o; o.x = pack2(acc[m][n][0], acc[m][n][1]); o.y = pack2(acc[m][n][2], acc[m][n][3]);
                    *(u32x2*)(dst + (size_t)(e0 + n * 16 + r) * TT + sb + m * 16 + quad * 4) = o;
                }
        } else if (c0 < 2176) {
            const bool isq = c0 < 2048; bf16_t* dst = isq ? p.Q1 : p.K1; const int ld = isq ? 512 : 128; const int cc = isq ? c0 - 1536 : c0 - 2048;
            const float* g = p.od_qk_g + ((layer >> 1) * 2 + (isq ? 0 : 1)) * 64;
            const float g0 = g[r], g1 = g[16 + r], g2 = g[32 + r], g3 = g[48 + r];
#pragma unroll
            for (int m = 0; m < 4; ++m)
#pragma unroll
                for (int j = 0; j < 4; ++j) {
                    const int row = rowb + m * 16 + quad * 4 + j;
                    float v0 = acc[m][0][j], v1 = acc[m][1][j], v2 = acc[m][2][j], v3 = acc[m][3][j];
                    float ss = v0 * v0 + v1 * v1 + v2 * v2 + v3 * v3;
                    ss = rowred_add(ss);
                    const float rs = 1.0f / sqrtf(ss * (1.f / 64.f) + EPS);
                    v0 *= rs * g0; v1 *= rs * g1; v2 *= rs * g2; v3 *= rs * g3;
                    if (lat) {
                        const int t = sb + m * 16 + quad * 4 + j - CTX; const int pr = t / GRID_W, pc = t % GRID_W;
                        const float cr = p.ROPE[(pr * 16 + r) * 2], sr = p.ROPE[(pr * 16 + r) * 2 + 1], cq = p.ROPE[(pc * 16 + r) * 2], sq = p.ROPE[(pc * 16 + r) * 2 + 1];
                        float o0 = v0 * cr - v2 * sr, o2 = v0 * sr + v2 * cr, o1 = v1 * cq - v3 * sq, o3 = v1 * sq + v3 * cq;
                        v0 = o0; v1 = o1; v2 = o2; v3 = o3;
                    }
                    bf16_t* d = dst + (size_t)row * ld + cc + r;
                    d[0] = f2bf(v0); d[16] = f2bf(v1); d[32] = f2bf(v2); d[48] = f2bf(v3);
                }
        } else {
            const int kv = (c0 - 2176) >> 6; bf16_t* dst = p.V1T + ((size_t)(b * HKV + kv) * 64) * TT;
#pragma unroll
            for (int m = 0; m < 4; ++m)
#pragma unroll
                for (int n = 0; n < 4; ++n) {
                    u32x2 o; o.x = pack2(acc[m][n][0], acc[m][n][1]); o.y = pack2(acc[m][n][2], acc[m][n][3]);
                    *(u32x2*)(dst + (size_t)(n * 16 + r) * TT + sb + m * 16 + quad * 4) = o;
                }
        }
    }
};

DEV void phaseA(const Params& p, int layer, unsigned char* smem) {
    const bool odd = layer & 1;
    const int ncol = odd ? ODD_IN / 256 : EVEN_INP / 256; const int nrow = NTOK / 128;
    const bf16_t* W = odd ? p.WinO + (size_t)(layer >> 1) * ODD_IN * D_MODEL : p.WinE + (size_t)(layer >> 1) * EVEN_INP * D_MODEL;
    const int bid = bid_(); const int tid = tid_(); const int trow = tid >> 2, lc8 = g2_lc(tid) * 8;
    if (odd) {
        for (int t = bid * 4 + (tid >> 6); t < NCHAIN * NCH; t += gridDim.x * 4) {
            const int chain = t / NCH, sp = t % NCH, lane = tid & 63; const int dir = chain & 1, h = (chain >> 1) & 3;
            const float lg = logsigf(p.od_decay[((layer >> 1) * 2 + dir) * HC + h]);
            const int sbase = chunk_of(dir, sp) * CH; const int i0 = 2 * lane, i1 = 2 * lane + 1;
            const int s0 = dir ? sbase + 127 - i0 : sbase + i0, s1 = dir ? sbase + 127 - i1 : sbase + i1;
            const float b0 = lg * (float)(i0 + 1), b1 = lg * (float)(i1 + 1), bend = lg * (float)CH;
            const size_t o = (size_t)chain * TT;
            p.BC[o + s0] = b0; p.BC[o + s1] = b1; p.AT[o + s0] = -b0; p.AT[o + s1] = -b1; p.MT[o + s0] = 0.f; p.MT[o + s1] = 0.f;
            if (lane == 0) { float* ms = p.MS + ((size_t)chain * NCH + sp) * 4; ms[0] = 0.f; ms[1] = 0.f; ms[2] = bend; ms[3] = __expf(bend); }
        }
    }
    const WorkRange wr = xcd_range(nrow * ncol, bid);
    for (int t = wr.lo; t < wr.hi; t += wr.step) {
        int rt, ct; dense_tile(t, nrow, ncol, rt, ct); const int row0 = rt * 128, col0 = ct * 256;
        const bf16_t* a0 = p.HIN + (size_t)(row0 + trow) * D_MODEL + lc8;
        const bf16_t* bb = W + (size_t)(col0 + trow) * D_MODEL + lc8;
        if (odd) {
            EpInOdd ep{p, layer, row0, col0};
            if (ct == 2 || ct == 3 || ct == 8) gemm_tile2<2, false>(smem, a0, a0 + (size_t)64 * D_MODEL, bb, D_MODEL, D_MODEL / 32, ep);
            else gemm_tile2<2, true>(smem, a0, a0 + (size_t)64 * D_MODEL, bb, D_MODEL, D_MODEL / 32, ep);
        } else {
            EpInEven ep{p, layer, row0, col0};
            if (ct == 4 || ct == 5 || ct == 10 || ct == 11) gemm_tile2<2, false>(smem, a0, a0 + (size_t)64 * D_MODEL, bb, D_MODEL, D_MODEL / 32, ep);
            else gemm_tile2<2, true>(smem, a0, a0 + (size_t)64 * D_MODEL, bb, D_MODEL, D_MODEL / 32, ep);
        }
    }
#ifdef PROBE_GEMM
    {
        Params q = p; bf16_t* scr = (bf16_t*)p.DC;
        q.Q1 = scr; q.K1 = scr; q.V1T = scr; q.PM = scr; q.V2T = scr; q.OG = scr; q.G = (float*)scr; q.Q2 = scr; q.K2 = scr;
        for (int t = wr.lo; t < wr.hi; t += wr.step) {
            int rt, ct; dense_tile(t, nrow, ncol, rt, ct); const int row0 = rt * 128, col0 = ct * 256;
            const bf16_t* a0 = p.HIN + (size_t)(row0 + trow) * D_MODEL + lc8;
            const bf16_t* bb = W + (size_t)(col0 + trow) * D_MODEL + lc8;
            const int erow0 = (PROBE_GEMM == 2) ? (row0 % TT >= CTX ? CTX : 0) : row0;
            if (odd) {
                EpInOdd ep{q, layer, erow0, col0};
                if (ct == 2 || ct == 3 || ct == 8) gemm_tile2<2, false>(smem, a0, a0 + (size_t)64 * D_MODEL, bb, D_MODEL, D_MODEL / 32, ep);
                else gemm_tile2<2, true>(smem, a0, a0 + (size_t)64 * D_MODEL, bb, D_MODEL, D_MODEL / 32, ep);
            } else {
                EpInEven ep{q, layer, erow0, col0};
                if (ct == 4 || ct == 5 || ct == 10 || ct == 11) gemm_tile2<2, false>(smem, a0, a0 + (size_t)64 * D_MODEL, bb, D_MODEL, D_MODEL / 32, ep);
                else gemm_tile2<2, true>(smem, a0, a0 + (size_t)64 * D_MODEL, bb, D_MODEL, D_MODEL / 32, ep);
            }
        }
    }
#endif
}
DEV void phase0b(const Params& p) {
    const int total = NTOK * (D_MODEL / 4);
    for (int idx = bid_() * 256 + tid_(); idx < total; idx += gridDim.x * 256) {
        const int row = idx / (D_MODEL / 4), k = (idx % (D_MODEL / 4)) * 4; const int b = row / TT, sq = row % TT; const int bb = sq < CTX ? BATCH : b;
        const float* mod = p.MOD + (size_t)bb * 6 * D_MODEL;
        const f32x4 x = bf4(*(const u32x2*)(p.X + (size_t)row * D_MODEL + k)), sh = *(const f32x4*)(mod + k), sc = *(const f32x4*)(mod + D_MODEL + k);
        u32x2 o; o.x = pack2(x.x * (1.f + sc.x) + sh.x, x.y * (1.f + sc.y) + sh.y); o.y = pack2(x.z * (1.f + sc.z) + sh.z, x.w * (1.f + sc.w) + sh.w);
        *(u32x2*)(p.HIN + (size_t)row * D_MODEL + k) = o;
    }
}

static_assert(NCH <= 64, "chunk summaries of a chain are scanned by one wave");
DEV void gate_chunk(const Params& p, int chain, int sp, int lane) {
    const int dir = chain & 1, h = (chain >> 1) & 3, b = chain >> 3;
    const int u = chunk_of(dir, sp); const int sbase = u * CH;
    const int i0 = 2 * lane, i1 = 2 * lane + 1;
    const int s0 = dir ? sbase + 127 - i0 : sbase + i0, s1 = dir ? sbase + 127 - i1 : sbase + i1;
    const float* g0 = p.G + ((size_t)b * TT + s0) * 16; const float* g1 = p.G + ((size_t)b * TT + s1) * 16;
    const float li0 = g0[(2 * dir) * 4 + h], li1 = g1[(2 * dir) * 4 + h];
    const float lf0 = logsigf(g0[(2 * dir + 1) * 4 + h]), lf1 = logsigf(g1[(2 * dir + 1) * 4 + h]);
    float ps = lf0 + lf1;
    for (int d = 1; d < 64; d <<= 1) { float o = lane_up(ps, d, lane); if (lane >= d) ps += o; }
    const float b1 = ps, b0 = ps - lf1;
    const float bend = lane_read(ps, 63, lane);
    const float a0 = li0 - b0, a1 = li1 - b1;
    float mx = fmaxf(a0, a1);
    for (int d = 1; d < 64; d <<= 1) { float o = lane_up(mx, d, lane); if (lane >= d) mx = fmaxf(mx, o); }
    float pmx_prev = lane_up(mx, 1, lane); if (lane == 0) pmx_prev = -3.0e38f;
    const float pm0 = fmaxf(pmx_prev, a0), pm1 = mx;
    const float amax = lane_read(mx, 63, lane);
    const size_t o = (size_t)chain * TT;
    p.BC[o + s0] = b0; p.BC[o + s1] = b1; p.AT[o + s0] = a0; p.AT[o + s1] = a1; p.MT[o + s0] = pm0; p.MT[o + s1] = pm1;
    if (lane == 0) { float* c2 = p.CH2 + ((size_t)chain * NCH + sp) * 2; c2[0] = bend; c2[1] = amax; }
}
DEV void phaseB(const Params& p, int layer) {
    const int tid = tid_();
    const int bid = bid_();
    for (int t = bid * 4 + (tid >> 6); t < NCHAIN * NCH; t += gridDim.x * 4) gate_chunk(p, t / NCH, t % NCH, tid & 63);
    const float* cw = p.ev_conv_w + (size_t)(layer >> 1) * 3 * 1024; const float* cb = p.ev_conv_b + (size_t)(layer >> 1) * 1024;
    const int total = NTOK * 128;
    for (int idx = bid * 256 + tid; idx < total; idx += gridDim.x * 256) {
        const int row = idx >> 7, cg8 = (idx & 127) * 8; const int b = row / TT, s = row % TT;
        const bool hasp = (s != 0) && (s != CTX), hasn = (s != CTX - 1) && (s != TT - 1);
        Frag xm, x0, xp; x0.q = *(const u32x4*)(p.PM + (size_t)row * 1024 + cg8);
        xm.q = u32x4{0u, 0u, 0u, 0u}; xp.q = u32x4{0u, 0u, 0u, 0u};
        if (hasp) xm.q = *(const u32x4*)(p.PM + (size_t)(row - 1) * 1024 + cg8);
        if (hasn) xp.q = *(const u32x4*)(p.PM + (size_t)(row + 1) * 1024 + cg8);
        float y[8];
#pragma unroll
        for (int i = 0; i < 8; ++i) {
            const int ch = cg8 + i;
            float v = cb[ch] + bf2f((bf16_t)xm.v[i]) * cw[ch] + bf2f((bf16_t)x0.v[i]) * cw[1024 + ch] + bf2f((bf16_t)xp.v[i]) * cw[2048 + ch];
            y[i] = siluf(v);
        }
        if (cg8 < 512) {
            u32x4 o; o.x = pack2(y[0], y[1]); o.y = pack2(y[2], y[3]); o.z = pack2(y[4], y[5]); o.w = pack2(y[6], y[7]);
            *(u32x4*)(p.Q2 + (size_t)row * 512 + cg8) = o;
        } else {
            const float sc = 0.08838834764831845f;
#pragma unroll
            for (int i = 0; i < 8; ++i) y[i] *= sc;
            u32x4 o; o.x = pack2(y[0], y[1]); o.y = pack2(y[2], y[3]); o.z = pack2(y[4], y[5]); o.w = pack2(y[6], y[7]);
            const int kc = cg8 - 512; *(u32x4*)(p.K2 + (size_t)row * 512 + kc) = o;
        }
    }
}

constexpr int KLD1 = 136, KLD0 = 72, VLD = 72;
template <int NC, int DV, int QT>
struct AttnState { f32x4 O[NC][DV / 16][QT]; f32x4 L[NC][QT]; float m[NC][QT]; };

DEV float max3f(float a, float b, float c) {
#ifdef CPU_EMU
    return fmaxf(fmaxf(a, b), c);
#else
    float d; asm("v_max3_f32 %0, %1, %2, %3" : "=v"(d) : "v"(a), "v"(b), "v"(c)); return d;
#endif
}
DEV float max2f(float a, float b) {
#ifdef CPU_EMU
    return fmaxf(a, b);
#else
    float d; asm("v_max_f32 %0, %1, %2" : "=v"(d) : "v"(a), "v"(b)); return d;
#endif
}
DEV bool wave_any(bool pr) {
#ifdef CPU_EMU
    int v = pr ? 1 : 0; for (int m = 1; m < 64; m <<= 1) v |= __shfl_xor(v, m); return v != 0;
#else
    return __builtin_amdgcn_ballot_w64(pr) != 0;
#endif
}

template <int NC, int DV, int QT, int KW>
DEV void attn_core(bf16_t* sm, const bf16_t* Kg, int ldk, const bf16_t* VTg, int nkeys, const Frag (&qf)[NC][2][QT], AttnState<NC, DV, QT>& st, float sc2, int koff) {
    constexpr int KLD = KW + 8;
    constexpr int NKR = KW / 32, NVR = DV / 32;
    constexpr int KBUF = 64 * KLD, VBUF = DV * VLD;
    constexpr float TH = 6.0f;
    const float isc2 = 1.0f / sc2;
    const int tid = tid_(), lane = tid & 63, r = lane & 15, quad = lane >> 4;
    u32x4 kreg[NKR], vreg[NVR];
    constexpr int VTPR = 8 / NVR;
    const bf16_t* kp = Kg + (size_t)(tid >> 2) * ldk + (tid & 3) * NKR * 8;
    const bf16_t* vp0 = VTg + (size_t)(tid / VTPR) * TT + (tid % VTPR) * NVR * 8;
    const int klo = (tid >> 2) * KLD + (tid & 3) * NKR * 8;
    const int nt = nkeys >> 6;
    Frag ones; ones.u[0] = ones.u[1] = ones.u[2] = ones.u[3] = 0x3F803F80u;
    auto loadK = [&]() {
#pragma unroll
        for (int i = 0; i < NKR; ++i) kreg[i] = *(const u32x4*)(kp + i * 8);
        kp += (size_t)64 * ldk; };
    auto loadV = [&]() {
#pragma unroll
        for (int i = 0; i < NVR; ++i) vreg[i] = *(const u32x4*)(vp0 + i * 8);
        vp0 += 64; };
    auto storeK = [&](int buf) {
#pragma unroll
        for (int i = 0; i < NKR; ++i) *(u32x4*)(sm + buf * KBUF + klo + i * 8) = kreg[i]; };
    auto storeV = [&](int buf) {
        bf16_t* vrow = sm + buf * VBUF + 2 * KBUF + (tid / VTPR) * VLD;
#pragma unroll
        for (int i = 0; i < NVR; ++i) {
            const int c = (tid % VTPR) * NVR + i;
#pragma unroll
            for (int hh = 0; hh < 2; ++hh) {
                const int g = 2 * c + hh; const int blk = g >> 3, g32 = g & 7; const int pos = blk * 32 + (2 * (g32 & 3) + (g32 >> 2)) * 4;
                u32x2 w; w.x = hh ? vreg[i].z : vreg[i].x; w.y = hh ? vreg[i].w : vreg[i].y;
                *(u32x2*)(vrow + pos) = w;
            }
        } };
    float al[QT], thr[QT], mxs[QT]; bool resc = false;
#pragma unroll
    for (int qt = 0; qt < QT; ++qt) { al[qt] = 1.f; thr[qt] = 0.f; mxs[qt] = 0.f; }
    auto sm_step = [&](int k, f32x4 (&sn)[4][QT], Frag (&pfn)[QT][2], const bool force) {
        if (k < QT) {
            const int qt = k;
            float mx = max3f(sn[0][qt][0], sn[0][qt][1], sn[0][qt][2]);
            mx = max3f(mx, sn[0][qt][3], sn[1][qt][0]); mx = max3f(mx, sn[1][qt][1], sn[1][qt][2]); mx = max3f(mx, sn[1][qt][3], sn[2][qt][0]);
            mx = max3f(mx, sn[2][qt][1], sn[2][qt][2]); mx = max3f(mx, sn[2][qt][3], sn[3][qt][0]); mx = max3f(mx, sn[3][qt][1], sn[3][qt][2]);
            mxs[qt] = max2f(mx, sn[3][qt][3]);
        } else if (k == QT) {
            bool need = false;
#pragma unroll
            for (int qt = 0; qt < QT; ++qt) need = need || (mxs[qt] > thr[qt]);
            if (force || wave_any(need)) {
#pragma unroll
                for (int qt = 0; qt < QT; ++qt) {
                    float mx = xmax16(mxs[qt]); mx = xmax32(mx);
                    const float mn = fmaxf(st.m[0][qt], mx * sc2);
                    al[qt] *= __builtin_amdgcn_exp2f(st.m[0][qt] - mn);
                    st.m[0][qt] = mn; thr[qt] = (mn + TH) * isc2;
                }
                resc = true;
            }
        } else if (k <= 5 * QT) {
            const int qt = (k - QT - 1) >> 2, kt = (k - QT - 1) & 3; const float mn = st.m[0][qt];
#pragma unroll
            for (int jj = 0; jj < 4; ++jj) sn[kt][qt][jj] = __builtin_amdgcn_exp2f(sn[kt][qt][jj] * sc2 - mn);
        } else if (k <= 7 * QT) {
            const int qt = (k - 5 * QT - 1) >> 1, kk = (k - 5 * QT - 1) & 1;
            pfn[qt][kk].u[0] = pack2(sn[2 * kk][qt][0], sn[2 * kk][qt][1]); pfn[qt][kk].u[1] = pack2(sn[2 * kk][qt][2], sn[2 * kk][qt][3]);
            pfn[qt][kk].u[2] = pack2(sn[2 * kk + 1][qt][0], sn[2 * kk + 1][qt][1]); pfn[qt][kk].u[3] = pack2(sn[2 * kk + 1][qt][2], sn[2 * kk + 1][qt][3]);
#ifndef CPU_EMU
            asm volatile("" : "+v"(pfn[qt][kk].u[0]), "+v"(pfn[qt][kk].u[1]), "+v"(pfn[qt][kk].u[2]), "+v"(pfn[qt][kk].u[3]));
#endif
        }
    };
    constexpr int NSM = 7 * QT + 1;
    auto rescale = [&]() {
        if (resc) {
#pragma unroll
            for (int qt = 0; qt < QT; ++qt) {
#pragma unroll
                for (int et = 0; et < DV / 16; ++et) { st.O[0][et][qt][0] *= al[qt]; st.O[0][et][qt][1] *= al[qt]; st.O[0][et][qt][2] *= al[qt]; st.O[0][et][qt][3] *= al[qt]; }
                st.L[0][qt][0] *= al[qt]; st.L[0][qt][1] *= al[qt]; st.L[0][qt][2] *= al[qt]; st.L[0][qt][3] *= al[qt];
                al[qt] = 1.f;
            }
            resc = false;
        }
    };
    auto pv = [&](int buf, const Frag (&pf)[QT][2]) {
        const bf16_t* Vs = sm + 2 * KBUF + buf * VBUF;
#pragma unroll
        for (int kk = 0; kk < 2; ++kk)
#pragma unroll
            for (int qt = 0; qt < QT; ++qt) st.L[0][qt] = mfma16(ones.v, pf[qt][kk].v, st.L[0][qt]);
#pragma unroll
        for (int et = 0; et < DV / 16; ++et) {
#pragma unroll
            for (int kk = 0; kk < 2; ++kk) {
                Frag vf; vf.q = *(const u32x4*)(Vs + (et * 16 + r) * VLD + kk * 32 + quad * 8);
#pragma unroll
                for (int qt = 0; qt < QT; ++qt) st.O[0][et][qt] = mfma16(vf.v, pf[qt][kk].v, st.O[0][et][qt]);
            }
        } };
    Frag pfa[QT][2], pfb[QT][2];
    loadK();
    __syncthreads();
    storeK(0);
    loadK();
    loadV();
    __syncthreads();
    {
        f32x4 s0[4][QT];
        const bf16_t* Ks = sm;
#pragma unroll
        for (int kt = 0; kt < 4; ++kt) {
            Frag ka0, ka1;
            ka0.q = *(const u32x4*)(Ks + (kt * 16 + r) * KLD + koff + quad * 8);
            ka1.q = *(const u32x4*)(Ks + (kt * 16 + r) * KLD + koff + 32 + quad * 8);
#pragma unroll
            for (int qt = 0; qt < QT; ++qt) {
                f32x4 z = f32x4{0.f, 0.f, 0.f, 0.f};
                z = mfma16(ka0.v, qf[0][0][qt].v, z); z = mfma16(ka1.v, qf[0][1][qt].v, z); s0[kt][qt] = z;
            }
        }
#pragma unroll
        for (int k = 0; k < NSM; ++k) sm_step(k, s0, pfa, true);
    }
    storeK(1);
    storeV(0);
    __syncthreads();
    auto body = [&](const int par, const Frag (&pin)[QT][2], Frag (&pout)[QT][2]) {
        f32x4 sn[4][QT];
        rescale();
        {
            const bf16_t* Ks = sm + ((par + 1) & 1) * KBUF + r * KLD + koff + quad * 8;
            Frag ka[2][2];
            ka[0][0].q = *(const u32x4*)(Ks); ka[0][1].q = *(const u32x4*)(Ks + 32);
#pragma unroll
            for (int kt = 0; kt < 4; ++kt) {
                if (kt < 3) { ka[(kt + 1) & 1][0].q = *(const u32x4*)(Ks + (kt + 1) * 16 * KLD); ka[(kt + 1) & 1][1].q = *(const u32x4*)(Ks + (kt + 1) * 16 * KLD + 32); }
#pragma unroll
                for (int qt = 0; qt < QT; ++qt) {
                    f32x4 z = f32x4{0.f, 0.f, 0.f, 0.f};
                    z = mfma16(ka[kt & 1][0].v, qf[0][0][qt].v, z);
                    z = mfma16(ka[kt & 1][1].v, qf[0][1][qt].v, z); sn[kt][qt] = z;
                }
                if (kt < 2) {
#pragma unroll
                    for (int qt = 0; qt < QT; ++qt) st.L[0][qt] = mfma16(ones.v, pin[qt][kt].v, st.L[0][qt]);
                }
                SCHED_BARRIER();
            }
        }
        {
            const bf16_t* Vs = sm + 2 * KBUF + (par & 1) * VBUF + r * VLD + quad * 8;
            constexpr int NPV = (DV / 16) * 2; constexpr int SPP = (NSM + NPV - 1) / NPV;
            Frag vf[2];
            vf[0].q = *(const u32x4*)Vs;
#pragma unroll
            for (int i = 0; i < NPV; ++i) {
                const int et = i >> 1, kk = i & 1;
                if (i + 1 < NPV) vf[(i + 1) & 1].q = *(const u32x4*)(Vs + ((i + 1) >> 1) * 16 * VLD + ((i + 1) & 1) * 32);
#pragma unroll
                for (int qt = 0; qt < QT; ++qt) st.O[0][et][qt] = mfma16(vf[i & 1].v, pin[qt][kk].v, st.O[0][et][qt]);
#pragma unroll
                for (int q = 0; q < SPP; ++q) sm_step(i * SPP + q, sn, pout, false);
                SCHED_BARRIER();
            }
        }
    };
    int j = 0;
    for (; j + 2 < nt; j += 2) {
        loadK(); loadV();
        body(0, pfa, pfb);
        storeK(0); storeV(1);
        __syncthreads();
        loadK(); loadV();
        body(1, pfb, pfa);
        storeK(1); storeV(0);
        __syncthreads();
    }
    loadV(); body(0, pfa, pfb); storeV(1); __syncthreads();
    rescale();
    pv(1, pfb);
    __syncthreads();
}

DEV void attn_diff_item(const Params& p, int layer, int item, bf16_t* sm) {
    const int nqb = TT / 64; const int qb = item % nqb, h = (item / nqb) % HA, b = item / (nqb * HA);
    const int tid = tid_(), wid = tid >> 6, lane = tid & 63, r = lane & 15, quad = lane >> 4;
    const int comp = wid & 1, rg = wid >> 1;
    const int s0 = qb * 64; const bool ctxq = s0 < CTX; const int nkeys = ctxq ? CTX : TT;
    Frag qf[1][2][2];
#pragma unroll
    for (int ks = 0; ks < 2; ++ks)
#pragma unroll
        for (int qt = 0; qt < 2; ++qt) qf[0][ks][qt].q = *(const u32x4*)(p.Q1 + ((size_t)b * TT + s0 + rg * 32 + qt * 16 + r) * 512 + h * 128 + comp * 64 + ks * 32 + quad * 8);
    AttnState<1, 128, 2> st;
#pragma unroll
    for (int qt = 0; qt < 2; ++qt) {
        st.m[0][qt] = -1.0e30f; st.L[0][qt] = f32x4{0.f, 0.f, 0.f, 0.f};
#pragma unroll
        for (int et = 0; et < 8; ++et) st.O[0][et][qt] = f32x4{0.f, 0.f, 0.f, 0.f};
    }
    attn_core<1, 128, 2, 128>(sm, p.K1 + (size_t)b * TT * 512 + h * 128, 512, p.V1T + ((size_t)(b * HA + h) * 128) * TT, nkeys, qf, st, 0.125f * 1.4426950408889634f, comp * 64);
    const float lam = p.LAM[layer >> 1]; const float lam_init = 0.8f - 0.6f * expf(-0.3f * (float)layer);
    const float* sg = p.ev_subln_g + (layer >> 1) * 128;
    f32x4* xo = (f32x4*)sm;
    __syncthreads();
    if (comp == 1) {
#pragma unroll
        for (int qt = 0; qt < 2; ++qt) {
            const float i2 = lam / st.L[0][qt][0];
#pragma unroll
            for (int et = 0; et < 8; ++et) xo[((rg * 2 + qt) * 8 + et) * 64 + lane] = f32x4{st.O[0][et][qt][0] * i2, st.O[0][et][qt][1] * i2, st.O[0][et][qt][2] * i2, st.O[0][et][qt][3] * i2};
        }
    }
    __syncthreads();
    if (comp == 0) {
#pragma unroll
        for (int qt = 0; qt < 2; ++qt) {
            const float i1 = 1.f / st.L[0][qt][0];
            float ss = 0.f; f32x4 o[8];
#pragma unroll
            for (int et = 0; et < 8; ++et) {
                const f32x4 x2 = xo[((rg * 2 + qt) * 8 + et) * 64 + lane];
#pragma unroll
                for (int j = 0; j < 4; ++j) { float v = st.O[0][et][qt][j] * i1 - x2[j]; o[et][j] = v; ss += v * v; }
            }
            ss = xadd16(ss); ss = xadd32(ss);
            const float rs = (1.f - lam_init) / sqrtf(ss * (1.f / 128.f) + EPS);
            bf16_t* dst = p.CAT + ((size_t)b * TT + s0 + rg * 32 + qt * 16 + r) * 1024 + h * 128;
#pragma unroll
            for (int et = 0; et < 8; ++et) {
                const int e = et * 16 + quad * 4;
                u32x2 w; w.x = pack2(o[et][0] * rs * sg[e], o[et][1] * rs * sg[e + 1]); w.y = pack2(o[et][2] * rs * sg[e + 2], o[et][3] * rs * sg[e + 3]);
                *(u32x2*)(dst + e) = w;
            }
        }
    }
}

DEV void attn_gqa_item(const Params& p, int item, bf16_t* sm) {
    const int nqb = TT / 32; const int qb = item % nqb, kv = (item / nqb) % HKV, b = item / (nqb * HKV);
    const int tid = tid_(), wid = tid >> 6, lane = tid & 63, r = lane & 15, quad = lane >> 4;
    const int s0 = qb * 32; const bool ctxq = s0 < CTX; const int nkeys = ctxq ? CTX : TT; const int hq = kv * 4 + wid;
    Frag qf[1][2][2];
#pragma unroll
    for (int ks = 0; ks < 2; ++ks)
#pragma unroll
        for (int qt = 0; qt < 2; ++qt) qf[0][ks][qt].q = *(const u32x4*)(p.Q1 + ((size_t)b * TT + s0 + qt * 16 + r) * 512 + hq * 64 + ks * 32 + quad * 8);
    AttnState<1, 64, 2> st;
#pragma unroll
    for (int qt = 0; qt < 2; ++qt) {
        st.m[0][qt] = -1.0e30f; st.L[0][qt] = f32x4{0.f, 0.f, 0.f, 0.f};
#pragma unroll
        for (int et = 0; et < 4; ++et) st.O[0][et][qt] = f32x4{0.f, 0.f, 0.f, 0.f};
    }
    attn_core<1, 64, 2, 64>(sm, p.K1 + (size_t)b * TT * 128 + kv * 64, 128, p.V1T + ((size_t)(b * HKV + kv) * 64) * TT, nkeys, qf, st, 0.125f * 1.4426950408889634f, 0);
#pragma unroll
    for (int qt = 0; qt < 2; ++qt) {
        const float il = 1.f / st.L[0][qt][0];
        bf16_t* dst = p.CAT + ((size_t)b * TT + s0 + qt * 16 + r) * 1024 + 512 + hq * 64;
#pragma unroll
        for (int et = 0; et < 4; ++et) {
            const int e = et * 16 + quad * 4;
            u32x2 w; w.x = pack2(st.O[0][et][qt][0] * il, st.O[0][et][qt][1] * il); w.y = pack2(st.O[0][et][qt][2] * il, st.O[0][et][qt][3] * il);
            *(u32x2*)(dst + e) = w;
        }
    }
}

template <int DK, bool NRM>
DEV void rec_dc_item(const Params& p, int item, bf16_t* sm) {
    constexpr int ET = NRM ? 9 : 8; constexpr int ER = NRM ? EVR : 128; constexpr int SLD = 136;
    const int chain = item / NCH, sp = item % NCH; const int dir = chain & 1, h = (chain >> 1) & 3, b = chain >> 3;
    const int u = chunk_of(dir, sp), sbase = u * CH;
    const int tid = tid_(), wid = tid >> 6, lane = tid & 63, r = lane & 15, quad = lane >> 4;
    bf16_t* Vs = sm; bf16_t* Ks = sm + 128 * SLD; float* wk = (float*)(sm + 128 * SLD + DK * SLD);
    __syncthreads();
    float ms1, ms2;
    if (NRM) {
        const float* c2 = p.CH2 + (size_t)chain * NCH * 2;
        const float be = lane < NCH ? c2[lane * 2] : 0.f, am = lane < NCH ? c2[lane * 2 + 1] : 0.f;
        float m = 0.f, mp = 0.f, bq = 0.f;
        for (int q = 0; q <= sp; ++q) { bq = lane_read(be, q, lane); const float aq = lane_read(am, q, lane); mp = m; m = fmaxf(bq + m, bq + aq); }
        ms1 = m; ms2 = bq;
        if (tid == 0) { float* mo = p.MS + ((size_t)chain * NCH + sp) * 4; mo[0] = mp; mo[1] = m; mo[2] = bq; mo[3] = __expf(bq + mp - m); }
    } else { const float* ms = p.MS + ((size_t)chain * NCH + sp) * 4; ms1 = ms[1]; ms2 = ms[2]; }
    if (tid < 128) wk[tid] = __expf(ms2 + p.AT[(size_t)chain * TT + sbase + tid] - ms1);
    const bf16_t* kg = p.K2 + ((size_t)b * TT + sbase) * (4 * DK) + h * DK;
    constexpr int NKC = 128 * (DK / 8) / 256;
    Frag kpre[NKC];
#pragma unroll
    for (int i = 0; i < NKC; ++i) { const int c = tid + 256 * i; const int sl = c & 127, dc8 = (c >> 7) * 8; kpre[i].q = *(const u32x4*)(kg + (size_t)sl * (4 * DK) + dc8); }
    const bf16_t* vt = p.V2T + ((size_t)(b * 4 + h) * 128) * TT + sbase;
    for (int c = tid; c < 128 * 16; c += 256) { int row = c >> 4, kc = c & 15; *(u32x4*)(Vs + row * SLD + kc * 8) = *(const u32x4*)(vt + (size_t)row * TT + kc * 8); }
    __syncthreads();
#pragma unroll
    for (int ii = 0; ii < NKC; ++ii) {
        const int c = tid + 256 * ii; const int sl = c & 127, dc8 = (c >> 7) * 8; const Frag f = kpre[ii];
        const float w = wk[sl];
#pragma unroll
        for (int i = 0; i < 8; ++i) Ks[(dc8 + i) * SLD + sl] = f2bf(bf2f((bf16_t)f.v[i]) * w);
    }
    __syncthreads();
    constexpr int NTW = DK / 64;
    f32x4 acc[ET][NTW];
#pragma unroll
    for (int et = 0; et < ET; ++et)
#pragma unroll
        for (int n = 0; n < NTW; ++n) acc[et][n] = f32x4{0.f, 0.f, 0.f, 0.f};
#pragma unroll
    for (int ks = 0; ks < 4; ++ks) {
        Frag bf[NTW];
#pragma unroll
        for (int n = 0; n < NTW; ++n) bf[n].q = *(const u32x4*)(Ks + ((wid + 4 * n) * 16 + r) * SLD + ks * 32 + quad * 8);
#pragma unroll
        for (int et = 0; et < ET; ++et) {
            Frag af;
            if (et < 8) af.q = *(const u32x4*)(Vs + (et * 16 + r) * SLD + ks * 32 + quad * 8);
            else { const unsigned one = (r == 0) ? 0x3F803F80u : 0u; af.q = u32x4{one, one, one, one}; }
#pragma unroll
            for (int n = 0; n < NTW; ++n) acc[et][n] = mfma16(bf[n].v, af.v, acc[et][n]);
        }
    }
    bf16_t* dc = p.DC + ((size_t)chain * NCH + sp) * ER * DK;
#pragma unroll
    for (int et = 0; et < ET; ++et)
#pragma unroll
        for (int n = 0; n < NTW; ++n) {
            u32x2 w; w.x = pack2(acc[et][n][0], acc[et][n][1]); w.y = pack2(acc[et][n][2], acc[et][n][3]);
            *(u32x2*)(dc + (size_t)(et * 16 + r) * DK + (wid + 4 * n) * 16 + quad * 4) = w;
        }
}

template <int DK, bool NRM>
DEV void rec_scan(const Params& p) {
    constexpr int ER = NRM ? EVR : 128; constexpr int EPC = ER * DK; constexpr int PD = 4;
    const int total = NCHAIN * (EPC / 8);
    for (int idx = bid_() * 256 + tid_(); idx < total; idx += gridDim.x * 256) {
        const int chain = idx / (EPC / 8), el = (idx % (EPC / 8)) * 8;
        const bf16_t* dc = p.DC + (size_t)chain * NCH * EPC + el; bf16_t* cp = p.CP + (size_t)chain * NCH * EPC + el;
        const float* ms = p.MS + (size_t)chain * NCH * 4 + 3;
        float c[8];
#pragma unroll
        for (int i = 0; i < 8; ++i) c[i] = 0.f;
        u32x4 q[PD]; float cr[PD];
#pragma unroll
        for (int i = 0; i < PD; ++i) if (i < NCH) { q[i] = *(const u32x4*)(dc + (size_t)i * EPC); cr[i] = ms[i * 4]; }
#pragma unroll 1
        for (int g = 0; g < NCH; g += PD)
#pragma unroll
        for (int i = 0; i < PD; ++i) {
            const int sp = g + i; if (sp >= NCH) break;
            const u32x4 d = q[i]; const float car = cr[i];
            if (sp + PD < NCH) { q[i] = *(const u32x4*)(dc + (size_t)(sp + PD) * EPC); cr[i] = ms[(sp + PD) * 4]; }
            u32x4 o; o.x = pack2(c[0], c[1]); o.y = pack2(c[2], c[3]); o.z = pack2(c[4], c[5]); o.w = pack2(c[6], c[7]);
            *(u32x4*)(cp + (size_t)sp * EPC) = o;
            c[0] = car * c[0] + __uint_as_float(d.x << 16); c[1] = car * c[1] + __uint_as_float(d.x & 0xFFFF0000u);
            c[2] = car * c[2] + __uint_as_float(d.y << 16); c[3] = car * c[3] + __uint_as_float(d.y & 0xFFFF0000u);
            c[4] = car * c[4] + __uint_as_float(d.z << 16); c[5] = car * c[5] + __uint_as_float(d.z & 0xFFFF0000u);
            c[6] = car * c[6] + __uint_as_float(d.w << 16); c[7] = car * c[7] + __uint_as_float(d.w & 0xFFFF0000u);
        }
    }
}

template <int DK, bool NRM>
DEV void rec_out_item(const Params& p, int layer, int item, bf16_t* sm) {
    constexpr int ET = NRM ? 9 : 8; constexpr int ER = NRM ? EVR : 128; constexpr int KLD = DK + 8; constexpr int SLD = 136; constexpr int NKS = DK / 32;
    const int half = item & 1, u = (item >> 1) % NCH, h = ((item >> 1) / NCH) & 3, b = (item >> 1) / (NCH * 4);
    const int tid = tid_(), wid = tid >> 6, lane = tid & 63, r = lane & 15, quad = lane >> 4;
    const int sbase = u * CH; const int tl = half * 64 + wid * 16 + r;
    const size_t rowt = (size_t)b * TT + sbase + tl; const int tq = tl - quad * 4;
    bf16_t* RA = sm; bf16_t* Vs = sm + ER * KLD; float* as_ = (float*)(Vs + 128 * SLD);
    __syncthreads();
    const bf16_t* kg = p.K2 + ((size_t)b * TT + sbase) * (4 * DK) + h * DK;
    for (int c = tid; c < 128 * (DK / 8); c += 256) { int row = c / (DK / 8), kc = c % (DK / 8); *(u32x4*)(RA + row * KLD + kc * 8) = *(const u32x4*)(kg + (size_t)row * (4 * DK) + kc * 8); }
    const int chain0 = (b * 4 + h) * 2;
    as_[tid] = p.AT[(size_t)(chain0 + (tid >> 7)) * TT + sbase + (tid & 127)];
    Frag qf[NKS];
#pragma unroll
    for (int ks = 0; ks < NKS; ++ks) qf[ks].q = *(const u32x4*)(p.Q2 + rowt * (4 * DK) + h * DK + ks * 32 + quad * 8);
    const bf16_t* vt = p.V2T + ((size_t)(b * 4 + h) * 128) * TT + sbase;
    u32x4 vpre[8];
#pragma unroll
    for (int i = 0; i < 8; ++i) { const int c = tid + 256 * i; const int row = c >> 4, kc = c & 15; vpre[i] = *(const u32x4*)(vt + (size_t)row * TT + kc * 8); }
    constexpr int NCPC = ER * (DK / 8), NCPI = (NCPC + 255) / 256;
    u32x4 cpre[NCPI];
    {
        const bf16_t* cp0 = p.CP + ((size_t)chain0 * NCH + sp_of(0, u)) * ER * DK;
#pragma unroll
        for (int i = 0; i < NCPI; ++i) { const int c = tid + 256 * i; if (c < NCPC) { const int row = c / (DK / 8), kc = c % (DK / 8); cpre[i] = *(const u32x4*)(cp0 + (size_t)row * DK + kc * 8); } }
    }
    __syncthreads();
    f32x4 sT[8];
#pragma unroll
    for (int st = 0; st < 8; ++st) {
        if ((st & 1) == 0) SCHED_BARRIER();
        f32x4 z = f32x4{0.f, 0.f, 0.f, 0.f};
#pragma unroll
        for (int ks = 0; ks < NKS; ++ks) { Frag ka; ka.q = *(const u32x4*)(RA + (st * 16 + r) * KLD + ks * 32 + quad * 8); z = mfma16(ka.v, qf[ks].v, z); }
        sT[st] = z;
    }
    __syncthreads();
#pragma unroll
    for (int i = 0; i < 8; ++i) { const int c = tid + 256 * i; const int row = c >> 4, kc = c & 15; *(u32x4*)(Vs + row * SLD + kc * 8) = vpre[i]; }
    f32x4 hs[8];
#pragma unroll
    for (int et = 0; et < 8; ++et) hs[et] = f32x4{0.f, 0.f, 0.f, 0.f};
#pragma unroll 1
    for (int dir = 0; dir < 2; ++dir) {
        const int chain = chain0 + dir; const int sp = sp_of(dir, u);
        if (dir) __syncthreads();
#pragma unroll
        for (int i = 0; i < NCPI; ++i) { const int c = tid + 256 * i; if (c < NCPC) { const int row = c / (DK / 8), kc = c % (DK / 8); *(u32x4*)(RA + row * KLD + kc * 8) = cpre[i]; } }
        __syncthreads();
        if (dir == 0) {
            const bf16_t* cp1 = p.CP + ((size_t)(chain0 + 1) * NCH + sp_of(1, u)) * ER * DK;
#pragma unroll
            for (int i = 0; i < NCPI; ++i) { const int c = tid + 256 * i; if (c < NCPC) { const int row = c / (DK / 8), kc = c % (DK / 8); cpre[i] = *(const u32x4*)(cp1 + (size_t)row * DK + kc * 8); } }
        }
        const float mprev = p.MS[((size_t)chain * NCH + sp) * 4];
        const float bt = p.BC[(size_t)chain * TT + sbase + tl], mtr = p.MT[(size_t)chain * TT + sbase + tl];
        const float mt = NRM ? bt + fmaxf(mprev, mtr) : mtr;
        const float winter = __expf(bt + mprev - mt); const float ct = bt - mt;
        f32x4 acc[ET];
#pragma unroll
        for (int et = 0; et < ET; ++et) {
            if ((et & 1) == 0) SCHED_BARRIER();
            f32x4 z = f32x4{0.f, 0.f, 0.f, 0.f};
#pragma unroll
            for (int ks = 0; ks < NKS; ++ks) { Frag ca; ca.q = *(const u32x4*)(RA + (et * 16 + r) * KLD + ks * 32 + quad * 8); z = mfma16(ca.v, qf[ks].v, z); }
            acc[et] = f32x4{z[0] * winter, z[1] * winter, z[2] * winter, z[3] * winter};
        }
#pragma unroll
        for (int kk = 0; kk < 4; ++kk) {
            SCHED_BARRIER();
            Frag pf;
#pragma unroll
            for (int hf = 0; hf < 2; ++hf) {
                const int st = 2 * kk + hf; float w[4];
#pragma unroll
                for (int j = 0; j < 4; ++j) {
                    const int s = st * 16 + quad * 4 + j; const bool ok = dir ? ((st * 16 + j) >= tq) : ((st * 16 + j) <= tq);
                    w[j] = ok ? sT[st][j] * __expf(ct + as_[dir * 128 + s]) : 0.f;
                }
                pf.u[2 * hf] = pack2(w[0], w[1]); pf.u[2 * hf + 1] = pack2(w[2], w[3]);
            }
#pragma unroll
            for (int et = 0; et < ET; ++et) {
                Frag vf;
                if (et < 8) { const bf16_t* vp = Vs + (et * 16 + r) * SLD + kk * 32 + quad * 4; vf.d[0] = *(const u32x2*)vp; vf.d[1] = *(const u32x2*)(vp + 16); }
                else { const unsigned one = (r == 0) ? 0x3F803F80u : 0u; vf.q = u32x4{one, one, one, one}; }
                acc[et] = mfma16(vf.v, pf.v, acc[et]);
            }
        }
        if (NRM) {
            float den = lane_read(acc[ET - 1][0], r, lane);
            const float dn = 1.f / fmaxf(fabsf(den), __expf(-mt));
#pragma unroll
            for (int et = 0; et < 8; ++et) { hs[et][0] += acc[et][0] * dn; hs[et][1] += acc[et][1] * dn; hs[et][2] += acc[et][2] * dn; hs[et][3] += acc[et][3] * dn; }
        } else {
#pragma unroll
            for (int et = 0; et < 8; ++et) { hs[et][0] += acc[et][0]; hs[et][1] += acc[et][1]; hs[et][2] += acc[et][2]; hs[et][3] += acc[et][3]; }
        }
    }
    if (NRM) {
        const bf16_t* og = p.OG + rowt * 512 + h * 128; const float* g = p.ev_mnorm_g + (layer >> 1) * 512 + h * 128;
        float sum = 0.f;
#pragma unroll
        for (int et = 0; et < 8; ++et) {
            const u32x2 gq = *(const u32x2*)(og + et * 16 + quad * 4);
            hs[et][0] *= sigmf(bf2f((bf16_t)(gq.x & 0xFFFF))); hs[et][1] *= sigmf(bf2f((bf16_t)(gq.x >> 16)));
            hs[et][2] *= sigmf(bf2f((bf16_t)(gq.y & 0xFFFF))); hs[et][3] *= sigmf(bf2f((bf16_t)(gq.y >> 16)));
            sum += hs[et][0] + hs[et][1] + hs[et][2] + hs[et][3];
        }
        sum = xadd16(sum); sum = xadd32(sum);
        const float mu = sum * (1.f / 128.f); float var = 0.f;
#pragma unroll
        for (int et = 0; et < 8; ++et)
#pragma unroll
            for (int j = 0; j < 4; ++j) { float d = hs[et][j] - mu; var += d * d; }
        var = xadd16(var); var = xadd32(var);
        const float rs = 1.f / sqrtf(var * (1.f / 128.f) + EPS);
        bf16_t* dst = p.CAT + rowt * 1024 + 512 + h * 128;
#pragma unroll
        for (int et = 0; et < 8; ++et) {
            const int e = et * 16 + quad * 4;
            u32x2 w; w.x = pack2((hs[et][0] - mu) * rs * g[e], (hs[et][1] - mu) * rs * g[e + 1]); w.y = pack2((hs[et][2] - mu) * rs * g[e + 2], (hs[et][3] - mu) * rs * g[e + 3]);
            *(u32x2*)(dst + e) = w;
        }
    } else {
        const bf16_t* og = p.OG + rowt * 512 + h * 128;
        float ss = 0.f;
#pragma unroll
        for (int et = 0; et < 8; ++et)
#pragma unroll
            for (int j = 0; j < 4; ++j) ss += hs[et][j] * hs[et][j];
        ss = xadd16(ss); ss = xadd32(ss);
        const float rs = 1.f / sqrtf(ss * (1.f / 128.f) + EPS);
        bf16_t* dst = p.CAT + rowt * 1024 + h * 128;
#pragma unroll
        for (int et = 0; et < 8; ++et) {
            const int e = et * 16 + quad * 4; const u32x2 gq = *(const u32x2*)(og + e);
            u32x2 w; w.x = pack2(hs[et][0] * rs * siluf(bf2f((bf16_t)(gq.x & 0xFFFF))), hs[et][1] * rs * siluf(bf2f((bf16_t)(gq.x >> 16))));
            w.y = pack2(hs[et][2] * rs * siluf(bf2f((bf16_t)(gq.y & 0xFFFF))), hs[et][3] * rs * siluf(bf2f((bf16_t)(gq.y >> 16))));
            *(u32x2*)(dst + e) = w;
        }
    }
}

DEV void phaseC(const Params& p, int layer, unsigned char* smem) {
    const bool odd = layer & 1; const bool with_ctx = layer < DEPTH - 1;
    bf16_t* sm = (bf16_t*)smem;
    const int nqb_l = odd ? SEQ / 32 : SEQ / 64, nqb_c = odd ? CTX / 32 : CTX / 64; const int nh = odd ? HKV : HA;
    const int n_lat = BATCH * nh * nqb_l, n_ctx = with_ctx ? BATCH * nh * nqb_c : 0; const int n_dc = NCHAIN * NCH;
    for (int it = bid_(); it < n_lat + n_ctx + n_dc; it += gridDim.x) {
        if (it < n_lat + n_ctx) {
            int qb, bh;
            if (it < n_lat) {
                const int nbh = BATCH * nh;
                if ((nbh & 7) == 0 && (gridDim.x & 7) == 0) { const int x = it & 7, j = it >> 3; bh = (j / nqb_l) * 8 + x; qb = nqb_c + j % nqb_l; }
                else { qb = nqb_c + it % nqb_l; bh = it / nqb_l; }
            } else { int i2 = it - n_lat; qb = i2 % nqb_c; bh = i2 / nqb_c; }
            const int item = bh * (nqb_l + nqb_c) + qb;
            if (odd) attn_gqa_item(p, item, sm); else attn_diff_item(p, layer, item, sm);
        } else {
            const int item = it - n_lat - n_ctx;
            if (odd) rec_dc_item<64, false>(p, item, sm); else rec_dc_item<128, true>(p, item, sm);
        }
    }
}
DEV void phaseD(const Params& p, int layer) { if (layer & 1) rec_scan<64, false>(p); else rec_scan<128, true>(p); }
DEV void phaseE(const Params& p, int layer, unsigned char* smem) {
    const bool odd = layer & 1; const bool with_ctx = layer < DEPTH - 1;
    const int n = BATCH * 4 * NCH * 2;
    for (int it = bid_(); it < n; it += gridDim.x) {
        const int u = (it >> 1) % NCH; if (!with_ctx && u < NCC) continue;
        if (odd) rec_out_item<64, false>(p, layer, it, (bf16_t*)smem); else rec_out_item<128, true>(p, layer, it, (bf16_t*)smem);
    }
}

#ifdef CPU_EMU_SMALL
constexpr int FM_T = 16;
#else
constexpr int FM_T = 17;
#endif
constexpr int F_ROWS = 16 * FM_T, F_NA = 4 * F_ROWS, F_NCH = F_NA + 512, F_STAGE = F_NCH * 16, F_NJ = (F_NCH + 255) / 256;
static_assert(NTOK % F_ROWS == 0 && TT % F_ROWS == 0, "tall output-projection tiles must not straddle sequences");
static_assert(3 * F_STAGE <= LDS_BYTES - 16, "LDS ring of the tall tile");
DEV void phaseF(const Params& p, int layer, unsigned char* smem) {
    const bool with_ctx = layer < DEPTH - 1; const int ncol = D_MODEL / 128, nrow = NTOK / F_ROWS;
    const WorkRange wr = xcd_range(nrow * ncol, bid_());
    for (int t = wr.lo; t < wr.hi; t += wr.step) {
        const int tid = tid_(), wid = tid >> 6, lane = tid & 63, r = lane & 15, quad = lane >> 4;
        const int lc8 = g2_lc(tid) * 8;
        int rt, ct;
        if ((nrow & 7) == 0) { const int rpg = nrow >> 3; const int rg = t / (ncol * rpg), q = t % (ncol * rpg); ct = q / rpg; rt = rg * rpg + q % rpg; } else { rt = t / ncol; ct = t % ncol; }
        const int row0 = rt * F_ROWS, col0 = ct * 128; const int b = row0 / TT, s0 = row0 % TT;
        if (!with_ctx && s0 + F_ROWS <= CTX) continue;
        const bf16_t* abase = p.CAT + (size_t)(row0 + (tid >> 2)) * MIX_OUT + lc8;
        const bf16_t* bbase = p.WoutT + ((size_t)layer * D_MODEL + col0 + (tid >> 2)) * MIX_OUT + lc8;
        constexpr int JMIX = F_NA / 256;
        const bf16_t* mbase = (F_NA % 256 != 0 && tid < F_NA - 256 * JMIX) ? abase + (size_t)JMIX * 64 * MIX_OUT : bbase + (256 * JMIX - F_NA) / 4 * MIX_OUT;
        f32x4 acc[FM_T][2];
#pragma unroll
        for (int m = 0; m < FM_T; ++m) { acc[m][0] = f32x4{0.f, 0.f, 0.f, 0.f}; acc[m][1] = f32x4{0.f, 0.f, 0.f, 0.f}; }
        unsigned char* dst0 = smem + tid * 16;
        auto issue = [&](int kt, int slot) {
            unsigned char* d = dst0 + slot * F_STAGE;
#pragma unroll
            for (int j = 0; j < F_NJ; ++j) {
                if (256 * j + 255 < F_NA) glds16(abase + (size_t)j * 64 * MIX_OUT + kt * 32, d + j * 4096);
                else if (j == JMIX && F_NA % 256 != 0) glds16(mbase + kt * 32, d + j * 4096);
                else if (256 * j + 255 < F_NCH) glds16(bbase + (256 * j - F_NA) / 4 * MIX_OUT + kt * 32, d + j * 4096);
                else if (tid + 256 * j < F_NCH) glds16(bbase + (256 * j - F_NA) / 4 * MIX_OUT + kt * 32, d + j * 4096);
            }
        };
        constexpr int nkt = MIX_OUT / 32;
        RAW_BARRIER();
        issue(0, 0); issue(1, 1);
        const int pco = (quad ^ g2_h((r >> 2) & 3)) * 16;
        const unsigned char* afr = smem + r * 64 + pco;
        const unsigned char* bfr = smem + F_NA * 16 + (wid * 32 + r) * 64 + pco;
        int slot = 0;
        for (int kt = 0; kt < nkt; ++kt) {
            if (kt + 1 < nkt) wait_vm<6>(); else wait_vm<0>();
            RAW_BARRIER();
            if (kt + 2 < nkt) { int ns = slot + 2; if (ns >= 3) ns -= 3; issue(kt + 2, ns); }
            const unsigned char* as = afr + slot * F_STAGE; const unsigned char* bs = bfr + slot * F_STAGE;
            Frag b0, b1; b0.q = *(const u32x4*)bs; b1.q = *(const u32x4*)(bs + 16 * 64);
#ifndef CPU_EMU
            __builtin_amdgcn_s_setprio(1);
#endif
#pragma unroll
            for (int m = 0; m < FM_T; ++m) {
                Frag af; af.q = *(const u32x4*)(as + m * 16 * 64);
                acc[m][0] = mfma16(b0.v, af.v, acc[m][0]); acc[m][1] = mfma16(b1.v, af.v, acc[m][1]);
            }
#ifndef CPU_EMU
            __builtin_amdgcn_s_setprio(0);
#endif
            if (++slot == 3) slot = 0;
        }
        const float* gl = p.MOD + ((size_t)layer * (BATCH + 1) + b) * 6 * D_MODEL + 2 * D_MODEL; const float* gc = p.MOD + ((size_t)layer * (BATCH + 1) + BATCH) * 6 * D_MODEL + 2 * D_MODEL;
#pragma unroll
        for (int n = 0; n < 2; ++n) {
            const int col = col0 + wid * 32 + n * 16 + quad * 4; const f32x4 g_l = *(const f32x4*)(gl + col), g_c = *(const f32x4*)(gc + col);
#pragma unroll
            for (int m = 0; m < FM_T; ++m) {
                const int s = s0 + m * 16 + r; const bool isc = s < CTX;
                if (with_ctx || !isc) { u32x2* x = (u32x2*)(p.X + (size_t)(row0 + m * 16 + r) * D_MODEL + col); *x = pk4(ALPHA * bf4(*x) + (isc ? g_c : g_l) * acc[m][n]); }
                if ((m & 7) == 7) SCHED_BARRIER();
            }
        }
    }
}

constexpr int NV4 = D_MODEL / 256;
DEV void phaseG(const Params& p, int layer, unsigned char* smem) {
    const bool with_ctx = layer < DEPTH - 1;
    const int tid = tid_(); const int wid = tid >> 6, lane = tid & 63; const int bid = bid_();
    const float* lg = p.ln_g + (size_t)(layer * 2) * D_MODEL; const float* lb = p.ln_b + (size_t)(layer * 2) * D_MODEL;
    const float* wr = p.WrT + (size_t)layer * NR * D_MODEL;
    constexpr int MAXTB = 48;
    const int NTB = imin((NTOK + (int)gridDim.x - 1) / (int)gridDim.x, MAXTB);
    const int nruns = (NTOK + NTB - 1) / NTB;
    int* lcnt = (int*)smem; int* lbase = lcnt + 32; int* rec = lbase + 32;
    float* t_mu = (float*)(rec + MAXTB * 8); float* t_rs = t_mu + MAXTB; float* t_gw = t_rs + MAXTB; int* t_g = (int*)(t_gw + MAXTB);
    int* gcount = t_g + MAXTB; int* glist = gcount + 4;
    static_assert((64 + MAXTB * 8 + MAXTB * 4 + 4 + 4 * MAXTB) * 4 <= 3584, "phase G tables");
    float* L_wg = (float*)(smem + 3584); float* L_we = L_wg + NG * D_MODEL; float* L_ab = L_we + EPG * D_MODEL;
    static_assert(3584 + (NG + EPG + 6) * D_MODEL * 4 <= LDS_BYTES - 16, "phase G LDS image");
    __syncthreads();
    for (int i = tid; i < NG * D_MODEL / 4; i += 256) ((f32x4*)L_wg)[i] = ((const f32x4*)wr)[i];
    for (int run = bid; run < nruns; run += gridDim.x) {
    const int base = run * NTB; const int ntb = imin(NTB, NTOK - base);
    const int b_first = base / TT;
    __syncthreads();
    if (tid < 32) lcnt[tid] = 0;
    if (tid < 4) gcount[tid] = 0;
    for (int i = tid; i < MAXTB; i += 256) { rec[i * 8] = -1; t_g[i] = -1; }
    for (int i = tid; i < 3 * D_MODEL / 4; i += 256) {
        const int set = i / (D_MODEL / 4), q = i % (D_MODEL / 4); const int bb = set == 0 ? BATCH : imin(b_first + set - 1, BATCH - 1);
        const float* mod = p.MOD + ((size_t)layer * (BATCH + 1) + bb) * 6 * D_MODEL;
        const f32x4 g4 = ((const f32x4*)lg)[q], b4 = ((const f32x4*)lb)[q], sh = ((const f32x4*)(mod + 3 * D_MODEL))[q], sc = ((const f32x4*)(mod + 4 * D_MODEL))[q];
        ((f32x4*)(L_ab + (size_t)set * 2 * D_MODEL))[q] = g4 * (1.f + sc);
        ((f32x4*)(L_ab + (size_t)set * 2 * D_MODEL + D_MODEL))[q] = b4 * (1.f + sc) + sh;
    }
    __syncthreads();
    auto set_of = [&](int tok) { const int b = tok / TT, sq = tok % TT; return sq < CTX ? 0 : 1 + (b - b_first); };
    auto live = [&](int ti) { if (ti >= ntb) return false; const int sq = (base + ti) % TT; return with_ctx || sq >= CTX; };
    for (int t0 = wid; t0 < ntb; t0 += 8) {
        f32x4 v[2][NV4]; int ti[2]; bool ok[2]; const float* ab[2];
#pragma unroll
        for (int u = 0; u < 2; ++u) {
            ti[u] = t0 + 4 * u; ok[u] = live(ti[u]); const int tl = imin(base + ti[u], NTOK - 1);
            ab[u] = L_ab + (size_t)set_of(tl) * 2 * D_MODEL;
#pragma unroll
            for (int i = 0; i < NV4; ++i) v[u][i] = bf4(*(const u32x2*)(p.X + (size_t)tl * D_MODEL + (i * 64 + lane) * 4));
        }
        float mu[2], rs[2];
#pragma unroll
        for (int u = 0; u < 2; ++u) { float sum = 0.f;
#pragma unroll
            for (int i = 0; i < NV4; ++i) sum += v[u][i].x + v[u][i].y + v[u][i].z + v[u][i].w;
            mu[u] = sum; }
        { mu[0] = wsum(mu[0]); mu[1] = wsum(mu[1]); }
#pragma unroll
        for (int u = 0; u < 2; ++u) { mu[u] *= (1.f / D_MODEL); float var = 0.f;
#pragma unroll
            for (int i = 0; i < NV4; ++i) { float a = v[u][i].x - mu[u], bq = v[u][i].y - mu[u], c = v[u][i].z - mu[u], d = v[u][i].w - mu[u]; var += a * a + bq * bq + c * c + d * d; }
            rs[u] = var; }
        { rs[0] = wsum(rs[0]); rs[1] = wsum(rs[1]); }
        f32x4 hv[2][NV4];
#pragma unroll
        for (int u = 0; u < 2; ++u) {
            rs[u] = 1.f / sqrtf(rs[u] * (1.f / D_MODEL) + EPS);
            const int tok = base + ti[u];
            if (lane == 0 && ok[u]) { p.STAT[tok * 2] = mu[u]; p.STAT[tok * 2 + 1] = rs[u]; t_mu[ti[u]] = mu[u]; t_rs[ti[u]] = rs[u]; }
#pragma unroll
            for (int i = 0; i < NV4; ++i) {
                const int k = (i * 64 + lane) * 4;
                const f32x4 A = *(const f32x4*)(ab[u] + k), B = *(const f32x4*)(ab[u] + D_MODEL + k);
                hv[u][i] = (v[u][i] - mu[u]) * rs[u] * A + B;
                if (ok[u]) *(u32x2*)(p.H + (size_t)tok * D_MODEL + k) = pk4(hv[u][i]);
            }
        }
        float gl[2][NG];
#pragma unroll
        for (int j = 0; j < NG; ++j) {
#pragma unroll
            for (int u = 0; u < 2; ++u) { float a = 0.f;
#pragma unroll
                for (int i = 0; i < NV4; ++i) { const f32x4 w4 = *(const f32x4*)(L_wg + j * D_MODEL + (i * 64 + lane) * 4); a += hv[u][i].x * w4.x + hv[u][i].y * w4.y + hv[u][i].z * w4.z + hv[u][i].w * w4.w; }
                gl[u][j] = a; }
        }
#pragma unroll
        for (int j = 0; j < NG; ++j) { gl[0][j] = wsum(gl[0][j]); gl[1][j] = wsum(gl[1][j]); }
#pragma unroll
        for (int u = 0; u < 2; ++u) {
#pragma unroll
            for (int j = 0; j < NG; ++j) gl[u][j] += p.moe_b_group[layer * NG + j];
            int g = 0; float gm = gl[u][0];
#pragma unroll
            for (int j = 1; j < NG; ++j) if (gl[u][j] > gm) { gm = gl[u][j]; g = j; }
            float gs = 0.f;
#pragma unroll
            for (int j = 0; j < NG; ++j) gs += expf(gl[u][j] - gm);
            if (lane == 0 && ok[u]) { t_g[ti[u]] = g; t_gw[ti[u]] = 1.f / gs; }
        }
    }
    __syncthreads();
    if (tid < 4) {
        int n = 0; for (int i = 0; i < ntb; ++i) if (t_g[i] == tid) glist[tid * MAXTB + n++] = i;
        gcount[tid] = n;
    }
    __syncthreads();
    for (int g = 0; g < NG; ++g) {
        const int ng = gcount[g];
        if (ng == 0) continue;
        const float* wre = wr + (size_t)(NG + g * EPG) * D_MODEL;
        for (int i = tid; i < EPG * D_MODEL / 4; i += 256) ((f32x4*)L_we)[i] = ((const f32x4*)wre)[i];
        __syncthreads();
        for (int q0 = wid; q0 < ng; q0 += 8) {
            f32x4 hv[2][NV4]; int ti[2]; bool ok[2];
#pragma unroll
            for (int u = 0; u < 2; ++u) {
                const int q = q0 + 4 * u; ok[u] = q < ng; ti[u] = glist[g * MAXTB + imin(q, ng - 1)]; const int tok = base + ti[u];
                const float* ab = L_ab + (size_t)set_of(tok) * 2 * D_MODEL; const float mu = t_mu[ti[u]], rs = t_rs[ti[u]];
#pragma unroll
                for (int i = 0; i < NV4; ++i) {
                    const int k = (i * 64 + lane) * 4;
                    const f32x4 x = bf4(*(const u32x2*)(p.X + (size_t)tok * D_MODEL + k)); const f32x4 A = *(const f32x4*)(ab + k), B = *(const f32x4*)(ab + D_MODEL + k);
                    hv[u][i] = (x - mu) * rs * A + B;
                }
            }
            float ev[2][EPG];
#pragma unroll
            for (int j = 0; j < EPG; ++j) {
#pragma unroll
                for (int u = 0; u < 2; ++u) { float a = 0.f;
#pragma unroll
                    for (int i = 0; i < NV4; ++i) { const f32x4 w4 = *(const f32x4*)(L_we + j * D_MODEL + (i * 64 + lane) * 4); a += hv[u][i].x * w4.x + hv[u][i].y * w4.y + hv[u][i].z * w4.z + hv[u][i].w * w4.w; }
                    ev[u][j] = a; }
            }
#pragma unroll
            for (int j = 0; j < EPG; ++j) { ev[0][j] = wsum(ev[0][j]); ev[1][j] = wsum(ev[1][j]); }
#pragma unroll
            for (int u = 0; u < 2; ++u) {
#pragma unroll
                for (int j = 0; j < EPG; ++j) ev[u][j] += p.moe_b_router[layer * NE + g * EPG + j];
                int i1 = 0; float v1 = ev[u][0];
#pragma unroll
                for (int j = 1; j < EPG; ++j) if (ev[u][j] > v1) { v1 = ev[u][j]; i1 = j; }
                int i2 = -1; float v2 = -3.0e38f;
#pragma unroll
                for (int j = 0; j < EPG; ++j) if (j != i1 && ev[u][j] > v2) { v2 = ev[u][j]; i2 = j; }
                const float gwt = t_gw[ti[u]];
                const float e2 = expf(v2 - v1); const float w1 = gwt / (1.f + e2), w2 = gwt * e2 / (1.f + e2);
                if (lane == 0 && ok[u]) {
                    const int ea = g * EPG + i1, eb = g * EPG + i2;
                    const int ra = atomicAdd(lcnt + ea, 1), rb = atomicAdd(lcnt + eb, 1);
                    int* rc = rec + ti[u] * 8;
                    rc[0] = base + ti[u]; rc[1] = ea; rc[2] = eb; rc[3] = ra; rc[4] = rb; rc[5] = (int)__float_as_uint(w1); rc[6] = (int)__float_as_uint(w2);
                }
            }
        }
        __syncthreads();
    }
    if (tid < 32) { const int c = lcnt[tid]; lbase[tid] = c ? atomicAdd(p.CNT + (layer * NE + tid) * 32, c) : 0; }
    __syncthreads();
    for (int i = tid; i < MAXTB; i += 256) {
        const int* rc = rec + i * 8; const int tk = rc[0];
        if (tk >= 0) {
            const int ea = rc[1], eb = rc[2]; const int pa = lbase[ea] + rc[3], pb = lbase[eb] + rc[4];
            p.LIST[(size_t)ea * NTOK + pa] = tk * 2; p.LISTW[(size_t)ea * NTOK + pa] = __uint_as_float((unsigned)rc[5]);
            p.LIST[(size_t)eb * NTOK + pb] = tk * 2 + 1; p.LISTW[(size_t)eb * NTOK + pb] = __uint_as_float((unsigned)rc[6]);
        }
    }
    }
}

struct EpGU {
    const Params& p; int slot0, nvalid, col0;
    DEV void nat(f32x4 (&acc)[4][4], int wr, int wc, int lane) {
        const int r = lane & 15, quad = lane >> 4; const int j0 = (col0 + wc * 64) >> 1;
#pragma unroll
        for (int m = 0; m < 4; ++m) {
            const int rl = wr * 64 + m * 16 + r;
            if (rl < nvalid) {
                bf16_t* d = p.ACT + (size_t)(slot0 + rl) * D_EXPERT + j0 + quad * 4;
#pragma unroll
                for (int n = 0; n < 2; ++n) {
                    u32x2 w; w.x = pack2(siluf(acc[m][n][0]) * acc[m][n + 2][0], siluf(acc[m][n][1]) * acc[m][n + 2][1]);
                    w.y = pack2(siluf(acc[m][n][2]) * acc[m][n + 2][2], siluf(acc[m][n][3]) * acc[m][n + 2][3]);
                    *(u32x2*)(d + n * 16) = w;
                }
            }
        }
    }
    DEV void operator()(f32x4 (&acc)[4][4], int wr, int wc, int lane) {
        const int r = lane & 15, quad = lane >> 4; const int j0 = (col0 + wc * 64) >> 1;
#pragma unroll
        for (int m = 0; m < 4; ++m)
#pragma unroll
            for (int j = 0; j < 4; ++j) {
                const int rl = wr * 64 + m * 16 + quad * 4 + j;
                if (rl < nvalid) {
                    bf16_t* d = p.ACT + (size_t)(slot0 + rl) * D_EXPERT + j0 + r;
                    d[0] = f2bf(siluf(acc[m][0][j]) * acc[m][2][j]); d[16] = f2bf(siluf(acc[m][1][j]) * acc[m][3][j]);
                }
            }
    }
};
struct EpDown {
    const Params& p; const float* lw; const int* lp; int nvalid, col0;
    DEV void nat(f32x4 (&acc)[4][4], int wr, int wc, int lane) {
        const int r = lane & 15, quad = lane >> 4;
#pragma unroll
        for (int m = 0; m < 4; ++m) {
            const int rl = wr * 64 + m * 16 + r;
            if (rl < nvalid) {
                const float w = lw[rl]; bf16_t* d = p.YS + (size_t)lp[rl] * D_MODEL + col0 + wc * 64 + quad * 4;
#pragma unroll
                for (int n = 0; n < 4; ++n) { u32x2 o; o.x = pack2(w * acc[m][n][0], w * acc[m][n][1]); o.y = pack2(w * acc[m][n][2], w * acc[m][n][3]); *(u32x2*)(d + n * 16) = o; }
            }
        }
    }
    DEV void operator()(f32x4 (&acc)[4][4], int wr, int wc, int lane) {}
};
template <bool DOWN>
DEV void phaseHI(const Params& p, int layer, unsigned char* smem) {
    int* tpre = (int*)(smem + 74 * 1024); int* sbase = tpre + 40;
    const int tid = tid_(); const int bid = bid_();
    __syncthreads();
    if (tid == 0) {
        int ta = 0, sa = 0;
        for (int e = 0; e < NE; ++e) { const int c = p.CNT[(layer * NE + e) * 32]; tpre[e] = ta; sbase[e] = sa; ta += (c + 127) >> 7; sa += c; }
        tpre[NE] = ta;
        if (bid == 0 && !DOWN) for (int e = 0; e < NE; ++e) p.BASE[e] = sbase[e];
    }
    __syncthreads();
    const int ncol = DOWN ? D_MODEL / 256 : 2 * D_EXPERT / 256; const int ntile = tpre[NE] * ncol;
    const int trow = tid >> 2, lc8 = g2_lc(tid) * 8;
    const WorkRange wr = xcd_range(ntile, bid);
    for (int t = wr.lo; t < wr.hi; t += wr.step) {
        int e = 0;
        for (int q = 1; q < NE; ++q) if (tpre[q] * ncol <= t) e = q;
        const int nrt = tpre[e + 1] - tpre[e]; const int q2 = t - tpre[e] * ncol; const int ct = q2 / nrt, rt = q2 % nrt;
        const int cnt = p.CNT[(layer * NE + e) * 32]; const int nvalid = imin(128, cnt - rt * 128); const int slot0 = sbase[e] + rt * 128;
        if (!DOWN) {
            const int* list = p.LIST + (size_t)e * NTOK + rt * 128;
            const int r0 = imin(trow, nvalid - 1), r1 = imin(64 + trow, nvalid - 1);
            const bf16_t* a0 = p.H + (size_t)(list[r0] >> 1) * D_MODEL + lc8; const bf16_t* a1 = p.H + (size_t)(list[r1] >> 1) * D_MODEL + lc8;
            const bf16_t* bw = p.Wgu + ((size_t)(layer * NE + e) * 2 * D_EXPERT + ct * 256 + trow) * D_MODEL + lc8;
            EpGU ep{p, slot0, nvalid, ct * 256};
            gemm_tile2<2, true>(smem, a0, a1, bw, D_MODEL, D_MODEL / 32, ep);
        } else {
            const bf16_t* a0 = p.ACT + (size_t)(slot0 + trow) * D_EXPERT + lc8;
            const bf16_t* bw = p.WdT + ((size_t)(layer * NE + e) * D_MODEL + ct * 256 + trow) * D_EXPERT + lc8;
            EpDown ep{p, p.LISTW + (size_t)e * NTOK + rt * 128, p.LIST + (size_t)e * NTOK + rt * 128, nvalid, ct * 256};
            gemm_tile2<2, true>(smem, a0, a0 + (size_t)64 * D_EXPERT, bw, D_EXPERT, D_EXPERT / 32, ep);
        }
    }
}

DEV void phaseJ(const Params& p, int layer) {
    const bool with_ctx = layer < DEPTH - 1; const bool last = layer == DEPTH - 1;
    const int wid = tid_() >> 6, lane = tid_() & 63;
    const float* lg1 = p.ln_g + (size_t)(layer * 2) * D_MODEL; const float* lb1 = p.ln_b + (size_t)(layer * 2) * D_MODEL;
    const float* lg = p.ln_g + (size_t)(layer * 2 + 1) * D_MODEL; const float* lb = p.ln_b + (size_t)(layer * 2 + 1) * D_MODEL;
    const int stride = gridDim.x * 4;
    int tok = bid_() * 4 + wid;
    u32x2 xn[NV4], an[NV4], cn[NV4]; float mun = 0.f, rsn = 0.f;
    if (tok < NTOK) {
#pragma unroll
        for (int i = 0; i < NV4; ++i) {
            const int k = (i * 64 + lane) * 4;
            xn[i] = *(const u32x2*)(p.X + (size_t)tok * D_MODEL + k); an[i] = *(const u32x2*)(p.YS + (size_t)(tok * 2) * D_MODEL + k); cn[i] = *(const u32x2*)(p.YS + (size_t)(tok * 2 + 1) * D_MODEL + k);
        }
        mun = p.STAT[tok * 2]; rsn = p.STAT[tok * 2 + 1];
    }
    for (; tok < NTOK; tok += stride) {
        u32x2 x[NV4], a[NV4], c[NV4]; const float mu1 = mun, rs1 = rsn;
#pragma unroll
        for (int i = 0; i < NV4; ++i) { x[i] = xn[i]; a[i] = an[i]; c[i] = cn[i]; }
        const int tn = tok + stride;
        if (tn < NTOK) {
#pragma unroll
            for (int i = 0; i < NV4; ++i) {
                const int k = (i * 64 + lane) * 4;
                xn[i] = *(const u32x2*)(p.X + (size_t)tn * D_MODEL + k); an[i] = *(const u32x2*)(p.YS + (size_t)(tn * 2) * D_MODEL + k); cn[i] = *(const u32x2*)(p.YS + (size_t)(tn * 2 + 1) * D_MODEL + k);
            }
            mun = p.STAT[tn * 2]; rsn = p.STAT[tn * 2 + 1];
        }
        const int b = tok / TT, s = tok % TT; if (!with_ctx && s < CTX) continue;
        const int bb = s < CTX ? BATCH : b; const float* gate = p.MOD + ((size_t)layer * (BATCH + 1) + bb) * 6 * D_MODEL + 5 * D_MODEL;
        f32x4 v[NV4]; float sum = 0.f;
#pragma unroll
        for (int i = 0; i < NV4; ++i) {
            const int k = (i * 64 + lane) * 4; const f32x4 g = *(const f32x4*)(gate + k), g1 = *(const f32x4*)(lg1 + k), b1 = *(const f32x4*)(lb1 + k);
            const f32x4 x1 = (bf4(x[i]) - mu1) * rs1 * g1 + b1;
            v[i] = ALPHA * x1 + g * (bf4(a[i]) + bf4(c[i]));
            sum += v[i].x + v[i].y + v[i].z + v[i].w;
        }
        const float mu = wsum(sum) * (1.f / D_MODEL); float var = 0.f;
#pragma unroll
        for (int i = 0; i < NV4; ++i) { float a0 = v[i].x - mu, bq = v[i].y - mu, c0 = v[i].z - mu, d = v[i].w - mu; var += a0 * a0 + bq * bq + c0 * c0 + d * d; }
        const float rs = 1.f / sqrtf(wsum(var) * (1.f / D_MODEL) + EPS);
        float* dst = p.out + ((size_t)b * SEQ + (s - CTX)) * D_MODEL; bf16_t* dx = p.X + (size_t)tok * D_MODEL;
#pragma unroll
        for (int i = 0; i < NV4; ++i) {
            const int k = (i * 64 + lane) * 4; const f32x4 g4 = *(const f32x4*)(lg + k), b4 = *(const f32x4*)(lb + k);
            f32x4 o; o.x = (v[i].x - mu) * rs * g4.x + b4.x; o.y = (v[i].y - mu) * rs * g4.y + b4.y; o.z = (v[i].z - mu) * rs * g4.z + b4.z; o.w = (v[i].w - mu) * rs * g4.w + b4.w;
            if (last) *(f32x4*)(dst + k) = o; else *(u32x2*)(dx + k) = pk4(o);
            if (!last) {
                const float* mn = p.MOD + ((size_t)(layer + 1) * (BATCH + 1) + bb) * 6 * D_MODEL;
                const f32x4 sh = *(const f32x4*)(mn + k), sc = *(const f32x4*)(mn + D_MODEL + k);
                u32x2 hq; hq.x = pack2(o.x * (1.f + sc.x) + sh.x, o.y * (1.f + sc.y) + sh.y); hq.y = pack2(o.z * (1.f + sc.z) + sh.z, o.w * (1.f + sc.w) + sh.w);
                *(u32x2*)(p.HIN + (size_t)tok * D_MODEL + k) = hq;
            }
        }
    }
}

constexpr int PH_PER_LAYER = 10;
constexpr int NPHASE = 2 + DEPTH * PH_PER_LAYER;
DEV void run_phase(const Params& p, int ph, unsigned char* smem) {
    if (ph == 0) { phase0(p, smem); return; }
    if (ph == 1) { phase0b(p); return; }
    const int layer = (ph - 2) / PH_PER_LAYER, sub = (ph - 2) % PH_PER_LAYER;
    switch (sub) {
        case 0: phaseA(p, layer, smem); break;
        case 1: if (!(layer & 1)) phaseB(p, layer); break;
        case 2: phaseC(p, layer, smem); break;
        case 3: phaseD(p, layer); break;
        case 4: phaseE(p, layer, smem); break;
        case 5: phaseF(p, layer, smem); break;
        case 6: phaseG(p, layer, smem); break;
        case 7: phaseHI<false>(p, layer, smem); break;
        case 8: phaseHI<true>(p, layer, smem); break;
        default: phaseJ(p, layer); break;
    }
}
DEV bool phase_is_empty(int ph) { if (ph < 2) return false; return ((ph - 2) % PH_PER_LAYER) == 1 && (((ph - 2) / PH_PER_LAYER) & 1); }

struct Carver { char* base; size_t off; template <class T> T* take(size_t n) { off = (off + 255) & ~(size_t)255; T* r = (T*)(base + off); off += n * sizeof(T); return r; } };
static void make_params(Params& p, void* const* d_in, void* d_out, void* d_ws) {
    const float** in = (const float**)d_in;
    p.x = in[0]; p.c = in[1]; p.ctx = in[2]; p.c_ctx = in[3]; p.w_mod = in[4]; p.b_mod = in[5]; p.ln_g = in[6]; p.ln_b = in[7];
    p.ev_w_in = in[8]; p.ev_w_out = in[9]; p.ev_lambda = in[10]; p.ev_subln_g = in[11]; p.ev_conv_w = in[12]; p.ev_conv_b = in[13];
    p.ev_gate_b = in[14]; p.ev_mnorm_g = in[15]; p.od_w_in = in[16]; p.od_w_out = in[17]; p.od_decay = in[18]; p.od_qk_g = in[19];
    p.moe_w_group = in[20]; p.moe_b_group = in[21]; p.moe_w_router = in[22]; p.moe_b_router = in[23]; p.moe_w_gate = in[24]; p.moe_w_up = in[25]; p.moe_w_down = in[26];
    p.out = (float*)d_out;
    Carver cv{(char*)d_ws, 0};
    p.X = cv.take<bf16_t>((size_t)NTOK * D_MODEL);
    p.MOD = cv.take<float>((size_t)DEPTH * (BATCH + 1) * 6 * D_MODEL);
    p.ROPE = cv.take<float>(64 * 16 * 2); p.LAM = cv.take<float>(4);
    p.WrT = cv.take<float>((size_t)DEPTH * NR * D_MODEL);
    p.CNT = cv.take<int>(DEPTH * NE * 32); p.BASE = cv.take<int>(NE); p.BAR = cv.take<unsigned>(4096);
    p.WinE = cv.take<bf16_t>((size_t)2 * EVEN_INP * D_MODEL); p.WinO = cv.take<bf16_t>((size_t)2 * ODD_IN * D_MODEL);
    p.WoutT = cv.take<bf16_t>((size_t)DEPTH * D_MODEL * MIX_OUT);
    p.Wgu = cv.take<bf16_t>((size_t)DEPTH * NE * 2 * D_EXPERT * D_MODEL); p.WdT = cv.take<bf16_t>((size_t)DEPTH * NE * D_MODEL * D_EXPERT);
    p.STAT = cv.take<float>((size_t)NTOK * 2);
    p.CAT = cv.take<bf16_t>((size_t)NTOK * 1024); p.HIN = cv.take<bf16_t>((size_t)NTOK * D_MODEL);
    p.LIST = cv.take<int>((size_t)NE * NTOK); p.LISTW = cv.take<float>((size_t)NE * NTOK); p.TOKSLOT = cv.take<int>((size_t)NTOK * 2);
    const size_t mix0 = cv.off;
    p.Q1 = cv.take<bf16_t>((size_t)NTOK * 512); p.K1 = cv.take<bf16_t>((size_t)NTOK * 512); p.V1T = cv.take<bf16_t>((size_t)NTOK * 512);
    p.PM = cv.take<bf16_t>((size_t)NTOK * 1024); p.V2T = cv.take<bf16_t>((size_t)NTOK * 512); p.OG = cv.take<bf16_t>((size_t)NTOK * 512);
    p.G = cv.take<float>((size_t)NTOK * 16);
    p.Q2 = cv.take<bf16_t>((size_t)NTOK * 512); p.K2 = cv.take<bf16_t>((size_t)NTOK * 512); p.K2T = cv.take<bf16_t>((size_t)NTOK * 512);
    p.DC = cv.take<bf16_t>((size_t)NCHAIN * NCH * EVR * 128); p.CP = cv.take<bf16_t>((size_t)NCHAIN * NCH * EVR * 128);
    p.BC = cv.take<float>((size_t)NCHAIN * TT); p.AT = cv.take<float>((size_t)NCHAIN * TT); p.MT = cv.take<float>((size_t)NCHAIN * TT); p.MS = cv.take<float>((size_t)NCHAIN * NCH * 4); p.CH2 = cv.take<float>((size_t)NCHAIN * NCH * 2);
    cv.off = mix0;
    p.H = cv.take<bf16_t>((size_t)NTOK * D_MODEL); p.ACT = cv.take<bf16_t>((size_t)(2 * NTOK + 128) * D_EXPERT); p.YS = cv.take<bf16_t>((size_t)2 * NTOK * D_MODEL);
}

#ifndef CPU_EMU
#define XB_TMO      128
#define XB_XCNT(j)  (256  + 64 * (j))
#define XB_XSUB(j)  (1280 + 64 * (j))
#define XB_XGEN(j)  (2304 + 64 * (j))
#define XB_TOP      3328
#define XB_TOPGEN   3392
#define XCD_BAR_WORDS 3456
#define XB_SPIN_CAP (1u << 20)
#define LAS __attribute__((address_space(3)))
__device__ __forceinline__ unsigned xb_ld(unsigned* p)              { return __hip_atomic_load(p, __ATOMIC_RELAXED, __HIP_MEMORY_SCOPE_AGENT); }
__device__ __forceinline__ unsigned xb_add(unsigned* p, unsigned v) { return __hip_atomic_fetch_add(p, v, __ATOMIC_RELAXED, __HIP_MEMORY_SCOPE_AGENT); }
__device__ __forceinline__ unsigned xb_xcc_id() { return (unsigned)__builtin_amdgcn_s_getreg((3 << 11) | 20) & 0xFu; }
#define XB_SPIN(cond, bar) do { unsigned _sp = 0; while (cond) { __builtin_amdgcn_s_sleep(1); \
    if ((++_sp & 255u) == 0u) { if (xb_ld(&(bar)[XB_TMO])) break; if (_sp > XB_SPIN_CAP) { atomicAdd(&(bar)[XB_TMO], 1u); break; } } } } while (0)
struct XcdBarrier { unsigned* bar; unsigned x; volatile LAS unsigned* st; };
__device__ __forceinline__ XcdBarrier xcd_barrier_post(unsigned* bar, volatile LAS unsigned* st) {
    XcdBarrier b; b.bar = bar; b.x = xb_xcc_id(); b.st = st;
    if (threadIdx.x == 0) (void)xb_add(&bar[XB_XCNT(b.x)], 1u);
    return b;
}
__device__ __forceinline__ void xcd_barrier_complete(unsigned* bar, unsigned x, unsigned& nloc, unsigned& nx) {
    const unsigned G = gridDim.x * gridDim.y * gridDim.z;
    unsigned sum, cnt, mine, sp = 0u;
    for (;;) {
        sum = 0u; cnt = 0u; mine = 0u;
#pragma unroll
        for (unsigned j = 0; j < 16; ++j) { const unsigned c = xb_ld(&bar[XB_XCNT(j)]); sum += c; cnt += (c > 0u) ? 1u : 0u; mine = (j == x) ? c : mine; }
        if (sum == G) break;
        __builtin_amdgcn_s_sleep(1);
        if ((++sp & 255u) == 0u) { if (xb_ld(&bar[XB_TMO])) break; if (sp > XB_SPIN_CAP) { atomicAdd(&bar[XB_TMO], 1u); break; } }
    }
    nloc = mine > 0u ? mine : 1u; nx = cnt > 0u ? cnt : 1u;
}
__device__ __forceinline__ void xcd_barrier(const XcdBarrier& b) {
    asm volatile("s_waitcnt vmcnt(0)" ::: "memory");
    __syncthreads();
    if (threadIdx.x == 0) {
        unsigned* bar = b.bar;
        __builtin_amdgcn_s_waitcnt(0);
        unsigned nloc = b.st[0], nx = b.st[1];
        if (nloc == 0u) { xcd_barrier_complete(bar, b.x, nloc, nx); b.st[0] = nloc; b.st[1] = nx; }
        const unsigned old = xb_add(&bar[XB_XSUB(b.x)], 1u);
        const unsigned gen = old / nloc;
        if (old + 1u == (gen + 1u) * nloc) {
            __builtin_amdgcn_fence(__ATOMIC_RELEASE, "agent");
            asm volatile("s_waitcnt vmcnt(0)" ::: "memory");
            const unsigned og = xb_add(&bar[XB_TOP], 1u);
            const unsigned tg = og / nx;
            if (og + 1u == (tg + 1u) * nx) xb_add(&bar[XB_TOPGEN], 1u);
            else XB_SPIN(xb_ld(&bar[XB_TOPGEN]) == tg, bar);
            __builtin_amdgcn_fence(__ATOMIC_ACQUIRE, "agent");
            xb_add(&bar[XB_XGEN(b.x)], 1u);
            asm volatile("s_waitcnt vmcnt(0)" ::: "memory");
        } else {
            XB_SPIN(xb_ld(&bar[XB_XGEN(b.x)]) == gen, bar);
            __builtin_amdgcn_fence(__ATOMIC_ACQUIRE, "agent");
            asm volatile("s_waitcnt vmcnt(0)" ::: "memory");
        }
    }
    __syncthreads();
}

__global__ void __launch_bounds__(NTHREADS, 2) fwd_megakernel(Params p) {
    __shared__ __attribute__((aligned(16))) unsigned char smem[LDS_BYTES];
    cg::grid_group grid = cg::this_grid();
    volatile LAS unsigned* xst = (volatile LAS unsigned*)(smem + LDS_BYTES - 16);
    if (threadIdx.x == 0) { xst[0] = 0u; xst[1] = 0u; }
    __syncthreads();
    const XcdBarrier xb = xcd_barrier_post(p.BAR, xst);
    grid.sync();
#ifdef PROBE_TS
    unsigned long long ts_acc = 0ull;
#endif
    for (int ph = 0; ph < NPHASE; ++ph) {
        if (phase_is_empty(ph)) continue;
#ifdef PROBE_TS
        const int psub_ = ph == 0 ? 10 : ph == 1 ? 11 : (ph - 2) % PH_PER_LAYER;
        const unsigned long long ts0 = __builtin_amdgcn_s_memrealtime();
#endif
#if defined(__HIP_DEVICE_COMPILE__)
        const __attribute__((address_space(4))) Params* pp = (const __attribute__((address_space(4))) Params*)__builtin_amdgcn_kernarg_segment_ptr();
        asm volatile("" : "+s"(pp));
        const Params q = *pp;
        run_phase(q, ph, smem);
#ifdef DBL_MASK
        { const int sub_ = ph == 0 ? 10 : ph == 1 ? 11 : (ph - 2) % PH_PER_LAYER; if ((DBL_MASK >> sub_) & 1) run_phase(q, ph, smem); }
#endif
#else
        run_phase(p, ph, smem);
#endif
#ifdef PROBE_TS
        const unsigned long long ts1 = __builtin_amdgcn_s_memrealtime();
        xcd_barrier(xb);
        const unsigned long long ts2 = __builtin_amdgcn_s_memrealtime();
        if (PROBE_TS == 100) ts_acc += ts2 - ts1; else if (psub_ == PROBE_TS) ts_acc += ts2 - ts0;
#else
        if (ph + 1 < NPHASE) xcd_barrier(xb);
#endif
    }
#ifdef PROBE_TS
    if (blockIdx.x == 0) { const int np = (int)(ts_acc / 100ull); for (int i = threadIdx.x; i < np; i += NTHREADS) p.out[i] += 1.0f; }
#endif
}

extern "C" void kernel_launch(void* const* d_in, const int* in_sizes, int n_in, void* d_out, int out_size, void* d_ws, size_t ws_size, hipStream_t stream) {
    static int grid_blocks = 0;
    if (!grid_blocks) {
        int dev = 0, cus = 0, per_cu = 0;
        (void)hipGetDevice(&dev); (void)hipDeviceGetAttribute(&cus, hipDeviceAttributeMultiprocessorCount, dev);
        (void)hipOccupancyMaxActiveBlocksPerMultiprocessor(&per_cu, fwd_megakernel, NTHREADS, 0);
        if (per_cu > 2) per_cu = 2;
        if (per_cu < 1) per_cu = 1;
        grid_blocks = cus * per_cu;
    }
    Params p; memset(&p, 0, sizeof(p));
    make_params(p, d_in, d_out, d_ws);
    (void)hipMemsetAsync(p.BAR, 0, 4096 * sizeof(unsigned), stream);
    void* args[] = {&p};
    hipError_t e = hipLaunchCooperativeKernel((void*)fwd_megakernel, dim3(grid_blocks), dim3(NTHREADS), args, 0, stream);
    if (e != hipSuccess) fprintf(stderr, "cooperative launch failed: %s (grid %d)\n", hipGetErrorString(e), grid_blocks);
}
#endif

#if defined(DIAG_KERNELS) && !defined(CPU_EMU)
template <int SUB, int ODD>
__global__ void __launch_bounds__(NTHREADS, 2) k_diag(Params p, int l2) {
    __shared__ __attribute__((aligned(16))) unsigned char smem[LDS_BYTES];
    const int layer = l2 * 2 + ODD;
    if (SUB == 100) { phase0(p, smem); return; }
    if (SUB == 0) phaseA(p, layer, smem);
    if (SUB == 1) phaseB(p, layer);
    if (SUB == 20) { for (int it = bid_(); it < 100; it += gridDim.x) { if (ODD) attn_gqa_item(p, it, (bf16_t*)smem); else attn_diff_item(p, layer, it, (bf16_t*)smem); } }
    if (SUB == 21) { for (int it = bid_(); it < 100; it += gridDim.x) { if (ODD) rec_dc_item<64, false>(p, it, (bf16_t*)smem); else rec_dc_item<128, true>(p, it, (bf16_t*)smem); } }
    if (SUB == 3) phaseD(p, layer);
    if (SUB == 4) phaseE(p, layer, smem);
    if (SUB == 5) phaseF(p, layer, smem);
    if (SUB == 6) phaseG(p, layer, smem);
    if (SUB == 7) phaseHI<false>(p, layer, smem);
    if (SUB == 8) phaseHI<true>(p, layer, smem);
    if (SUB == 9) phaseJ(p, layer);
}
template __global__ void k_diag<100, 0>(Params, int);
template __global__ void k_diag<0, 0>(Params, int);
template __global__ void k_diag<0, 1>(Params, int);
template __global__ void k_diag<1, 0>(Params, int);
template __global__ void k_diag<20, 0>(Params, int);
template __global__ void k_diag<20, 1>(Params, int);
template __global__ void k_diag<21, 0>(Params, int);
template __global__ void k_diag<21, 1>(Params, int);
template __global__ void k_diag<3, 0>(Params, int);
template __global__ void k_diag<4, 0>(Params, int);
template __global__ void k_diag<4, 1>(Params, int);
template __global__ void k_diag<5, 0>(Params, int);
template __global__ void k_diag<6, 0>(Params, int);
template __global__ void k_diag<7, 0>(Params, int);
template __global__ void k_diag<8, 0>(Params, int);
template __global__ void k_diag<9, 0>(Params, int);
#endif
```

```cpp
#ifdef CPU_EMU
#include "emu.h"
#else
#include <hip/hip_runtime.h>
#include <hip/hip_cooperative_groups.h>
#include <cstdio>
#include <cstdint>
#include <cstring>
namespace cg = cooperative_groups;
#endif

#define DEV __device__ __forceinline__
#ifdef CPU_EMU
#define SCHED_BARRIER() do {} while (0)
#else
#define SCHED_BARRIER() __builtin_amdgcn_sched_barrier(0)
#endif
#ifdef CPU_EMU
static inline void glds16(const void* g, void* l) { memcpy(l, g, 16); }
template <int N> static inline void wait_vm() {}
#define RAW_BARRIER() __syncthreads()
#else
__device__ __forceinline__ void glds16(const void* g, void* l) {
    __builtin_amdgcn_global_load_lds((const __attribute__((address_space(1))) unsigned*)g, (__attribute__((address_space(3))) unsigned*)l, 16, 0, 0);
}
template <int N> __device__ __forceinline__ void wait_vm() { asm volatile("s_waitcnt vmcnt(%0)" ::"n"(N) : "memory"); }
#define RAW_BARRIER() do { asm volatile("s_waitcnt lgkmcnt(0)" ::: "memory"); __builtin_amdgcn_s_barrier(); } while (0)
#endif
#ifdef CPU_EMU
static inline int tid_() { return (int)threadIdx.x; }
static inline int bid_() { return (int)blockIdx.x; }
#else
__device__ __forceinline__ int tid_() { int t = threadIdx.x; asm volatile("" : "+v"(t)); return t; }
__device__ __forceinline__ int bid_() { int b = blockIdx.x; asm volatile("" : "+s"(b)); return b; }
#endif

#ifdef CPU_EMU_SMALL
constexpr int D_MODEL = 256, BATCH = 2, SEQ = 256, CTX = 256, D_EXPERT = 128;
#else
constexpr int D_MODEL = 1024, BATCH = 4, SEQ = 4096, CTX = 256, D_EXPERT = 512;
#endif
constexpr int DEPTH = 4, GRID_W = 64, CH = 128;
constexpr int TT = CTX + SEQ, NTOK = BATCH * TT, NCH = TT / CH, NCC = CTX / CH;
constexpr float EPS = 1e-5f;
constexpr float ALPHA = 1.6817928305074290f;
constexpr int HA = 4, HB = 4, HC = 4, HD = 8, HKV = 2;
constexpr int EVEN_IN = 3600, EVEN_INP = 3840, ODD_IN = 2304, MIX_OUT = 1024;
constexpr int NG = 4, EPG = 8, NE = 32, NR = NG + NE;
constexpr int NTHREADS = 256;
constexpr int LDS_BYTES = 76 * 1024;
constexpr int NCHAIN = BATCH * 4 * 2;
constexpr int EVR = 144;

typedef unsigned short bf16_t;
typedef short bf16x8 __attribute__((ext_vector_type(8)));
typedef float f32x4 __attribute__((ext_vector_type(4)));
typedef unsigned u32x4 __attribute__((ext_vector_type(4)));
typedef unsigned u32x2 __attribute__((ext_vector_type(2)));
union Frag { bf16x8 v; u32x4 q; u32x2 d[2]; unsigned u[4]; };
DEV int imin(int a, int b) { return a < b ? a : b; }

#ifdef CPU_EMU
DEV bf16_t f2bf(float f) { unsigned u = __float_as_uint(f); u += 0x7FFFu + ((u >> 16) & 1u); return (bf16_t)(u >> 16); }
DEV unsigned pack2(float a, float b) { return (unsigned)f2bf(a) | ((unsigned)f2bf(b) << 16); }
#else
typedef __bf16 hwbf16x2 __attribute__((ext_vector_type(2)));
typedef float hwf32x2 __attribute__((ext_vector_type(2)));
DEV unsigned pack2(float a, float b) { hwf32x2 v = {a, b}; hwbf16x2 h = __builtin_convertvector(v, hwbf16x2); return __builtin_bit_cast(unsigned, h); }
DEV bf16_t f2bf(float f) { return (bf16_t)(pack2(f, 0.f) & 0xFFFFu); }
#endif
DEV float bf2f(bf16_t h) { return __uint_as_float(((unsigned)h) << 16); }
DEV f32x4 bf4(u32x2 v) { return f32x4{__uint_as_float(v.x << 16), __uint_as_float(v.x & 0xFFFF0000u), __uint_as_float(v.y << 16), __uint_as_float(v.y & 0xFFFF0000u)}; }
DEV u32x2 pk4(f32x4 v) { u32x2 o; o.x = pack2(v.x, v.y); o.y = pack2(v.z, v.w); return o; }
DEV float siluf(float x) { return x / (1.0f + __expf(-x)); }
DEV float sigmf(float x) { return 1.0f / (1.0f + __expf(-x)); }
DEV float logsigf(float x) { return (x >= 0.f) ? -log1pf(expf(-x)) : x - log1pf(expf(x)); }
#ifdef CPU_EMU
DEV float rowred_add(float v) { v += __shfl_xor(v, 1); v += __shfl_xor(v, 2); v += __shfl_xor(v, 4); v += __shfl_xor(v, 8); return v; }
DEV float rowred_max(float v) { v = fmaxf(v, __shfl_xor(v, 1)); v = fmaxf(v, __shfl_xor(v, 2)); v = fmaxf(v, __shfl_xor(v, 4)); v = fmaxf(v, __shfl_xor(v, 8)); return v; }
DEV float lane_read(float v, int src, int lane) { return __shfl(v, src); }
DEV float lane_up(float v, int d, int lane) { return __shfl_up(v, d); }
#else
template <int CTRL> DEV float dppf(float v) { return __uint_as_float((unsigned)__builtin_amdgcn_update_dpp(0, (int)__float_as_uint(v), CTRL, 0xF, 0xF, true)); }
DEV float rowred_add(float v) { v += dppf<0xB1>(v); v += dppf<0x4E>(v); v += dppf<0x141>(v); v += dppf<0x140>(v); return v; }
DEV float rowred_max(float v) { v = fmaxf(v, dppf<0xB1>(v)); v = fmaxf(v, dppf<0x4E>(v)); v = fmaxf(v, dppf<0x141>(v)); v = fmaxf(v, dppf<0x140>(v)); return v; }
DEV float lane_read(float v, int src, int lane) { return __uint_as_float((unsigned)__builtin_amdgcn_ds_bpermute((src & 63) << 2, (int)__float_as_uint(v))); }
DEV float lane_up(float v, int d, int lane) { const float o = __uint_as_float((unsigned)__builtin_amdgcn_ds_bpermute(((lane - d) & 63) << 2, (int)__float_as_uint(v))); return lane >= d ? o : v; }
#endif
#ifdef CPU_EMU
DEV float xch16(float v) { return __shfl_xor(v, 16); }
DEV float xch32(float v) { return __shfl_xor(v, 32); }
#else
typedef unsigned hwu2 __attribute__((ext_vector_type(2)));
DEV void xpair16(float v, float& a, float& b) { const unsigned u = __float_as_uint(v); hwu2 r = __builtin_amdgcn_permlane16_swap(u, u, false, false); a = __uint_as_float(r.x); b = __uint_as_float(r.y); }
DEV void xpair32(float v, float& a, float& b) { const unsigned u = __float_as_uint(v); hwu2 r = __builtin_amdgcn_permlane32_swap(u, u, false, false); a = __uint_as_float(r.x); b = __uint_as_float(r.y); }
#endif
DEV float xmax16(float v) {
#ifdef CPU_EMU
    return fmaxf(v, xch16(v));
#else
    float a, b; xpair16(v, a, b); return fmaxf(a, b);
#endif
}
DEV float xmax32(float v) {
#ifdef CPU_EMU
    return fmaxf(v, xch32(v));
#else
    float a, b; xpair32(v, a, b); return fmaxf(a, b);
#endif
}
DEV float xadd16(float v) {
#ifdef CPU_EMU
    return v + xch16(v);
#else
    float a, b; xpair16(v, a, b); return a + b;
#endif
}
DEV float xadd32(float v) {
#ifdef CPU_EMU
    return v + xch32(v);
#else
    float a, b; xpair32(v, a, b); return a + b;
#endif
}
DEV float wsum(float v) { v = rowred_add(v); v = xadd16(v); return xadd32(v); }
DEV float wmax(float v) { v = rowred_max(v); v = xmax16(v); return xmax32(v); }
DEV f32x4 mfma16(bf16x8 a, bf16x8 b, f32x4 c) { return __builtin_amdgcn_mfma_f32_16x16x32_bf16(a, b, c, 0, 0, 0); }

struct WorkRange { int lo, hi, step; };
DEV WorkRange xcd_range(int T, int bid) {
    WorkRange w; const int G = gridDim.x;
    if ((G & 7) == 0) { const int x = bid & 7, k = bid >> 3; w.lo = (int)(((long long)x * T) >> 3) + k; w.hi = (int)(((long long)(x + 1) * T) >> 3); w.step = G >> 3; }
    else { w.lo = bid; w.hi = T; w.step = G; }
    return w;
}
DEV void dense_tile(int t, int nrow, int ncol, int& rt, int& ct) {
    if ((nrow & 7) == 0) { const int rpg = nrow >> 3; const int rg = t / (ncol * rpg), q = t % (ncol * rpg); ct = q / rpg; rt = rg * rpg + q % rpg; }
    else { rt = t / ncol; ct = t % ncol; }
}

struct Params {
    const float *x, *c, *ctx, *c_ctx, *w_mod, *b_mod, *ln_g, *ln_b, *ev_w_in, *ev_w_out, *ev_lambda, *ev_subln_g, *ev_conv_w, *ev_conv_b,
        *ev_gate_b, *ev_mnorm_g, *od_w_in, *od_w_out, *od_decay, *od_qk_g, *moe_w_group, *moe_b_group, *moe_w_router, *moe_b_router,
        *moe_w_gate, *moe_w_up, *moe_w_down;
    float* out;
    bf16_t* X;
    float *MOD, *ROPE, *LAM, *WrT;
    int* CNT; unsigned* BAR;
    bf16_t *WinE, *WinO, *WoutT, *Wgu, *WdT;
    bf16_t *Q1, *K1, *V1T;
    bf16_t *PM, *V2T, *OG;
    float* G;
    bf16_t *Q2, *K2, *K2T;
    bf16_t* CAT;
    bf16_t *DC, *CP;
    float *BC, *AT, *MT, *MS, *CH2;
    bf16_t *H, *ACT, *HIN, *YS; float* STAT;
    int *LIST, *TOKSLOT, *BASE; float *LISTW;
};

constexpr int GLD = 72;
constexpr int GT = 128 * GLD;

struct BLoadW {
    const bf16_t* base; int ld; u32x4 r[4];
    DEV void fetch(int kt, int tid) {
#pragma unroll
        for (int i = 0; i < 4; ++i) { int c = tid + 256 * i, row = c >> 3, kc = c & 7; r[i] = *(const u32x4*)(base + (size_t)row * ld + kt * 64 + kc * 8); }
    }
    DEV void commit(bf16_t* S, int tid) {
#pragma unroll
        for (int i = 0; i < 4; ++i) { int c = tid + 256 * i, row = c >> 3, kc = c & 7; *(u32x4*)(S + row * GLD + kc * 8) = r[i]; }
    }
};
struct ALoadB {
    const bf16_t* base; int ld; u32x4 r[4];
    DEV void fetch(int kt, int tid) {
#pragma unroll
        for (int i = 0; i < 4; ++i) { int c = tid + 256 * i, row = c >> 3, kc = c & 7; r[i] = *(const u32x4*)(base + (size_t)row * ld + kt * 64 + kc * 8); }
    }
    DEV void commit(bf16_t* S, int tid) {
#pragma unroll
        for (int i = 0; i < 4; ++i) { int c = tid + 256 * i, row = c >> 3, kc = c & 7; *(u32x4*)(S + row * GLD + kc * 8) = r[i]; }
    }
};
struct ALoadG {
    const bf16_t* H; const int* list; int nvalid; u32x4 r[4];
    DEV void fetch(int kt, int tid) {
#pragma unroll
        for (int i = 0; i < 4; ++i) {
            int c = tid + 256 * i, row = c >> 3, kc = c & 7; int rr = row < nvalid ? row : nvalid - 1; int tok = list[rr];
            r[i] = *(const u32x4*)(H + (size_t)tok * D_MODEL + kt * 64 + kc * 8);
        }
    }
    DEV void commit(bf16_t* S, int tid) {
#pragma unroll
        for (int i = 0; i < 4; ++i) { int c = tid + 256 * i, row = c >> 3, kc = c & 7; *(u32x4*)(S + row * GLD + kc * 8) = r[i]; }
    }
};
struct ALoadX {
    const float* base; const float *sc, *sh; f32x4 r[8]; f32x4 s4, h4;
    DEV void fetch(int kt, int tid) {
        int kc = tid & 15;
        s4 = *(const f32x4*)(sc + kt * 64 + kc * 4); h4 = *(const f32x4*)(sh + kt * 64 + kc * 4);
#pragma unroll
        for (int i = 0; i < 8; ++i) { int row = (tid >> 4) + 16 * i; r[i] = *(const f32x4*)(base + (size_t)row * D_MODEL + kt * 64 + kc * 4); }
    }
    DEV void commit(bf16_t* S, int tid) {
        int kc = tid & 15;
#pragma unroll
        for (int i = 0; i < 8; ++i) {
            int row = (tid >> 4) + 16 * i;
            u32x2 o; o.x = pack2(r[i].x * (1.f + s4.x) + h4.x, r[i].y * (1.f + s4.y) + h4.y); o.y = pack2(r[i].z * (1.f + s4.z) + h4.z, r[i].w * (1.f + s4.w) + h4.w);
            *(u32x2*)(S + row * GLD + kc * 4) = o;
        }
    }
};

template <class AL, class BL, class EP>
DEV void gemm_tile(bf16_t* sm, AL& al, BL& bl, int nkt, EP& ep) {
    const int tid = tid_(), wid = tid >> 6, lane = tid & 63, wr = wid >> 1, wc = wid & 1, r = lane & 15, quad = lane >> 4;
    bf16_t* As = sm; bf16_t* Bs = sm + 2 * GT;
    f32x4 acc[4][4];
#pragma unroll
    for (int m = 0; m < 4; ++m)
#pragma unroll
        for (int n = 0; n < 4; ++n) acc[m][n] = f32x4{0.f, 0.f, 0.f, 0.f};
    al.fetch(0, tid); bl.fetch(0, tid); al.commit(As, tid); bl.commit(Bs, tid);
    __syncthreads();
    for (int kt = 0; kt < nkt; ++kt) {
        const int cur = kt & 1;
        if (kt + 1 < nkt) { al.fetch(kt + 1, tid); bl.fetch(kt + 1, tid); }
        const bf16_t* Ac = As + cur * GT + (wr * 64 + r) * GLD + quad * 8;
        const bf16_t* Bc = Bs + cur * GT + (wc * 64 + r) * GLD + quad * 8;
#pragma unroll
        for (int ks = 0; ks < 2; ++ks) {
            Frag a[4], b[4];
#pragma unroll
            for (int m = 0; m < 4; ++m) a[m].q = *(const u32x4*)(Ac + m * 16 * GLD + ks * 32);
#pragma unroll
            for (int n = 0; n < 4; ++n) b[n].q = *(const u32x4*)(Bc + n * 16 * GLD + ks * 32);
#pragma unroll
            for (int m = 0; m < 4; ++m)
#pragma unroll
                for (int n = 0; n < 4; ++n) acc[m][n] = mfma16(a[m].v, b[n].v, acc[m][n]);
        }
        if (kt + 1 < nkt) { al.commit(As + (cur ^ 1) * GT, tid); bl.commit(Bs + (cur ^ 1) * GT, tid); }
        __syncthreads();
    }
    ep(acc, wr, wc, lane);
}


DEV int g2_h(int g) { return (0x78 >> (2 * g)) & 3; }
template <int NH> struct G2 { static constexpr int BROWS = 128 * NH, STAGE = 8192 + BROWS * 64, NST = (NH == 2 ? 3 : 4), LPS = 2 + 2 * NH; };

template <int NH, bool TR, class EP>
DEV void gemm_tile2(unsigned char* sm, const bf16_t* a0, const bf16_t* a1, const bf16_t* bb, int ldb, int nkt, EP& ep) {
    constexpr int STAGE = G2<NH>::STAGE, NST = G2<NH>::NST, LPS = G2<NH>::LPS;
    const int tid = tid_(), wid = tid >> 6, lane = tid & 63, wr = wid >> 1, wc = wid & 1, r = lane & 15, quad = lane >> 4;
    f32x4 acc[NH][4][4];
#pragma unroll
    for (int h = 0; h < NH; ++h)
#pragma unroll
        for (int m = 0; m < 4; ++m)
#pragma unroll
            for (int n = 0; n < 4; ++n) acc[h][m][n] = f32x4{0.f, 0.f, 0.f, 0.f};
    unsigned char* dst0 = sm + tid * 16;
    auto issue = [&](int kt, int slot) {
        unsigned char* d = dst0 + slot * STAGE;
        glds16(a0 + kt * 32, d); glds16(a1 + kt * 32, d + 4096);
#pragma unroll
        for (int j = 0; j < 2 * NH; ++j) glds16(bb + (size_t)j * 64 * ldb + kt * 32, d + 8192 + j * 4096);
    };
    RAW_BARRIER();
#pragma unroll
    for (int st = 0; st < NST - 1; ++st) if (st < nkt) issue(st, st);
    const int pco = (quad ^ g2_h((r >> 2) & 3)) * 16;
    const unsigned char* afr = sm + (wr * 64 + r) * 64 + pco;
    const unsigned char* bfr = sm + 8192 + (wc * 64 * NH + r) * 64 + pco;
    int slot = 0;
    for (int kt = 0; kt < nkt; ++kt) {
        const int rem = nkt - 1 - kt;
        if (NST == 3) { if (rem >= 1) wait_vm<LPS>(); else wait_vm<0>(); }
        else { if (rem >= 2) wait_vm<2 * LPS>(); else if (rem == 1) wait_vm<LPS>(); else wait_vm<0>(); }
        RAW_BARRIER();
        if (kt + NST - 1 < nkt) { int ns = slot + NST - 1; if (ns >= NST) ns -= NST; issue(kt + NST - 1, ns); }
        const unsigned char* as = afr + slot * STAGE; const unsigned char* bs = bfr + slot * STAGE;
        Frag a[4];
#pragma unroll
        for (int m = 0; m < 4; ++m) a[m].q = *(const u32x4*)(as + m * 16 * 64);
#ifndef CPU_EMU
        __builtin_amdgcn_s_setprio(1);
#endif
#pragma unroll
        for (int h = 0; h < NH; ++h) {
            Frag b[4];
#pragma unroll
            for (int n = 0; n < 4; ++n) b[n].q = *(const u32x4*)(bs + (h * 64 + n * 16) * 64);
#pragma unroll
            for (int m = 0; m < 4; ++m)
#pragma unroll
                for (int n = 0; n < 4; ++n) acc[h][m][n] = TR ? mfma16(b[n].v, a[m].v, acc[h][m][n]) : mfma16(a[m].v, b[n].v, acc[h][m][n]);
        }
#ifndef CPU_EMU
        __builtin_amdgcn_s_setprio(0);
#endif
        if (++slot == NST) slot = 0;
    }
#pragma unroll
    for (int h = 0; h < NH; ++h) { if (TR) ep.nat(acc[h], wr, wc * NH + h, lane); else ep(acc[h], wr, wc * NH + h, lane); }
}
DEV int g2_lc(int tid) { return (tid & 3) ^ g2_h((tid >> 4) & 3); }

struct ConvJob { const float* src; bf16_t* dst; int ldsrc, N, K, k0, n0, mapkind; };
DEV void conv_load(const ConvJob& j, int tid, f32x4 (&v)[4]) {
#pragma unroll
    for (int i = 0; i < 4; ++i) {
        const int kk = (tid >> 4) + 16 * i, n = j.n0 + 4 * (tid & 15);
        v[i] = f32x4{0.f, 0.f, 0.f, 0.f};
        if (n + 3 < j.N) v[i] = *(const f32x4*)(j.src + (size_t)(j.k0 + kk) * j.ldsrc + n);
    }
}
DEV void conv_store(float* T, const ConvJob& j, int tid, const f32x4 (&v)[4]) {
    __syncthreads();
#pragma unroll
    for (int i = 0; i < 4; ++i) {
        const int kk = (tid >> 4) + 16 * i, n4 = tid & 15;
        T[(4 * n4 + 0) * 65 + kk] = v[i].x; T[(4 * n4 + 1) * 65 + kk] = v[i].y; T[(4 * n4 + 2) * 65 + kk] = v[i].z; T[(4 * n4 + 3) * 65 + kk] = v[i].w;
    }
    __syncthreads();
    const int nl = tid >> 2, ks = (tid & 3) * 16; const int n = j.n0 + nl; int dr = n;
    if (j.mapkind == 1) dr = (n >> 5) * 64 + (n & 31); else if (j.mapkind == 2) dr = (n >> 5) * 64 + 32 + (n & 31);
    const float* t = T + nl * 65 + ks;
    u32x4 o0, o1;
    o0.x = pack2(t[0], t[1]); o0.y = pack2(t[2], t[3]); o0.z = pack2(t[4], t[5]); o0.w = pack2(t[6], t[7]);
    o1.x = pack2(t[8], t[9]); o1.y = pack2(t[10], t[11]); o1.z = pack2(t[12], t[13]); o1.w = pack2(t[14], t[15]);
    bf16_t* d = j.dst + (size_t)dr * j.K + j.k0 + ks;
    *(u32x4*)d = o0; *(u32x4*)(d + 8) = o1;
}
constexpr int P0_NMOD = DEPTH * 6 * D_MODEL / 64;
constexpr int P0_NCOPY = NTOK / 64;
constexpr int T_EIN = (D_MODEL / 64) * (EVEN_INP / 64), T_OIN = (D_MODEL / 64) * (ODD_IN / 64), T_OUT = (MIX_OUT / 64) * (D_MODEL / 64);
constexpr int T_GU = (D_MODEL / 64) * (D_EXPERT / 64), T_DN = (D_EXPERT / 64) * (D_MODEL / 64);
constexpr int P0_C0 = P0_NMOD + P0_NCOPY + 1 + DEPTH;
constexpr int P0_C1 = 2 * T_EIN, P0_C2 = P0_C1 + 2 * T_OIN, P0_C3 = P0_C2 + DEPTH * T_OUT, P0_C4 = P0_C3 + DEPTH * NE * 2 * T_GU, P0_C5 = P0_C4 + DEPTH * NE * T_DN;
DEV ConvJob conv_job(const Params& p, int t) {
    ConvJob j;
    if (t < P0_C1) {
        const int i = t / T_EIN, tt = t % T_EIN; const int nt = tt % (EVEN_INP / 64), kt = tt / (EVEN_INP / 64);
        j.src = p.ev_w_in + (size_t)i * D_MODEL * EVEN_IN; j.ldsrc = EVEN_IN; j.N = EVEN_IN; j.K = D_MODEL; j.k0 = kt * 64; j.n0 = nt * 64; j.dst = p.WinE + (size_t)i * EVEN_INP * D_MODEL; j.mapkind = 0;
    } else if (t < P0_C2) {
        const int q = t - P0_C1, i = q / T_OIN, tt = q % T_OIN; const int nt = tt % (ODD_IN / 64), kt = tt / (ODD_IN / 64);
        j.src = p.od_w_in + (size_t)i * D_MODEL * ODD_IN; j.ldsrc = ODD_IN; j.N = ODD_IN; j.K = D_MODEL; j.k0 = kt * 64; j.n0 = nt * 64; j.dst = p.WinO + (size_t)i * ODD_IN * D_MODEL; j.mapkind = 0;
    } else if (t < P0_C3) {
        const int q = t - P0_C2, layer = q / T_OUT, tt = q % T_OUT; const int nt = tt % (D_MODEL / 64), kt = tt / (D_MODEL / 64);
        j.src = (layer & 1) ? p.od_w_out + (size_t)(layer >> 1) * MIX_OUT * D_MODEL : p.ev_w_out + (size_t)(layer >> 1) * MIX_OUT * D_MODEL;
        j.ldsrc = D_MODEL; j.N = D_MODEL; j.K = MIX_OUT; j.k0 = kt * 64; j.n0 = nt * 64; j.dst = p.WoutT + (size_t)layer * D_MODEL * MIX_OUT; j.mapkind = 0;
    } else if (t < P0_C4) {
        const int q = t - P0_C3, le = q / (2 * T_GU); int tt = q % (2 * T_GU); const int up = tt / T_GU; tt %= T_GU; const int nt = tt % (D_EXPERT / 64), kt = tt / (D_EXPERT / 64);
        j.src = (up ? p.moe_w_up : p.moe_w_gate) + (size_t)le * D_MODEL * D_EXPERT; j.ldsrc = D_EXPERT; j.N = D_EXPERT; j.K = D_MODEL; j.k0 = kt * 64; j.n0 = nt * 64;
        j.dst = p.Wgu + (size_t)le * 2 * D_EXPERT * D_MODEL; j.mapkind = 1 + up;
    } else {
        const int q = t - P0_C4, le = q / T_DN, tt = q % T_DN; const int nt = tt % (D_MODEL / 64), kt = tt / (D_MODEL / 64);
        j.src = p.moe_w_down + (size_t)le * D_EXPERT * D_MODEL; j.ldsrc = D_MODEL; j.N = D_MODEL; j.K = D_EXPERT; j.k0 = kt * 64; j.n0 = nt * 64; j.dst = p.WdT + (size_t)le * D_MODEL * D_EXPERT; j.mapkind = 0;
    }
    return j;
}

DEV void phase0(const Params& p, unsigned char* smem) {
    const int tid = tid_(); const int bid = bid_();
    float* fs = (float*)smem;
    for (int task = bid; task < P0_C0; task += gridDim.x) {
        if (task < P0_NMOD) {
            __syncthreads();
            for (int i = tid; i < (BATCH + 1) * D_MODEL; i += 256) { int bb = i / D_MODEL, k = i % D_MODEL; float v = bb < BATCH ? p.c[bb * D_MODEL + k] : p.c_ctx[k]; fs[i] = v / (1.f + expf(-v)); }
            __syncthreads();
            const int col = task * 64 + (tid & 63), kg = tid >> 6; const int layer = col / (6 * D_MODEL), j = col % (6 * D_MODEL);
            const float* w = p.w_mod + (size_t)layer * D_MODEL * 6 * D_MODEL + j;
            float acc[BATCH + 1];
#pragma unroll
            for (int bb = 0; bb <= BATCH; ++bb) acc[bb] = 0.f;
#pragma unroll 16
            for (int k = kg * (D_MODEL / 4); k < (kg + 1) * (D_MODEL / 4); ++k) {
                float wv = w[(size_t)k * 6 * D_MODEL];
#pragma unroll
                for (int bb = 0; bb <= BATCH; ++bb) acc[bb] += fs[bb * D_MODEL + k] * wv;
            }
            float* red = fs + (BATCH + 1) * D_MODEL;
#pragma unroll
            for (int bb = 0; bb <= BATCH; ++bb) red[(kg * (BATCH + 1) + bb) * 64 + (tid & 63)] = acc[bb];
            __syncthreads();
            if (tid < 64) {
                const float bm = p.b_mod[layer * 6 * D_MODEL + j];
#pragma unroll
                for (int bb = 0; bb <= BATCH; ++bb) {
                    const float sacc = red[(0 * (BATCH + 1) + bb) * 64 + tid] + red[(1 * (BATCH + 1) + bb) * 64 + tid] + red[(2 * (BATCH + 1) + bb) * 64 + tid] + red[(3 * (BATCH + 1) + bb) * 64 + tid];
                    p.MOD[((size_t)layer * (BATCH + 1) + bb) * 6 * D_MODEL + j] = sacc + bm;
                }
            }
        } else if (task < P0_NMOD + P0_NCOPY) {
            int r0 = (task - P0_NMOD) * 64;
            for (int i = tid; i < 64 * D_MODEL / 4; i += 256) {
                int row = r0 + i / (D_MODEL / 4), c4 = i % (D_MODEL / 4); int b = row / TT, s = row % TT;
                const float* src = s < CTX ? p.ctx + ((size_t)b * CTX + s) * D_MODEL : p.x + ((size_t)b * SEQ + (s - CTX)) * D_MODEL;
                *(u32x2*)(p.X + (size_t)row * D_MODEL + c4 * 4) = pk4(*(const f32x4*)(src + c4 * 4));

            }
        } else if (task == P0_NMOD + P0_NCOPY) {
            for (int i = tid; i < 64 * 16; i += 256) {
                int pos = i / 16, f = i % 16;
                double th = 1.0; for (int q = 0; q < f; ++q) th *= 0.5623413251903490804;
                double t2 = th * th, cs = 1.0, sn = th, tc = 1.0, ts = th;
                for (int n = 1; n < 14; ++n) { tc *= -t2 / ((2 * n - 1) * (2 * n)); ts *= -t2 / ((2 * n) * (2 * n + 1)); cs += tc; sn += ts; }
                double c = 1.0, s = 0.0;
                for (int q = 0; q < pos; ++q) { double cn = c * cs - s * sn, sn2 = s * cs + c * sn; c = cn; s = sn2; }
                p.ROPE[i * 2] = (float)c; p.ROPE[i * 2 + 1] = (float)s;
            }
            if (tid < 2) {
                const float* lp = p.ev_lambda + tid * 4 * 64; float s01 = 0.f, s23 = 0.f;
                for (int k = 0; k < 64; ++k) { s01 += lp[k] * lp[64 + k]; s23 += lp[128 + k] * lp[192 + k]; }
                float lam_init = 0.8f - 0.6f * expf(-0.3f * (float)(2 * tid));
                p.LAM[tid] = expf(s01) - expf(s23) + lam_init;
            }
            for (int i = tid; i < DEPTH * NE * 32; i += 256) p.CNT[i] = 0;
        } else {
            int layer = task - (P0_NMOD + P0_NCOPY + 1);
            for (int i = tid; i < NR * D_MODEL; i += 256) {
                int j = i / D_MODEL, k = i % D_MODEL;
                float v = j < NG ? p.moe_w_group[((size_t)layer * D_MODEL + k) * NG + j] : p.moe_w_router[((size_t)layer * D_MODEL + k) * NE + (j - NG)];
                p.WrT[(size_t)layer * NR * D_MODEL + i] = v;
            }
        }
    }
    {
        const int G = gridDim.x; int t = bid;
        ConvJob j0, j1, j2; f32x4 v0[4], v1[4], v2[4];
        const bool h0 = t < P0_C5, h1 = t + G < P0_C5;
        if (h0) { j0 = conv_job(p, t); conv_load(j0, tid, v0); } else { j0 = conv_job(p, 0); }
        if (h1) { j1 = conv_job(p, t + G); conv_load(j1, tid, v1); } else { j1 = j0; }
        j2 = j1;
        while (t < P0_C5) {
            const bool h2 = t + 2 * G < P0_C5;
            if (h2) { j2 = conv_job(p, t + 2 * G); conv_load(j2, tid, v2); }
            conv_store(fs, j0, tid, v0);
            j0 = j1; j1 = j2;
#pragma unroll
            for (int i = 0; i < 4; ++i) { v0[i] = v1[i]; v1[i] = v2[i]; }
            t += G;
        }
    }
}

DEV int chunk_of(int dir, int sp) { return dir == 0 ? sp : (sp < NCC ? NCC - 1 - sp : NCC + (NCH - 1 - sp)); }
DEV int sp_of(int dir, int u) { return dir == 0 ? u : (u < NCC ? NCC - 1 - u : NCC + (NCH - 1 - u)); }

template <bool RET>
DEV void gate_chain(const Params& p, int layer, int chain) {
    const int lane = tid_() & 63;
    const int dir = chain & 1, h = (chain >> 1) & 3, b = chain >> 3;
    float lg = 0.f;
    if (RET) lg = logsigf(p.od_decay[((layer >> 1) * 2 + dir) * HC + h]);
    float mprev = 0.f;
    for (int sp = 0; sp < NCH; ++sp) {
        const int u = chunk_of(dir, sp); const int sbase = u * CH;
        int i0 = 2 * lane, i1 = 2 * lane + 1;
        int s0 = dir ? sbase + 127 - i0 : sbase + i0, s1 = dir ? sbase + 127 - i1 : sbase + i1;
        float lf0, lf1, li0, li1;
        if (RET) { lf0 = lf1 = lg; li0 = li1 = 0.f; }
        else {
            const float* g0 = p.G + ((size_t)b * TT + s0) * 16; const float* g1 = p.G + ((size_t)b * TT + s1) * 16;
            li0 = g0[(2 * dir) * 4 + h]; li1 = g1[(2 * dir) * 4 + h];
            lf0 = logsigf(g0[(2 * dir + 1) * 4 + h]); lf1 = logsigf(g1[(2 * dir + 1) * 4 + h]);
        }
        float ps = lf0 + lf1;
        for (int d = 1; d < 64; d <<= 1) { float o = lane_up(ps, d, lane); if (lane >= d) ps += o; }
        float b1 = ps, b0 = ps - lf1;
        float bend = lane_read(ps, 63, lane);
        float a0 = li0 - b0, a1 = li1 - b1;
        float pm = fmaxf(a0, a1);
        float mx = pm;
        for (int d = 1; d < 64; d <<= 1) { float o = lane_up(mx, d, lane); if (lane >= d) mx = fmaxf(mx, o); }
        float pmx_prev = lane_up(mx, 1, lane); if (lane == 0) pmx_prev = -3.0e38f;
        float pm0 = fmaxf(pmx_prev, a0), pm1 = mx;
        float amax = lane_read(mx, 63, lane);
        float mnew, carry, mt0, mt1;
        if (RET) { mnew = 0.f; carry = __expf(bend); mt0 = mt1 = 0.f; }
        else { mnew = fmaxf(bend + mprev, bend + amax); carry = __expf(bend + mprev - mnew); mt0 = b0 + fmaxf(mprev, pm0); mt1 = b1 + fmaxf(mprev, pm1); }
        size_t o = (size_t)chain * TT;
        p.BC[o + s0] = b0; p.BC[o + s1] = b1; p.AT[o + s0] = a0; p.AT[o + s1] = a1; p.MT[o + s0] = mt0; p.MT[o + s1] = mt1;
        if (lane == 0) { float* ms = p.MS + ((size_t)chain * NCH + sp) * 4; ms[0] = mprev; ms[1] = mnew; ms[2] = bend; ms[3] = carry; }
        mprev = mnew;
    }
}

struct EpInEven {
    const Params& p; int layer, row0, col0;
    DEV void nat(f32x4 (&acc)[4][4], int wr, int wc, int lane) {
        const int r = lane & 15, quad = lane >> 4;
        const int c0 = col0 + wc * 64, rowb = row0 + wr * 64;
        const int b = row0 / TT; const int sb = rowb - b * TT; const bool lat = sb >= CTX;
        if (c0 < 1024) {
            bf16_t* dst = c0 < 512 ? p.Q1 : p.K1; const int cc = c0 & 511;
#pragma unroll
            for (int m = 0; m < 4; ++m) {
                const int row = rowb + m * 16 + r;
                f32x4 v0 = acc[m][0], v1 = acc[m][1], v2 = acc[m][2], v3 = acc[m][3];
                if (lat) {
                    const int t = sb + m * 16 + r - CTX; const int pr = t / GRID_W, pc = t % GRID_W;
                    const f32x4 ra = *(const f32x4*)(p.ROPE + (pr * 16 + quad * 4) * 2), rb = *(const f32x4*)(p.ROPE + (pr * 16 + quad * 4) * 2 + 4);
                    const f32x4 ca = *(const f32x4*)(p.ROPE + (pc * 16 + quad * 4) * 2), cb = *(const f32x4*)(p.ROPE + (pc * 16 + quad * 4) * 2 + 4);
                    const f32x4 cr = f32x4{ra[0], ra[2], rb[0], rb[2]}, sr = f32x4{ra[1], ra[3], rb[1], rb[3]};
                    const f32x4 cq = f32x4{ca[0], ca[2], cb[0], cb[2]}, sq = f32x4{ca[1], ca[3], cb[1], cb[3]};
                    const f32x4 o0 = v0 * cr - v2 * sr, o2 = v0 * sr + v2 * cr, o1 = v1 * cq - v3 * sq, o3 = v1 * sq + v3 * cq;
                    v0 = o0; v1 = o1; v2 = o2; v3 = o3;
                }
                bf16_t* d = dst + (size_t)row * 512 + cc + quad * 4;
                u32x2 w; w.x = pack2(v0[0], v0[1]); w.y = pack2(v0[2], v0[3]); *(u32x2*)d = w;
                w.x = pack2(v1[0], v1[1]); w.y = pack2(v1[2], v1[3]); *(u32x2*)(d + 16) = w;
                w.x = pack2(v2[0], v2[1]); w.y = pack2(v2[2], v2[3]); *(u32x2*)(d + 32) = w;
                w.x = pack2(v3[0], v3[1]); w.y = pack2(v3[2], v3[3]); *(u32x2*)(d + 48) = w;
            }
        } else if (c0 < 3584) {
            const bool pm = c0 < 2560; bf16_t* dst = pm ? p.PM : p.OG; const int ld = pm ? 1024 : 512; const int cc = pm ? c0 - 1536 : c0 - 3072;
#pragma unroll
            for (int m = 0; m < 4; ++m) {
                bf16_t* d = dst + (size_t)(rowb + m * 16 + r) * ld + cc + quad * 4;
#pragma unroll
                for (int n = 0; n < 4; ++n) { u32x2 w; w.x = pack2(acc[m][n][0], acc[m][n][1]); w.y = pack2(acc[m][n][2], acc[m][n][3]); *(u32x2*)(d + n * 16) = w; }
            }
        } else if (c0 == 3584) {
            const f32x4 gb = *(const f32x4*)(p.ev_gate_b + (layer >> 1) * 16 + quad * 4);
#pragma unroll
            for (int m = 0; m < 4; ++m) *(f32x4*)(p.G + (size_t)(rowb + m * 16 + r) * 16 + quad * 4) = acc[m][0] + gb;
        }
    }
    DEV void operator()(f32x4 (&acc)[4][4], int wr, int wc, int lane) {
        const int r = lane & 15, quad = lane >> 4;
        const int c0 = col0 + wc * 64, rowb = row0 + wr * 64;
        const int b = row0 / TT; const int sb = rowb - b * TT; const bool lat = sb >= CTX;
        if (c0 < 1024) {
            bf16_t* dst = c0 < 512 ? p.Q1 : p.K1; const int cc = c0 & 511;
#pragma unroll
            for (int m = 0; m < 4; ++m)
#pragma unroll
                for (int j = 0; j < 4; ++j) {
                    const int row = rowb + m * 16 + quad * 4 + j;
                    float v0 = acc[m][0][j], v1 = acc[m][1][j], v2 = acc[m][2][j], v3 = acc[m][3][j];
                    if (lat) {
                        const int t = sb + m * 16 + quad * 4 + j - CTX; const int pr = t / GRID_W, pc = t % GRID_W;
                        const float cr = p.ROPE[(pr * 16 + r) * 2], sr = p.ROPE[(pr * 16 + r) * 2 + 1], cq = p.ROPE[(pc * 16 + r) * 2], sq = p.ROPE[(pc * 16 + r) * 2 + 1];
                        float o0 = v0 * cr - v2 * sr, o2 = v0 * sr + v2 * cr, o1 = v1 * cq - v3 * sq, o3 = v1 * sq + v3 * cq;
                        v0 = o0; v1 = o1; v2 = o2; v3 = o3;
                    }
                    bf16_t* d = dst + (size_t)row * 512 + cc + r;
                    d[0] = f2bf(v0); d[16] = f2bf(v1); d[32] = f2bf(v2); d[48] = f2bf(v3);
                }
        } else if (c0 < 1536 || (c0 >= 2560 && c0 < 3072)) {
            const bool at = c0 < 1536; const int cc = at ? c0 - 1024 : c0 - 2560; const int h = cc >> 7, e0 = (cc & 127);
            bf16_t* dst = (at ? p.V1T : p.V2T) + ((size_t)(b * 4 + h) * 128) * TT;
#pragma unroll
            for (int m = 0; m < 4; ++m)
#pragma unroll
                for (int n = 0; n < 4; ++n) {
                    u32x2 o; o.x = pack2(acc[m][n][0], acc[m][n][1]); o.y = pack2(acc[m][n][2], acc[m][n][3]);
                    *(u32x2*)(dst + (size_t)(e0 + n * 16 + r) * TT + sb + m * 16 + quad * 4) = o;
                }
        } else if (c0 < 2560 || (c0 >= 3072 && c0 < 3584)) {
            const bool pm = c0 < 2560; bf16_t* dst = pm ? p.PM : p.OG; const int ld = pm ? 1024 : 512; const int cc = pm ? c0 - 1536 : c0 - 3072;
#pragma unroll
            for (int m = 0; m < 4; ++m)
#pragma unroll
                for (int j = 0; j < 4; ++j) {
                    const int row = rowb + m * 16 + quad * 4 + j; bf16_t* d = dst + (size_t)row * ld + cc + r;
                    d[0] = f2bf(acc[m][0][j]); d[16] = f2bf(acc[m][1][j]); d[32] = f2bf(acc[m][2][j]); d[48] = f2bf(acc[m][3][j]);
                }
        } else if (c0 == 3584) {
            const float gb = p.ev_gate_b[(layer >> 1) * 16 + r];
#pragma unroll
            for (int m = 0; m < 4; ++m)
#pragma unroll
                for (int j = 0; j < 4; ++j) { const int row = rowb + m * 16 + quad * 4 + j; p.G[(size_t)row * 16 + r] = acc[m][0][j] + gb; }
        }
    }
};

struct EpInOdd {
    const Params& p; int layer, row0, col0;
    DEV void nat(f32x4 (&acc)[4][4], int wr, int wc, int lane) {
        const int r = lane & 15, quad = lane >> 4;
        const int c0 = col0 + wc * 64, rowb = row0 + wr * 64;
        const int b = row0 / TT; const int sb = rowb - b * TT; const bool lat = sb >= CTX;
        if (c0 < 512 || (c0 >= 1024 && c0 < 1536)) {
            bf16_t* dst; int ld, cc; float scl = 1.f;
            if (c0 < 256) { dst = p.Q2; ld = 256; cc = c0; } else if (c0 < 512) { dst = p.K2; ld = 256; cc = c0 - 256; scl = 0.125f; } else { dst = p.OG; ld = 512; cc = c0 - 1024; }
#pragma unroll
            for (int m = 0; m < 4; ++m) {
                bf16_t* d = dst + (size_t)(rowb + m * 16 + r) * ld + cc + quad * 4;
#pragma unroll
                for (int n = 0; n < 4; ++n) { u32x2 w; w.x = pack2(acc[m][n][0] * scl, acc[m][n][1] * scl); w.y = pack2(acc[m][n][2] * scl, acc[m][n][3] * scl); *(u32x2*)(d + n * 16) = w; }
            }
        } else if (c0 >= 1536 && c0 < 2176) {
            const bool isq = c0 < 2048; bf16_t* dst = isq ? p.Q1 : p.K1; const int ld = isq ? 512 : 128; const int cc = isq ? c0 - 1536 : c0 - 2048;
            const float* g = p.od_qk_g + ((layer >> 1) * 2 + (isq ? 0 : 1)) * 64 + quad * 4;
            const f32x4 g0 = *(const f32x4*)g, g1 = *(const f32x4*)(g + 16), g2 = *(const f32x4*)(g + 32), g3 = *(const f32x4*)(g + 48);
#pragma unroll
            for (int m = 0; m < 4; ++m) {
                const int row = rowb + m * 16 + r;
                f32x4 v0 = acc[m][0], v1 = acc[m][1], v2 = acc[m][2], v3 = acc[m][3];
                float ss = 0.f;
#pragma unroll
                for (int j = 0; j < 4; ++j) ss += v0[j] * v0[j] + v1[j] * v1[j] + v2[j] * v2[j] + v3[j] * v3[j];
                ss = xadd16(ss); ss = xadd32(ss);
                const float rs = 1.0f / sqrtf(ss * (1.f / 64.f) + EPS);
                v0 = v0 * rs * g0; v1 = v1 * rs * g1; v2 = v2 * rs * g2; v3 = v3 * rs * g3;
                if (lat) {
                    const int t = sb + m * 16 + r - CTX; const int pr = t / GRID_W, pc = t % GRID_W;
                    const f32x4 ra = *(const f32x4*)(p.ROPE + (pr * 16 + quad * 4) * 2), rb = *(const f32x4*)(p.ROPE + (pr * 16 + quad * 4) * 2 + 4);
                    const f32x4 ca = *(const f32x4*)(p.ROPE + (pc * 16 + quad * 4) * 2), cb = *(const f32x4*)(p.ROPE + (pc * 16 + quad * 4) * 2 + 4);
                    const f32x4 cr = f32x4{ra[0], ra[2], rb[0], rb[2]}, sr = f32x4{ra[1], ra[3], rb[1], rb[3]};
                    const f32x4 cq = f32x4{ca[0], ca[2], cb[0], cb[2]}, sq = f32x4{ca[1], ca[3], cb[1], cb[3]};
                    const f32x4 o0 = v0 * cr - v2 * sr, o2 = v0 * sr + v2 * cr, o1 = v1 * cq - v3 * sq, o3 = v1 * sq + v3 * cq;
                    v0 = o0; v1 = o1; v2 = o2; v3 = o3;
                }
                bf16_t* d = dst + (size_t)row * ld + cc + quad * 4;
                u32x2 w; w.x = pack2(v0[0], v0[1]); w.y = pack2(v0[2], v0[3]); *(u32x2*)d = w;
                w.x = pack2(v1[0], v1[1]); w.y = pack2(v1[2], v1[3]); *(u32x2*)(d + 16) = w;
                w.x = pack2(v2[0], v2[1]); w.y = pack2(v2[2], v2[3]); *(u32x2*)(d + 32) = w;
                w.x = pack2(v3[0], v3[1]); w.y = pack2(v3[2], v3[3]); *(u32x2*)(d + 48) = w;
            }
        }
    }
    DEV void operator()(f32x4 (&acc)[4][4], int wr, int wc, int lane) {
        const int r = lane & 15, quad = lane >> 4;
        const int c0 = col0 + wc * 64, rowb = row0 + wr * 64;
        const int b = row0 / TT; const int sb = rowb - b * TT; const bool lat = sb >= CTX;
        if (c0 < 512 || (c0 >= 1024 && c0 < 1536)) {
            bf16_t* dst; int ld, cc; float scl = 1.f;
            if (c0 < 256) { dst = p.Q2; ld = 256; cc = c0; } else if (c0 < 512) { dst = p.K2; ld = 256; cc = c0 - 256; scl = 0.125f; } else { dst = p.OG; ld = 512; cc = c0 - 1024; }
#pragma unroll
            for (int m = 0; m < 4; ++m)
#pragma unroll
                for (int j = 0; j < 4; ++j) {
                    const int row = rowb + m * 16 + quad * 4 + j; bf16_t* d = dst + (size_t)row * ld + cc + r;
                    d[0] = f2bf(acc[m][0][j] * scl); d[16] = f2bf(acc[m][1][j] * scl); d[32] = f2bf(acc[m][2][j] * scl); d[48] = f2bf(acc[m][3][j] * scl);
                }
        } else if (c0 < 1024) {
            const int cc = c0 - 512; const int h = cc >> 7, e0 = cc & 127; bf16_t* dst = p.V2T + ((size_t)(b * 4 + h) * 128) * TT;
#pragma unroll
            for (int m = 0; m < 4; ++m)
#pragma unroll
                for (int n = 0; n < 4; ++n) {
                    u32x2 o; o.x = pack2(acc[m][n][0], acc[m][n][1]); o.y = pack2(acc[m][n][2], acc[m][n][3]);
                    *(u32x2*)(dst + (size_t)(e0 + n * 16 + r) * TT + sb + m * 16 + quad * 4) = o;
                }
        } else if (c0 < 2176) {
            const bool isq = c0 < 2048; bf16_t* dst = isq ? p.Q1 : p.K1; const int ld = isq ? 512 : 128; const int cc = isq ? c0 - 1536 : c0 - 2048;
            const float* g = p.od_qk_g + ((layer >> 1) * 2 + (isq ? 0 : 1)) * 64;
            const float g0 = g[r], g1 = g[16 + r], g2 = g[32 + r], g3 = g[48 + r];
#pragma unroll
            for (int m = 0; m < 4; ++m)
#pragma unroll
                for (int j = 0; j < 4; ++j) {
                    const int row = rowb + m * 16 + quad * 4 + j;
                    float v0 = acc[m][0][j], v1 = acc[m][1][j], v2 = acc[m][2][j], v3 = acc[m][3][j];
                    float ss = v0 * v0 + v1 * v1 + v2 * v2 + v3 * v3;
                    ss = rowred_add(ss);
                    const float rs = 1.0f / sqrtf(ss * (1.f / 64.f) + EPS);
                    v0 *= rs * g0; v1 *= rs * g1; v2 *= rs * g2; v3 *= rs * g3;
                    if (lat) {
                        const int t = sb + m * 16 + quad * 4 + j - CTX; const int pr = t / GRID_W, pc = t % GRID_W;
                        const float cr = p.ROPE[(pr * 16 + r) * 2], sr = p.ROPE[(pr * 16 + r) * 2 + 1], cq = p.ROPE[(pc * 16 + r) * 2], sq = p.ROPE[(pc * 16 + r) * 2 + 1];
                        float o0 = v0 * cr - v2 * sr, o2 = v0 * sr + v2 * cr, o1 = v1 * cq - v3 * sq, o3 = v1 * sq + v3 * cq;
                        v0 = o0; v1 = o1; v2 = o2; v3 = o3;
                    }
                    bf16_t* d = dst + (size_t)row * ld + cc + r;
                    d[0] = f2bf(v0); d[16] = f2bf(v1); d[32] = f2bf(v2); d[48] = f2bf(v3);
                }
        } else {
            const int kv = (c0 - 2176) >> 6; bf16_t* dst = p.V1T + ((size_t)(b * HKV + kv) * 64) * TT;
#pragma unroll
            for (int m = 0; m < 4; ++m)
#pragma unroll
                for (int n = 0; n < 4; ++n) {
                    u32x2 o; o.x = pack2(acc[m][n][0], acc[m][n][1]); o.y = pack2(acc[m][n][2], acc[m][n][3]);
                    *(u32x2*)(dst + (size_t)(n * 16 + r) * TT + sb + m * 16 + quad * 4) = o;
                }
        }
    }
};

DEV void phaseA(const Params& p, int layer, unsigned char* smem) {
    const bool odd = layer & 1;
    const int ncol = odd ? ODD_IN / 256 : EVEN_INP / 256; const int nrow = NTOK / 128;
    const bf16_t* W = odd ? p.WinO + (size_t)(layer >> 1) * ODD_IN * D_MODEL : p.WinE + (size_t)(layer >> 1) * EVEN_INP * D_MODEL;
    const int bid = bid_(); const int tid = tid_(); const int trow = tid >> 2, lc8 = g2_lc(tid) * 8;
    if (odd) {
        for (int t = bid * 4 + (tid >> 6); t < NCHAIN * NCH; t += gridDim.x * 4) {
            const int chain = t / NCH, sp = t % NCH, lane = tid & 63; const int dir = chain & 1, h = (chain >> 1) & 3;
            const float lg = logsigf(p.od_decay[((layer >> 1) * 2 + dir) * HC + h]);
            const int sbase = chunk_of(dir, sp) * CH; const int i0 = 2 * lane, i1 = 2 * lane + 1;
            const int s0 = dir ? sbase + 127 - i0 : sbase + i0, s1 = dir ? sbase + 127 - i1 : sbase + i1;
            const float b0 = lg * (float)(i0 + 1), b1 = lg * (float)(i1 + 1), bend = lg * (float)CH;
            const size_t o = (size_t)chain * TT;
            p.BC[o + s0] = b0; p.BC[o + s1] = b1; p.AT[o + s0] = -b0; p.AT[o + s1] = -b1; p.MT[o + s0] = 0.f; p.MT[o + s1] = 0.f;
            if (lane == 0) { float* ms = p.MS + ((size_t)chain * NCH + sp) * 4; ms[0] = 0.f; ms[1] = 0.f; ms[2] = bend; ms[3] = __expf(bend); }
        }
    }
    const WorkRange wr = xcd_range(nrow * ncol, bid);
    for (int t = wr.lo; t < wr.hi; t += wr.step) {
        int rt, ct; dense_tile(t, nrow, ncol, rt, ct); const int row0 = rt * 128, col0 = ct * 256;
        const bf16_t* a0 = p.HIN + (size_t)(row0 + trow) * D_MODEL + lc8;
        const bf16_t* bb = W + (size_t)(col0 + trow) * D_MODEL + lc8;
        if (odd) {
            EpInOdd ep{p, layer, row0, col0};
            if (ct == 2 || ct == 3 || ct == 8) gemm_tile2<2, false>(smem, a0, a0 + (size_t)64 * D_MODEL, bb, D_MODEL, D_MODEL / 32, ep);
            else gemm_tile2<2, true>(smem, a0, a0 + (size_t)64 * D_MODEL, bb, D_MODEL, D_MODEL / 32, ep);
        } else {
            EpInEven ep{p, layer, row0, col0};
            if (ct == 4 || ct == 5 || ct == 10 || ct == 11) gemm_tile2<2, false>(smem, a0, a0 + (size_t)64 * D_MODEL, bb, D_MODEL, D_MODEL / 32, ep);
            else gemm_tile2<2, true>(smem, a0, a0 + (size_t)64 * D_MODEL, bb, D_MODEL, D_MODEL / 32, ep);
        }
    }
#ifdef PROBE_GEMM
    {
        Params q = p; bf16_t* scr = (bf16_t*)p.DC;
        q.Q1 = scr; q.K1 = scr; q.V1T = scr; q.PM = scr; q.V2T = scr; q.OG = scr; q.G = (float*)scr; q.Q2 = scr; q.K2 = scr;
        for (int t = wr.lo; t < wr.hi; t += wr.step) {
            int rt, ct; dense_tile(t, nrow, ncol, rt, ct); const int row0 = rt * 128, col0 = ct * 256;
            const bf16_t* a0 = p.HIN + (size_t)(row0 + trow) * D_MODEL + lc8;
            const bf16_t* bb = W + (size_t)(col0 + trow) * D_MODEL + lc8;
            const int erow0 = (PROBE_GEMM == 2) ? (row0 % TT >= CTX ? CTX : 0) : row0;
            if (odd) {
                EpInOdd ep{q, layer, erow0, col0};
                if (ct == 2 || ct == 3 || ct == 8) gemm_tile2<2, false>(smem, a0, a0 + (size_t)64 * D_MODEL, bb, D_MODEL, D_MODEL / 32, ep);
                else gemm_tile2<2, true>(smem, a0, a0 + (size_t)64 * D_MODEL, bb, D_MODEL, D_MODEL / 32, ep);
            } else {
                EpInEven ep{q, layer, erow0, col0};
                if (ct == 4 || ct == 5 || ct == 10 || ct == 11) gemm_tile2<2, false>(smem, a0, a0 + (size_t)64 * D_MODEL, bb, D_MODEL, D_MODEL / 32, ep);
                else gemm_tile2<2, true>(smem, a0, a0 + (size_t)64 * D_MODEL, bb, D_MODEL, D_MODEL / 32, ep);
            }
        }
    }
#endif
}
DEV void phase0b(const Params& p) {
    const int total = NTOK * (D_MODEL / 4);
    for (int idx = bid_() * 256 + tid_(); idx < total; idx += gridDim.x * 256) {
        const int row = idx / (D_MODEL / 4), k = (idx % (D_MODEL / 4)) * 4; const int b = row / TT, sq = row % TT; const int bb = sq < CTX ? BATCH : b;
        const float* mod = p.MOD + (size_t)bb * 6 * D_MODEL;
        const f32x4 x = bf4(*(const u32x2*)(p.X + (size_t)row * D_MODEL + k)), sh = *(const f32x4*)(mod + k), sc = *(const f32x4*)(mod + D_MODEL + k);
        u32x2 o; o.x = pack2(x.x * (1.f + sc.x) + sh.x, x.y * (1.f + sc.y) + sh.y); o.y = pack2(x.z * (1.f + sc.z) + sh.z, x.w * (1.f + sc.w) + sh.w);
        *(u32x2*)(p.HIN + (size_t)row * D_MODEL + k) = o;
    }
}

static_assert(NCH <= 64, "chunk summaries of a chain are scanned by one wave");
DEV void gate_chunk(const Params& p, int chain, int sp, int lane) {
    const int dir = chain & 1, h = (chain >> 1) & 3, b = chain >> 3;
    const int u = chunk_of(dir, sp); const int sbase = u * CH;
    const int i0 = 2 * lane, i1 = 2 * lane + 1;
    const int s0 = dir ? sbase + 127 - i0 : sbase + i0, s1 = dir ? sbase + 127 - i1 : sbase + i1;
    const float* g0 = p.G + ((size_t)b * TT + s0) * 16; const float* g1 = p.G + ((size_t)b * TT + s1) * 16;
    const float li0 = g0[(2 * dir) * 4 + h], li1 = g1[(2 * dir) * 4 + h];
    const float lf0 = logsigf(g0[(2 * dir + 1) * 4 + h]), lf1 = logsigf(g1[(2 * dir + 1) * 4 + h]);
    float ps = lf0 + lf1;
    for (int d = 1; d < 64; d <<= 1) { float o = lane_up(ps, d, lane); if (lane >= d) ps += o; }
    const float b1 = ps, b0 = ps - lf1;
    const float bend = lane_read(ps, 63, lane);
    const float a0 = li0 - b0, a1 = li1 - b1;
    float mx = fmaxf(a0, a1);
    for (int d = 1; d < 64; d <<= 1) { float o = lane_up(mx, d, lane); if (lane >= d) mx = fmaxf(mx, o); }
    float pmx_prev = lane_up(mx, 1, lane); if (lane == 0) pmx_prev = -3.0e38f;
    const float pm0 = fmaxf(pmx_prev, a0), pm1 = mx;
    const float amax = lane_read(mx, 63, lane);
    const size_t o = (size_t)chain * TT;
    p.BC[o + s0] = b0; p.BC[o + s1] = b1; p.AT[o + s0] = a0; p.AT[o + s1] = a1; p.MT[o + s0] = pm0; p.MT[o + s1] = pm1;
    if (lane == 0) { float* c2 = p.CH2 + ((size_t)chain * NCH + sp) * 2; c2[0] = bend; c2[1] = amax; }
}
DEV void phaseB(const Params& p, int layer) {
    const int tid = tid_();
    const int bid = bid_();
    for (int t = bid * 4 + (tid >> 6); t < NCHAIN * NCH; t += gridDim.x * 4) gate_chunk(p, t / NCH, t % NCH, tid & 63);
    const float* cw = p.ev_conv_w + (size_t)(layer >> 1) * 3 * 1024; const float* cb = p.ev_conv_b + (size_t)(layer >> 1) * 1024;
    const int total = NTOK * 128;
    for (int idx = bid * 256 + tid; idx < total; idx += gridDim.x * 256) {
        const int row = idx >> 7, cg8 = (idx & 127) * 8; const int b = row / TT, s = row % TT;
        const bool hasp = (s != 0) && (s != CTX), hasn = (s != CTX - 1) && (s != TT - 1);
        Frag xm, x0, xp; x0.q = *(const u32x4*)(p.PM + (size_t)row * 1024 + cg8);
        xm.q = u32x4{0u, 0u, 0u, 0u}; xp.q = u32x4{0u, 0u, 0u, 0u};
        if (hasp) xm.q = *(const u32x4*)(p.PM + (size_t)(row - 1) * 1024 + cg8);
        if (hasn) xp.q = *(const u32x4*)(p.PM + (size_t)(row + 1) * 1024 + cg8);
        float y[8];
#pragma unroll
        for (int i = 0; i < 8; ++i) {
            const int ch = cg8 + i;
            float v = cb[ch] + bf2f((bf16_t)xm.v[i]) * cw[ch] + bf2f((bf16_t)x0.v[i]) * cw[1024 + ch] + bf2f((bf16_t)xp.v[i]) * cw[2048 + ch];
            y[i] = siluf(v);
        }
        if (cg8 < 512) {
            u32x4 o; o.x = pack2(y[0], y[1]); o.y = pack2(y[2], y[3]); o.z = pack2(y[4], y[5]); o.w = pack2(y[6], y[7]);
            *(u32x4*)(p.Q2 + (size_t)row * 512 + cg8) = o;
        } else {
            const float sc = 0.08838834764831845f;
#pragma unroll
            for (int i = 0; i < 8; ++i) y[i] *= sc;
            u32x4 o; o.x = pack2(y[0], y[1]); o.y = pack2(y[2], y[3]); o.z = pack2(y[4], y[5]); o.w = pack2(y[6], y[7]);
            const int kc = cg8 - 512; *(u32x4*)(p.K2 + (size_t)row * 512 + kc) = o;
        }
    }
}

constexpr int KLD1 = 136, KLD0 = 72, VLD = 72;
template <int NC, int DV, int QT>
struct AttnState { f32x4 O[NC][DV / 16][QT]; f32x4 L[NC][QT]; float m[NC][QT]; };

DEV float max3f(float a, float b, float c) {
#ifdef CPU_EMU
    return fmaxf(fmaxf(a, b), c);
#else
    float d; asm("v_max3_f32 %0, %1, %2, %3" : "=v"(d) : "v"(a), "v"(b), "v"(c)); return d;
#endif
}
DEV float max2f(float a, float b) {
#ifdef CPU_EMU
    return fmaxf(a, b);
#else
    float d; asm("v_max_f32 %0, %1, %2" : "=v"(d) : "v"(a), "v"(b)); return d;
#endif
}
DEV bool wave_any(bool pr) {
#ifdef CPU_EMU
    int v = pr ? 1 : 0; for (int m = 1; m < 64; m <<= 1) v |= __shfl_xor(v, m); return v != 0;
#else
    return __builtin_amdgcn_ballot_w64(pr) != 0;
#endif
}

template <int NC, int DV, int QT, int KW>
DEV void attn_core(bf16_t* sm, const bf16_t* Kg, int ldk, const bf16_t* VTg, int nkeys, const Frag (&qf)[NC][2][QT], AttnState<NC, DV, QT>& st, float sc2, int koff) {
    constexpr int KLD = KW + 8;
    constexpr int NKR = KW / 32, NVR = DV / 32;
    constexpr int KBUF = 64 * KLD, VBUF = DV * VLD;
    constexpr float TH = 6.0f;
    const float isc2 = 1.0f / sc2;
    const int tid = tid_(), lane = tid & 63, r = lane & 15, quad = lane >> 4;
    u32x4 kreg[NKR], vreg[NVR];
    constexpr int VTPR = 8 / NVR;
    const bf16_t* kp = Kg + (size_t)(tid >> 2) * ldk + (tid & 3) * NKR * 8;
    const bf16_t* vp0 = VTg + (size_t)(tid / VTPR) * TT + (tid % VTPR) * NVR * 8;
    const int klo = (tid >> 2) * KLD + (tid & 3) * NKR * 8;
    const int nt = nkeys >> 6;
    Frag ones; ones.u[0] = ones.u[1] = ones.u[2] = ones.u[3] = 0x3F803F80u;
    auto loadK = [&]() {
#pragma unroll
        for (int i = 0; i < NKR; ++i) kreg[i] = *(const u32x4*)(kp + i * 8);
        kp += (size_t)64 * ldk; };
    auto loadV = [&]() {
#pragma unroll
        for (int i = 0; i < NVR; ++i) vreg[i] = *(const u32x4*)(vp0 + i * 8);
        vp0 += 64; };
    auto storeK = [&](int buf) {
#pragma unroll
        for (int i = 0; i < NKR; ++i) *(u32x4*)(sm + buf * KBUF + klo + i * 8) = kreg[i]; };
    auto storeV = [&](int buf) {
        bf16_t* vrow = sm + buf * VBUF + 2 * KBUF + (tid / VTPR) * VLD;
#pragma unroll
        for (int i = 0; i < NVR; ++i) {
            const int c = (tid % VTPR) * NVR + i;
#pragma unroll
            for (int hh = 0; hh < 2; ++hh) {
                const int g = 2 * c + hh; const int blk = g >> 3, g32 = g & 7; const int pos = blk * 32 + (2 * (g32 & 3) + (g32 >> 2)) * 4;
                u32x2 w; w.x = hh ? vreg[i].z : vreg[i].x; w.y = hh ? vreg[i].w : vreg[i].y;
                *(u32x2*)(vrow + pos) = w;
            }
        } };
    float al[QT], thr[QT], mxs[QT]; bool resc = false;
#pragma unroll
    for (int qt = 0; qt < QT; ++qt) { al[qt] = 1.f; thr[qt] = 0.f; mxs[qt] = 0.f; }
    auto sm_step = [&](int k, f32x4 (&sn)[4][QT], Frag (&pfn)[QT][2], const bool force) {
        if (k < QT) {
            const int qt = k;
            float mx = max3f(sn[0][qt][0], sn[0][qt][1], sn[0][qt][2]);
            mx = max3f(mx, sn[0][qt][3], sn[1][qt][0]); mx = max3f(mx, sn[1][qt][1], sn[1][qt][2]); mx = max3f(mx, sn[1][qt][3], sn[2][qt][0]);
            mx = max3f(mx, sn[2][qt][1], sn[2][qt][2]); mx = max3f(mx, sn[2][qt][3], sn[3][qt][0]); mx = max3f(mx, sn[3][qt][1], sn[3][qt][2]);
            mxs[qt] = max2f(mx, sn[3][qt][3]);
        } else if (k == QT) {
            bool need = false;
#pragma unroll
            for (int qt = 0; qt < QT; ++qt) need = need || (mxs[qt] > thr[qt]);
            if (force || wave_any(need)) {
#pragma unroll
                for (int qt = 0; qt < QT; ++qt) {
                    float mx = xmax16(mxs[qt]); mx = xmax32(mx);
                    const float mn = fmaxf(st.m[0][qt], mx * sc2);
                    al[qt] *= __builtin_amdgcn_exp2f(st.m[0][qt] - mn);
                    st.m[0][qt] = mn; thr[qt] = (mn + TH) * isc2;
                }
                resc = true;
            }
        } else if (k <= 5 * QT) {
            const int qt = (k - QT - 1) >> 2, kt = (k - QT - 1) & 3; const float mn = st.m[0][qt];
#pragma unroll
            for (int jj = 0; jj < 4; ++jj) sn[kt][qt][jj] = __builtin_amdgcn_exp2f(sn[kt][qt][jj] * sc2 - mn);
        } else if (k <= 7 * QT) {
            const int qt = (k - 5 * QT - 1) >> 1, kk = (k - 5 * QT - 1) & 1;
            pfn[qt][kk].u[0] = pack2(sn[2 * kk][qt][0], sn[2 * kk][qt][1]); pfn[qt][kk].u[1] = pack2(sn[2 * kk][qt][2], sn[2 * kk][qt][3]);
            pfn[qt][kk].u[2] = pack2(sn[2 * kk + 1][qt][0], sn[2 * kk + 1][qt][1]); pfn[qt][kk].u[3] = pack2(sn[2 * kk + 1][qt][2], sn[2 * kk + 1][qt][3]);
#ifndef CPU_EMU
            asm volatile("" : "+v"(pfn[qt][kk].u[0]), "+v"(pfn[qt][kk].u[1]), "+v"(pfn[qt][kk].u[2]), "+v"(pfn[qt][kk].u[3]));
#endif
        }
    };
    constexpr int NSM = 7 * QT + 1;
    auto rescale = [&]() {
        if (resc) {
#pragma unroll
            for (int qt = 0; qt < QT; ++qt) {
#pragma unroll
                for (int et = 0; et < DV / 16; ++et) { st.O[0][et][qt][0] *= al[qt]; st.O[0][et][qt][1] *= al[qt]; st.O[0][et][qt][2] *= al[qt]; st.O[0][et][qt][3] *= al[qt]; }
                st.L[0][qt][0] *= al[qt]; st.L[0][qt][1] *= al[qt]; st.L[0][qt][2] *= al[qt]; st.L[0][qt][3] *= al[qt];
                al[qt] = 1.f;
            }
            resc = false;
        }
    };
    auto pv = [&](int buf, const Frag (&pf)[QT][2]) {
        const bf16_t* Vs = sm + 2 * KBUF + buf * VBUF;
#pragma unroll
        for (int kk = 0; kk < 2; ++kk)
#pragma unroll
            for (int qt = 0; qt < QT; ++qt) st.L[0][qt] = mfma16(ones.v, pf[qt][kk].v, st.L[0][qt]);
#pragma unroll
        for (int et = 0; et < DV / 16; ++et) {
#pragma unroll
            for (int kk = 0; kk < 2; ++kk) {
                Frag vf; vf.q = *(const u32x4*)(Vs + (et * 16 + r) * VLD + kk * 32 + quad * 8);
#pragma unroll
                for (int qt = 0; qt < QT; ++qt) st.O[0][et][qt] = mfma16(vf.v, pf[qt][kk].v, st.O[0][et][qt]);
            }
        } };
    Frag pfa[QT][2], pfb[QT][2];
    loadK();
    __syncthreads();
    storeK(0);
    loadK();
    loadV();
    __syncthreads();
    {
        f32x4 s0[4][QT];
        const bf16_t* Ks = sm;
#pragma unroll
        for (int kt = 0; kt < 4; ++kt) {
            Frag ka0, ka1;
            ka0.q = *(const u32x4*)(Ks + (kt * 16 + r) * KLD + koff + quad * 8);
            ka1.q = *(const u32x4*)(Ks + (kt * 16 + r) * KLD + koff + 32 + quad * 8);
#pragma unroll
            for (int qt = 0; qt < QT; ++qt) {
                f32x4 z = f32x4{0.f, 0.f, 0.f, 0.f};
                z = mfma16(ka0.v, qf[0][0][qt].v, z); z = mfma16(ka1.v, qf[0][1][qt].v, z); s0[kt][qt] = z;
            }
        }
#pragma unroll
        for (int k = 0; k < NSM; ++k) sm_step(k, s0, pfa, true);
    }
    storeK(1);
    storeV(0);
    __syncthreads();
    auto body = [&](const int par, const Frag (&pin)[QT][2], Frag (&pout)[QT][2]) {
        f32x4 sn[4][QT];
        rescale();
        {
            const bf16_t* Ks = sm + ((par + 1) & 1) * KBUF + r * KLD + koff + quad * 8;
            Frag ka[2][2];
            ka[0][0].q = *(const u32x4*)(Ks); ka[0][1].q = *(const u32x4*)(Ks + 32);
#pragma unroll
            for (int kt = 0; kt < 4; ++kt) {
                if (kt < 3) { ka[(kt + 1) & 1][0].q = *(const u32x4*)(Ks + (kt + 1) * 16 * KLD); ka[(kt + 1) & 1][1].q = *(const u32x4*)(Ks + (kt + 1) * 16 * KLD + 32); }
#pragma unroll
                for (int qt = 0; qt < QT; ++qt) {
                    f32x4 z = f32x4{0.f, 0.f, 0.f, 0.f};
                    z = mfma16(ka[kt & 1][0].v, qf[0][0][qt].v, z);
                    z = mfma16(ka[kt & 1][1].v, qf[0][1][qt].v, z); sn[kt][qt] = z;
                }
                if (kt < 2) {
#pragma unroll
                    for (int qt = 0; qt < QT; ++qt) st.L[0][qt] = mfma16(ones.v, pin[qt][kt].v, st.L[0][qt]);
                }
                SCHED_BARRIER();
            }
        }
        {
            const bf16_t* Vs = sm + 2 * KBUF + (par & 1) * VBUF + r * VLD + quad * 8;
            constexpr int NPV = (DV / 16) * 2; constexpr int SPP = (NSM + NPV - 1) / NPV;
            Frag vf[2];
            vf[0].q = *(const u32x4*)Vs;
#pragma unroll
            for (int i = 0; i < NPV; ++i) {
                const int et = i >> 1, kk = i & 1;
                if (i + 1 < NPV) vf[(i + 1) & 1].q = *(const u32x4*)(Vs + ((i + 1) >> 1) * 16 * VLD + ((i + 1) & 1) * 32);
#pragma unroll
                for (int qt = 0; qt < QT; ++qt) st.O[0][et][qt] = mfma16(vf[i & 1].v, pin[qt][kk].v, st.O[0][et][qt]);
#pragma unroll
                for (int q = 0; q < SPP; ++q) sm_step(i * SPP + q, sn, pout, false);
                SCHED_BARRIER();
            }
        }
    };
    int j = 0;
    for (; j + 2 < nt; j += 2) {
        loadK(); loadV();
        body(0, pfa, pfb);
        storeK(0); storeV(1);
        __syncthreads();
        loadK(); loadV();
        body(1, pfb, pfa);
        storeK(1); storeV(0);
        __syncthreads();
    }
    loadV(); body(0, pfa, pfb); storeV(1); __syncthreads();
    rescale();
    pv(1, pfb);
    __syncthreads();
}

DEV void attn_diff_item(const Params& p, int layer, int item, bf16_t* sm) {
    const int nqb = TT / 64; const int qb = item % nqb, h = (item / nqb) % HA, b = item / (nqb * HA);
    const int tid = tid_(), wid = tid >> 6, lane = tid & 63, r = lane & 15, quad = lane >> 4;
    const int comp = wid & 1, rg = wid >> 1;
    const int s0 = qb * 64; const bool ctxq = s0 < CTX; const int nkeys = ctxq ? CTX : TT;
    Frag qf[1][2][2];
#pragma unroll
    for (int ks = 0; ks < 2; ++ks)
#pragma unroll
        for (int qt = 0; qt < 2; ++qt) qf[0][ks][qt].q = *(const u32x4*)(p.Q1 + ((size_t)b * TT + s0 + rg * 32 + qt * 16 + r) * 512 + h * 128 + comp * 64 + ks * 32 + quad * 8);
    AttnState<1, 128, 2> st;
#pragma unroll
    for (int qt = 0; qt < 2; ++qt) {
        st.m[0][qt] = -1.0e30f; st.L[0][qt] = f32x4{0.f, 0.f, 0.f, 0.f};
#pragma unroll
        for (int et = 0; et < 8; ++et) st.O[0][et][qt] = f32x4{0.f, 0.f, 0.f, 0.f};
    }
    attn_core<1, 128, 2, 128>(sm, p.K1 + (size_t)b * TT * 512 + h * 128, 512, p.V1T + ((size_t)(b * HA + h) * 128) * TT, nkeys, qf, st, 0.125f * 1.4426950408889634f, comp * 64);
    const float lam = p.LAM[layer >> 1]; const float lam_init = 0.8f - 0.6f * expf(-0.3f * (float)layer);
    const float* sg = p.ev_subln_g + (layer >> 1) * 128;
    f32x4* xo = (f32x4*)sm;
    __syncthreads();
    if (comp == 1) {
#pragma unroll
        for (int qt = 0; qt < 2; ++qt) {
            const float i2 = lam / st.L[0][qt][0];
#pragma unroll
            for (int et = 0; et < 8; ++et) xo[((rg * 2 + qt) * 8 + et) * 64 + lane] = f32x4{st.O[0][et][qt][0] * i2, st.O[0][et][qt][1] * i2, st.O[0][et][qt][2] * i2, st.O[0][et][qt][3] * i2};
        }
    }
    __syncthreads();
    if (comp == 0) {
#pragma unroll
        for (int qt = 0; qt < 2; ++qt) {
            const float i1 = 1.f / st.L[0][qt][0];
            float ss = 0.f; f32x4 o[8];
#pragma unroll
            for (int et = 0; et < 8; ++et) {
                const f32x4 x2 = xo[((rg * 2 + qt) * 8 + et) * 64 + lane];
#pragma unroll
                for (int j = 0; j < 4; ++j) { float v = st.O[0][et][qt][j] * i1 - x2[j]; o[et][j] = v; ss += v * v; }
            }
            ss = xadd16(ss); ss = xadd32(ss);
            const float rs = (1.f - lam_init) / sqrtf(ss * (1.f / 128.f) + EPS);
            bf16_t* dst = p.CAT + ((size_t)b * TT + s0 + rg * 32 + qt * 16 + r) * 1024 + h * 128;
#pragma unroll
            for (int et = 0; et < 8; ++et) {
                const int e = et * 16 + quad * 4;
                u32x2 w; w.x = pack2(o[et][0] * rs * sg[e], o[et][1] * rs * sg[e + 1]); w.y = pack2(o[et][2] * rs * sg[e + 2], o[et][3] * rs * sg[e + 3]);
                *(u32x2*)(dst + e) = w;
            }
        }
    }
}

DEV void attn_gqa_item(const Params& p, int item, bf16_t* sm) {
    const int nqb = TT / 32; const int qb = item % nqb, kv = (item / nqb) % HKV, b = item / (nqb * HKV);
    const int tid = tid_(), wid = tid >> 6, lane = tid & 63, r = lane & 15, quad = lane >> 4;
    const int s0 = qb * 32; const bool ctxq = s0 < CTX; const int nkeys = ctxq ? CTX : TT; const int hq = kv * 4 + wid;
    Frag qf[1][2][2];
#pragma unroll
    for (int ks = 0; ks < 2; ++ks)
#pragma unroll
        for (int qt = 0; qt < 2; ++qt) qf[0][ks][qt].q = *(const u32x4*)(p.Q1 + ((size_t)b * TT + s0 + qt * 16 + r) * 512 + hq * 64 + ks * 32 + quad * 8);
    AttnState<1, 64, 2> st;
#pragma unroll
    for (int qt = 0; qt < 2; ++qt) {
        st.m[0][qt] = -1.0e30f; st.L[0][qt] = f32x4{0.f, 0.f, 0.f, 0.f};
#pragma unroll
        for (int et = 0; et < 4; ++et) st.O[0][et][qt] = f32x4{0.f, 0.f, 0.f, 0.f};
    }
    attn_core<1, 64, 2, 64>(sm, p.K1 + (size_t)b * TT * 128 + kv * 64, 128, p.V1T + ((size_t)(b * HKV + kv) * 64) * TT, nkeys, qf, st, 0.125f * 1.4426950408889634f, 0);
#pragma unroll
    for (int qt = 0; qt < 2; ++qt) {
        const float il = 1.f / st.L[0][qt][0];
        bf16_t* dst = p.CAT + ((size_t)b * TT + s0 + qt * 16 + r) * 1024 + 512 + hq * 64;
#pragma unroll
        for (int et = 0; et < 4; ++et) {
            const int e = et * 16 + quad * 4;
            u32x2 w; w.x = pack2(st.O[0][et][qt][0] * il, st.O[0][et][qt][1] * il); w.y = pack2(st.O[0][et][qt][2] * il, st.O[0][et][qt][3] * il);
            *(u32x2*)(dst + e) = w;
        }
    }
}

template <int DK, bool NRM>
DEV void rec_dc_item(const Params& p, int item, bf16_t* sm) {
    constexpr int ET = NRM ? 9 : 8; constexpr int ER = NRM ? EVR : 128; constexpr int SLD = 136;
    const int chain = item / NCH, sp = item % NCH; const int dir = chain & 1, h = (chain >> 1) & 3, b = chain >> 3;
    const int u = chunk_of(dir, sp), sbase = u * CH;
    const int tid = tid_(), wid = tid >> 6, lane = tid & 63, r = lane & 15, quad = lane >> 4;
    bf16_t* Vs = sm; bf16_t* Ks = sm + 128 * SLD; float* wk = (float*)(sm + 128 * SLD + DK * SLD);
    __syncthreads();
    float ms1, ms2;
    if (NRM) {
        const float* c2 = p.CH2 + (size_t)chain * NCH * 2;
        const float be = lane < NCH ? c2[lane * 2] : 0.f, am = lane < NCH ? c2[lane * 2 + 1] : 0.f;
        float m = 0.f, mp = 0.f, bq = 0.f;
        for (int q = 0; q <= sp; ++q) { bq = lane_read(be, q, lane); const float aq = lane_read(am, q, lane); mp = m; m = fmaxf(bq + m, bq + aq); }
        ms1 = m; ms2 = bq;
        if (tid == 0) { float* mo = p.MS + ((size_t)chain * NCH + sp) * 4; mo[0] = mp; mo[1] = m; mo[2] = bq; mo[3] = __expf(bq + mp - m); }
    } else { const float* ms = p.MS + ((size_t)chain * NCH + sp) * 4; ms1 = ms[1]; ms2 = ms[2]; }
    if (tid < 128) wk[tid] = __expf(ms2 + p.AT[(size_t)chain * TT + sbase + tid] - ms1);
    const bf16_t* kg = p.K2 + ((size_t)b * TT + sbase) * (4 * DK) + h * DK;
    constexpr int NKC = 128 * (DK / 8) / 256;
    Frag kpre[NKC];
#pragma unroll
    for (int i = 0; i < NKC; ++i) { const int c = tid + 256 * i; const int sl = c & 127, dc8 = (c >> 7) * 8; kpre[i].q = *(const u32x4*)(kg + (size_t)sl * (4 * DK) + dc8); }
    const bf16_t* vt = p.V2T + ((size_t)(b * 4 + h) * 128) * TT + sbase;
    for (int c = tid; c < 128 * 16; c += 256) { int row = c >> 4, kc = c & 15; *(u32x4*)(Vs + row * SLD + kc * 8) = *(const u32x4*)(vt + (size_t)row * TT + kc * 8); }
    __syncthreads();
#pragma unroll
    for (int ii = 0; ii < NKC; ++ii) {
        const int c = tid + 256 * ii; const int sl = c & 127, dc8 = (c >> 7) * 8; const Frag f = kpre[ii];
        const float w = wk[sl];
#pragma unroll
        for (int i = 0; i < 8; ++i) Ks[(dc8 + i) * SLD + sl] = f2bf(bf2f((bf16_t)f.v[i]) * w);
    }
    __syncthreads();
    constexpr int NTW = DK / 64;
    f32x4 acc[ET][NTW];
#pragma unroll
    for (int et = 0; et < ET; ++et)
#pragma unroll
        for (int n = 0; n < NTW; ++n) acc[et][n] = f32x4{0.f, 0.f, 0.f, 0.f};
#pragma unroll
    for (int ks = 0; ks < 4; ++ks) {
        Frag bf[NTW];
#pragma unroll
        for (int n = 0; n < NTW; ++n) bf[n].q = *(const u32x4*)(Ks + ((wid + 4 * n) * 16 + r) * SLD + ks * 32 + quad * 8);
#pragma unroll
        for (int et = 0; et < ET; ++et) {
            Frag af;
            if (et < 8) af.q = *(const u32x4*)(Vs + (et * 16 + r) * SLD + ks * 32 + quad * 8);
            else { const unsigned one = (r == 0) ? 0x3F803F80u : 0u; af.q = u32x4{one, one, one, one}; }
#pragma unroll
            for (int n = 0; n < NTW; ++n) acc[et][n] = mfma16(bf[n].v, af.v, acc[et][n]);
        }
    }
    bf16_t* dc = p.DC + ((size_t)chain * NCH + sp) * ER * DK;
#pragma unroll
    for (int et = 0; et < ET; ++et)
#pragma unroll
        for (int n = 0; n < NTW; ++n) {
            u32x2 w; w.x = pack2(acc[et][n][0], acc[et][n][1]); w.y = pack2(acc[et][n][2], acc[et][n][3]);
            *(u32x2*)(dc + (size_t)(et * 16 + r) * DK + (wid + 4 * n) * 16 + quad * 4) = w;
        }
}

template <int DK, bool NRM>
DEV void rec_scan(const Params& p) {
    constexpr int ER = NRM ? EVR : 128; constexpr int EPC = ER * DK; constexpr int PD = 4;
    const int total = NCHAIN * (EPC / 8);
    for (int idx = bid_() * 256 + tid_(); idx < total; idx += gridDim.x * 256) {
        const int chain = idx / (EPC / 8), el = (idx % (EPC / 8)) * 8;
        const bf16_t* dc = p.DC + (size_t)chain * NCH * EPC + el; bf16_t* cp = p.CP + (size_t)chain * NCH * EPC + el;
        const float* ms = p.MS + (size_t)chain * NCH * 4 + 3;
        float c[8];
#pragma unroll
        for (int i = 0; i < 8; ++i) c[i] = 0.f;
        u32x4 q[PD]; float cr[PD];
#pragma unroll
        for (int i = 0; i < PD; ++i) if (i < NCH) { q[i] = *(const u32x4*)(dc + (size_t)i * EPC); cr[i] = ms[i * 4]; }
#pragma unroll 1
        for (int g = 0; g < NCH; g += PD)
#pragma unroll
        for (int i = 0; i < PD; ++i) {
            const int sp = g + i; if (sp >= NCH) break;
            const u32x4 d = q[i]; const float car = cr[i];
            if (sp + PD < NCH) { q[i] = *(const u32x4*)(dc + (size_t)(sp + PD) * EPC); cr[i] = ms[(sp + PD) * 4]; }
            u32x4 o; o.x = pack2(c[0], c[1]); o.y = pack2(c[2], c[3]); o.z = pack2(c[4], c[5]); o.w = pack2(c[6], c[7]);
            *(u32x4*)(cp + (size_t)sp * EPC) = o;
            c[0] = car * c[0] + __uint_as_float(d.x << 16); c[1] = car * c[1] + __uint_as_float(d.x & 0xFFFF0000u);
            c[2] = car * c[2] + __uint_as_float(d.y << 16); c[3] = car * c[3] + __uint_as_float(d.y & 0xFFFF0000u);
            c[4] = car * c[4] + __uint_as_float(d.z << 16); c[5] = car * c[5] + __uint_as_float(d.z & 0xFFFF0000u);
            c[6] = car * c[6] + __uint_as_float(d.w << 16); c[7] = car * c[7] + __uint_as_float(d.w & 0xFFFF0000u);
        }
    }
}

template <int DK, bool NRM>
DEV void rec_out_item(const Params& p, int layer, int item, bf16_t* sm) {
    constexpr int ET = NRM ? 9 : 8; constexpr int ER = NRM ? EVR : 128; constexpr int KLD = DK + 8; constexpr int SLD = 136; constexpr int NKS = DK / 32;
    const int half = item & 1, u = (item >> 1) % NCH, h = ((item >> 1) / NCH) & 3, b = (item >> 1) / (NCH * 4);
    const int tid = tid_(), wid = tid >> 6, lane = tid & 63, r = lane & 15, quad = lane >> 4;
    const int sbase = u * CH; const int tl = half * 64 + wid * 16 + r;
    const size_t rowt = (size_t)b * TT + sbase + tl; const int tq = tl - quad * 4;
    bf16_t* RA = sm; bf16_t* Vs = sm + ER * KLD; float* as_ = (float*)(Vs + 128 * SLD);
    __syncthreads();
    const bf16_t* kg = p.K2 + ((size_t)b * TT + sbase) * (4 * DK) + h * DK;
    for (int c = tid; c < 128 * (DK / 8); c += 256) { int row = c / (DK / 8), kc = c % (DK / 8); *(u32x4*)(RA + row * KLD + kc * 8) = *(const u32x4*)(kg + (size_t)row * (4 * DK) + kc * 8); }
    const int chain0 = (b * 4 + h) * 2;
    as_[tid] = p.AT[(size_t)(chain0 + (tid >> 7)) * TT + sbase + (tid & 127)];
    Frag qf[NKS];
#pragma unroll
    for (int ks = 0; ks < NKS; ++ks) qf[ks].q = *(const u32x4*)(p.Q2 + rowt * (4 * DK) + h * DK + ks * 32 + quad * 8);
    const bf16_t* vt = p.V2T + ((size_t)(b * 4 + h) * 128) * TT + sbase;
    u32x4 vpre[8];
#pragma unroll
    for (int i = 0; i < 8; ++i) { const int c = tid + 256 * i; const int row = c >> 4, kc = c & 15; vpre[i] = *(const u32x4*)(vt + (size_t)row * TT + kc * 8); }
    constexpr int NCPC = ER * (DK / 8), NCPI = (NCPC + 255) / 256;
    u32x4 cpre[NCPI];
    {
        const bf16_t* cp0 = p.CP + ((size_t)chain0 * NCH + sp_of(0, u)) * ER * DK;
#pragma unroll
        for (int i = 0; i < NCPI; ++i) { const int c = tid + 256 * i; if (c < NCPC) { const int row = c / (DK / 8), kc = c % (DK / 8); cpre[i] = *(const u32x4*)(cp0 + (size_t)row * DK + kc * 8); } }
    }
    __syncthreads();
    f32x4 sT[8];
#pragma unroll
    for (int st = 0; st < 8; ++st) {
        if ((st & 1) == 0) SCHED_BARRIER();
        f32x4 z = f32x4{0.f, 0.f, 0.f, 0.f};
#pragma unroll
        for (int ks = 0; ks < NKS; ++ks) { Frag ka; ka.q = *(const u32x4*)(RA + (st * 16 + r) * KLD + ks * 32 + quad * 8); z = mfma16(ka.v, qf[ks].v, z); }
        sT[st] = z;
    }
    __syncthreads();
#pragma unroll
    for (int i = 0; i < 8; ++i) { const int c = tid + 256 * i; const int row = c >> 4, kc = c & 15; *(u32x4*)(Vs + row * SLD + kc * 8) = vpre[i]; }
    f32x4 hs[8];
#pragma unroll
    for (int et = 0; et < 8; ++et) hs[et] = f32x4{0.f, 0.f, 0.f, 0.f};
#pragma unroll 1
    for (int dir = 0; dir < 2; ++dir) {
        const int chain = chain0 + dir; const int sp = sp_of(dir, u);
        if (dir) __syncthreads();
#pragma unroll
        for (int i = 0; i < NCPI; ++i) { const int c = tid + 256 * i; if (c < NCPC) { const int row = c / (DK / 8), kc = c % (DK / 8); *(u32x4*)(RA + row * KLD + kc * 8) = cpre[i]; } }
        __syncthreads();
        if (dir == 0) {
            const bf16_t* cp1 = p.CP + ((size_t)(chain0 + 1) * NCH + sp_of(1, u)) * ER * DK;
#pragma unroll
            for (int i = 0; i < NCPI; ++i) { const int c = tid + 256 * i; if (c < NCPC) { const int row = c / (DK / 8), kc = c % (DK / 8); cpre[i] = *(const u32x4*)(cp1 + (size_t)row * DK + kc * 8); } }
        }
        const float mprev = p.MS[((size_t)chain * NCH + sp) * 4];
        const float bt = p.BC[(size_t)chain * TT + sbase + tl], mtr = p.MT[(size_t)chain * TT + sbase + tl];
        const float mt = NRM ? bt + fmaxf(mprev, mtr) : mtr;
        const float winter = __expf(bt + mprev - mt); const float ct = bt - mt;
        f32x4 acc[ET];
#pragma unroll
        for (int et = 0; et < ET; ++et) {
            if ((et & 1) == 0) SCHED_BARRIER();
            f32x4 z = f32x4{0.f, 0.f, 0.f, 0.f};
#pragma unroll
            for (int ks = 0; ks < NKS; ++ks) { Frag ca; ca.q = *(const u32x4*)(RA + (et * 16 + r) * KLD + ks * 32 + quad * 8); z = mfma16(ca.v, qf[ks].v, z); }
            acc[et] = f32x4{z[0] * winter, z[1] * winter, z[2] * winter, z[3] * winter};
        }
#pragma unroll
        for (int kk = 0; kk < 4; ++kk) {
            SCHED_BARRIER();
            Frag pf;
#pragma unroll
            for (int hf = 0; hf < 2; ++hf) {
                const int st = 2 * kk + hf; float w[4];
#pragma unroll
                for (int j = 0; j < 4; ++j) {
                    const int s = st * 16 + quad * 4 + j; const bool ok = dir ? ((st * 16 + j) >= tq) : ((st * 16 + j) <= tq);
                    w[j] = ok ? sT[st][j] * __expf(ct + as_[dir * 128 + s]) : 0.f;
                }
                pf.u[2 * hf] = pack2(w[0], w[1]); pf.u[2 * hf + 1] = pack2(w[2], w[3]);
            }
#pragma unroll
            for (int et = 0; et < ET; ++et) {
                Frag vf;
                if (et < 8) { const bf16_t* vp = Vs + (et * 16 + r) * SLD + kk * 32 + quad * 4; vf.d[0] = *(const u32x2*)vp; vf.d[1] = *(const u32x2*)(vp + 16); }
                else { const unsigned one = (r == 0) ? 0x3F803F80u : 0u; vf.q = u32x4{one, one, one, one}; }
                acc[et] = mfma16(vf.v, pf.v, acc[et]);
            }
        }
        if (NRM) {
            float den = lane_read(acc[ET - 1][0], r, lane);
            const float dn = 1.f / fmaxf(fabsf(den), __expf(-mt));
#pragma unroll
            for (int et = 0; et < 8; ++et) { hs[et][0] += acc[et][0] * dn; hs[et][1] += acc[et][1] * dn; hs[et][2] += acc[et][2] * dn; hs[et][3] += acc[et][3] * dn; }
        } else {
#pragma unroll
            for (int et = 0; et < 8; ++et) { hs[et][0] += acc[et][0]; hs[et][1] += acc[et][1]; hs[et][2] += acc[et][2]; hs[et][3] += acc[et][3]; }
        }
    }
    if (NRM) {
        const bf16_t* og = p.OG + rowt * 512 + h * 128; const float* g = p.ev_mnorm_g + (layer >> 1) * 512 + h * 128;
        float sum = 0.f;
#pragma unroll
        for (int et = 0; et < 8; ++et) {
            const u32x2 gq = *(const u32x2*)(og + et * 16 + quad * 4);
            hs[et][0] *= sigmf(bf2f((bf16_t)(gq.x & 0xFFFF))); hs[et][1] *= sigmf(bf2f((bf16_t)(gq.x >> 16)));
            hs[et][2] *= sigmf(bf2f((bf16_t)(gq.y & 0xFFFF))); hs[et][3] *= sigmf(bf2f((bf16_t)(gq.y >> 16)));
            sum += hs[et][0] + hs[et][1] + hs[et][2] + hs[et][3];
        }
        sum = xadd16(sum); sum = xadd32(sum);
        const float mu = sum * (1.f / 128.f); float var = 0.f;
#pragma unroll
        for (int et = 0; et < 8; ++et)
#pragma unroll
            for (int j = 0; j < 4; ++j) { float d = hs[et][j] - mu; var += d * d; }
        var = xadd16(var); var = xadd32(var);
        const float rs = 1.f / sqrtf(var * (1.f / 128.f) + EPS);
        bf16_t* dst = p.CAT + rowt * 1024 + 512 + h * 128;
#pragma unroll
        for (int et = 0; et < 8; ++et) {
            const int e = et * 16 + quad * 4;
            u32x2 w; w.x = pack2((hs[et][0] - mu) * rs * g[e], (hs[et][1] - mu) * rs * g[e + 1]); w.y = pack2((hs[et][2] - mu) * rs * g[e + 2], (hs[et][3] - mu) * rs * g[e + 3]);
            *(u32x2*)(dst + e) = w;
        }
    } else {
        const bf16_t* og = p.OG + rowt * 512 + h * 128;
        float ss = 0.f;
#pragma unroll
        for (int et = 0; et < 8; ++et)
#pragma unroll
            for (int j = 0; j < 4; ++j) ss += hs[et][j] * hs[et][j];
        ss = xadd16(ss); ss = xadd32(ss);
        const float rs = 1.f / sqrtf(ss * (1.f / 128.f) + EPS);
        bf16_t* dst = p.CAT + rowt * 1024 + h * 128;
#pragma unroll
        for (int et = 0; et < 8; ++et) {
            const int e = et * 16 + quad * 4; const u32x2 gq = *(const u32x2*)(og + e);
            u32x2 w; w.x = pack2(hs[et][0] * rs * siluf(bf2f((bf16_t)(gq.x & 0xFFFF))), hs[et][1] * rs * siluf(bf2f((bf16_t)(gq.x >> 16))));
            w.y = pack2(hs[et][2] * rs * siluf(bf2f((bf16_t)(gq.y & 0xFFFF))), hs[et][3] * rs * siluf(bf2f((bf16_t)(gq.y >> 16))));
            *(u32x2*)(dst + e) = w;
        }
    }
}

DEV void phaseC(const Params& p, int layer, unsigned char* smem) {
    const bool odd = layer & 1; const bool with_ctx = layer < DEPTH - 1;
    bf16_t* sm = (bf16_t*)smem;
    const int nqb_l = odd ? SEQ / 32 : SEQ / 64, nqb_c = odd ? CTX / 32 : CTX / 64; const int nh = odd ? HKV : HA;
    const int n_lat = BATCH * nh * nqb_l, n_ctx = with_ctx ? BATCH * nh * nqb_c : 0; const int n_dc = NCHAIN * NCH;
    for (int it = bid_(); it < n_lat + n_ctx + n_dc; it += gridDim.x) {
        if (it < n_lat + n_ctx) {
            int qb, bh;
            if (it < n_lat) {
                const int nbh = BATCH * nh;
                if ((nbh & 7) == 0 && (gridDim.x & 7) == 0) { const int x = it & 7, j = it >> 3; bh = (j / nqb_l) * 8 + x; qb = nqb_c + j % nqb_l; }
                else { qb = nqb_c + it % nqb_l; bh = it / nqb_l; }
            } else { int i2 = it - n_lat; qb = i2 % nqb_c; bh = i2 / nqb_c; }
            const int item = bh * (nqb_l + nqb_c) + qb;
            if (odd) attn_gqa_item(p, item, sm); else attn_diff_item(p, layer, item, sm);
        } else {
            const int item = it - n_lat - n_ctx;
            if (odd) rec_dc_item<64, false>(p, item, sm); else rec_dc_item<128, true>(p, item, sm);
        }
    }
}
DEV void phaseD(const Params& p, int layer) { if (layer & 1) rec_scan<64, false>(p); else rec_scan<128, true>(p); }
DEV void phaseE(const Params& p, int layer, unsigned char* smem) {
    const bool odd = layer & 1; const bool with_ctx = layer < DEPTH - 1;
    const int n = BATCH * 4 * NCH * 2;
    for (int it = bid_(); it < n; it += gridDim.x) {
        const int u = (it >> 1) % NCH; if (!with_ctx && u < NCC) continue;
        if (odd) rec_out_item<64, false>(p, layer, it, (bf16_t*)smem); else rec_out_item<128, true>(p, layer, it, (bf16_t*)smem);
    }
}

#ifdef CPU_EMU_SMALL
constexpr int FM_T = 16;
#else
constexpr int FM_T = 17;
#endif
constexpr int F_ROWS = 16 * FM_T, F_NA = 4 * F_ROWS, F_NCH = F_NA + 512, F_STAGE = F_NCH * 16, F_NJ = (F_NCH + 255) / 256;
static_assert(NTOK % F_ROWS == 0 && TT % F_ROWS == 0, "tall output-projection tiles must not straddle sequences");
static_assert(3 * F_STAGE <= LDS_BYTES - 16, "LDS ring of the tall tile");
DEV void phaseF(const Params& p, int layer, unsigned char* smem) {
    const bool with_ctx = layer < DEPTH - 1; const int ncol = D_MODEL / 128, nrow = NTOK / F_ROWS;
    const WorkRange wr = xcd_range(nrow * ncol, bid_());
    for (int t = wr.lo; t < wr.hi; t += wr.step) {
        const int tid = tid_(), wid = tid >> 6, lane = tid & 63, r = lane & 15, quad = lane >> 4;
        const int lc8 = g2_lc(tid) * 8;
        int rt, ct;
        if ((nrow & 7) == 0) { const int rpg = nrow >> 3; const int rg = t / (ncol * rpg), q = t % (ncol * rpg); ct = q / rpg; rt = rg * rpg + q % rpg; } else { rt = t / ncol; ct = t % ncol; }
        const int row0 = rt * F_ROWS, col0 = ct * 128; const int b = row0 / TT, s0 = row0 % TT;
        if (!with_ctx && s0 + F_ROWS <= CTX) continue;
        const bf16_t* abase = p.CAT + (size_t)(row0 + (tid >> 2)) * MIX_OUT + lc8;
        const bf16_t* bbase = p.WoutT + ((size_t)layer * D_MODEL + col0 + (tid >> 2)) * MIX_OUT + lc8;
        constexpr int JMIX = F_NA / 256;
        const bf16_t* mbase = (F_NA % 256 != 0 && tid < F_NA - 256 * JMIX) ? abase + (size_t)JMIX * 64 * MIX_OUT : bbase + (256 * JMIX - F_NA) / 4 * MIX_OUT;
        f32x4 acc[FM_T][2];
#pragma unroll
        for (int m = 0; m < FM_T; ++m) { acc[m][0] = f32x4{0.f, 0.f, 0.f, 0.f}; acc[m][1] = f32x4{0.f, 0.f, 0.f, 0.f}; }
        unsigned char* dst0 = smem + tid * 16;
        auto issue = [&](int kt, int slot) {
            unsigned char* d = dst0 + slot * F_STAGE;
#pragma unroll
            for (int j = 0; j < F_NJ; ++j) {
                if (256 * j + 255 < F_NA) glds16(abase + (size_t)j * 64 * MIX_OUT + kt * 32, d + j * 4096);
                else if (j == JMIX && F_NA % 256 != 0) glds16(mbase + kt * 32, d + j * 4096);
                else if (256 * j + 255 < F_NCH) glds16(bbase + (256 * j - F_NA) / 4 * MIX_OUT + kt * 32, d + j * 4096);
                else if (tid + 256 * j < F_NCH) glds16(bbase + (256 * j - F_NA) / 4 * MIX_OUT + kt * 32, d + j * 4096);
            }
        };
        constexpr int nkt = MIX_OUT / 32;
        RAW_BARRIER();
        issue(0, 0); issue(1, 1);
        const int pco = (quad ^ g2_h((r >> 2) & 3)) * 16;
        const unsigned char* afr = smem + r * 64 + pco;
        const unsigned char* bfr = smem + F_NA * 16 + (wid * 32 + r) * 64 + pco;
        int slot = 0;
        for (int kt = 0; kt < nkt; ++kt) {
            if (kt + 1 < nkt) wait_vm<6>(); else wait_vm<0>();
            RAW_BARRIER();
            if (kt + 2 < nkt) { int ns = slot + 2; if (ns >= 3) ns -= 3; issue(kt + 2, ns); }
            const unsigned char* as = afr + slot * F_STAGE; const unsigned char* bs = bfr + slot * F_STAGE;
            Frag b0, b1; b0.q = *(const u32x4*)bs; b1.q = *(const u32x4*)(bs + 16 * 64);
#ifndef CPU_EMU
            __builtin_amdgcn_s_setprio(1);
#endif
#pragma unroll
            for (int m = 0; m < FM_T; ++m) {
                Frag af; af.q = *(const u32x4*)(as + m * 16 * 64);
                acc[m][0] = mfma16(b0.v, af.v, acc[m][0]); acc[m][1] = mfma16(b1.v, af.v, acc[m][1]);
            }
#ifndef CPU_EMU
            __builtin_amdgcn_s_setprio(0);
#endif
            if (++slot == 3) slot = 0;
        }
        const float* gl = p.MOD + ((size_t)layer * (BATCH + 1) + b) * 6 * D_MODEL + 2 * D_MODEL; const float* gc = p.MOD + ((size_t)layer * (BATCH + 1) + BATCH) * 6 * D_MODEL + 2 * D_MODEL;
#pragma unroll
        for (int n = 0; n < 2; ++n) {
            const int col = col0 + wid * 32 + n * 16 + quad * 4; const f32x4 g_l = *(const f32x4*)(gl + col), g_c = *(const f32x4*)(gc + col);
#pragma unroll
            for (int m = 0; m < FM_T; ++m) {
                const int s = s0 + m * 16 + r; const bool isc = s < CTX;
                if (with_ctx || !isc) { u32x2* x = (u32x2*)(p.X + (size_t)(row0 + m * 16 + r) * D_MODEL + col); *x = pk4(ALPHA * bf4(*x) + (isc ? g_c : g_l) * acc[m][n]); }
                if ((m & 7) == 7) SCHED_BARRIER();
            }
        }
    }
}

constexpr int NV4 = D_MODEL / 256;
DEV void phaseG(const Params& p, int layer, unsigned char* smem) {
    const bool with_ctx = layer < DEPTH - 1;
    const int tid = tid_(); const int wid = tid >> 6, lane = tid & 63; const int bid = bid_();
    const float* lg = p.ln_g + (size_t)(layer * 2) * D_MODEL; const float* lb = p.ln_b + (size_t)(layer * 2) * D_MODEL;
    const float* wr = p.WrT + (size_t)layer * NR * D_MODEL;
    constexpr int MAXTB = 48;
    const int NTB = imin((NTOK + (int)gridDim.x - 1) / (int)gridDim.x, MAXTB);
    const int nruns = (NTOK + NTB - 1) / NTB;
    int* lcnt = (int*)smem; int* lbase = lcnt + 32; int* rec = lbase + 32;
    float* t_mu = (float*)(rec + MAXTB * 8); float* t_rs = t_mu + MAXTB; float* t_gw = t_rs + MAXTB; int* t_g = (int*)(t_gw + MAXTB);
    int* gcount = t_g + MAXTB; int* glist = gcount + 4;
    static_assert((64 + MAXTB * 8 + MAXTB * 4 + 4 + 4 * MAXTB) * 4 <= 3584, "phase G tables");
    float* L_wg = (float*)(smem + 3584); float* L_we = L_wg + NG * D_MODEL; float* L_ab = L_we + EPG * D_MODEL;
    static_assert(3584 + (NG + EPG + 6) * D_MODEL * 4 <= LDS_BYTES - 16, "phase G LDS image");
    __syncthreads();
    for (int i = tid; i < NG * D_MODEL / 4; i += 256) ((f32x4*)L_wg)[i] = ((const f32x4*)wr)[i];
    for (int run = bid; run < nruns; run += gridDim.x) {
    const int base = run * NTB; const int ntb = imin(NTB, NTOK - base);
    const int b_first = base / TT;
    __syncthreads();
    if (tid < 32) lcnt[tid] = 0;
    if (tid < 4) gcount[tid] = 0;
    for (int i = tid; i < MAXTB; i += 256) { rec[i * 8] = -1; t_g[i] = -1; }
    for (int i = tid; i < 3 * D_MODEL / 4; i += 256) {
        const int set = i / (D_MODEL / 4), q = i % (D_MODEL / 4); const int bb = set == 0 ? BATCH : imin(b_first + set - 1, BATCH - 1);
        const float* mod = p.MOD + ((size_t)layer * (BATCH + 1) + bb) * 6 * D_MODEL;
        const f32x4 g4 = ((const f32x4*)lg)[q], b4 = ((const f32x4*)lb)[q], sh = ((const f32x4*)(mod + 3 * D_MODEL))[q], sc = ((const f32x4*)(mod + 4 * D_MODEL))[q];
        ((f32x4*)(L_ab + (size_t)set * 2 * D_MODEL))[q] = g4 * (1.f + sc);
        ((f32x4*)(L_ab + (size_t)set * 2 * D_MODEL + D_MODEL))[q] = b4 * (1.f + sc) + sh;
    }
    __syncthreads();
    auto set_of = [&](int tok) { const int b = tok / TT, sq = tok % TT; return sq < CTX ? 0 : 1 + (b - b_first); };
    auto live = [&](int ti) { if (ti >= ntb) return false; const int sq = (base + ti) % TT; return with_ctx || sq >= CTX; };
    u32x2 xq[2][NV4];
    auto ldx = [&](int t0) {
#pragma unroll
        for (int u = 0; u < 2; ++u) {
            const int tl = imin(base + t0 + 4 * u, NTOK - 1);
#pragma unroll
            for (int i = 0; i < NV4; ++i) xq[u][i] = *(const u32x2*)(p.X + (size_t)tl * D_MODEL + (i * 64 + lane) * 4);
        } };
    if (wid < ntb) ldx(wid);
    for (int t0 = wid; t0 < ntb; t0 += 8) {
        f32x4 v[2][NV4]; int ti[2]; bool ok[2]; const float* ab[2];
#pragma unroll
        for (int u = 0; u < 2; ++u) {
            ti[u] = t0 + 4 * u; ok[u] = live(ti[u]); const int tl = imin(base + ti[u], NTOK - 1);
            ab[u] = L_ab + (size_t)set_of(tl) * 2 * D_MODEL;
#pragma unroll
            for (int i = 0; i < NV4; ++i) v[u][i] = bf4(xq[u][i]);
        }
        if (t0 + 8 < ntb) ldx(t0 + 8);
        float mu[2], rs[2];
#pragma unroll
        for (int u = 0; u < 2; ++u) { float sum = 0.f;
#pragma unroll
            for (int i = 0; i < NV4; ++i) sum += v[u][i].x + v[u][i].y + v[u][i].z + v[u][i].w;
            mu[u] = sum; }
        { mu[0] = wsum(mu[0]); mu[1] = wsum(mu[1]); }
#pragma unroll
        for (int u = 0; u < 2; ++u) { mu[u] *= (1.f / D_MODEL); float var = 0.f;
#pragma unroll
            for (int i = 0; i < NV4; ++i) { float a = v[u][i].x - mu[u], bq = v[u][i].y - mu[u], c = v[u][i].z - mu[u], d = v[u][i].w - mu[u]; var += a * a + bq * bq + c * c + d * d; }
            rs[u] = var; }
        { rs[0] = wsum(rs[0]); rs[1] = wsum(rs[1]); }
        f32x4 hv[2][NV4];
#pragma unroll
        for (int u = 0; u < 2; ++u) {
            rs[u] = 1.f / sqrtf(rs[u] * (1.f / D_MODEL) + EPS);
            const int tok = base + ti[u];
            if (lane == 0 && ok[u]) { p.STAT[tok * 2] = mu[u]; p.STAT[tok * 2 + 1] = rs[u]; t_mu[ti[u]] = mu[u]; t_rs[ti[u]] = rs[u]; }
#pragma unroll
            for (int i = 0; i < NV4; ++i) {
                const int k = (i * 64 + lane) * 4;
                const f32x4 A = *(const f32x4*)(ab[u] + k), B = *(const f32x4*)(ab[u] + D_MODEL + k);
                hv[u][i] = (v[u][i] - mu[u]) * rs[u] * A + B;
                if (ok[u]) *(u32x2*)(p.H + (size_t)tok * D_MODEL + k) = pk4(hv[u][i]);
            }
        }
        float gl[2][NG];
#pragma unroll
        for (int j = 0; j < NG; ++j) {
#pragma unroll
            for (int u = 0; u < 2; ++u) { float a = 0.f;
#pragma unroll
                for (int i = 0; i < NV4; ++i) { const f32x4 w4 = *(const f32x4*)(L_wg + j * D_MODEL + (i * 64 + lane) * 4); a += hv[u][i].x * w4.x + hv[u][i].y * w4.y + hv[u][i].z * w4.z + hv[u][i].w * w4.w; }
                gl[u][j] = a; }
        }
#pragma unroll
        for (int j = 0; j < NG; ++j) { gl[0][j] = wsum(gl[0][j]); gl[1][j] = wsum(gl[1][j]); }
#pragma unroll
        for (int u = 0; u < 2; ++u) {
#pragma unroll
            for (int j = 0; j < NG; ++j) gl[u][j] += p.moe_b_group[layer * NG + j];
            int g = 0; float gm = gl[u][0];
#pragma unroll
            for (int j = 1; j < NG; ++j) if (gl[u][j] > gm) { gm = gl[u][j]; g = j; }
            float gs = 0.f;
#pragma unroll
            for (int j = 0; j < NG; ++j) gs += expf(gl[u][j] - gm);
            if (lane == 0 && ok[u]) { t_g[ti[u]] = g; t_gw[ti[u]] = 1.f / gs; }
        }
    }
    __syncthreads();
    if (tid < 4) {
        int n = 0; for (int i = 0; i < ntb; ++i) if (t_g[i] == tid) glist[tid * MAXTB + n++] = i;
        gcount[tid] = n;
    }
    __syncthreads();
    for (int g = 0; g < NG; ++g) {
        const int ng = gcount[g];
        if (ng == 0) continue;
        const float* wre = wr + (size_t)(NG + g * EPG) * D_MODEL;
        for (int i = tid; i < EPG * D_MODEL / 4; i += 256) ((f32x4*)L_we)[i] = ((const f32x4*)wre)[i];
        __syncthreads();
        for (int q0 = wid; q0 < ng; q0 += 8) {
            f32x4 hv[2][NV4]; int ti[2]; bool ok[2];
#pragma unroll
            for (int u = 0; u < 2; ++u) {
                const int q = q0 + 4 * u; ok[u] = q < ng; ti[u] = glist[g * MAXTB + imin(q, ng - 1)]; const int tok = base + ti[u];
                const float* ab = L_ab + (size_t)set_of(tok) * 2 * D_MODEL; const float mu = t_mu[ti[u]], rs = t_rs[ti[u]];
#pragma unroll
                for (int i = 0; i < NV4; ++i) {
                    const int k = (i * 64 + lane) * 4;
                    const f32x4 x = bf4(*(const u32x2*)(p.X + (size_t)tok * D_MODEL + k)); const f32x4 A = *(const f32x4*)(ab + k), B = *(const f32x4*)(ab + D_MODEL + k);
                    hv[u][i] = (x - mu) * rs * A + B;
                }
            }
            float ev[2][EPG];
#pragma unroll
            for (int j = 0; j < EPG; ++j) {
#pragma unroll
                for (int u = 0; u < 2; ++u) { float a = 0.f;
#pragma unroll
                    for (int i = 0; i < NV4; ++i) { const f32x4 w4 = *(const f32x4*)(L_we + j * D_MODEL + (i * 64 + lane) * 4); a += hv[u][i].x * w4.x + hv[u][i].y * w4.y + hv[u][i].z * w4.z + hv[u][i].w * w4.w; }
                    ev[u][j] = a; }
            }
#pragma unroll
            for (int j = 0; j < EPG; ++j) { ev[0][j] = wsum(ev[0][j]); ev[1][j] = wsum(ev[1][j]); }
#pragma unroll
            for (int u = 0; u < 2; ++u) {
#pragma unroll
                for (int j = 0; j < EPG; ++j) ev[u][j] += p.moe_b_router[layer * NE + g * EPG + j];
                int i1 = 0; float v1 = ev[u][0];
#pragma unroll
                for (int j = 1; j < EPG; ++j) if (ev[u][j] > v1) { v1 = ev[u][j]; i1 = j; }
                int i2 = -1; float v2 = -3.0e38f;
#pragma unroll
                for (int j = 0; j < EPG; ++j) if (j != i1 && ev[u][j] > v2) { v2 = ev[u][j]; i2 = j; }
                const float gwt = t_gw[ti[u]];
                const float e2 = expf(v2 - v1); const float w1 = gwt / (1.f + e2), w2 = gwt * e2 / (1.f + e2);
                if (lane == 0 && ok[u]) {
                    const int ea = g * EPG + i1, eb = g * EPG + i2;
                    const int ra = atomicAdd(lcnt + ea, 1), rb = atomicAdd(lcnt + eb, 1);
                    int* rc = rec + ti[u] * 8;
                    rc[0] = base + ti[u]; rc[1] = ea; rc[2] = eb; rc[3] = ra; rc[4] = rb; rc[5] = (int)__float_as_uint(w1); rc[6] = (int)__float_as_uint(w2);
                }
            }
        }
        __syncthreads();
    }
    if (tid < 32) { const int c = lcnt[tid]; lbase[tid] = c ? atomicAdd(p.CNT + (layer * NE + tid) * 32, c) : 0; }
    __syncthreads();
    for (int i = tid; i < MAXTB; i += 256) {
        const int* rc = rec + i * 8; const int tk = rc[0];
        if (tk >= 0) {
            const int ea = rc[1], eb = rc[2]; const int pa = lbase[ea] + rc[3], pb = lbase[eb] + rc[4];
            p.LIST[(size_t)ea * NTOK + pa] = tk * 2; p.LISTW[(size_t)ea * NTOK + pa] = __uint_as_float((unsigned)rc[5]);
            p.LIST[(size_t)eb * NTOK + pb] = tk * 2 + 1; p.LISTW[(size_t)eb * NTOK + pb] = __uint_as_float((unsigned)rc[6]);
        }
    }
    }
}

struct EpGU {
    const Params& p; int slot0, nvalid, col0;
    DEV void nat(f32x4 (&acc)[4][4], int wr, int wc, int lane) {
        const int r = lane & 15, quad = lane >> 4; const int j0 = (col0 + wc * 64) >> 1;
#pragma unroll
        for (int m = 0; m < 4; ++m) {
            const int rl = wr * 64 + m * 16 + r;
            if (rl < nvalid) {
                bf16_t* d = p.ACT + (size_t)(slot0 + rl) * D_EXPERT + j0 + quad * 4;
#pragma unroll
                for (int n = 0; n < 2; ++n) {
                    u32x2 w; w.x = pack2(siluf(acc[m][n][0]) * acc[m][n + 2][0], siluf(acc[m][n][1]) * acc[m][n + 2][1]);
                    w.y = pack2(siluf(acc[m][n][2]) * acc[m][n + 2][2], siluf(acc[m][n][3]) * acc[m][n + 2][3]);
                    *(u32x2*)(d + n * 16) = w;
                }
            }
        }
    }
    DEV void operator()(f32x4 (&acc)[4][4], int wr, int wc, int lane) {
        const int r = lane & 15, quad = lane >> 4; const int j0 = (col0 + wc * 64) >> 1;
#pragma unroll
        for (int m = 0; m < 4; ++m)
#pragma unroll
            for (int j = 0; j < 4; ++j) {
                const int rl = wr * 64 + m * 16 + quad * 4 + j;
                if (rl < nvalid) {
                    bf16_t* d = p.ACT + (size_t)(slot0 + rl) * D_EXPERT + j0 + r;
                    d[0] = f2bf(siluf(acc[m][0][j]) * acc[m][2][j]); d[16] = f2bf(siluf(acc[m][1][j]) * acc[m][3][j]);
                }
            }
    }
};
struct EpDown {
    const Params& p; const float* lw; const int* lp; int nvalid, col0;
    DEV void nat(f32x4 (&acc)[4][4], int wr, int wc, int lane) {
        const int r = lane & 15, quad = lane >> 4;
#pragma unroll
        for (int m = 0; m < 4; ++m) {
            const int rl = wr * 64 + m * 16 + r;
            if (rl < nvalid) {
                const float w = lw[rl]; bf16_t* d = p.YS + (size_t)lp[rl] * D_MODEL + col0 + wc * 64 + quad * 4;
#pragma unroll
                for (int n = 0; n < 4; ++n) { u32x2 o; o.x = pack2(w * acc[m][n][0], w * acc[m][n][1]); o.y = pack2(w * acc[m][n][2], w * acc[m][n][3]); *(u32x2*)(d + n * 16) = o; }
            }
        }
    }
    DEV void operator()(f32x4 (&acc)[4][4], int wr, int wc, int lane) {}
};
template <bool DOWN>
DEV void phaseHI(const Params& p, int layer, unsigned char* smem) {
    int* tpre = (int*)(smem + 74 * 1024); int* sbase = tpre + 40;
    const int tid = tid_(); const int bid = bid_();
    __syncthreads();
    if (tid == 0) {
        int ta = 0, sa = 0;
        for (int e = 0; e < NE; ++e) { const int c = p.CNT[(layer * NE + e) * 32]; tpre[e] = ta; sbase[e] = sa; ta += (c + 127) >> 7; sa += c; }
        tpre[NE] = ta;
        if (bid == 0 && !DOWN) for (int e = 0; e < NE; ++e) p.BASE[e] = sbase[e];
    }
    __syncthreads();
    const int ncol = DOWN ? D_MODEL / 256 : 2 * D_EXPERT / 256; const int ntile = tpre[NE] * ncol;
    const int trow = tid >> 2, lc8 = g2_lc(tid) * 8;
    const WorkRange wr = xcd_range(ntile, bid);
    for (int t = wr.lo; t < wr.hi; t += wr.step) {
        int e = 0;
        for (int q = 1; q < NE; ++q) if (tpre[q] * ncol <= t) e = q;
        const int nrt = tpre[e + 1] - tpre[e]; const int q2 = t - tpre[e] * ncol; const int ct = q2 / nrt, rt = q2 % nrt;
        const int cnt = p.CNT[(layer * NE + e) * 32]; const int nvalid = imin(128, cnt - rt * 128); const int slot0 = sbase[e] + rt * 128;
        if (!DOWN) {
            const int* list = p.LIST + (size_t)e * NTOK + rt * 128;
            const int r0 = imin(trow, nvalid - 1), r1 = imin(64 + trow, nvalid - 1);
            const bf16_t* a0 = p.H + (size_t)(list[r0] >> 1) * D_MODEL + lc8; const bf16_t* a1 = p.H + (size_t)(list[r1] >> 1) * D_MODEL + lc8;
            const bf16_t* bw = p.Wgu + ((size_t)(layer * NE + e) * 2 * D_EXPERT + ct * 256 + trow) * D_MODEL + lc8;
            EpGU ep{p, slot0, nvalid, ct * 256};
            gemm_tile2<2, true>(smem, a0, a1, bw, D_MODEL, D_MODEL / 32, ep);
        } else {
            const bf16_t* a0 = p.ACT + (size_t)(slot0 + trow) * D_EXPERT + lc8;
            const bf16_t* bw = p.WdT + ((size_t)(layer * NE + e) * D_MODEL + ct * 256 + trow) * D_EXPERT + lc8;
            EpDown ep{p, p.LISTW + (size_t)e * NTOK + rt * 128, p.LIST + (size_t)e * NTOK + rt * 128, nvalid, ct * 256};
            gemm_tile2<2, true>(smem, a0, a0 + (size_t)64 * D_EXPERT, bw, D_EXPERT, D_EXPERT / 32, ep);
        }
    }
}

DEV void phaseJ(const Params& p, int layer, unsigned char* smem) {
    const bool with_ctx = layer < DEPTH - 1; const bool last = layer == DEPTH - 1;
    const int tid = tid_(); const int wid = tid >> 6, lane = tid & 63; const int bid = bid_();
    const float* lg1 = p.ln_g + (size_t)(layer * 2) * D_MODEL; const float* lb1 = p.ln_b + (size_t)(layer * 2) * D_MODEL;
    const float* lg = p.ln_g + (size_t)(layer * 2 + 1) * D_MODEL; const float* lb = p.ln_b + (size_t)(layer * 2 + 1) * D_MODEL;
    float* L_a1 = (float*)smem; float* L_b1 = L_a1 + D_MODEL; float* L_g2 = L_b1 + D_MODEL; float* L_b2 = L_g2 + D_MODEL; float* L_set = L_b2 + D_MODEL;
    static_assert((4 + 9) * D_MODEL * 4 <= LDS_BYTES - 16, "phase J LDS image");
    constexpr int MAXTB = 48;
    const int NTB = imin((NTOK + (int)gridDim.x - 1) / (int)gridDim.x, MAXTB); const int nruns = (NTOK + NTB - 1) / NTB;
    __syncthreads();
    for (int i = tid; i < D_MODEL / 4; i += 256) {
        ((f32x4*)L_a1)[i] = ALPHA * ((const f32x4*)lg1)[i]; ((f32x4*)L_b1)[i] = ALPHA * ((const f32x4*)lb1)[i]; ((f32x4*)L_g2)[i] = ((const f32x4*)lg)[i]; ((f32x4*)L_b2)[i] = ((const f32x4*)lb)[i];
    }
    for (int run = bid; run < nruns; run += gridDim.x) {
        const int base = run * NTB; const int ntb = imin(NTB, NTOK - base); const int b_first = base / TT;
        __syncthreads();
        for (int i = tid; i < 3 * D_MODEL / 4; i += 256) {
            const int set = i / (D_MODEL / 4), q = i % (D_MODEL / 4); const int bb = set == 0 ? BATCH : imin(b_first + set - 1, BATCH - 1);
            float* dst = L_set + (size_t)set * 3 * D_MODEL;
            ((f32x4*)dst)[q] = ((const f32x4*)(p.MOD + ((size_t)layer * (BATCH + 1) + bb) * 6 * D_MODEL + 5 * D_MODEL))[q];
            if (!last) {
                const float* mn = p.MOD + ((size_t)(layer + 1) * (BATCH + 1) + bb) * 6 * D_MODEL;
                const f32x4 sh = ((const f32x4*)mn)[q], sc = ((const f32x4*)(mn + D_MODEL))[q], g4 = ((const f32x4*)lg)[q], b4 = ((const f32x4*)lb)[q];
                ((f32x4*)(dst + D_MODEL))[q] = g4 * (1.f + sc); ((f32x4*)(dst + 2 * D_MODEL))[q] = b4 * (1.f + sc) + sh;
            }
        }
        __syncthreads();
        u32x2 xn[NV4], an[NV4], cn[NV4]; float mun = 0.f, rsn = 0.f;
        auto ldt = [&](int ti) {
            const int tok = base + ti;
#pragma unroll
            for (int i = 0; i < NV4; ++i) {
                const int k = (i * 64 + lane) * 4;
                xn[i] = *(const u32x2*)(p.X + (size_t)tok * D_MODEL + k); an[i] = *(const u32x2*)(p.YS + (size_t)(tok * 2) * D_MODEL + k); cn[i] = *(const u32x2*)(p.YS + (size_t)(tok * 2 + 1) * D_MODEL + k);
            }
            mun = p.STAT[tok * 2]; rsn = p.STAT[tok * 2 + 1]; };
        if (wid < ntb) ldt(wid);
        for (int ti = wid; ti < ntb; ti += 4) {
            u32x2 x[NV4], a[NV4], c[NV4]; const float mu1 = mun, rs1 = rsn;
#pragma unroll
            for (int i = 0; i < NV4; ++i) { x[i] = xn[i]; a[i] = an[i]; c[i] = cn[i]; }
            if (ti + 4 < ntb) ldt(ti + 4);
            const int tok = base + ti; const int b = tok / TT, s = tok % TT; if (!with_ctx && s < CTX) continue;
            const float* ps = L_set + (size_t)(s < CTX ? 0 : 1 + (b - b_first)) * 3 * D_MODEL;
            f32x4 v[NV4]; float sum = 0.f;
#pragma unroll
            for (int i = 0; i < NV4; ++i) {
                const int k = (i * 64 + lane) * 4; const f32x4 g = *(const f32x4*)(ps + k), a1 = *(const f32x4*)(L_a1 + k), b1 = *(const f32x4*)(L_b1 + k);
                v[i] = (bf4(x[i]) - mu1) * rs1 * a1 + b1 + g * (bf4(a[i]) + bf4(c[i]));
                sum += v[i].x + v[i].y + v[i].z + v[i].w;
            }
            const float mu = wsum(sum) * (1.f / D_MODEL); float var = 0.f;
#pragma unroll
            for (int i = 0; i < NV4; ++i) { float a0 = v[i].x - mu, bq = v[i].y - mu, c0 = v[i].z - mu, d = v[i].w - mu; var += a0 * a0 + bq * bq + c0 * c0 + d * d; }
            const float rs = 1.f / sqrtf(wsum(var) * (1.f / D_MODEL) + EPS);
            float* dst = p.out + ((size_t)b * SEQ + (s - CTX)) * D_MODEL; bf16_t* dx = p.X + (size_t)tok * D_MODEL;
#pragma unroll
            for (int i = 0; i < NV4; ++i) {
                const int k = (i * 64 + lane) * 4; const f32x4 g4 = *(const f32x4*)(L_g2 + k), b4 = *(const f32x4*)(L_b2 + k);
                const f32x4 xh = (v[i] - mu) * rs;
                const f32x4 o = xh * g4 + b4;
                if (last) *(f32x4*)(dst + k) = o;
                else {
                    *(u32x2*)(dx + k) = pk4(o);
                    const f32x4 A2 = *(const f32x4*)(ps + D_MODEL + k), B2 = *(const f32x4*)(ps + 2 * D_MODEL + k);
                    *(u32x2*)(p.HIN + (size_t)tok * D_MODEL + k) = pk4(xh * A2 + B2);
                }
            }
        }
    }
}

constexpr int PH_PER_LAYER = 10;
constexpr int NPHASE = 2 + DEPTH * PH_PER_LAYER;
DEV void run_phase(const Params& p, int ph, unsigned char* smem) {
    if (ph == 0) { phase0(p, smem); return; }
    if (ph == 1) { phase0b(p); return; }
    const int layer = (ph - 2) / PH_PER_LAYER, sub = (ph - 2) % PH_PER_LAYER;
    switch (sub) {
        case 0: phaseA(p, layer, smem); break;
        case 1: if (!(layer & 1)) phaseB(p, layer); break;
        case 2: phaseC(p, layer, smem); break;
        case 3: phaseD(p, layer); break;
        case 4: phaseE(p, layer, smem); break;
        case 5: phaseF(p, layer, smem); break;
        case 6: phaseG(p, layer, smem); break;
        case 7: phaseHI<false>(p, layer, smem); break;
        case 8: phaseHI<true>(p, layer, smem); break;
        default: phaseJ(p, layer, smem); break;
    }
}
DEV bool phase_is_empty(int ph) { if (ph < 2) return false; return ((ph - 2) % PH_PER_LAYER) == 1 && (((ph - 2) / PH_PER_LAYER) & 1); }

struct Carver { char* base; size_t off; template <class T> T* take(size_t n) { off = (off + 255) & ~(size_t)255; T* r = (T*)(base + off); off += n * sizeof(T); return r; } };
static void make_params(Params& p, void* const* d_in, void* d_out, void* d_ws) {
    const float** in = (const float**)d_in;
    p.x = in[0]; p.c = in[1]; p.ctx = in[2]; p.c_ctx = in[3]; p.w_mod = in[4]; p.b_mod = in[5]; p.ln_g = in[6]; p.ln_b = in[7];
    p.ev_w_in = in[8]; p.ev_w_out = in[9]; p.ev_lambda = in[10]; p.ev_subln_g = in[11]; p.ev_conv_w = in[12]; p.ev_conv_b = in[13];
    p.ev_gate_b = in[14]; p.ev_mnorm_g = in[15]; p.od_w_in = in[16]; p.od_w_out = in[17]; p.od_decay = in[18]; p.od_qk_g = in[19];
    p.moe_w_group = in[20]; p.moe_b_group = in[21]; p.moe_w_router = in[22]; p.moe_b_router = in[23]; p.moe_w_gate = in[24]; p.moe_w_up = in[25]; p.moe_w_down = in[26];
    p.out = (float*)d_out;
    Carver cv{(char*)d_ws, 0};
    p.X = cv.take<bf16_t>((size_t)NTOK * D_MODEL);
    p.MOD = cv.take<float>((size_t)DEPTH * (BATCH + 1) * 6 * D_MODEL);
    p.ROPE = cv.take<float>(64 * 16 * 2); p.LAM = cv.take<float>(4);
    p.WrT = cv.take<float>((size_t)DEPTH * NR * D_MODEL);
    p.CNT = cv.take<int>(DEPTH * NE * 32); p.BASE = cv.take<int>(NE); p.BAR = cv.take<unsigned>(4096);
    p.WinE = cv.take<bf16_t>((size_t)2 * EVEN_INP * D_MODEL); p.WinO = cv.take<bf16_t>((size_t)2 * ODD_IN * D_MODEL);
    p.WoutT = cv.take<bf16_t>((size_t)DEPTH * D_MODEL * MIX_OUT);
    p.Wgu = cv.take<bf16_t>((size_t)DEPTH * NE * 2 * D_EXPERT * D_MODEL); p.WdT = cv.take<bf16_t>((size_t)DEPTH * NE * D_MODEL * D_EXPERT);
    p.STAT = cv.take<float>((size_t)NTOK * 2);
    p.CAT = cv.take<bf16_t>((size_t)NTOK * 1024); p.HIN = cv.take<bf16_t>((size_t)NTOK * D_MODEL);
    p.LIST = cv.take<int>((size_t)NE * NTOK); p.LISTW = cv.take<float>((size_t)NE * NTOK); p.TOKSLOT = cv.take<int>((size_t)NTOK * 2);
    const size_t mix0 = cv.off;
    p.Q1 = cv.take<bf16_t>((size_t)NTOK * 512); p.K1 = cv.take<bf16_t>((size_t)NTOK * 512); p.V1T = cv.take<bf16_t>((size_t)NTOK * 512);
    p.PM = cv.take<bf16_t>((size_t)NTOK * 1024); p.V2T = cv.take<bf16_t>((size_t)NTOK * 512); p.OG = cv.take<bf16_t>((size_t)NTOK * 512);
    p.G = cv.take<float>((size_t)NTOK * 16);
    p.Q2 = cv.take<bf16_t>((size_t)NTOK * 512); p.K2 = cv.take<bf16_t>((size_t)NTOK * 512); p.K2T = cv.take<bf16_t>((size_t)NTOK * 512);
    p.DC = cv.take<bf16_t>((size_t)NCHAIN * NCH * EVR * 128); p.CP = cv.take<bf16_t>((size_t)NCHAIN * NCH * EVR * 128);
    p.BC = cv.take<float>((size_t)NCHAIN * TT); p.AT = cv.take<float>((size_t)NCHAIN * TT); p.MT = cv.take<float>((size_t)NCHAIN * TT); p.MS = cv.take<float>((size_t)NCHAIN * NCH * 4); p.CH2 = cv.take<float>((size_t)NCHAIN * NCH * 2);
    cv.off = mix0;
    p.H = cv.take<bf16_t>((size_t)NTOK * D_MODEL); p.ACT = cv.take<bf16_t>((size_t)(2 * NTOK + 128) * D_EXPERT); p.YS = cv.take<bf16_t>((size_t)2 * NTOK * D_MODEL);
}

#ifndef CPU_EMU
#define XB_TMO      128
#define XB_XCNT(j)  (256  + 64 * (j))
#define XB_XSUB(j)  (1280 + 64 * (j))
#define XB_XGEN(j)  (2304 + 64 * (j))
#define XB_TOP      3328
#define XB_TOPGEN   3392
#define XCD_BAR_WORDS 3456
#define XB_SPIN_CAP (1u << 20)
#define LAS __attribute__((address_space(3)))
__device__ __forceinline__ unsigned xb_ld(unsigned* p)              { return __hip_atomic_load(p, __ATOMIC_RELAXED, __HIP_MEMORY_SCOPE_AGENT); }
__device__ __forceinline__ unsigned xb_add(unsigned* p, unsigned v) { return __hip_atomic_fetch_add(p, v, __ATOMIC_RELAXED, __HIP_MEMORY_SCOPE_AGENT); }
__device__ __forceinline__ unsigned xb_xcc_id() { return (unsigned)__builtin_amdgcn_s_getreg((3 << 11) | 20) & 0xFu; }
#define XB_SPIN(cond, bar) do { unsigned _sp = 0; while (cond) { __builtin_amdgcn_s_sleep(1); \
    if ((++_sp & 255u) == 0u) { if (xb_ld(&(bar)[XB_TMO])) break; if (_sp > XB_SPIN_CAP) { atomicAdd(&(bar)[XB_TMO], 1u); break; } } } } while (0)
struct XcdBarrier { unsigned* bar; unsigned x; volatile LAS unsigned* st; };
__device__ __forceinline__ XcdBarrier xcd_barrier_post(unsigned* bar, volatile LAS unsigned* st) {
    XcdBarrier b; b.bar = bar; b.x = xb_xcc_id(); b.st = st;
    if (threadIdx.x == 0) (void)xb_add(&bar[XB_XCNT(b.x)], 1u);
    return b;
}
__device__ __forceinline__ void xcd_barrier_complete(unsigned* bar, unsigned x, unsigned& nloc, unsigned& nx) {
    const unsigned G = gridDim.x * gridDim.y * gridDim.z;
    unsigned sum, cnt, mine, sp = 0u;
    for (;;) {
        sum = 0u; cnt = 0u; mine = 0u;
#pragma unroll
        for (unsigned j = 0; j < 16; ++j) { const unsigned c = xb_ld(&bar[XB_XCNT(j)]); sum += c; cnt += (c > 0u) ? 1u : 0u; mine = (j == x) ? c : mine; }
        if (sum == G) break;
        __builtin_amdgcn_s_sleep(1);
        if ((++sp & 255u) == 0u) { if (xb_ld(&bar[XB_TMO])) break; if (sp > XB_SPIN_CAP) { atomicAdd(&bar[XB_TMO], 1u); break; } }
    }
    nloc = mine > 0u ? mine : 1u; nx = cnt > 0u ? cnt : 1u;
}
__device__ __forceinline__ void xcd_barrier(const XcdBarrier& b) {
    asm volatile("s_waitcnt vmcnt(0)" ::: "memory");
    __syncthreads();
    if (threadIdx.x == 0) {
        unsigned* bar = b.bar;
        __builtin_amdgcn_s_waitcnt(0);
        unsigned nloc = b.st[0], nx = b.st[1];
        if (nloc == 0u) { xcd_barrier_complete(bar, b.x, nloc, nx); b.st[0] = nloc; b.st[1] = nx; }
        const unsigned old = xb_add(&bar[XB_XSUB(b.x)], 1u);
        const unsigned gen = old / nloc;
        if (old + 1u == (gen + 1u) * nloc) {
            __builtin_amdgcn_fence(__ATOMIC_RELEASE, "agent");
            asm volatile("s_waitcnt vmcnt(0)" ::: "memory");
            const unsigned og = xb_add(&bar[XB_TOP], 1u);
            const unsigned tg = og / nx;
            if (og + 1u == (tg + 1u) * nx) xb_add(&bar[XB_TOPGEN], 1u);
            else XB_SPIN(xb_ld(&bar[XB_TOPGEN]) == tg, bar);
            __builtin_amdgcn_fence(__ATOMIC_ACQUIRE, "agent");
            xb_add(&bar[XB_XGEN(b.x)], 1u);
            asm volatile("s_waitcnt vmcnt(0)" ::: "memory");
        } else {
            XB_SPIN(xb_ld(&bar[XB_XGEN(b.x)]) == gen, bar);
            __builtin_amdgcn_fence(__ATOMIC_ACQUIRE, "agent");
            asm volatile("s_waitcnt vmcnt(0)" ::: "memory");
        }
    }
    __syncthreads();
}

__global__ void __launch_bounds__(NTHREADS, 2) fwd_megakernel(Params p) {
    __shared__ __attribute__((aligned(16))) unsigned char smem[LDS_BYTES];
    cg::grid_group grid = cg::this_grid();
    volatile LAS unsigned* xst = (volatile LAS unsigned*)(smem + LDS_BYTES - 16);
    if (threadIdx.x == 0) { xst[0] = 0u; xst[1] = 0u; }
    __syncthreads();
    const XcdBarrier xb = xcd_barrier_post(p.BAR, xst);
    grid.sync();
#ifdef PROBE_TS
    unsigned long long ts_acc = 0ull;
#endif
    for (int ph = 0; ph < NPHASE; ++ph) {
        if (phase_is_empty(ph)) continue;
#ifdef PROBE_TS
        const int psub_ = ph == 0 ? 10 : ph == 1 ? 11 : (ph - 2) % PH_PER_LAYER;
        const unsigned long long ts0 = __builtin_amdgcn_s_memrealtime();
#endif
#if defined(__HIP_DEVICE_COMPILE__)
        const __attribute__((address_space(4))) Params* pp = (const __attribute__((address_space(4))) Params*)__builtin_amdgcn_kernarg_segment_ptr();
        asm volatile("" : "+s"(pp));
        const Params q = *pp;
        run_phase(q, ph, smem);
#ifdef DBL_MASK
        { const int sub_ = ph == 0 ? 10 : ph == 1 ? 11 : (ph - 2) % PH_PER_LAYER; if ((DBL_MASK >> sub_) & 1) run_phase(q, ph, smem); }
#endif
#else
        run_phase(p, ph, smem);
#endif
#ifdef PROBE_TS
        const unsigned long long ts1 = __builtin_amdgcn_s_memrealtime();
        xcd_barrier(xb);
        const unsigned long long ts2 = __builtin_amdgcn_s_memrealtime();
        if (PROBE_TS == 100) ts_acc += ts2 - ts1; else if (psub_ == PROBE_TS) ts_acc += ts2 - ts0;
#else
        if (ph + 1 < NPHASE) xcd_barrier(xb);
#endif
    }
#ifdef PROBE_TS
    if (blockIdx.x == 0) { const int np = (int)(ts_acc / 100ull); for (int i = threadIdx.x; i < np; i += NTHREADS) p.out[i] += 1.0f; }
#endif
}

extern "C" void kernel_launch(void* const* d_in, const int* in_sizes, int n_in, void* d_out, int out_size, void* d_ws, size_t ws_size, hipStream_t stream) {
    static int grid_blocks = 0;
    if (!grid_blocks) {
        int dev = 0, cus = 0, per_cu = 0;
        (void)hipGetDevice(&dev); (void)hipDeviceGetAttribute(&cus, hipDeviceAttributeMultiprocessorCount, dev);
        (void)hipOccupancyMaxActiveBlocksPerMultiprocessor(&per_cu, fwd_megakernel, NTHREADS, 0);
        if (per_cu > 2) per_cu = 2;
        if (per_cu < 1) per_cu = 1;
        grid_blocks = cus * per_cu;
    }
    Params p; memset(&p, 0, sizeof(p));
    make_params(p, d_in, d_out, d_ws);
    (void)hipMemsetAsync(p.BAR, 0, 4096 * sizeof(unsigned), stream);
    void* args[] = {&p};
    hipError_t e = hipLaunchCooperativeKernel((void*)fwd_megakernel, dim3(grid_blocks), dim3(NTHREADS), args, 0, stream);
    if (e != hipSuccess) fprintf(stderr, "cooperative launch failed: %s (grid %d)\n", hipGetErrorString(e), grid_blocks);
}
#endif

#if defined(DIAG_KERNELS) && !defined(CPU_EMU)
template <int SUB, int ODD>
__global__ void __launch_bounds__(NTHREADS, 2) k_diag(Params p, int l2) {
    __shared__ __attribute__((aligned(16))) unsigned char smem[LDS_BYTES];
    const int layer = l2 * 2 + ODD;
    if (SUB == 100) { phase0(p, smem); return; }
    if (SUB == 0) phaseA(p, layer, smem);
    if (SUB == 1) phaseB(p, layer);
    if (SUB == 20) { for (int it = bid_(); it < 100; it += gridDim.x) { if (ODD) attn_gqa_item(p, it, (bf16_t*)smem); else attn_diff_item(p, layer, it, (bf16_t*)smem); } }
    if (SUB == 21) { for (int it = bid_(); it < 100; it += gridDim.x) { if (ODD) rec_dc_item<64, false>(p, it, (bf16_t*)smem); else rec_dc_item<128, true>(p, it, (bf16_t*)smem); } }
    if (SUB == 3) phaseD(p, layer);
    if (SUB == 4) phaseE(p, layer, smem);
    if (SUB == 5) phaseF(p, layer, smem);
    if (SUB == 6) phaseG(p, layer, smem);
    if (SUB == 7) phaseHI<false>(p, layer, smem);
    if (SUB == 8) phaseHI<true>(p, layer, smem);
    if (SUB == 9) phaseJ(p, layer, smem);
}
template __global__ void k_diag<100, 0>(Params, int);
template __global__ void k_diag<0, 0>(Params, int);
template __global__ void k_diag<0, 1>(Params, int);
template __global__ void k_diag<1, 0>(Params, int);
template __global__ void k_diag<20, 0>(Params, int);
template __global__ void k_diag<20, 1>(Params, int);
template __global__ void k_diag<21, 0>(Params, int);
template __global__ void k_diag<21, 1>(Params, int);
template __global__ void k_diag<3, 0>(Params, int);
template __global__ void k_diag<4, 0>(Params, int);
template __global__ void k_diag<4, 1>(Params, int);
template __global__ void k_diag<5, 0>(Params, int);
template __global__ void k_diag<6, 0>(Params, int);
template __global__ void k_diag<7, 0>(Params, int);
template __global__ void k_diag<8, 0>(Params, int);
template __global__ void k_diag<9, 0>(Params, int);
#endif
```
